# Optimizing an MI355X kernel written in HIP

```python
import jax, jax.numpy as jnp
from jax import lax
import numpy as np

D_MODEL = 1024
BATCH = 8
SEQ = 4096
DEPTH = 2

N_BRANCH = 3
BRANCH_W = D_MODEL // 2
NORM_EPS = 1e-6
MAX_POS_OFFSET = 1024
MLA_HEADS = 8
MLA_NOPE = 64
MLA_ROPE = 32
MLA_V = BRANCH_W // MLA_HEADS
MLA_Q_LORA = 256
MLA_KV_LORA = 128
ROPE_BASE = 10000.0
Q_BLOCK = 128
RWKV_HEADS = 8
RWKV_HEAD = BRANCH_W // RWKV_HEADS
RWKV_DECAY_RANK = 64
RWKV_ICLR_RANK = 64
RWKV_IN = 3 * BRANCH_W + RWKV_DECAY_RANK + RWKV_ICLR_RANK
RWKV_GN_EPS = 64e-5
GLA_HEADS = 4
GLA_DK = 64
GLA_DV = BRANCH_W // GLA_HEADS
GLA_GATE_RANK = 16
GLA_TAU = 16.0
GLA_CHUNK = 64
IN_SIZES = (MLA_Q_LORA, MLA_KV_LORA, MLA_ROPE, RWKV_IN,
            GLA_HEADS * GLA_DK, GLA_HEADS * GLA_DK, GLA_HEADS * GLA_DV, GLA_GATE_RANK,
            N_BRANCH * BRANCH_W, N_BRANCH * D_MODEL)
N_IN = sum(IN_SIZES)

kernel_name = "hybrid_mla_rwkv7_gla_gated_merge"


def rms_norm(x, g, eps=NORM_EPS):
    xf = x.astype(jnp.float32)
    y = xf * lax.rsqrt(jnp.mean(xf * xf, axis=-1, keepdims=True) + eps)
    return (y * g.astype(jnp.float32)).astype(x.dtype)


def rope_tables(positions):
    inv = 1.0 / (ROPE_BASE ** (jnp.arange(0, MLA_ROPE, 2, dtype=jnp.float32) / MLA_ROPE))
    ang = positions.astype(jnp.float32)[..., None] * inv
    return jnp.cos(ang), jnp.sin(ang)


def apply_rope(x, cos, sin):
    xf = x.astype(jnp.float32)
    x1, x2 = xf[..., : MLA_ROPE // 2], xf[..., MLA_ROPE // 2:]
    return jnp.concatenate([x1 * cos - x2 * sin, x2 * cos + x1 * sin], axis=-1).astype(x.dtype)


def mla_branch(c_q, c_kv, k_rope, cos, sin, q_norm, kv_norm, w_uq, w_ukv):
    B, S, _ = c_q.shape
    q = (rms_norm(c_q, q_norm) @ w_uq).reshape(B, S, MLA_HEADS, MLA_NOPE + MLA_ROPE)
    q_nope = q[..., :MLA_NOPE]
    q_rope = apply_rope(q[..., MLA_NOPE:], cos[:, :, None, :], sin[:, :, None, :])
    kv = (rms_norm(c_kv, kv_norm) @ w_ukv).reshape(B, S, MLA_HEADS, MLA_NOPE + MLA_V)
    k_nope, v = kv[..., :MLA_NOPE], kv[..., MLA_NOPE:]
    k_r = apply_rope(k_rope, cos, sin)
    scale = (MLA_NOPE + MLA_ROPE) ** -0.5
    n_blk = S // Q_BLOCK
    qn_b = q_nope.reshape(B, n_blk, Q_BLOCK, MLA_HEADS, MLA_NOPE).transpose(1, 0, 2, 3, 4)
    qr_b = q_rope.reshape(B, n_blk, Q_BLOCK, MLA_HEADS, MLA_ROPE).transpose(1, 0, 2, 3, 4)
    k_idx = jnp.arange(S)

    def block(args):
        qn, qr, i = args
        s = (jnp.einsum('bqhd,bkhd->bhqk', qn, k_nope)
             + jnp.einsum('bqhr,bkr->bhqk', qr, k_r)).astype(jnp.float32) * scale
        q_idx = i * Q_BLOCK + jnp.arange(Q_BLOCK)
        s = jnp.where(k_idx[None, :] <= q_idx[:, None], s, -jnp.inf)
        p = jax.nn.softmax(s, axis=-1).astype(v.dtype)
        return jnp.einsum('bhqk,bkhd->bqhd', p, v)

    o = lax.map(block, (qn_b, qr_b, jnp.arange(n_blk)))
    return o.transpose(1, 0, 2, 3, 4).reshape(B, S, MLA_HEADS * MLA_V)


def rwkv7_branch(u, mu, w0, w_up, a0, a_up, k_k, k_a, r_k, ln_w, ln_b):
    B, S, _ = u.shape
    W = BRANCH_W
    u_prev = jnp.pad(u[:, :-1], ((0, 0), (1, 0), (0, 0)))
    u = u + (u_prev - u) * mu
    r, k, v, lw, la = jnp.split(u, [W, 2 * W, 3 * W, 3 * W + RWKV_DECAY_RANK], axis=-1)
    w = -jax.nn.softplus(-(w0 + jnp.tanh(lw) @ w_up)) - 0.5
    decay = jnp.exp(-jnp.exp(w.astype(jnp.float32)))
    a = jax.nn.sigmoid(a0 + la @ a_up)
    heads = lambda t: t.astype(jnp.float32).reshape(B, S, RWKV_HEADS, RWKV_HEAD)
    kk = heads(k * k_k)
    kk = kk / jnp.maximum(jnp.sqrt(jnp.sum(kk * kk, axis=-1, keepdims=True)), 1e-12)
    k = k * (1.0 + (a - 1.0) * k_a)
    r_h, k_h, v_h, a_h, w_h = heads(r), heads(k), heads(v), heads(a), heads(decay)

    def step(state, inp):
        r_t, w_t, k_t, v_t, kk_t, a_t = inp
        sa = jnp.einsum('bhvk,bhk->bhv', state, -kk_t)
        state = (state * w_t[:, :, None, :] + sa[..., None] * (kk_t * a_t)[:, :, None, :]
                 + v_t[..., None] * k_t[:, :, None, :])
        return state, jnp.einsum('bhvk,bhk->bhv', state, r_t)

    xs = tuple(t.transpose(1, 0, 2, 3) for t in (r_h, w_h, k_h, v_h, kk, a_h))
    state0 = jnp.zeros((B, RWKV_HEADS, RWKV_HEAD, RWKV_HEAD), jnp.float32)
    _, y = lax.scan(step, state0, xs)
    y = y.transpose(1, 0, 2, 3)
    mean = jnp.mean(y, axis=-1, keepdims=True)
    var = jnp.mean(jnp.square(y - mean), axis=-1, keepdims=True)
    y = ((y - mean) * lax.rsqrt(var + RWKV_GN_EPS)).reshape(B, S, W)
    y = y * ln_w.astype(jnp.float32) + ln_b.astype(jnp.float32)
    bonus = jnp.sum(r_h * k_h * r_k.astype(jnp.float32), axis=-1, keepdims=True) * v_h
    return (y + bonus.reshape(B, S, W)).astype(u.dtype)


def gla_branch(q, k, v, lat, a_up, a_b, g_norm):
    B, S, _ = q.shape
    H, C = GLA_HEADS, GLA_CHUNK
    n_c = S // C
    log_a = jax.nn.log_sigmoid((lat @ a_up + a_b).astype(jnp.float32)) / GLA_TAU

    def chunks(t, d):
        return t.astype(jnp.float32).reshape(B, n_c, C, H, d).transpose(1, 0, 2, 3, 4)

    qc = chunks(q * GLA_DK ** -0.5, GLA_DK)
    kc = chunks(k, GLA_DK)
    vc = chunks(v, GLA_DV)
    bc = jnp.cumsum(chunks(log_a, GLA_DK), axis=2)
    causal = jnp.tril(jnp.ones((C, C), dtype=bool))[None, :, :, None, None]

    def step(state, inp):
        q_t, k_t, v_t, b_t = inp
        diff = b_t[:, :, None] - b_t[:, None, :]
        dec = jnp.exp(jnp.where(causal, diff, -jnp.inf))
        att = jnp.einsum('bihd,bjhd,bijhd->bhij', q_t, k_t, dec)
        o = (jnp.einsum('bhij,bjhv->bihv', att, v_t)
             + jnp.einsum('bihk,bhkv->bihv', q_t * jnp.exp(b_t), state))
        b_last = b_t[:, -1]
        state = (state * jnp.exp(b_last)[..., None]
                 + jnp.einsum('bjhk,bjhv->bhkv', k_t * jnp.exp(b_last[:, None] - b_t), v_t))
        return state, o

    state0 = jnp.zeros((B, H, GLA_DK, GLA_DV), jnp.float32)
    _, o = lax.scan(step, state0, (qc, kc, vc, bc))
    o = o.transpose(1, 0, 2, 3, 4).reshape(B, S, H, GLA_DV)
    o = rms_norm(o, g_norm.reshape(H, GLA_DV))
    return o.reshape(B, S, H * GLA_DV).astype(q.dtype)


def setup_inputs(seed: int = 0) -> dict:
    key = jax.random.key(seed)
    ks = jax.random.split(key, 24)
    L, W = DEPTH, BRANCH_W

    def dense(k, shape, fan_in, scale=1.0):
        return scale * fan_in ** -0.5 * jax.random.normal(k, shape, jnp.float32)

    def gain(k, shape):
        return 1.0 + 0.05 * jax.random.normal(k, shape, jnp.float32)

    x = jax.random.normal(ks[0], (BATCH, SEQ, D_MODEL), jnp.float32)
    offset = jax.random.randint(ks[1], (BATCH, 1), 0, MAX_POS_OFFSET, dtype=jnp.int32)
    positions = offset + jnp.arange(SEQ, dtype=jnp.int32)[None, :]
    return {
        "x": x,
        "positions": positions,
        "norm_pre": gain(ks[2], (L, D_MODEL)),
        "w_in": dense(ks[3], (L, D_MODEL, N_IN), D_MODEL),
        "mla_q_norm": gain(ks[4], (L, MLA_Q_LORA)),
        "mla_kv_norm": gain(ks[5], (L, MLA_KV_LORA)),
        "mla_w_uq": dense(ks[6], (L, MLA_Q_LORA, MLA_HEADS * (MLA_NOPE + MLA_ROPE)), MLA_Q_LORA),
        "mla_w_ukv": dense(ks[7], (L, MLA_KV_LORA, MLA_HEADS * (MLA_NOPE + MLA_V)), MLA_KV_LORA),
        "rwkv_mu": jax.random.uniform(ks[8], (L, RWKV_IN), jnp.float32),
        "rwkv_w0": jax.random.uniform(ks[9], (L, W), jnp.float32, -6.0, -1.0),
        "rwkv_w_up": dense(ks[10], (L, RWKV_DECAY_RANK, W), RWKV_DECAY_RANK, 0.5),
        "rwkv_a0": 0.1 * jax.random.normal(ks[11], (L, W), jnp.float32),
        "rwkv_a_up": dense(ks[12], (L, RWKV_ICLR_RANK, W), RWKV_ICLR_RANK, 0.5),
        "rwkv_k_k": 0.85 + 0.05 * jax.random.normal(ks[13], (L, W), jnp.float32),
        "rwkv_k_a": 1.0 + 0.05 * jax.random.normal(ks[14], (L, W), jnp.float32),
        "rwkv_r_k": 0.1 * jax.random.normal(ks[15], (L, RWKV_HEADS, RWKV_HEAD), jnp.float32),
        "rwkv_ln_w": gain(ks[16], (L, W)),
        "rwkv_ln_b": 0.01 * jax.random.normal(ks[17], (L, W), jnp.float32),
        "gla_a_up": dense(ks[18], (L, GLA_GATE_RANK, GLA_HEADS * GLA_DK), GLA_GATE_RANK),
        "gla_a_b": 0.1 * jax.random.normal(ks[19], (L, GLA_HEADS * GLA_DK), jnp.float32),
        "gla_norm": gain(ks[20], (L, W)),
        "w_branch_out": dense(ks[21], (L, N_BRANCH, W, D_MODEL), W),
        "w_out": dense(ks[22], (L, D_MODEL, D_MODEL), D_MODEL),
        "norm_post": gain(ks[23], (L, D_MODEL)),
    }


def reference(x, positions, norm_pre, w_in, mla_q_norm, mla_kv_norm, mla_w_uq, mla_w_ukv,
              rwkv_mu, rwkv_w0, rwkv_w_up, rwkv_a0, rwkv_a_up, rwkv_k_k, rwkv_k_a, rwkv_r_k,
              rwkv_ln_w, rwkv_ln_b, gla_a_up, gla_a_b, gla_norm, w_branch_out, w_out, norm_post):
    B, S, _ = x.shape
    splits = [int(i) for i in np.cumsum(IN_SIZES)[:-1]]
    cos, sin = rope_tables(positions)
    for l in range(DEPTH):
        h = rms_norm(x, norm_pre[l])
        proj = h @ w_in[l]
        (c_q, c_kv, k_rope, u_rwkv, g_q, g_k, g_v, g_lat,
         br_gate, merge_gate) = jnp.split(proj, splits, axis=-1)
        y_mla = mla_branch(c_q, c_kv, k_rope, cos, sin, mla_q_norm[l], mla_kv_norm[l],
                           mla_w_uq[l], mla_w_ukv[l])
        y_rwkv = rwkv7_branch(u_rwkv, rwkv_mu[l], rwkv_w0[l], rwkv_w_up[l], rwkv_a0[l],
                              rwkv_a_up[l], rwkv_k_k[l], rwkv_k_a[l], rwkv_r_k[l],
                              rwkv_ln_w[l], rwkv_ln_b[l])
        y_gla = gla_branch(g_q, g_k, g_v, g_lat, gla_a_up[l], gla_a_b[l], gla_norm[l])
        ys = (jnp.stack([y_mla, y_rwkv, y_gla], axis=2)
              * jax.nn.silu(br_gate).reshape(B, S, N_BRANCH, BRANCH_W))
        branch = jnp.einsum('bsnw,nwd->bsnd', ys, w_branch_out[l])
        merged = jnp.sum(jax.nn.sigmoid(merge_gate).reshape(B, S, N_BRANCH, D_MODEL) * branch, axis=2)
        x = x + rms_norm(merged @ w_out[l], norm_post[l])
    return x
```

```cpp
#include <hip/hip_runtime.h>
#include <hip/hip_cooperative_groups.h>
#include <cstdio>
#include <cstdint>
#include <cmath>
namespace cg = cooperative_groups;
namespace pg8 {
#define PG8_LAS __attribute__((address_space(3)))
typedef unsigned short bf16_t;
typedef short bf16x8 __attribute__((ext_vector_type(8)));
typedef float f32x4 __attribute__((ext_vector_type(4)));
typedef unsigned u32x4 __attribute__((ext_vector_type(4)));
typedef unsigned u32x2 __attribute__((ext_vector_type(2)));
constexpr int BM = 256, BK = 64, HALF = 128, HTB = HALF * BK * 2  , STAGE_BYTES = 8 * HTB, NXCD = 8, WGM = 8;

__host__ __device__ __forceinline__ int lds_byte(int r, int c) { const int st = (r >> 4) * 2 + (c >> 5), rr = r & 15, cc = c & 31, ob = rr * 64 + cc * 2; return st * 1024 + (ob ^ (((ob >> 9) & 1) << 5)); }
__host__ __device__ __forceinline__ void stage_rc(int b, int& R, int& C) { const int st = b / 1024, sb = b % 1024, swz = sb ^ (((sb >> 9) & 1) << 5); R = (st >> 1) * 16 + swz / 64; C = (st & 1) * 32 + (swz % 64) / 2; }
__host__ __device__ __forceinline__ int perm32(int rho) { const int n = rho >> 4, i = rho & 15; return 8 * (i >> 2) + 4 * n + (i & 3); }

struct Unit { int pm, pn, aux; const char* A; const char* B; };
struct Gemm { int lda, ldb, K; };

__device__ __forceinline__ void tile_of(int L, int nM, int nN, int& pm, int& pn) {
    const int nwg = nM * nN; int wgid = L;
    { const int q = nwg / NXCD, r = nwg % NXCD, xcd = wgid % NXCD, off = wgid / NXCD; wgid = (xcd < r ? xcd * (q + 1) : r * (q + 1) + (xcd - r) * q) + off; }
    const int nig = WGM * nN, gid = wgid / nig, fm = gid * WGM, gsz = (nM - fm) < WGM ? (nM - fm) : WGM;
    pm = fm + ((wgid % nig) % gsz); pn = (wgid % nig) / gsz;
}
struct PlainOrder {
    const char* A; const char* Bt; int lda, ldb, nM, nN, G, c, bskip;
    __device__ __forceinline__ bool next(int i, Unit& u) const {
        const long L = (long)i * G + c; if (L >= (long)nM * nN) return false;
        tile_of((int)L, nM, nN, u.pm, u.pn); u.aux = 0;
        u.A = A + (size_t)u.pm * BM * lda * 2; u.B = Bt + (size_t)(u.pn + ((u.pn >= 2) ? bskip : 0)) * BM * ldb * 2; return true;
    }
};
struct GroupOrder3 {
    const char* A; const char* Bt; int lda, ldb, nM, nN, G, c; size_t a_gstride, b_gstride;
    __device__ __forceinline__ bool next(int i, Unit& u) const {
        const int n = i % 3; const long L = (long)(i / 3) * G + c; if (L >= (long)nM * nN) return false;
        tile_of((int)L, nM, nN, u.pm, u.pn); u.aux = n;
        u.A = A + n * a_gstride + (size_t)u.pm * BM * lda * 2; u.B = Bt + n * b_gstride + (size_t)u.pn * BM * ldb * 2; return true;
    }
};

template <class Epi, class Sched, bool ALIGN_EPI>
__device__ __forceinline__ void gemm_phase(PG8_LAS unsigned char* lds, const Gemm g, const Sched& S, const Epi& E) {
    int tid_ = threadIdx.x; asm volatile("" : "+v"(tid_));
    const int tid = tid_, wid = __builtin_amdgcn_readfirstlane(tid >> 6), lane = tid & 63, wr = wid >> 2, wc = wid & 3, fr = lane & 15, fq = lane >> 4;
    const int K = g.K, nt = K / BK;
    unsigned voffA[2], voffB[2];
#pragma unroll
    for (int i = 0; i < 2; ++i) { int R, C; stage_rc(tid * 16 + i * 8192, R, C); const int Rb = Epi::PERM ? ((R & ~31) + perm32(R & 31)) : R;
        voffA[i] = (unsigned)(R * g.lda + C) * 2u; voffB[i] = (unsigned)(Rb * g.ldb + C) * 2u; }
    const size_t kstep = (size_t)(BK * 2);
    const size_t hstepA = (size_t)HALF * g.lda * 2, hstepB = (size_t)HALF * g.ldb * 2;
    const unsigned ldsw = (unsigned)wid * 1024u;
    const int aoff = lds_byte(wr * 64 + fr, fq * 8), boff = lds_byte(wc * 32 + fr, fq * 8);
#define PG8_SA(b, h) (((b) * 2 + (h)) * HTB)
#define PG8_SB(b, h) ((4 + (b) * 2 + (h)) * HTB)
#define PG8_STAGE(bufoff, gbase, voff) do { _Pragma("unroll") for (int _i = 0; _i < 2; ++_i) \
        __builtin_amdgcn_global_load_lds((const unsigned*)((const char*)(gbase) + (voff)[_i]), (PG8_LAS unsigned*)(lds + (bufoff) + ldsw + _i * 8192), 16, 0, 0); } while (0)
#define PG8_LDA(dst, b, h) do { _Pragma("unroll") for (int m = 0; m < 4; ++m) _Pragma("unroll") for (int k = 0; k < 2; ++k) dst[m][k] = *(const PG8_LAS bf16x8*)(lds + PG8_SA(b, h) + aoff + m * 2048 + k * 1024); } while (0)
#define PG8_LDB(dst, b, h) do { _Pragma("unroll") for (int n = 0; n < 2; ++n) _Pragma("unroll") for (int k = 0; k < 2; ++k) dst[n][k] = *(const PG8_LAS bf16x8*)(lds + PG8_SB(b, h) + boff + n * 2048 + k * 1024); } while (0)
#define PG8_MMA(ai, bj, At, Bt) do { __builtin_amdgcn_s_setprio(1); _Pragma("unroll") for (int m = 0; m < 4; ++m) _Pragma("unroll") for (int n = 0; n < 2; ++n) _Pragma("unroll") for (int k = 0; k < 2; ++k) \
        acc[ai][bj][m][n] = __builtin_amdgcn_mfma_f32_16x16x32_bf16(Bt[n][k], At[m][k], acc[ai][bj][m][n], 0, 0, 0); __builtin_amdgcn_s_setprio(0); } while (0)
#define PG8_WAIT_V(n) asm volatile("s_waitcnt vmcnt(" #n ")" ::: "memory")
#define PG8_WAIT_L(n) asm volatile("s_waitcnt lgkmcnt(" #n ")" ::: "memory")
#define PG8_BAR __builtin_amdgcn_s_barrier()
#define PG8_SCHED __builtin_amdgcn_sched_barrier(0)
    Unit cur, nxt; int ui = 0;
    if (!S.next(0, cur)) return;
    f32x4 acc[2][2][4][2];
#pragma unroll
    for (int a = 0; a < 2; ++a)
#pragma unroll
        for (int b = 0; b < 2; ++b)
#pragma unroll
            for (int m = 0; m < 4; ++m)
#pragma unroll
                for (int n = 0; n < 2; ++n) acc[a][b][m][n] = (f32x4){0.f, 0.f, 0.f, 0.f};
    bf16x8 At[4][2], B0[2][2], B1[2][2];
    const char* cA = cur.A; const char* cB = cur.B;
    PG8_STAGE(PG8_SB(0, 0), cB, voffB); PG8_STAGE(PG8_SB(0, 1), cB + hstepB, voffB); PG8_STAGE(PG8_SA(0, 0), cA, voffA); PG8_STAGE(PG8_SA(0, 1), cA + hstepA, voffA);
    if (wr == 1) PG8_BAR;
    PG8_WAIT_V(2); PG8_BAR;
    PG8_STAGE(PG8_SB(1, 0), cB + kstep, voffB); PG8_STAGE(PG8_SA(1, 0), cA + kstep, voffA); PG8_STAGE(PG8_SB(1, 1), cB + hstepB + kstep, voffB);
    PG8_WAIT_V(6); PG8_BAR;
    for (;;) {
        const bool has_next = S.next(ui + 1, nxt);
        const char* nA = has_next ? nxt.A : cA; const char* nB = has_next ? nxt.B : cB;
#pragma unroll 1
        for (int t = 0; t < nt; t += 2) {
            const bool last = (t == nt - 2);
            const char* a1 = cA + (size_t)(t + 1) * kstep;
            const char* a2 = last ? nA : cA + (size_t)(t + 2) * kstep; const char* b2 = last ? nB : cB + (size_t)(t + 2) * kstep;
            const char* a3 = a2 + kstep; const char* b3 = b2 + kstep;
            PG8_LDB(B0, 0, 0); PG8_LDB(B1, 0, 1); PG8_SCHED; PG8_LDA(At, 0, 0); PG8_STAGE(PG8_SA(1, 1), a1 + hstepA, voffA);
            PG8_WAIT_V(8); PG8_WAIT_L(0); PG8_BAR; PG8_MMA(0, 0, At, B0); PG8_MMA(0, 1, At, B1); PG8_BAR; PG8_SCHED;
            PG8_LDA(At, 0, 1); PG8_STAGE(PG8_SB(0, 0), b2, voffB); PG8_STAGE(PG8_SB(0, 1), b2 + hstepB, voffB); PG8_STAGE(PG8_SA(0, 0), a2, voffA);
            PG8_WAIT_V(8); PG8_WAIT_L(0); PG8_BAR; PG8_MMA(1, 0, At, B0); PG8_MMA(1, 1, At, B1); PG8_BAR; PG8_SCHED;
            PG8_LDB(B0, 1, 0); PG8_LDB(B1, 1, 1); PG8_SCHED; PG8_LDA(At, 1, 0); PG8_STAGE(PG8_SA(0, 1), a2 + hstepA, voffA);
            PG8_WAIT_V(8); PG8_WAIT_L(0); PG8_BAR; PG8_MMA(0, 0, At, B0); PG8_MMA(0, 1, At, B1); PG8_BAR; PG8_SCHED;
            PG8_LDA(At, 1, 1); PG8_STAGE(PG8_SB(1, 0), b3, voffB); PG8_STAGE(PG8_SB(1, 1), b3 + hstepB, voffB); PG8_STAGE(PG8_SA(1, 0), a3, voffA);
            PG8_WAIT_V(8); PG8_WAIT_L(0); PG8_BAR; PG8_MMA(1, 0, At, B0); PG8_MMA(1, 1, At, B1); PG8_BAR; PG8_SCHED;
        }
        if constexpr (ALIGN_EPI) { if (wr == 0) PG8_BAR; }
        E(acc, cur, wr, wc, fr, fq);
        if (!has_next) break;
#pragma unroll
        for (int a = 0; a < 2; ++a)
#pragma unroll
            for (int b = 0; b < 2; ++b)
#pragma unroll
                for (int m = 0; m < 4; ++m)
#pragma unroll
                    for (int n = 0; n < 2; ++n) acc[a][b][m][n] = (f32x4){0.f, 0.f, 0.f, 0.f};
        cur = nxt; cA = nA; cB = nB; ++ui;
        if constexpr (ALIGN_EPI) { if (wr == 1) PG8_BAR; }
    }
    PG8_WAIT_V(0);
    if constexpr (!ALIGN_EPI) { if (wr == 0) PG8_BAR; }
    PG8_BAR;
#undef PG8_SA
#undef PG8_SB
#undef PG8_STAGE
#undef PG8_LDA
#undef PG8_LDB
#undef PG8_MMA
#undef PG8_WAIT_V
#undef PG8_WAIT_L
#undef PG8_BAR
#undef PG8_SCHED
}
}
#define LAS __attribute__((address_space(3)))
typedef unsigned short bf16_t;
typedef short bf16x8 __attribute__((ext_vector_type(8)));
typedef short s16x4 __attribute__((ext_vector_type(4)));
typedef float f32x4 __attribute__((ext_vector_type(4)));
typedef float f32x2 __attribute__((ext_vector_type(2)));
typedef float f32x16 __attribute__((ext_vector_type(16)));
typedef unsigned u32x4 __attribute__((ext_vector_type(4)));
typedef unsigned u32x2 __attribute__((ext_vector_type(2)));
typedef __bf16 bf16x2_t __attribute__((ext_vector_type(2)));

constexpr int BATCH = 8, SEQ = 4096, DM = 1024, T = BATCH * SEQ, DEPTH = 2;
constexpr int N_IN = 7728, NA = 3328, NG = 4608, NALL = NA + NG;
constexpr int CQ = 0, CKV = 256, KROPE = 384, GLAT = 416, RW_R = 512, RW_K = 1024, RW_V = 1536, RW_LW = 2048, RW_LA = 2112, GQ = 2304, GK = 2560, GV = 2816;
constexpr int KP = 544;
constexpr float NORM_EPS = 1e-6f, RWKV_GN_EPS = 64e-5f;
constexpr float QSCALE = 0.10206207261596577f * 1.4426950408889634f;

constexpr size_t MiB = 1u << 20;
constexpr size_t WS_CTL = 0;
constexpr size_t WS_ROPE = 1 * MiB;
constexpr size_t WS_RSTD = 5 * MiB;
constexpr size_t WS_WIN = 6 * MiB;
constexpr size_t WS_WBO = WS_WIN + (size_t)NALL * 1024 * 2;
constexpr size_t WS_WOUT = WS_WBO + 3 * MiB;
constexpr size_t WS_WUQ = WS_WOUT + 2 * MiB;
constexpr size_t WS_WUKV = WS_WUQ + 768 * 256 * 2;
constexpr size_t WS_HB = 28 * MiB;
constexpr size_t WS_PA = 92 * MiB;
constexpr size_t WS_Q = 300 * MiB;
constexpr size_t WS_K = 348 * MiB;
constexpr size_t WS_V = 382 * MiB;
constexpr size_t WS_YS = 414 * MiB;
constexpr size_t WS_SMG8 = WS_Q;
constexpr size_t WS_MG = WS_PA, WS_OF = WS_PA + 64 * MiB;
constexpr size_t WS_END = 510 * MiB;
static_assert(WS_WUKV + 1024 * 256 * 2 <= WS_HB, "weights fit");

__device__ __forceinline__ unsigned pk2(float lo, float hi) { f32x2 v = {lo, hi}; bf16x2_t b = __builtin_convertvector(v, bf16x2_t); return __builtin_bit_cast(unsigned, b); }
__device__ __forceinline__ float bflo(unsigned w) { return __uint_as_float(w << 16); }
__device__ __forceinline__ float bfhi(unsigned w) { return __uint_as_float(w & 0xffff0000u); }
__device__ __forceinline__ float bf2f(bf16_t b) { return __uint_as_float((unsigned)b << 16); }
__device__ __forceinline__ bf16_t f2bf(float f) { return (bf16_t)(pk2(f, 0.f) & 0xffffu); }
__device__ __forceinline__ float wave_sum(float v) {
#pragma unroll
    for (int o = 1; o < 64; o <<= 1) v += __shfl_xor(v, o);
    return v;
}
__device__ __forceinline__ float fast_exp(float x) { return __builtin_amdgcn_exp2f(x * 1.4426950408889634f); }
__device__ __forceinline__ float fast_sigmoid(float x) { return __builtin_amdgcn_rcpf(1.0f + fast_exp(-x)); }
template <int CTRL> __device__ __forceinline__ float dpp_f(float x) { return __int_as_float(__builtin_amdgcn_update_dpp(0, __float_as_int(x), CTRL, 0xf, 0xf, false)); }
__device__ __forceinline__ float sum8(float x) { x += dpp_f<0xB1>(x); x += dpp_f<0x4E>(x); x += dpp_f<0x141>(x); return x; }
__device__ __forceinline__ float sum16(float x) { x += dpp_f<0xB1>(x); x += dpp_f<0x4E>(x); x += dpp_f<0x141>(x); x += dpp_f<0x140>(x); return x; }

struct Params {
    const float* x; const int* positions; const float* norm_pre; const float* w_in; const float* mla_q_norm; const float* mla_kv_norm; const float* mla_w_uq; const float* mla_w_ukv;
    const float* rwkv_mu; const float* rwkv_w0; const float* rwkv_w_up; const float* rwkv_a0; const float* rwkv_a_up; const float* rwkv_k_k; const float* rwkv_k_a; const float* rwkv_r_k;
    const float* rwkv_ln_w; const float* rwkv_ln_b; const float* gla_a_up; const float* gla_a_b; const float* gla_norm; const float* w_branch_out; const float* w_out; const float* norm_post;
    float* out; unsigned char* ws; int ph_lo, ph_hi;
};

typedef const __attribute__((address_space(4))) Params* KArgs;
__device__ __forceinline__ KArgs kargs() { KArgs kp = (KArgs)__builtin_amdgcn_kernarg_segment_ptr(); asm volatile("" : "+s"(kp)); return kp; }

__device__ __forceinline__ Params load_params() { Params p{}; KArgs kp = kargs(); p.x = kp->x; p.positions = kp->positions; p.norm_pre = kp->norm_pre; p.w_in = kp->w_in; p.mla_q_norm = kp->mla_q_norm; p.mla_kv_norm = kp->mla_kv_norm; p.mla_w_uq = kp->mla_w_uq; p.mla_w_ukv = kp->mla_w_ukv; p.rwkv_mu = kp->rwkv_mu; p.rwkv_w0 = kp->rwkv_w0; p.rwkv_w_up = kp->rwkv_w_up; p.rwkv_a0 = kp->rwkv_a0; p.rwkv_a_up = kp->rwkv_a_up; p.rwkv_k_k = kp->rwkv_k_k; p.rwkv_k_a = kp->rwkv_k_a; p.rwkv_r_k = kp->rwkv_r_k; p.rwkv_ln_w = kp->rwkv_ln_w; p.rwkv_ln_b = kp->rwkv_ln_b; p.gla_a_up = kp->gla_a_up; p.gla_a_b = kp->gla_a_b; p.gla_norm = kp->gla_norm; p.w_branch_out = kp->w_branch_out; p.w_out = kp->w_out; p.norm_post = kp->norm_post; p.out = kp->out; p.ws = kp->ws; p.ph_lo = kp->ph_lo; p.ph_hi = kp->ph_hi; return p; }
__device__ __forceinline__ int opaque_tid() { int t = threadIdx.x; asm volatile("" : "+v"(t)); return t; }

using pg8::Unit;
struct EpiStore {
    static constexpr bool PERM = true; bf16_t* O; int ldc;
    __device__ __forceinline__ void operator()(const f32x4 (&acc)[2][2][4][2], const Unit& u, int wr, int wc, int fr, int fq) const {
        const int row0 = u.pm * 256 + wr * 64 + fr, col0 = u.pn * 256 + wc * 32 + 8 * fq;
#pragma unroll
        for (int ai = 0; ai < 2; ++ai)
#pragma unroll
            for (int m = 0; m < 4; ++m) { bf16_t* rowp = O + (size_t)(row0 + ai * 128 + m * 16) * ldc + col0;
#pragma unroll
                for (int bj = 0; bj < 2; ++bj) { const f32x4 v0 = acc[ai][bj][m][0], v1 = acc[ai][bj][m][1];
                    u32x4 w; w.x = pk2(v0[0], v0[1]); w.y = pk2(v0[2], v0[3]); w.z = pk2(v1[0], v1[1]); w.w = pk2(v1[2], v1[3]);
                    *(u32x4*)(rowp + bj * 128) = w; } }
    }
};
struct EpiQ {
    static constexpr bool PERM = true; bf16_t* Q; const float* rstd;
    __device__ __forceinline__ void operator()(const f32x4 (&acc)[2][2][4][2], const Unit& u, int wr, int wc, int fr, int fq) const {
        const int row0 = u.pm * 256 + wr * 64 + fr, col0 = u.pn * 256 + wc * 32 + 8 * fq;
        float rsv[2][4];
#pragma unroll
        for (int ai = 0; ai < 2; ++ai)
#pragma unroll
            for (int m = 0; m < 4; ++m) rsv[ai][m] = rstd[row0 + ai * 128 + m * 16];
#pragma unroll
        for (int ai = 0; ai < 2; ++ai)
#pragma unroll
            for (int m = 0; m < 4; ++m) { const int row = row0 + ai * 128 + m * 16; const float rs = rsv[ai][m] * QSCALE; bf16_t* rowp = Q + (size_t)row * 768 + col0;
#pragma unroll
                for (int bj = 0; bj < 2; ++bj) { const f32x4 v0 = acc[ai][bj][m][0] * rs, v1 = acc[ai][bj][m][1] * rs;
                    u32x4 w; w.x = pk2(v0[0], v0[1]); w.y = pk2(v0[2], v0[3]); w.z = pk2(v1[0], v1[1]); w.w = pk2(v1[2], v1[3]);
                    *(u32x4*)(rowp + bj * 128) = w; } }
    }
};
struct EpiKV {
    static constexpr bool PERM = true; bf16_t* Kb; bf16_t* Vb; const float* rstd;
    __device__ __forceinline__ void operator()(const f32x4 (&acc)[2][2][4][2], const Unit& u, int wr, int wc, int fr, int fq) const {
        const int row0 = u.pm * 256 + wr * 64 + fr, col0 = (u.pn & 1) * 256 + wc * 32 + 8 * fq; const bool isv = u.pn >= 2;
        float rsv[2][4];
#pragma unroll
        for (int ai = 0; ai < 2; ++ai)
#pragma unroll
            for (int m = 0; m < 4; ++m) rsv[ai][m] = rstd[row0 + ai * 128 + m * 16];
#pragma unroll
        for (int ai = 0; ai < 2; ++ai)
#pragma unroll
            for (int m = 0; m < 4; ++m) { const int row = row0 + ai * 128 + m * 16; const float rs = rsv[ai][m];
                bf16_t* rowp = isv ? (Vb + (size_t)row * 512 + col0) : (Kb + (size_t)row * KP + col0);
#pragma unroll
                for (int bj = 0; bj < 2; ++bj) { const f32x4 v0 = acc[ai][bj][m][0] * rs, v1 = acc[ai][bj][m][1] * rs;
                    u32x4 w; w.x = pk2(v0[0], v0[1]); w.y = pk2(v0[2], v0[3]); w.z = pk2(v1[0], v1[1]); w.w = pk2(v1[2], v1[3]);
                    *(u32x4*)(rowp + bj * 128) = w; } }
    }
};
__device__ __forceinline__ unsigned q8(float s) { return (unsigned)(s * 255.0f + 0.5f); }
struct EpiGateBG {
    static constexpr bool PERM = true; bf16_t* YS; int pn0, skip;
    __device__ __forceinline__ void operator()(const f32x4 (&acc)[2][2][4][2], const Unit& u, int wr, int wc, int fr, int fq) const {
        const int pn = pn0 + u.pn + ((u.pn >= 2) ? skip : 0);
        const int row0 = u.pm * 256 + wr * 64 + fr, col0 = (pn & 1) * 256 + wc * 32 + 8 * fq;
        bf16_t* base = YS + (size_t)(pn >> 1) * T * 512;
#pragma unroll
        for (int ai = 0; ai < 2; ++ai) {
            u32x4 y[4][2];
#pragma unroll
            for (int m = 0; m < 4; ++m) { const bf16_t* rowp = base + (size_t)(row0 + ai * 128 + m * 16) * 512 + col0;
#pragma unroll
                for (int bj = 0; bj < 2; ++bj) y[m][bj] = *(const u32x4*)(rowp + bj * 128); }
#pragma unroll
            for (int m = 0; m < 4; ++m) { bf16_t* rowp = base + (size_t)(row0 + ai * 128 + m * 16) * 512 + col0;
#pragma unroll
                for (int bj = 0; bj < 2; ++bj) { const f32x4 a0 = acc[ai][bj][m][0], a1 = acc[ai][bj][m][1]; const u32x4 yy = y[m][bj];
                    float v[8] = {a0[0], a0[1], a0[2], a0[3], a1[0], a1[1], a1[2], a1[3]};
#pragma unroll
                    for (int j = 0; j < 8; ++j) v[j] = fast_sigmoid(v[j]) * v[j];
                    v[0] *= bflo(yy.x); v[1] *= bfhi(yy.x); v[2] *= bflo(yy.y); v[3] *= bfhi(yy.y); v[4] *= bflo(yy.z); v[5] *= bfhi(yy.z); v[6] *= bflo(yy.w); v[7] *= bfhi(yy.w);
                    u32x4 w; w.x = pk2(v[0], v[1]); w.y = pk2(v[2], v[3]); w.z = pk2(v[4], v[5]); w.w = pk2(v[6], v[7]);
                    *(u32x4*)(rowp + bj * 128) = w; } }
        }
    }
};
struct EpiGateMG8 {
    static constexpr bool PERM = true; unsigned char* SMG;
    __device__ __forceinline__ void operator()(const f32x4 (&acc)[2][2][4][2], const Unit& u, int wr, int wc, int fr, int fq) const {
        const int row0 = u.pm * 256 + wr * 64 + fr, col0 = u.pn * 256 + wc * 32 + 8 * fq;
#pragma unroll
        for (int ai = 0; ai < 2; ++ai)
#pragma unroll
            for (int m = 0; m < 4; ++m) { const int row = row0 + ai * 128 + m * 16; unsigned char* rowp = SMG + (size_t)row * 3072 + col0;
#pragma unroll
                for (int bj = 0; bj < 2; ++bj) { const f32x4 a0 = acc[ai][bj][m][0], a1 = acc[ai][bj][m][1];
                    u32x2 w; w.x = q8(fast_sigmoid(a0[0])) | (q8(fast_sigmoid(a0[1])) << 8) | (q8(fast_sigmoid(a0[2])) << 16) | (q8(fast_sigmoid(a0[3])) << 24);
                    w.y = q8(fast_sigmoid(a1[0])) | (q8(fast_sigmoid(a1[1])) << 8) | (q8(fast_sigmoid(a1[2])) << 16) | (q8(fast_sigmoid(a1[3])) << 24);
                    *(u32x2*)(rowp + bj * 128) = w; } }
    }
};
struct EpiMerge {
    static constexpr bool PERM = true; bf16_t* MG; const unsigned char* SMG;
    __device__ __forceinline__ void operator()(const f32x4 (&acc)[2][2][4][2], const Unit& u, int wr, int wc, int fr, int fq) const {
        const int row0 = u.pm * 256 + wr * 64 + fr, col0 = u.pn * 256 + wc * 32 + 8 * fq, n = u.aux; constexpr float S = 1.0f / 255.0f;
#pragma unroll
        for (int ai = 0; ai < 2; ++ai) {
            u32x2 g[4][2]; u32x4 y[4][2];
#pragma unroll
            for (int m = 0; m < 4; ++m) { const int row = row0 + ai * 128 + m * 16; const unsigned char* gp = SMG + (size_t)row * 3072 + n * 1024 + col0; const bf16_t* rowp = MG + (size_t)row * 1024 + col0;
#pragma unroll
                for (int bj = 0; bj < 2; ++bj) { g[m][bj] = *(const u32x2*)(gp + bj * 128); if (n > 0) y[m][bj] = *(const u32x4*)(rowp + bj * 128); } }
#pragma unroll
            for (int m = 0; m < 4; ++m) { const int row = row0 + ai * 128 + m * 16; bf16_t* rowp = MG + (size_t)row * 1024 + col0;
#pragma unroll
                for (int bj = 0; bj < 2; ++bj) { const f32x4 a0 = acc[ai][bj][m][0], a1 = acc[ai][bj][m][1]; const u32x2 gg = g[m][bj];
                    float v[8] = {a0[0] * (S * (float)(gg.x & 0xffu)), a0[1] * (S * (float)((gg.x >> 8) & 0xffu)), a0[2] * (S * (float)((gg.x >> 16) & 0xffu)), a0[3] * (S * (float)(gg.x >> 24)),
                                  a1[0] * (S * (float)(gg.y & 0xffu)), a1[1] * (S * (float)((gg.y >> 8) & 0xffu)), a1[2] * (S * (float)((gg.y >> 16) & 0xffu)), a1[3] * (S * (float)(gg.y >> 24))};
                    if (n > 0) { const u32x4 yy = y[m][bj];
                        v[0] += bflo(yy.x); v[1] += bfhi(yy.x); v[2] += bflo(yy.y); v[3] += bfhi(yy.y); v[4] += bflo(yy.z); v[5] += bfhi(yy.z); v[6] += bflo(yy.w); v[7] += bfhi(yy.w); }
                    u32x4 w; w.x = pk2(v[0], v[1]); w.y = pk2(v[2], v[3]); w.z = pk2(v[4], v[5]); w.w = pk2(v[6], v[7]);
                    *(u32x4*)(rowp + bj * 128) = w; } }
        }
    }
};
struct EpiF32 {
    static constexpr bool PERM = false; float* O; int ldc;
    __device__ __forceinline__ void operator()(const f32x4 (&acc)[2][2][4][2], const Unit& u, int wr, int wc, int fr, int fq) const {
        const int row0 = u.pm * 256 + wr * 64 + fr, col0 = u.pn * 256 + wc * 32 + 4 * fq;
#pragma unroll
        for (int ai = 0; ai < 2; ++ai)
#pragma unroll
            for (int m = 0; m < 4; ++m) { float* rowp = O + (size_t)(row0 + ai * 128 + m * 16) * ldc + col0;
#pragma unroll
                for (int bj = 0; bj < 2; ++bj)
#pragma unroll
                    for (int n = 0; n < 2; ++n) *(f32x4*)(rowp + bj * 128 + n * 16) = acc[ai][bj][m][n]; }
    }
};

template <class SrcCol>
__device__ __forceinline__ void transpose_item(const float* W, int Ksrc, int Nsrc, bf16_t* WT, int Kdst, int item, int nblk, float* scr, int lane, SrcCol src, const float* kscale) {
    const int kb = item / nblk, nb = item % nblk, k0 = 64 * kb, n0 = 32 * nb;
    const int sc = src(n0 + (lane & 31));
#pragma unroll 8
    for (int i = 0; i < 32; ++i) { const int kk = 2 * i + (lane >> 5), k = k0 + kk; float v = 0.f;
        if (sc >= 0 && k < Ksrc) { v = W[(size_t)k * Nsrc + sc]; if (kscale) v *= kscale[k]; }
        scr[kk * 33 + (lane & 31)] = v; }
    asm volatile("s_waitcnt lgkmcnt(0)" ::: "memory");
    const int c = lane & 7;
#pragma unroll
    for (int j = 0; j < 4; ++j) { const int n = (lane >> 3) + 8 * j; const float* s = scr + (8 * c) * 33 + n;
        u32x4 o; o.x = pk2(s[0 * 33], s[1 * 33]); o.y = pk2(s[2 * 33], s[3 * 33]); o.z = pk2(s[4 * 33], s[5 * 33]); o.w = pk2(s[6 * 33], s[7 * 33]);
        *(u32x4*)(WT + (size_t)(n0 + n) * Kdst + k0 + 8 * c) = o; }
    asm volatile("s_waitcnt lgkmcnt(0)" ::: "memory");
}
__device__ __forceinline__ int win_src(int j) {
    if (j < 416) return j;
    if (j < 432) return 3104 + (j - 416);
    if (j < 512) return -1;
    if (j < 2048) return 416 + (j - 512);
    if (j < 2176) return 1952 + (j - 2048);
    if (j < 2304) return -1;
    if (j < 3328) return 2080 + (j - 2304);
    return 3120 + (j - 3328);
}
__device__ __forceinline__ int wuq_src(int j) { const int h = j / 96, c = j % 96; if (c < 64) return h * 96 + c; const int r = c - 64; return h * 96 + 64 + (r & 1) * 16 + (r >> 1); }
__device__ __forceinline__ int wukv_src(int j) { return j < 512 ? (j >> 6) * 128 + (j & 63) : ((j - 512) >> 6) * 128 + 64 + (j & 63); }

__device__ __forceinline__ void convert_weights(int l, unsigned char* lds, int gw, int NGW, int wave, int lane) {
    float* scr = (float*)(lds + wave * 8448); const Params p = load_params();
    bf16_t* WinT = (bf16_t*)(p.ws + WS_WIN); bf16_t* WboT = (bf16_t*)(p.ws + WS_WBO); bf16_t* WoutT = (bf16_t*)(p.ws + WS_WOUT); bf16_t* WuqT = (bf16_t*)(p.ws + WS_WUQ); bf16_t* WukvT = (bf16_t*)(p.ws + WS_WUKV);
    constexpr int I_IN = 16 * (NALL / 32), I_BO = 8 * 32, I_OUT = 16 * 32, I_UQ = 4 * 24, I_UKV = 4 * 32;
    constexpr int NITEMS = I_IN + 3 * I_BO + I_OUT + I_UQ + I_UKV;
    for (int it = gw; it < NITEMS; it += NGW) {
        int r = it;
        if (r < I_IN) { transpose_item(p.w_in + (size_t)l * 1024 * N_IN, 1024, N_IN, WinT, 1024, r, NALL / 32, scr, lane, [](int j) { return win_src(j); }, nullptr); continue; } r -= I_IN;
        if (r < 3 * I_BO) { const int n = r / I_BO; r -= n * I_BO;
            transpose_item(p.w_branch_out + ((size_t)l * 3 + n) * 512 * 1024, 512, 1024, WboT + (size_t)n * 1024 * 512, 512, r, 32, scr, lane, [](int j) { return j; }, nullptr); continue; } r -= 3 * I_BO;
        if (r < I_OUT) { transpose_item(p.w_out + (size_t)l * 1024 * 1024, 1024, 1024, WoutT, 1024, r, 32, scr, lane, [](int j) { return j; }, nullptr); continue; } r -= I_OUT;
        if (r < I_UQ) { transpose_item(p.mla_w_uq + (size_t)l * 256 * 768, 256, 768, WuqT, 256, r, 24, scr, lane, [](int j) { return wuq_src(j); }, p.mla_q_norm + l * 256); continue; } r -= I_UQ;
        transpose_item(p.mla_w_ukv + (size_t)l * 128 * 1024, 128, 1024, WukvT, 256, r, 32, scr, lane, [](int j) { return wukv_src(j); }, p.mla_kv_norm + l * 128);
    }
}
__device__ __forceinline__ void hb_row(const float* xrow, const float* g, bf16_t* orow, int lane) {
    const f32x4* xr = (const f32x4*)xrow + lane; const f32x4* gr = (const f32x4*)g + lane;
    f32x4 v[4]; float s = 0.f;
#pragma unroll
    for (int j = 0; j < 4; ++j) { v[j] = xr[64 * j]; s += (v[j].x * v[j].x + v[j].y * v[j].y) + (v[j].z * v[j].z + v[j].w * v[j].w); }
    const float rstd = rsqrtf(wave_sum(s) * (1.f / DM) + NORM_EPS);
    u32x2* o8 = (u32x2*)orow + lane;
#pragma unroll
    for (int j = 0; j < 4; ++j) { const f32x4 gg = gr[64 * j]; u32x2 w; w.x = pk2(v[j].x * rstd * gg.x, v[j].y * rstd * gg.y); w.y = pk2(v[j].z * rstd * gg.z, v[j].w * rstd * gg.w); o8[64 * j] = w; }
}
__device__ __forceinline__ void final_row(const bf16_t* orow, const float* xold, const float* gpost, float* xnew, const float* gnext, bf16_t* hbrow, int lane) {
    float o[16], x[16], g[16];
    { const u32x4 a = *((const u32x4*)orow + lane), b = *((const u32x4*)orow + 64 + lane);
      o[0] = bflo(a.x); o[1] = bfhi(a.x); o[2] = bflo(a.y); o[3] = bfhi(a.y); o[4] = bflo(a.z); o[5] = bfhi(a.z); o[6] = bflo(a.w); o[7] = bfhi(a.w);
      o[8] = bflo(b.x); o[9] = bfhi(b.x); o[10] = bflo(b.y); o[11] = bfhi(b.y); o[12] = bflo(b.z); o[13] = bfhi(b.z); o[14] = bflo(b.w); o[15] = bfhi(b.w); }
#pragma unroll
    for (int h = 0; h < 2; ++h)
#pragma unroll
        for (int q = 0; q < 2; ++q) { const f32x4 xv = *((const f32x4*)(xold + 512 * h + 8 * lane) + q), gv = *((const f32x4*)(gpost + 512 * h + 8 * lane) + q);
#pragma unroll
            for (int e = 0; e < 4; ++e) { x[8 * h + 4 * q + e] = xv[e]; g[8 * h + 4 * q + e] = gv[e]; } }
    float s = 0.f;
#pragma unroll
    for (int e = 0; e < 16; ++e) s += o[e] * o[e];
    const float rstd = rsqrtf(wave_sum(s) * (1.f / DM) + NORM_EPS);
    float s2 = 0.f;
#pragma unroll
    for (int e = 0; e < 16; ++e) { x[e] += o[e] * rstd * g[e]; s2 += x[e] * x[e]; }
#pragma unroll
    for (int h = 0; h < 2; ++h)
#pragma unroll
        for (int q = 0; q < 2; ++q) *((f32x4*)(xnew + 512 * h + 8 * lane) + q) = (f32x4){x[8 * h + 4 * q], x[8 * h + 4 * q + 1], x[8 * h + 4 * q + 2], x[8 * h + 4 * q + 3]};
    if (gnext) { const float rstd2 = rsqrtf(wave_sum(s2) * (1.f / DM) + NORM_EPS);
#pragma unroll
        for (int h = 0; h < 2; ++h) { const f32x4 g0 = *((const f32x4*)(gnext + 512 * h + 8 * lane)), g1 = *((const f32x4*)(gnext + 512 * h + 8 * lane) + 1);
            u32x4 w; w.x = pk2(x[8 * h] * rstd2 * g0[0], x[8 * h + 1] * rstd2 * g0[1]); w.y = pk2(x[8 * h + 2] * rstd2 * g0[2], x[8 * h + 3] * rstd2 * g0[3]);
            w.z = pk2(x[8 * h + 4] * rstd2 * g1[0], x[8 * h + 5] * rstd2 * g1[1]); w.w = pk2(x[8 * h + 6] * rstd2 * g1[2], x[8 * h + 7] * rstd2 * g1[3]);
            *((u32x4*)hbrow + 64 * h + lane) = w; } }
}
__device__ __forceinline__ void mla_prep_row(const bf16_t* prow, const f32x2* rope_t, float* rstdq, float* rstdkv, bf16_t* krow, int lane) {
    const u32x2 a = *((const u32x2*)(prow + CQ) + lane); const unsigned c = *((const unsigned*)(prow + CKV) + lane);
    float sq = bflo(a.x) * bflo(a.x) + bfhi(a.x) * bfhi(a.x) + bflo(a.y) * bflo(a.y) + bfhi(a.y) * bfhi(a.y);
    float sk = bflo(c) * bflo(c) + bfhi(c) * bfhi(c);
    sq = wave_sum(sq); sk = wave_sum(sk);
    if (lane == 0) { *rstdq = rsqrtf(sq * (1.f / 256.f) + NORM_EPS); *rstdkv = rsqrtf(sk * (1.f / 128.f) + NORM_EPS); }
    if (lane < 16) { const float x1 = bf2f(prow[KROPE + lane]), x2 = bf2f(prow[KROPE + 16 + lane]); const f32x2 cs = rope_t[lane];
        *((unsigned*)(krow + 512) + lane) = pk2(x1 * cs.x - x2 * cs.y, x2 * cs.x + x1 * cs.y); }
}

namespace att {
constexpr int KSLOT = 12288, VSLOT = 8192, BUFB = KSLOT + VSLOT, L_WS = 2 * BUFB, L_OST = L_WS + 8 * 128 * 4, L_END = L_OST + 8 * 4096;
constexpr int UNIT_ROWS = 512;
__device__ __forceinline__ int crow(int r, int hi) { return (r & 3) + 8 * (r >> 2) + 4 * hi; }
__device__ __forceinline__ s16x4 vtr(const LAS unsigned char* p) { return __builtin_bit_cast(s16x4, __builtin_amdgcn_ds_read_tr16_b64_v4i16((LAS s16x4*)p)); }
__device__ __forceinline__ void load_q(bf16x8 (&qr)[6], const bf16_t* Q, const f32x2* rope, size_t row, int h, int hi) {
    const bf16_t* Qw = Q + row * 768 + h * 96 + hi * 8;
#pragma unroll
    for (int s = 0; s < 6; ++s) qr[s] = *(const bf16x8*)(Qw + s * 16);
    const f32x4* rp = (const f32x4*)(rope + row * 16 + 4 * hi);
#pragma unroll
    for (int s = 4; s < 6; ++s) { const f32x4 c01 = rp[(s - 4) * 4], c23 = rp[(s - 4) * 4 + 1]; const u32x4 w = __builtin_bit_cast(u32x4, qr[s]); u32x4 o;
        { const float e = bflo(w.x), d = bfhi(w.x); o.x = pk2(e * c01[0] - d * c01[1], d * c01[0] + e * c01[1]); }
        { const float e = bflo(w.y), d = bfhi(w.y); o.y = pk2(e * c01[2] - d * c01[3], d * c01[2] + e * c01[3]); }
        { const float e = bflo(w.z), d = bfhi(w.z); o.z = pk2(e * c23[0] - d * c23[1], d * c23[0] + e * c23[1]); }
        { const float e = bflo(w.w), d = bfhi(w.w); o.w = pk2(e * c23[2] - d * c23[3], d * c23[2] + e * c23[3]); }
        qr[s] = __builtin_bit_cast(bf16x8, o); }
}
__device__ __forceinline__ void softmax_half(f32x16& p0, f32x16& p1, f32x16& o0, f32x16& o1, float& mrun, float& lrun, bf16x8 (&pa)[4],
                                             bool first, bool band, int kb0, int qrel, int r32, int hi, LAS float* wsf) {
    if (band) {
#pragma unroll
        for (int r = 0; r < 16; ++r) { const int kv = kb0 + (r & 3) + 8 * (r >> 2); if (kv > qrel) p0[r] = -INFINITY; if (kv + 32 > qrel) p1[r] = -INFINITY; } }
    float mx = fmaxf(p0[0], p1[0]);
#pragma unroll
    for (int r = 1; r < 16; ++r) mx = fmaxf(mx, fmaxf(p0[r], p1[r]));
    mx = fmaxf(mx, __shfl_xor(mx, 32));
    if (first || __any(mx > 8.0f)) {
        const float dl = first ? mx : fmaxf(mx, 0.f); mrun += dl;
#pragma unroll
        for (int r = 0; r < 16; ++r) { p0[r] -= dl; p1[r] -= dl; }
        const float alpha = __builtin_amdgcn_exp2f(-dl); lrun *= alpha;
        if (hi == 0) wsf[r32] = alpha;
#pragma unroll
        for (int r = 0; r < 16; ++r) { const float a = wsf[crow(r, hi)]; o0[r] *= a; o1[r] *= a; }
    }
    float ls = 0.f;
#pragma unroll
    for (int r = 0; r < 16; ++r) { p0[r] = __builtin_amdgcn_exp2f(p0[r]); p1[r] = __builtin_amdgcn_exp2f(p1[r]); ls += p0[r] + p1[r]; }
    lrun += ls;
#pragma unroll
    for (int s = 0; s < 4; ++s) { const int bb = 8 * (s & 1); u32x4 w;
        if (s < 2) { w.x = pk2(p0[bb], p0[bb + 1]); w.y = pk2(p0[bb + 2], p0[bb + 3]); w.z = pk2(p0[bb + 4], p0[bb + 5]); w.w = pk2(p0[bb + 6], p0[bb + 7]); }
        else { w.x = pk2(p1[bb], p1[bb + 1]); w.y = pk2(p1[bb + 2], p1[bb + 3]); w.z = pk2(p1[bb + 4], p1[bb + 5]); w.w = pk2(p1[bb + 6], p1[bb + 7]); }
        pa[s] = __builtin_bit_cast(bf16x8, w); }
}
__device__ __forceinline__ void attn_unit(int b, int h, int qb, LAS unsigned char* lds, unsigned* done_ctr) {
    KArgs kp = kargs(); unsigned char* ws_ = kp->ws;
    const bf16_t* Q = (const bf16_t*)(ws_ + WS_Q); const bf16_t* Kg = (const bf16_t*)(ws_ + WS_K); const bf16_t* Vg = (const bf16_t*)(ws_ + WS_V); bf16_t* O = (bf16_t*)(ws_ + WS_YS);
    const int tid = opaque_tid(), lane = tid & 63, r32 = lane & 31, hi = lane >> 5; const int wid = __builtin_amdgcn_readfirstlane(tid >> 6);
    const size_t rowbase = (size_t)b * SEQ; const int q0 = qb * UNIT_ROWS;
    bf16x8 qa[6], qb_[6];
    load_q(qa, Q, (const f32x2*)(ws_ + WS_ROPE), rowbase + q0 + wid * 64 + r32, h, hi);
    load_q(qb_, Q, (const f32x2*)(ws_ + WS_ROPE), rowbase + q0 + wid * 64 + 32 + r32, h, hi);
    const bf16_t* ksrc0 = Kg + (rowbase + (tid & 63)) * KP + h * 64 + (tid >> 6) * 8;
    const bf16_t* ksrc1 = Kg + (rowbase + (tid & 63)) * KP + 512 + (tid >> 6) * 8;
    const bf16_t* vsrc = Vg + (rowbase + ((tid & 255) >> 2)) * 512 + h * 64 + (tid >> 8) * 32 + (tid & 3) * 8;
    const int NT = (q0 + UNIT_ROWS) / 64;
    LAS float* wsf = (LAS float*)(lds + L_WS) + wid * 128;
    u32x4 sk0, sk1, sv;
    sk0 = *(const u32x4*)ksrc0; if (tid < 256) sk1 = *(const u32x4*)ksrc1; sv = *(const u32x4*)vsrc;
    *(LAS u32x4*)(lds + tid * 16) = sk0; if (tid < 256) *(LAS u32x4*)(lds + (tid + 512) * 16) = sk1; *(LAS u32x4*)(lds + KSLOT + tid * 16) = sv;
    __syncthreads();
    f32x16 oa0 = {}, oa1 = {}, ob0 = {}, ob1 = {}; float ma = 0.f, la = 0.f, mb = 0.f, lb = 0.f;
    const int qra = wid * 64 + r32, qrb = qra + 32;
    for (int t = 0; t < NT; ++t) {
        LAS unsigned char* buf = lds + (t & 1) * BUFB; LAS unsigned char* nbuf = lds + ((t + 1) & 1) * BUFB;
        if (t + 1 < NT) { sk0 = *(const u32x4*)(ksrc0 + (size_t)(t + 1) * 64 * KP); if (tid < 256) sk1 = *(const u32x4*)(ksrc1 + (size_t)(t + 1) * 64 * KP); sv = *(const u32x4*)(vsrc + (size_t)(t + 1) * 64 * 512); }
        f32x16 pa0, pa1, pb0, pb1;
#pragma unroll
        for (int r = 0; r < 16; ++r) { pa0[r] = -ma; pa1[r] = -ma; pb0[r] = -mb; pb1[r] = -mb; }
        { const LAS unsigned char* kb = buf + hi * 1024 + r32 * 16;
#pragma unroll
          for (int s = 0; s < 6; ++s) { const bf16x8 a0 = *(const LAS bf16x8*)(kb + s * 2048), a1 = *(const LAS bf16x8*)(kb + s * 2048 + 512);
              pa0 = __builtin_amdgcn_mfma_f32_32x32x16_bf16(a0, qa[s], pa0, 0, 0, 0); pa1 = __builtin_amdgcn_mfma_f32_32x32x16_bf16(a1, qa[s], pa1, 0, 0, 0);
              pb0 = __builtin_amdgcn_mfma_f32_32x32x16_bf16(a0, qb_[s], pb0, 0, 0, 0); pb1 = __builtin_amdgcn_mfma_f32_32x32x16_bf16(a1, qb_[s], pb1, 0, 0, 0); } }
        const bool band = t >= NT - 8; const int kb0 = 64 * (t - (NT - 8)) + 4 * hi;
        bf16x8 fa[4], fb[4];
        softmax_half(pa0, pa1, oa0, oa1, ma, la, fa, t == 0, band, kb0, qra, r32, hi, wsf);
        softmax_half(pb0, pb1, ob0, ob1, mb, lb, fb, t == 0, band, kb0, qrb, r32, hi, wsf + 64);
        { const LAS unsigned char* vb = buf + KSLOT + ((lane >> 4) & 1) * 32 + (lane & 3) * 8 + (4 * hi + ((lane & 15) >> 2)) * 64;
#pragma unroll
          for (int s = 0; s < 4; ++s) {
              { const s16x4 lo = vtr(vb + s * 1024), hh = vtr(vb + s * 1024 + 512); const bf16x8 vf = {lo[0], lo[1], lo[2], lo[3], hh[0], hh[1], hh[2], hh[3]};
                oa0 = __builtin_amdgcn_mfma_f32_32x32x16_bf16(fa[s], vf, oa0, 0, 0, 0); ob0 = __builtin_amdgcn_mfma_f32_32x32x16_bf16(fb[s], vf, ob0, 0, 0, 0); }
              { const s16x4 lo = vtr(vb + 4096 + s * 1024), hh = vtr(vb + 4096 + s * 1024 + 512); const bf16x8 vf = {lo[0], lo[1], lo[2], lo[3], hh[0], hh[1], hh[2], hh[3]};
                oa1 = __builtin_amdgcn_mfma_f32_32x32x16_bf16(fa[s], vf, oa1, 0, 0, 0); ob1 = __builtin_amdgcn_mfma_f32_32x32x16_bf16(fb[s], vf, ob1, 0, 0, 0); } } }
        if (t + 1 < NT) { *(LAS u32x4*)(nbuf + tid * 16) = sk0; if (tid < 256) *(LAS u32x4*)(nbuf + (tid + 512) * 16) = sk1; *(LAS u32x4*)(nbuf + KSLOT + tid * 16) = sv; }
        __syncthreads();
    }
    la += __shfl_xor(la, 32); lb += __shfl_xor(lb, 32);
    if (hi == 0) { wsf[32 + r32] = la; wsf[96 + r32] = lb; }
    LAS bf16_t* stg = (LAS bf16_t*)(lds + L_OST) + wid * 2048;
#pragma unroll
    for (int hf = 0; hf < 2; ++hf) {
#pragma unroll
        for (int r = 0; r < 16; ++r) { const int orow = crow(r, hi); const float rl = __builtin_amdgcn_rcpf(wsf[hf * 64 + 32 + orow]);
            stg[orow * 64 + r32] = f2bf((hf ? ob0[r] : oa0[r]) * rl); stg[orow * 64 + 32 + r32] = f2bf((hf ? ob1[r] : oa1[r]) * rl); }
        asm volatile("" ::: "memory");
        bf16_t* Ow = O + (rowbase + q0 + wid * 64 + hf * 32) * 512 + h * 64;
#pragma unroll
        for (int i = 0; i < 4; ++i) { const int row = i * 8 + (lane >> 3), ch = lane & 7; const u32x4 v = *(const LAS u32x4*)(stg + row * 64 + ch * 8); *(u32x4*)(Ow + (size_t)row * 512 + ch * 8) = v; }
        asm volatile("" ::: "memory");
    }
    asm volatile("s_waitcnt vmcnt(0)" ::: "memory");
    __syncthreads();
    if (tid == 0) __hip_atomic_fetch_add(done_ctr, 1u, __ATOMIC_RELEASE, __HIP_MEMORY_SCOPE_AGENT);
}
}

namespace rwkv {
constexpr int LP = 72, TB = 64 * LP * 2;
constexpr int S_HT0 = 0, S_HT1 = 1, S_A = 2  , S_B = 3  , S_K = 4, S_R = 5, S_BT = 6, S_KT = 7, S_V = 8,
              S_MOFF = 9, S_MAK = 10, S_MRK = 11, S_MRB = 12, S_D = 13, S_WU = 14, S_AU = 15, NSLOT = 16,
              S_ZT = S_B  , S_ACC = S_K  ;
constexpr int FP = 68;
constexpr int O_ZW = S_K * TB, O_ZA = O_ZW + 64 * FP * 4, O_YB = S_MAK * TB, O_WT = NSLOT * TB, O_CL = O_WT + 8 * 64 * 4, O_CST = O_CL + 64 * 4, O_END = O_CST + 12 * 64 * 4;
static_assert(O_ZA + 64 * FP * 4 <= (S_KT + 1) * TB && O_YB + 64 * FP * 4 <= (S_MRK + 1) * TB, "f32 aliases");
__device__ __forceinline__ s16x4 vtr(const LAS unsigned char* p) { return __builtin_bit_cast(s16x4, __builtin_amdgcn_ds_read_tr16_b64_v4i16((LAS s16x4*)p)); }
struct LaneOff { int bn, bt, bs; };
__device__ __forceinline__ LaneOff lane_off(int fr, int fq) { LaneOff o; o.bn = (fr * LP + 8 * fq) * 2; o.bt = ((8 * fq + (fr >> 2)) * LP + 4 * (fr & 3)) * 2; o.bs = (fr * LP + 4 * fq) * 2; return o; }
__device__ __forceinline__ void relaunder(LaneOff& o) { asm volatile("" : "+v"(o.bn), "+v"(o.bt), "+v"(o.bs)); }
__device__ __forceinline__ bf16x8 frag_t(const LAS unsigned char* tile, int kk, int c0, const LaneOff& o) {
    const LAS unsigned char* q = tile + o.bt + (32 * kk * LP + c0) * 2;
    const s16x4 lo = vtr(q), hi = vtr(q + 4 * LP * 2); return (bf16x8){lo[0], lo[1], lo[2], lo[3], hi[0], hi[1], hi[2], hi[3]};
}
__device__ __forceinline__ bf16x8 frag_n(const LAS unsigned char* tile, int r0, int kk, const LaneOff& o) { return *(const LAS bf16x8*)(tile + o.bn + (r0 * LP + 32 * kk) * 2); }
__device__ __forceinline__ f32x4 MFMA16(bf16x8 a, bf16x8 b, f32x4 c) { return __builtin_amdgcn_mfma_f32_16x16x32_bf16(a, b, c, 0, 0, 0); }
__device__ __forceinline__ void st_tile_T(LAS unsigned char* tile, int m0, int n0, const LaneOff& o, const f32x4 c) {
    u32x2 w; w.x = pk2(c[0], c[1]); w.y = pk2(c[2], c[3]); *(LAS u32x2*)(tile + o.bs + (n0 * LP + m0) * 2) = w;
}
__device__ __forceinline__ void unpack8(const u32x4 w, float (&f)[8]) { f[0] = bflo(w.x); f[1] = bfhi(w.x); f[2] = bflo(w.y); f[3] = bfhi(w.y); f[4] = bflo(w.z); f[5] = bfhi(w.z); f[6] = bflo(w.w); f[7] = bfhi(w.w); }
__device__ __forceinline__ u32x4 pack8(const float (&f)[8]) { u32x4 w; w.x = pk2(f[0], f[1]); w.y = pk2(f[2], f[3]); w.z = pk2(f[4], f[5]); w.w = pk2(f[6], f[7]); return w; }
__device__ __forceinline__ void ld8(const float* p, float (&f)[8]) { const f32x4 a = *(const f32x4*)p, b = *(const f32x4*)(p + 4); f[0] = a[0]; f[1] = a[1]; f[2] = a[2]; f[3] = a[3]; f[4] = b[0]; f[5] = b[1]; f[6] = b[2]; f[7] = b[3]; }
__device__ __forceinline__ void ld8l(const LAS float* p, float (&f)[8]) { const f32x4 a = *(const LAS f32x4*)p, b = *(const LAS f32x4*)(p + 4); f[0] = a[0]; f[1] = a[1]; f[2] = a[2]; f[3] = a[3]; f[4] = b[0]; f[5] = b[1]; f[6] = b[2]; f[7] = b[3]; }
__device__ __forceinline__ float ex2(float x) { return __builtin_amdgcn_exp2f(x); }
constexpr float LOG2E = 1.4426950408889634f, LN2 = 0.6931471805599453f;

__device__ __forceinline__ void rwkv_unit(int l, int b, int h, LAS unsigned char* L) {
    const int tid = opaque_tid(), lane = tid & 63, fr = lane & 15, fq = lane >> 4; const int w = __builtin_amdgcn_readfirstlane(tid >> 6);
    const Params p = load_params();
    const bf16_t* PA = (const bf16_t*)(p.ws + WS_PA); bf16_t* Yout = (bf16_t*)(p.ws + WS_YS) + (size_t)T * 512;
    const int t = tid >> 3, c8 = (tid & 7) * 8;
    const int tw = (lane >> 3);
    const int cw = 16 * (w & 3);
    const float* mu = p.rwkv_mu + l * 1664;
    LaneOff lo = lane_off(fr, fq);
#define SLOT(s) (L + (s) * TB)
    for (int e = tid; e < 4096; e += 512) { const int j = e >> 6, i = e & 63; const size_t g_ = (size_t)l * 64 * 512 + (size_t)j * 512 + h * 64 + i;
        *(LAS bf16_t*)(SLOT(S_WU) + (j * LP + i) * 2) = f2bf(p.rwkv_w_up[g_]); *(LAS bf16_t*)(SLOT(S_AU) + (j * LP + i) * 2) = f2bf(p.rwkv_a_up[g_]); }
    for (int e = tid; e < TB / 4; e += 512) { ((LAS unsigned*)SLOT(S_HT0))[e] = 0u; ((LAS unsigned*)SLOT(S_D))[e] = 0u; ((LAS unsigned*)SLOT(S_MOFF))[e] = 0u; ((LAS unsigned*)SLOT(S_MRB))[e] = 0u;
        }
    f32x4 hacc[4];
#pragma unroll
    for (int i = 0; i < 4; ++i) hacc[i] = (f32x4){0.f, 0.f, 0.f, 0.f};
    int hcur = S_HT0, hnxt = S_HT1;
    u32x4 raw[10];
#define RWKV_LOAD(c, t, c8) do { const size_t row_ = (size_t)b * SEQ + (c) * 64 + (t); const bf16_t* s_ = PA + row_ * NA; const bool hp_ = ((c) * 64 + (t)) > 0; const u32x4 z_ = {0u, 0u, 0u, 0u}; \
        raw[0] = *(const u32x4*)(s_ + RW_R + h * 64 + c8); raw[1] = hp_ ? *(const u32x4*)(s_ - NA + RW_R + h * 64 + c8) : z_; \
        raw[2] = *(const u32x4*)(s_ + RW_K + h * 64 + c8); raw[3] = hp_ ? *(const u32x4*)(s_ - NA + RW_K + h * 64 + c8) : z_; \
        raw[4] = *(const u32x4*)(s_ + RW_V + h * 64 + c8); raw[5] = hp_ ? *(const u32x4*)(s_ - NA + RW_V + h * 64 + c8) : z_; \
        raw[6] = *(const u32x4*)(s_ + RW_LW + c8); raw[7] = hp_ ? *(const u32x4*)(s_ - NA + RW_LW + c8) : z_; \
        raw[8] = *(const u32x4*)(s_ + RW_LA + c8); raw[9] = hp_ ? *(const u32x4*)(s_ - NA + RW_LA + c8) : z_; } while (0)
    for (int e = tid; e < 12 * 64; e += 512) { const int rw_ = e >> 6, i_ = e & 63; const int hci = l * 512 + h * 64 + i_; float val;
        switch (rw_) { case 0: val = mu[h * 64 + i_]; break; case 1: val = mu[512 + h * 64 + i_]; break; case 2: val = mu[1024 + h * 64 + i_]; break; case 3: val = mu[1536 + i_]; break; case 4: val = mu[1600 + i_]; break;
            case 5: val = p.rwkv_w0[hci]; break; case 6: val = p.rwkv_a0[hci]; break; case 7: val = p.rwkv_k_k[hci]; break; case 8: val = p.rwkv_k_a[hci]; break; case 9: val = p.rwkv_r_k[hci]; break;
            case 10: val = p.rwkv_ln_w[hci]; break; default: val = p.rwkv_ln_b[hci]; break; }
        ((LAS float*)(L + O_CST))[e] = val; }
    RWKV_LOAD(0, t, c8);
    __syncthreads();
    for (int c = 0; c < SEQ / 64; ++c) {
        int c8v = c8, tv = t, frv = fr, fqv = fq; asm volatile("" : "+v"(c8v), "+v"(tv), "+v"(frv), "+v"(fqv));
        const int twv = tv & 7;
        float r[8], kraw[8], v[8];
        { float cu[8], pr[8], m8[8], o[8];
          unpack8(raw[0], cu); unpack8(raw[1], pr); ld8l((const LAS float*)(L + O_CST) + 0 * 64 + c8v, m8);
#pragma unroll
          for (int e = 0; e < 8; ++e) r[e] = cu[e] + (pr[e] - cu[e]) * m8[e];
          unpack8(raw[2], cu); unpack8(raw[3], pr); ld8l((const LAS float*)(L + O_CST) + 1 * 64 + c8v, m8);
#pragma unroll
          for (int e = 0; e < 8; ++e) kraw[e] = cu[e] + (pr[e] - cu[e]) * m8[e];
          unpack8(raw[4], cu); unpack8(raw[5], pr); ld8l((const LAS float*)(L + O_CST) + 2 * 64 + c8v, m8);
#pragma unroll
          for (int e = 0; e < 8; ++e) v[e] = cu[e] + (pr[e] - cu[e]) * m8[e];
          unpack8(raw[6], cu); unpack8(raw[7], pr); ld8l((const LAS float*)(L + O_CST) + 3 * 64 + c8v, m8);
#pragma unroll
          for (int e = 0; e < 8; ++e) { const float x = cu[e] + (pr[e] - cu[e]) * m8[e]; o[e] = 1.0f - 2.0f * __builtin_amdgcn_rcpf(ex2(x * (2.0f * LOG2E)) + 1.0f); }
          *(LAS u32x4*)(SLOT(S_A) + (tv * LP + c8v) * 2) = pack8(o);
          unpack8(raw[8], cu); unpack8(raw[9], pr); ld8l((const LAS float*)(L + O_CST) + 4 * 64 + c8v, m8);
#pragma unroll
          for (int e = 0; e < 8; ++e) o[e] = cu[e] + (pr[e] - cu[e]) * m8[e];
          *(LAS u32x4*)(SLOT(S_B) + (tv * LP + c8v) * 2) = pack8(o); }
        asm volatile("" ::: "memory");
        relaunder(lo);
        { LAS float* Zw = (LAS float*)(L + O_ZW) + w * (2 * 8 * FP); LAS float* Za = Zw + 8 * FP;
#pragma unroll
          for (int n = 0; n < 4; ++n) { f32x4 aw = {0.f, 0.f, 0.f, 0.f}, aa = {0.f, 0.f, 0.f, 0.f};
#pragma unroll
              for (int kk = 0; kk < 2; ++kk) { aw = MFMA16(frag_n(SLOT(S_A), 8 * w, kk, lo), frag_t(SLOT(S_WU), kk, 16 * n, lo), aw);
                  aa = MFMA16(frag_n(SLOT(S_B), 8 * w, kk, lo), frag_t(SLOT(S_AU), kk, 16 * n, lo), aa); }
              if (fqv < 2) {
#pragma unroll
                  for (int rr = 0; rr < 4; ++rr) { Zw[(4 * fqv + rr) * FP + 16 * n + frv] = aw[rr]; Za[(4 * fqv + rr) * FP + 16 * n + frv] = aa[rr]; } } } }
        asm volatile("" ::: "memory");
        float kk_[8], kp[8], bb[8], lw[8], cs[8], cb;
        { float zw[8], za[8], c0[8], c1[8];
          ld8l((const LAS float*)(L + O_ZW) + w * (2 * 8 * FP) + twv * FP + c8v, zw); ld8l((const LAS float*)(L + O_ZW) + w * (2 * 8 * FP) + 8 * FP + twv * FP + c8v, za);
          ld8l((const LAS float*)(L + O_CST) + 5 * 64 + c8v, c0); ld8l((const LAS float*)(L + O_CST) + 6 * 64 + c8v, c1);
          float av[8];
#pragma unroll
          for (int e = 0; e < 8; ++e) { const float x = -(zw[e] + c0[e]); const float sp = fmaxf(x, 0.f) + LN2 * __builtin_amdgcn_logf(1.0f + ex2(-fabsf(x) * LOG2E));
              lw[e] = -LOG2E * ex2((-sp - 0.5f) * LOG2E);
              av[e] = __builtin_amdgcn_rcpf(1.0f + ex2(-(za[e] + c1[e]) * LOG2E)); }
          ld8l((const LAS float*)(L + O_CST) + 7 * 64 + c8v, c0); ld8l((const LAS float*)(L + O_CST) + 8 * 64 + c8v, c1);
          float ss = 0.f;
#pragma unroll
          for (int e = 0; e < 8; ++e) { kk_[e] = kraw[e] * c0[e]; ss += kk_[e] * kk_[e]; kp[e] = kraw[e] * (1.0f + (av[e] - 1.0f) * c1[e]); }
          ss = sum8(ss);
          const float inv = 1.0f / fmaxf(sqrtf(ss), 1e-12f);
          ld8l((const LAS float*)(L + O_CST) + 9 * 64 + c8v, c0);
          float cp = 0.f;
#pragma unroll
          for (int e = 0; e < 8; ++e) { kk_[e] *= inv; bb[e] = kk_[e] * av[e]; cp += r[e] * kp[e] * c0[e]; }
          cb = sum8(cp);
#pragma unroll
          for (int e = 0; e < 8; ++e) { float x = lw[e];
              float y = __shfl_up(x, 8); if (twv >= 1) x += y;
              y = __shfl_up(x, 16); if (twv >= 2) x += y;
              y = __shfl_up(x, 32); if (twv >= 4) x += y;
              cs[e] = x; }
          if (twv == 7) { LAS float* WT = (LAS float*)(L + O_WT) + w * 64 + c8v;
#pragma unroll
              for (int e = 0; e < 8; ++e) WT[e] = cs[e]; } }
        __syncthreads();
        { float off[8], tot[8];
#pragma unroll
          for (int e = 0; e < 8; ++e) { off[e] = 0.f; tot[e] = 0.f; }
#pragma unroll
          for (int g = 0; g < 8; ++g) { float x[8]; ld8l((const LAS float*)(L + O_WT) + g * 64 + c8v, x);
#pragma unroll
              for (int e = 0; e < 8; ++e) { if (g < w) off[e] += x[e]; tot[e] += x[e]; } }
          if (tv == 0) { LAS float* CL = (LAS float*)(L + O_CL) + c8v;
#pragma unroll
              for (int e = 0; e < 8; ++e) CL[e] = tot[e]; }
          float o[8], en[8], ep[8]; const int toff = (tv * LP + c8v) * 2;
#pragma unroll
          for (int e = 0; e < 8; ++e) { cs[e] += off[e]; en[e] = ex2(-cs[e]); ep[e] = __builtin_amdgcn_rcpf(en[e]); o[e] = -kk_[e] * ep[e] * ex2(-lw[e]); }
          *(LAS u32x4*)(SLOT(S_A) + toff) = pack8(o);
#pragma unroll
          for (int e = 0; e < 8; ++e) o[e] = bb[e] * en[e];
          *(LAS u32x4*)(SLOT(S_B) + toff) = pack8(o);
#pragma unroll
          for (int e = 0; e < 8; ++e) o[e] = kp[e] * en[e];
          *(LAS u32x4*)(SLOT(S_K) + toff) = pack8(o);
#pragma unroll
          for (int e = 0; e < 8; ++e) o[e] = r[e] * ep[e];
          *(LAS u32x4*)(SLOT(S_R) + toff) = pack8(o);
#pragma unroll
          for (int e = 0; e < 8; ++e) { en[e] = ex2(tot[e] - cs[e]); o[e] = bb[e] * en[e]; }
          *(LAS u32x4*)(SLOT(S_BT) + toff) = pack8(o);
#pragma unroll
          for (int e = 0; e < 8; ++e) o[e] = kp[e] * en[e];
          *(LAS u32x4*)(SLOT(S_KT) + toff) = pack8(o);
          *(LAS u32x4*)(SLOT(S_V) + toff) = pack8(v); }
        __syncthreads();
        relaunder(lo);
        int wv = w; asm volatile("" : "+s"(wv));
        if (wv < 4) {
            f32x4 a = {0.f, 0.f, 0.f, 0.f};
#pragma unroll
            for (int kk = 0; kk < 2; ++kk) a = MFMA16(frag_n(SLOT(S_A), 16 * wv, kk, lo), frag_n(SLOT(S_B), 16 * wv, kk, lo), a);
#pragma unroll
            for (int rr = 0; rr < 4; ++rr) a[rr] = (frv < 4 * fqv + rr) ? a[rr] : 0.f;
            float x[16];
            { LAS float* NS = (LAS float*)(SLOT(hnxt) + wv * 1024);
#pragma unroll
              for (int rr = 0; rr < 4; ++rr) NS[(4 * fqv + rr) * 16 + frv] = a[rr];
              asm volatile("s_waitcnt lgkmcnt(0)" ::: "memory");
#pragma unroll
              for (int rw = 0; rw < 16; ++rw) { float s = (rw == frv) ? 1.f : 0.f;
#pragma unroll
                  for (int sc = 0; sc < rw; ++sc) s += NS[rw * 16 + sc] * x[sc];
                  x[rw] = s; }
              asm volatile("s_waitcnt lgkmcnt(0)" ::: "memory"); }
            if (fqv == 0) { LAS unsigned char* dp = SLOT(S_D) + ((16 * wv + frv) * LP + 16 * wv) * 2;
                float lo8[8], hi8[8];
#pragma unroll
                for (int e = 0; e < 8; ++e) { lo8[e] = x[e]; hi8[e] = x[8 + e]; }
                *(LAS u32x4*)dp = pack8(lo8); *(LAS u32x4*)(dp + 16) = pack8(hi8); }
        }
#pragma unroll
        for (int it = 0; it < 6; ++it) { const int task = wv + 8 * it;
            if (task < 36) {
                int q, mn;
                if (task < 6) { q = 0; mn = (int)((0xEDC984ull >> (4 * task)) & 0xF); }
                else { q = 1 + (task - 6) / 10; mn = (int)((0xFEDCA98540ull >> (4 * ((task - 6) % 10))) & 0xF); }
                const int m0 = 16 * (mn >> 2), n0 = 16 * (mn & 3);
                const LAS unsigned char* XA = (q < 2) ? SLOT(S_A) : SLOT(S_R); const LAS unsigned char* XB = (q & 1) ? SLOT(S_K) : SLOT(S_B);
                f32x4 a = {0.f, 0.f, 0.f, 0.f};
#pragma unroll
                for (int kk = 0; kk < 2; ++kk) a = MFMA16(frag_n(XA, m0, kk, lo), frag_n(XB, n0, kk, lo), a);
                if (m0 == n0) {
#pragma unroll
                    for (int rr = 0; rr < 4; ++rr) { const bool keep = (q < 2) ? (frv < 4 * fqv + rr) : (frv <= 4 * fqv + rr); a[rr] = keep ? a[rr] : 0.f; } }
                st_tile_T(SLOT((q == 0) ? S_MOFF : (q == 1) ? S_MAK : (q == 2) ? S_MRB : S_MRK), m0, n0, lo, a);
            } else if (task < 48) {
                const int z = task - 36; const int mn = (int)((0xB76321ull >> (4 * (z % 6))) & 0xF);
                st_tile_T(SLOT((z < 6) ? S_MAK : S_MRK), 16 * (mn >> 2), 16 * (mn & 3), lo, (f32x4){0.f, 0.f, 0.f, 0.f});
            } }
        __syncthreads();
        relaunder(lo);
        f32x4 yacc[4];
        if (w < 4) {
#pragma unroll
            for (int i = 0; i < 4; ++i) { f32x4 a = {0.f, 0.f, 0.f, 0.f};
#pragma unroll
                for (int kk = 0; kk < 2; ++kk) { if (32 * kk < 16 * i + 16) a = MFMA16(frag_t(SLOT(S_MAK), kk, 16 * i, lo), frag_t(SLOT(S_V), kk, cw, lo), a);
                    a = MFMA16(frag_n(SLOT(S_A), 16 * i, kk, lo), frag_n(SLOT(hcur), cw, kk, lo), a); }
#pragma unroll
                for (int kk = 0; kk < 2; ++kk) if (32 * kk < 16 * i) a = MFMA16(frag_t(SLOT(S_MOFF), kk, 16 * i, lo), frag_n(SLOT(S_ZT), cw, kk, lo), a);
                st_tile_T(SLOT(S_ACC), 16 * i, cw, lo, a);
                const f32x4 z = MFMA16(frag_t(SLOT(S_D), i >> 1, 16 * i, lo), frag_n(SLOT(S_ACC), cw, i >> 1, lo), (f32x4){0.f, 0.f, 0.f, 0.f});
                st_tile_T(SLOT(S_ZT), 16 * i, cw, lo, z); }
        } else {
#pragma unroll
            for (int i = 0; i < 4; ++i) { f32x4 a = {0.f, 0.f, 0.f, 0.f};
#pragma unroll
                for (int kk = 0; kk < 2; ++kk) { if (32 * kk < 16 * i + 16) a = MFMA16(frag_t(SLOT(S_MRK), kk, 16 * i, lo), frag_t(SLOT(S_V), kk, cw, lo), a);
                    a = MFMA16(frag_n(SLOT(S_R), 16 * i, kk, lo), frag_n(SLOT(hcur), cw, kk, lo), a);
                }
                yacc[i] = a; }
        }
        __syncthreads();
        relaunder(lo);
        if (c + 1 < SEQ / 64) RWKV_LOAD(c + 1, tv, c8v);
        if (w >= 4) {
#pragma unroll
            for (int i = 0; i < 4; ++i) {
#pragma unroll
                for (int rr = 0; rr < 4; ++rr) hacc[i][rr] = hacc[i][rr] * ex2(((const LAS float*)(L + O_CL))[16 * i + 4 * fqv + rr]);
#pragma unroll
                for (int kk = 0; kk < 2; ++kk) { hacc[i] = MFMA16(frag_t(SLOT(S_KT), kk, 16 * i, lo), frag_t(SLOT(S_V), kk, cw, lo), hacc[i]);
                    hacc[i] = MFMA16(frag_t(SLOT(S_BT), kk, 16 * i, lo), frag_n(SLOT(S_ZT), cw, kk, lo), hacc[i]); }
                st_tile_T(SLOT(hnxt), 16 * i, cw, lo, hacc[i]);
#pragma unroll
                for (int kk = 0; kk < 2; ++kk) if (32 * kk < 16 * i + 16) yacc[i] = MFMA16(frag_t(SLOT(S_MRB), kk, 16 * i, lo), frag_n(SLOT(S_ZT), cw, kk, lo), yacc[i]);
#pragma unroll
                for (int rr = 0; rr < 4; ++rr) ((LAS float*)(L + O_YB))[(16 * i + 4 * fqv + rr) * FP + cw + frv] = yacc[i][rr]; }
        }
        __syncthreads();
        { float y[8], g0[8], g1[8]; ld8l((const LAS float*)(L + O_YB) + tv * FP + c8v, y); ld8l((const LAS float*)(L + O_CST) + 10 * 64 + c8v, g0); ld8l((const LAS float*)(L + O_CST) + 11 * 64 + c8v, g1);
          float s = 0.f;
#pragma unroll
          for (int e = 0; e < 8; ++e) s += y[e];
          const float mean = sum8(s) * (1.f / 64.f); float q = 0.f;
#pragma unroll
          for (int e = 0; e < 8; ++e) { y[e] -= mean; q += y[e] * y[e]; }
          const float rs = rsqrtf(sum8(q) * (1.f / 64.f) + RWKV_GN_EPS);
#pragma unroll
          for (int e = 0; e < 8; ++e) y[e] = y[e] * rs * g0[e] + g1[e] + cb * v[e];
          *(u32x4*)(Yout + ((size_t)b * SEQ + c * 64 + tv) * 512 + h * 64 + c8v) = pack8(y); }
        { const int tmp = hcur; hcur = hnxt; hnxt = tmp; }
    }
    __syncthreads();
#undef SLOT
#undef RWKV_LOAD
}
}

namespace gla {
using rwkv::vtr; using rwkv::unpack8; using rwkv::pack8; using rwkv::ld8l; using rwkv::ex2; using rwkv::LOG2E; using rwkv::LN2; using rwkv::MFMA16;
constexpr int LP = 72, VP = 136, TB = 64 * LP * 2;
constexpr int B_QH = 0, B_KH = TB, B_KT = 2 * TB, B_PT = 3 * TB, B_VV = 4 * TB, B_ST = B_VV + 64 * VP * 2, B_OB = B_ST + 128 * LP * 2, B_WT = B_OB + 64 * 132 * 4,
              B_CL = B_WT + 8 * 64 * 4, B_AUP = B_CL + 64 * 4, B_AB = B_AUP + 16 * 64 * 4, B_GN = B_AB + 64 * 4, B_END = B_GN + 128 * 4;
static_assert(B_END <= 131072, "gla lds");
struct LaneOff { int bn, bt, btv, bs; };
__device__ __forceinline__ LaneOff lane_off(int fr, int fq) { LaneOff o; o.bn = (fr * LP + 8 * fq) * 2; o.bt = ((8 * fq + (fr >> 2)) * LP + 4 * (fr & 3)) * 2; o.btv = ((8 * fq + (fr >> 2)) * VP + 4 * (fr & 3)) * 2; o.bs = (fr * LP + 4 * fq) * 2; return o; }
__device__ __forceinline__ void relaunder(LaneOff& o) { asm volatile("" : "+v"(o.bn), "+v"(o.bt), "+v"(o.btv), "+v"(o.bs)); }
__device__ __forceinline__ bf16x8 frag_t(const LAS unsigned char* tile, int kk, int c0, const LaneOff& o) {
    const LAS unsigned char* q = tile + o.bt + (32 * kk * LP + c0) * 2; const s16x4 lo = vtr(q), hi = vtr(q + 4 * LP * 2); return (bf16x8){lo[0], lo[1], lo[2], lo[3], hi[0], hi[1], hi[2], hi[3]}; }
__device__ __forceinline__ bf16x8 frag_tv(const LAS unsigned char* tile, int kk, int c0, const LaneOff& o) {
    const LAS unsigned char* q = tile + o.btv + (32 * kk * VP + c0) * 2; const s16x4 lo = vtr(q), hi = vtr(q + 4 * VP * 2); return (bf16x8){lo[0], lo[1], lo[2], lo[3], hi[0], hi[1], hi[2], hi[3]}; }
__device__ __forceinline__ bf16x8 frag_n(const LAS unsigned char* tile, int r0, int kk, const LaneOff& o) { return *(const LAS bf16x8*)(tile + o.bn + (r0 * LP + 32 * kk) * 2); }
__device__ __forceinline__ void st_tile_T(LAS unsigned char* tile, int m0, int n0, const LaneOff& o, const f32x4 c) { u32x2 w; w.x = pk2(c[0], c[1]); w.y = pk2(c[2], c[3]); *(LAS u32x2*)(tile + o.bs + (n0 * LP + m0) * 2) = w; }

__device__ __forceinline__ void gla_unit(int l, int b, int h, LAS unsigned char* L, unsigned* done_ctr) {
    const Params p = load_params();
    const bf16_t* PA = (const bf16_t*)(p.ws + WS_PA); bf16_t* Yout = (bf16_t*)(p.ws + WS_YS) + (size_t)2 * T * 512;
    const int tid = opaque_tid(), lane = tid & 63, fr = lane & 15, fq = lane >> 4; const int w = __builtin_amdgcn_readfirstlane(tid >> 6);
    const int t = tid >> 3, c8 = (tid & 7) * 8;
    LaneOff lo = lane_off(fr, fq);
    for (int e = tid; e < 16 * 64; e += 512) ((LAS float*)(L + B_AUP))[e] = p.gla_a_up[(size_t)l * 16 * 256 + (e >> 6) * 256 + h * 64 + (e & 63)];
    if (tid < 64) ((LAS float*)(L + B_AB))[tid] = p.gla_a_b[l * 256 + h * 64 + tid];
    if (tid < 128) ((LAS float*)(L + B_GN))[tid] = p.gla_norm[l * 512 + h * 128 + tid];
    for (int e = tid; e < 128 * LP / 2; e += 512) ((LAS unsigned*)(L + B_ST))[e] = 0u;
    for (int e = tid; e < TB / 4; e += 512) ((LAS unsigned*)(L + B_PT))[e] = 0u;
    f32x4 sacc[4];
#pragma unroll
    for (int m = 0; m < 4; ++m) sacc[m] = (f32x4){0.f, 0.f, 0.f, 0.f};
    u32x4 rq, rk, rv0, rv1, rl0, rl1;
#define GLA_LOAD(c) do { const bf16_t* s_ = PA + ((size_t)b * SEQ + (c) * 64 + t) * NA; rq = *(const u32x4*)(s_ + GQ + h * 64 + c8); rk = *(const u32x4*)(s_ + GK + h * 64 + c8); \
        rv0 = *(const u32x4*)(s_ + GV + h * 128 + 2 * c8); rv1 = *(const u32x4*)(s_ + GV + h * 128 + 2 * c8 + 8); rl0 = *(const u32x4*)(s_ + GLAT); rl1 = *(const u32x4*)(s_ + GLAT + 8); } while (0)
    GLA_LOAD(0);
    __syncthreads();
    for (int c = 0; c < SEQ / 64; ++c) {
        int c8v = c8, tv = t, frv = fr, fqv = fq; asm volatile("" : "+v"(c8v), "+v"(tv), "+v"(frv), "+v"(fqv));
        const int twv = tv & 7;
        float cs[8];
        { float lat[16]; { float a8[8]; unpack8(rl0, a8);
#pragma unroll
              for (int j = 0; j < 8; ++j) lat[j] = a8[j];
              unpack8(rl1, a8);
#pragma unroll
              for (int j = 0; j < 8; ++j) lat[8 + j] = a8[j]; }
          float z[8]; ld8l((const LAS float*)(L + B_AB) + c8v, z);
#pragma unroll
          for (int j = 0; j < 16; ++j) { float a8[8]; ld8l((const LAS float*)(L + B_AUP) + j * 64 + c8v, a8);
#pragma unroll
              for (int e = 0; e < 8; ++e) z[e] += lat[j] * a8[e]; }
#pragma unroll
          for (int e = 0; e < 8; ++e) { const float x = -z[e]; const float sp = fmaxf(x, 0.f) + LN2 * __builtin_amdgcn_logf(1.0f + ex2(-fabsf(x) * LOG2E));
              float v_ = -sp * (LOG2E / 16.0f);
              float y = __shfl_up(v_, 8); if (twv >= 1) v_ += y;
              y = __shfl_up(v_, 16); if (twv >= 2) v_ += y;
              y = __shfl_up(v_, 32); if (twv >= 4) v_ += y;
              cs[e] = v_; }
          if (twv == 7) { LAS float* WT = (LAS float*)(L + B_WT) + w * 64 + c8v;
#pragma unroll
              for (int e = 0; e < 8; ++e) WT[e] = cs[e]; } }
        __syncthreads();
        { float off[8], tot[8];
#pragma unroll
          for (int e = 0; e < 8; ++e) { off[e] = 0.f; tot[e] = 0.f; }
#pragma unroll
          for (int g = 0; g < 8; ++g) { float x[8]; ld8l((const LAS float*)(L + B_WT) + g * 64 + c8v, x);
#pragma unroll
              for (int e = 0; e < 8; ++e) { if (g < w) off[e] += x[e]; tot[e] += x[e]; } }
          if (tv == 0) { LAS float* CL = (LAS float*)(L + B_CL) + c8v;
#pragma unroll
              for (int e = 0; e < 8; ++e) CL[e] = tot[e]; }
          float q8[8], k8[8], o[8], en[8]; unpack8(rq, q8); unpack8(rk, k8); const int toff = (tv * LP + c8v) * 2;
#pragma unroll
          for (int e = 0; e < 8; ++e) { cs[e] += off[e]; en[e] = ex2(-cs[e]); o[e] = q8[e] * 0.125f * __builtin_amdgcn_rcpf(en[e]); }
          *(LAS u32x4*)(L + B_QH + toff) = pack8(o);
#pragma unroll
          for (int e = 0; e < 8; ++e) o[e] = k8[e] * en[e];
          *(LAS u32x4*)(L + B_KH + toff) = pack8(o);
#pragma unroll
          for (int e = 0; e < 8; ++e) o[e] = k8[e] * ex2(tot[e] - cs[e]);
          *(LAS u32x4*)(L + B_KT + toff) = pack8(o);
          *(LAS u32x4*)(L + B_VV + (tv * VP + 2 * c8v) * 2) = rv0; *(LAS u32x4*)(L + B_VV + (tv * VP + 2 * c8v + 8) * 2) = rv1; }
        if (c + 1 < SEQ / 64) GLA_LOAD(c + 1);
        __syncthreads();
        relaunder(lo);
        { const int m0 = 16 * (w >> 1);
#pragma unroll
          for (int nn = 0; nn < 2; ++nn) { const int n0 = 32 * (w & 1) + 16 * nn;
              if (n0 <= m0) { f32x4 a = {0.f, 0.f, 0.f, 0.f};
#pragma unroll
                  for (int kk = 0; kk < 2; ++kk) a = MFMA16(frag_n(L + B_QH, m0, kk, lo), frag_n(L + B_KH, n0, kk, lo), a);
                  if (n0 == m0) {
#pragma unroll
                      for (int rr = 0; rr < 4; ++rr) a[rr] = (frv <= 4 * fqv + rr) ? a[rr] : 0.f; }
                  st_tile_T(L + B_PT, m0, n0, lo, a); } } }
        __syncthreads();
        relaunder(lo);
        { const int n0 = 16 * w;
#pragma unroll
          for (int m = 0; m < 4; ++m) { f32x4 a = {0.f, 0.f, 0.f, 0.f};
#pragma unroll
              for (int kk = 0; kk < 2; ++kk) { if (32 * kk < 16 * m + 16) a = MFMA16(frag_t(L + B_PT, kk, 16 * m, lo), frag_tv(L + B_VV, kk, n0, lo), a);
                  a = MFMA16(frag_n(L + B_QH, 16 * m, kk, lo), frag_n(L + B_ST, n0, kk, lo), a); }
#pragma unroll
              for (int rr = 0; rr < 4; ++rr) ((LAS float*)(L + B_OB))[(16 * m + 4 * fqv + rr) * 132 + n0 + frv] = a[rr]; }
          asm volatile("" ::: "memory");
#pragma unroll
          for (int m = 0; m < 4; ++m) { f32x4 a = sacc[m];
#pragma unroll
              for (int rr = 0; rr < 4; ++rr) a[rr] *= ex2(((const LAS float*)(L + B_CL))[16 * m + 4 * fqv + rr]);
#pragma unroll
              for (int kk = 0; kk < 2; ++kk) a = MFMA16(frag_t(L + B_KT, kk, 16 * m, lo), frag_tv(L + B_VV, kk, n0, lo), a);
              sacc[m] = a; st_tile_T(L + B_ST, 16 * m, n0, lo, a); } }
        __syncthreads();
        { float v0[8], v1[8], g0[8], g1[8]; float ss = 0.f; const LAS float* ob = (const LAS float*)(L + B_OB) + tv * 132 + 2 * c8v;
          ld8l(ob, v0); ld8l(ob + 8, v1);
#pragma unroll
          for (int e = 0; e < 8; ++e) ss += v0[e] * v0[e] + v1[e] * v1[e];
          ss = sum8(ss);
          const float rstd = rsqrtf(ss * (1.f / 128.f) + NORM_EPS);
          ld8l((const LAS float*)(L + B_GN) + 2 * c8v, g0); ld8l((const LAS float*)(L + B_GN) + 2 * c8v + 8, g1);
          float o0[8], o1[8];
#pragma unroll
          for (int e = 0; e < 8; ++e) { o0[e] = v0[e] * rstd * g0[e]; o1[e] = v1[e] * rstd * g1[e]; }
          bf16_t* dst = Yout + ((size_t)b * SEQ + c * 64 + tv) * 512 + h * 128 + 2 * c8v;
          *(u32x4*)dst = pack8(o0); *(u32x4*)(dst + 8) = pack8(o1); }
    }
    asm volatile("s_waitcnt vmcnt(0)" ::: "memory");
    __syncthreads();
    if (tid == 0) __hip_atomic_fetch_add(done_ctr, 1u, __ATOMIC_RELEASE, __HIP_MEMORY_SCOPE_AGENT);
#undef GLA_LOAD
}
}

#define XB_TMO      128
#define XB_XCNT(j)  (256  + 64 * (j))
#define XB_XSUB(j)  (1280 + 64 * (j))
#define XB_XGEN(j)  (2304 + 64 * (j))
#define XB_TOP      3328
#define XB_TOPGEN   3392
#define XCD_BAR_WORDS 3456
#define XB_SPIN_CAP (1u << 18)

__device__ __forceinline__ unsigned xb_ld(unsigned* p)              { return __hip_atomic_load(p, __ATOMIC_RELAXED, __HIP_MEMORY_SCOPE_AGENT); }
__device__ __forceinline__ unsigned xb_add(unsigned* p, unsigned v) { return __hip_atomic_fetch_add(p, v, __ATOMIC_RELAXED, __HIP_MEMORY_SCOPE_AGENT); }
__device__ __forceinline__ unsigned xb_xcc_id() { return (unsigned)__builtin_amdgcn_s_getreg((3 << 11) | 20) & 0xFu; }
#define XB_SPIN(cond, bar) do { unsigned _sp = 0; while (cond) { __builtin_amdgcn_s_sleep(1); \
    if ((++_sp & 255u) == 0u) { if (xb_ld(&(bar)[XB_TMO])) break; if (_sp > XB_SPIN_CAP) { atomicAdd(&(bar)[XB_TMO], 1u); break; } } } } while (0)

struct XcdBarrier {
    unsigned* bar; unsigned x;
    volatile LAS unsigned* st;
};

__device__ __forceinline__ XcdBarrier xcd_barrier_post(unsigned* bar, volatile LAS unsigned* st) {
    XcdBarrier b; b.bar = bar; b.x = xb_xcc_id(); b.st = st;
    if (threadIdx.x == 0) (void)xb_add(&bar[XB_XCNT(b.x)], 1u);
    return b;
}
__device__ __forceinline__ void xcd_barrier_complete(unsigned* bar, unsigned x, unsigned& nloc, unsigned& nx) {
    const unsigned G = gridDim.x * gridDim.y * gridDim.z;
    unsigned sum, cnt, mine, sp = 0u;
    for (;;) {
        sum = 0u; cnt = 0u; mine = 0u;
#pragma unroll
        for (unsigned j = 0; j < 16; ++j) { const unsigned c = xb_ld(&bar[XB_XCNT(j)]); sum += c; cnt += (c > 0u) ? 1u : 0u; mine = (j == x) ? c : mine; }
        if (sum == G) break;
        __builtin_amdgcn_s_sleep(1);
        if ((++sp & 255u) == 0u) { if (xb_ld(&bar[XB_TMO])) break; if (sp > XB_SPIN_CAP) { atomicAdd(&bar[XB_TMO], 1u); break; } }
    }
    nloc = mine > 0u ? mine : 1u; nx = cnt > 0u ? cnt : 1u;
}

__device__ __forceinline__ void xcd_barrier(const XcdBarrier& b) {
    asm volatile("s_waitcnt vmcnt(0)" ::: "memory");
    __syncthreads();
    if (threadIdx.x == 0) {
        unsigned* bar = b.bar;
        __builtin_amdgcn_s_waitcnt(0);
        unsigned nloc = b.st[0], nx = b.st[1];
        if (nloc == 0u) { xcd_barrier_complete(bar, b.x, nloc, nx); b.st[0] = nloc; b.st[1] = nx; }
        const unsigned old = xb_add(&bar[XB_XSUB(b.x)], 1u);
        const unsigned gen = old / nloc;
        if (old + 1u == (gen + 1u) * nloc) {
            __builtin_amdgcn_fence(__ATOMIC_RELEASE, "agent");
            asm volatile("s_waitcnt vmcnt(0)" ::: "memory");
            const unsigned og = xb_add(&bar[XB_TOP], 1u);
            const unsigned tg = og / nx;
            if (og + 1u == (tg + 1u) * nx) xb_add(&bar[XB_TOPGEN], 1u);
            else XB_SPIN(xb_ld(&bar[XB_TOPGEN]) == tg, bar);
            __builtin_amdgcn_fence(__ATOMIC_ACQUIRE, "agent");
            xb_add(&bar[XB_XGEN(b.x)], 1u);
            asm volatile("s_waitcnt vmcnt(0)" ::: "memory");
        } else {
            XB_SPIN(xb_ld(&bar[XB_XGEN(b.x)]) == gen, bar);
            __builtin_amdgcn_fence(__ATOMIC_ACQUIRE, "agent");
            asm volatile("s_waitcnt vmcnt(0)" ::: "memory");
        }
    }
    __syncthreads();
}

constexpr int NWAVES = 8, NTHREADS = 512;
constexpr int LDS_MISC = 155648, LDS_BYTES = 159744;
constexpr int PH_PER_LAYER = 8, N_PHASES = 1 + DEPTH * PH_PER_LAYER;
constexpr int CW_BAR = 4096;
constexpr int MG_BLOCKS = 192;
constexpr int RWKV_BLOCKS = 64, SUB_BLOCKS = 256 - RWKV_BLOCKS;
constexpr int N_ATT_UNITS = 64 * (SEQ / 512), N_MIX_ITEMS = 32 + N_ATT_UNITS;
#ifndef MK_MULTI_LAUNCH
#define MK_MULTI_LAUNCH 0
#endif

__device__ __forceinline__ void sub_barrier(unsigned* cnt, unsigned target) {
    asm volatile("s_waitcnt vmcnt(0)" ::: "memory");
    __syncthreads();
    if (threadIdx.x == 0) {
        __builtin_amdgcn_fence(__ATOMIC_RELEASE, "agent"); asm volatile("s_waitcnt vmcnt(0)" ::: "memory");
        __hip_atomic_fetch_add(cnt, 1u, __ATOMIC_RELAXED, __HIP_MEMORY_SCOPE_AGENT);
        unsigned sp = 0; while (__hip_atomic_load(cnt, __ATOMIC_RELAXED, __HIP_MEMORY_SCOPE_AGENT) < target && ++sp < (1u << 24)) __builtin_amdgcn_s_sleep(2);
        __builtin_amdgcn_fence(__ATOMIC_ACQUIRE, "agent"); asm volatile("s_waitcnt vmcnt(0)" ::: "memory");
    }
    __syncthreads();
}
__global__ void __launch_bounds__(NTHREADS, 2) hybrid_fwd(Params p_unused) {
    extern __shared__ __attribute__((aligned(16))) unsigned char lds[];
    cg::grid_group grid = cg::this_grid();
#define G ((int)gridDim.x)
#define bx ((int)blockIdx.x)
#define NGW (G * NWAVES)
#define PHASE_VARS const int tid = opaque_tid(), lane = tid & 63, wave = __builtin_amdgcn_readfirstlane(tid >> 6), gw = bx * NWAVES + wave; (void)lane; (void)gw
    LAS unsigned char* ldsl = (LAS unsigned char*)lds;
    { volatile LAS unsigned* misc = (volatile LAS unsigned*)(ldsl + LDS_MISC); if (threadIdx.x < 64) misc[threadIdx.x] = 0u; __syncthreads(); }
    (void)xcd_barrier_post((unsigned*)(kargs()->ws + WS_CTL) + CW_BAR, (volatile LAS unsigned*)(ldsl + LDS_MISC) + 8);
#define GRID_BAR() do { XcdBarrier xb_; xb_.bar = (unsigned*)(kargs()->ws + WS_CTL) + CW_BAR; xb_.x = xb_xcc_id(); xb_.st = (volatile LAS unsigned*)(ldsl + LDS_MISC) + 8; xcd_barrier(xb_); } while (0)
#ifndef EPI_ALIGN_PD1
#define EPI_ALIGN_PD1 true
#endif
#ifndef EPI_ALIGN_PA2
#define EPI_ALIGN_PA2 true
#endif
#ifndef REPEAT_PH
#define REPEAT_PH 0
#endif
#ifndef PH_MASK
#define PH_MASK 0xFFFF
#endif
#ifndef MIX_MASK
#define MIX_MASK 7
#endif
#define IN(k) true
#define EN(b) ((PH_MASK >> (b)) & 1)
#define SEAM(k) do { if (IN(k) && IN((k) + 1)) { if ((k) == 0) grid.sync(); else GRID_BAR(); } } while (0)
#define WSP(type, off) ((type*)(ws + (off)))

    if (EN(0) && IN(0)) { PHASE_VARS;
        convert_weights(0, lds, gw, NGW, wave, lane);
        KArgs kp = kargs(); unsigned char* ws = kp->ws; const int* positions = kp->positions; const float* x = kp->x; const float* g = kp->norm_pre;
        f32x2* ROPE = WSP(f32x2, WS_ROPE); bf16_t* HB = WSP(bf16_t, WS_HB);
        for (int i = bx * NTHREADS + tid; i < T * 16; i += G * NTHREADS) {
            const int t = i >> 4, j = i & 15; const float inv = exp2f(-(float)j * (13.287712379549449f / 16.0f));
            const float ang = (float)positions[t] * inv; const float k = rintf(ang * 0.15915494309189535f);
            float r = fmaf(-k, 6.2831854820251465f, ang); r = fmaf(-k, -1.7484555314695172e-7f, r);
            ROPE[i] = (f32x2){__cosf(r), __sinf(r)};
        }
        for (int m = gw; m < T; m += NGW) hb_row(x + (size_t)m * DM, g, HB + (size_t)m * DM, lane);
    }
    SEAM(0);
#ifdef EXTRA_SYNCS
    for (int i = 0; i < EXTRA_SYNCS; ++i) GRID_BAR();
#endif

    for (int l = 0; l < DEPTH; ++l) {
        const int P0 = 1 + l * PH_PER_LAYER;
        for (int rp = 0; rp < ((REPEAT_PH == 1 && l == 0) ? 2 : 1); ++rp) { if (rp) GRID_BAR();
        if (EN(1) && IN(P0 + 0)) {
            unsigned char* ws = kargs()->ws;
            pg8::PlainOrder S{(const char*)WSP(bf16_t, WS_HB), (const char*)WSP(bf16_t, WS_WIN), 1024, 1024, T / 256, NA / 256, G, bx, 0};
            EpiStore E{WSP(bf16_t, WS_PA), NA};
            pg8::gemm_phase<EpiStore, pg8::PlainOrder, true>(ldsl, pg8::Gemm{1024, 1024, 1024}, S, E);
        }
        }
        SEAM(P0 + 0);
        if (EN(2) && IN(P0 + 1)) { PHASE_VARS;
            if (bx >= RWKV_BLOCKS) {
                unsigned char* ws = kargs()->ws; const int c2 = bx - RWKV_BLOCKS;
                { const bf16_t* PA = WSP(bf16_t, WS_PA); const f32x2* ROPE = WSP(f32x2, WS_ROPE); float* RSTDQ = WSP(float, WS_RSTD); float* RSTDKV = RSTDQ + T; bf16_t* Kb = WSP(bf16_t, WS_K);
                  for (int m = c2 * NWAVES + wave; m < T; m += SUB_BLOCKS * NWAVES) mla_prep_row(PA + (size_t)m * NA, ROPE + (size_t)m * 16, RSTDQ + m, RSTDKV + m, Kb + (size_t)m * KP, lane); }
                sub_barrier((unsigned*)(ws + WS_CTL) + 64 * 40, (unsigned)SUB_BLOCKS * (unsigned)(2 * l + 1));
                { pg8::PlainOrder S{(const char*)(WSP(bf16_t, WS_PA) + CQ), (const char*)WSP(bf16_t, WS_WUQ), NA, 256, T / 256, 3, SUB_BLOCKS, c2, 0};
                  EpiQ E{WSP(bf16_t, WS_Q), WSP(float, WS_RSTD)};
                  pg8::gemm_phase<EpiQ, pg8::PlainOrder, true>(ldsl, pg8::Gemm{NA, 256, 256}, S, E); }
                { pg8::PlainOrder S{(const char*)(WSP(bf16_t, WS_PA) + CKV), (const char*)WSP(bf16_t, WS_WUKV), NA, 256, T / 256, 4, SUB_BLOCKS, c2, 0};
                  EpiKV E{WSP(bf16_t, WS_K), WSP(bf16_t, WS_V), WSP(float, WS_RSTD) + T};
                  pg8::gemm_phase<EpiKV, pg8::PlainOrder, true>(ldsl, pg8::Gemm{NA, 256, 256}, S, E); }
                sub_barrier((unsigned*)(kargs()->ws + WS_CTL) + 64 * 40, (unsigned)SUB_BLOCKS * (unsigned)(2 * l + 2));
            } else {
                rwkv::rwkv_unit(l, bx >> 3, bx & 7, ldsl);
            }
        }
        if (EN(4) && IN(P0 + 3)) { PHASE_VARS;
            volatile LAS unsigned* qw = (volatile LAS unsigned*)(ldsl + LDS_MISC);
            for (;;) {
                __syncthreads();
                if (tid == 0) { unsigned* CTL = (unsigned*)(kargs()->ws + WS_CTL); qw[0] = atomicAdd(CTL + 64 * (1 + l), 1u); }
                __syncthreads();
                const int it = __builtin_amdgcn_readfirstlane((int)qw[0]);
                if (it >= N_MIX_ITEMS) break;
                if (it < 32) gla::gla_unit(l, it >> 2, it & 3, ldsl, (unsigned*)(kargs()->ws + WS_CTL) + 64 * (24 + l));
                else { const int a = it - 32; att::attn_unit((a & 63) >> 3, a & 7, (SEQ / 512 - 1) - (a >> 6), ldsl, (unsigned*)(kargs()->ws + WS_CTL) + 64 * (16 + l)); }
            }
            { unsigned* ctl = (unsigned*)(kargs()->ws + WS_CTL);
              __syncthreads();
              if (tid == 0) { const unsigned tk = __hip_atomic_fetch_add(ctl + 64 * (20 + l), 1u, __ATOMIC_RELAXED, __HIP_MEMORY_SCOPE_AGENT); qw[0] = tk;
                  if (tk < (unsigned)MG_BLOCKS) { unsigned sp = 0; while (__hip_atomic_load(ctl + 64 * (16 + l), __ATOMIC_RELAXED, __HIP_MEMORY_SCOPE_AGENT) < (unsigned)N_ATT_UNITS && ++sp < (1u << 22)) __builtin_amdgcn_s_sleep(8); }
                  __builtin_amdgcn_fence(__ATOMIC_ACQUIRE, "agent"); asm volatile("s_waitcnt vmcnt(0)" ::: "memory"); }
              __syncthreads();
              const int tk = __builtin_amdgcn_readfirstlane((int)qw[0]);
              if (tk < MG_BLOCKS) {
                  unsigned char* ws = kargs()->ws;
                  pg8::PlainOrder S{(const char*)WSP(bf16_t, WS_HB), (const char*)(WSP(bf16_t, WS_WIN) + (size_t)(NA + 1536) * 1024), 1024, 1024, T / 256, 12, MG_BLOCKS, tk, 0};
                  EpiGateMG8 E{WSP(unsigned char, WS_SMG8)};
                  pg8::gemm_phase<EpiGateMG8, pg8::PlainOrder, true>(ldsl, pg8::Gemm{1024, 1024, 1024}, S, E);
                  __syncthreads();
                  if (tid == 0) { unsigned sp = 0; while (__hip_atomic_load(ctl + 64 * (24 + l), __ATOMIC_RELAXED, __HIP_MEMORY_SCOPE_AGENT) < 32u && ++sp < (1u << 22)) __builtin_amdgcn_s_sleep(8);
                      __builtin_amdgcn_fence(__ATOMIC_ACQUIRE, "agent"); asm volatile("s_waitcnt vmcnt(0)" ::: "memory"); }
                  __syncthreads();
                  pg8::PlainOrder S2{(const char*)WSP(bf16_t, WS_HB), (const char*)(WSP(bf16_t, WS_WIN) + (size_t)NA * 1024), 1024, 1024, T / 256, 4, MG_BLOCKS, tk, 2};
                  EpiGateBG E2{WSP(bf16_t, WS_YS), 0, 2};
                  pg8::gemm_phase<EpiGateBG, pg8::PlainOrder, true>(ldsl, pg8::Gemm{1024, 1024, 1024}, S2, E2);
              } }
        }
        SEAM(P0 + 3);
        if (EN(5) && IN(P0 + 4)) {
            unsigned char* ws = kargs()->ws;
            pg8::PlainOrder S{(const char*)WSP(bf16_t, WS_HB), (const char*)(WSP(bf16_t, WS_WIN) + (size_t)(NA + 512) * 1024), 1024, 1024, T / 256, 2, G, bx, 0};
            EpiGateBG E{WSP(bf16_t, WS_YS), 2, 0};
            pg8::gemm_phase<EpiGateBG, pg8::PlainOrder, true>(ldsl, pg8::Gemm{1024, 1024, 1024}, S, E);
        }
        SEAM(P0 + 4);
        for (int rp = 0; rp < ((REPEAT_PH == 6 && l == 0) ? 2 : 1); ++rp) { if (rp) GRID_BAR();
        if (EN(6) && IN(P0 + 5)) {
            unsigned char* ws = kargs()->ws;
            pg8::GroupOrder3 S{(const char*)WSP(bf16_t, WS_YS), (const char*)WSP(bf16_t, WS_WBO), 512, 512, T / 256, 4, G, bx, (size_t)T * 512 * 2, (size_t)1024 * 512 * 2};
            EpiMerge E{WSP(bf16_t, WS_MG), WSP(unsigned char, WS_SMG8)};
            pg8::gemm_phase<EpiMerge, pg8::GroupOrder3, EPI_ALIGN_PD1>(ldsl, pg8::Gemm{512, 512, 512}, S, E);
        }
        }
        SEAM(P0 + 5);
        for (int rp = 0; rp < ((REPEAT_PH == 7 && l == 0) ? 2 : 1); ++rp) { if (rp) GRID_BAR();
        if (EN(7) && IN(P0 + 6)) {
            unsigned char* ws = kargs()->ws;
            pg8::PlainOrder S{(const char*)WSP(bf16_t, WS_MG), (const char*)WSP(bf16_t, WS_WOUT), 1024, 1024, T / 256, 4, G, bx, 0};
            EpiStore E{WSP(bf16_t, WS_OF), 1024};
            pg8::gemm_phase<EpiStore, pg8::PlainOrder, true>(ldsl, pg8::Gemm{1024, 1024, 1024}, S, E);
        }
        }
        SEAM(P0 + 6);
        if (EN(8) && IN(P0 + 7)) { PHASE_VARS;
            const bool more = (l + 1 < DEPTH);
            if (more) convert_weights(l + 1, lds, gw, NGW, wave, lane);
            KArgs kp = kargs(); unsigned char* ws = kp->ws; float* out = kp->out; const float* xold = (l == 0) ? kp->x : out; const float* gpost = kp->norm_post + l * DM; const float* gnext = more ? kp->norm_pre + (l + 1) * DM : nullptr;
            const bf16_t* OF = WSP(bf16_t, WS_OF); bf16_t* HB = WSP(bf16_t, WS_HB);
            for (int m = gw; m < T; m += NGW)
                final_row(OF + (size_t)m * DM, xold + (size_t)m * DM, gpost, out + (size_t)m * DM, gnext, HB + (size_t)m * DM, lane);
        }
        if (l + 1 < DEPTH) SEAM(P0 + 7);
    }
#undef IN
#undef EN
#undef SEAM
#undef WSP
#undef PHASE_VARS
#undef G
#undef bx
#undef NGW
}

extern "C" void kernel_launch(void* const* d_in, const int* in_sizes, int n_in, void* d_out, int out_size, void* d_ws, size_t ws_size, hipStream_t stream) {
    static int grid = 0;
    if (grid == 0) {
        if (n_in != 24 || in_sizes[0] != T * DM || out_size != T * DM || ws_size < WS_END) {
            fprintf(stderr, "kernel_launch: unexpected shapes (n_in %d, in0 %d, out %d, ws %zu; need ws >= %zu); nothing launched\n", n_in, n_in > 0 ? in_sizes[0] : -1, out_size, ws_size, (size_t)WS_END);
            grid = -1; return; }
        int dev = 0, cus = 0, per_cu = 0;
        (void)hipGetDevice(&dev); (void)hipDeviceGetAttribute(&cus, hipDeviceAttributeMultiprocessorCount, dev);
        if (hipFuncSetAttribute((const void*)hybrid_fwd, hipFuncAttributeMaxDynamicSharedMemorySize, LDS_BYTES) != hipSuccess) { fprintf(stderr, "kernel_launch: hipFuncSetAttribute failed\n"); grid = -1; return; }
        if (hipOccupancyMaxActiveBlocksPerMultiprocessor(&per_cu, (const void*)hybrid_fwd, NTHREADS, LDS_BYTES) != hipSuccess || per_cu < 1) {
            fprintf(stderr, "kernel_launch: occupancy query reports %d blocks per CU\n", per_cu); per_cu = 1; }
        (void)hipGetLastError();
        grid = cus * (per_cu < 1 ? 1 : 1);
        fprintf(stderr, "kernel_launch: grid %d (cus %d, occupancy %d), ws %zu\n", grid, cus, per_cu, ws_size);
    }
    if (grid < 0) return;
    (void)hipMemsetAsync((char*)d_ws + WS_CTL, 0, 65536, stream);
    Params p{};
    p.x = (const float*)d_in[0]; p.positions = (const int*)d_in[1]; p.norm_pre = (const float*)d_in[2]; p.w_in = (const float*)d_in[3]; p.mla_q_norm = (const float*)d_in[4]; p.mla_kv_norm = (const float*)d_in[5];
    p.mla_w_uq = (const float*)d_in[6]; p.mla_w_ukv = (const float*)d_in[7]; p.rwkv_mu = (const float*)d_in[8]; p.rwkv_w0 = (const float*)d_in[9]; p.rwkv_w_up = (const float*)d_in[10]; p.rwkv_a0 = (const float*)d_in[11];
    p.rwkv_a_up = (const float*)d_in[12]; p.rwkv_k_k = (const float*)d_in[13]; p.rwkv_k_a = (const float*)d_in[14]; p.rwkv_r_k = (const float*)d_in[15]; p.rwkv_ln_w = (const float*)d_in[16]; p.rwkv_ln_b = (const float*)d_in[17];
    p.gla_a_up = (const float*)d_in[18]; p.gla_a_b = (const float*)d_in[19]; p.gla_norm = (const float*)d_in[20]; p.w_branch_out = (const float*)d_in[21]; p.w_out = (const float*)d_in[22]; p.norm_post = (const float*)d_in[23];
    p.out = (float*)d_out; p.ws = (unsigned char*)d_ws;
#if MK_MULTI_LAUNCH
    for (int ph = 0; ph < N_PHASES; ++ph) { p.ph_lo = ph; p.ph_hi = ph + 1; void* args[] = {&p};
        hipError_t e = hipLaunchCooperativeKernel((const void*)hybrid_fwd, dim3(grid), dim3(NTHREADS), args, LDS_BYTES, stream);
        if (e != hipSuccess) { fprintf(stderr, "kernel_launch: launch of phase %d failed: %s\n", ph, hipGetErrorString(e)); break; } }
#else
    p.ph_lo = 0; p.ph_hi = N_PHASES; void* args[] = {&p};
    hipError_t e = hipLaunchCooperativeKernel((const void*)hybrid_fwd, dim3(grid), dim3(NTHREADS), args, LDS_BYTES, stream);
    if (e != hipSuccess) fprintf(stderr, "kernel_launch: cooperative launch failed: %s (grid %d)\n", hipGetErrorString(e), grid);
#endif
}
```

```cpp
#include <hip/hip_runtime.h>
#include <hip/hip_cooperative_groups.h>
#include <cstdio>
#include <cstdint>
#include <cmath>
namespace cg = cooperative_groups;
#define U_P2 1
#define U_P5 1
#define U_P7 1
namespace pg8 {
#define PG8_LAS __attribute__((address_space(3)))
typedef unsigned short bf16_t;
typedef short bf16x8 __attribute__((ext_vector_type(8)));
typedef float f32x4 __attribute__((ext_vector_type(4)));
typedef unsigned u32x4 __attribute__((ext_vector_type(4)));
typedef unsigned u32x2 __attribute__((ext_vector_type(2)));
constexpr int BM = 256, BK = 64, HALF = 128, HTB = HALF * BK * 2  , STAGE_BYTES = 8 * HTB, NXCD = 8, WGM = 8;

__host__ __device__ __forceinline__ int lds_byte(int r, int c) { const int st = (r >> 4) * 2 + (c >> 5), rr = r & 15, cc = c & 31, ob = rr * 64 + cc * 2; return st * 1024 + (ob ^ (((ob >> 9) & 1) << 5)); }
__host__ __device__ __forceinline__ void stage_rc(int b, int& R, int& C) { const int st = b / 1024, sb = b % 1024, swz = sb ^ (((sb >> 9) & 1) << 5); R = (st >> 1) * 16 + swz / 64; C = (st & 1) * 32 + (swz % 64) / 2; }
__host__ __device__ __forceinline__ int perm32(int rho) { const int n = rho >> 4, i = rho & 15; return 8 * (i >> 2) + 4 * n + (i & 3); }

struct Unit { int pm, pn, aux; const char* A; const char* B; };
struct Gemm { int lda, ldb, K; };

__device__ __forceinline__ void tile_of(int L, int nM, int nN, int& pm, int& pn) {
    const int nwg = nM * nN; int wgid = L;
    { const int q = nwg / NXCD, r = nwg % NXCD, xcd = wgid % NXCD, off = wgid / NXCD; wgid = (xcd < r ? xcd * (q + 1) : r * (q + 1) + (xcd - r) * q) + off; }
    const int nig = WGM * nN, gid = wgid / nig, fm = gid * WGM, gsz = (nM - fm) < WGM ? (nM - fm) : WGM;
    pm = fm + ((wgid % nig) % gsz); pn = (wgid % nig) / gsz;
}
struct PlainOrder {
    const char* A; const char* Bt; int lda, ldb, nM, nN, G, c, bskip;
    __device__ __forceinline__ bool next(int i, Unit& u) const {
        const long L = (long)i * G + c; if (L >= (long)nM * nN) return false;
        tile_of((int)L, nM, nN, u.pm, u.pn); u.aux = 0;
        u.A = A + (size_t)u.pm * BM * lda * 2; u.B = Bt + (size_t)(u.pn + ((u.pn >= 2) ? bskip : 0)) * BM * ldb * 2; return true;
    }
};
struct GroupOrder3 {
    const char* A; const char* Bt; int lda, ldb, nM, nN, G, c; size_t a_gstride, b_gstride;
    __device__ __forceinline__ bool next(int i, Unit& u) const {
        const int n = i % 3; const long L = (long)(i / 3) * G + c; if (L >= (long)nM * nN) return false;
        tile_of((int)L, nM, nN, u.pm, u.pn); u.aux = n;
        u.A = A + n * a_gstride + (size_t)u.pm * BM * lda * 2; u.B = Bt + n * b_gstride + (size_t)u.pn * BM * ldb * 2; return true;
    }
};

template <class Epi, class Sched, bool ALIGN_EPI>
__device__ __forceinline__ void gemm_phase(PG8_LAS unsigned char* lds, const Gemm g, const Sched& S, const Epi& E) {
    int tid_ = threadIdx.x; asm volatile("" : "+v"(tid_));
    const int tid = tid_, wid = __builtin_amdgcn_readfirstlane(tid >> 6), lane = tid & 63, wr = wid >> 2, wc = wid & 3, fr = lane & 15, fq = lane >> 4;
    const int K = g.K, nt = K / BK;
    unsigned voffA[2], voffB[2];
#pragma unroll
    for (int i = 0; i < 2; ++i) { int R, C; stage_rc(tid * 16 + i * 8192, R, C); const int Rb = Epi::PERM ? ((R & ~31) + perm32(R & 31)) : R;
        voffA[i] = (unsigned)(R * g.lda + C) * 2u; voffB[i] = (unsigned)(Rb * g.ldb + C) * 2u; }
    const size_t kstep = (size_t)(BK * 2);
    const size_t hstepA = (size_t)HALF * g.lda * 2, hstepB = (size_t)HALF * g.ldb * 2;
    const unsigned ldsw = (unsigned)wid * 1024u;
    const int aoff = lds_byte(wr * 64 + fr, fq * 8), boff = lds_byte(wc * 32 + fr, fq * 8);
#define PG8_SA(b, h) (((b) * 2 + (h)) * HTB)
#define PG8_SB(b, h) ((4 + (b) * 2 + (h)) * HTB)
#define PG8_STAGE(bufoff, gbase, voff) do { _Pragma("unroll") for (int _i = 0; _i < 2; ++_i) \
        __builtin_amdgcn_global_load_lds((const unsigned*)((const char*)(gbase) + (voff)[_i]), (PG8_LAS unsigned*)(lds + (bufoff) + ldsw + _i * 8192), 16, 0, 0); } while (0)
#define PG8_LDA(dst, b, h) do { _Pragma("unroll") for (int m = 0; m < 4; ++m) _Pragma("unroll") for (int k = 0; k < 2; ++k) dst[m][k] = *(const PG8_LAS bf16x8*)(lds + PG8_SA(b, h) + aoff + m * 2048 + k * 1024); } while (0)
#define PG8_LDB(dst, b, h) do { _Pragma("unroll") for (int n = 0; n < 2; ++n) _Pragma("unroll") for (int k = 0; k < 2; ++k) dst[n][k] = *(const PG8_LAS bf16x8*)(lds + PG8_SB(b, h) + boff + n * 2048 + k * 1024); } while (0)
#define PG8_MMA(ai, bj, At, Bt) do { __builtin_amdgcn_s_setprio(1); _Pragma("unroll") for (int m = 0; m < 4; ++m) _Pragma("unroll") for (int n = 0; n < 2; ++n) _Pragma("unroll") for (int k = 0; k < 2; ++k) \
        acc[ai][bj][m][n] = __builtin_amdgcn_mfma_f32_16x16x32_bf16(Bt[n][k], At[m][k], acc[ai][bj][m][n], 0, 0, 0); __builtin_amdgcn_s_setprio(0); } while (0)
#define PG8_WAIT_V(n) asm volatile("s_waitcnt vmcnt(" #n ")" ::: "memory")
#define PG8_WAIT_L(n) asm volatile("s_waitcnt lgkmcnt(" #n ")" ::: "memory")
#define PG8_BAR __builtin_amdgcn_s_barrier()
#define PG8_SCHED __builtin_amdgcn_sched_barrier(0)
    Unit cur, nxt; int ui = 0;
    if (!S.next(0, cur)) return;
    f32x4 acc[2][2][4][2];
#pragma unroll
    for (int a = 0; a < 2; ++a)
#pragma unroll
        for (int b = 0; b < 2; ++b)
#pragma unroll
            for (int m = 0; m < 4; ++m)
#pragma unroll
                for (int n = 0; n < 2; ++n) acc[a][b][m][n] = (f32x4){0.f, 0.f, 0.f, 0.f};
    bf16x8 At[4][2], B0[2][2], B1[2][2];
    const char* cA = cur.A; const char* cB = cur.B;
    PG8_STAGE(PG8_SB(0, 0), cB, voffB); PG8_STAGE(PG8_SB(0, 1), cB + hstepB, voffB); PG8_STAGE(PG8_SA(0, 0), cA, voffA); PG8_STAGE(PG8_SA(0, 1), cA + hstepA, voffA);
    if (wr == 1) PG8_BAR;
    PG8_WAIT_V(2); PG8_BAR;
    PG8_STAGE(PG8_SB(1, 0), cB + kstep, voffB); PG8_STAGE(PG8_SA(1, 0), cA + kstep, voffA); PG8_STAGE(PG8_SB(1, 1), cB + hstepB + kstep, voffB);
    PG8_WAIT_V(6); PG8_BAR;
    for (;;) {
        const bool has_next = S.next(ui + 1, nxt);
        const char* nA = has_next ? nxt.A : cA; const char* nB = has_next ? nxt.B : cB;
#pragma unroll 1
        for (int t = 0; t < nt; t += 2) {
            const bool last = (t == nt - 2);
            const char* a1 = cA + (size_t)(t + 1) * kstep;
            const char* a2 = last ? nA : cA + (size_t)(t + 2) * kstep; const char* b2 = last ? nB : cB + (size_t)(t + 2) * kstep;
            const char* a3 = a2 + kstep; const char* b3 = b2 + kstep;
            PG8_LDB(B0, 0, 0); PG8_LDB(B1, 0, 1); PG8_SCHED; PG8_LDA(At, 0, 0); PG8_STAGE(PG8_SA(1, 1), a1 + hstepA, voffA);
            PG8_WAIT_V(8); PG8_WAIT_L(0); PG8_BAR; PG8_MMA(0, 0, At, B0); PG8_MMA(0, 1, At, B1); PG8_BAR; PG8_SCHED;
            PG8_LDA(At, 0, 1); PG8_STAGE(PG8_SB(0, 0), b2, voffB); PG8_STAGE(PG8_SB(0, 1), b2 + hstepB, voffB); PG8_STAGE(PG8_SA(0, 0), a2, voffA);
            PG8_WAIT_V(8); PG8_WAIT_L(0); PG8_BAR; PG8_MMA(1, 0, At, B0); PG8_MMA(1, 1, At, B1); PG8_BAR; PG8_SCHED;
            PG8_LDB(B0, 1, 0); PG8_LDB(B1, 1, 1); PG8_SCHED; PG8_LDA(At, 1, 0); PG8_STAGE(PG8_SA(0, 1), a2 + hstepA, voffA);
            PG8_WAIT_V(8); PG8_WAIT_L(0); PG8_BAR; PG8_MMA(0, 0, At, B0); PG8_MMA(0, 1, At, B1); PG8_BAR; PG8_SCHED;
            PG8_LDA(At, 1, 1); PG8_STAGE(PG8_SB(1, 0), b3, voffB); PG8_STAGE(PG8_SB(1, 1), b3 + hstepB, voffB); PG8_STAGE(PG8_SA(1, 0), a3, voffA);
            PG8_WAIT_V(8); PG8_WAIT_L(0); PG8_BAR; PG8_MMA(1, 0, At, B0); PG8_MMA(1, 1, At, B1); PG8_BAR; PG8_SCHED;
        }
        if constexpr (ALIGN_EPI) { if (wr == 0) PG8_BAR; }
        E(acc, cur, wr, wc, fr, fq);
        if (!has_next) break;
#pragma unroll
        for (int a = 0; a < 2; ++a)
#pragma unroll
            for (int b = 0; b < 2; ++b)
#pragma unroll
                for (int m = 0; m < 4; ++m)
#pragma unroll
                    for (int n = 0; n < 2; ++n) acc[a][b][m][n] = (f32x4){0.f, 0.f, 0.f, 0.f};
        cur = nxt; cA = nA; cB = nB; ++ui;
        if constexpr (ALIGN_EPI) { if (wr == 1) PG8_BAR; }
    }
    PG8_WAIT_V(0);
    if constexpr (!ALIGN_EPI) { if (wr == 0) PG8_BAR; }
    PG8_BAR;
#undef PG8_SA
#undef PG8_SB
#undef PG8_STAGE
#undef PG8_LDA
#undef PG8_LDB
#undef PG8_MMA
#undef PG8_WAIT_V
#undef PG8_WAIT_L
#undef PG8_BAR
#undef PG8_SCHED
}
}
#define LAS __attribute__((address_space(3)))
typedef unsigned short bf16_t;
typedef short bf16x8 __attribute__((ext_vector_type(8)));
typedef short s16x4 __attribute__((ext_vector_type(4)));
typedef float f32x4 __attribute__((ext_vector_type(4)));
typedef float f32x2 __attribute__((ext_vector_type(2)));
typedef float f32x16 __attribute__((ext_vector_type(16)));
typedef unsigned u32x4 __attribute__((ext_vector_type(4)));
typedef unsigned u32x2 __attribute__((ext_vector_type(2)));
typedef __bf16 bf16x2_t __attribute__((ext_vector_type(2)));

constexpr int BATCH = 8, SEQ = 4096, DM = 1024, T = BATCH * SEQ, DEPTH = 2;
constexpr int N_IN = 7728, NA = 3328, NG = 4608, NALL = NA + NG;
constexpr int CQ = 0, CKV = 256, KROPE = 384, GLAT = 416, RW_R = 512, RW_K = 1024, RW_V = 1536, RW_LW = 2048, RW_LA = 2112, GQ = 2304, GK = 2560, GV = 2816;
constexpr int KP = 544;
constexpr float NORM_EPS = 1e-6f, RWKV_GN_EPS = 64e-5f;
constexpr float QSCALE = 0.10206207261596577f * 1.4426950408889634f;

constexpr size_t MiB = 1u << 20;
constexpr size_t WS_CTL = 0;
constexpr size_t WS_ROPE = 1 * MiB;
constexpr size_t WS_RSTD = 5 * MiB;
constexpr size_t WS_WIN = 6 * MiB;
constexpr size_t WS_WBO = WS_WIN + (size_t)NALL * 1024 * 2;
constexpr size_t WS_WOUT = WS_WBO + 3 * MiB;
constexpr size_t WS_WUQ = WS_WOUT + 2 * MiB;
constexpr size_t WS_WUKV = WS_WUQ + 768 * 256 * 2;
constexpr size_t WS_HB = 28 * MiB;
constexpr size_t WS_PA = 92 * MiB;
constexpr size_t WS_Q = 300 * MiB;
constexpr size_t WS_K = 348 * MiB;
constexpr size_t WS_V = 382 * MiB;
constexpr size_t WS_YS = 414 * MiB;
constexpr size_t WS_SMG8 = WS_Q;
constexpr size_t WS_MG = WS_PA, WS_OF = WS_PA + 64 * MiB;
constexpr size_t WS_END = 510 * MiB;
static_assert(WS_WUKV + 1024 * 256 * 2 <= WS_HB, "weights fit");

__device__ __forceinline__ unsigned pk2(float lo, float hi) { f32x2 v = {lo, hi}; bf16x2_t b = __builtin_convertvector(v, bf16x2_t); return __builtin_bit_cast(unsigned, b); }
__device__ __forceinline__ float bflo(unsigned w) { return __uint_as_float(w << 16); }
__device__ __forceinline__ float bfhi(unsigned w) { return __uint_as_float(w & 0xffff0000u); }
__device__ __forceinline__ float bf2f(bf16_t b) { return __uint_as_float((unsigned)b << 16); }
__device__ __forceinline__ bf16_t f2bf(float f) { return (bf16_t)(pk2(f, 0.f) & 0xffffu); }
__device__ __forceinline__ float wave_sum(float v) {
#pragma unroll
    for (int o = 1; o < 64; o <<= 1) v += __shfl_xor(v, o);
    return v;
}
__device__ __forceinline__ float fast_exp(float x) { return __builtin_amdgcn_exp2f(x * 1.4426950408889634f); }
__device__ __forceinline__ float fast_sigmoid(float x) { return __builtin_amdgcn_rcpf(1.0f + fast_exp(-x)); }
template <int CTRL> __device__ __forceinline__ float dpp_f(float x) { return __int_as_float(__builtin_amdgcn_update_dpp(0, __float_as_int(x), CTRL, 0xf, 0xf, false)); }
__device__ __forceinline__ float sum8(float x) { x += dpp_f<0xB1>(x); x += dpp_f<0x4E>(x); x += dpp_f<0x141>(x); return x; }
__device__ __forceinline__ float sum16(float x) { x += dpp_f<0xB1>(x); x += dpp_f<0x4E>(x); x += dpp_f<0x141>(x); x += dpp_f<0x140>(x); return x; }

struct Params {
    const float* x; const int* positions; const float* norm_pre; const float* w_in; const float* mla_q_norm; const float* mla_kv_norm; const float* mla_w_uq; const float* mla_w_ukv;
    const float* rwkv_mu; const float* rwkv_w0; const float* rwkv_w_up; const float* rwkv_a0; const float* rwkv_a_up; const float* rwkv_k_k; const float* rwkv_k_a; const float* rwkv_r_k;
    const float* rwkv_ln_w; const float* rwkv_ln_b; const float* gla_a_up; const float* gla_a_b; const float* gla_norm; const float* w_branch_out; const float* w_out; const float* norm_post;
    float* out; unsigned char* ws; int ph_lo, ph_hi;
};

typedef const __attribute__((address_space(4))) Params* KArgs;
__device__ __forceinline__ KArgs kargs() { KArgs kp = (KArgs)__builtin_amdgcn_kernarg_segment_ptr(); asm volatile("" : "+s"(kp)); return kp; }

__device__ __forceinline__ Params load_params() { Params p{}; KArgs kp = kargs(); p.x = kp->x; p.positions = kp->positions; p.norm_pre = kp->norm_pre; p.w_in = kp->w_in; p.mla_q_norm = kp->mla_q_norm; p.mla_kv_norm = kp->mla_kv_norm; p.mla_w_uq = kp->mla_w_uq; p.mla_w_ukv = kp->mla_w_ukv; p.rwkv_mu = kp->rwkv_mu; p.rwkv_w0 = kp->rwkv_w0; p.rwkv_w_up = kp->rwkv_w_up; p.rwkv_a0 = kp->rwkv_a0; p.rwkv_a_up = kp->rwkv_a_up; p.rwkv_k_k = kp->rwkv_k_k; p.rwkv_k_a = kp->rwkv_k_a; p.rwkv_r_k = kp->rwkv_r_k; p.rwkv_ln_w = kp->rwkv_ln_w; p.rwkv_ln_b = kp->rwkv_ln_b; p.gla_a_up = kp->gla_a_up; p.gla_a_b = kp->gla_a_b; p.gla_norm = kp->gla_norm; p.w_branch_out = kp->w_branch_out; p.w_out = kp->w_out; p.norm_post = kp->norm_post; p.out = kp->out; p.ws = kp->ws; p.ph_lo = kp->ph_lo; p.ph_hi = kp->ph_hi; return p; }
__device__ __forceinline__ int opaque_tid() { int t = threadIdx.x; asm volatile("" : "+v"(t)); return t; }

using pg8::Unit;
struct EpiStore {
    static constexpr bool PERM = true; bf16_t* O; int ldc;
    __device__ __forceinline__ void operator()(const f32x4 (&acc)[2][2][4][2], const Unit& u, int wr, int wc, int fr, int fq) const {
        const int row0 = u.pm * 256 + wr * 64 + fr, col0 = u.pn * 256 + wc * 32 + 8 * fq;
#pragma unroll
        for (int ai = 0; ai < 2; ++ai)
#pragma unroll
            for (int m = 0; m < 4; ++m) { bf16_t* rowp = O + (size_t)(row0 + ai * 128 + m * 16) * ldc + col0;
#pragma unroll
                for (int bj = 0; bj < 2; ++bj) { const f32x4 v0 = acc[ai][bj][m][0], v1 = acc[ai][bj][m][1];
                    u32x4 w; w.x = pk2(v0[0], v0[1]); w.y = pk2(v0[2], v0[3]); w.z = pk2(v1[0], v1[1]); w.w = pk2(v1[2], v1[3]);
                    *(u32x4*)(rowp + bj * 128) = w; } }
    }
};
struct EpiQ {
    static constexpr bool PERM = true; bf16_t* Q; const float* rstd;
    __device__ __forceinline__ void operator()(const f32x4 (&acc)[2][2][4][2], const Unit& u, int wr, int wc, int fr, int fq) const {
        const int row0 = u.pm * 256 + wr * 64 + fr, col0 = u.pn * 256 + wc * 32 + 8 * fq;
        float rsv[2][4];
#pragma unroll
        for (int ai = 0; ai < 2; ++ai)
#pragma unroll
            for (int m = 0; m < 4; ++m) rsv[ai][m] = rstd[row0 + ai * 128 + m * 16];
#pragma unroll
        for (int ai = 0; ai < 2; ++ai)
#pragma unroll
            for (int m = 0; m < 4; ++m) { const int row = row0 + ai * 128 + m * 16; const float rs = rsv[ai][m] * QSCALE; bf16_t* rowp = Q + (size_t)row * 768 + col0;
#pragma unroll
                for (int bj = 0; bj < 2; ++bj) { const f32x4 v0 = acc[ai][bj][m][0] * rs, v1 = acc[ai][bj][m][1] * rs;
                    u32x4 w; w.x = pk2(v0[0], v0[1]); w.y = pk2(v0[2], v0[3]); w.z = pk2(v1[0], v1[1]); w.w = pk2(v1[2], v1[3]);
                    *(u32x4*)(rowp + bj * 128) = w; } }
    }
};
struct EpiKV {
    static constexpr bool PERM = true; bf16_t* Kb; bf16_t* Vb; const float* rstd;
    __device__ __forceinline__ void operator()(const f32x4 (&acc)[2][2][4][2], const Unit& u, int wr, int wc, int fr, int fq) const {
        const int row0 = u.pm * 256 + wr * 64 + fr, col0 = (u.pn & 1) * 256 + wc * 32 + 8 * fq; const bool isv = u.pn >= 2;
        float rsv[2][4];
#pragma unroll
        for (int ai = 0; ai < 2; ++ai)
#pragma unroll
            for (int m = 0; m < 4; ++m) rsv[ai][m] = rstd[row0 + ai * 128 + m * 16];
#pragma unroll
        for (int ai = 0; ai < 2; ++ai)
#pragma unroll
            for (int m = 0; m < 4; ++m) { const int row = row0 + ai * 128 + m * 16; const float rs = rsv[ai][m];
                bf16_t* rowp = isv ? (Vb + (size_t)row * 512 + col0) : (Kb + (size_t)row * KP + col0);
#pragma unroll
                for (int bj = 0; bj < 2; ++bj) { const f32x4 v0 = acc[ai][bj][m][0] * rs, v1 = acc[ai][bj][m][1] * rs;
                    u32x4 w; w.x = pk2(v0[0], v0[1]); w.y = pk2(v0[2], v0[3]); w.z = pk2(v1[0], v1[1]); w.w = pk2(v1[2], v1[3]);
                    *(u32x4*)(rowp + bj * 128) = w; } }
    }
};
__device__ __forceinline__ unsigned q8(float s) { return (unsigned)(s * 255.0f + 0.5f); }
struct EpiGateBG {
    static constexpr bool PERM = true; bf16_t* YS; int pn0, skip;
    __device__ __forceinline__ void operator()(const f32x4 (&acc)[2][2][4][2], const Unit& u, int wr, int wc, int fr, int fq) const {
        const int pn = pn0 + u.pn + ((u.pn >= 2) ? skip : 0);
        const int row0 = u.pm * 256 + wr * 64 + fr, col0 = (pn & 1) * 256 + wc * 32 + 8 * fq;
        bf16_t* base = YS + (size_t)(pn >> 1) * T * 512;
#pragma unroll
        for (int ai = 0; ai < 2; ++ai) {
            u32x4 y[4][2];
#pragma unroll
            for (int m = 0; m < 4; ++m) { const bf16_t* rowp = base + (size_t)(row0 + ai * 128 + m * 16) * 512 + col0;
#pragma unroll
                for (int bj = 0; bj < 2; ++bj) y[m][bj] = *(const u32x4*)(rowp + bj * 128); }
#pragma unroll
            for (int m = 0; m < 4; ++m) { bf16_t* rowp = base + (size_t)(row0 + ai * 128 + m * 16) * 512 + col0;
#pragma unroll
                for (int bj = 0; bj < 2; ++bj) { const f32x4 a0 = acc[ai][bj][m][0], a1 = acc[ai][bj][m][1]; const u32x4 yy = y[m][bj];
                    float v[8] = {a0[0], a0[1], a0[2], a0[3], a1[0], a1[1], a1[2], a1[3]};
#pragma unroll
                    for (int j = 0; j < 8; ++j) v[j] = fast_sigmoid(v[j]) * v[j];
                    v[0] *= bflo(yy.x); v[1] *= bfhi(yy.x); v[2] *= bflo(yy.y); v[3] *= bfhi(yy.y); v[4] *= bflo(yy.z); v[5] *= bfhi(yy.z); v[6] *= bflo(yy.w); v[7] *= bfhi(yy.w);
                    u32x4 w; w.x = pk2(v[0], v[1]); w.y = pk2(v[2], v[3]); w.z = pk2(v[4], v[5]); w.w = pk2(v[6], v[7]);
                    *(u32x4*)(rowp + bj * 128) = w; } }
        }
    }
};
struct EpiGateMG8 {
    static constexpr bool PERM = true; unsigned char* SMG;
    __device__ __forceinline__ void operator()(const f32x4 (&acc)[2][2][4][2], const Unit& u, int wr, int wc, int fr, int fq) const {
        const int row0 = u.pm * 256 + wr * 64 + fr, col0 = u.pn * 256 + wc * 32 + 8 * fq;
#pragma unroll
        for (int ai = 0; ai < 2; ++ai)
#pragma unroll
            for (int m = 0; m < 4; ++m) { const int row = row0 + ai * 128 + m * 16; unsigned char* rowp = SMG + (size_t)row * 3072 + col0;
#pragma unroll
                for (int bj = 0; bj < 2; ++bj) { const f32x4 a0 = acc[ai][bj][m][0], a1 = acc[ai][bj][m][1];
                    u32x2 w; w.x = q8(fast_sigmoid(a0[0])) | (q8(fast_sigmoid(a0[1])) << 8) | (q8(fast_sigmoid(a0[2])) << 16) | (q8(fast_sigmoid(a0[3])) << 24);
                    w.y = q8(fast_sigmoid(a1[0])) | (q8(fast_sigmoid(a1[1])) << 8) | (q8(fast_sigmoid(a1[2])) << 16) | (q8(fast_sigmoid(a1[3])) << 24);
                    *(u32x2*)(rowp + bj * 128) = w; } }
    }
};
struct EpiMerge {
    static constexpr bool PERM = true; bf16_t* MG; const unsigned char* SMG;
    __device__ __forceinline__ void operator()(const f32x4 (&acc)[2][2][4][2], const Unit& u, int wr, int wc, int fr, int fq) const {
        const int row0 = u.pm * 256 + wr * 64 + fr, col0 = u.pn * 256 + wc * 32 + 8 * fq, n = u.aux; constexpr float S = 1.0f / 255.0f;
#pragma unroll
        for (int ai = 0; ai < 2; ++ai) {
            u32x2 g[4][2]; u32x4 y[4][2];
#pragma unroll
            for (int m = 0; m < 4; ++m) { const int row = row0 + ai * 128 + m * 16; const unsigned char* gp = SMG + (size_t)row * 3072 + n * 1024 + col0; const bf16_t* rowp = MG + (size_t)row * 1024 + col0;
#pragma unroll
                for (int bj = 0; bj < 2; ++bj) { g[m][bj] = *(const u32x2*)(gp + bj * 128); if (n > 0) y[m][bj] = *(const u32x4*)(rowp + bj * 128); } }
#pragma unroll
            for (int m = 0; m < 4; ++m) { const int row = row0 + ai * 128 + m * 16; bf16_t* rowp = MG + (size_t)row * 1024 + col0;
#pragma unroll
                for (int bj = 0; bj < 2; ++bj) { const f32x4 a0 = acc[ai][bj][m][0], a1 = acc[ai][bj][m][1]; const u32x2 gg = g[m][bj];
                    float v[8] = {a0[0] * (S * (float)(gg.x & 0xffu)), a0[1] * (S * (float)((gg.x >> 8) & 0xffu)), a0[2] * (S * (float)((gg.x >> 16) & 0xffu)), a0[3] * (S * (float)(gg.x >> 24)),
                                  a1[0] * (S * (float)(gg.y & 0xffu)), a1[1] * (S * (float)((gg.y >> 8) & 0xffu)), a1[2] * (S * (float)((gg.y >> 16) & 0xffu)), a1[3] * (S * (float)(gg.y >> 24))};
                    if (n > 0) { const u32x4 yy = y[m][bj];
                        v[0] += bflo(yy.x); v[1] += bfhi(yy.x); v[2] += bflo(yy.y); v[3] += bfhi(yy.y); v[4] += bflo(yy.z); v[5] += bfhi(yy.z); v[6] += bflo(yy.w); v[7] += bfhi(yy.w); }
                    u32x4 w; w.x = pk2(v[0], v[1]); w.y = pk2(v[2], v[3]); w.z = pk2(v[4], v[5]); w.w = pk2(v[6], v[7]);
                    *(u32x4*)(rowp + bj * 128) = w; } }
        }
    }
};
struct EpiF32 {
    static constexpr bool PERM = false; float* O; int ldc;
    __device__ __forceinline__ void operator()(const f32x4 (&acc)[2][2][4][2], const Unit& u, int wr, int wc, int fr, int fq) const {
        const int row0 = u.pm * 256 + wr * 64 + fr, col0 = u.pn * 256 + wc * 32 + 4 * fq;
#pragma unroll
        for (int ai = 0; ai < 2; ++ai)
#pragma unroll
            for (int m = 0; m < 4; ++m) { float* rowp = O + (size_t)(row0 + ai * 128 + m * 16) * ldc + col0;
#pragma unroll
                for (int bj = 0; bj < 2; ++bj)
#pragma unroll
                    for (int n = 0; n < 2; ++n) *(f32x4*)(rowp + bj * 128 + n * 16) = acc[ai][bj][m][n]; }
    }
};

template <class SrcCol>
__device__ __forceinline__ void transpose_item(const float* W, int Ksrc, int Nsrc, bf16_t* WT, int Kdst, int item, int nblk, float* scr, int lane, SrcCol src, const float* kscale) {
    const int kb = item / nblk, nb = item % nblk, k0 = 64 * kb, n0 = 32 * nb;
    const int sc = src(n0 + (lane & 31));
#pragma unroll 8
    for (int i = 0; i < 32; ++i) { const int kk = 2 * i + (lane >> 5), k = k0 + kk; float v = 0.f;
        if (sc >= 0 && k < Ksrc) { v = W[(size_t)k * Nsrc + sc]; if (kscale) v *= kscale[k]; }
        scr[kk * 33 + (lane & 31)] = v; }
    asm volatile("s_waitcnt lgkmcnt(0)" ::: "memory");
    const int c = lane & 7;
#pragma unroll
    for (int j = 0; j < 4; ++j) { const int n = (lane >> 3) + 8 * j; const float* s = scr + (8 * c) * 33 + n;
        u32x4 o; o.x = pk2(s[0 * 33], s[1 * 33]); o.y = pk2(s[2 * 33], s[3 * 33]); o.z = pk2(s[4 * 33], s[5 * 33]); o.w = pk2(s[6 * 33], s[7 * 33]);
        *(u32x4*)(WT + (size_t)(n0 + n) * Kdst + k0 + 8 * c) = o; }
    asm volatile("s_waitcnt lgkmcnt(0)" ::: "memory");
}
__device__ __forceinline__ int win_src(int j) {
    if (j < 416) return j;
    if (j < 432) return 3104 + (j - 416);
    if (j < 512) return -1;
    if (j < 2048) return 416 + (j - 512);
    if (j < 2176) return 1952 + (j - 2048);
    if (j < 2304) return -1;
    if (j < 3328) return 2080 + (j - 2304);
    return 3120 + (j - 3328);
}
__device__ __forceinline__ int wuq_src(int j) { const int h = j / 96, c = j % 96; if (c < 64) return h * 96 + c; const int r = c - 64; return h * 96 + 64 + (r & 1) * 16 + (r >> 1); }
__device__ __forceinline__ int wukv_src(int j) { return j < 512 ? (j >> 6) * 128 + (j & 63) : ((j - 512) >> 6) * 128 + 64 + (j & 63); }

__device__ __forceinline__ void convert_weights(int l, unsigned char* lds, int gw, int NGW, int wave, int lane) {
    float* scr = (float*)(lds + wave * 8448); const Params p = load_params();
    bf16_t* WinT = (bf16_t*)(p.ws + WS_WIN); bf16_t* WboT = (bf16_t*)(p.ws + WS_WBO); bf16_t* WoutT = (bf16_t*)(p.ws + WS_WOUT); bf16_t* WuqT = (bf16_t*)(p.ws + WS_WUQ); bf16_t* WukvT = (bf16_t*)(p.ws + WS_WUKV);
    constexpr int I_IN = 16 * (NALL / 32), I_BO = 8 * 32, I_OUT = 16 * 32, I_UQ = 4 * 24, I_UKV = 4 * 32;
    constexpr int NITEMS = I_IN + 3 * I_BO + I_OUT + I_UQ + I_UKV;
    for (int it = gw; it < NITEMS; it += NGW) {
        int r = it;
        if (r < I_IN) { transpose_item(p.w_in + (size_t)l * 1024 * N_IN, 1024, N_IN, WinT, 1024, r, NALL / 32, scr, lane, [](int j) { return win_src(j); }, nullptr); continue; } r -= I_IN;
        if (r < 3 * I_BO) { const int n = r / I_BO; r -= n * I_BO;
            transpose_item(p.w_branch_out + ((size_t)l * 3 + n) * 512 * 1024, 512, 1024, WboT + (size_t)n * 1024 * 512, 512, r, 32, scr, lane, [](int j) { return j; }, nullptr); continue; } r -= 3 * I_BO;
        if (r < I_OUT) { transpose_item(p.w_out + (size_t)l * 1024 * 1024, 1024, 1024, WoutT, 1024, r, 32, scr, lane, [](int j) { return j; }, nullptr); continue; } r -= I_OUT;
        if (r < I_UQ) { transpose_item(p.mla_w_uq + (size_t)l * 256 * 768, 256, 768, WuqT, 256, r, 24, scr, lane, [](int j) { return wuq_src(j); }, p.mla_q_norm + l * 256); continue; } r -= I_UQ;
        transpose_item(p.mla_w_ukv + (size_t)l * 128 * 1024, 128, 1024, WukvT, 256, r, 32, scr, lane, [](int j) { return wukv_src(j); }, p.mla_kv_norm + l * 128);
    }
}
__device__ __forceinline__ void hb_row(const float* xrow, const float* g, bf16_t* orow, int lane) {
    const f32x4* xr = (const f32x4*)xrow + lane; const f32x4* gr = (const f32x4*)g + lane;
    f32x4 v[4]; float s = 0.f;
#pragma unroll
    for (int j = 0; j < 4; ++j) { v[j] = xr[64 * j]; s += (v[j].x * v[j].x + v[j].y * v[j].y) + (v[j].z * v[j].z + v[j].w * v[j].w); }
    const float rstd = rsqrtf(wave_sum(s) * (1.f / DM) + NORM_EPS);
    u32x2* o8 = (u32x2*)orow + lane;
#pragma unroll
    for (int j = 0; j < 4; ++j) { const f32x4 gg = gr[64 * j]; u32x2 w; w.x = pk2(v[j].x * rstd * gg.x, v[j].y * rstd * gg.y); w.y = pk2(v[j].z * rstd * gg.z, v[j].w * rstd * gg.w); o8[64 * j] = w; }
}
__device__ __forceinline__ void final_row(const bf16_t* orow, const float* xold, const float* gpost, float* xnew, const float* gnext, bf16_t* hbrow, int lane) {
    float o[16], x[16], g[16];
    { const u32x4 a = *((const u32x4*)orow + lane), b = *((const u32x4*)orow + 64 + lane);
      o[0] = bflo(a.x); o[1] = bfhi(a.x); o[2] = bflo(a.y); o[3] = bfhi(a.y); o[4] = bflo(a.z); o[5] = bfhi(a.z); o[6] = bflo(a.w); o[7] = bfhi(a.w);
      o[8] = bflo(b.x); o[9] = bfhi(b.x); o[10] = bflo(b.y); o[11] = bfhi(b.y); o[12] = bflo(b.z); o[13] = bfhi(b.z); o[14] = bflo(b.w); o[15] = bfhi(b.w); }
#pragma unroll
    for (int h = 0; h < 2; ++h)
#pragma unroll
        for (int q = 0; q < 2; ++q) { const f32x4 xv = *((const f32x4*)(xold + 512 * h + 8 * lane) + q), gv = *((const f32x4*)(gpost + 512 * h + 8 * lane) + q);
#pragma unroll
            for (int e = 0; e < 4; ++e) { x[8 * h + 4 * q + e] = xv[e]; g[8 * h + 4 * q + e] = gv[e]; } }
    float s = 0.f;
#pragma unroll
    for (int e = 0; e < 16; ++e) s += o[e] * o[e];
    const float rstd = rsqrtf(wave_sum(s) * (1.f / DM) + NORM_EPS);
    float s2 = 0.f;
#pragma unroll
    for (int e = 0; e < 16; ++e) { x[e] += o[e] * rstd * g[e]; s2 += x[e] * x[e]; }
#pragma unroll
    for (int h = 0; h < 2; ++h)
#pragma unroll
        for (int q = 0; q < 2; ++q) *((f32x4*)(xnew + 512 * h + 8 * lane) + q) = (f32x4){x[8 * h + 4 * q], x[8 * h + 4 * q + 1], x[8 * h + 4 * q + 2], x[8 * h + 4 * q + 3]};
    if (gnext) { const float rstd2 = rsqrtf(wave_sum(s2) * (1.f / DM) + NORM_EPS);
#pragma unroll
        for (int h = 0; h < 2; ++h) { const f32x4 g0 = *((const f32x4*)(gnext + 512 * h + 8 * lane)), g1 = *((const f32x4*)(gnext + 512 * h + 8 * lane) + 1);
            u32x4 w; w.x = pk2(x[8 * h] * rstd2 * g0[0], x[8 * h + 1] * rstd2 * g0[1]); w.y = pk2(x[8 * h + 2] * rstd2 * g0[2], x[8 * h + 3] * rstd2 * g0[3]);
            w.z = pk2(x[8 * h + 4] * rstd2 * g1[0], x[8 * h + 5] * rstd2 * g1[1]); w.w = pk2(x[8 * h + 6] * rstd2 * g1[2], x[8 * h + 7] * rstd2 * g1[3]);
            *((u32x4*)hbrow + 64 * h + lane) = w; } }
}
__device__ __forceinline__ void mla_prep_row(const bf16_t* prow, const f32x2* rope_t, float* rstdq, float* rstdkv, bf16_t* krow, int lane) {
    const u32x2 a = *((const u32x2*)(prow + CQ) + lane); const unsigned c = *((const unsigned*)(prow + CKV) + lane);
    float sq = bflo(a.x) * bflo(a.x) + bfhi(a.x) * bfhi(a.x) + bflo(a.y) * bflo(a.y) + bfhi(a.y) * bfhi(a.y);
    float sk = bflo(c) * bflo(c) + bfhi(c) * bfhi(c);
    sq = wave_sum(sq); sk = wave_sum(sk);
    if (lane == 0) { *rstdq = rsqrtf(sq * (1.f / 256.f) + NORM_EPS); *rstdkv = rsqrtf(sk * (1.f / 128.f) + NORM_EPS); }
    if (lane < 16) { const float x1 = bf2f(prow[KROPE + lane]), x2 = bf2f(prow[KROPE + 16 + lane]); const f32x2 cs = rope_t[lane];
        *((unsigned*)(krow + 512) + lane) = pk2(x1 * cs.x - x2 * cs.y, x2 * cs.x + x1 * cs.y); }
}

namespace att {
constexpr int KSLOT = 12288, VSLOT = 8192, BUFB = KSLOT + VSLOT, L_WS = 2 * BUFB, L_OST = L_WS + 8 * 128 * 4, L_END = L_OST + 8 * 4096;
constexpr int UNIT_ROWS = 512;
__device__ __forceinline__ int crow(int r, int hi) { return (r & 3) + 8 * (r >> 2) + 4 * hi; }
__device__ __forceinline__ s16x4 vtr(const LAS unsigned char* p) { return __builtin_bit_cast(s16x4, __builtin_amdgcn_ds_read_tr16_b64_v4i16((LAS s16x4*)p)); }
__device__ __forceinline__ void load_q(bf16x8 (&qr)[6], const bf16_t* Q, const f32x2* rope, size_t row, int h, int hi) {
    const bf16_t* Qw = Q + row * 768 + h * 96 + hi * 8;
#pragma unroll
    for (int s = 0; s < 6; ++s) qr[s] = *(const bf16x8*)(Qw + s * 16);
    const f32x4* rp = (const f32x4*)(rope + row * 16 + 4 * hi);
#pragma unroll
    for (int s = 4; s < 6; ++s) { const f32x4 c01 = rp[(s - 4) * 4], c23 = rp[(s - 4) * 4 + 1]; const u32x4 w = __builtin_bit_cast(u32x4, qr[s]); u32x4 o;
        { const float e = bflo(w.x), d = bfhi(w.x); o.x = pk2(e * c01[0] - d * c01[1], d * c01[0] + e * c01[1]); }
        { const float e = bflo(w.y), d = bfhi(w.y); o.y = pk2(e * c01[2] - d * c01[3], d * c01[2] + e * c01[3]); }
        { const float e = bflo(w.z), d = bfhi(w.z); o.z = pk2(e * c23[0] - d * c23[1], d * c23[0] + e * c23[1]); }
        { const float e = bflo(w.w), d = bfhi(w.w); o.w = pk2(e * c23[2] - d * c23[3], d * c23[2] + e * c23[3]); }
        qr[s] = __builtin_bit_cast(bf16x8, o); }
}
__device__ __forceinline__ void softmax_half(f32x16& p0, f32x16& p1, f32x16& o0, f32x16& o1, float& mrun, float& lrun, bf16x8 (&pa)[4],
                                             bool first, bool band, int kb0, int qrel, int r32, int hi, LAS float* wsf) {
    if (band) {
#pragma unroll
        for (int r = 0; r < 16; ++r) { const int kv = kb0 + (r & 3) + 8 * (r >> 2); if (kv > qrel) p0[r] = -INFINITY; if (kv + 32 > qrel) p1[r] = -INFINITY; } }
    float mx = fmaxf(p0[0], p1[0]);
#pragma unroll
    for (int r = 1; r < 16; ++r) mx = fmaxf(mx, fmaxf(p0[r], p1[r]));
    mx = fmaxf(mx, __shfl_xor(mx, 32));
    if (first || __any(mx > 8.0f)) {
        const float dl = first ? mx : fmaxf(mx, 0.f); mrun += dl;
#pragma unroll
        for (int r = 0; r < 16; ++r) { p0[r] -= dl; p1[r] -= dl; }
        const float alpha = __builtin_amdgcn_exp2f(-dl); lrun *= alpha;
        if (hi == 0) wsf[r32] = alpha;
#pragma unroll
        for (int r = 0; r < 16; ++r) { const float a = wsf[crow(r, hi)]; o0[r] *= a; o1[r] *= a; }
    }
    float ls = 0.f;
#pragma unroll
    for (int r = 0; r < 16; ++r) { p0[r] = __builtin_amdgcn_exp2f(p0[r]); p1[r] = __builtin_amdgcn_exp2f(p1[r]); ls += p0[r] + p1[r]; }
    lrun += ls;
#pragma unroll
    for (int s = 0; s < 4; ++s) { const int bb = 8 * (s & 1); u32x4 w;
        if (s < 2) { w.x = pk2(p0[bb], p0[bb + 1]); w.y = pk2(p0[bb + 2], p0[bb + 3]); w.z = pk2(p0[bb + 4], p0[bb + 5]); w.w = pk2(p0[bb + 6], p0[bb + 7]); }
        else { w.x = pk2(p1[bb], p1[bb + 1]); w.y = pk2(p1[bb + 2], p1[bb + 3]); w.z = pk2(p1[bb + 4], p1[bb + 5]); w.w = pk2(p1[bb + 6], p1[bb + 7]); }
        pa[s] = __builtin_bit_cast(bf16x8, w); }
}
__device__ __forceinline__ void attn_unit(int b, int h, int qb, LAS unsigned char* lds, unsigned* done_ctr) {
    KArgs kp = kargs(); unsigned char* ws_ = kp->ws;
    const bf16_t* Q = (const bf16_t*)(ws_ + WS_Q); const bf16_t* Kg = (const bf16_t*)(ws_ + WS_K); const bf16_t* Vg = (const bf16_t*)(ws_ + WS_V); bf16_t* O = (bf16_t*)(ws_ + WS_YS);
    const int tid = opaque_tid(), lane = tid & 63, r32 = lane & 31, hi = lane >> 5; const int wid = __builtin_amdgcn_readfirstlane(tid >> 6);
    const size_t rowbase = (size_t)b * SEQ; const int q0 = qb * UNIT_ROWS;
    bf16x8 qa[6], qb_[6];
    load_q(qa, Q, (const f32x2*)(ws_ + WS_ROPE), rowbase + q0 + wid * 64 + r32, h, hi);
    load_q(qb_, Q, (const f32x2*)(ws_ + WS_ROPE), rowbase + q0 + wid * 64 + 32 + r32, h, hi);
    const bf16_t* ksrc0 = Kg + (rowbase + (tid & 63)) * KP + h * 64 + (tid >> 6) * 8;
    const bf16_t* ksrc1 = Kg + (rowbase + (tid & 63)) * KP + 512 + (tid >> 6) * 8;
    const bf16_t* vsrc = Vg + (rowbase + ((tid & 255) >> 2)) * 512 + h * 64 + (tid >> 8) * 32 + (tid & 3) * 8;
    const int NT = (q0 + UNIT_ROWS) / 64;
    LAS float* wsf = (LAS float*)(lds + L_WS) + wid * 128;
    u32x4 sk0, sk1, sv;
    sk0 = *(const u32x4*)ksrc0; if (tid < 256) sk1 = *(const u32x4*)ksrc1; sv = *(const u32x4*)vsrc;
    *(LAS u32x4*)(lds + tid * 16) = sk0; if (tid < 256) *(LAS u32x4*)(lds + (tid + 512) * 16) = sk1; *(LAS u32x4*)(lds + KSLOT + tid * 16) = sv;
    __syncthreads();
    f32x16 oa0 = {}, oa1 = {}, ob0 = {}, ob1 = {}; float ma = 0.f, la = 0.f, mb = 0.f, lb = 0.f;
    const int qra = wid * 64 + r32, qrb = qra + 32;
    for (int t = 0; t < NT; ++t) {
        LAS unsigned char* buf = lds + (t & 1) * BUFB; LAS unsigned char* nbuf = lds + ((t + 1) & 1) * BUFB;
        if (t + 1 < NT) { sk0 = *(const u32x4*)(ksrc0 + (size_t)(t + 1) * 64 * KP); if (tid < 256) sk1 = *(const u32x4*)(ksrc1 + (size_t)(t + 1) * 64 * KP); sv = *(const u32x4*)(vsrc + (size_t)(t + 1) * 64 * 512); }
        f32x16 pa0, pa1, pb0, pb1;
#pragma unroll
        for (int r = 0; r < 16; ++r) { pa0[r] = -ma; pa1[r] = -ma; pb0[r] = -mb; pb1[r] = -mb; }
        { const LAS unsigned char* kb = buf + hi * 1024 + r32 * 16;
#pragma unroll
          for (int s = 0; s < 6; ++s) { const bf16x8 a0 = *(const LAS bf16x8*)(kb + s * 2048), a1 = *(const LAS bf16x8*)(kb + s * 2048 + 512);
              pa0 = __builtin_amdgcn_mfma_f32_32x32x16_bf16(a0, qa[s], pa0, 0, 0, 0); pa1 = __builtin_amdgcn_mfma_f32_32x32x16_bf16(a1, qa[s], pa1, 0, 0, 0);
              pb0 = __builtin_amdgcn_mfma_f32_32x32x16_bf16(a0, qb_[s], pb0, 0, 0, 0); pb1 = __builtin_amdgcn_mfma_f32_32x32x16_bf16(a1, qb_[s], pb1, 0, 0, 0); } }
        const bool band = t >= NT - 8; const int kb0 = 64 * (t - (NT - 8)) + 4 * hi;
        bf16x8 fa[4], fb[4];
        softmax_half(pa0, pa1, oa0, oa1, ma, la, fa, t == 0, band, kb0, qra, r32, hi, wsf);
        softmax_half(pb0, pb1, ob0, ob1, mb, lb, fb, t == 0, band, kb0, qrb, r32, hi, wsf + 64);
        { const LAS unsigned char* vb = buf + KSLOT + ((lane >> 4) & 1) * 32 + (lane & 3) * 8 + (4 * hi + ((lane & 15) >> 2)) * 64;
#pragma unroll
          for (int s = 0; s < 4; ++s) {
              { const s16x4 lo = vtr(vb + s * 1024), hh = vtr(vb + s * 1024 + 512); const bf16x8 vf = {lo[0], lo[1], lo[2], lo[3], hh[0], hh[1], hh[2], hh[3]};
                oa0 = __builtin_amdgcn_mfma_f32_32x32x16_bf16(fa[s], vf, oa0, 0, 0, 0); ob0 = __builtin_amdgcn_mfma_f32_32x32x16_bf16(fb[s], vf, ob0, 0, 0, 0); }
              { const s16x4 lo = vtr(vb + 4096 + s * 1024), hh = vtr(vb + 4096 + s * 1024 + 512); const bf16x8 vf = {lo[0], lo[1], lo[2], lo[3], hh[0], hh[1], hh[2], hh[3]};
                oa1 = __builtin_amdgcn_mfma_f32_32x32x16_bf16(fa[s], vf, oa1, 0, 0, 0); ob1 = __builtin_amdgcn_mfma_f32_32x32x16_bf16(fb[s], vf, ob1, 0, 0, 0); } } }
        if (t + 1 < NT) { *(LAS u32x4*)(nbuf + tid * 16) = sk0; if (tid < 256) *(LAS u32x4*)(nbuf + (tid + 512) * 16) = sk1; *(LAS u32x4*)(nbuf + KSLOT + tid * 16) = sv; }
        __syncthreads();
    }
    la += __shfl_xor(la, 32); lb += __shfl_xor(lb, 32);
    if (hi == 0) { wsf[32 + r32] = la; wsf[96 + r32] = lb; }
    LAS bf16_t* stg = (LAS bf16_t*)(lds + L_OST) + wid * 2048;
#pragma unroll
    for (int hf = 0; hf < 2; ++hf) {
#pragma unroll
        for (int r = 0; r < 16; ++r) { const int orow = crow(r, hi); const float rl = __builtin_amdgcn_rcpf(wsf[hf * 64 + 32 + orow]);
            stg[orow * 64 + r32] = f2bf((hf ? ob0[r] : oa0[r]) * rl); stg[orow * 64 + 32 + r32] = f2bf((hf ? ob1[r] : oa1[r]) * rl); }
        asm volatile("" ::: "memory");
        bf16_t* Ow = O + (rowbase + q0 + wid * 64 + hf * 32) * 512 + h * 64;
#pragma unroll
        for (int i = 0; i < 4; ++i) { const int row = i * 8 + (lane >> 3), ch = lane & 7; const u32x4 v = *(const LAS u32x4*)(stg + row * 64 + ch * 8); *(u32x4*)(Ow + (size_t)row * 512 + ch * 8) = v; }
        asm volatile("" ::: "memory");
    }
    asm volatile("s_waitcnt vmcnt(0)" ::: "memory");
    __syncthreads();
    if (tid == 0) __hip_atomic_fetch_add(done_ctr, 1u, __ATOMIC_RELEASE, __HIP_MEMORY_SCOPE_AGENT);
}
}

namespace rwkv {
constexpr int LP = 72, TB = 64 * LP * 2;
constexpr int S_HT0 = 0, S_HT1 = 1, S_A = 2  , S_B = 3  , S_K = 4, S_R = 5, S_BT = 6, S_KT = 7, S_V = 8,
              S_MOFF = 9, S_MAK = 10, S_MRK = 11, S_MRB = 12, S_D = 13, S_ZT = 14, S_ACC = 15, NSLOT = 16;
constexpr int FP = 68;
constexpr int O_ZW = S_K * TB, O_ZA = O_ZW + 64 * FP * 4, O_YB = S_MAK * TB, O_WT = NSLOT * TB, O_CL = O_WT + 8 * 64 * 4, O_CST = O_CL + 64 * 4, O_END = O_CST + 12 * 64 * 4;
static_assert(O_ZA + 64 * FP * 4 <= (S_KT + 1) * TB && O_YB + 64 * FP * 4 <= (S_MRK + 1) * TB, "f32 aliases");
__device__ __forceinline__ s16x4 vtr(const LAS unsigned char* p) { return __builtin_bit_cast(s16x4, __builtin_amdgcn_ds_read_tr16_b64_v4i16((LAS s16x4*)p)); }
struct LaneOff { int bn, bt, bs; };
__device__ __forceinline__ LaneOff lane_off(int fr, int fq) { LaneOff o; o.bn = (fr * LP + 8 * fq) * 2; o.bt = ((8 * fq + (fr >> 2)) * LP + 4 * (fr & 3)) * 2; o.bs = (fr * LP + 4 * fq) * 2; return o; }
__device__ __forceinline__ void relaunder(LaneOff& o) { asm volatile("" : "+v"(o.bn), "+v"(o.bt), "+v"(o.bs)); }
__device__ __forceinline__ bf16x8 frag_t(const LAS unsigned char* tile, int kk, int c0, const LaneOff& o) {
    const LAS unsigned char* q = tile + o.bt + (32 * kk * LP + c0) * 2;
    const s16x4 lo = vtr(q), hi = vtr(q + 4 * LP * 2); return (bf16x8){lo[0], lo[1], lo[2], lo[3], hi[0], hi[1], hi[2], hi[3]};
}
__device__ __forceinline__ bf16x8 frag_n(const LAS unsigned char* tile, int r0, int kk, const LaneOff& o) { return *(const LAS bf16x8*)(tile + o.bn + (r0 * LP + 32 * kk) * 2); }
__device__ __forceinline__ f32x4 MFMA16(bf16x8 a, bf16x8 b, f32x4 c) { return __builtin_amdgcn_mfma_f32_16x16x32_bf16(a, b, c, 0, 0, 0); }
__device__ __forceinline__ void st_tile_T(LAS unsigned char* tile, int m0, int n0, const LaneOff& o, const f32x4 c) {
    u32x2 w; w.x = pk2(c[0], c[1]); w.y = pk2(c[2], c[3]); *(LAS u32x2*)(tile + o.bs + (n0 * LP + m0) * 2) = w;
}
__device__ __forceinline__ void unpack8(const u32x4 w, float (&f)[8]) { f[0] = bflo(w.x); f[1] = bfhi(w.x); f[2] = bflo(w.y); f[3] = bfhi(w.y); f[4] = bflo(w.z); f[5] = bfhi(w.z); f[6] = bflo(w.w); f[7] = bfhi(w.w); }
__device__ __forceinline__ u32x4 pack8(const float (&f)[8]) { u32x4 w; w.x = pk2(f[0], f[1]); w.y = pk2(f[2], f[3]); w.z = pk2(f[4], f[5]); w.w = pk2(f[6], f[7]); return w; }
__device__ __forceinline__ void ld8(const float* p, float (&f)[8]) { const f32x4 a = *(const f32x4*)p, b = *(const f32x4*)(p + 4); f[0] = a[0]; f[1] = a[1]; f[2] = a[2]; f[3] = a[3]; f[4] = b[0]; f[5] = b[1]; f[6] = b[2]; f[7] = b[3]; }
__device__ __forceinline__ void ld8l(const LAS float* p, float (&f)[8]) { const f32x4 a = *(const LAS f32x4*)p, b = *(const LAS f32x4*)(p + 4); f[0] = a[0]; f[1] = a[1]; f[2] = a[2]; f[3] = a[3]; f[4] = b[0]; f[5] = b[1]; f[6] = b[2]; f[7] = b[3]; }
__device__ __forceinline__ float ex2(float x) { return __builtin_amdgcn_exp2f(x); }
constexpr float LOG2E = 1.4426950408889634f, LN2 = 0.6931471805599453f;

__device__ __forceinline__ void rwkv_unit(int l, int b, int h, LAS unsigned char* L) {
    const int tid = opaque_tid(), lane = tid & 63, fr = lane & 15, fq = lane >> 4; const int w = __builtin_amdgcn_readfirstlane(tid >> 6);
    const Params p = load_params();
    const bf16_t* PA = (const bf16_t*)(p.ws + WS_PA); bf16_t* Yout = (bf16_t*)(p.ws + WS_YS) + (size_t)T * 512;
    const int t = tid >> 3, c8 = (tid & 7) * 8;
    const int tw = (lane >> 3);
    const int cw = 16 * (w & 3);
    const float* mu = p.rwkv_mu + l * 1664;
    LaneOff lo = lane_off(fr, fq);
#define SLOT(s) (L + (s) * TB)
    bf16x8 bup[2];
    { const float* U = ((w < 4) ? p.rwkv_w_up : p.rwkv_a_up) + (size_t)l * 64 * 512 + h * 64 + 16 * (w & 3) + fr;
#pragma unroll
      for (int kk = 0; kk < 2; ++kk) { float f[8];
#pragma unroll
          for (int e = 0; e < 8; ++e) f[e] = U[(size_t)(32 * kk + 8 * fq + e) * 512];
          bup[kk] = __builtin_bit_cast(bf16x8, pack8(f)); } }
    for (int e = tid; e < TB / 4; e += 512) { ((LAS unsigned*)SLOT(S_HT0))[e] = 0u; ((LAS unsigned*)SLOT(S_D))[e] = 0u; ((LAS unsigned*)SLOT(S_MOFF))[e] = 0u; ((LAS unsigned*)SLOT(S_MRB))[e] = 0u;
        ((LAS unsigned*)SLOT(S_ZT))[e] = 0u; ((LAS unsigned*)SLOT(S_ACC))[e] = 0u; }
    f32x4 hacc[4];
#pragma unroll
    for (int i = 0; i < 4; ++i) hacc[i] = (f32x4){0.f, 0.f, 0.f, 0.f};
    int hcur = S_HT0, hnxt = S_HT1;
    u32x4 raw[10];
#define RWKV_LOAD(c, t, c8) do { const size_t row_ = (size_t)b * SEQ + (c) * 64 + (t); const bf16_t* s_ = PA + row_ * NA; const bool hp_ = ((c) * 64 + (t)) > 0; const u32x4 z_ = {0u, 0u, 0u, 0u}; \
        raw[0] = *(const u32x4*)(s_ + RW_R + h * 64 + c8); raw[1] = hp_ ? *(const u32x4*)(s_ - NA + RW_R + h * 64 + c8) : z_; \
        raw[2] = *(const u32x4*)(s_ + RW_K + h * 64 + c8); raw[3] = hp_ ? *(const u32x4*)(s_ - NA + RW_K + h * 64 + c8) : z_; \
        raw[4] = *(const u32x4*)(s_ + RW_V + h * 64 + c8); raw[5] = hp_ ? *(const u32x4*)(s_ - NA + RW_V + h * 64 + c8) : z_; \
        raw[6] = *(const u32x4*)(s_ + RW_LW + c8); raw[7] = hp_ ? *(const u32x4*)(s_ - NA + RW_LW + c8) : z_; \
        raw[8] = *(const u32x4*)(s_ + RW_LA + c8); raw[9] = hp_ ? *(const u32x4*)(s_ - NA + RW_LA + c8) : z_; } while (0)
    for (int e = tid; e < 12 * 64; e += 512) { const int rw_ = e >> 6, i_ = e & 63; const int hci = l * 512 + h * 64 + i_; float val;
        switch (rw_) { case 0: val = mu[h * 64 + i_]; break; case 1: val = mu[512 + h * 64 + i_]; break; case 2: val = mu[1024 + h * 64 + i_]; break; case 3: val = mu[1536 + i_]; break; case 4: val = mu[1600 + i_]; break;
            case 5: val = p.rwkv_w0[hci]; break; case 6: val = p.rwkv_a0[hci]; break; case 7: val = p.rwkv_k_k[hci]; break; case 8: val = p.rwkv_k_a[hci]; break; case 9: val = p.rwkv_r_k[hci]; break;
            case 10: val = p.rwkv_ln_w[hci]; break; default: val = p.rwkv_ln_b[hci]; break; }
        ((LAS float*)(L + O_CST))[e] = val; }
    RWKV_LOAD(0, t, c8);
    __syncthreads();
    for (int c = 0; c < SEQ / 64; ++c) {
        int c8v = c8, tv = t, frv = fr, fqv = fq; asm volatile("" : "+v"(c8v), "+v"(tv), "+v"(frv), "+v"(fqv));
        const int twv = tv & 7;
        float r[8], kraw[8], v[8];
        { float cu[8], pr[8], m8[8], o[8];
          unpack8(raw[0], cu); unpack8(raw[1], pr); ld8l((const LAS float*)(L + O_CST) + 0 * 64 + c8v, m8);
#pragma unroll
          for (int e = 0; e < 8; ++e) r[e] = cu[e] + (pr[e] - cu[e]) * m8[e];
          unpack8(raw[2], cu); unpack8(raw[3], pr); ld8l((const LAS float*)(L + O_CST) + 1 * 64 + c8v, m8);
#pragma unroll
          for (int e = 0; e < 8; ++e) kraw[e] = cu[e] + (pr[e] - cu[e]) * m8[e];
          unpack8(raw[4], cu); unpack8(raw[5], pr); ld8l((const LAS float*)(L + O_CST) + 2 * 64 + c8v, m8);
#pragma unroll
          for (int e = 0; e < 8; ++e) v[e] = cu[e] + (pr[e] - cu[e]) * m8[e];
          unpack8(raw[6], cu); unpack8(raw[7], pr); ld8l((const LAS float*)(L + O_CST) + 3 * 64 + c8v, m8);
#pragma unroll
          for (int e = 0; e < 8; ++e) { const float x = cu[e] + (pr[e] - cu[e]) * m8[e]; o[e] = 1.0f - 2.0f * __builtin_amdgcn_rcpf(ex2(x * (2.0f * LOG2E)) + 1.0f); }
          *(LAS u32x4*)(SLOT(S_A) + (tv * LP + c8v) * 2) = pack8(o);
          unpack8(raw[8], cu); unpack8(raw[9], pr); ld8l((const LAS float*)(L + O_CST) + 4 * 64 + c8v, m8);
#pragma unroll
          for (int e = 0; e < 8; ++e) o[e] = cu[e] + (pr[e] - cu[e]) * m8[e];
          *(LAS u32x4*)(SLOT(S_B) + (tv * LP + c8v) * 2) = pack8(o); }
        __syncthreads();
        relaunder(lo);
#ifdef U_P2
        { const LAS unsigned char* X = (w < 4) ? SLOT(S_A) : SLOT(S_B); LAS float* Z = (LAS float*)(L + ((w < 4) ? O_ZW : O_ZA));
          f32x4 zacc[4];
#pragma unroll
          for (int m = 0; m < 4; ++m) { f32x4 a = {0.f, 0.f, 0.f, 0.f};
#pragma unroll
              for (int kk = 0; kk < 2; ++kk) a = MFMA16(frag_n(X, 16 * m, kk, lo), bup[kk], a);
              zacc[m] = a; }
#pragma unroll
          for (int m = 0; m < 4; ++m)
#pragma unroll
              for (int rr = 0; rr < 4; ++rr) Z[(16 * m + 4 * fqv + rr) * FP + cw + frv] = zacc[m][rr]; }
#else
        { const LAS unsigned char* X = (w < 4) ? SLOT(S_A) : SLOT(S_B); LAS float* Z = (LAS float*)(L + ((w < 4) ? O_ZW : O_ZA));
#pragma unroll
          for (int m = 0; m < 4; ++m) { f32x4 a = {0.f, 0.f, 0.f, 0.f};
#pragma unroll
              for (int kk = 0; kk < 2; ++kk) a = MFMA16(frag_n(X, 16 * m, kk, lo), bup[kk], a);
#pragma unroll
              for (int rr = 0; rr < 4; ++rr) Z[(16 * m + 4 * fqv + rr) * FP + cw + frv] = a[rr]; } }
#endif
        __syncthreads();
        float kk_[8], kp[8], bb[8], lw[8], cs[8], cb;
        { float zw[8], za[8], c0[8], c1[8];
          ld8l((const LAS float*)(L + O_ZW) + tv * FP + c8v, zw); ld8l((const LAS float*)(L + O_ZA) + tv * FP + c8v, za);
          ld8l((const LAS float*)(L + O_CST) + 5 * 64 + c8v, c0); ld8l((const LAS float*)(L + O_CST) + 6 * 64 + c8v, c1);
          float av[8];
#pragma unroll
          for (int e = 0; e < 8; ++e) { const float x = -(zw[e] + c0[e]); const float sp = fmaxf(x, 0.f) + LN2 * __builtin_amdgcn_logf(1.0f + ex2(-fabsf(x) * LOG2E));
              lw[e] = -LOG2E * ex2((-sp - 0.5f) * LOG2E);
              av[e] = __builtin_amdgcn_rcpf(1.0f + ex2(-(za[e] + c1[e]) * LOG2E)); }
          ld8l((const LAS float*)(L + O_CST) + 7 * 64 + c8v, c0); ld8l((const LAS float*)(L + O_CST) + 8 * 64 + c8v, c1);
          float ss = 0.f;
#pragma unroll
          for (int e = 0; e < 8; ++e) { kk_[e] = kraw[e] * c0[e]; ss += kk_[e] * kk_[e]; kp[e] = kraw[e] * (1.0f + (av[e] - 1.0f) * c1[e]); }
          ss = sum8(ss);
          const float inv = 1.0f / fmaxf(sqrtf(ss), 1e-12f);
          ld8l((const LAS float*)(L + O_CST) + 9 * 64 + c8v, c0);
          float cp = 0.f;
#pragma unroll
          for (int e = 0; e < 8; ++e) { kk_[e] *= inv; bb[e] = kk_[e] * av[e]; cp += r[e] * kp[e] * c0[e]; }
          cb = sum8(cp);
#pragma unroll
          for (int e = 0; e < 8; ++e) { float x = lw[e];
              float y = __shfl_up(x, 8); if (twv >= 1) x += y;
              y = __shfl_up(x, 16); if (twv >= 2) x += y;
              y = __shfl_up(x, 32); if (twv >= 4) x += y;
              cs[e] = x; }
          if (twv == 7) { LAS float* WT = (LAS float*)(L + O_WT) + w * 64 + c8v;
#pragma unroll
              for (int e = 0; e < 8; ++e) WT[e] = cs[e]; } }
        __syncthreads();
        { float off[8], tot[8];
#pragma unroll
          for (int e = 0; e < 8; ++e) { off[e] = 0.f; tot[e] = 0.f; }
#pragma unroll
          for (int g = 0; g < 8; ++g) { float x[8]; ld8l((const LAS float*)(L + O_WT) + g * 64 + c8v, x);
#pragma unroll
              for (int e = 0; e < 8; ++e) { if (g < w) off[e] += x[e]; tot[e] += x[e]; } }
          if (tv == 0) { LAS float* CL = (LAS float*)(L + O_CL) + c8v;
#pragma unroll
              for (int e = 0; e < 8; ++e) CL[e] = tot[e]; }
          float o[8], en[8], ep[8]; const int toff = (tv * LP + c8v) * 2;
#pragma unroll
          for (int e = 0; e < 8; ++e) { cs[e] += off[e]; en[e] = ex2(-cs[e]); ep[e] = __builtin_amdgcn_rcpf(en[e]); o[e] = -kk_[e] * ep[e] * ex2(-lw[e]); }
          *(LAS u32x4*)(SLOT(S_A) + toff) = pack8(o);
#pragma unroll
          for (int e = 0; e < 8; ++e) o[e] = bb[e] * en[e];
          *(LAS u32x4*)(SLOT(S_B) + toff) = pack8(o);
#pragma unroll
          for (int e = 0; e < 8; ++e) o[e] = kp[e] * en[e];
          *(LAS u32x4*)(SLOT(S_K) + toff) = pack8(o);
#pragma unroll
          for (int e = 0; e < 8; ++e) o[e] = r[e] * ep[e];
          *(LAS u32x4*)(SLOT(S_R) + toff) = pack8(o);
#pragma unroll
          for (int e = 0; e < 8; ++e) { en[e] = ex2(tot[e] - cs[e]); o[e] = bb[e] * en[e]; }
          *(LAS u32x4*)(SLOT(S_BT) + toff) = pack8(o);
#pragma unroll
          for (int e = 0; e < 8; ++e) o[e] = kp[e] * en[e];
          *(LAS u32x4*)(SLOT(S_KT) + toff) = pack8(o);
          *(LAS u32x4*)(SLOT(S_V) + toff) = pack8(v); }
        __syncthreads();
        relaunder(lo);
        int wv = w; asm volatile("" : "+s"(wv));
#ifdef U_P4
        f32x4 tacc[5];
#pragma unroll
        for (int it = 0; it < 5; ++it) { const int task = wv + 8 * it; f32x4 a = {0.f, 0.f, 0.f, 0.f};
            if (task < 36) {
                int q, mn;
                if (task < 6) { q = 0; mn = (int)((0xEDC984ull >> (4 * task)) & 0xF); }
                else { q = 1 + (task - 6) / 10; mn = (int)((0xFEDCA98540ull >> (4 * ((task - 6) % 10))) & 0xF); }
                const int m0 = 16 * (mn >> 2), n0 = 16 * (mn & 3);
                const LAS unsigned char* XA = (q < 2) ? SLOT(S_A) : SLOT(S_R); const LAS unsigned char* XB = (q & 1) ? SLOT(S_K) : SLOT(S_B);
#pragma unroll
                for (int kk = 0; kk < 2; ++kk) a = MFMA16(frag_n(XA, m0, kk, lo), frag_n(XB, n0, kk, lo), a);
                if (m0 == n0) {
#pragma unroll
                    for (int rr = 0; rr < 4; ++rr) { const bool keep = (q < 2) ? (frv < 4 * fqv + rr) : (frv <= 4 * fqv + rr); a[rr] = keep ? a[rr] : 0.f; } } }
            tacc[it] = a; }
        if (wv < 4) {
            f32x4 a = {0.f, 0.f, 0.f, 0.f};
#pragma unroll
            for (int kk = 0; kk < 2; ++kk) a = MFMA16(frag_n(SLOT(S_A), 16 * wv, kk, lo), frag_n(SLOT(S_B), 16 * wv, kk, lo), a);
#pragma unroll
            for (int rr = 0; rr < 4; ++rr) a[rr] = (frv < 4 * fqv + rr) ? a[rr] : 0.f;
            float x[16];
            { LAS float* NS = (LAS float*)(SLOT(hnxt) + wv * 1024);
#pragma unroll
              for (int rr = 0; rr < 4; ++rr) NS[(4 * fqv + rr) * 16 + frv] = a[rr];
              asm volatile("s_waitcnt lgkmcnt(0)" ::: "memory");
#pragma unroll
              for (int rw = 0; rw < 16; ++rw) { float s = (rw == frv) ? 1.f : 0.f;
#pragma unroll
                  for (int sc = 0; sc < rw; ++sc) s += NS[rw * 16 + sc] * x[sc];
                  x[rw] = s; }
              asm volatile("s_waitcnt lgkmcnt(0)" ::: "memory"); }
            if (fqv == 0) { LAS unsigned char* dp = SLOT(S_D) + ((16 * wv + frv) * LP + 16 * wv) * 2;
                float lo8[8], hi8[8];
#pragma unroll
                for (int e = 0; e < 8; ++e) { lo8[e] = x[e]; hi8[e] = x[8 + e]; }
                *(LAS u32x4*)dp = pack8(lo8); *(LAS u32x4*)(dp + 16) = pack8(hi8); }
        }
#pragma unroll
        for (int it = 0; it < 6; ++it) { const int task = wv + 8 * it;
            if (task < 36) {
                int q, mn;
                if (task < 6) { q = 0; mn = (int)((0xEDC984ull >> (4 * task)) & 0xF); }
                else { q = 1 + (task - 6) / 10; mn = (int)((0xFEDCA98540ull >> (4 * ((task - 6) % 10))) & 0xF); }
                st_tile_T(SLOT((q == 0) ? S_MOFF : (q == 1) ? S_MAK : (q == 2) ? S_MRB : S_MRK), 16 * (mn >> 2), 16 * (mn & 3), lo, tacc[it < 5 ? it : 4]);
            } else if (task < 48) {
                const int z = task - 36; const int mn = (int)((0xB76321ull >> (4 * (z % 6))) & 0xF);
                st_tile_T(SLOT((z < 6) ? S_MAK : S_MRK), 16 * (mn >> 2), 16 * (mn & 3), lo, (f32x4){0.f, 0.f, 0.f, 0.f});
            } }
#else
        if (wv < 4) {
            f32x4 a = {0.f, 0.f, 0.f, 0.f};
#pragma unroll
            for (int kk = 0; kk < 2; ++kk) a = MFMA16(frag_n(SLOT(S_A), 16 * wv, kk, lo), frag_n(SLOT(S_B), 16 * wv, kk, lo), a);
#pragma unroll
            for (int rr = 0; rr < 4; ++rr) a[rr] = (frv < 4 * fqv + rr) ? a[rr] : 0.f;
            float x[16];
            { LAS float* NS = (LAS float*)(SLOT(hnxt) + wv * 1024);
#pragma unroll
              for (int rr = 0; rr < 4; ++rr) NS[(4 * fqv + rr) * 16 + frv] = a[rr];
              asm volatile("s_waitcnt lgkmcnt(0)" ::: "memory");
#pragma unroll
              for (int rw = 0; rw < 16; ++rw) { float s = (rw == frv) ? 1.f : 0.f;
#pragma unroll
                  for (int sc = 0; sc < rw; ++sc) s += NS[rw * 16 + sc] * x[sc];
                  x[rw] = s; }
              asm volatile("s_waitcnt lgkmcnt(0)" ::: "memory"); }
            if (fqv == 0) { LAS unsigned char* dp = SLOT(S_D) + ((16 * wv + frv) * LP + 16 * wv) * 2;
                float lo8[8], hi8[8];
#pragma unroll
                for (int e = 0; e < 8; ++e) { lo8[e] = x[e]; hi8[e] = x[8 + e]; }
                *(LAS u32x4*)dp = pack8(lo8); *(LAS u32x4*)(dp + 16) = pack8(hi8); }
        }
#pragma unroll
        for (int it = 0; it < 6; ++it) { const int task = wv + 8 * it;
            if (task < 36) {
                int q, mn;
                if (task < 6) { q = 0; mn = (int)((0xEDC984ull >> (4 * task)) & 0xF); }
                else { q = 1 + (task - 6) / 10; mn = (int)((0xFEDCA98540ull >> (4 * ((task - 6) % 10))) & 0xF); }
                const int m0 = 16 * (mn >> 2), n0 = 16 * (mn & 3);
                const LAS unsigned char* XA = (q < 2) ? SLOT(S_A) : SLOT(S_R); const LAS unsigned char* XB = (q & 1) ? SLOT(S_K) : SLOT(S_B);
                f32x4 a = {0.f, 0.f, 0.f, 0.f};
#pragma unroll
                for (int kk = 0; kk < 2; ++kk) a = MFMA16(frag_n(XA, m0, kk, lo), frag_n(XB, n0, kk, lo), a);
                if (m0 == n0) {
#pragma unroll
                    for (int rr = 0; rr < 4; ++rr) { const bool keep = (q < 2) ? (frv < 4 * fqv + rr) : (frv <= 4 * fqv + rr); a[rr] = keep ? a[rr] : 0.f; } }
                st_tile_T(SLOT((q == 0) ? S_MOFF : (q == 1) ? S_MAK : (q == 2) ? S_MRB : S_MRK), m0, n0, lo, a);
            } else if (task < 48) {
                const int z = task - 36; const int mn = (int)((0xB76321ull >> (4 * (z % 6))) & 0xF);
                st_tile_T(SLOT((z < 6) ? S_MAK : S_MRK), 16 * (mn >> 2), 16 * (mn & 3), lo, (f32x4){0.f, 0.f, 0.f, 0.f});
            } }
#endif
        __syncthreads();
        relaunder(lo);
        f32x4 yacc[4];
#ifdef U_P5
        if (w < 4) {
            f32x4 xr[4];
#pragma unroll
            for (int i = 0; i < 4; ++i) { f32x4 a = {0.f, 0.f, 0.f, 0.f};
#pragma unroll
                for (int kk = 0; kk < 2; ++kk) { if (32 * kk < 16 * i + 16) a = MFMA16(frag_t(SLOT(S_MAK), kk, 16 * i, lo), frag_t(SLOT(S_V), kk, cw, lo), a);
                    a = MFMA16(frag_n(SLOT(S_A), 16 * i, kk, lo), frag_n(SLOT(hcur), cw, kk, lo), a); }
                xr[i] = a; }
#pragma unroll
            for (int i = 0; i < 4; ++i) { f32x4 a = xr[i];
#pragma unroll
                for (int kk = 0; kk < 2; ++kk) if (32 * kk < 16 * i) a = MFMA16(frag_t(SLOT(S_MOFF), kk, 16 * i, lo), frag_n(SLOT(S_ZT), cw, kk, lo), a);
                st_tile_T(SLOT(S_ACC), 16 * i, cw, lo, a);
                asm volatile("" ::: "memory");
                const f32x4 z = MFMA16(frag_t(SLOT(S_D), i >> 1, 16 * i, lo), frag_n(SLOT(S_ACC), cw, i >> 1, lo), (f32x4){0.f, 0.f, 0.f, 0.f});
                st_tile_T(SLOT(S_ZT), 16 * i, cw, lo, z);
                asm volatile("" ::: "memory"); }
#else
        if (w < 4) {
#pragma unroll
            for (int i = 0; i < 4; ++i) { f32x4 a = {0.f, 0.f, 0.f, 0.f};
#pragma unroll
                for (int kk = 0; kk < 2; ++kk) { if (32 * kk < 16 * i + 16) a = MFMA16(frag_t(SLOT(S_MAK), kk, 16 * i, lo), frag_t(SLOT(S_V), kk, cw, lo), a);
                    a = MFMA16(frag_n(SLOT(S_A), 16 * i, kk, lo), frag_n(SLOT(hcur), cw, kk, lo), a); }
#pragma unroll
                for (int kk = 0; kk < 2; ++kk) if (32 * kk < 16 * i) a = MFMA16(frag_t(SLOT(S_MOFF), kk, 16 * i, lo), frag_n(SLOT(S_ZT), cw, kk, lo), a);
                st_tile_T(SLOT(S_ACC), 16 * i, cw, lo, a);
                const f32x4 z = MFMA16(frag_t(SLOT(S_D), i >> 1, 16 * i, lo), frag_n(SLOT(S_ACC), cw, i >> 1, lo), (f32x4){0.f, 0.f, 0.f, 0.f});
                st_tile_T(SLOT(S_ZT), 16 * i, cw, lo, z); }
#endif
        } else {
#pragma unroll
            for (int i = 0; i < 4; ++i) { f32x4 a = {0.f, 0.f, 0.f, 0.f};
#pragma unroll
                for (int kk = 0; kk < 2; ++kk) { if (32 * kk < 16 * i + 16) a = MFMA16(frag_t(SLOT(S_MRK), kk, 16 * i, lo), frag_t(SLOT(S_V), kk, cw, lo), a);
                    a = MFMA16(frag_n(SLOT(S_R), 16 * i, kk, lo), frag_n(SLOT(hcur), cw, kk, lo), a);
                }
                yacc[i] = a; }
        }
        __syncthreads();
        relaunder(lo);
        if (c + 1 < SEQ / 64) RWKV_LOAD(c + 1, tv, c8v);
#ifdef U_P7
        if (w >= 4) {
#pragma unroll
            for (int i = 0; i < 4; ++i) {
#pragma unroll
                for (int rr = 0; rr < 4; ++rr) hacc[i][rr] = hacc[i][rr] * ex2(((const LAS float*)(L + O_CL))[16 * i + 4 * fqv + rr]);
#pragma unroll
                for (int kk = 0; kk < 2; ++kk) { hacc[i] = MFMA16(frag_t(SLOT(S_KT), kk, 16 * i, lo), frag_t(SLOT(S_V), kk, cw, lo), hacc[i]);
                    hacc[i] = MFMA16(frag_t(SLOT(S_BT), kk, 16 * i, lo), frag_n(SLOT(S_ZT), cw, kk, lo), hacc[i]); }
#pragma unroll
                for (int kk = 0; kk < 2; ++kk) if (32 * kk < 16 * i + 16) yacc[i] = MFMA16(frag_t(SLOT(S_MRB), kk, 16 * i, lo), frag_n(SLOT(S_ZT), cw, kk, lo), yacc[i]); }
#pragma unroll
            for (int i = 0; i < 4; ++i) { st_tile_T(SLOT(hnxt), 16 * i, cw, lo, hacc[i]);
#pragma unroll
                for (int rr = 0; rr < 4; ++rr) ((LAS float*)(L + O_YB))[(16 * i + 4 * fqv + rr) * FP + cw + frv] = yacc[i][rr]; }
        }
#else
        if (w >= 4) {
#pragma unroll
            for (int i = 0; i < 4; ++i) {
#pragma unroll
                for (int rr = 0; rr < 4; ++rr) hacc[i][rr] = hacc[i][rr] * ex2(((const LAS float*)(L + O_CL))[16 * i + 4 * fqv + rr]);
#pragma unroll
                for (int kk = 0; kk < 2; ++kk) { hacc[i] = MFMA16(frag_t(SLOT(S_KT), kk, 16 * i, lo), frag_t(SLOT(S_V), kk, cw, lo), hacc[i]);
                    hacc[i] = MFMA16(frag_t(SLOT(S_BT), kk, 16 * i, lo), frag_n(SLOT(S_ZT), cw, kk, lo), hacc[i]); }
                st_tile_T(SLOT(hnxt), 16 * i, cw, lo, hacc[i]);
#pragma unroll
                for (int kk = 0; kk < 2; ++kk) if (32 * kk < 16 * i + 16) yacc[i] = MFMA16(frag_t(SLOT(S_MRB), kk, 16 * i, lo), frag_n(SLOT(S_ZT), cw, kk, lo), yacc[i]);
#pragma unroll
                for (int rr = 0; rr < 4; ++rr) ((LAS float*)(L + O_YB))[(16 * i + 4 * fqv + rr) * FP + cw + frv] = yacc[i][rr]; }
        }
#endif
        __syncthreads();
        { float y[8], g0[8], g1[8]; ld8l((const LAS float*)(L + O_YB) + tv * FP + c8v, y); ld8l((const LAS float*)(L + O_CST) + 10 * 64 + c8v, g0); ld8l((const LAS float*)(L + O_CST) + 11 * 64 + c8v, g1);
          float s = 0.f;
#pragma unroll
          for (int e = 0; e < 8; ++e) s += y[e];
          const float mean = sum8(s) * (1.f / 64.f); float q = 0.f;
#pragma unroll
          for (int e = 0; e < 8; ++e) { y[e] -= mean; q += y[e] * y[e]; }
          const float rs = rsqrtf(sum8(q) * (1.f / 64.f) + RWKV_GN_EPS);
#pragma unroll
          for (int e = 0; e < 8; ++e) y[e] = y[e] * rs * g0[e] + g1[e] + cb * v[e];
          *(u32x4*)(Yout + ((size_t)b * SEQ + c * 64 + tv) * 512 + h * 64 + c8v) = pack8(y); }
        { const int tmp = hcur; hcur = hnxt; hnxt = tmp; }
    }
    __syncthreads();
#undef SLOT
#undef RWKV_LOAD
}
}

namespace gla {
using rwkv::vtr; using rwkv::unpack8; using rwkv::pack8; using rwkv::ld8l; using rwkv::ex2; using rwkv::LOG2E; using rwkv::LN2; using rwkv::MFMA16;
constexpr int LP = 72, VP = 136, TB = 64 * LP * 2;
constexpr int B_QH = 0, B_KH = TB, B_KT = 2 * TB, B_PT = 3 * TB, B_VV = 4 * TB, B_ST = B_VV + 64 * VP * 2, B_OB = B_ST + 128 * LP * 2, B_WT = B_OB + 64 * 132 * 4,
              B_CL = B_WT + 8 * 64 * 4, B_AUP = B_CL + 64 * 4, B_AB = B_AUP + 16 * 64 * 4, B_GN = B_AB + 64 * 4, B_END = B_GN + 128 * 4;
static_assert(B_END <= 131072, "gla lds");
struct LaneOff { int bn, bt, btv, bs; };
__device__ __forceinline__ LaneOff lane_off(int fr, int fq) { LaneOff o; o.bn = (fr * LP + 8 * fq) * 2; o.bt = ((8 * fq + (fr >> 2)) * LP + 4 * (fr & 3)) * 2; o.btv = ((8 * fq + (fr >> 2)) * VP + 4 * (fr & 3)) * 2; o.bs = (fr * LP + 4 * fq) * 2; return o; }
__device__ __forceinline__ void relaunder(LaneOff& o) { asm volatile("" : "+v"(o.bn), "+v"(o.bt), "+v"(o.btv), "+v"(o.bs)); }
__device__ __forceinline__ bf16x8 frag_t(const LAS unsigned char* tile, int kk, int c0, const LaneOff& o) {
    const LAS unsigned char* q = tile + o.bt + (32 * kk * LP + c0) * 2; const s16x4 lo = vtr(q), hi = vtr(q + 4 * LP * 2); return (bf16x8){lo[0], lo[1], lo[2], lo[3], hi[0], hi[1], hi[2], hi[3]}; }
__device__ __forceinline__ bf16x8 frag_tv(const LAS unsigned char* tile, int kk, int c0, const LaneOff& o) {
    const LAS unsigned char* q = tile + o.btv + (32 * kk * VP + c0) * 2; const s16x4 lo = vtr(q), hi = vtr(q + 4 * VP * 2); return (bf16x8){lo[0], lo[1], lo[2], lo[3], hi[0], hi[1], hi[2], hi[3]}; }
__device__ __forceinline__ bf16x8 frag_n(const LAS unsigned char* tile, int r0, int kk, const LaneOff& o) { return *(const LAS bf16x8*)(tile + o.bn + (r0 * LP + 32 * kk) * 2); }
__device__ __forceinline__ void st_tile_T(LAS unsigned char* tile, int m0, int n0, const LaneOff& o, const f32x4 c) { u32x2 w; w.x = pk2(c[0], c[1]); w.y = pk2(c[2], c[3]); *(LAS u32x2*)(tile + o.bs + (n0 * LP + m0) * 2) = w; }

__device__ __forceinline__ void gla_unit(int l, int b, int h, LAS unsigned char* L, unsigned* done_ctr) {
    const Params p = load_params();
    const bf16_t* PA = (const bf16_t*)(p.ws + WS_PA); bf16_t* Yout = (bf16_t*)(p.ws + WS_YS) + (size_t)2 * T * 512;
    const int tid = opaque_tid(), lane = tid & 63, fr = lane & 15, fq = lane >> 4; const int w = __builtin_amdgcn_readfirstlane(tid >> 6);
    const int t = tid >> 3, c8 = (tid & 7) * 8;
    LaneOff lo = lane_off(fr, fq);
    for (int e = tid; e < 16 * 64; e += 512) ((LAS float*)(L + B_AUP))[e] = p.gla_a_up[(size_t)l * 16 * 256 + (e >> 6) * 256 + h * 64 + (e & 63)];
    if (tid < 64) ((LAS float*)(L + B_AB))[tid] = p.gla_a_b[l * 256 + h * 64 + tid];
    if (tid < 128) ((LAS float*)(L + B_GN))[tid] = p.gla_norm[l * 512 + h * 128 + tid];
    for (int e = tid; e < 128 * LP / 2; e += 512) ((LAS unsigned*)(L + B_ST))[e] = 0u;
    for (int e = tid; e < TB / 4; e += 512) ((LAS unsigned*)(L + B_PT))[e] = 0u;
    f32x4 sacc[4];
#pragma unroll
    for (int m = 0; m < 4; ++m) sacc[m] = (f32x4){0.f, 0.f, 0.f, 0.f};
    u32x4 rq, rk, rv0, rv1, rl0, rl1;
#define GLA_LOAD(c) do { const bf16_t* s_ = PA + ((size_t)b * SEQ + (c) * 64 + t) * NA; rq = *(const u32x4*)(s_ + GQ + h * 64 + c8); rk = *(const u32x4*)(s_ + GK + h * 64 + c8); \
        rv0 = *(const u32x4*)(s_ + GV + h * 128 + 2 * c8); rv1 = *(const u32x4*)(s_ + GV + h * 128 + 2 * c8 + 8); rl0 = *(const u32x4*)(s_ + GLAT); rl1 = *(const u32x4*)(s_ + GLAT + 8); } while (0)
    GLA_LOAD(0);
    __syncthreads();
    for (int c = 0; c < SEQ / 64; ++c) {
        int c8v = c8, tv = t, frv = fr, fqv = fq; asm volatile("" : "+v"(c8v), "+v"(tv), "+v"(frv), "+v"(fqv));
        const int twv = tv & 7;
        float cs[8];
        { float lat[16]; { float a8[8]; unpack8(rl0, a8);
#pragma unroll
              for (int j = 0; j < 8; ++j) lat[j] = a8[j];
              unpack8(rl1, a8);
#pragma unroll
              for (int j = 0; j < 8; ++j) lat[8 + j] = a8[j]; }
          float z[8]; ld8l((const LAS float*)(L + B_AB) + c8v, z);
#pragma unroll
          for (int j = 0; j < 16; ++j) { float a8[8]; ld8l((const LAS float*)(L + B_AUP) + j * 64 + c8v, a8);
#pragma unroll
              for (int e = 0; e < 8; ++e) z[e] += lat[j] * a8[e]; }
#pragma unroll
          for (int e = 0; e < 8; ++e) { const float x = -z[e]; const float sp = fmaxf(x, 0.f) + LN2 * __builtin_amdgcn_logf(1.0f + ex2(-fabsf(x) * LOG2E));
              float v_ = -sp * (LOG2E / 16.0f);
              float y = __shfl_up(v_, 8); if (twv >= 1) v_ += y;
              y = __shfl_up(v_, 16); if (twv >= 2) v_ += y;
              y = __shfl_up(v_, 32); if (twv >= 4) v_ += y;
              cs[e] = v_; }
          if (twv == 7) { LAS float* WT = (LAS float*)(L + B_WT) + w * 64 + c8v;
#pragma unroll
              for (int e = 0; e < 8; ++e) WT[e] = cs[e]; } }
        __syncthreads();
        { float off[8], tot[8];
#pragma unroll
          for (int e = 0; e < 8; ++e) { off[e] = 0.f; tot[e] = 0.f; }
#pragma unroll
          for (int g = 0; g < 8; ++g) { float x[8]; ld8l((const LAS float*)(L + B_WT) + g * 64 + c8v, x);
#pragma unroll
              for (int e = 0; e < 8; ++e) { if (g < w) off[e] += x[e]; tot[e] += x[e]; } }
          if (tv == 0) { LAS float* CL = (LAS float*)(L + B_CL) + c8v;
#pragma unroll
              for (int e = 0; e < 8; ++e) CL[e] = tot[e]; }
          float q8[8], k8[8], o[8], en[8]; unpack8(rq, q8); unpack8(rk, k8); const int toff = (tv * LP + c8v) * 2;
#pragma unroll
          for (int e = 0; e < 8; ++e) { cs[e] += off[e]; en[e] = ex2(-cs[e]); o[e] = q8[e] * 0.125f * __builtin_amdgcn_rcpf(en[e]); }
          *(LAS u32x4*)(L + B_QH + toff) = pack8(o);
#pragma unroll
          for (int e = 0; e < 8; ++e) o[e] = k8[e] * en[e];
          *(LAS u32x4*)(L + B_KH + toff) = pack8(o);
#pragma unroll
          for (int e = 0; e < 8; ++e) o[e] = k8[e] * ex2(tot[e] - cs[e]);
          *(LAS u32x4*)(L + B_KT + toff) = pack8(o);
          *(LAS u32x4*)(L + B_VV + (tv * VP + 2 * c8v) * 2) = rv0; *(LAS u32x4*)(L + B_VV + (tv * VP + 2 * c8v + 8) * 2) = rv1; }
        if (c + 1 < SEQ / 64) GLA_LOAD(c + 1);
        __syncthreads();
        relaunder(lo);
        { const int m0 = 16 * (w >> 1);
#pragma unroll
          for (int nn = 0; nn < 2; ++nn) { const int n0 = 32 * (w & 1) + 16 * nn;
              if (n0 <= m0) { f32x4 a = {0.f, 0.f, 0.f, 0.f};
#pragma unroll
                  for (int kk = 0; kk < 2; ++kk) a = MFMA16(frag_n(L + B_QH, m0, kk, lo), frag_n(L + B_KH, n0, kk, lo), a);
                  if (n0 == m0) {
#pragma unroll
                      for (int rr = 0; rr < 4; ++rr) a[rr] = (frv <= 4 * fqv + rr) ? a[rr] : 0.f; }
                  st_tile_T(L + B_PT, m0, n0, lo, a); } } }
        __syncthreads();
        relaunder(lo);
        { const int n0 = 16 * w;
#pragma unroll
          for (int m = 0; m < 4; ++m) { f32x4 a = {0.f, 0.f, 0.f, 0.f};
#pragma unroll
              for (int kk = 0; kk < 2; ++kk) { if (32 * kk < 16 * m + 16) a = MFMA16(frag_t(L + B_PT, kk, 16 * m, lo), frag_tv(L + B_VV, kk, n0, lo), a);
                  a = MFMA16(frag_n(L + B_QH, 16 * m, kk, lo), frag_n(L + B_ST, n0, kk, lo), a); }
#pragma unroll
              for (int rr = 0; rr < 4; ++rr) ((LAS float*)(L + B_OB))[(16 * m + 4 * fqv + rr) * 132 + n0 + frv] = a[rr]; }
          asm volatile("" ::: "memory");
#pragma unroll
          for (int m = 0; m < 4; ++m) { f32x4 a = sacc[m];
#pragma unroll
              for (int rr = 0; rr < 4; ++rr) a[rr] *= ex2(((const LAS float*)(L + B_CL))[16 * m + 4 * fqv + rr]);
#pragma unroll
              for (int kk = 0; kk < 2; ++kk) a = MFMA16(frag_t(L + B_KT, kk, 16 * m, lo), frag_tv(L + B_VV, kk, n0, lo), a);
              sacc[m] = a; st_tile_T(L + B_ST, 16 * m, n0, lo, a); } }
        __syncthreads();
        { float v0[8], v1[8], g0[8], g1[8]; float ss = 0.f; const LAS float* ob = (const LAS float*)(L + B_OB) + tv * 132 + 2 * c8v;
          ld8l(ob, v0); ld8l(ob + 8, v1);
#pragma unroll
          for (int e = 0; e < 8; ++e) ss += v0[e] * v0[e] + v1[e] * v1[e];
          ss = sum8(ss);
          const float rstd = rsqrtf(ss * (1.f / 128.f) + NORM_EPS);
          ld8l((const LAS float*)(L + B_GN) + 2 * c8v, g0); ld8l((const LAS float*)(L + B_GN) + 2 * c8v + 8, g1);
          float o0[8], o1[8];
#pragma unroll
          for (int e = 0; e < 8; ++e) { o0[e] = v0[e] * rstd * g0[e]; o1[e] = v1[e] * rstd * g1[e]; }
          bf16_t* dst = Yout + ((size_t)b * SEQ + c * 64 + tv) * 512 + h * 128 + 2 * c8v;
          *(u32x4*)dst = pack8(o0); *(u32x4*)(dst + 8) = pack8(o1); }
    }
    asm volatile("s_waitcnt vmcnt(0)" ::: "memory");
    __syncthreads();
    if (tid == 0) __hip_atomic_fetch_add(done_ctr, 1u, __ATOMIC_RELEASE, __HIP_MEMORY_SCOPE_AGENT);
#undef GLA_LOAD
}
}

#define XB_TMO      128
#define XB_XCNT(j)  (256  + 64 * (j))
#define XB_XSUB(j)  (1280 + 64 * (j))
#define XB_XGEN(j)  (2304 + 64 * (j))
#define XB_TOP      3328
#define XB_TOPGEN   3392
#define XCD_BAR_WORDS 3456
#define XB_SPIN_CAP (1u << 18)

__device__ __forceinline__ unsigned xb_ld(unsigned* p)              { return __hip_atomic_load(p, __ATOMIC_RELAXED, __HIP_MEMORY_SCOPE_AGENT); }
__device__ __forceinline__ unsigned xb_add(unsigned* p, unsigned v) { return __hip_atomic_fetch_add(p, v, __ATOMIC_RELAXED, __HIP_MEMORY_SCOPE_AGENT); }
__device__ __forceinline__ unsigned xb_xcc_id() { return (unsigned)__builtin_amdgcn_s_getreg((3 << 11) | 20) & 0xFu; }
#define XB_SPIN(cond, bar) do { unsigned _sp = 0; while (cond) { __builtin_amdgcn_s_sleep(1); \
    if ((++_sp & 255u) == 0u) { if (xb_ld(&(bar)[XB_TMO])) break; if (_sp > XB_SPIN_CAP) { atomicAdd(&(bar)[XB_TMO], 1u); break; } } } } while (0)

struct XcdBarrier {
    unsigned* bar; unsigned x;
    volatile LAS unsigned* st;
};

__device__ __forceinline__ XcdBarrier xcd_barrier_post(unsigned* bar, volatile LAS unsigned* st) {
    XcdBarrier b; b.bar = bar; b.x = xb_xcc_id(); b.st = st;
    if (threadIdx.x == 0) (void)xb_add(&bar[XB_XCNT(b.x)], 1u);
    return b;
}
__device__ __forceinline__ void xcd_barrier_complete(unsigned* bar, unsigned x, unsigned& nloc, unsigned& nx) {
    const unsigned G = gridDim.x * gridDim.y * gridDim.z;
    unsigned sum, cnt, mine, sp = 0u;
    for (;;) {
        sum = 0u; cnt = 0u; mine = 0u;
#pragma unroll
        for (unsigned j = 0; j < 16; ++j) { const unsigned c = xb_ld(&bar[XB_XCNT(j)]); sum += c; cnt += (c > 0u) ? 1u : 0u; mine = (j == x) ? c : mine; }
        if (sum == G) break;
        __builtin_amdgcn_s_sleep(1);
        if ((++sp & 255u) == 0u) { if (xb_ld(&bar[XB_TMO])) break; if (sp > XB_SPIN_CAP) { atomicAdd(&bar[XB_TMO], 1u); break; } }
    }
    nloc = mine > 0u ? mine : 1u; nx = cnt > 0u ? cnt : 1u;
}

__device__ __forceinline__ void xcd_barrier(const XcdBarrier& b) {
    asm volatile("s_waitcnt vmcnt(0)" ::: "memory");
    __syncthreads();
    if (threadIdx.x == 0) {
        unsigned* bar = b.bar;
        __builtin_amdgcn_s_waitcnt(0);
        unsigned nloc = b.st[0], nx = b.st[1];
        if (nloc == 0u) { xcd_barrier_complete(bar, b.x, nloc, nx); b.st[0] = nloc; b.st[1] = nx; }
        const unsigned old = xb_add(&bar[XB_XSUB(b.x)], 1u);
        const unsigned gen = old / nloc;
        if (old + 1u == (gen + 1u) * nloc) {
            __builtin_amdgcn_fence(__ATOMIC_RELEASE, "agent");
            asm volatile("s_waitcnt vmcnt(0)" ::: "memory");
            const unsigned og = xb_add(&bar[XB_TOP], 1u);
            const unsigned tg = og / nx;
            if (og + 1u == (tg + 1u) * nx) xb_add(&bar[XB_TOPGEN], 1u);
            else XB_SPIN(xb_ld(&bar[XB_TOPGEN]) == tg, bar);
            __builtin_amdgcn_fence(__ATOMIC_ACQUIRE, "agent");
            xb_add(&bar[XB_XGEN(b.x)], 1u);
            asm volatile("s_waitcnt vmcnt(0)" ::: "memory");
        } else {
            XB_SPIN(xb_ld(&bar[XB_XGEN(b.x)]) == gen, bar);
            __builtin_amdgcn_fence(__ATOMIC_ACQUIRE, "agent");
            asm volatile("s_waitcnt vmcnt(0)" ::: "memory");
        }
    }
    __syncthreads();
}

constexpr int NWAVES = 8, NTHREADS = 512;
constexpr int LDS_MISC = 155648, LDS_BYTES = 159744;
constexpr int PH_PER_LAYER = 8, N_PHASES = 1 + DEPTH * PH_PER_LAYER;
constexpr int CW_BAR = 4096;
constexpr int MG_BLOCKS = 192;
constexpr int RWKV_BLOCKS = 64, SUB_BLOCKS = 256 - RWKV_BLOCKS;
constexpr int N_ATT_UNITS = 64 * (SEQ / 512), N_MIX_ITEMS = 32 + N_ATT_UNITS;
#ifndef MK_MULTI_LAUNCH
#define MK_MULTI_LAUNCH 0
#endif

__device__ __forceinline__ void sub_barrier(unsigned* cnt, unsigned target) {
    asm volatile("s_waitcnt vmcnt(0)" ::: "memory");
    __syncthreads();
    if (threadIdx.x == 0) {
        __builtin_amdgcn_fence(__ATOMIC_RELEASE, "agent"); asm volatile("s_waitcnt vmcnt(0)" ::: "memory");
        __hip_atomic_fetch_add(cnt, 1u, __ATOMIC_RELAXED, __HIP_MEMORY_SCOPE_AGENT);
        unsigned sp = 0; while (__hip_atomic_load(cnt, __ATOMIC_RELAXED, __HIP_MEMORY_SCOPE_AGENT) < target && ++sp < (1u << 24)) __builtin_amdgcn_s_sleep(2);
        __builtin_amdgcn_fence(__ATOMIC_ACQUIRE, "agent"); asm volatile("s_waitcnt vmcnt(0)" ::: "memory");
    }
    __syncthreads();
}
__global__ void __launch_bounds__(NTHREADS, 2) hybrid_fwd(Params p_unused) {
    extern __shared__ __attribute__((aligned(16))) unsigned char lds[];
    cg::grid_group grid = cg::this_grid();
#define G ((int)gridDim.x)
#define bx ((int)blockIdx.x)
#define NGW (G * NWAVES)
#define PHASE_VARS const int tid = opaque_tid(), lane = tid & 63, wave = __builtin_amdgcn_readfirstlane(tid >> 6), gw = bx * NWAVES + wave; (void)lane; (void)gw
    LAS unsigned char* ldsl = (LAS unsigned char*)lds;
    { volatile LAS unsigned* misc = (volatile LAS unsigned*)(ldsl + LDS_MISC); if (threadIdx.x < 64) misc[threadIdx.x] = 0u; __syncthreads(); }
    (void)xcd_barrier_post((unsigned*)(kargs()->ws + WS_CTL) + CW_BAR, (volatile LAS unsigned*)(ldsl + LDS_MISC) + 8);
#define GRID_BAR() do { XcdBarrier xb_; xb_.bar = (unsigned*)(kargs()->ws + WS_CTL) + CW_BAR; xb_.x = xb_xcc_id(); xb_.st = (volatile LAS unsigned*)(ldsl + LDS_MISC) + 8; xcd_barrier(xb_); } while (0)
#ifndef EPI_ALIGN_PD1
#define EPI_ALIGN_PD1 true
#endif
#ifndef EPI_ALIGN_PA2
#define EPI_ALIGN_PA2 true
#endif
#ifndef REPEAT_PH
#define REPEAT_PH 0
#endif
#ifndef PH_MASK
#define PH_MASK 0xFFFF
#endif
#ifndef MIX_MASK
#define MIX_MASK 7
#endif
#define IN(k) true
#define EN(b) ((PH_MASK >> (b)) & 1)
#define SEAM(k) do { if (IN(k) && IN((k) + 1)) { if ((k) == 0) grid.sync(); else GRID_BAR(); } } while (0)
#define WSP(type, off) ((type*)(ws + (off)))

    if (EN(0) && IN(0)) { PHASE_VARS;
        convert_weights(0, lds, gw, NGW, wave, lane);
        KArgs kp = kargs(); unsigned char* ws = kp->ws; const int* positions = kp->positions; const float* x = kp->x; const float* g = kp->norm_pre;
        f32x2* ROPE = WSP(f32x2, WS_ROPE); bf16_t* HB = WSP(bf16_t, WS_HB);
        for (int i = bx * NTHREADS + tid; i < T * 16; i += G * NTHREADS) {
            const int t = i >> 4, j = i & 15; const float inv = exp2f(-(float)j * (13.287712379549449f / 16.0f));
            const float ang = (float)positions[t] * inv; const float k = rintf(ang * 0.15915494309189535f);
            float r = fmaf(-k, 6.2831854820251465f, ang); r = fmaf(-k, -1.7484555314695172e-7f, r);
            ROPE[i] = (f32x2){__cosf(r), __sinf(r)};
        }
        for (int m = gw; m < T; m += NGW) hb_row(x + (size_t)m * DM, g, HB + (size_t)m * DM, lane);
    }
    SEAM(0);
#ifdef EXTRA_SYNCS
    for (int i = 0; i < EXTRA_SYNCS; ++i) GRID_BAR();
#endif

    for (int l = 0; l < DEPTH; ++l) {
        const int P0 = 1 + l * PH_PER_LAYER;
        for (int rp = 0; rp < ((REPEAT_PH == 1 && l == 0) ? 2 : 1); ++rp) { if (rp) GRID_BAR();
        if (EN(1) && IN(P0 + 0)) {
            unsigned char* ws = kargs()->ws;
            pg8::PlainOrder S{(const char*)WSP(bf16_t, WS_HB), (const char*)WSP(bf16_t, WS_WIN), 1024, 1024, T / 256, NA / 256, G, bx, 0};
            EpiStore E{WSP(bf16_t, WS_PA), NA};
            pg8::gemm_phase<EpiStore, pg8::PlainOrder, true>(ldsl, pg8::Gemm{1024, 1024, 1024}, S, E);
        }
        }
        SEAM(P0 + 0);
        if (EN(2) && IN(P0 + 1)) { PHASE_VARS;
            if (bx >= RWKV_BLOCKS) {
                unsigned char* ws = kargs()->ws; const int c2 = bx - RWKV_BLOCKS;
                { const bf16_t* PA = WSP(bf16_t, WS_PA); const f32x2* ROPE = WSP(f32x2, WS_ROPE); float* RSTDQ = WSP(float, WS_RSTD); float* RSTDKV = RSTDQ + T; bf16_t* Kb = WSP(bf16_t, WS_K);
                  for (int m = c2 * NWAVES + wave; m < T; m += SUB_BLOCKS * NWAVES) mla_prep_row(PA + (size_t)m * NA, ROPE + (size_t)m * 16, RSTDQ + m, RSTDKV + m, Kb + (size_t)m * KP, lane); }
                sub_barrier((unsigned*)(ws + WS_CTL) + 64 * 40, (unsigned)SUB_BLOCKS * (unsigned)(2 * l + 1));
                { pg8::PlainOrder S{(const char*)(WSP(bf16_t, WS_PA) + CQ), (const char*)WSP(bf16_t, WS_WUQ), NA, 256, T / 256, 3, SUB_BLOCKS, c2, 0};
                  EpiQ E{WSP(bf16_t, WS_Q), WSP(float, WS_RSTD)};
                  pg8::gemm_phase<EpiQ, pg8::PlainOrder, true>(ldsl, pg8::Gemm{NA, 256, 256}, S, E); }
                { pg8::PlainOrder S{(const char*)(WSP(bf16_t, WS_PA) + CKV), (const char*)WSP(bf16_t, WS_WUKV), NA, 256, T / 256, 4, SUB_BLOCKS, c2, 0};
                  EpiKV E{WSP(bf16_t, WS_K), WSP(bf16_t, WS_V), WSP(float, WS_RSTD) + T};
                  pg8::gemm_phase<EpiKV, pg8::PlainOrder, true>(ldsl, pg8::Gemm{NA, 256, 256}, S, E); }
                sub_barrier((unsigned*)(kargs()->ws + WS_CTL) + 64 * 40, (unsigned)SUB_BLOCKS * (unsigned)(2 * l + 2));
            } else {
                rwkv::rwkv_unit(l, bx >> 3, bx & 7, ldsl);
            }
        }
        if (EN(4) && IN(P0 + 3)) { PHASE_VARS;
            volatile LAS unsigned* qw = (volatile LAS unsigned*)(ldsl + LDS_MISC);
            for (;;) {
                __syncthreads();
                if (tid == 0) { unsigned* CTL = (unsigned*)(kargs()->ws + WS_CTL); qw[0] = atomicAdd(CTL + 64 * (1 + l), 1u); }
                __syncthreads();
                const int it = __builtin_amdgcn_readfirstlane((int)qw[0]);
                if (it >= N_MIX_ITEMS) break;
                if (it < 32) gla::gla_unit(l, it >> 2, it & 3, ldsl, (unsigned*)(kargs()->ws + WS_CTL) + 64 * (24 + l));
                else { const int a = it - 32; att::attn_unit((a & 63) >> 3, a & 7, (SEQ / 512 - 1) - (a >> 6), ldsl, (unsigned*)(kargs()->ws + WS_CTL) + 64 * (16 + l)); }
            }
            { unsigned* ctl = (unsigned*)(kargs()->ws + WS_CTL);
              __syncthreads();
              if (tid == 0) { const unsigned tk = __hip_atomic_fetch_add(ctl + 64 * (20 + l), 1u, __ATOMIC_RELAXED, __HIP_MEMORY_SCOPE_AGENT); qw[0] = tk;
                  if (tk < (unsigned)MG_BLOCKS) { unsigned sp = 0; while (__hip_atomic_load(ctl + 64 * (16 + l), __ATOMIC_RELAXED, __HIP_MEMORY_SCOPE_AGENT) < (unsigned)N_ATT_UNITS && ++sp < (1u << 22)) __builtin_amdgcn_s_sleep(8); }
                  __builtin_amdgcn_fence(__ATOMIC_ACQUIRE, "agent"); asm volatile("s_waitcnt vmcnt(0)" ::: "memory"); }
              __syncthreads();
              const int tk = __builtin_amdgcn_readfirstlane((int)qw[0]);
              if (tk < MG_BLOCKS) {
                  unsigned char* ws = kargs()->ws;
                  pg8::PlainOrder S{(const char*)WSP(bf16_t, WS_HB), (const char*)(WSP(bf16_t, WS_WIN) + (size_t)(NA + 1536) * 1024), 1024, 1024, T / 256, 12, MG_BLOCKS, tk, 0};
                  EpiGateMG8 E{WSP(unsigned char, WS_SMG8)};
                  pg8::gemm_phase<EpiGateMG8, pg8::PlainOrder, true>(ldsl, pg8::Gemm{1024, 1024, 1024}, S, E);
                  __syncthreads();
                  if (tid == 0) { unsigned sp = 0; while (__hip_atomic_load(ctl + 64 * (24 + l), __ATOMIC_RELAXED, __HIP_MEMORY_SCOPE_AGENT) < 32u && ++sp < (1u << 22)) __builtin_amdgcn_s_sleep(8);
                      __builtin_amdgcn_fence(__ATOMIC_ACQUIRE, "agent"); asm volatile("s_waitcnt vmcnt(0)" ::: "memory"); }
                  __syncthreads();
                  pg8::PlainOrder S2{(const char*)WSP(bf16_t, WS_HB), (const char*)(WSP(bf16_t, WS_WIN) + (size_t)NA * 1024), 1024, 1024, T / 256, 4, MG_BLOCKS, tk, 2};
                  EpiGateBG E2{WSP(bf16_t, WS_YS), 0, 2};
                  pg8::gemm_phase<EpiGateBG, pg8::PlainOrder, true>(ldsl, pg8::Gemm{1024, 1024, 1024}, S2, E2);
              } }
        }
        SEAM(P0 + 3);
        if (EN(5) && IN(P0 + 4)) {
            unsigned char* ws = kargs()->ws;
            pg8::PlainOrder S{(const char*)WSP(bf16_t, WS_HB), (const char*)(WSP(bf16_t, WS_WIN) + (size_t)(NA + 512) * 1024), 1024, 1024, T / 256, 2, G, bx, 0};
            EpiGateBG E{WSP(bf16_t, WS_YS), 2, 0};
            pg8::gemm_phase<EpiGateBG, pg8::PlainOrder, true>(ldsl, pg8::Gemm{1024, 1024, 1024}, S, E);
        }
        SEAM(P0 + 4);
        for (int rp = 0; rp < ((REPEAT_PH == 6 && l == 0) ? 2 : 1); ++rp) { if (rp) GRID_BAR();
        if (EN(6) && IN(P0 + 5)) {
            unsigned char* ws = kargs()->ws;
            pg8::GroupOrder3 S{(const char*)WSP(bf16_t, WS_YS), (const char*)WSP(bf16_t, WS_WBO), 512, 512, T / 256, 4, G, bx, (size_t)T * 512 * 2, (size_t)1024 * 512 * 2};
            EpiMerge E{WSP(bf16_t, WS_MG), WSP(unsigned char, WS_SMG8)};
            pg8::gemm_phase<EpiMerge, pg8::GroupOrder3, EPI_ALIGN_PD1>(ldsl, pg8::Gemm{512, 512, 512}, S, E);
        }
        }
        SEAM(P0 + 5);
        for (int rp = 0; rp < ((REPEAT_PH == 7 && l == 0) ? 2 : 1); ++rp) { if (rp) GRID_BAR();
        if (EN(7) && IN(P0 + 6)) {
            unsigned char* ws = kargs()->ws;
            pg8::PlainOrder S{(const char*)WSP(bf16_t, WS_MG), (const char*)WSP(bf16_t, WS_WOUT), 1024, 1024, T / 256, 4, G, bx, 0};
            EpiStore E{WSP(bf16_t, WS_OF), 1024};
            pg8::gemm_phase<EpiStore, pg8::PlainOrder, true>(ldsl, pg8::Gemm{1024, 1024, 1024}, S, E);
        }
        }
        SEAM(P0 + 6);
        if (EN(8) && IN(P0 + 7)) { PHASE_VARS;
            const bool more = (l + 1 < DEPTH);
            if (more) convert_weights(l + 1, lds, gw, NGW, wave, lane);
            KArgs kp = kargs(); unsigned char* ws = kp->ws; float* out = kp->out; const float* xold = (l == 0) ? kp->x : out; const float* gpost = kp->norm_post + l * DM; const float* gnext = more ? kp->norm_pre + (l + 1) * DM : nullptr;
            const bf16_t* OF = WSP(bf16_t, WS_OF); bf16_t* HB = WSP(bf16_t, WS_HB);
            for (int m = gw; m < T; m += NGW)
                final_row(OF + (size_t)m * DM, xold + (size_t)m * DM, gpost, out + (size_t)m * DM, gnext, HB + (size_t)m * DM, lane);
        }
        if (l + 1 < DEPTH) SEAM(P0 + 7);
    }
#undef IN
#undef EN
#undef SEAM
#undef WSP
#undef PHASE_VARS
#undef G
#undef bx
#undef NGW
}

extern "C" void kernel_launch(void* const* d_in, const int* in_sizes, int n_in, void* d_out, int out_size, void* d_ws, size_t ws_size, hipStream_t stream) {
    static int grid = 0;
    if (grid == 0) {
        if (n_in != 24 || in_sizes[0] != T * DM || out_size != T * DM || ws_size < WS_END) {
            fprintf(stderr, "kernel_launch: unexpected shapes (n_in %d, in0 %d, out %d, ws %zu; need ws >= %zu); nothing launched\n", n_in, n_in > 0 ? in_sizes[0] : -1, out_size, ws_size, (size_t)WS_END);
            grid = -1; return; }
        int dev = 0, cus = 0, per_cu = 0;
        (void)hipGetDevice(&dev); (void)hipDeviceGetAttribute(&cus, hipDeviceAttributeMultiprocessorCount, dev);
        if (hipFuncSetAttribute((const void*)hybrid_fwd, hipFuncAttributeMaxDynamicSharedMemorySize, LDS_BYTES) != hipSuccess) { fprintf(stderr, "kernel_launch: hipFuncSetAttribute failed\n"); grid = -1; return; }
        if (hipOccupancyMaxActiveBlocksPerMultiprocessor(&per_cu, (const void*)hybrid_fwd, NTHREADS, LDS_BYTES) != hipSuccess || per_cu < 1) {
            fprintf(stderr, "kernel_launch: occupancy query reports %d blocks per CU\n", per_cu); per_cu = 1; }
        (void)hipGetLastError();
        grid = cus * (per_cu < 1 ? 1 : 1);
        fprintf(stderr, "kernel_launch: grid %d (cus %d, occupancy %d), ws %zu\n", grid, cus, per_cu, ws_size);
    }
    if (grid < 0) return;
    (void)hipMemsetAsync((char*)d_ws + WS_CTL, 0, 65536, stream);
    Params p{};
    p.x = (const float*)d_in[0]; p.positions = (const int*)d_in[1]; p.norm_pre = (const float*)d_in[2]; p.w_in = (const float*)d_in[3]; p.mla_q_norm = (const float*)d_in[4]; p.mla_kv_norm = (const float*)d_in[5];
    p.mla_w_uq = (const float*)d_in[6]; p.mla_w_ukv = (const float*)d_in[7]; p.rwkv_mu = (const float*)d_in[8]; p.rwkv_w0 = (const float*)d_in[9]; p.rwkv_w_up = (const float*)d_in[10]; p.rwkv_a0 = (const float*)d_in[11];
    p.rwkv_a_up = (const float*)d_in[12]; p.rwkv_k_k = (const float*)d_in[13]; p.rwkv_k_a = (const float*)d_in[14]; p.rwkv_r_k = (const float*)d_in[15]; p.rwkv_ln_w = (const float*)d_in[16]; p.rwkv_ln_b = (const float*)d_in[17];
    p.gla_a_up = (const float*)d_in[18]; p.gla_a_b = (const float*)d_in[19]; p.gla_norm = (const float*)d_in[20]; p.w_branch_out = (const float*)d_in[21]; p.w_out = (const float*)d_in[22]; p.norm_post = (const float*)d_in[23];
    p.out = (float*)d_out; p.ws = (unsigned char*)d_ws;
#if MK_MULTI_LAUNCH
    for (int ph = 0; ph < N_PHASES; ++ph) { p.ph_lo = ph; p.ph_hi = ph + 1; void* args[] = {&p};
        hipError_t e = hipLaunchCooperativeKernel((const void*)hybrid_fwd, dim3(grid), dim3(NTHREADS), args, LDS_BYTES, stream);
        if (e != hipSuccess) { fprintf(stderr, "kernel_launch: launch of phase %d failed: %s\n", ph, hipGetErrorString(e)); break; } }
#else
    p.ph_lo = 0; p.ph_hi = N_PHASES; void* args[] = {&p};
    hipError_t e = hipLaunchCooperativeKernel((const void*)hybrid_fwd, dim3(grid), dim3(NTHREADS), args, LDS_BYTES, stream);
    if (e != hipSuccess) fprintf(stderr, "kernel_launch: cooperative launch failed: %s (grid %d)\n", hipGetErrorString(e), grid);
#endif
}
```

```cpp
#include <hip/hip_runtime.h>
#include <hip/hip_cooperative_groups.h>
#include <cstdio>
#include <cstdint>
#include <cmath>
namespace cg = cooperative_groups;
#define U_P2 1
#define U_P5 1
#define U_P7 1
namespace pg8 {
#define PG8_LAS __attribute__((address_space(3)))
typedef unsigned short bf16_t;
typedef short bf16x8 __attribute__((ext_vector_type(8)));
typedef float f32x4 __attribute__((ext_vector_type(4)));
typedef unsigned u32x4 __attribute__((ext_vector_type(4)));
typedef unsigned u32x2 __attribute__((ext_vector_type(2)));
constexpr int BM = 256, BK = 64, HALF = 128, HTB = HALF * BK * 2  , STAGE_BYTES = 8 * HTB, NXCD = 8, WGM = 8;

__host__ __device__ __forceinline__ int lds_byte(int r, int c) { const int st = (r >> 4) * 2 + (c >> 5), rr = r & 15, cc = c & 31, ob = rr * 64 + cc * 2; return st * 1024 + (ob ^ (((ob >> 9) & 1) << 5)); }
__host__ __device__ __forceinline__ void stage_rc(int b, int& R, int& C) { const int st = b / 1024, sb = b % 1024, swz = sb ^ (((sb >> 9) & 1) << 5); R = (st >> 1) * 16 + swz / 64; C = (st & 1) * 32 + (swz % 64) / 2; }
__host__ __device__ __forceinline__ int perm32(int rho) { const int n = rho >> 4, i = rho & 15; return 8 * (i >> 2) + 4 * n + (i & 3); }

struct Unit { int pm, pn, aux; const char* A; const char* B; };
struct Gemm { int lda, ldb, K; };

__device__ __forceinline__ void tile_of(int L, int nM, int nN, int& pm, int& pn) {
    const int nwg = nM * nN; int wgid = L;
    { const int q = nwg / NXCD, r = nwg % NXCD, xcd = wgid % NXCD, off = wgid / NXCD; wgid = (xcd < r ? xcd * (q + 1) : r * (q + 1) + (xcd - r) * q) + off; }
    const int nig = WGM * nN, gid = wgid / nig, fm = gid * WGM, gsz = (nM - fm) < WGM ? (nM - fm) : WGM;
    pm = fm + ((wgid % nig) % gsz); pn = (wgid % nig) / gsz;
}
struct PlainOrder {
    const char* A; const char* Bt; int lda, ldb, nM, nN, G, c, bskip;
    __device__ __forceinline__ bool next(int i, Unit& u) const {
        const long L = (long)i * G + c; if (L >= (long)nM * nN) return false;
        tile_of((int)L, nM, nN, u.pm, u.pn); u.aux = 0;
        u.A = A + (size_t)u.pm * BM * lda * 2; u.B = Bt + (size_t)(u.pn + ((u.pn >= 2) ? bskip : 0)) * BM * ldb * 2; return true;
    }
};
struct GroupOrder3 {
    const char* A; const char* Bt; int lda, ldb, nM, nN, G, c; size_t a_gstride, b_gstride;
    __device__ __forceinline__ bool next(int i, Unit& u) const {
        const int n = i % 3; const long L = (long)(i / 3) * G + c; if (L >= (long)nM * nN) return false;
        tile_of((int)L, nM, nN, u.pm, u.pn); u.aux = n;
        u.A = A + n * a_gstride + (size_t)u.pm * BM * lda * 2; u.B = Bt + n * b_gstride + (size_t)u.pn * BM * ldb * 2; return true;
    }
};

template <class Epi, class Sched, bool ALIGN_EPI>
__device__ __forceinline__ void gemm_phase(PG8_LAS unsigned char* lds, const Gemm g, const Sched& S, const Epi& E) {
    int tid_ = threadIdx.x; asm volatile("" : "+v"(tid_));
    const int tid = tid_, wid = __builtin_amdgcn_readfirstlane(tid >> 6), lane = tid & 63, wr = wid >> 2, wc = wid & 3, fr = lane & 15, fq = lane >> 4;
    const int K = g.K, nt = K / BK;
    unsigned voffA[2], voffB[2];
#pragma unroll
    for (int i = 0; i < 2; ++i) { int R, C; stage_rc(tid * 16 + i * 8192, R, C); const int Rb = (int)Epi::PERM == 2 ? (64 * (R >> 5) + perm32(R & 31)) : (int)Epi::PERM == 1 ? ((R & ~31) + perm32(R & 31)) : R;
        voffA[i] = (unsigned)(R * g.lda + C) * 2u; voffB[i] = (unsigned)(Rb * g.ldb + C) * 2u; }
    const size_t kstep = (size_t)(BK * 2);
    const size_t hstepA = (size_t)HALF * g.lda * 2, hstepB = (size_t)((int)Epi::PERM == 2 ? 32 : HALF) * g.ldb * 2;
    const unsigned ldsw = (unsigned)wid * 1024u;
    const int aoff = lds_byte(wr * 64 + fr, fq * 8), boff = lds_byte(wc * 32 + fr, fq * 8);
#define PG8_SA(b, h) (((b) * 2 + (h)) * HTB)
#define PG8_SB(b, h) ((4 + (b) * 2 + (h)) * HTB)
#define PG8_STAGE(bufoff, gbase, voff) do { _Pragma("unroll") for (int _i = 0; _i < 2; ++_i) \
        __builtin_amdgcn_global_load_lds((const unsigned*)((const char*)(gbase) + (voff)[_i]), (PG8_LAS unsigned*)(lds + (bufoff) + ldsw + _i * 8192), 16, 0, 0); } while (0)
#define PG8_LDA(dst, b, h) do { _Pragma("unroll") for (int m = 0; m < 4; ++m) _Pragma("unroll") for (int k = 0; k < 2; ++k) dst[m][k] = *(const PG8_LAS bf16x8*)(lds + PG8_SA(b, h) + aoff + m * 2048 + k * 1024); } while (0)
#define PG8_LDB(dst, b, h) do { _Pragma("unroll") for (int n = 0; n < 2; ++n) _Pragma("unroll") for (int k = 0; k < 2; ++k) dst[n][k] = *(const PG8_LAS bf16x8*)(lds + PG8_SB(b, h) + boff + n * 2048 + k * 1024); } while (0)
#define PG8_MMA(ai, bj, At, Bt) do { __builtin_amdgcn_s_setprio(1); _Pragma("unroll") for (int m = 0; m < 4; ++m) _Pragma("unroll") for (int n = 0; n < 2; ++n) _Pragma("unroll") for (int k = 0; k < 2; ++k) \
        acc[ai][bj][m][n] = __builtin_amdgcn_mfma_f32_16x16x32_bf16(Bt[n][k], At[m][k], acc[ai][bj][m][n], 0, 0, 0); __builtin_amdgcn_s_setprio(0); } while (0)
#define PG8_WAIT_V(n) asm volatile("s_waitcnt vmcnt(" #n ")" ::: "memory")
#define PG8_WAIT_L(n) asm volatile("s_waitcnt lgkmcnt(" #n ")" ::: "memory")
#define PG8_BAR __builtin_amdgcn_s_barrier()
#define PG8_SCHED __builtin_amdgcn_sched_barrier(0)
    Unit cur, nxt; int ui = 0;
    if (!S.next(0, cur)) return;
    f32x4 acc[2][2][4][2];
#pragma unroll
    for (int a = 0; a < 2; ++a)
#pragma unroll
        for (int b = 0; b < 2; ++b)
#pragma unroll
            for (int m = 0; m < 4; ++m)
#pragma unroll
                for (int n = 0; n < 2; ++n) acc[a][b][m][n] = (f32x4){0.f, 0.f, 0.f, 0.f};
    bf16x8 At[4][2], B0[2][2], B1[2][2];
    const char* cA = cur.A; const char* cB = cur.B;
    PG8_STAGE(PG8_SB(0, 0), cB, voffB); PG8_STAGE(PG8_SB(0, 1), cB + hstepB, voffB); PG8_STAGE(PG8_SA(0, 0), cA, voffA); PG8_STAGE(PG8_SA(0, 1), cA + hstepA, voffA);
    if (wr == 1) PG8_BAR;
    PG8_WAIT_V(2); PG8_BAR;
    PG8_STAGE(PG8_SB(1, 0), cB + kstep, voffB); PG8_STAGE(PG8_SA(1, 0), cA + kstep, voffA); PG8_STAGE(PG8_SB(1, 1), cB + hstepB + kstep, voffB);
    PG8_WAIT_V(6); PG8_BAR;
    for (;;) {
        const bool has_next = S.next(ui + 1, nxt);
        const char* nA = has_next ? nxt.A : cA; const char* nB = has_next ? nxt.B : cB;
#pragma unroll 1
        for (int t = 0; t < nt; t += 2) {
            const bool last = (t == nt - 2);
            const char* a1 = cA + (size_t)(t + 1) * kstep;
            const char* a2 = last ? nA : cA + (size_t)(t + 2) * kstep; const char* b2 = last ? nB : cB + (size_t)(t + 2) * kstep;
            const char* a3 = a2 + kstep; const char* b3 = b2 + kstep;
            PG8_LDB(B0, 0, 0); PG8_LDB(B1, 0, 1); PG8_SCHED; PG8_LDA(At, 0, 0); PG8_STAGE(PG8_SA(1, 1), a1 + hstepA, voffA);
            PG8_WAIT_V(8); PG8_WAIT_L(0); PG8_BAR; PG8_MMA(0, 0, At, B0); PG8_MMA(0, 1, At, B1); PG8_BAR; PG8_SCHED;
            PG8_LDA(At, 0, 1); PG8_STAGE(PG8_SB(0, 0), b2, voffB); PG8_STAGE(PG8_SB(0, 1), b2 + hstepB, voffB); PG8_STAGE(PG8_SA(0, 0), a2, voffA);
            PG8_WAIT_V(8); PG8_WAIT_L(0); PG8_BAR; PG8_MMA(1, 0, At, B0); PG8_MMA(1, 1, At, B1); PG8_BAR; PG8_SCHED;
            PG8_LDB(B0, 1, 0); PG8_LDB(B1, 1, 1); PG8_SCHED; PG8_LDA(At, 1, 0); PG8_STAGE(PG8_SA(0, 1), a2 + hstepA, voffA);
            PG8_WAIT_V(8); PG8_WAIT_L(0); PG8_BAR; PG8_MMA(0, 0, At, B0); PG8_MMA(0, 1, At, B1); PG8_BAR; PG8_SCHED;
            PG8_LDA(At, 1, 1); PG8_STAGE(PG8_SB(1, 0), b3, voffB); PG8_STAGE(PG8_SB(1, 1), b3 + hstepB, voffB); PG8_STAGE(PG8_SA(1, 0), a3, voffA);
            PG8_WAIT_V(8); PG8_WAIT_L(0); PG8_BAR; PG8_MMA(1, 0, At, B0); PG8_MMA(1, 1, At, B1); PG8_BAR; PG8_SCHED;
        }
        if constexpr (ALIGN_EPI) { if (wr == 0) PG8_BAR; }
        E(acc, cur, wr, wc, fr, fq);
        if (!has_next) break;
#pragma unroll
        for (int a = 0; a < 2; ++a)
#pragma unroll
            for (int b = 0; b < 2; ++b)
#pragma unroll
                for (int m = 0; m < 4; ++m)
#pragma unroll
                    for (int n = 0; n < 2; ++n) acc[a][b][m][n] = (f32x4){0.f, 0.f, 0.f, 0.f};
        cur = nxt; cA = nA; cB = nB; ++ui;
        if constexpr (ALIGN_EPI) { if (wr == 1) PG8_BAR; }
    }
    PG8_WAIT_V(0);
    if constexpr (!ALIGN_EPI) { if (wr == 0) PG8_BAR; }
    PG8_BAR;
#undef PG8_SA
#undef PG8_SB
#undef PG8_STAGE
#undef PG8_LDA
#undef PG8_LDB
#undef PG8_MMA
#undef PG8_WAIT_V
#undef PG8_WAIT_L
#undef PG8_BAR
#undef PG8_SCHED
}
}
#define LAS __attribute__((address_space(3)))
typedef unsigned short bf16_t;
typedef short bf16x8 __attribute__((ext_vector_type(8)));
typedef short s16x4 __attribute__((ext_vector_type(4)));
typedef float f32x4 __attribute__((ext_vector_type(4)));
typedef float f32x2 __attribute__((ext_vector_type(2)));
typedef float f32x16 __attribute__((ext_vector_type(16)));
typedef unsigned u32x4 __attribute__((ext_vector_type(4)));
typedef unsigned u32x2 __attribute__((ext_vector_type(2)));
typedef __bf16 bf16x2_t __attribute__((ext_vector_type(2)));

constexpr int BATCH = 8, SEQ = 4096, DM = 1024, T = BATCH * SEQ, DEPTH = 2;
constexpr int N_IN = 7728, NA = 3328, NG = 4608, NALL = NA + NG;
constexpr int CQ = 0, CKV = 256, KROPE = 384, GLAT = 416, RW_R = 512, RW_K = 1024, RW_V = 1536, RW_LW = 2048, RW_LA = 2112, GQ = 2304, GK = 2560, GV = 2816;
constexpr int KP = 544;
constexpr float NORM_EPS = 1e-6f, RWKV_GN_EPS = 64e-5f;
constexpr float QSCALE = 0.10206207261596577f * 1.4426950408889634f;

constexpr size_t MiB = 1u << 20;
constexpr size_t WS_CTL = 0;
constexpr size_t WS_ROPE = 1 * MiB;
constexpr size_t WS_RSTD = 5 * MiB;
constexpr size_t WS_WIN = 6 * MiB;
constexpr size_t WS_WBO = WS_WIN + (size_t)NALL * 1024 * 2;
constexpr size_t WS_WOUT = WS_WBO + 3 * MiB;
constexpr size_t WS_WUQ = WS_WOUT + 2 * MiB;
constexpr size_t WS_WUKV = WS_WUQ + 768 * 256 * 2;
constexpr size_t WS_HB = 28 * MiB;
constexpr size_t WS_PA = 92 * MiB;
constexpr size_t WS_Q = 300 * MiB;
constexpr size_t WS_K = 348 * MiB;
constexpr size_t WS_V = 382 * MiB;
constexpr size_t WS_YS = 414 * MiB;
constexpr size_t WS_SMG8 = WS_Q;
constexpr size_t WS_MG = WS_PA, WS_OF = WS_PA + 64 * MiB;
constexpr size_t WS_END = 510 * MiB;
static_assert(WS_WUKV + 1024 * 256 * 2 <= WS_HB, "weights fit");

__device__ __forceinline__ unsigned pk2(float lo, float hi) { f32x2 v = {lo, hi}; bf16x2_t b = __builtin_convertvector(v, bf16x2_t); return __builtin_bit_cast(unsigned, b); }
__device__ __forceinline__ float bflo(unsigned w) { return __uint_as_float(w << 16); }
__device__ __forceinline__ float bfhi(unsigned w) { return __uint_as_float(w & 0xffff0000u); }
__device__ __forceinline__ float bf2f(bf16_t b) { return __uint_as_float((unsigned)b << 16); }
__device__ __forceinline__ bf16_t f2bf(float f) { return (bf16_t)(pk2(f, 0.f) & 0xffffu); }
__device__ __forceinline__ float wave_sum(float v) {
#pragma unroll
    for (int o = 1; o < 64; o <<= 1) v += __shfl_xor(v, o);
    return v;
}
__device__ __forceinline__ float fast_exp(float x) { return __builtin_amdgcn_exp2f(x * 1.4426950408889634f); }
__device__ __forceinline__ float fast_sigmoid(float x) { return __builtin_amdgcn_rcpf(1.0f + fast_exp(-x)); }
template <int CTRL> __device__ __forceinline__ float dpp_f(float x) { return __int_as_float(__builtin_amdgcn_update_dpp(0, __float_as_int(x), CTRL, 0xf, 0xf, false)); }
__device__ __forceinline__ float sum8(float x) { x += dpp_f<0xB1>(x); x += dpp_f<0x4E>(x); x += dpp_f<0x141>(x); return x; }
__device__ __forceinline__ float sum16(float x) { x += dpp_f<0xB1>(x); x += dpp_f<0x4E>(x); x += dpp_f<0x141>(x); x += dpp_f<0x140>(x); return x; }

struct Params {
    const float* x; const int* positions; const float* norm_pre; const float* w_in; const float* mla_q_norm; const float* mla_kv_norm; const float* mla_w_uq; const float* mla_w_ukv;
    const float* rwkv_mu; const float* rwkv_w0; const float* rwkv_w_up; const float* rwkv_a0; const float* rwkv_a_up; const float* rwkv_k_k; const float* rwkv_k_a; const float* rwkv_r_k;
    const float* rwkv_ln_w; const float* rwkv_ln_b; const float* gla_a_up; const float* gla_a_b; const float* gla_norm; const float* w_branch_out; const float* w_out; const float* norm_post;
    float* out; unsigned char* ws; int ph_lo, ph_hi;
};

typedef const __attribute__((address_space(4))) Params* KArgs;
__device__ __forceinline__ KArgs kargs() { KArgs kp = (KArgs)__builtin_amdgcn_kernarg_segment_ptr(); asm volatile("" : "+s"(kp)); return kp; }

__device__ __forceinline__ Params load_params() { Params p{}; KArgs kp = kargs(); p.x = kp->x; p.positions = kp->positions; p.norm_pre = kp->norm_pre; p.w_in = kp->w_in; p.mla_q_norm = kp->mla_q_norm; p.mla_kv_norm = kp->mla_kv_norm; p.mla_w_uq = kp->mla_w_uq; p.mla_w_ukv = kp->mla_w_ukv; p.rwkv_mu = kp->rwkv_mu; p.rwkv_w0 = kp->rwkv_w0; p.rwkv_w_up = kp->rwkv_w_up; p.rwkv_a0 = kp->rwkv_a0; p.rwkv_a_up = kp->rwkv_a_up; p.rwkv_k_k = kp->rwkv_k_k; p.rwkv_k_a = kp->rwkv_k_a; p.rwkv_r_k = kp->rwkv_r_k; p.rwkv_ln_w = kp->rwkv_ln_w; p.rwkv_ln_b = kp->rwkv_ln_b; p.gla_a_up = kp->gla_a_up; p.gla_a_b = kp->gla_a_b; p.gla_norm = kp->gla_norm; p.w_branch_out = kp->w_branch_out; p.w_out = kp->w_out; p.norm_post = kp->norm_post; p.out = kp->out; p.ws = kp->ws; p.ph_lo = kp->ph_lo; p.ph_hi = kp->ph_hi; return p; }
__device__ __forceinline__ int opaque_tid() { int t = threadIdx.x; asm volatile("" : "+v"(t)); return t; }

using pg8::Unit;
constexpr int EPI_SCR = 131072, EPI_SCR_WAVE = 2304, EPI_PITCH = 144;
struct EpiStore {
    static constexpr int PERM = 2; bf16_t* O; int ldc; LAS unsigned char* lds;
    __device__ __forceinline__ void operator()(const f32x4 (&acc)[2][2][4][2], const Unit& u, int wr, int wc, int fr, int fq) const {
        LAS unsigned char* scr = lds + EPI_SCR + (wr * 4 + wc) * EPI_SCR_WAVE;
        const int lane = fq * 16 + fr;
        LAS unsigned char* wp = scr + fr * EPI_PITCH + fq * 16;
        const LAS unsigned char* rp = scr + (lane >> 3) * EPI_PITCH + (lane & 7) * 16;
        bf16_t* gp = O + (size_t)(u.pm * 256 + wr * 64 + (lane >> 3)) * ldc + u.pn * 256 + wc * 64 + (lane & 7) * 8;
#pragma unroll
        for (int ai = 0; ai < 2; ++ai)
#pragma unroll
            for (int m = 0; m < 4; ++m) {
#pragma unroll
                for (int bj = 0; bj < 2; ++bj) { const f32x4 v0 = acc[ai][bj][m][0], v1 = acc[ai][bj][m][1];
                    u32x4 w; w.x = pk2(v0[0], v0[1]); w.y = pk2(v0[2], v0[3]); w.z = pk2(v1[0], v1[1]); w.w = pk2(v1[2], v1[3]);
                    *(LAS u32x4*)(wp + bj * 64) = w; }
                asm volatile("" ::: "memory");
                const u32x4 r0 = *(const LAS u32x4*)rp, r1 = *(const LAS u32x4*)(rp + 8 * EPI_PITCH);
                asm volatile("" ::: "memory");
                bf16_t* g = gp + (size_t)(ai * 128 + m * 16) * ldc;
                *(u32x4*)g = r0; *(u32x4*)(g + (size_t)8 * ldc) = r1; }
    }
};
struct EpiNull {
    static constexpr bool PERM = true; float* sink;
    __device__ __forceinline__ void operator()(const f32x4 (&acc)[2][2][4][2], const Unit& u, int wr, int wc, int fr, int fq) const {
#pragma unroll
        for (int ai = 0; ai < 2; ++ai)
#pragma unroll
            for (int m = 0; m < 4; ++m)
#pragma unroll
                for (int bj = 0; bj < 2; ++bj) { asm volatile("" :: "v"(acc[ai][bj][m][0]), "v"(acc[ai][bj][m][1])); }
    }
};
struct EpiQ {
    static constexpr bool PERM = true; bf16_t* Q; const float* rstd;
    __device__ __forceinline__ void operator()(const f32x4 (&acc)[2][2][4][2], const Unit& u, int wr, int wc, int fr, int fq) const {
        const int row0 = u.pm * 256 + wr * 64 + fr, col0 = u.pn * 256 + wc * 32 + 8 * fq;
        float rsv[2][4];
#pragma unroll
        for (int ai = 0; ai < 2; ++ai)
#pragma unroll
            for (int m = 0; m < 4; ++m) rsv[ai][m] = rstd[row0 + ai * 128 + m * 16];
#pragma unroll
        for (int ai = 0; ai < 2; ++ai)
#pragma unroll
            for (int m = 0; m < 4; ++m) { const int row = row0 + ai * 128 + m * 16; const float rs = rsv[ai][m] * QSCALE; bf16_t* rowp = Q + (size_t)row * 768 + col0;
#pragma unroll
                for (int bj = 0; bj < 2; ++bj) { const f32x4 v0 = acc[ai][bj][m][0] * rs, v1 = acc[ai][bj][m][1] * rs;
                    u32x4 w; w.x = pk2(v0[0], v0[1]); w.y = pk2(v0[2], v0[3]); w.z = pk2(v1[0], v1[1]); w.w = pk2(v1[2], v1[3]);
                    *(u32x4*)(rowp + bj * 128) = w; } }
    }
};
struct EpiKV {
    static constexpr bool PERM = true; bf16_t* Kb; bf16_t* Vb; const float* rstd;
    __device__ __forceinline__ void operator()(const f32x4 (&acc)[2][2][4][2], const Unit& u, int wr, int wc, int fr, int fq) const {
        const int row0 = u.pm * 256 + wr * 64 + fr, col0 = (u.pn & 1) * 256 + wc * 32 + 8 * fq; const bool isv = u.pn >= 2;
        float rsv[2][4];
#pragma unroll
        for (int ai = 0; ai < 2; ++ai)
#pragma unroll
            for (int m = 0; m < 4; ++m) rsv[ai][m] = rstd[row0 + ai * 128 + m * 16];
#pragma unroll
        for (int ai = 0; ai < 2; ++ai)
#pragma unroll
            for (int m = 0; m < 4; ++m) { const int row = row0 + ai * 128 + m * 16; const float rs = rsv[ai][m];
                bf16_t* rowp = isv ? (Vb + (size_t)row * 512 + col0) : (Kb + (size_t)row * KP + col0);
#pragma unroll
                for (int bj = 0; bj < 2; ++bj) { const f32x4 v0 = acc[ai][bj][m][0] * rs, v1 = acc[ai][bj][m][1] * rs;
                    u32x4 w; w.x = pk2(v0[0], v0[1]); w.y = pk2(v0[2], v0[3]); w.z = pk2(v1[0], v1[1]); w.w = pk2(v1[2], v1[3]);
                    *(u32x4*)(rowp + bj * 128) = w; } }
    }
};
__device__ __forceinline__ unsigned q8(float s) { return (unsigned)(s * 255.0f + 0.5f); }
struct EpiGateBG {
    static constexpr bool PERM = true; bf16_t* YS; int pn0, skip;
    __device__ __forceinline__ void operator()(const f32x4 (&acc)[2][2][4][2], const Unit& u, int wr, int wc, int fr, int fq) const {
        const int pn = pn0 + u.pn + ((u.pn >= 2) ? skip : 0);
        const int row0 = u.pm * 256 + wr * 64 + fr, col0 = (pn & 1) * 256 + wc * 32 + 8 * fq;
        bf16_t* base = YS + (size_t)(pn >> 1) * T * 512;
#pragma unroll
        for (int ai = 0; ai < 2; ++ai) {
            u32x4 y[4][2];
#pragma unroll
            for (int m = 0; m < 4; ++m) { const bf16_t* rowp = base + (size_t)(row0 + ai * 128 + m * 16) * 512 + col0;
#pragma unroll
                for (int bj = 0; bj < 2; ++bj) y[m][bj] = *(const u32x4*)(rowp + bj * 128); }
#pragma unroll
            for (int m = 0; m < 4; ++m) { bf16_t* rowp = base + (size_t)(row0 + ai * 128 + m * 16) * 512 + col0;
#pragma unroll
                for (int bj = 0; bj < 2; ++bj) { const f32x4 a0 = acc[ai][bj][m][0], a1 = acc[ai][bj][m][1]; const u32x4 yy = y[m][bj];
                    float v[8] = {a0[0], a0[1], a0[2], a0[3], a1[0], a1[1], a1[2], a1[3]};
#pragma unroll
                    for (int j = 0; j < 8; ++j) v[j] = fast_sigmoid(v[j]) * v[j];
                    v[0] *= bflo(yy.x); v[1] *= bfhi(yy.x); v[2] *= bflo(yy.y); v[3] *= bfhi(yy.y); v[4] *= bflo(yy.z); v[5] *= bfhi(yy.z); v[6] *= bflo(yy.w); v[7] *= bfhi(yy.w);
                    u32x4 w; w.x = pk2(v[0], v[1]); w.y = pk2(v[2], v[3]); w.z = pk2(v[4], v[5]); w.w = pk2(v[6], v[7]);
                    *(u32x4*)(rowp + bj * 128) = w; } }
        }
    }
};
struct EpiGateMG8 {
    static constexpr bool PERM = true; unsigned char* SMG;
    __device__ __forceinline__ void operator()(const f32x4 (&acc)[2][2][4][2], const Unit& u, int wr, int wc, int fr, int fq) const {
        const int row0 = u.pm * 256 + wr * 64 + fr, col0 = u.pn * 256 + wc * 32 + 8 * fq;
#pragma unroll
        for (int ai = 0; ai < 2; ++ai)
#pragma unroll
            for (int m = 0; m < 4; ++m) { const int row = row0 + ai * 128 + m * 16; unsigned char* rowp = SMG + (size_t)row * 3072 + col0;
#pragma unroll
                for (int bj = 0; bj < 2; ++bj) { const f32x4 a0 = acc[ai][bj][m][0], a1 = acc[ai][bj][m][1];
                    u32x2 w; w.x = q8(fast_sigmoid(a0[0])) | (q8(fast_sigmoid(a0[1])) << 8) | (q8(fast_sigmoid(a0[2])) << 16) | (q8(fast_sigmoid(a0[3])) << 24);
                    w.y = q8(fast_sigmoid(a1[0])) | (q8(fast_sigmoid(a1[1])) << 8) | (q8(fast_sigmoid(a1[2])) << 16) | (q8(fast_sigmoid(a1[3])) << 24);
                    *(u32x2*)(rowp + bj * 128) = w; } }
    }
};
struct EpiMerge {
    static constexpr bool PERM = true; bf16_t* MG; const unsigned char* SMG;
    __device__ __forceinline__ void operator()(const f32x4 (&acc)[2][2][4][2], const Unit& u, int wr, int wc, int fr, int fq) const {
        const int row0 = u.pm * 256 + wr * 64 + fr, col0 = u.pn * 256 + wc * 32 + 8 * fq, n = u.aux; constexpr float S = 1.0f / 255.0f;
#pragma unroll
        for (int ai = 0; ai < 2; ++ai) {
            u32x2 g[4][2]; u32x4 y[4][2];
#pragma unroll
            for (int m = 0; m < 4; ++m) { const int row = row0 + ai * 128 + m * 16; const unsigned char* gp = SMG + (size_t)row * 3072 + n * 1024 + col0; const bf16_t* rowp = MG + (size_t)row * 1024 + col0;
#pragma unroll
                for (int bj = 0; bj < 2; ++bj) { g[m][bj] = *(const u32x2*)(gp + bj * 128); if (n > 0) y[m][bj] = *(const u32x4*)(rowp + bj * 128); } }
#pragma unroll
            for (int m = 0; m < 4; ++m) { const int row = row0 + ai * 128 + m * 16; bf16_t* rowp = MG + (size_t)row * 1024 + col0;
#pragma unroll
                for (int bj = 0; bj < 2; ++bj) { const f32x4 a0 = acc[ai][bj][m][0], a1 = acc[ai][bj][m][1]; const u32x2 gg = g[m][bj];
                    float v[8] = {a0[0] * (S * (float)(gg.x & 0xffu)), a0[1] * (S * (float)((gg.x >> 8) & 0xffu)), a0[2] * (S * (float)((gg.x >> 16) & 0xffu)), a0[3] * (S * (float)(gg.x >> 24)),
                                  a1[0] * (S * (float)(gg.y & 0xffu)), a1[1] * (S * (float)((gg.y >> 8) & 0xffu)), a1[2] * (S * (float)((gg.y >> 16) & 0xffu)), a1[3] * (S * (float)(gg.y >> 24))};
                    if (n > 0) { const u32x4 yy = y[m][bj];
                        v[0] += bflo(yy.x); v[1] += bfhi(yy.x); v[2] += bflo(yy.y); v[3] += bfhi(yy.y); v[4] += bflo(yy.z); v[5] += bfhi(yy.z); v[6] += bflo(yy.w); v[7] += bfhi(yy.w); }
                    u32x4 w; w.x = pk2(v[0], v[1]); w.y = pk2(v[2], v[3]); w.z = pk2(v[4], v[5]); w.w = pk2(v[6], v[7]);
                    *(u32x4*)(rowp + bj * 128) = w; } }
        }
    }
};
struct EpiF32 {
    static constexpr bool PERM = false; float* O; int ldc;
    __device__ __forceinline__ void operator()(const f32x4 (&acc)[2][2][4][2], const Unit& u, int wr, int wc, int fr, int fq) const {
        const int row0 = u.pm * 256 + wr * 64 + fr, col0 = u.pn * 256 + wc * 32 + 4 * fq;
#pragma unroll
        for (int ai = 0; ai < 2; ++ai)
#pragma unroll
            for (int m = 0; m < 4; ++m) { float* rowp = O + (size_t)(row0 + ai * 128 + m * 16) * ldc + col0;
#pragma unroll
                for (int bj = 0; bj < 2; ++bj)
#pragma unroll
                    for (int n = 0; n < 2; ++n) *(f32x4*)(rowp + bj * 128 + n * 16) = acc[ai][bj][m][n]; }
    }
};

template <class SrcCol>
__device__ __forceinline__ void transpose_item(const float* W, int Ksrc, int Nsrc, bf16_t* WT, int Kdst, int item, int nblk, float* scr, int lane, SrcCol src, const float* kscale) {
    const int kb = item / nblk, nb = item % nblk, k0 = 64 * kb, n0 = 32 * nb;
    const int sc = src(n0 + (lane & 31));
#pragma unroll 8
    for (int i = 0; i < 32; ++i) { const int kk = 2 * i + (lane >> 5), k = k0 + kk; float v = 0.f;
        if (sc >= 0 && k < Ksrc) { v = W[(size_t)k * Nsrc + sc]; if (kscale) v *= kscale[k]; }
        scr[kk * 33 + (lane & 31)] = v; }
    asm volatile("s_waitcnt lgkmcnt(0)" ::: "memory");
    const int c = lane & 7;
#pragma unroll
    for (int j = 0; j < 4; ++j) { const int n = (lane >> 3) + 8 * j; const float* s = scr + (8 * c) * 33 + n;
        u32x4 o; o.x = pk2(s[0 * 33], s[1 * 33]); o.y = pk2(s[2 * 33], s[3 * 33]); o.z = pk2(s[4 * 33], s[5 * 33]); o.w = pk2(s[6 * 33], s[7 * 33]);
        *(u32x4*)(WT + (size_t)(n0 + n) * Kdst + k0 + 8 * c) = o; }
    asm volatile("s_waitcnt lgkmcnt(0)" ::: "memory");
}
__device__ __forceinline__ int win_src(int j) {
    if (j < 416) return j;
    if (j < 432) return 3104 + (j - 416);
    if (j < 512) return -1;
    if (j < 2048) return 416 + (j - 512);
    if (j < 2176) return 1952 + (j - 2048);
    if (j < 2304) return -1;
    if (j < 3328) return 2080 + (j - 2304);
    return 3120 + (j - 3328);
}
__device__ __forceinline__ int wuq_src(int j) { const int h = j / 96, c = j % 96; if (c < 64) return h * 96 + c; const int r = c - 64; return h * 96 + 64 + (r & 1) * 16 + (r >> 1); }
__device__ __forceinline__ int wukv_src(int j) { return j < 512 ? (j >> 6) * 128 + (j & 63) : ((j - 512) >> 6) * 128 + 64 + (j & 63); }

__device__ __forceinline__ void convert_weights(int l, unsigned char* lds, int gw, int NGW, int wave, int lane) {
    float* scr = (float*)(lds + wave * 8448); const Params p = load_params();
    bf16_t* WinT = (bf16_t*)(p.ws + WS_WIN); bf16_t* WboT = (bf16_t*)(p.ws + WS_WBO); bf16_t* WoutT = (bf16_t*)(p.ws + WS_WOUT); bf16_t* WuqT = (bf16_t*)(p.ws + WS_WUQ); bf16_t* WukvT = (bf16_t*)(p.ws + WS_WUKV);
    constexpr int I_IN = 16 * (NALL / 32), I_BO = 8 * 32, I_OUT = 16 * 32, I_UQ = 4 * 24, I_UKV = 4 * 32;
    constexpr int NITEMS = I_IN + 3 * I_BO + I_OUT + I_UQ + I_UKV;
    for (int it = gw; it < NITEMS; it += NGW) {
        int r = it;
        if (r < I_IN) { transpose_item(p.w_in + (size_t)l * 1024 * N_IN, 1024, N_IN, WinT, 1024, r, NALL / 32, scr, lane, [](int j) { return win_src(j); }, nullptr); continue; } r -= I_IN;
        if (r < 3 * I_BO) { const int n = r / I_BO; r -= n * I_BO;
            transpose_item(p.w_branch_out + ((size_t)l * 3 + n) * 512 * 1024, 512, 1024, WboT + (size_t)n * 1024 * 512, 512, r, 32, scr, lane, [](int j) { return j; }, nullptr); continue; } r -= 3 * I_BO;
        if (r < I_OUT) { transpose_item(p.w_out + (size_t)l * 1024 * 1024, 1024, 1024, WoutT, 1024, r, 32, scr, lane, [](int j) { return j; }, nullptr); continue; } r -= I_OUT;
        if (r < I_UQ) { transpose_item(p.mla_w_uq + (size_t)l * 256 * 768, 256, 768, WuqT, 256, r, 24, scr, lane, [](int j) { return wuq_src(j); }, p.mla_q_norm + l * 256); continue; } r -= I_UQ;
        transpose_item(p.mla_w_ukv + (size_t)l * 128 * 1024, 128, 1024, WukvT, 256, r, 32, scr, lane, [](int j) { return wukv_src(j); }, p.mla_kv_norm + l * 128);
    }
}
__device__ __forceinline__ void hb_row(const float* xrow, const float* g, bf16_t* orow, int lane) {
    const f32x4* xr = (const f32x4*)xrow + lane; const f32x4* gr = (const f32x4*)g + lane;
    f32x4 v[4]; float s = 0.f;
#pragma unroll
    for (int j = 0; j < 4; ++j) { v[j] = xr[64 * j]; s += (v[j].x * v[j].x + v[j].y * v[j].y) + (v[j].z * v[j].z + v[j].w * v[j].w); }
    const float rstd = rsqrtf(wave_sum(s) * (1.f / DM) + NORM_EPS);
    u32x2* o8 = (u32x2*)orow + lane;
#pragma unroll
    for (int j = 0; j < 4; ++j) { const f32x4 gg = gr[64 * j]; u32x2 w; w.x = pk2(v[j].x * rstd * gg.x, v[j].y * rstd * gg.y); w.y = pk2(v[j].z * rstd * gg.z, v[j].w * rstd * gg.w); o8[64 * j] = w; }
}
__device__ __forceinline__ void final_row(const bf16_t* orow, const float* xold, const float* gpost, float* xnew, const float* gnext, bf16_t* hbrow, int lane) {
    float o[16], x[16], g[16];
    { const u32x4 a = *((const u32x4*)orow + lane), b = *((const u32x4*)orow + 64 + lane);
      o[0] = bflo(a.x); o[1] = bfhi(a.x); o[2] = bflo(a.y); o[3] = bfhi(a.y); o[4] = bflo(a.z); o[5] = bfhi(a.z); o[6] = bflo(a.w); o[7] = bfhi(a.w);
      o[8] = bflo(b.x); o[9] = bfhi(b.x); o[10] = bflo(b.y); o[11] = bfhi(b.y); o[12] = bflo(b.z); o[13] = bfhi(b.z); o[14] = bflo(b.w); o[15] = bfhi(b.w); }
#pragma unroll
    for (int h = 0; h < 2; ++h)
#pragma unroll
        for (int q = 0; q < 2; ++q) { const f32x4 xv = *((const f32x4*)(xold + 512 * h + 8 * lane) + q), gv = *((const f32x4*)(gpost + 512 * h + 8 * lane) + q);
#pragma unroll
            for (int e = 0; e < 4; ++e) { x[8 * h + 4 * q + e] = xv[e]; g[8 * h + 4 * q + e] = gv[e]; } }
    float s = 0.f;
#pragma unroll
    for (int e = 0; e < 16; ++e) s += o[e] * o[e];
    const float rstd = rsqrtf(wave_sum(s) * (1.f / DM) + NORM_EPS);
    float s2 = 0.f;
#pragma unroll
    for (int e = 0; e < 16; ++e) { x[e] += o[e] * rstd * g[e]; s2 += x[e] * x[e]; }
#pragma unroll
    for (int h = 0; h < 2; ++h)
#pragma unroll
        for (int q = 0; q < 2; ++q) *((f32x4*)(xnew + 512 * h + 8 * lane) + q) = (f32x4){x[8 * h + 4 * q], x[8 * h + 4 * q + 1], x[8 * h + 4 * q + 2], x[8 * h + 4 * q + 3]};
    if (gnext) { const float rstd2 = rsqrtf(wave_sum(s2) * (1.f / DM) + NORM_EPS);
#pragma unroll
        for (int h = 0; h < 2; ++h) { const f32x4 g0 = *((const f32x4*)(gnext + 512 * h + 8 * lane)), g1 = *((const f32x4*)(gnext + 512 * h + 8 * lane) + 1);
            u32x4 w; w.x = pk2(x[8 * h] * rstd2 * g0[0], x[8 * h + 1] * rstd2 * g0[1]); w.y = pk2(x[8 * h + 2] * rstd2 * g0[2], x[8 * h + 3] * rstd2 * g0[3]);
            w.z = pk2(x[8 * h + 4] * rstd2 * g1[0], x[8 * h + 5] * rstd2 * g1[1]); w.w = pk2(x[8 * h + 6] * rstd2 * g1[2], x[8 * h + 7] * rstd2 * g1[3]);
            *((u32x4*)hbrow + 64 * h + lane) = w; } }
}
__device__ __forceinline__ void mla_prep_row(const bf16_t* prow, const f32x2* rope_t, float* rstdq, float* rstdkv, bf16_t* krow, int lane) {
    const u32x2 a = *((const u32x2*)(prow + CQ) + lane); const unsigned c = *((const unsigned*)(prow + CKV) + lane);
    float sq = bflo(a.x) * bflo(a.x) + bfhi(a.x) * bfhi(a.x) + bflo(a.y) * bflo(a.y) + bfhi(a.y) * bfhi(a.y);
    float sk = bflo(c) * bflo(c) + bfhi(c) * bfhi(c);
    sq = wave_sum(sq); sk = wave_sum(sk);
    if (lane == 0) { *rstdq = rsqrtf(sq * (1.f / 256.f) + NORM_EPS); *rstdkv = rsqrtf(sk * (1.f / 128.f) + NORM_EPS); }
    if (lane < 16) { const float x1 = bf2f(prow[KROPE + lane]), x2 = bf2f(prow[KROPE + 16 + lane]); const f32x2 cs = rope_t[lane];
        *((unsigned*)(krow + 512) + lane) = pk2(x1 * cs.x - x2 * cs.y, x2 * cs.x + x1 * cs.y); }
}

namespace att {
constexpr int KSLOT = 12288, VSLOT = 8192, BUFB = KSLOT + VSLOT, L_WS = 2 * BUFB, L_OST = L_WS + 8 * 128 * 4, L_END = L_OST + 8 * 4096;
constexpr int UNIT_ROWS = 512;
__device__ __forceinline__ int crow(int r, int hi) { return (r & 3) + 8 * (r >> 2) + 4 * hi; }
__device__ __forceinline__ s16x4 vtr(const LAS unsigned char* p) { return __builtin_bit_cast(s16x4, __builtin_amdgcn_ds_read_tr16_b64_v4i16((LAS s16x4*)p)); }
__device__ __forceinline__ void load_q(bf16x8 (&qr)[6], const bf16_t* Q, const f32x2* rope, size_t row, int h, int hi) {
    const bf16_t* Qw = Q + row * 768 + h * 96 + hi * 8;
#pragma unroll
    for (int s = 0; s < 6; ++s) qr[s] = *(const bf16x8*)(Qw + s * 16);
    const f32x4* rp = (const f32x4*)(rope + row * 16 + 4 * hi);
#pragma unroll
    for (int s = 4; s < 6; ++s) { const f32x4 c01 = rp[(s - 4) * 4], c23 = rp[(s - 4) * 4 + 1]; const u32x4 w = __builtin_bit_cast(u32x4, qr[s]); u32x4 o;
        { const float e = bflo(w.x), d = bfhi(w.x); o.x = pk2(e * c01[0] - d * c01[1], d * c01[0] + e * c01[1]); }
        { const float e = bflo(w.y), d = bfhi(w.y); o.y = pk2(e * c01[2] - d * c01[3], d * c01[2] + e * c01[3]); }
        { const float e = bflo(w.z), d = bfhi(w.z); o.z = pk2(e * c23[0] - d * c23[1], d * c23[0] + e * c23[1]); }
        { const float e = bflo(w.w), d = bfhi(w.w); o.w = pk2(e * c23[2] - d * c23[3], d * c23[2] + e * c23[3]); }
        qr[s] = __builtin_bit_cast(bf16x8, o); }
}
__device__ __forceinline__ void softmax_half(f32x16& p0, f32x16& p1, f32x16& o0, f32x16& o1, float& mrun, float& lrun, bf16x8 (&pa)[4],
                                             bool first, bool band, int kb0, int qrel, int r32, int hi, LAS float* wsf) {
    if (band) {
#pragma unroll
        for (int r = 0; r < 16; ++r) { const int kv = kb0 + (r & 3) + 8 * (r >> 2); if (kv > qrel) p0[r] = -INFINITY; if (kv + 32 > qrel) p1[r] = -INFINITY; } }
    float mx = fmaxf(p0[0], p1[0]);
#pragma unroll
    for (int r = 1; r < 16; ++r) mx = fmaxf(mx, fmaxf(p0[r], p1[r]));
    mx = fmaxf(mx, __shfl_xor(mx, 32));
    if (first || __any(mx > 8.0f)) {
        const float dl = first ? mx : fmaxf(mx, 0.f); mrun += dl;
#pragma unroll
        for (int r = 0; r < 16; ++r) { p0[r] -= dl; p1[r] -= dl; }
        const float alpha = __builtin_amdgcn_exp2f(-dl); lrun *= alpha;
        if (hi == 0) wsf[r32] = alpha;
#pragma unroll
        for (int r = 0; r < 16; ++r) { const float a = wsf[crow(r, hi)]; o0[r] *= a; o1[r] *= a; }
    }
    float ls = 0.f;
#pragma unroll
    for (int r = 0; r < 16; ++r) { p0[r] = __builtin_amdgcn_exp2f(p0[r]); p1[r] = __builtin_amdgcn_exp2f(p1[r]); ls += p0[r] + p1[r]; }
    lrun += ls;
#pragma unroll
    for (int s = 0; s < 4; ++s) { const int bb = 8 * (s & 1); u32x4 w;
        if (s < 2) { w.x = pk2(p0[bb], p0[bb + 1]); w.y = pk2(p0[bb + 2], p0[bb + 3]); w.z = pk2(p0[bb + 4], p0[bb + 5]); w.w = pk2(p0[bb + 6], p0[bb + 7]); }
        else { w.x = pk2(p1[bb], p1[bb + 1]); w.y = pk2(p1[bb + 2], p1[bb + 3]); w.z = pk2(p1[bb + 4], p1[bb + 5]); w.w = pk2(p1[bb + 6], p1[bb + 7]); }
        pa[s] = __builtin_bit_cast(bf16x8, w); }
}
__device__ __forceinline__ void attn_unit(int b, int h, int qb, LAS unsigned char* lds, unsigned* done_ctr) {
    KArgs kp = kargs(); unsigned char* ws_ = kp->ws;
    const bf16_t* Q = (const bf16_t*)(ws_ + WS_Q); const bf16_t* Kg = (const bf16_t*)(ws_ + WS_K); const bf16_t* Vg = (const bf16_t*)(ws_ + WS_V); bf16_t* O = (bf16_t*)(ws_ + WS_YS);
    const int tid = opaque_tid(), lane = tid & 63, r32 = lane & 31, hi = lane >> 5; const int wid = __builtin_amdgcn_readfirstlane(tid >> 6);
    const size_t rowbase = (size_t)b * SEQ; const int q0 = qb * UNIT_ROWS;
    bf16x8 qa[6], qb_[6];
    load_q(qa, Q, (const f32x2*)(ws_ + WS_ROPE), rowbase + q0 + wid * 64 + r32, h, hi);
    load_q(qb_, Q, (const f32x2*)(ws_ + WS_ROPE), rowbase + q0 + wid * 64 + 32 + r32, h, hi);
    const bf16_t* ksrc0 = Kg + (rowbase + (tid & 63)) * KP + h * 64 + (tid >> 6) * 8;
    const bf16_t* ksrc1 = Kg + (rowbase + (tid & 63)) * KP + 512 + (tid >> 6) * 8;
    const bf16_t* vsrc = Vg + (rowbase + ((tid & 255) >> 2)) * 512 + h * 64 + (tid >> 8) * 32 + (tid & 3) * 8;
    const int NT = (q0 + UNIT_ROWS) / 64;
    LAS float* wsf = (LAS float*)(lds + L_WS) + wid * 128;
    u32x4 sk0, sk1, sv;
    sk0 = *(const u32x4*)ksrc0; if (tid < 256) sk1 = *(const u32x4*)ksrc1; sv = *(const u32x4*)vsrc;
    *(LAS u32x4*)(lds + tid * 16) = sk0; if (tid < 256) *(LAS u32x4*)(lds + (tid + 512) * 16) = sk1; *(LAS u32x4*)(lds + KSLOT + tid * 16) = sv;
    __syncthreads();
    f32x16 oa0 = {}, oa1 = {}, ob0 = {}, ob1 = {}; float ma = 0.f, la = 0.f, mb = 0.f, lb = 0.f;
    const int qra = wid * 64 + r32, qrb = qra + 32;
    for (int t = 0; t < NT; ++t) {
        LAS unsigned char* buf = lds + (t & 1) * BUFB; LAS unsigned char* nbuf = lds + ((t + 1) & 1) * BUFB;
        if (t + 1 < NT) { sk0 = *(const u32x4*)(ksrc0 + (size_t)(t + 1) * 64 * KP); if (tid < 256) sk1 = *(const u32x4*)(ksrc1 + (size_t)(t + 1) * 64 * KP); sv = *(const u32x4*)(vsrc + (size_t)(t + 1) * 64 * 512); }
        f32x16 pa0, pa1, pb0, pb1;
#pragma unroll
        for (int r = 0; r < 16; ++r) { pa0[r] = -ma; pa1[r] = -ma; pb0[r] = -mb; pb1[r] = -mb; }
        { const LAS unsigned char* kb = buf + hi * 1024 + r32 * 16;
#pragma unroll
          for (int s = 0; s < 6; ++s) { const bf16x8 a0 = *(const LAS bf16x8*)(kb + s * 2048), a1 = *(const LAS bf16x8*)(kb + s * 2048 + 512);
              pa0 = __builtin_amdgcn_mfma_f32_32x32x16_bf16(a0, qa[s], pa0, 0, 0, 0); pa1 = __builtin_amdgcn_mfma_f32_32x32x16_bf16(a1, qa[s], pa1, 0, 0, 0);
              pb0 = __builtin_amdgcn_mfma_f32_32x32x16_bf16(a0, qb_[s], pb0, 0, 0, 0); pb1 = __builtin_amdgcn_mfma_f32_32x32x16_bf16(a1, qb_[s], pb1, 0, 0, 0); } }
        const bool band = t >= NT - 8; const int kb0 = 64 * (t - (NT - 8)) + 4 * hi;
        bf16x8 fa[4], fb[4];
        softmax_half(pa0, pa1, oa0, oa1, ma, la, fa, t == 0, band, kb0, qra, r32, hi, wsf);
        softmax_half(pb0, pb1, ob0, ob1, mb, lb, fb, t == 0, band, kb0, qrb, r32, hi, wsf + 64);
        { const LAS unsigned char* vb = buf + KSLOT + ((lane >> 4) & 1) * 32 + (lane & 3) * 8 + (4 * hi + ((lane & 15) >> 2)) * 64;
#pragma unroll
          for (int s = 0; s < 4; ++s) {
              { const s16x4 lo = vtr(vb + s * 1024), hh = vtr(vb + s * 1024 + 512); const bf16x8 vf = {lo[0], lo[1], lo[2], lo[3], hh[0], hh[1], hh[2], hh[3]};
                oa0 = __builtin_amdgcn_mfma_f32_32x32x16_bf16(fa[s], vf, oa0, 0, 0, 0); ob0 = __builtin_amdgcn_mfma_f32_32x32x16_bf16(fb[s], vf, ob0, 0, 0, 0); }
              { const s16x4 lo = vtr(vb + 4096 + s * 1024), hh = vtr(vb + 4096 + s * 1024 + 512); const bf16x8 vf = {lo[0], lo[1], lo[2], lo[3], hh[0], hh[1], hh[2], hh[3]};
                oa1 = __builtin_amdgcn_mfma_f32_32x32x16_bf16(fa[s], vf, oa1, 0, 0, 0); ob1 = __builtin_amdgcn_mfma_f32_32x32x16_bf16(fb[s], vf, ob1, 0, 0, 0); } } }
        if (t + 1 < NT) { *(LAS u32x4*)(nbuf + tid * 16) = sk0; if (tid < 256) *(LAS u32x4*)(nbuf + (tid + 512) * 16) = sk1; *(LAS u32x4*)(nbuf + KSLOT + tid * 16) = sv; }
        __syncthreads();
    }
    la += __shfl_xor(la, 32); lb += __shfl_xor(lb, 32);
    if (hi == 0) { wsf[32 + r32] = la; wsf[96 + r32] = lb; }
    LAS bf16_t* stg = (LAS bf16_t*)(lds + L_OST) + wid * 2048;
#pragma unroll
    for (int hf = 0; hf < 2; ++hf) {
#pragma unroll
        for (int r = 0; r < 16; ++r) { const int orow = crow(r, hi); const float rl = __builtin_amdgcn_rcpf(wsf[hf * 64 + 32 + orow]);
            stg[orow * 64 + r32] = f2bf((hf ? ob0[r] : oa0[r]) * rl); stg[orow * 64 + 32 + r32] = f2bf((hf ? ob1[r] : oa1[r]) * rl); }
        asm volatile("" ::: "memory");
        bf16_t* Ow = O + (rowbase + q0 + wid * 64 + hf * 32) * 512 + h * 64;
#pragma unroll
        for (int i = 0; i < 4; ++i) { const int row = i * 8 + (lane >> 3), ch = lane & 7; const u32x4 v = *(const LAS u32x4*)(stg + row * 64 + ch * 8); *(u32x4*)(Ow + (size_t)row * 512 + ch * 8) = v; }
        asm volatile("" ::: "memory");
    }
    asm volatile("s_waitcnt vmcnt(0)" ::: "memory");
    __syncthreads();
    if (tid == 0) __hip_atomic_fetch_add(done_ctr, 1u, __ATOMIC_RELEASE, __HIP_MEMORY_SCOPE_AGENT);
}
}

namespace rwkv {
constexpr int LP = 72, TB = 64 * LP * 2;
constexpr int S_HT0 = 0, S_HT1 = 1, S_A = 2  , S_B = 3  , S_K = 4, S_R = 5, S_BT = 6, S_KT = 7, S_V = 8,
              S_MOFF = 9, S_MAK = 10, S_MRK = 11, S_MRB = 12, S_D = 13, S_ZT = 14, S_ACC = 15, NSLOT = 16;
constexpr int FP = 68;
constexpr int O_ZW = S_K * TB, O_ZA = O_ZW + 64 * FP * 4, O_YB = S_MAK * TB, O_WT = NSLOT * TB, O_CL = O_WT + 8 * 64 * 4, O_CST = O_CL + 64 * 4, O_END = O_CST + 12 * 64 * 4;
static_assert(O_ZA + 64 * FP * 4 <= (S_KT + 1) * TB && O_YB + 64 * FP * 4 <= (S_MRK + 1) * TB, "f32 aliases");
__device__ __forceinline__ s16x4 vtr(const LAS unsigned char* p) { return __builtin_bit_cast(s16x4, __builtin_amdgcn_ds_read_tr16_b64_v4i16((LAS s16x4*)p)); }
struct LaneOff { int bn, bt, bs; };
__device__ __forceinline__ LaneOff lane_off(int fr, int fq) { LaneOff o; o.bn = (fr * LP + 8 * fq) * 2; o.bt = ((8 * fq + (fr >> 2)) * LP + 4 * (fr & 3)) * 2; o.bs = (fr * LP + 4 * fq) * 2; return o; }
__device__ __forceinline__ void relaunder(LaneOff& o) { asm volatile("" : "+v"(o.bn), "+v"(o.bt), "+v"(o.bs)); }
__device__ __forceinline__ bf16x8 frag_t(const LAS unsigned char* tile, int kk, int c0, const LaneOff& o) {
    const LAS unsigned char* q = tile + o.bt + (32 * kk * LP + c0) * 2;
    const s16x4 lo = vtr(q), hi = vtr(q + 4 * LP * 2); return (bf16x8){lo[0], lo[1], lo[2], lo[3], hi[0], hi[1], hi[2], hi[3]};
}
__device__ __forceinline__ bf16x8 frag_n(const LAS unsigned char* tile, int r0, int kk, const LaneOff& o) { return *(const LAS bf16x8*)(tile + o.bn + (r0 * LP + 32 * kk) * 2); }
__device__ __forceinline__ f32x4 MFMA16(bf16x8 a, bf16x8 b, f32x4 c) { return __builtin_amdgcn_mfma_f32_16x16x32_bf16(a, b, c, 0, 0, 0); }
__device__ __forceinline__ void st_tile_T(LAS unsigned char* tile, int m0, int n0, const LaneOff& o, const f32x4 c) {
    u32x2 w; w.x = pk2(c[0], c[1]); w.y = pk2(c[2], c[3]); *(LAS u32x2*)(tile + o.bs + (n0 * LP + m0) * 2) = w;
}
__device__ __forceinline__ void unpack8(const u32x4 w, float (&f)[8]) { f[0] = bflo(w.x); f[1] = bfhi(w.x); f[2] = bflo(w.y); f[3] = bfhi(w.y); f[4] = bflo(w.z); f[5] = bfhi(w.z); f[6] = bflo(w.w); f[7] = bfhi(w.w); }
__device__ __forceinline__ u32x4 pack8(const float (&f)[8]) { u32x4 w; w.x = pk2(f[0], f[1]); w.y = pk2(f[2], f[3]); w.z = pk2(f[4], f[5]); w.w = pk2(f[6], f[7]); return w; }
__device__ __forceinline__ void ld8(const float* p, float (&f)[8]) { const f32x4 a = *(const f32x4*)p, b = *(const f32x4*)(p + 4); f[0] = a[0]; f[1] = a[1]; f[2] = a[2]; f[3] = a[3]; f[4] = b[0]; f[5] = b[1]; f[6] = b[2]; f[7] = b[3]; }
__device__ __forceinline__ void ld8l(const LAS float* p, float (&f)[8]) { const f32x4 a = *(const LAS f32x4*)p, b = *(const LAS f32x4*)(p + 4); f[0] = a[0]; f[1] = a[1]; f[2] = a[2]; f[3] = a[3]; f[4] = b[0]; f[5] = b[1]; f[6] = b[2]; f[7] = b[3]; }
__device__ __forceinline__ float ex2(float x) { return __builtin_amdgcn_exp2f(x); }
constexpr float LOG2E = 1.4426950408889634f, LN2 = 0.6931471805599453f;

__device__ __forceinline__ void rwkv_unit(int l, int b, int h, LAS unsigned char* L) {
    const int tid = opaque_tid(), lane = tid & 63, fr = lane & 15, fq = lane >> 4; const int w = __builtin_amdgcn_readfirstlane(tid >> 6);
    const Params p = load_params();
    const bf16_t* PA = (const bf16_t*)(p.ws + WS_PA); bf16_t* Yout = (bf16_t*)(p.ws + WS_YS) + (size_t)T * 512;
    const int t = tid >> 3, c8 = (tid & 7) * 8;
    const int tw = (lane >> 3);
    const int cw = 16 * (w & 3);
    const float* mu = p.rwkv_mu + l * 1664;
    LaneOff lo = lane_off(fr, fq);
#define SLOT(s) (L + (s) * TB)
    bf16x8 bup[2];
    { const float* U = ((w < 4) ? p.rwkv_w_up : p.rwkv_a_up) + (size_t)l * 64 * 512 + h * 64 + 16 * (w & 3) + fr;
#pragma unroll
      for (int kk = 0; kk < 2; ++kk) { float f[8];
#pragma unroll
          for (int e = 0; e < 8; ++e) f[e] = U[(size_t)(32 * kk + 8 * fq + e) * 512];
          bup[kk] = __builtin_bit_cast(bf16x8, pack8(f)); } }
    for (int e = tid; e < TB / 4; e += 512) { ((LAS unsigned*)SLOT(S_HT0))[e] = 0u; ((LAS unsigned*)SLOT(S_D))[e] = 0u; ((LAS unsigned*)SLOT(S_MOFF))[e] = 0u; ((LAS unsigned*)SLOT(S_MRB))[e] = 0u;
        ((LAS unsigned*)SLOT(S_ZT))[e] = 0u; ((LAS unsigned*)SLOT(S_ACC))[e] = 0u; }
    f32x4 hacc[4];
#pragma unroll
    for (int i = 0; i < 4; ++i) hacc[i] = (f32x4){0.f, 0.f, 0.f, 0.f};
    int hcur = S_HT0, hnxt = S_HT1;
    u32x4 raw[10];
#define RWKV_LOAD(c, t, c8) do { const size_t row_ = (size_t)b * SEQ + (c) * 64 + (t); const bf16_t* s_ = PA + row_ * NA; const bool hp_ = ((c) * 64 + (t)) > 0; const u32x4 z_ = {0u, 0u, 0u, 0u}; \
        raw[0] = *(const u32x4*)(s_ + RW_R + h * 64 + c8); raw[1] = hp_ ? *(const u32x4*)(s_ - NA + RW_R + h * 64 + c8) : z_; \
        raw[2] = *(const u32x4*)(s_ + RW_K + h * 64 + c8); raw[3] = hp_ ? *(const u32x4*)(s_ - NA + RW_K + h * 64 + c8) : z_; \
        raw[4] = *(const u32x4*)(s_ + RW_V + h * 64 + c8); raw[5] = hp_ ? *(const u32x4*)(s_ - NA + RW_V + h * 64 + c8) : z_; \
        raw[6] = *(const u32x4*)(s_ + RW_LW + c8); raw[7] = hp_ ? *(const u32x4*)(s_ - NA + RW_LW + c8) : z_; \
        raw[8] = *(const u32x4*)(s_ + RW_LA + c8); raw[9] = hp_ ? *(const u32x4*)(s_ - NA + RW_LA + c8) : z_; } while (0)
    for (int e = tid; e < 12 * 64; e += 512) { const int rw_ = e >> 6, i_ = e & 63; const int hci = l * 512 + h * 64 + i_; float val;
        switch (rw_) { case 0: val = mu[h * 64 + i_]; break; case 1: val = mu[512 + h * 64 + i_]; break; case 2: val = mu[1024 + h * 64 + i_]; break; case 3: val = mu[1536 + i_]; break; case 4: val = mu[1600 + i_]; break;
            case 5: val = p.rwkv_w0[hci]; break; case 6: val = p.rwkv_a0[hci]; break; case 7: val = p.rwkv_k_k[hci]; break; case 8: val = p.rwkv_k_a[hci]; break; case 9: val = p.rwkv_r_k[hci]; break;
            case 10: val = p.rwkv_ln_w[hci]; break; default: val = p.rwkv_ln_b[hci]; break; }
        ((LAS float*)(L + O_CST))[e] = val; }
    RWKV_LOAD(0, t, c8);
    __syncthreads();
    for (int c = 0; c < SEQ / 64; ++c) {
        int c8v = c8, tv = t, frv = fr, fqv = fq; asm volatile("" : "+v"(c8v), "+v"(tv), "+v"(frv), "+v"(fqv));
        const int twv = tv & 7;
        float r[8], kraw[8], v[8];
        { float cu[8], pr[8], m8[8], o[8];
          unpack8(raw[0], cu); unpack8(raw[1], pr); ld8l((const LAS float*)(L + O_CST) + 0 * 64 + c8v, m8);
#pragma unroll
          for (int e = 0; e < 8; ++e) r[e] = cu[e] + (pr[e] - cu[e]) * m8[e];
          unpack8(raw[2], cu); unpack8(raw[3], pr); ld8l((const LAS float*)(L + O_CST) + 1 * 64 + c8v, m8);
#pragma unroll
          for (int e = 0; e < 8; ++e) kraw[e] = cu[e] + (pr[e] - cu[e]) * m8[e];
          unpack8(raw[4], cu); unpack8(raw[5], pr); ld8l((const LAS float*)(L + O_CST) + 2 * 64 + c8v, m8);
#pragma unroll
          for (int e = 0; e < 8; ++e) v[e] = cu[e] + (pr[e] - cu[e]) * m8[e];
          unpack8(raw[6], cu); unpack8(raw[7], pr); ld8l((const LAS float*)(L + O_CST) + 3 * 64 + c8v, m8);
#pragma unroll
          for (int e = 0; e < 8; ++e) { const float x = cu[e] + (pr[e] - cu[e]) * m8[e]; o[e] = 1.0f - 2.0f * __builtin_amdgcn_rcpf(ex2(x * (2.0f * LOG2E)) + 1.0f); }
          *(LAS u32x4*)(SLOT(S_A) + (tv * LP + c8v) * 2) = pack8(o);
          unpack8(raw[8], cu); unpack8(raw[9], pr); ld8l((const LAS float*)(L + O_CST) + 4 * 64 + c8v, m8);
#pragma unroll
          for (int e = 0; e < 8; ++e) o[e] = cu[e] + (pr[e] - cu[e]) * m8[e];
          *(LAS u32x4*)(SLOT(S_B) + (tv * LP + c8v) * 2) = pack8(o); }
        __syncthreads();
        relaunder(lo);
#ifdef U_P2
        { const LAS unsigned char* X = (w < 4) ? SLOT(S_A) : SLOT(S_B); LAS float* Z = (LAS float*)(L + ((w < 4) ? O_ZW : O_ZA));
          f32x4 zacc[4];
#pragma unroll
          for (int m = 0; m < 4; ++m) { f32x4 a = {0.f, 0.f, 0.f, 0.f};
#pragma unroll
              for (int kk = 0; kk < 2; ++kk) a = MFMA16(frag_n(X, 16 * m, kk, lo), bup[kk], a);
              zacc[m] = a; }
#pragma unroll
          for (int m = 0; m < 4; ++m)
#pragma unroll
              for (int rr = 0; rr < 4; ++rr) Z[(16 * m + 4 * fqv + rr) * FP + cw + frv] = zacc[m][rr]; }
#else
        { const LAS unsigned char* X = (w < 4) ? SLOT(S_A) : SLOT(S_B); LAS float* Z = (LAS float*)(L + ((w < 4) ? O_ZW : O_ZA));
#pragma unroll
          for (int m = 0; m < 4; ++m) { f32x4 a = {0.f, 0.f, 0.f, 0.f};
#pragma unroll
              for (int kk = 0; kk < 2; ++kk) a = MFMA16(frag_n(X, 16 * m, kk, lo), bup[kk], a);
#pragma unroll
              for (int rr = 0; rr < 4; ++rr) Z[(16 * m + 4 * fqv + rr) * FP + cw + frv] = a[rr]; } }
#endif
        __syncthreads();
        float kk_[8], kp[8], bb[8], lw[8], cs[8], cb;
        { float zw[8], za[8], c0[8], c1[8];
          ld8l((const LAS float*)(L + O_ZW) + tv * FP + c8v, zw); ld8l((const LAS float*)(L + O_ZA) + tv * FP + c8v, za);
          ld8l((const LAS float*)(L + O_CST) + 5 * 64 + c8v, c0); ld8l((const LAS float*)(L + O_CST) + 6 * 64 + c8v, c1);
          float av[8];
#pragma unroll
          for (int e = 0; e < 8; ++e) { const float x = -(zw[e] + c0[e]); const float sp = fmaxf(x, 0.f) + LN2 * __builtin_amdgcn_logf(1.0f + ex2(-fabsf(x) * LOG2E));
              lw[e] = -LOG2E * ex2((-sp - 0.5f) * LOG2E);
              av[e] = __builtin_amdgcn_rcpf(1.0f + ex2(-(za[e] + c1[e]) * LOG2E)); }
          ld8l((const LAS float*)(L + O_CST) + 7 * 64 + c8v, c0); ld8l((const LAS float*)(L + O_CST) + 8 * 64 + c8v, c1);
          float ss = 0.f;
#pragma unroll
          for (int e = 0; e < 8; ++e) { kk_[e] = kraw[e] * c0[e]; ss += kk_[e] * kk_[e]; kp[e] = kraw[e] * (1.0f + (av[e] - 1.0f) * c1[e]); }
          ss = sum8(ss);
          const float inv = 1.0f / fmaxf(sqrtf(ss), 1e-12f);
          ld8l((const LAS float*)(L + O_CST) + 9 * 64 + c8v, c0);
          float cp = 0.f;
#pragma unroll
          for (int e = 0; e < 8; ++e) { kk_[e] *= inv; bb[e] = kk_[e] * av[e]; cp += r[e] * kp[e] * c0[e]; }
          cb = sum8(cp);
#pragma unroll
          for (int e = 0; e < 8; ++e) { float x = lw[e];
              float y = __shfl_up(x, 8); if (twv >= 1) x += y;
              y = __shfl_up(x, 16); if (twv >= 2) x += y;
              y = __shfl_up(x, 32); if (twv >= 4) x += y;
              cs[e] = x; }
          if (twv == 7) { LAS float* WT = (LAS float*)(L + O_WT) + w * 64 + c8v;
#pragma unroll
              for (int e = 0; e < 8; ++e) WT[e] = cs[e]; } }
        __syncthreads();
        { float off[8], tot[8];
#pragma unroll
          for (int e = 0; e < 8; ++e) { off[e] = 0.f; tot[e] = 0.f; }
#pragma unroll
          for (int g = 0; g < 8; ++g) { float x[8]; ld8l((const LAS float*)(L + O_WT) + g * 64 + c8v, x);
#pragma unroll
              for (int e = 0; e < 8; ++e) { if (g < w) off[e] += x[e]; tot[e] += x[e]; } }
          if (tv == 0) { LAS float* CL = (LAS float*)(L + O_CL) + c8v;
#pragma unroll
              for (int e = 0; e < 8; ++e) CL[e] = tot[e]; }
          float o[8], en[8], ep[8]; const int toff = (tv * LP + c8v) * 2;
#pragma unroll
          for (int e = 0; e < 8; ++e) { cs[e] += off[e]; en[e] = ex2(-cs[e]); ep[e] = __builtin_amdgcn_rcpf(en[e]); o[e] = -kk_[e] * ep[e] * ex2(-lw[e]); }
          *(LAS u32x4*)(SLOT(S_A) + toff) = pack8(o);
#pragma unroll
          for (int e = 0; e < 8; ++e) o[e] = bb[e] * en[e];
          *(LAS u32x4*)(SLOT(S_B) + toff) = pack8(o);
#pragma unroll
          for (int e = 0; e < 8; ++e) o[e] = kp[e] * en[e];
          *(LAS u32x4*)(SLOT(S_K) + toff) = pack8(o);
#pragma unroll
          for (int e = 0; e < 8; ++e) o[e] = r[e] * ep[e];
          *(LAS u32x4*)(SLOT(S_R) + toff) = pack8(o);
#pragma unroll
          for (int e = 0; e < 8; ++e) { en[e] = ex2(tot[e] - cs[e]); o[e] = bb[e] * en[e]; }
          *(LAS u32x4*)(SLOT(S_BT) + toff) = pack8(o);
#pragma unroll
          for (int e = 0; e < 8; ++e) o[e] = kp[e] * en[e];
          *(LAS u32x4*)(SLOT(S_KT) + toff) = pack8(o);
          *(LAS u32x4*)(SLOT(S_V) + toff) = pack8(v); }
        __syncthreads();
        relaunder(lo);
        int wv = w; asm volatile("" : "+s"(wv));
#ifdef U_P4
        f32x4 tacc[5];
#pragma unroll
        for (int it = 0; it < 5; ++it) { const int task = wv + 8 * it; f32x4 a = {0.f, 0.f, 0.f, 0.f};
            if (task < 36) {
                int q, mn;
                if (task < 6) { q = 0; mn = (int)((0xEDC984ull >> (4 * task)) & 0xF); }
                else { q = 1 + (task - 6) / 10; mn = (int)((0xFEDCA98540ull >> (4 * ((task - 6) % 10))) & 0xF); }
                const int m0 = 16 * (mn >> 2), n0 = 16 * (mn & 3);
                const LAS unsigned char* XA = (q < 2) ? SLOT(S_A) : SLOT(S_R); const LAS unsigned char* XB = (q & 1) ? SLOT(S_K) : SLOT(S_B);
#pragma unroll
                for (int kk = 0; kk < 2; ++kk) a = MFMA16(frag_n(XA, m0, kk, lo), frag_n(XB, n0, kk, lo), a);
                if (m0 == n0) {
#pragma unroll
                    for (int rr = 0; rr < 4; ++rr) { const bool keep = (q < 2) ? (frv < 4 * fqv + rr) : (frv <= 4 * fqv + rr); a[rr] = keep ? a[rr] : 0.f; } } }
            tacc[it] = a; }
        if (wv < 4) {
            f32x4 a = {0.f, 0.f, 0.f, 0.f};
#pragma unroll
            for (int kk = 0; kk < 2; ++kk) a = MFMA16(frag_n(SLOT(S_A), 16 * wv, kk, lo), frag_n(SLOT(S_B), 16 * wv, kk, lo), a);
#pragma unroll
            for (int rr = 0; rr < 4; ++rr) a[rr] = (frv < 4 * fqv + rr) ? a[rr] : 0.f;
            float x[16];
            { LAS float* NS = (LAS float*)(SLOT(hnxt) + wv * 1024);
#pragma unroll
              for (int rr = 0; rr < 4; ++rr) NS[(4 * fqv + rr) * 16 + frv] = a[rr];
              asm volatile("s_waitcnt lgkmcnt(0)" ::: "memory");
#pragma unroll
              for (int rw = 0; rw < 16; ++rw) { float s = (rw == frv) ? 1.f : 0.f;
#pragma unroll
                  for (int sc = 0; sc < rw; ++sc) s += NS[rw * 16 + sc] * x[sc];
                  x[rw] = s; }
              asm volatile("s_waitcnt lgkmcnt(0)" ::: "memory"); }
            if (fqv == 0) { LAS unsigned char* dp = SLOT(S_D) + ((16 * wv + frv) * LP + 16 * wv) * 2;
                float lo8[8], hi8[8];
#pragma unroll
                for (int e = 0; e < 8; ++e) { lo8[e] = x[e]; hi8[e] = x[8 + e]; }
                *(LAS u32x4*)dp = pack8(lo8); *(LAS u32x4*)(dp + 16) = pack8(hi8); }
        }
#pragma unroll
        for (int it = 0; it < 6; ++it) { const int task = wv + 8 * it;
            if (task < 36) {
                int q, mn;
                if (task < 6) { q = 0; mn = (int)((0xEDC984ull >> (4 * task)) & 0xF); }
                else { q = 1 + (task - 6) / 10; mn = (int)((0xFEDCA98540ull >> (4 * ((task - 6) % 10))) & 0xF); }
                st_tile_T(SLOT((q == 0) ? S_MOFF : (q == 1) ? S_MAK : (q == 2) ? S_MRB : S_MRK), 16 * (mn >> 2), 16 * (mn & 3), lo, tacc[it < 5 ? it : 4]);
            } else if (task < 48) {
                const int z = task - 36; const int mn = (int)((0xB76321ull >> (4 * (z % 6))) & 0xF);
                st_tile_T(SLOT((z < 6) ? S_MAK : S_MRK), 16 * (mn >> 2), 16 * (mn & 3), lo, (f32x4){0.f, 0.f, 0.f, 0.f});
            } }
#else
        if (wv < 4) {
            f32x4 a = {0.f, 0.f, 0.f, 0.f};
#pragma unroll
            for (int kk = 0; kk < 2; ++kk) a = MFMA16(frag_n(SLOT(S_A), 16 * wv, kk, lo), frag_n(SLOT(S_B), 16 * wv, kk, lo), a);
#pragma unroll
            for (int rr = 0; rr < 4; ++rr) a[rr] = (frv < 4 * fqv + rr) ? a[rr] : 0.f;
            float x[16];
            { LAS float* NS = (LAS float*)(SLOT(hnxt) + wv * 1024);
#pragma unroll
              for (int rr = 0; rr < 4; ++rr) NS[(4 * fqv + rr) * 16 + frv] = a[rr];
              asm volatile("s_waitcnt lgkmcnt(0)" ::: "memory");
#pragma unroll
              for (int rw = 0; rw < 16; ++rw) { float s = (rw == frv) ? 1.f : 0.f;
#pragma unroll
                  for (int sc = 0; sc < rw; ++sc) s += NS[rw * 16 + sc] * x[sc];
                  x[rw] = s; }
              asm volatile("s_waitcnt lgkmcnt(0)" ::: "memory"); }
            if (fqv == 0) { LAS unsigned char* dp = SLOT(S_D) + ((16 * wv + frv) * LP + 16 * wv) * 2;
                float lo8[8], hi8[8];
#pragma unroll
                for (int e = 0; e < 8; ++e) { lo8[e] = x[e]; hi8[e] = x[8 + e]; }
                *(LAS u32x4*)dp = pack8(lo8); *(LAS u32x4*)(dp + 16) = pack8(hi8); }
        }
#pragma unroll
        for (int it = 0; it < 6; ++it) { const int task = wv + 8 * it;
            if (task < 36) {
                int q, mn;
                if (task < 6) { q = 0; mn = (int)((0xEDC984ull >> (4 * task)) & 0xF); }
                else { q = 1 + (task - 6) / 10; mn = (int)((0xFEDCA98540ull >> (4 * ((task - 6) % 10))) & 0xF); }
                const int m0 = 16 * (mn >> 2), n0 = 16 * (mn & 3);
                const LAS unsigned char* XA = (q < 2) ? SLOT(S_A) : SLOT(S_R); const LAS unsigned char* XB = (q & 1) ? SLOT(S_K) : SLOT(S_B);
                f32x4 a = {0.f, 0.f, 0.f, 0.f};
#pragma unroll
                for (int kk = 0; kk < 2; ++kk) a = MFMA16(frag_n(XA, m0, kk, lo), frag_n(XB, n0, kk, lo), a);
                if (m0 == n0) {
#pragma unroll
                    for (int rr = 0; rr < 4; ++rr) { const bool keep = (q < 2) ? (frv < 4 * fqv + rr) : (frv <= 4 * fqv + rr); a[rr] = keep ? a[rr] : 0.f; } }
                st_tile_T(SLOT((q == 0) ? S_MOFF : (q == 1) ? S_MAK : (q == 2) ? S_MRB : S_MRK), m0, n0, lo, a);
            } else if (task < 48) {
                const int z = task - 36; const int mn = (int)((0xB76321ull >> (4 * (z % 6))) & 0xF);
                st_tile_T(SLOT((z < 6) ? S_MAK : S_MRK), 16 * (mn >> 2), 16 * (mn & 3), lo, (f32x4){0.f, 0.f, 0.f, 0.f});
            } }
#endif
        __syncthreads();
        relaunder(lo);
        f32x4 yacc[4];
#ifdef U_P5
        if (w < 4) {
            f32x4 xr[4];
#pragma unroll
            for (int i = 0; i < 4; ++i) { f32x4 a = {0.f, 0.f, 0.f, 0.f};
#pragma unroll
                for (int kk = 0; kk < 2; ++kk) { if (32 * kk < 16 * i + 16) a = MFMA16(frag_t(SLOT(S_MAK), kk, 16 * i, lo), frag_t(SLOT(S_V), kk, cw, lo), a);
                    a = MFMA16(frag_n(SLOT(S_A), 16 * i, kk, lo), frag_n(SLOT(hcur), cw, kk, lo), a); }
                xr[i] = a; }
#pragma unroll
            for (int i = 0; i < 4; ++i) { f32x4 a = xr[i];
#pragma unroll
                for (int kk = 0; kk < 2; ++kk) if (32 * kk < 16 * i) a = MFMA16(frag_t(SLOT(S_MOFF), kk, 16 * i, lo), frag_n(SLOT(S_ZT), cw, kk, lo), a);
                st_tile_T(SLOT(S_ACC), 16 * i, cw, lo, a);
                asm volatile("" ::: "memory");
                const f32x4 z = MFMA16(frag_t(SLOT(S_D), i >> 1, 16 * i, lo), frag_n(SLOT(S_ACC), cw, i >> 1, lo), (f32x4){0.f, 0.f, 0.f, 0.f});
                st_tile_T(SLOT(S_ZT), 16 * i, cw, lo, z);
                asm volatile("" ::: "memory"); }
#else
        if (w < 4) {
#pragma unroll
            for (int i = 0; i < 4; ++i) { f32x4 a = {0.f, 0.f, 0.f, 0.f};
#pragma unroll
                for (int kk = 0; kk < 2; ++kk) { if (32 * kk < 16 * i + 16) a = MFMA16(frag_t(SLOT(S_MAK), kk, 16 * i, lo), frag_t(SLOT(S_V), kk, cw, lo), a);
                    a = MFMA16(frag_n(SLOT(S_A), 16 * i, kk, lo), frag_n(SLOT(hcur), cw, kk, lo), a); }
#pragma unroll
                for (int kk = 0; kk < 2; ++kk) if (32 * kk < 16 * i) a = MFMA16(frag_t(SLOT(S_MOFF), kk, 16 * i, lo), frag_n(SLOT(S_ZT), cw, kk, lo), a);
                st_tile_T(SLOT(S_ACC), 16 * i, cw, lo, a);
                const f32x4 z = MFMA16(frag_t(SLOT(S_D), i >> 1, 16 * i, lo), frag_n(SLOT(S_ACC), cw, i >> 1, lo), (f32x4){0.f, 0.f, 0.f, 0.f});
                st_tile_T(SLOT(S_ZT), 16 * i, cw, lo, z); }
#endif
        } else {
#pragma unroll
            for (int i = 0; i < 4; ++i) { f32x4 a = {0.f, 0.f, 0.f, 0.f};
#pragma unroll
                for (int kk = 0; kk < 2; ++kk) { if (32 * kk < 16 * i + 16) a = MFMA16(frag_t(SLOT(S_MRK), kk, 16 * i, lo), frag_t(SLOT(S_V), kk, cw, lo), a);
                    a = MFMA16(frag_n(SLOT(S_R), 16 * i, kk, lo), frag_n(SLOT(hcur), cw, kk, lo), a);
                }
                yacc[i] = a; }
        }
        __syncthreads();
        relaunder(lo);
        if (c + 1 < SEQ / 64) RWKV_LOAD(c + 1, tv, c8v);
#ifdef U_P7
        if (w >= 4) {
#pragma unroll
            for (int i = 0; i < 4; ++i) {
#pragma unroll
                for (int rr = 0; rr < 4; ++rr) hacc[i][rr] = hacc[i][rr] * ex2(((const LAS float*)(L + O_CL))[16 * i + 4 * fqv + rr]);
#pragma unroll
                for (int kk = 0; kk < 2; ++kk) { hacc[i] = MFMA16(frag_t(SLOT(S_KT), kk, 16 * i, lo), frag_t(SLOT(S_V), kk, cw, lo), hacc[i]);
                    hacc[i] = MFMA16(frag_t(SLOT(S_BT), kk, 16 * i, lo), frag_n(SLOT(S_ZT), cw, kk, lo), hacc[i]); }
#pragma unroll
                for (int kk = 0; kk < 2; ++kk) if (32 * kk < 16 * i + 16) yacc[i] = MFMA16(frag_t(SLOT(S_MRB), kk, 16 * i, lo), frag_n(SLOT(S_ZT), cw, kk, lo), yacc[i]); }
#pragma unroll
            for (int i = 0; i < 4; ++i) { st_tile_T(SLOT(hnxt), 16 * i, cw, lo, hacc[i]);
#pragma unroll
                for (int rr = 0; rr < 4; ++rr) ((LAS float*)(L + O_YB))[(16 * i + 4 * fqv + rr) * FP + cw + frv] = yacc[i][rr]; }
        }
#else
        if (w >= 4) {
#pragma unroll
            for (int i = 0; i < 4; ++i) {
#pragma unroll
                for (int rr = 0; rr < 4; ++rr) hacc[i][rr] = hacc[i][rr] * ex2(((const LAS float*)(L + O_CL))[16 * i + 4 * fqv + rr]);
#pragma unroll
                for (int kk = 0; kk < 2; ++kk) { hacc[i] = MFMA16(frag_t(SLOT(S_KT), kk, 16 * i, lo), frag_t(SLOT(S_V), kk, cw, lo), hacc[i]);
                    hacc[i] = MFMA16(frag_t(SLOT(S_BT), kk, 16 * i, lo), frag_n(SLOT(S_ZT), cw, kk, lo), hacc[i]); }
                st_tile_T(SLOT(hnxt), 16 * i, cw, lo, hacc[i]);
#pragma unroll
                for (int kk = 0; kk < 2; ++kk) if (32 * kk < 16 * i + 16) yacc[i] = MFMA16(frag_t(SLOT(S_MRB), kk, 16 * i, lo), frag_n(SLOT(S_ZT), cw, kk, lo), yacc[i]);
#pragma unroll
                for (int rr = 0; rr < 4; ++rr) ((LAS float*)(L + O_YB))[(16 * i + 4 * fqv + rr) * FP + cw + frv] = yacc[i][rr]; }
        }
#endif
        __syncthreads();
        { float y[8], g0[8], g1[8]; ld8l((const LAS float*)(L + O_YB) + tv * FP + c8v, y); ld8l((const LAS float*)(L + O_CST) + 10 * 64 + c8v, g0); ld8l((const LAS float*)(L + O_CST) + 11 * 64 + c8v, g1);
          float s = 0.f;
#pragma unroll
          for (int e = 0; e < 8; ++e) s += y[e];
          const float mean = sum8(s) * (1.f / 64.f); float q = 0.f;
#pragma unroll
          for (int e = 0; e < 8; ++e) { y[e] -= mean; q += y[e] * y[e]; }
          const float rs = rsqrtf(sum8(q) * (1.f / 64.f) + RWKV_GN_EPS);
#pragma unroll
          for (int e = 0; e < 8; ++e) y[e] = y[e] * rs * g0[e] + g1[e] + cb * v[e];
          *(u32x4*)(Yout + ((size_t)b * SEQ + c * 64 + tv) * 512 + h * 64 + c8v) = pack8(y); }
        { const int tmp = hcur; hcur = hnxt; hnxt = tmp; }
    }
    __syncthreads();
#undef SLOT
#undef RWKV_LOAD
}
}

namespace gla {
using rwkv::vtr; using rwkv::unpack8; using rwkv::pack8; using rwkv::ld8l; using rwkv::ex2; using rwkv::LOG2E; using rwkv::LN2; using rwkv::MFMA16;
constexpr int LP = 72, VP = 136, TB = 64 * LP * 2;
constexpr int B_QH = 0, B_KH = TB, B_KT = 2 * TB, B_PT = 3 * TB, B_VV = 4 * TB, B_ST = B_VV + 64 * VP * 2, B_OB = B_ST + 128 * LP * 2, B_WT = B_OB + 64 * 132 * 4,
              B_CL = B_WT + 8 * 64 * 4, B_AUP = B_CL + 64 * 4, B_AB = B_AUP + 16 * 64 * 4, B_GN = B_AB + 64 * 4, B_END = B_GN + 128 * 4;
static_assert(B_END <= 131072, "gla lds");
struct LaneOff { int bn, bt, btv, bs; };
__device__ __forceinline__ LaneOff lane_off(int fr, int fq) { LaneOff o; o.bn = (fr * LP + 8 * fq) * 2; o.bt = ((8 * fq + (fr >> 2)) * LP + 4 * (fr & 3)) * 2; o.btv = ((8 * fq + (fr >> 2)) * VP + 4 * (fr & 3)) * 2; o.bs = (fr * LP + 4 * fq) * 2; return o; }
__device__ __forceinline__ void relaunder(LaneOff& o) { asm volatile("" : "+v"(o.bn), "+v"(o.bt), "+v"(o.btv), "+v"(o.bs)); }
__device__ __forceinline__ bf16x8 frag_t(const LAS unsigned char* tile, int kk, int c0, const LaneOff& o) {
    const LAS unsigned char* q = tile + o.bt + (32 * kk * LP + c0) * 2; const s16x4 lo = vtr(q), hi = vtr(q + 4 * LP * 2); return (bf16x8){lo[0], lo[1], lo[2], lo[3], hi[0], hi[1], hi[2], hi[3]}; }
__device__ __forceinline__ bf16x8 frag_tv(const LAS unsigned char* tile, int kk, int c0, const LaneOff& o) {
    const LAS unsigned char* q = tile + o.btv + (32 * kk * VP + c0) * 2; const s16x4 lo = vtr(q), hi = vtr(q + 4 * VP * 2); return (bf16x8){lo[0], lo[1], lo[2], lo[3], hi[0], hi[1], hi[2], hi[3]}; }
__device__ __forceinline__ bf16x8 frag_n(const LAS unsigned char* tile, int r0, int kk, const LaneOff& o) { return *(const LAS bf16x8*)(tile + o.bn + (r0 * LP + 32 * kk) * 2); }
__device__ __forceinline__ void st_tile_T(LAS unsigned char* tile, int m0, int n0, const LaneOff& o, const f32x4 c) { u32x2 w; w.x = pk2(c[0], c[1]); w.y = pk2(c[2], c[3]); *(LAS u32x2*)(tile + o.bs + (n0 * LP + m0) * 2) = w; }

__device__ __forceinline__ void gla_unit(int l, int b, int h, LAS unsigned char* L, unsigned* done_ctr) {
    const Params p = load_params();
    const bf16_t* PA = (const bf16_t*)(p.ws + WS_PA); bf16_t* Yout = (bf16_t*)(p.ws + WS_YS) + (size_t)2 * T * 512;
    const int tid = opaque_tid(), lane = tid & 63, fr = lane & 15, fq = lane >> 4; const int w = __builtin_amdgcn_readfirstlane(tid >> 6);
    const int t = tid >> 3, c8 = (tid & 7) * 8;
    LaneOff lo = lane_off(fr, fq);
    for (int e = tid; e < 16 * 64; e += 512) ((LAS float*)(L + B_AUP))[e] = p.gla_a_up[(size_t)l * 16 * 256 + (e >> 6) * 256 + h * 64 + (e & 63)];
    if (tid < 64) ((LAS float*)(L + B_AB))[tid] = p.gla_a_b[l * 256 + h * 64 + tid];
    if (tid < 128) ((LAS float*)(L + B_GN))[tid] = p.gla_norm[l * 512 + h * 128 + tid];
    for (int e = tid; e < 128 * LP / 2; e += 512) ((LAS unsigned*)(L + B_ST))[e] = 0u;
    for (int e = tid; e < TB / 4; e += 512) ((LAS unsigned*)(L + B_PT))[e] = 0u;
    f32x4 sacc[4];
#pragma unroll
    for (int m = 0; m < 4; ++m) sacc[m] = (f32x4){0.f, 0.f, 0.f, 0.f};
    u32x4 rq, rk, rv0, rv1, rl0, rl1;
#define GLA_LOAD(c) do { const bf16_t* s_ = PA + ((size_t)b * SEQ + (c) * 64 + t) * NA; rq = *(const u32x4*)(s_ + GQ + h * 64 + c8); rk = *(const u32x4*)(s_ + GK + h * 64 + c8); \
        rv0 = *(const u32x4*)(s_ + GV + h * 128 + 2 * c8); rv1 = *(const u32x4*)(s_ + GV + h * 128 + 2 * c8 + 8); rl0 = *(const u32x4*)(s_ + GLAT); rl1 = *(const u32x4*)(s_ + GLAT + 8); } while (0)
    GLA_LOAD(0);
    __syncthreads();
    for (int c = 0; c < SEQ / 64; ++c) {
        int c8v = c8, tv = t, frv = fr, fqv = fq; asm volatile("" : "+v"(c8v), "+v"(tv), "+v"(frv), "+v"(fqv));
        const int twv = tv & 7;
        float cs[8];
        { float lat[16]; { float a8[8]; unpack8(rl0, a8);
#pragma unroll
              for (int j = 0; j < 8; ++j) lat[j] = a8[j];
              unpack8(rl1, a8);
#pragma unroll
              for (int j = 0; j < 8; ++j) lat[8 + j] = a8[j]; }
          float z[8]; ld8l((const LAS float*)(L + B_AB) + c8v, z);
#pragma unroll
          for (int j = 0; j < 16; ++j) { float a8[8]; ld8l((const LAS float*)(L + B_AUP) + j * 64 + c8v, a8);
#pragma unroll
              for (int e = 0; e < 8; ++e) z[e] += lat[j] * a8[e]; }
#pragma unroll
          for (int e = 0; e < 8; ++e) { const float x = -z[e]; const float sp = fmaxf(x, 0.f) + LN2 * __builtin_amdgcn_logf(1.0f + ex2(-fabsf(x) * LOG2E));
              float v_ = -sp * (LOG2E / 16.0f);
              float y = __shfl_up(v_, 8); if (twv >= 1) v_ += y;
              y = __shfl_up(v_, 16); if (twv >= 2) v_ += y;
              y = __shfl_up(v_, 32); if (twv >= 4) v_ += y;
              cs[e] = v_; }
          if (twv == 7) { LAS float* WT = (LAS float*)(L + B_WT) + w * 64 + c8v;
#pragma unroll
              for (int e = 0; e < 8; ++e) WT[e] = cs[e]; } }
        __syncthreads();
        { float off[8], tot[8];
#pragma unroll
          for (int e = 0; e < 8; ++e) { off[e] = 0.f; tot[e] = 0.f; }
#pragma unroll
          for (int g = 0; g < 8; ++g) { float x[8]; ld8l((const LAS float*)(L + B_WT) + g * 64 + c8v, x);
#pragma unroll
              for (int e = 0; e < 8; ++e) { if (g < w) off[e] += x[e]; tot[e] += x[e]; } }
          if (tv == 0) { LAS float* CL = (LAS float*)(L + B_CL) + c8v;
#pragma unroll
              for (int e = 0; e < 8; ++e) CL[e] = tot[e]; }
          float q8[8], k8[8], o[8], en[8]; unpack8(rq, q8); unpack8(rk, k8); const int toff = (tv * LP + c8v) * 2;
#pragma unroll
          for (int e = 0; e < 8; ++e) { cs[e] += off[e]; en[e] = ex2(-cs[e]); o[e] = q8[e] * 0.125f * __builtin_amdgcn_rcpf(en[e]); }
          *(LAS u32x4*)(L + B_QH + toff) = pack8(o);
#pragma unroll
          for (int e = 0; e < 8; ++e) o[e] = k8[e] * en[e];
          *(LAS u32x4*)(L + B_KH + toff) = pack8(o);
#pragma unroll
          for (int e = 0; e < 8; ++e) o[e] = k8[e] * ex2(tot[e] - cs[e]);
          *(LAS u32x4*)(L + B_KT + toff) = pack8(o);
          *(LAS u32x4*)(L + B_VV + (tv * VP + 2 * c8v) * 2) = rv0; *(LAS u32x4*)(L + B_VV + (tv * VP + 2 * c8v + 8) * 2) = rv1; }
        if (c + 1 < SEQ / 64) GLA_LOAD(c + 1);
        __syncthreads();
        relaunder(lo);
        { const int m0 = 16 * (w >> 1);
#pragma unroll
          for (int nn = 0; nn < 2; ++nn) { const int n0 = 32 * (w & 1) + 16 * nn;
              if (n0 <= m0) { f32x4 a = {0.f, 0.f, 0.f, 0.f};
#pragma unroll
                  for (int kk = 0; kk < 2; ++kk) a = MFMA16(frag_n(L + B_QH, m0, kk, lo), frag_n(L + B_KH, n0, kk, lo), a);
                  if (n0 == m0) {
#pragma unroll
                      for (int rr = 0; rr < 4; ++rr) a[rr] = (frv <= 4 * fqv + rr) ? a[rr] : 0.f; }
                  st_tile_T(L + B_PT, m0, n0, lo, a); } } }
        __syncthreads();
        relaunder(lo);
        { const int n0 = 16 * w;
#pragma unroll
          for (int m = 0; m < 4; ++m) { f32x4 a = {0.f, 0.f, 0.f, 0.f};
#pragma unroll
              for (int kk = 0; kk < 2; ++kk) { if (32 * kk < 16 * m + 16) a = MFMA16(frag_t(L + B_PT, kk, 16 * m, lo), frag_tv(L + B_VV, kk, n0, lo), a);
                  a = MFMA16(frag_n(L + B_QH, 16 * m, kk, lo), frag_n(L + B_ST, n0, kk, lo), a); }
#pragma unroll
              for (int rr = 0; rr < 4; ++rr) ((LAS float*)(L + B_OB))[(16 * m + 4 * fqv + rr) * 132 + n0 + frv] = a[rr]; }
          asm volatile("" ::: "memory");
#pragma unroll
          for (int m = 0; m < 4; ++m) { f32x4 a = sacc[m];
#pragma unroll
              for (int rr = 0; rr < 4; ++rr) a[rr] *= ex2(((const LAS float*)(L + B_CL))[16 * m + 4 * fqv + rr]);
#pragma unroll
              for (int kk = 0; kk < 2; ++kk) a = MFMA16(frag_t(L + B_KT, kk, 16 * m, lo), frag_tv(L + B_VV, kk, n0, lo), a);
              sacc[m] = a; st_tile_T(L + B_ST, 16 * m, n0, lo, a); } }
        __syncthreads();
        { float v0[8], v1[8], g0[8], g1[8]; float ss = 0.f; const LAS float* ob = (const LAS float*)(L + B_OB) + tv * 132 + 2 * c8v;
          ld8l(ob, v0); ld8l(ob + 8, v1);
#pragma unroll
          for (int e = 0; e < 8; ++e) ss += v0[e] * v0[e] + v1[e] * v1[e];
          ss = sum8(ss);
          const float rstd = rsqrtf(ss * (1.f / 128.f) + NORM_EPS);
          ld8l((const LAS float*)(L + B_GN) + 2 * c8v, g0); ld8l((const LAS float*)(L + B_GN) + 2 * c8v + 8, g1);
          float o0[8], o1[8];
#pragma unroll
          for (int e = 0; e < 8; ++e) { o0[e] = v0[e] * rstd * g0[e]; o1[e] = v1[e] * rstd * g1[e]; }
          bf16_t* dst = Yout + ((size_t)b * SEQ + c * 64 + tv) * 512 + h * 128 + 2 * c8v;
          *(u32x4*)dst = pack8(o0); *(u32x4*)(dst + 8) = pack8(o1); }
    }
    asm volatile("s_waitcnt vmcnt(0)" ::: "memory");
    __syncthreads();
    if (tid == 0) __hip_atomic_fetch_add(done_ctr, 1u, __ATOMIC_RELEASE, __HIP_MEMORY_SCOPE_AGENT);
#undef GLA_LOAD
}
}

#define XB_TMO      128
#define XB_XCNT(j)  (256  + 64 * (j))
#define XB_XSUB(j)  (1280 + 64 * (j))
#define XB_XGEN(j)  (2304 + 64 * (j))
#define XB_TOP      3328
#define XB_TOPGEN   3392
#define XCD_BAR_WORDS 3456
#define XB_SPIN_CAP (1u << 18)

__device__ __forceinline__ unsigned xb_ld(unsigned* p)              { return __hip_atomic_load(p, __ATOMIC_RELAXED, __HIP_MEMORY_SCOPE_AGENT); }
__device__ __forceinline__ unsigned xb_add(unsigned* p, unsigned v) { return __hip_atomic_fetch_add(p, v, __ATOMIC_RELAXED, __HIP_MEMORY_SCOPE_AGENT); }
__device__ __forceinline__ unsigned xb_xcc_id() { return (unsigned)__builtin_amdgcn_s_getreg((3 << 11) | 20) & 0xFu; }
#define XB_SPIN(cond, bar) do { unsigned _sp = 0; while (cond) { __builtin_amdgcn_s_sleep(1); \
    if ((++_sp & 255u) == 0u) { if (xb_ld(&(bar)[XB_TMO])) break; if (_sp > XB_SPIN_CAP) { atomicAdd(&(bar)[XB_TMO], 1u); break; } } } } while (0)

struct XcdBarrier {
    unsigned* bar; unsigned x;
    volatile LAS unsigned* st;
};

__device__ __forceinline__ XcdBarrier xcd_barrier_post(unsigned* bar, volatile LAS unsigned* st) {
    XcdBarrier b; b.bar = bar; b.x = xb_xcc_id(); b.st = st;
    if (threadIdx.x == 0) (void)xb_add(&bar[XB_XCNT(b.x)], 1u);
    return b;
}
__device__ __forceinline__ void xcd_barrier_complete(unsigned* bar, unsigned x, unsigned& nloc, unsigned& nx) {
    const unsigned G = gridDim.x * gridDim.y * gridDim.z;
    unsigned sum, cnt, mine, sp = 0u;
    for (;;) {
        sum = 0u; cnt = 0u; mine = 0u;
#pragma unroll
        for (unsigned j = 0; j < 16; ++j) { const unsigned c = xb_ld(&bar[XB_XCNT(j)]); sum += c; cnt += (c > 0u) ? 1u : 0u; mine = (j == x) ? c : mine; }
        if (sum == G) break;
        __builtin_amdgcn_s_sleep(1);
        if ((++sp & 255u) == 0u) { if (xb_ld(&bar[XB_TMO])) break; if (sp > XB_SPIN_CAP) { atomicAdd(&bar[XB_TMO], 1u); break; } }
    }
    nloc = mine > 0u ? mine : 1u; nx = cnt > 0u ? cnt : 1u;
}

__device__ __forceinline__ void xcd_barrier(const XcdBarrier& b) {
    asm volatile("s_waitcnt vmcnt(0)" ::: "memory");
    __syncthreads();
    if (threadIdx.x == 0) {
        unsigned* bar = b.bar;
        __builtin_amdgcn_s_waitcnt(0);
        unsigned nloc = b.st[0], nx = b.st[1];
        if (nloc == 0u) { xcd_barrier_complete(bar, b.x, nloc, nx); b.st[0] = nloc; b.st[1] = nx; }
        const unsigned old = xb_add(&bar[XB_XSUB(b.x)], 1u);
        const unsigned gen = old / nloc;
        if (old + 1u == (gen + 1u) * nloc) {
            __builtin_amdgcn_fence(__ATOMIC_RELEASE, "agent");
            asm volatile("s_waitcnt vmcnt(0)" ::: "memory");
            const unsigned og = xb_add(&bar[XB_TOP], 1u);
            const unsigned tg = og / nx;
            if (og + 1u == (tg + 1u) * nx) xb_add(&bar[XB_TOPGEN], 1u);
            else XB_SPIN(xb_ld(&bar[XB_TOPGEN]) == tg, bar);
            __builtin_amdgcn_fence(__ATOMIC_ACQUIRE, "agent");
            xb_add(&bar[XB_XGEN(b.x)], 1u);
            asm volatile("s_waitcnt vmcnt(0)" ::: "memory");
        } else {
            XB_SPIN(xb_ld(&bar[XB_XGEN(b.x)]) == gen, bar);
            __builtin_amdgcn_fence(__ATOMIC_ACQUIRE, "agent");
            asm volatile("s_waitcnt vmcnt(0)" ::: "memory");
        }
    }
    __syncthreads();
}

constexpr int NWAVES = 8, NTHREADS = 512;
constexpr int LDS_MISC = 155648, LDS_BYTES = 159744;
constexpr int PH_PER_LAYER = 8, N_PHASES = 1 + DEPTH * PH_PER_LAYER;
constexpr int CW_BAR = 4096;
constexpr int MG_BLOCKS = 192;
constexpr int RWKV_BLOCKS = 64, SUB_BLOCKS = 256 - RWKV_BLOCKS;
constexpr int N_ATT_UNITS = 64 * (SEQ / 512), N_MIX_ITEMS = 32 + N_ATT_UNITS;
#ifndef MK_MULTI_LAUNCH
#define MK_MULTI_LAUNCH 0
#endif

__device__ __forceinline__ void sub_barrier(unsigned* cnt, unsigned target) {
    asm volatile("s_waitcnt vmcnt(0)" ::: "memory");
    __syncthreads();
    if (threadIdx.x == 0) {
        __builtin_amdgcn_fence(__ATOMIC_RELEASE, "agent"); asm volatile("s_waitcnt vmcnt(0)" ::: "memory");
        __hip_atomic_fetch_add(cnt, 1u, __ATOMIC_RELAXED, __HIP_MEMORY_SCOPE_AGENT);
        unsigned sp = 0; while (__hip_atomic_load(cnt, __ATOMIC_RELAXED, __HIP_MEMORY_SCOPE_AGENT) < target && ++sp < (1u << 24)) __builtin_amdgcn_s_sleep(2);
        __builtin_amdgcn_fence(__ATOMIC_ACQUIRE, "agent"); asm volatile("s_waitcnt vmcnt(0)" ::: "memory");
    }
    __syncthreads();
}
__global__ void __launch_bounds__(NTHREADS, 2) hybrid_fwd(Params p_unused) {
    extern __shared__ __attribute__((aligned(16))) unsigned char lds[];
    cg::grid_group grid = cg::this_grid();
#define G ((int)gridDim.x)
#define bx ((int)blockIdx.x)
#define NGW (G * NWAVES)
#define PHASE_VARS const int tid = opaque_tid(), lane = tid & 63, wave = __builtin_amdgcn_readfirstlane(tid >> 6), gw = bx * NWAVES + wave; (void)lane; (void)gw
    LAS unsigned char* ldsl = (LAS unsigned char*)lds;
    { volatile LAS unsigned* misc = (volatile LAS unsigned*)(ldsl + LDS_MISC); if (threadIdx.x < 64) misc[threadIdx.x] = 0u; __syncthreads(); }
    (void)xcd_barrier_post((unsigned*)(kargs()->ws + WS_CTL) + CW_BAR, (volatile LAS unsigned*)(ldsl + LDS_MISC) + 8);
#define GRID_BAR() do { XcdBarrier xb_; xb_.bar = (unsigned*)(kargs()->ws + WS_CTL) + CW_BAR; xb_.x = xb_xcc_id(); xb_.st = (volatile LAS unsigned*)(ldsl + LDS_MISC) + 8; xcd_barrier(xb_); } while (0)
#ifndef EPI_ALIGN_PD1
#define EPI_ALIGN_PD1 true
#endif
#ifndef EPI_ALIGN_PA2
#define EPI_ALIGN_PA2 true
#endif
#ifndef REPEAT_PH
#define REPEAT_PH 0
#endif
#ifndef PH_MASK
#define PH_MASK 0xFFFF
#endif
#ifndef MIX_MASK
#define MIX_MASK 7
#endif
#define IN(k) true
#define EN(b) ((PH_MASK >> (b)) & 1)
#define SEAM(k) do { if (IN(k) && IN((k) + 1)) { if ((k) == 0) grid.sync(); else GRID_BAR(); } } while (0)
#define WSP(type, off) ((type*)(ws + (off)))

    if (EN(0) && IN(0)) { PHASE_VARS;
        convert_weights(0, lds, gw, NGW, wave, lane);
        KArgs kp = kargs(); unsigned char* ws = kp->ws; const int* positions = kp->positions; const float* x = kp->x; const float* g = kp->norm_pre;
        f32x2* ROPE = WSP(f32x2, WS_ROPE); bf16_t* HB = WSP(bf16_t, WS_HB);
        for (int i = bx * NTHREADS + tid; i < T * 16; i += G * NTHREADS) {
            const int t = i >> 4, j = i & 15; const float inv = exp2f(-(float)j * (13.287712379549449f / 16.0f));
            const float ang = (float)positions[t] * inv; const float k = rintf(ang * 0.15915494309189535f);
            float r = fmaf(-k, 6.2831854820251465f, ang); r = fmaf(-k, -1.7484555314695172e-7f, r);
            ROPE[i] = (f32x2){__cosf(r), __sinf(r)};
        }
        for (int m = gw; m < T; m += NGW) hb_row(x + (size_t)m * DM, g, HB + (size_t)m * DM, lane);
    }
    SEAM(0);
#ifdef EXTRA_SYNCS
    for (int i = 0; i < EXTRA_SYNCS; ++i) GRID_BAR();
#endif

    for (int l = 0; l < DEPTH; ++l) {
        const int P0 = 1 + l * PH_PER_LAYER;
        for (int rp = 0; rp < ((REPEAT_PH == 1) ? 2 : 1); ++rp) { if (rp) GRID_BAR();
        if (EN(1) && IN(P0 + 0)) {
            unsigned char* ws = kargs()->ws;
            pg8::PlainOrder S{(const char*)WSP(bf16_t, WS_HB), (const char*)WSP(bf16_t, WS_WIN), 1024, 1024, T / 256, NA / 256, G, bx, 0};
            EpiStore E{WSP(bf16_t, WS_PA), NA, ldsl};
#ifdef STAGGER_US
            if (bx >= 128) { const unsigned long long t0_ = __builtin_amdgcn_s_memrealtime(); while (__builtin_amdgcn_s_memrealtime() - t0_ < (unsigned long long)(STAGGER_US * 100)) __builtin_amdgcn_s_sleep(8); }
#endif
            pg8::gemm_phase<EpiStore, pg8::PlainOrder, true>(ldsl, pg8::Gemm{1024, 1024, 1024}, S, E);
#ifdef PROBE_PA1NULL
#endif
        }
        }
        SEAM(P0 + 0);
        if (EN(2) && IN(P0 + 1)) { PHASE_VARS;
            if (bx >= RWKV_BLOCKS) {
                unsigned char* ws = kargs()->ws; const int c2 = bx - RWKV_BLOCKS;
                { const bf16_t* PA = WSP(bf16_t, WS_PA); const f32x2* ROPE = WSP(f32x2, WS_ROPE); float* RSTDQ = WSP(float, WS_RSTD); float* RSTDKV = RSTDQ + T; bf16_t* Kb = WSP(bf16_t, WS_K);
                  for (int m = c2 * NWAVES + wave; m < T; m += SUB_BLOCKS * NWAVES) mla_prep_row(PA + (size_t)m * NA, ROPE + (size_t)m * 16, RSTDQ + m, RSTDKV + m, Kb + (size_t)m * KP, lane); }
                sub_barrier((unsigned*)(ws + WS_CTL) + 64 * 40, (unsigned)SUB_BLOCKS * (unsigned)(2 * l + 1));
                { pg8::PlainOrder S{(const char*)(WSP(bf16_t, WS_PA) + CQ), (const char*)WSP(bf16_t, WS_WUQ), NA, 256, T / 256, 3, SUB_BLOCKS, c2, 0};
                  EpiQ E{WSP(bf16_t, WS_Q), WSP(float, WS_RSTD)};
                  pg8::gemm_phase<EpiQ, pg8::PlainOrder, true>(ldsl, pg8::Gemm{NA, 256, 256}, S, E); }
                { pg8::PlainOrder S{(const char*)(WSP(bf16_t, WS_PA) + CKV), (const char*)WSP(bf16_t, WS_WUKV), NA, 256, T / 256, 4, SUB_BLOCKS, c2, 0};
                  EpiKV E{WSP(bf16_t, WS_K), WSP(bf16_t, WS_V), WSP(float, WS_RSTD) + T};
                  pg8::gemm_phase<EpiKV, pg8::PlainOrder, true>(ldsl, pg8::Gemm{NA, 256, 256}, S, E); }
                sub_barrier((unsigned*)(kargs()->ws + WS_CTL) + 64 * 40, (unsigned)SUB_BLOCKS * (unsigned)(2 * l + 2));
            } else {
#ifdef RWKV_TWICE
#pragma unroll 1
                for (int rep_ = 0; rep_ < RWKV_TWICE; ++rep_) { rwkv::rwkv_unit(l, bx >> 3, bx & 7, ldsl); __syncthreads(); }
#else
                rwkv::rwkv_unit(l, bx >> 3, bx & 7, ldsl);
#endif
            }
        }
        if (EN(4) && IN(P0 + 3)) { PHASE_VARS;
            volatile LAS unsigned* qw = (volatile LAS unsigned*)(ldsl + LDS_MISC);
            for (;;) {
                __syncthreads();
                if (tid == 0) { unsigned* CTL = (unsigned*)(kargs()->ws + WS_CTL); qw[0] = atomicAdd(CTL + 64 * (1 + l), 1u); }
                __syncthreads();
                const int it = __builtin_amdgcn_readfirstlane((int)qw[0]);
                if (it >= N_MIX_ITEMS) break;
                if (it < 32) gla::gla_unit(l, it >> 2, it & 3, ldsl, (unsigned*)(kargs()->ws + WS_CTL) + 64 * (24 + l));
                else { const int a = it - 32; att::attn_unit((a & 63) >> 3, a & 7, (SEQ / 512 - 1) - (a >> 6), ldsl, (unsigned*)(kargs()->ws + WS_CTL) + 64 * (16 + l)); }
            }
            { unsigned* ctl = (unsigned*)(kargs()->ws + WS_CTL);
              __syncthreads();
              if (tid == 0) { const unsigned tk = __hip_atomic_fetch_add(ctl + 64 * (20 + l), 1u, __ATOMIC_RELAXED, __HIP_MEMORY_SCOPE_AGENT); qw[0] = tk;
                  if (tk < (unsigned)MG_BLOCKS) { unsigned sp = 0; while (__hip_atomic_load(ctl + 64 * (16 + l), __ATOMIC_RELAXED, __HIP_MEMORY_SCOPE_AGENT) < (unsigned)N_ATT_UNITS && ++sp < (1u << 22)) __builtin_amdgcn_s_sleep(8); }
                  __builtin_amdgcn_fence(__ATOMIC_ACQUIRE, "agent"); asm volatile("s_waitcnt vmcnt(0)" ::: "memory"); }
              __syncthreads();
              const int tk = __builtin_amdgcn_readfirstlane((int)qw[0]);
              if (tk < MG_BLOCKS) {
                  unsigned char* ws = kargs()->ws;
                  pg8::PlainOrder S{(const char*)WSP(bf16_t, WS_HB), (const char*)(WSP(bf16_t, WS_WIN) + (size_t)(NA + 1536) * 1024), 1024, 1024, T / 256, 12, MG_BLOCKS, tk, 0};
                  EpiGateMG8 E{WSP(unsigned char, WS_SMG8)};
                  pg8::gemm_phase<EpiGateMG8, pg8::PlainOrder, true>(ldsl, pg8::Gemm{1024, 1024, 1024}, S, E);
                  __syncthreads();
                  if (tid == 0) { unsigned sp = 0; while (__hip_atomic_load(ctl + 64 * (24 + l), __ATOMIC_RELAXED, __HIP_MEMORY_SCOPE_AGENT) < 32u && ++sp < (1u << 22)) __builtin_amdgcn_s_sleep(8);
                      __builtin_amdgcn_fence(__ATOMIC_ACQUIRE, "agent"); asm volatile("s_waitcnt vmcnt(0)" ::: "memory"); }
                  __syncthreads();
                  pg8::PlainOrder S2{(const char*)WSP(bf16_t, WS_HB), (const char*)(WSP(bf16_t, WS_WIN) + (size_t)NA * 1024), 1024, 1024, T / 256, 4, MG_BLOCKS, tk, 2};
                  EpiGateBG E2{WSP(bf16_t, WS_YS), 0, 2};
                  pg8::gemm_phase<EpiGateBG, pg8::PlainOrder, true>(ldsl, pg8::Gemm{1024, 1024, 1024}, S2, E2);
              } }
        }
        SEAM(P0 + 3);
        if (EN(5) && IN(P0 + 4)) {
            unsigned char* ws = kargs()->ws;
            pg8::PlainOrder S{(const char*)WSP(bf16_t, WS_HB), (const char*)(WSP(bf16_t, WS_WIN) + (size_t)(NA + 512) * 1024), 1024, 1024, T / 256, 2, G, bx, 0};
            EpiGateBG E{WSP(bf16_t, WS_YS), 2, 0};
            pg8::gemm_phase<EpiGateBG, pg8::PlainOrder, true>(ldsl, pg8::Gemm{1024, 1024, 1024}, S, E);
        }
        SEAM(P0 + 4);
        for (int rp = 0; rp < ((REPEAT_PH == 6 && l == 0) ? 2 : 1); ++rp) { if (rp) GRID_BAR();
        if (EN(6) && IN(P0 + 5)) {
            unsigned char* ws = kargs()->ws;
            pg8::GroupOrder3 S{(const char*)WSP(bf16_t, WS_YS), (const char*)WSP(bf16_t, WS_WBO), 512, 512, T / 256, 4, G, bx, (size_t)T * 512 * 2, (size_t)1024 * 512 * 2};
            EpiMerge E{WSP(bf16_t, WS_MG), WSP(unsigned char, WS_SMG8)};
            pg8::gemm_phase<EpiMerge, pg8::GroupOrder3, EPI_ALIGN_PD1>(ldsl, pg8::Gemm{512, 512, 512}, S, E);
        }
        }
        SEAM(P0 + 5);
        for (int rp = 0; rp < ((REPEAT_PH == 7 && l == 0) ? 2 : 1); ++rp) { if (rp) GRID_BAR();
        if (EN(7) && IN(P0 + 6)) {
            unsigned char* ws = kargs()->ws;
            pg8::PlainOrder S{(const char*)WSP(bf16_t, WS_MG), (const char*)WSP(bf16_t, WS_WOUT), 1024, 1024, T / 256, 4, G, bx, 0};
            EpiStore E{WSP(bf16_t, WS_OF), 1024, ldsl};
            pg8::gemm_phase<EpiStore, pg8::PlainOrder, true>(ldsl, pg8::Gemm{1024, 1024, 1024}, S, E);
        }
        }
        SEAM(P0 + 6);
        if (EN(8) && IN(P0 + 7)) { PHASE_VARS;
            const bool more = (l + 1 < DEPTH);
            if (more) convert_weights(l + 1, lds, gw, NGW, wave, lane);
            KArgs kp = kargs(); unsigned char* ws = kp->ws; float* out = kp->out; const float* xold = (l == 0) ? kp->x : out; const float* gpost = kp->norm_post + l * DM; const float* gnext = more ? kp->norm_pre + (l + 1) * DM : nullptr;
            const bf16_t* OF = WSP(bf16_t, WS_OF); bf16_t* HB = WSP(bf16_t, WS_HB);
            for (int m = gw; m < T; m += NGW)
                final_row(OF + (size_t)m * DM, xold + (size_t)m * DM, gpost, out + (size_t)m * DM, gnext, HB + (size_t)m * DM, lane);
        }
        if (l + 1 < DEPTH) SEAM(P0 + 7);
    }
#undef IN
#undef EN
#undef SEAM
#undef WSP
#undef PHASE_VARS
#undef G
#undef bx
#undef NGW
}

extern "C" void kernel_launch(void* const* d_in, const int* in_sizes, int n_in, void* d_out, int out_size, void* d_ws, size_t ws_size, hipStream_t stream) {
    static int grid = 0;
    if (grid == 0) {
        if (n_in != 24 || in_sizes[0] != T * DM || out_size != T * DM || ws_size < WS_END) {
            fprintf(stderr, "kernel_launch: unexpected shapes (n_in %d, in0 %d, out %d, ws %zu; need ws >= %zu); nothing launched\n", n_in, n_in > 0 ? in_sizes[0] : -1, out_size, ws_size, (size_t)WS_END);
            grid = -1; return; }
        int dev = 0, cus = 0, per_cu = 0;
        (void)hipGetDevice(&dev); (void)hipDeviceGetAttribute(&cus, hipDeviceAttributeMultiprocessorCount, dev);
        if (hipFuncSetAttribute((const void*)hybrid_fwd, hipFuncAttributeMaxDynamicSharedMemorySize, LDS_BYTES) != hipSuccess) { fprintf(stderr, "kernel_launch: hipFuncSetAttribute failed\n"); grid = -1; return; }
        if (hipOccupancyMaxActiveBlocksPerMultiprocessor(&per_cu, (const void*)hybrid_fwd, NTHREADS, LDS_BYTES) != hipSuccess || per_cu < 1) {
            fprintf(stderr, "kernel_launch: occupancy query reports %d blocks per CU\n", per_cu); per_cu = 1; }
        (void)hipGetLastError();
        grid = cus * (per_cu < 1 ? 1 : 1);
        fprintf(stderr, "kernel_launch: grid %d (cus %d, occupancy %d), ws %zu\n", grid, cus, per_cu, ws_size);
    }
    if (grid < 0) return;
    (void)hipMemsetAsync((char*)d_ws + WS_CTL, 0, 65536, stream);
    Params p{};
    p.x = (const float*)d_in[0]; p.positions = (const int*)d_in[1]; p.norm_pre = (const float*)d_in[2]; p.w_in = (const float*)d_in[3]; p.mla_q_norm = (const float*)d_in[4]; p.mla_kv_norm = (const float*)d_in[5];
    p.mla_w_uq = (const float*)d_in[6]; p.mla_w_ukv = (const float*)d_in[7]; p.rwkv_mu = (const float*)d_in[8]; p.rwkv_w0 = (const float*)d_in[9]; p.rwkv_w_up = (const float*)d_in[10]; p.rwkv_a0 = (const float*)d_in[11];
    p.rwkv_a_up = (const float*)d_in[12]; p.rwkv_k_k = (const float*)d_in[13]; p.rwkv_k_a = (const float*)d_in[14]; p.rwkv_r_k = (const float*)d_in[15]; p.rwkv_ln_w = (const float*)d_in[16]; p.rwkv_ln_b = (const float*)d_in[17];
    p.gla_a_up = (const float*)d_in[18]; p.gla_a_b = (const float*)d_in[19]; p.gla_norm = (const float*)d_in[20]; p.w_branch_out = (const float*)d_in[21]; p.w_out = (const float*)d_in[22]; p.norm_post = (const float*)d_in[23];
    p.out = (float*)d_out; p.ws = (unsigned char*)d_ws;
#if MK_MULTI_LAUNCH
    for (int ph = 0; ph < N_PHASES; ++ph) { p.ph_lo = ph; p.ph_hi = ph + 1; void* args[] = {&p};
        hipError_t e = hipLaunchCooperativeKernel((const void*)hybrid_fwd, dim3(grid), dim3(NTHREADS), args, LDS_BYTES, stream);
        if (e != hipSuccess) { fprintf(stderr, "kernel_launch: launch of phase %d failed: %s\n", ph, hipGetErrorString(e)); break; } }
#else
    p.ph_lo = 0; p.ph_hi = N_PHASES; void* args[] = {&p};
    hipError_t e = hipLaunchCooperativeKernel((const void*)hybrid_fwd, dim3(grid), dim3(NTHREADS), args, LDS_BYTES, stream);
    if (e != hipSuccess) fprintf(stderr, "kernel_launch: cooperative launch failed: %s (grid %d)\n", hipGetErrorString(e), grid);
#endif
}
```

```cpp
#include <hip/hip_runtime.h>
#include <hip/hip_cooperative_groups.h>
#include <cstdio>
#include <cstdint>
#include <cmath>
namespace cg = cooperative_groups;
#define U_P2 1
#define U_P5 1
#define U_P7 1
namespace pg8 {
#define PG8_LAS __attribute__((address_space(3)))
typedef unsigned short bf16_t;
typedef short bf16x8 __attribute__((ext_vector_type(8)));
typedef float f32x4 __attribute__((ext_vector_type(4)));
typedef unsigned u32x4 __attribute__((ext_vector_type(4)));
typedef unsigned u32x2 __attribute__((ext_vector_type(2)));
constexpr int BM = 256, BK = 64, HALF = 128, HTB = HALF * BK * 2  , STAGE_BYTES = 8 * HTB, NXCD = 8, WGM = 8;

__host__ __device__ __forceinline__ int lds_byte(int r, int c) { const int st = (r >> 4) * 2 + (c >> 5), rr = r & 15, cc = c & 31, ob = rr * 64 + cc * 2; return st * 1024 + (ob ^ (((ob >> 9) & 1) << 5)); }
__host__ __device__ __forceinline__ void stage_rc(int b, int& R, int& C) { const int st = b / 1024, sb = b % 1024, swz = sb ^ (((sb >> 9) & 1) << 5); R = (st >> 1) * 16 + swz / 64; C = (st & 1) * 32 + (swz % 64) / 2; }
__host__ __device__ __forceinline__ int perm32(int rho) { const int n = rho >> 4, i = rho & 15; return 8 * (i >> 2) + 4 * n + (i & 3); }

struct Unit { int pm, pn, aux; const char* A; const char* B; };
struct Gemm { int lda, ldb, K; };

__device__ __forceinline__ void tile_of(int L, int nM, int nN, int& pm, int& pn) {
    const int nwg = nM * nN; int wgid = L;
    { const int q = nwg / NXCD, r = nwg % NXCD, xcd = wgid % NXCD, off = wgid / NXCD; wgid = (xcd < r ? xcd * (q + 1) : r * (q + 1) + (xcd - r) * q) + off; }
    const int nig = WGM * nN, gid = wgid / nig, fm = gid * WGM, gsz = (nM - fm) < WGM ? (nM - fm) : WGM;
    pm = fm + ((wgid % nig) % gsz); pn = (wgid % nig) / gsz;
}
struct PlainOrder {
    const char* A; const char* Bt; int lda, ldb, nM, nN, G, c, bskip;
    __device__ __forceinline__ bool next(int i, Unit& u) const {
        const long L = (long)i * G + c; if (L >= (long)nM * nN) return false;
        tile_of((int)L, nM, nN, u.pm, u.pn); u.aux = 0;
        u.A = A + (size_t)u.pm * BM * lda * 2; u.B = Bt + (size_t)(u.pn + ((u.pn >= 2) ? bskip : 0)) * BM * ldb * 2; return true;
    }
};
struct GroupOrder3 {
    const char* A; const char* Bt; int lda, ldb, nM, nN, G, c; size_t a_gstride, b_gstride;
    __device__ __forceinline__ bool next(int i, Unit& u) const {
        const int n = i % 3; const long L = (long)(i / 3) * G + c; if (L >= (long)nM * nN) return false;
        tile_of((int)L, nM, nN, u.pm, u.pn); u.aux = n;
        u.A = A + n * a_gstride + (size_t)u.pm * BM * lda * 2; u.B = Bt + n * b_gstride + (size_t)u.pn * BM * ldb * 2; return true;
    }
};

template <class Epi, class Sched, bool ALIGN_EPI>
__device__ __forceinline__ void gemm_phase(PG8_LAS unsigned char* lds, const Gemm g, const Sched& S, const Epi& E) {
    int tid_ = threadIdx.x; asm volatile("" : "+v"(tid_));
    const int tid = tid_, wid = __builtin_amdgcn_readfirstlane(tid >> 6), lane = tid & 63, wr = wid >> 2, wc = wid & 3, fr = lane & 15, fq = lane >> 4;
    const int K = g.K, nt = K / BK;
    unsigned voffA[2], voffB[2];
#pragma unroll
    for (int i = 0; i < 2; ++i) { int R, C; stage_rc(tid * 16 + i * 8192, R, C); const int Rb = (int)Epi::PERM == 2 ? (64 * (R >> 5) + perm32(R & 31)) : (int)Epi::PERM == 1 ? ((R & ~31) + perm32(R & 31)) : R;
        voffA[i] = (unsigned)(R * g.lda + C) * 2u; voffB[i] = (unsigned)(Rb * g.ldb + C) * 2u; }
    const size_t kstep = (size_t)(BK * 2);
    const size_t hstepA = (size_t)HALF * g.lda * 2, hstepB = (size_t)((int)Epi::PERM == 2 ? 32 : HALF) * g.ldb * 2;
    const unsigned ldsw = (unsigned)wid * 1024u;
    const int aoff = lds_byte(wr * 64 + fr, fq * 8), boff = lds_byte(wc * 32 + fr, fq * 8);
#define PG8_SA(b, h) (((b) * 2 + (h)) * HTB)
#define PG8_SB(b, h) ((4 + (b) * 2 + (h)) * HTB)
#define PG8_STAGE(bufoff, gbase, voff) do { _Pragma("unroll") for (int _i = 0; _i < 2; ++_i) \
        __builtin_amdgcn_global_load_lds((const unsigned*)((const char*)(gbase) + (voff)[_i]), (PG8_LAS unsigned*)(lds + (bufoff) + ldsw + _i * 8192), 16, 0, 0); } while (0)
#define PG8_LDA(dst, b, h) do { _Pragma("unroll") for (int m = 0; m < 4; ++m) _Pragma("unroll") for (int k = 0; k < 2; ++k) dst[m][k] = *(const PG8_LAS bf16x8*)(lds + PG8_SA(b, h) + aoff + m * 2048 + k * 1024); } while (0)
#define PG8_LDB(dst, b, h) do { _Pragma("unroll") for (int n = 0; n < 2; ++n) _Pragma("unroll") for (int k = 0; k < 2; ++k) dst[n][k] = *(const PG8_LAS bf16x8*)(lds + PG8_SB(b, h) + boff + n * 2048 + k * 1024); } while (0)
#define PG8_MMA(ai, bj, At, Bt) do { __builtin_amdgcn_s_setprio(1); _Pragma("unroll") for (int m = 0; m < 4; ++m) _Pragma("unroll") for (int n = 0; n < 2; ++n) _Pragma("unroll") for (int k = 0; k < 2; ++k) \
        acc[ai][bj][m][n] = __builtin_amdgcn_mfma_f32_16x16x32_bf16(Bt[n][k], At[m][k], acc[ai][bj][m][n], 0, 0, 0); __builtin_amdgcn_s_setprio(0); } while (0)
#define PG8_WAIT_V(n) asm volatile("s_waitcnt vmcnt(" #n ")" ::: "memory")
#define PG8_WAIT_L(n) asm volatile("s_waitcnt lgkmcnt(" #n ")" ::: "memory")
#define PG8_BAR __builtin_amdgcn_s_barrier()
#define PG8_SCHED __builtin_amdgcn_sched_barrier(0)
    Unit cur, nxt; int ui = 0;
    if (!S.next(0, cur)) return;
    f32x4 acc[2][2][4][2];
#pragma unroll
    for (int a = 0; a < 2; ++a)
#pragma unroll
        for (int b = 0; b < 2; ++b)
#pragma unroll
            for (int m = 0; m < 4; ++m)
#pragma unroll
                for (int n = 0; n < 2; ++n) acc[a][b][m][n] = (f32x4){0.f, 0.f, 0.f, 0.f};
    bf16x8 At[4][2], B0[2][2], B1[2][2];
    const char* cA = cur.A; const char* cB = cur.B;
    PG8_STAGE(PG8_SB(0, 0), cB, voffB); PG8_STAGE(PG8_SB(0, 1), cB + hstepB, voffB); PG8_STAGE(PG8_SA(0, 0), cA, voffA); PG8_STAGE(PG8_SA(0, 1), cA + hstepA, voffA);
    if (wr == 1) PG8_BAR;
    PG8_WAIT_V(2); PG8_BAR;
    PG8_STAGE(PG8_SB(1, 0), cB + kstep, voffB); PG8_STAGE(PG8_SA(1, 0), cA + kstep, voffA); PG8_STAGE(PG8_SB(1, 1), cB + hstepB + kstep, voffB);
    PG8_WAIT_V(6); PG8_BAR;
    for (;;) {
        const bool has_next = S.next(ui + 1, nxt);
        const char* nA = has_next ? nxt.A : cA; const char* nB = has_next ? nxt.B : cB;
#pragma unroll 1
        for (int t = 0; t < nt; t += 2) {
            const bool last = (t == nt - 2);
            const char* a1 = cA + (size_t)(t + 1) * kstep;
            const char* a2 = last ? nA : cA + (size_t)(t + 2) * kstep; const char* b2 = last ? nB : cB + (size_t)(t + 2) * kstep;
            const char* a3 = a2 + kstep; const char* b3 = b2 + kstep;
            PG8_LDB(B0, 0, 0); PG8_LDB(B1, 0, 1); PG8_SCHED; PG8_LDA(At, 0, 0); PG8_STAGE(PG8_SA(1, 1), a1 + hstepA, voffA);
            PG8_WAIT_V(8); PG8_WAIT_L(0); PG8_BAR; PG8_MMA(0, 0, At, B0); PG8_MMA(0, 1, At, B1); PG8_BAR; PG8_SCHED;
            PG8_LDA(At, 0, 1); PG8_STAGE(PG8_SB(0, 0), b2, voffB); PG8_STAGE(PG8_SB(0, 1), b2 + hstepB, voffB); PG8_STAGE(PG8_SA(0, 0), a2, voffA);
            PG8_WAIT_V(8); PG8_WAIT_L(0); PG8_BAR; PG8_MMA(1, 0, At, B0); PG8_MMA(1, 1, At, B1); PG8_BAR; PG8_SCHED;
            PG8_LDB(B0, 1, 0); PG8_LDB(B1, 1, 1); PG8_SCHED; PG8_LDA(At, 1, 0); PG8_STAGE(PG8_SA(0, 1), a2 + hstepA, voffA);
            PG8_WAIT_V(8); PG8_WAIT_L(0); PG8_BAR; PG8_MMA(0, 0, At, B0); PG8_MMA(0, 1, At, B1); PG8_BAR; PG8_SCHED;
            PG8_LDA(At, 1, 1); PG8_STAGE(PG8_SB(1, 0), b3, voffB); PG8_STAGE(PG8_SB(1, 1), b3 + hstepB, voffB); PG8_STAGE(PG8_SA(1, 0), a3, voffA);
            PG8_WAIT_V(8); PG8_WAIT_L(0); PG8_BAR; PG8_MMA(1, 0, At, B0); PG8_MMA(1, 1, At, B1); PG8_BAR; PG8_SCHED;
        }
        if constexpr (ALIGN_EPI) { if (wr == 0) PG8_BAR; }
        E(acc, cur, wr, wc, fr, fq);
        if (!has_next) break;
#pragma unroll
        for (int a = 0; a < 2; ++a)
#pragma unroll
            for (int b = 0; b < 2; ++b)
#pragma unroll
                for (int m = 0; m < 4; ++m)
#pragma unroll
                    for (int n = 0; n < 2; ++n) acc[a][b][m][n] = (f32x4){0.f, 0.f, 0.f, 0.f};
        cur = nxt; cA = nA; cB = nB; ++ui;
        if constexpr (ALIGN_EPI) { if (wr == 1) PG8_BAR; }
    }
    PG8_WAIT_V(0);
    if constexpr (!ALIGN_EPI) { if (wr == 0) PG8_BAR; }
    PG8_BAR;
#undef PG8_SA
#undef PG8_SB
#undef PG8_STAGE
#undef PG8_LDA
#undef PG8_LDB
#undef PG8_MMA
#undef PG8_WAIT_V
#undef PG8_WAIT_L
#undef PG8_BAR
#undef PG8_SCHED
}
}
#define LAS __attribute__((address_space(3)))
typedef unsigned short bf16_t;
typedef short bf16x8 __attribute__((ext_vector_type(8)));
typedef short s16x4 __attribute__((ext_vector_type(4)));
typedef float f32x4 __attribute__((ext_vector_type(4)));
typedef float f32x2 __attribute__((ext_vector_type(2)));
typedef float f32x16 __attribute__((ext_vector_type(16)));
typedef unsigned u32x4 __attribute__((ext_vector_type(4)));
typedef unsigned u32x2 __attribute__((ext_vector_type(2)));
typedef __bf16 bf16x2_t __attribute__((ext_vector_type(2)));

constexpr int BATCH = 8, SEQ = 4096, DM = 1024, T = BATCH * SEQ, DEPTH = 2;
constexpr int N_IN = 7728, NA = 3328, NG = 4608, NALL = NA + NG;
constexpr int CQ = 0, CKV = 256, KROPE = 384, GLAT = 416, RW_R = 512, RW_K = 1024, RW_V = 1536, RW_LW = 2048, RW_LA = 2112, GQ = 2304, GK = 2560, GV = 2816;
constexpr int KP = 544;
constexpr float NORM_EPS = 1e-6f, RWKV_GN_EPS = 64e-5f;
constexpr float QSCALE = 0.10206207261596577f * 1.4426950408889634f;

constexpr size_t MiB = 1u << 20;
constexpr size_t WS_CTL = 0;
constexpr size_t WS_ROPE = 1 * MiB;
constexpr size_t WS_RSTD = 5 * MiB;
constexpr size_t WS_WIN = 6 * MiB;
constexpr size_t WS_WBO = WS_WIN + (size_t)NALL * 1024 * 2;
constexpr size_t WS_WOUT = WS_WBO + 3 * MiB;
constexpr size_t WS_WUQ = WS_WOUT + 2 * MiB;
constexpr size_t WS_WUKV = WS_WUQ + 768 * 256 * 2;
constexpr size_t WS_HB = 28 * MiB;
constexpr size_t WS_PA = 92 * MiB;
constexpr size_t WS_Q = 300 * MiB;
constexpr size_t WS_K = 348 * MiB;
constexpr size_t WS_V = 382 * MiB;
constexpr size_t WS_YS = 414 * MiB;
constexpr size_t WS_SMG8 = WS_Q;
constexpr size_t WS_MG = WS_PA, WS_OF = WS_PA + 64 * MiB;
constexpr size_t WS_END = 510 * MiB;
static_assert(WS_WUKV + 1024 * 256 * 2 <= WS_HB, "weights fit");

__device__ __forceinline__ unsigned pk2(float lo, float hi) { f32x2 v = {lo, hi}; bf16x2_t b = __builtin_convertvector(v, bf16x2_t); return __builtin_bit_cast(unsigned, b); }
__device__ __forceinline__ float bflo(unsigned w) { return __uint_as_float(w << 16); }
__device__ __forceinline__ float bfhi(unsigned w) { return __uint_as_float(w & 0xffff0000u); }
__device__ __forceinline__ float bf2f(bf16_t b) { return __uint_as_float((unsigned)b << 16); }
__device__ __forceinline__ bf16_t f2bf(float f) { return (bf16_t)(pk2(f, 0.f) & 0xffffu); }
__device__ __forceinline__ float wave_sum(float v) {
#pragma unroll
    for (int o = 1; o < 64; o <<= 1) v += __shfl_xor(v, o);
    return v;
}
__device__ __forceinline__ float fast_exp(float x) { return __builtin_amdgcn_exp2f(x * 1.4426950408889634f); }
__device__ __forceinline__ float fast_sigmoid(float x) { return __builtin_amdgcn_rcpf(1.0f + fast_exp(-x)); }
template <int CTRL> __device__ __forceinline__ float dpp_f(float x) { return __int_as_float(__builtin_amdgcn_update_dpp(0, __float_as_int(x), CTRL, 0xf, 0xf, false)); }
__device__ __forceinline__ float sum8(float x) { x += dpp_f<0xB1>(x); x += dpp_f<0x4E>(x); x += dpp_f<0x141>(x); return x; }
__device__ __forceinline__ float sum16(float x) { x += dpp_f<0xB1>(x); x += dpp_f<0x4E>(x); x += dpp_f<0x141>(x); x += dpp_f<0x140>(x); return x; }

struct Params {
    const float* x; const int* positions; const float* norm_pre; const float* w_in; const float* mla_q_norm; const float* mla_kv_norm; const float* mla_w_uq; const float* mla_w_ukv;
    const float* rwkv_mu; const float* rwkv_w0; const float* rwkv_w_up; const float* rwkv_a0; const float* rwkv_a_up; const float* rwkv_k_k; const float* rwkv_k_a; const float* rwkv_r_k;
    const float* rwkv_ln_w; const float* rwkv_ln_b; const float* gla_a_up; const float* gla_a_b; const float* gla_norm; const float* w_branch_out; const float* w_out; const float* norm_post;
    float* out; unsigned char* ws; int ph_lo, ph_hi;
};

typedef const __attribute__((address_space(4))) Params* KArgs;
__device__ __forceinline__ KArgs kargs() { KArgs kp = (KArgs)__builtin_amdgcn_kernarg_segment_ptr(); asm volatile("" : "+s"(kp)); return kp; }

__device__ __forceinline__ Params load_params() { Params p{}; KArgs kp = kargs(); p.x = kp->x; p.positions = kp->positions; p.norm_pre = kp->norm_pre; p.w_in = kp->w_in; p.mla_q_norm = kp->mla_q_norm; p.mla_kv_norm = kp->mla_kv_norm; p.mla_w_uq = kp->mla_w_uq; p.mla_w_ukv = kp->mla_w_ukv; p.rwkv_mu = kp->rwkv_mu; p.rwkv_w0 = kp->rwkv_w0; p.rwkv_w_up = kp->rwkv_w_up; p.rwkv_a0 = kp->rwkv_a0; p.rwkv_a_up = kp->rwkv_a_up; p.rwkv_k_k = kp->rwkv_k_k; p.rwkv_k_a = kp->rwkv_k_a; p.rwkv_r_k = kp->rwkv_r_k; p.rwkv_ln_w = kp->rwkv_ln_w; p.rwkv_ln_b = kp->rwkv_ln_b; p.gla_a_up = kp->gla_a_up; p.gla_a_b = kp->gla_a_b; p.gla_norm = kp->gla_norm; p.w_branch_out = kp->w_branch_out; p.w_out = kp->w_out; p.norm_post = kp->norm_post; p.out = kp->out; p.ws = kp->ws; p.ph_lo = kp->ph_lo; p.ph_hi = kp->ph_hi; return p; }
__device__ __forceinline__ int opaque_tid() { int t = threadIdx.x; asm volatile("" : "+v"(t)); return t; }

using pg8::Unit;
constexpr int EPI_SCR = 131072, EPI_SCR_WAVE = 2304, EPI_PITCH = 144;
struct EpiGeo { LAS unsigned char* wp; const LAS unsigned char* rp; int r8, p8; };
__device__ __forceinline__ EpiGeo epi_geo(LAS unsigned char* lds, int wr, int wc, int fr, int fq) {
    LAS unsigned char* scr = lds + EPI_SCR + (wr * 4 + wc) * EPI_SCR_WAVE; const int lane = fq * 16 + fr;
    return EpiGeo{scr + fr * EPI_PITCH + fq * 16, scr + (lane >> 3) * EPI_PITCH + (lane & 7) * 16, lane >> 3, lane & 7};
}
__device__ __forceinline__ void epi_xpose(const EpiGeo& g, const u32x4 w0, const u32x4 w1, u32x4& r0, u32x4& r1) {
    *(LAS u32x4*)g.wp = w0; *(LAS u32x4*)(g.wp + 64) = w1;
    asm volatile("" ::: "memory");
    r0 = *(const LAS u32x4*)g.rp; r1 = *(const LAS u32x4*)(g.rp + 8 * EPI_PITCH);
    asm volatile("" ::: "memory");
}
__device__ __forceinline__ u32x4 pack8(const f32x4 v0, const f32x4 v1) { u32x4 w; w.x = pk2(v0[0], v0[1]); w.y = pk2(v0[2], v0[3]); w.z = pk2(v1[0], v1[1]); w.w = pk2(v1[2], v1[3]); return w; }
struct EpiStore {
    static constexpr int PERM = 2; bf16_t* O; int ldc; LAS unsigned char* lds;
    __device__ __forceinline__ void operator()(const f32x4 (&acc)[2][2][4][2], const Unit& u, int wr, int wc, int fr, int fq) const {
        const EpiGeo G = epi_geo(lds, wr, wc, fr, fq);
        bf16_t* gp = O + (size_t)(u.pm * 256 + wr * 64 + G.r8) * ldc + u.pn * 256 + wc * 64 + G.p8 * 8;
#pragma unroll
        for (int ai = 0; ai < 2; ++ai)
#pragma unroll
            for (int m = 0; m < 4; ++m) { u32x4 r0, r1; epi_xpose(G, pack8(acc[ai][0][m][0], acc[ai][0][m][1]), pack8(acc[ai][1][m][0], acc[ai][1][m][1]), r0, r1);
                bf16_t* g = gp + (size_t)(ai * 128 + m * 16) * ldc;
                *(u32x4*)g = r0; *(u32x4*)(g + (size_t)8 * ldc) = r1; }
    }
};
struct EpiQ {
    static constexpr int PERM = 2; bf16_t* Q; const float* rstd; LAS unsigned char* lds;
    __device__ __forceinline__ void operator()(const f32x4 (&acc)[2][2][4][2], const Unit& u, int wr, int wc, int fr, int fq) const {
        const EpiGeo G = epi_geo(lds, wr, wc, fr, fq);
        const int row0 = u.pm * 256 + wr * 64 + fr;
        float rsv[2][4];
#pragma unroll
        for (int ai = 0; ai < 2; ++ai)
#pragma unroll
            for (int m = 0; m < 4; ++m) rsv[ai][m] = rstd[row0 + ai * 128 + m * 16];
        bf16_t* gp = Q + (size_t)(u.pm * 256 + wr * 64 + G.r8) * 768 + u.pn * 256 + wc * 64 + G.p8 * 8;
#pragma unroll
        for (int ai = 0; ai < 2; ++ai)
#pragma unroll
            for (int m = 0; m < 4; ++m) { const float rs = rsv[ai][m] * QSCALE; u32x4 r0, r1;
                epi_xpose(G, pack8(acc[ai][0][m][0] * rs, acc[ai][0][m][1] * rs), pack8(acc[ai][1][m][0] * rs, acc[ai][1][m][1] * rs), r0, r1);
                bf16_t* g = gp + (size_t)(ai * 128 + m * 16) * 768;
                *(u32x4*)g = r0; *(u32x4*)(g + (size_t)8 * 768) = r1; }
    }
};
struct EpiKV {
    static constexpr int PERM = 2; bf16_t* Kb; bf16_t* Vb; const float* rstd; LAS unsigned char* lds;
    __device__ __forceinline__ void operator()(const f32x4 (&acc)[2][2][4][2], const Unit& u, int wr, int wc, int fr, int fq) const {
        const EpiGeo G = epi_geo(lds, wr, wc, fr, fq);
        const int row0 = u.pm * 256 + wr * 64 + fr; const bool isv = u.pn >= 2; const int ldc = isv ? 512 : KP;
        float rsv[2][4];
#pragma unroll
        for (int ai = 0; ai < 2; ++ai)
#pragma unroll
            for (int m = 0; m < 4; ++m) rsv[ai][m] = rstd[row0 + ai * 128 + m * 16];
        bf16_t* gp = (isv ? Vb : Kb) + (size_t)(u.pm * 256 + wr * 64 + G.r8) * ldc + (u.pn & 1) * 256 + wc * 64 + G.p8 * 8;
#pragma unroll
        for (int ai = 0; ai < 2; ++ai)
#pragma unroll
            for (int m = 0; m < 4; ++m) { const float rs = rsv[ai][m]; u32x4 r0, r1;
                epi_xpose(G, pack8(acc[ai][0][m][0] * rs, acc[ai][0][m][1] * rs), pack8(acc[ai][1][m][0] * rs, acc[ai][1][m][1] * rs), r0, r1);
                bf16_t* g = gp + (size_t)(ai * 128 + m * 16) * ldc;
                *(u32x4*)g = r0; *(u32x4*)(g + (size_t)8 * ldc) = r1; }
    }
};
__device__ __forceinline__ unsigned q8(float s) { return (unsigned)(s * 255.0f + 0.5f); }
__device__ __forceinline__ f32x4 silu4(const f32x4 a) { f32x4 r; r[0] = fast_sigmoid(a[0]) * a[0]; r[1] = fast_sigmoid(a[1]) * a[1]; r[2] = fast_sigmoid(a[2]) * a[2]; r[3] = fast_sigmoid(a[3]) * a[3]; return r; }
struct EpiGateBG {
    static constexpr int PERM = 2; bf16_t* YS; int pn0, skip; LAS unsigned char* lds;
    __device__ __forceinline__ void operator()(const f32x4 (&acc)[2][2][4][2], const Unit& u, int wr, int wc, int fr, int fq) const {
        const int pn = pn0 + u.pn + ((u.pn >= 2) ? skip : 0);
        const EpiGeo G = epi_geo(lds, wr, wc, fr, fq);
        bf16_t* gp = YS + (size_t)(pn >> 1) * T * 512 + (size_t)(u.pm * 256 + wr * 64 + G.r8) * 512 + (pn & 1) * 256 + wc * 64 + G.p8 * 8;
#pragma unroll
        for (int ai = 0; ai < 2; ++ai) {
            u32x4 y[4][2];
#pragma unroll
            for (int m = 0; m < 4; ++m)
#pragma unroll
                for (int h = 0; h < 2; ++h) y[m][h] = *(const u32x4*)(gp + (size_t)(ai * 128 + m * 16 + 8 * h) * 512);
#pragma unroll
            for (int m = 0; m < 4; ++m) { u32x4 r[2];
                epi_xpose(G, pack8(silu4(acc[ai][0][m][0]), silu4(acc[ai][0][m][1])), pack8(silu4(acc[ai][1][m][0]), silu4(acc[ai][1][m][1])), r[0], r[1]);
#pragma unroll
                for (int h = 0; h < 2; ++h) { const u32x4 yy = y[m][h], gg = r[h];
                    u32x4 w; w.x = pk2(bflo(gg.x) * bflo(yy.x), bfhi(gg.x) * bfhi(yy.x)); w.y = pk2(bflo(gg.y) * bflo(yy.y), bfhi(gg.y) * bfhi(yy.y));
                    w.z = pk2(bflo(gg.z) * bflo(yy.z), bfhi(gg.z) * bfhi(yy.z)); w.w = pk2(bflo(gg.w) * bflo(yy.w), bfhi(gg.w) * bfhi(yy.w));
                    *(u32x4*)(gp + (size_t)(ai * 128 + m * 16 + 8 * h) * 512) = w; } }
        }
    }
};
struct EpiGateMG8 {
    static constexpr int PERM = 2; unsigned char* SMG; LAS unsigned char* lds;
    __device__ __forceinline__ void operator()(const f32x4 (&acc)[2][2][4][2], const Unit& u, int wr, int wc, int fr, int fq) const {
        LAS unsigned char* scr = lds + EPI_SCR + (wr * 4 + wc) * EPI_SCR_WAVE; const int lane = fq * 16 + fr;
        LAS unsigned char* wp = scr + fr * 72 + fq * 8; const LAS unsigned char* rp = scr + (lane >> 2) * 72 + (lane & 3) * 16;
        unsigned char* gp = SMG + (size_t)(u.pm * 256 + wr * 64 + (lane >> 2)) * 3072 + u.pn * 256 + wc * 64 + (lane & 3) * 16;
#pragma unroll
        for (int ai = 0; ai < 2; ++ai)
#pragma unroll
            for (int m = 0; m < 4; ++m) {
#pragma unroll
                for (int bj = 0; bj < 2; ++bj) { const f32x4 a0 = acc[ai][bj][m][0], a1 = acc[ai][bj][m][1];
                    u32x2 w; w.x = q8(fast_sigmoid(a0[0])) | (q8(fast_sigmoid(a0[1])) << 8) | (q8(fast_sigmoid(a0[2])) << 16) | (q8(fast_sigmoid(a0[3])) << 24);
                    w.y = q8(fast_sigmoid(a1[0])) | (q8(fast_sigmoid(a1[1])) << 8) | (q8(fast_sigmoid(a1[2])) << 16) | (q8(fast_sigmoid(a1[3])) << 24);
                    *(LAS u32x2*)(wp + bj * 32) = w; }
                asm volatile("" ::: "memory");
                const u32x2 ra = *(const LAS u32x2*)rp, rb = *(const LAS u32x2*)(rp + 8);
                asm volatile("" ::: "memory");
                *(u32x4*)(gp + (size_t)(ai * 128 + m * 16) * 3072) = (u32x4){ra.x, ra.y, rb.x, rb.y}; }
    }
};
struct EpiMerge {
    static constexpr int PERM = 2; bf16_t* MG; const unsigned char* SMG; LAS unsigned char* lds;
    __device__ __forceinline__ void operator()(const f32x4 (&acc)[2][2][4][2], const Unit& u, int wr, int wc, int fr, int fq) const {
        const EpiGeo G = epi_geo(lds, wr, wc, fr, fq); const int n = u.aux; constexpr float S = 1.0f / 255.0f;
        const size_t rowb = (size_t)(u.pm * 256 + wr * 64 + G.r8); const int colb = u.pn * 256 + wc * 64 + G.p8 * 8;
        const unsigned char* sp = SMG + rowb * 3072 + n * 1024 + colb; bf16_t* mp = MG + rowb * 1024 + colb;
#pragma unroll
        for (int ai = 0; ai < 2; ++ai) {
            u32x2 g[4][2]; u32x4 y[4][2];
#pragma unroll
            for (int m = 0; m < 4; ++m)
#pragma unroll
                for (int h = 0; h < 2; ++h) { g[m][h] = *(const u32x2*)(sp + (size_t)(ai * 128 + m * 16 + 8 * h) * 3072); if (n > 0) y[m][h] = *(const u32x4*)(mp + (size_t)(ai * 128 + m * 16 + 8 * h) * 1024); }
#pragma unroll
            for (int m = 0; m < 4; ++m) { u32x4 r[2];
                epi_xpose(G, pack8(acc[ai][0][m][0], acc[ai][0][m][1]), pack8(acc[ai][1][m][0], acc[ai][1][m][1]), r[0], r[1]);
#pragma unroll
                for (int h = 0; h < 2; ++h) { const u32x2 gg = g[m][h]; const u32x4 aa = r[h];
                    float v[8] = {bflo(aa.x) * (S * (float)(gg.x & 0xffu)), bfhi(aa.x) * (S * (float)((gg.x >> 8) & 0xffu)), bflo(aa.y) * (S * (float)((gg.x >> 16) & 0xffu)), bfhi(aa.y) * (S * (float)(gg.x >> 24)),
                                  bflo(aa.z) * (S * (float)(gg.y & 0xffu)), bfhi(aa.z) * (S * (float)((gg.y >> 8) & 0xffu)), bflo(aa.w) * (S * (float)((gg.y >> 16) & 0xffu)), bfhi(aa.w) * (S * (float)(gg.y >> 24))};
                    if (n > 0) { const u32x4 yy = y[m][h];
                        v[0] += bflo(yy.x); v[1] += bfhi(yy.x); v[2] += bflo(yy.y); v[3] += bfhi(yy.y); v[4] += bflo(yy.z); v[5] += bfhi(yy.z); v[6] += bflo(yy.w); v[7] += bfhi(yy.w); }
                    u32x4 w; w.x = pk2(v[0], v[1]); w.y = pk2(v[2], v[3]); w.z = pk2(v[4], v[5]); w.w = pk2(v[6], v[7]);
                    *(u32x4*)(mp + (size_t)(ai * 128 + m * 16 + 8 * h) * 1024) = w; } }
        }
    }
};
struct EpiF32 {
    static constexpr bool PERM = false; float* O; int ldc;
    __device__ __forceinline__ void operator()(const f32x4 (&acc)[2][2][4][2], const Unit& u, int wr, int wc, int fr, int fq) const {
        const int row0 = u.pm * 256 + wr * 64 + fr, col0 = u.pn * 256 + wc * 32 + 4 * fq;
#pragma unroll
        for (int ai = 0; ai < 2; ++ai)
#pragma unroll
            for (int m = 0; m < 4; ++m) { float* rowp = O + (size_t)(row0 + ai * 128 + m * 16) * ldc + col0;
#pragma unroll
                for (int bj = 0; bj < 2; ++bj)
#pragma unroll
                    for (int n = 0; n < 2; ++n) *(f32x4*)(rowp + bj * 128 + n * 16) = acc[ai][bj][m][n]; }
    }
};

template <class SrcCol>
__device__ __forceinline__ void transpose_item(const float* W, int Ksrc, int Nsrc, bf16_t* WT, int Kdst, int item, int nblk, float* scr, int lane, SrcCol src, const float* kscale) {
    const int kb = item / nblk, nb = item % nblk, k0 = 64 * kb, n0 = 32 * nb;
    const int sc = src(n0 + (lane & 31));
#pragma unroll 8
    for (int i = 0; i < 32; ++i) { const int kk = 2 * i + (lane >> 5), k = k0 + kk; float v = 0.f;
        if (sc >= 0 && k < Ksrc) { v = W[(size_t)k * Nsrc + sc]; if (kscale) v *= kscale[k]; }
        scr[kk * 33 + (lane & 31)] = v; }
    asm volatile("s_waitcnt lgkmcnt(0)" ::: "memory");
    const int c = lane & 7;
#pragma unroll
    for (int j = 0; j < 4; ++j) { const int n = (lane >> 3) + 8 * j; const float* s = scr + (8 * c) * 33 + n;
        u32x4 o; o.x = pk2(s[0 * 33], s[1 * 33]); o.y = pk2(s[2 * 33], s[3 * 33]); o.z = pk2(s[4 * 33], s[5 * 33]); o.w = pk2(s[6 * 33], s[7 * 33]);
        *(u32x4*)(WT + (size_t)(n0 + n) * Kdst + k0 + 8 * c) = o; }
    asm volatile("s_waitcnt lgkmcnt(0)" ::: "memory");
}
__device__ __forceinline__ int win_src(int j) {
    if (j < 416) return j;
    if (j < 432) return 3104 + (j - 416);
    if (j < 512) return -1;
    if (j < 2048) return 416 + (j - 512);
    if (j < 2176) return 1952 + (j - 2048);
    if (j < 2304) return -1;
    if (j < 3328) return 2080 + (j - 2304);
    return 3120 + (j - 3328);
}
__device__ __forceinline__ int wuq_src(int j) { const int h = j / 96, c = j % 96; if (c < 64) return h * 96 + c; const int r = c - 64; return h * 96 + 64 + (r & 1) * 16 + (r >> 1); }
__device__ __forceinline__ int wukv_src(int j) { return j < 512 ? (j >> 6) * 128 + (j & 63) : ((j - 512) >> 6) * 128 + 64 + (j & 63); }

__device__ __forceinline__ void convert_weights(int l, unsigned char* lds, int gw, int NGW, int wave, int lane) {
    float* scr = (float*)(lds + wave * 8448); const Params p = load_params();
    bf16_t* WinT = (bf16_t*)(p.ws + WS_WIN); bf16_t* WboT = (bf16_t*)(p.ws + WS_WBO); bf16_t* WoutT = (bf16_t*)(p.ws + WS_WOUT); bf16_t* WuqT = (bf16_t*)(p.ws + WS_WUQ); bf16_t* WukvT = (bf16_t*)(p.ws + WS_WUKV);
    constexpr int I_IN = 16 * (NALL / 32), I_BO = 8 * 32, I_OUT = 16 * 32, I_UQ = 4 * 24, I_UKV = 4 * 32;
    constexpr int NITEMS = I_IN + 3 * I_BO + I_OUT + I_UQ + I_UKV;
    for (int it = gw; it < NITEMS; it += NGW) {
        int r = it;
        if (r < I_IN) { transpose_item(p.w_in + (size_t)l * 1024 * N_IN, 1024, N_IN, WinT, 1024, r, NALL / 32, scr, lane, [](int j) { return win_src(j); }, nullptr); continue; } r -= I_IN;
        if (r < 3 * I_BO) { const int n = r / I_BO; r -= n * I_BO;
            transpose_item(p.w_branch_out + ((size_t)l * 3 + n) * 512 * 1024, 512, 1024, WboT + (size_t)n * 1024 * 512, 512, r, 32, scr, lane, [](int j) { return j; }, nullptr); continue; } r -= 3 * I_BO;
        if (r < I_OUT) { transpose_item(p.w_out + (size_t)l * 1024 * 1024, 1024, 1024, WoutT, 1024, r, 32, scr, lane, [](int j) { return j; }, nullptr); continue; } r -= I_OUT;
        if (r < I_UQ) { transpose_item(p.mla_w_uq + (size_t)l * 256 * 768, 256, 768, WuqT, 256, r, 24, scr, lane, [](int j) { return wuq_src(j); }, p.mla_q_norm + l * 256); continue; } r -= I_UQ;
        transpose_item(p.mla_w_ukv + (size_t)l * 128 * 1024, 128, 1024, WukvT, 256, r, 32, scr, lane, [](int j) { return wukv_src(j); }, p.mla_kv_norm + l * 128);
    }
}
__device__ __forceinline__ void hb_row(const float* xrow, const float* g, bf16_t* orow, int lane) {
    const f32x4* xr = (const f32x4*)xrow + lane; const f32x4* gr = (const f32x4*)g + lane;
    f32x4 v[4]; float s = 0.f;
#pragma unroll
    for (int j = 0; j < 4; ++j) { v[j] = xr[64 * j]; s += (v[j].x * v[j].x + v[j].y * v[j].y) + (v[j].z * v[j].z + v[j].w * v[j].w); }
    const float rstd = rsqrtf(wave_sum(s) * (1.f / DM) + NORM_EPS);
    u32x2* o8 = (u32x2*)orow + lane;
#pragma unroll
    for (int j = 0; j < 4; ++j) { const f32x4 gg = gr[64 * j]; u32x2 w; w.x = pk2(v[j].x * rstd * gg.x, v[j].y * rstd * gg.y); w.y = pk2(v[j].z * rstd * gg.z, v[j].w * rstd * gg.w); o8[64 * j] = w; }
}
__device__ __forceinline__ void final_row(const bf16_t* orow, const float* xold, const float* gpost, float* xnew, const float* gnext, bf16_t* hbrow, int lane) {
    float o[16], x[16], g[16];
    { const u32x4 a = *((const u32x4*)orow + lane), b = *((const u32x4*)orow + 64 + lane);
      o[0] = bflo(a.x); o[1] = bfhi(a.x); o[2] = bflo(a.y); o[3] = bfhi(a.y); o[4] = bflo(a.z); o[5] = bfhi(a.z); o[6] = bflo(a.w); o[7] = bfhi(a.w);
      o[8] = bflo(b.x); o[9] = bfhi(b.x); o[10] = bflo(b.y); o[11] = bfhi(b.y); o[12] = bflo(b.z); o[13] = bfhi(b.z); o[14] = bflo(b.w); o[15] = bfhi(b.w); }
#pragma unroll
    for (int h = 0; h < 2; ++h)
#pragma unroll
        for (int q = 0; q < 2; ++q) { const f32x4 xv = *((const f32x4*)(xold + 512 * h + 8 * lane) + q), gv = *((const f32x4*)(gpost + 512 * h + 8 * lane) + q);
#pragma unroll
            for (int e = 0; e < 4; ++e) { x[8 * h + 4 * q + e] = xv[e]; g[8 * h + 4 * q + e] = gv[e]; } }
    float s = 0.f;
#pragma unroll
    for (int e = 0; e < 16; ++e) s += o[e] * o[e];
    const float rstd = rsqrtf(wave_sum(s) * (1.f / DM) + NORM_EPS);
    float s2 = 0.f;
#pragma unroll
    for (int e = 0; e < 16; ++e) { x[e] += o[e] * rstd * g[e]; s2 += x[e] * x[e]; }
#pragma unroll
    for (int h = 0; h < 2; ++h)
#pragma unroll
        for (int q = 0; q < 2; ++q) *((f32x4*)(xnew + 512 * h + 8 * lane) + q) = (f32x4){x[8 * h + 4 * q], x[8 * h + 4 * q + 1], x[8 * h + 4 * q + 2], x[8 * h + 4 * q + 3]};
    if (gnext) { const float rstd2 = rsqrtf(wave_sum(s2) * (1.f / DM) + NORM_EPS);
#pragma unroll
        for (int h = 0; h < 2; ++h) { const f32x4 g0 = *((const f32x4*)(gnext + 512 * h + 8 * lane)), g1 = *((const f32x4*)(gnext + 512 * h + 8 * lane) + 1);
            u32x4 w; w.x = pk2(x[8 * h] * rstd2 * g0[0], x[8 * h + 1] * rstd2 * g0[1]); w.y = pk2(x[8 * h + 2] * rstd2 * g0[2], x[8 * h + 3] * rstd2 * g0[3]);
            w.z = pk2(x[8 * h + 4] * rstd2 * g1[0], x[8 * h + 5] * rstd2 * g1[1]); w.w = pk2(x[8 * h + 6] * rstd2 * g1[2], x[8 * h + 7] * rstd2 * g1[3]);
            *((u32x4*)hbrow + 64 * h + lane) = w; } }
}
__device__ __forceinline__ void mla_prep_row(const bf16_t* prow, const f32x2* rope_t, float* rstdq, float* rstdkv, bf16_t* krow, int lane) {
    const u32x2 a = *((const u32x2*)(prow + CQ) + lane); const unsigned c = *((const unsigned*)(prow + CKV) + lane);
    float sq = bflo(a.x) * bflo(a.x) + bfhi(a.x) * bfhi(a.x) + bflo(a.y) * bflo(a.y) + bfhi(a.y) * bfhi(a.y);
    float sk = bflo(c) * bflo(c) + bfhi(c) * bfhi(c);
    sq = wave_sum(sq); sk = wave_sum(sk);
    if (lane == 0) { *rstdq = rsqrtf(sq * (1.f / 256.f) + NORM_EPS); *rstdkv = rsqrtf(sk * (1.f / 128.f) + NORM_EPS); }
    if (lane < 16) { const float x1 = bf2f(prow[KROPE + lane]), x2 = bf2f(prow[KROPE + 16 + lane]); const f32x2 cs = rope_t[lane];
        *((unsigned*)(krow + 512) + lane) = pk2(x1 * cs.x - x2 * cs.y, x2 * cs.x + x1 * cs.y); }
}

namespace att {
constexpr int KSLOT = 12288, VSLOT = 8192, BUFB = KSLOT + VSLOT, L_WS = 2 * BUFB, L_OST = L_WS + 8 * 128 * 4, L_END = L_OST + 8 * 4096;
constexpr int UNIT_ROWS = 512;
__device__ __forceinline__ int crow(int r, int hi) { return (r & 3) + 8 * (r >> 2) + 4 * hi; }
__device__ __forceinline__ s16x4 vtr(const LAS unsigned char* p) { return __builtin_bit_cast(s16x4, __builtin_amdgcn_ds_read_tr16_b64_v4i16((LAS s16x4*)p)); }
__device__ __forceinline__ void load_q(bf16x8 (&qr)[6], const bf16_t* Q, const f32x2* rope, size_t row, int h, int hi) {
    const bf16_t* Qw = Q + row * 768 + h * 96 + hi * 8;
#pragma unroll
    for (int s = 0; s < 6; ++s) qr[s] = *(const bf16x8*)(Qw + s * 16);
    const f32x4* rp = (const f32x4*)(rope + row * 16 + 4 * hi);
#pragma unroll
    for (int s = 4; s < 6; ++s) { const f32x4 c01 = rp[(s - 4) * 4], c23 = rp[(s - 4) * 4 + 1]; const u32x4 w = __builtin_bit_cast(u32x4, qr[s]); u32x4 o;
        { const float e = bflo(w.x), d = bfhi(w.x); o.x = pk2(e * c01[0] - d * c01[1], d * c01[0] + e * c01[1]); }
        { const float e = bflo(w.y), d = bfhi(w.y); o.y = pk2(e * c01[2] - d * c01[3], d * c01[2] + e * c01[3]); }
        { const float e = bflo(w.z), d = bfhi(w.z); o.z = pk2(e * c23[0] - d * c23[1], d * c23[0] + e * c23[1]); }
        { const float e = bflo(w.w), d = bfhi(w.w); o.w = pk2(e * c23[2] - d * c23[3], d * c23[2] + e * c23[3]); }
        qr[s] = __builtin_bit_cast(bf16x8, o); }
}
__device__ __forceinline__ void softmax_half(f32x16& p0, f32x16& p1, f32x16& o0, f32x16& o1, float& mrun, float& lrun, bf16x8 (&pa)[4],
                                             bool first, bool band, int kb0, int qrel, int r32, int hi, LAS float* wsf) {
    if (band) {
#pragma unroll
        for (int r = 0; r < 16; ++r) { const int kv = kb0 + (r & 3) + 8 * (r >> 2); if (kv > qrel) p0[r] = -INFINITY; if (kv + 32 > qrel) p1[r] = -INFINITY; } }
    float mx = fmaxf(p0[0], p1[0]);
#pragma unroll
    for (int r = 1; r < 16; ++r) mx = fmaxf(mx, fmaxf(p0[r], p1[r]));
    mx = fmaxf(mx, __shfl_xor(mx, 32));
    if (first || __any(mx > 8.0f)) {
        const float dl = first ? mx : fmaxf(mx, 0.f); mrun += dl;
#pragma unroll
        for (int r = 0; r < 16; ++r) { p0[r] -= dl; p1[r] -= dl; }
        const float alpha = __builtin_amdgcn_exp2f(-dl); lrun *= alpha;
        if (hi == 0) wsf[r32] = alpha;
#pragma unroll
        for (int r = 0; r < 16; ++r) { const float a = wsf[crow(r, hi)]; o0[r] *= a; o1[r] *= a; }
    }
    float ls = 0.f;
#pragma unroll
    for (int r = 0; r < 16; ++r) { p0[r] = __builtin_amdgcn_exp2f(p0[r]); p1[r] = __builtin_amdgcn_exp2f(p1[r]); ls += p0[r] + p1[r]; }
    lrun += ls;
#pragma unroll
    for (int s = 0; s < 4; ++s) { const int bb = 8 * (s & 1); u32x4 w;
        if (s < 2) { w.x = pk2(p0[bb], p0[bb + 1]); w.y = pk2(p0[bb + 2], p0[bb + 3]); w.z = pk2(p0[bb + 4], p0[bb + 5]); w.w = pk2(p0[bb + 6], p0[bb + 7]); }
        else { w.x = pk2(p1[bb], p1[bb + 1]); w.y = pk2(p1[bb + 2], p1[bb + 3]); w.z = pk2(p1[bb + 4], p1[bb + 5]); w.w = pk2(p1[bb + 6], p1[bb + 7]); }
        pa[s] = __builtin_bit_cast(bf16x8, w); }
}
__device__ __forceinline__ void attn_unit(int b, int h, int qb, LAS unsigned char* lds, unsigned* done_ctr) {
    KArgs kp = kargs(); unsigned char* ws_ = kp->ws;
    const bf16_t* Q = (const bf16_t*)(ws_ + WS_Q); const bf16_t* Kg = (const bf16_t*)(ws_ + WS_K); const bf16_t* Vg = (const bf16_t*)(ws_ + WS_V); bf16_t* O = (bf16_t*)(ws_ + WS_YS);
    const int tid = opaque_tid(), lane = tid & 63, r32 = lane & 31, hi = lane >> 5; const int wid = __builtin_amdgcn_readfirstlane(tid >> 6);
    const size_t rowbase = (size_t)b * SEQ; const int q0 = qb * UNIT_ROWS;
    bf16x8 qa[6], qb_[6];
    load_q(qa, Q, (const f32x2*)(ws_ + WS_ROPE), rowbase + q0 + wid * 64 + r32, h, hi);
    load_q(qb_, Q, (const f32x2*)(ws_ + WS_ROPE), rowbase + q0 + wid * 64 + 32 + r32, h, hi);
    const bf16_t* ksrc0 = Kg + (rowbase + (tid & 63)) * KP + h * 64 + (tid >> 6) * 8;
    const bf16_t* ksrc1 = Kg + (rowbase + (tid & 63)) * KP + 512 + (tid >> 6) * 8;
    const bf16_t* vsrc = Vg + (rowbase + ((tid & 255) >> 2)) * 512 + h * 64 + (tid >> 8) * 32 + (tid & 3) * 8;
    const int NT = (q0 + UNIT_ROWS) / 64;
    LAS float* wsf = (LAS float*)(lds + L_WS) + wid * 128;
    u32x4 sk0, sk1, sv;
    sk0 = *(const u32x4*)ksrc0; if (tid < 256) sk1 = *(const u32x4*)ksrc1; sv = *(const u32x4*)vsrc;
    *(LAS u32x4*)(lds + tid * 16) = sk0; if (tid < 256) *(LAS u32x4*)(lds + (tid + 512) * 16) = sk1; *(LAS u32x4*)(lds + KSLOT + tid * 16) = sv;
    __syncthreads();
    f32x16 oa0 = {}, oa1 = {}, ob0 = {}, ob1 = {}; float ma = 0.f, la = 0.f, mb = 0.f, lb = 0.f;
    const int qra = wid * 64 + r32, qrb = qra + 32;
    for (int t = 0; t < NT; ++t) {
        LAS unsigned char* buf = lds + (t & 1) * BUFB; LAS unsigned char* nbuf = lds + ((t + 1) & 1) * BUFB;
        if (t + 1 < NT) { sk0 = *(const u32x4*)(ksrc0 + (size_t)(t + 1) * 64 * KP); if (tid < 256) sk1 = *(const u32x4*)(ksrc1 + (size_t)(t + 1) * 64 * KP); sv = *(const u32x4*)(vsrc + (size_t)(t + 1) * 64 * 512); }
        f32x16 pa0, pa1, pb0, pb1;
#pragma unroll
        for (int r = 0; r < 16; ++r) { pa0[r] = -ma; pa1[r] = -ma; pb0[r] = -mb; pb1[r] = -mb; }
        { const LAS unsigned char* kb = buf + hi * 1024 + r32 * 16;
#pragma unroll
          for (int s = 0; s < 6; ++s) { const bf16x8 a0 = *(const LAS bf16x8*)(kb + s * 2048), a1 = *(const LAS bf16x8*)(kb + s * 2048 + 512);
              pa0 = __builtin_amdgcn_mfma_f32_32x32x16_bf16(a0, qa[s], pa0, 0, 0, 0); pa1 = __builtin_amdgcn_mfma_f32_32x32x16_bf16(a1, qa[s], pa1, 0, 0, 0);
              pb0 = __builtin_amdgcn_mfma_f32_32x32x16_bf16(a0, qb_[s], pb0, 0, 0, 0); pb1 = __builtin_amdgcn_mfma_f32_32x32x16_bf16(a1, qb_[s], pb1, 0, 0, 0); } }
        const bool band = t >= NT - 8; const int kb0 = 64 * (t - (NT - 8)) + 4 * hi;
        bf16x8 fa[4], fb[4];
        softmax_half(pa0, pa1, oa0, oa1, ma, la, fa, t == 0, band, kb0, qra, r32, hi, wsf);
        softmax_half(pb0, pb1, ob0, ob1, mb, lb, fb, t == 0, band, kb0, qrb, r32, hi, wsf + 64);
        { const LAS unsigned char* vb = buf + KSLOT + ((lane >> 4) & 1) * 32 + (lane & 3) * 8 + (4 * hi + ((lane & 15) >> 2)) * 64;
#pragma unroll
          for (int s = 0; s < 4; ++s) {
              { const s16x4 lo = vtr(vb + s * 1024), hh = vtr(vb + s * 1024 + 512); const bf16x8 vf = {lo[0], lo[1], lo[2], lo[3], hh[0], hh[1], hh[2], hh[3]};
                oa0 = __builtin_amdgcn_mfma_f32_32x32x16_bf16(fa[s], vf, oa0, 0, 0, 0); ob0 = __builtin_amdgcn_mfma_f32_32x32x16_bf16(fb[s], vf, ob0, 0, 0, 0); }
              { const s16x4 lo = vtr(vb + 4096 + s * 1024), hh = vtr(vb + 4096 + s * 1024 + 512); const bf16x8 vf = {lo[0], lo[1], lo[2], lo[3], hh[0], hh[1], hh[2], hh[3]};
                oa1 = __builtin_amdgcn_mfma_f32_32x32x16_bf16(fa[s], vf, oa1, 0, 0, 0); ob1 = __builtin_amdgcn_mfma_f32_32x32x16_bf16(fb[s], vf, ob1, 0, 0, 0); } } }
        if (t + 1 < NT) { *(LAS u32x4*)(nbuf + tid * 16) = sk0; if (tid < 256) *(LAS u32x4*)(nbuf + (tid + 512) * 16) = sk1; *(LAS u32x4*)(nbuf + KSLOT + tid * 16) = sv; }
        __syncthreads();
    }
    la += __shfl_xor(la, 32); lb += __shfl_xor(lb, 32);
    if (hi == 0) { wsf[32 + r32] = la; wsf[96 + r32] = lb; }
    LAS bf16_t* stg = (LAS bf16_t*)(lds + L_OST) + wid * 2048;
#pragma unroll
    for (int hf = 0; hf < 2; ++hf) {
#pragma unroll
        for (int r = 0; r < 16; ++r) { const int orow = crow(r, hi); const float rl = __builtin_amdgcn_rcpf(wsf[hf * 64 + 32 + orow]);
            stg[orow * 64 + r32] = f2bf((hf ? ob0[r] : oa0[r]) * rl); stg[orow * 64 + 32 + r32] = f2bf((hf ? ob1[r] : oa1[r]) * rl); }
        asm volatile("" ::: "memory");
        bf16_t* Ow = O + (rowbase + q0 + wid * 64 + hf * 32) * 512 + h * 64;
#pragma unroll
        for (int i = 0; i < 4; ++i) { const int row = i * 8 + (lane >> 3), ch = lane & 7; const u32x4 v = *(const LAS u32x4*)(stg + row * 64 + ch * 8); *(u32x4*)(Ow + (size_t)row * 512 + ch * 8) = v; }
        asm volatile("" ::: "memory");
    }
    asm volatile("s_waitcnt vmcnt(0)" ::: "memory");
    __syncthreads();
    if (tid == 0) __hip_atomic_fetch_add(done_ctr, 1u, __ATOMIC_RELEASE, __HIP_MEMORY_SCOPE_AGENT);
}
}

namespace rwkv {
constexpr int LP = 72, TB = 64 * LP * 2;
constexpr int S_HT0 = 0, S_HT1 = 1, S_A = 2  , S_B = 3  , S_K = 4, S_R = 5, S_BT = 6, S_KT = 7, S_V = 8,
              S_MOFF = 9, S_MAK = 10, S_MRK = 11, S_MRB = 12, S_D = 13, S_ZT = 14, S_ACC = 15, NSLOT = 16;
constexpr int FP = 68;
constexpr int O_ZW = S_K * TB, O_ZA = O_ZW + 64 * FP * 4, O_YB = S_MAK * TB, O_WT = NSLOT * TB, O_CL = O_WT + 8 * 64 * 4, O_CST = O_CL + 64 * 4, O_END = O_CST + 12 * 64 * 4;
static_assert(O_ZA + 64 * FP * 4 <= (S_KT + 1) * TB && O_YB + 64 * FP * 4 <= (S_MRK + 1) * TB, "f32 aliases");
__device__ __forceinline__ s16x4 vtr(const LAS unsigned char* p) { return __builtin_bit_cast(s16x4, __builtin_amdgcn_ds_read_tr16_b64_v4i16((LAS s16x4*)p)); }
struct LaneOff { int bn, bt, bs; };
__device__ __forceinline__ LaneOff lane_off(int fr, int fq) { LaneOff o; o.bn = (fr * LP + 8 * fq) * 2; o.bt = ((8 * fq + (fr >> 2)) * LP + 4 * (fr & 3)) * 2; o.bs = (fr * LP + 4 * fq) * 2; return o; }
__device__ __forceinline__ void relaunder(LaneOff& o) { asm volatile("" : "+v"(o.bn), "+v"(o.bt), "+v"(o.bs)); }
__device__ __forceinline__ bf16x8 frag_t(const LAS unsigned char* tile, int kk, int c0, const LaneOff& o) {
    const LAS unsigned char* q = tile + o.bt + (32 * kk * LP + c0) * 2;
    const s16x4 lo = vtr(q), hi = vtr(q + 4 * LP * 2); return (bf16x8){lo[0], lo[1], lo[2], lo[3], hi[0], hi[1], hi[2], hi[3]};
}
__device__ __forceinline__ bf16x8 frag_n(const LAS unsigned char* tile, int r0, int kk, const LaneOff& o) { return *(const LAS bf16x8*)(tile + o.bn + (r0 * LP + 32 * kk) * 2); }
__device__ __forceinline__ f32x4 MFMA16(bf16x8 a, bf16x8 b, f32x4 c) { return __builtin_amdgcn_mfma_f32_16x16x32_bf16(a, b, c, 0, 0, 0); }
__device__ __forceinline__ void st_tile_T(LAS unsigned char* tile, int m0, int n0, const LaneOff& o, const f32x4 c) {
    u32x2 w; w.x = pk2(c[0], c[1]); w.y = pk2(c[2], c[3]); *(LAS u32x2*)(tile + o.bs + (n0 * LP + m0) * 2) = w;
}
__device__ __forceinline__ void unpack8(const u32x4 w, float (&f)[8]) { f[0] = bflo(w.x); f[1] = bfhi(w.x); f[2] = bflo(w.y); f[3] = bfhi(w.y); f[4] = bflo(w.z); f[5] = bfhi(w.z); f[6] = bflo(w.w); f[7] = bfhi(w.w); }
__device__ __forceinline__ u32x4 pack8(const float (&f)[8]) { u32x4 w; w.x = pk2(f[0], f[1]); w.y = pk2(f[2], f[3]); w.z = pk2(f[4], f[5]); w.w = pk2(f[6], f[7]); return w; }
__device__ __forceinline__ void ld8(const float* p, float (&f)[8]) { const f32x4 a = *(const f32x4*)p, b = *(const f32x4*)(p + 4); f[0] = a[0]; f[1] = a[1]; f[2] = a[2]; f[3] = a[3]; f[4] = b[0]; f[5] = b[1]; f[6] = b[2]; f[7] = b[3]; }
__device__ __forceinline__ void ld8l(const LAS float* p, float (&f)[8]) { const f32x4 a = *(const LAS f32x4*)p, b = *(const LAS f32x4*)(p + 4); f[0] = a[0]; f[1] = a[1]; f[2] = a[2]; f[3] = a[3]; f[4] = b[0]; f[5] = b[1]; f[6] = b[2]; f[7] = b[3]; }
__device__ __forceinline__ float ex2(float x) { return __builtin_amdgcn_exp2f(x); }
constexpr float LOG2E = 1.4426950408889634f, LN2 = 0.6931471805599453f;

__device__ __forceinline__ void rwkv_unit(int l, int b, int h, LAS unsigned char* L) {
    const int tid = opaque_tid(), lane = tid & 63, fr = lane & 15, fq = lane >> 4; const int w = __builtin_amdgcn_readfirstlane(tid >> 6);
    const Params p = load_params();
    const bf16_t* PA = (const bf16_t*)(p.ws + WS_PA); bf16_t* Yout = (bf16_t*)(p.ws + WS_YS) + (size_t)T * 512;
    const int t = tid >> 3, c8 = (tid & 7) * 8;
    const int tw = (lane >> 3);
    const int cw = 16 * (w & 3);
    const float* mu = p.rwkv_mu + l * 1664;
    LaneOff lo = lane_off(fr, fq);
#define SLOT(s) (L + (s) * TB)
    bf16x8 bup[2];
    { const float* U = ((w < 4) ? p.rwkv_w_up : p.rwkv_a_up) + (size_t)l * 64 * 512 + h * 64 + 16 * (w & 3) + fr;
#pragma unroll
      for (int kk = 0; kk < 2; ++kk) { float f[8];
#pragma unroll
          for (int e = 0; e < 8; ++e) f[e] = U[(size_t)(32 * kk + 8 * fq + e) * 512];
          bup[kk] = __builtin_bit_cast(bf16x8, pack8(f)); } }
    for (int e = tid; e < TB / 4; e += 512) { ((LAS unsigned*)SLOT(S_HT0))[e] = 0u; ((LAS unsigned*)SLOT(S_D))[e] = 0u; ((LAS unsigned*)SLOT(S_MOFF))[e] = 0u; ((LAS unsigned*)SLOT(S_MRB))[e] = 0u;
        ((LAS unsigned*)SLOT(S_ZT))[e] = 0u; ((LAS unsigned*)SLOT(S_ACC))[e] = 0u; }
    f32x4 hacc[4];
#pragma unroll
    for (int i = 0; i < 4; ++i) hacc[i] = (f32x4){0.f, 0.f, 0.f, 0.f};
    int hcur = S_HT0, hnxt = S_HT1;
    u32x4 raw[10];
#define RWKV_LOAD(c, t, c8) do { const size_t row_ = (size_t)b * SEQ + (c) * 64 + (t); const bf16_t* s_ = PA + row_ * NA; const bool hp_ = ((c) * 64 + (t)) > 0; const u32x4 z_ = {0u, 0u, 0u, 0u}; \
        raw[0] = *(const u32x4*)(s_ + RW_R + h * 64 + c8); raw[1] = hp_ ? *(const u32x4*)(s_ - NA + RW_R + h * 64 + c8) : z_; \
        raw[2] = *(const u32x4*)(s_ + RW_K + h * 64 + c8); raw[3] = hp_ ? *(const u32x4*)(s_ - NA + RW_K + h * 64 + c8) : z_; \
        raw[4] = *(const u32x4*)(s_ + RW_V + h * 64 + c8); raw[5] = hp_ ? *(const u32x4*)(s_ - NA + RW_V + h * 64 + c8) : z_; \
        raw[6] = *(const u32x4*)(s_ + RW_LW + c8); raw[7] = hp_ ? *(const u32x4*)(s_ - NA + RW_LW + c8) : z_; \
        raw[8] = *(const u32x4*)(s_ + RW_LA + c8); raw[9] = hp_ ? *(const u32x4*)(s_ - NA + RW_LA + c8) : z_; } while (0)
    for (int e = tid; e < 12 * 64; e += 512) { const int rw_ = e >> 6, i_ = e & 63; const int hci = l * 512 + h * 64 + i_; float val;
        switch (rw_) { case 0: val = mu[h * 64 + i_]; break; case 1: val = mu[512 + h * 64 + i_]; break; case 2: val = mu[1024 + h * 64 + i_]; break; case 3: val = mu[1536 + i_]; break; case 4: val = mu[1600 + i_]; break;
            case 5: val = p.rwkv_w0[hci]; break; case 6: val = p.rwkv_a0[hci]; break; case 7: val = p.rwkv_k_k[hci]; break; case 8: val = p.rwkv_k_a[hci]; break; case 9: val = p.rwkv_r_k[hci]; break;
            case 10: val = p.rwkv_ln_w[hci]; break; default: val = p.rwkv_ln_b[hci]; break; }
        ((LAS float*)(L + O_CST))[e] = val; }
    RWKV_LOAD(0, t, c8);
    __syncthreads();
    for (int c = 0; c < SEQ / 64; ++c) {
        int c8v = c8, tv = t, frv = fr, fqv = fq; asm volatile("" : "+v"(c8v), "+v"(tv), "+v"(frv), "+v"(fqv));
        const int twv = tv & 7;
        float r[8], kraw[8], v[8];
        { float cu[8], pr[8], m8[8], o[8];
          unpack8(raw[0], cu); unpack8(raw[1], pr); ld8l((const LAS float*)(L + O_CST) + 0 * 64 + c8v, m8);
#pragma unroll
          for (int e = 0; e < 8; ++e) r[e] = cu[e] + (pr[e] - cu[e]) * m8[e];
          unpack8(raw[2], cu); unpack8(raw[3], pr); ld8l((const LAS float*)(L + O_CST) + 1 * 64 + c8v, m8);
#pragma unroll
          for (int e = 0; e < 8; ++e) kraw[e] = cu[e] + (pr[e] - cu[e]) * m8[e];
          unpack8(raw[4], cu); unpack8(raw[5], pr); ld8l((const LAS float*)(L + O_CST) + 2 * 64 + c8v, m8);
#pragma unroll
          for (int e = 0; e < 8; ++e) v[e] = cu[e] + (pr[e] - cu[e]) * m8[e];
          unpack8(raw[6], cu); unpack8(raw[7], pr); ld8l((const LAS float*)(L + O_CST) + 3 * 64 + c8v, m8);
#pragma unroll
          for (int e = 0; e < 8; ++e) { const float x = cu[e] + (pr[e] - cu[e]) * m8[e]; o[e] = 1.0f - 2.0f * __builtin_amdgcn_rcpf(ex2(x * (2.0f * LOG2E)) + 1.0f); }
          *(LAS u32x4*)(SLOT(S_A) + (tv * LP + c8v) * 2) = pack8(o);
          unpack8(raw[8], cu); unpack8(raw[9], pr); ld8l((const LAS float*)(L + O_CST) + 4 * 64 + c8v, m8);
#pragma unroll
          for (int e = 0; e < 8; ++e) o[e] = cu[e] + (pr[e] - cu[e]) * m8[e];
          *(LAS u32x4*)(SLOT(S_B) + (tv * LP + c8v) * 2) = pack8(o); }
        __syncthreads();
        relaunder(lo);
#ifdef U_P2
        { const LAS unsigned char* X = (w < 4) ? SLOT(S_A) : SLOT(S_B); LAS float* Z = (LAS float*)(L + ((w < 4) ? O_ZW : O_ZA));
          f32x4 zacc[4];
#pragma unroll
          for (int m = 0; m < 4; ++m) { f32x4 a = {0.f, 0.f, 0.f, 0.f};
#pragma unroll
              for (int kk = 0; kk < 2; ++kk) a = MFMA16(frag_n(X, 16 * m, kk, lo), bup[kk], a);
              zacc[m] = a; }
#pragma unroll
          for (int m = 0; m < 4; ++m)
#pragma unroll
              for (int rr = 0; rr < 4; ++rr) Z[(16 * m + 4 * fqv + rr) * FP + cw + frv] = zacc[m][rr]; }
#else
        { const LAS unsigned char* X = (w < 4) ? SLOT(S_A) : SLOT(S_B); LAS float* Z = (LAS float*)(L + ((w < 4) ? O_ZW : O_ZA));
#pragma unroll
          for (int m = 0; m < 4; ++m) { f32x4 a = {0.f, 0.f, 0.f, 0.f};
#pragma unroll
              for (int kk = 0; kk < 2; ++kk) a = MFMA16(frag_n(X, 16 * m, kk, lo), bup[kk], a);
#pragma unroll
              for (int rr = 0; rr < 4; ++rr) Z[(16 * m + 4 * fqv + rr) * FP + cw + frv] = a[rr]; } }
#endif
        __syncthreads();
        float kk_[8], kp[8], bb[8], lw[8], cs[8], cb;
        { float zw[8], za[8], c0[8], c1[8];
          ld8l((const LAS float*)(L + O_ZW) + tv * FP + c8v, zw); ld8l((const LAS float*)(L + O_ZA) + tv * FP + c8v, za);
          ld8l((const LAS float*)(L + O_CST) + 5 * 64 + c8v, c0); ld8l((const LAS float*)(L + O_CST) + 6 * 64 + c8v, c1);
          float av[8];
#pragma unroll
          for (int e = 0; e < 8; ++e) { const float x = -(zw[e] + c0[e]); const float sp = fmaxf(x, 0.f) + LN2 * __builtin_amdgcn_logf(1.0f + ex2(-fabsf(x) * LOG2E));
              lw[e] = -LOG2E * ex2((-sp - 0.5f) * LOG2E);
              av[e] = __builtin_amdgcn_rcpf(1.0f + ex2(-(za[e] + c1[e]) * LOG2E)); }
          ld8l((const LAS float*)(L + O_CST) + 7 * 64 + c8v, c0); ld8l((const LAS float*)(L + O_CST) + 8 * 64 + c8v, c1);
          float ss = 0.f;
#pragma unroll
          for (int e = 0; e < 8; ++e) { kk_[e] = kraw[e] * c0[e]; ss += kk_[e] * kk_[e]; kp[e] = kraw[e] * (1.0f + (av[e] - 1.0f) * c1[e]); }
          ss = sum8(ss);
          const float inv = 1.0f / fmaxf(sqrtf(ss), 1e-12f);
          ld8l((const LAS float*)(L + O_CST) + 9 * 64 + c8v, c0);
          float cp = 0.f;
#pragma unroll
          for (int e = 0; e < 8; ++e) { kk_[e] *= inv; bb[e] = kk_[e] * av[e]; cp += r[e] * kp[e] * c0[e]; }
          cb = sum8(cp);
#pragma unroll
          for (int e = 0; e < 8; ++e) { float x = lw[e];
              float y = __shfl_up(x, 8); if (twv >= 1) x += y;
              y = __shfl_up(x, 16); if (twv >= 2) x += y;
              y = __shfl_up(x, 32); if (twv >= 4) x += y;
              cs[e] = x; }
          if (twv == 7) { LAS float* WT = (LAS float*)(L + O_WT) + w * 64 + c8v;
#pragma unroll
              for (int e = 0; e < 8; ++e) WT[e] = cs[e]; } }
        __syncthreads();
        { float off[8], tot[8];
#pragma unroll
          for (int e = 0; e < 8; ++e) { off[e] = 0.f; tot[e] = 0.f; }
#pragma unroll
          for (int g = 0; g < 8; ++g) { float x[8]; ld8l((const LAS float*)(L + O_WT) + g * 64 + c8v, x);
#pragma unroll
              for (int e = 0; e < 8; ++e) { if (g < w) off[e] += x[e]; tot[e] += x[e]; } }
          if (tv == 0) { LAS float* CL = (LAS float*)(L + O_CL) + c8v;
#pragma unroll
              for (int e = 0; e < 8; ++e) CL[e] = tot[e]; }
          float o[8], en[8], ep[8]; const int toff = (tv * LP + c8v) * 2;
#pragma unroll
          for (int e = 0; e < 8; ++e) { cs[e] += off[e]; en[e] = ex2(-cs[e]); ep[e] = __builtin_amdgcn_rcpf(en[e]); o[e] = -kk_[e] * ep[e] * ex2(-lw[e]); }
          *(LAS u32x4*)(SLOT(S_A) + toff) = pack8(o);
#pragma unroll
          for (int e = 0; e < 8; ++e) o[e] = bb[e] * en[e];
          *(LAS u32x4*)(SLOT(S_B) + toff) = pack8(o);
#pragma unroll
          for (int e = 0; e < 8; ++e) o[e] = kp[e] * en[e];
          *(LAS u32x4*)(SLOT(S_K) + toff) = pack8(o);
#pragma unroll
          for (int e = 0; e < 8; ++e) o[e] = r[e] * ep[e];
          *(LAS u32x4*)(SLOT(S_R) + toff) = pack8(o);
#pragma unroll
          for (int e = 0; e < 8; ++e) { en[e] = ex2(tot[e] - cs[e]); o[e] = bb[e] * en[e]; }
          *(LAS u32x4*)(SLOT(S_BT) + toff) = pack8(o);
#pragma unroll
          for (int e = 0; e < 8; ++e) o[e] = kp[e] * en[e];
          *(LAS u32x4*)(SLOT(S_KT) + toff) = pack8(o);
          *(LAS u32x4*)(SLOT(S_V) + toff) = pack8(v); }
        __syncthreads();
        relaunder(lo);
        int wv = w; asm volatile("" : "+s"(wv));
#ifdef U_P4
        f32x4 tacc[5];
#pragma unroll
        for (int it = 0; it < 5; ++it) { const int task = wv + 8 * it; f32x4 a = {0.f, 0.f, 0.f, 0.f};
            if (task < 36) {
                int q, mn;
                if (task < 6) { q = 0; mn = (int)((0xEDC984ull >> (4 * task)) & 0xF); }
                else { q = 1 + (task - 6) / 10; mn = (int)((0xFEDCA98540ull >> (4 * ((task - 6) % 10))) & 0xF); }
                const int m0 = 16 * (mn >> 2), n0 = 16 * (mn & 3);
                const LAS unsigned char* XA = (q < 2) ? SLOT(S_A) : SLOT(S_R); const LAS unsigned char* XB = (q & 1) ? SLOT(S_K) : SLOT(S_B);
#pragma unroll
                for (int kk = 0; kk < 2; ++kk) a = MFMA16(frag_n(XA, m0, kk, lo), frag_n(XB, n0, kk, lo), a);
                if (m0 == n0) {
#pragma unroll
                    for (int rr = 0; rr < 4; ++rr) { const bool keep = (q < 2) ? (frv < 4 * fqv + rr) : (frv <= 4 * fqv + rr); a[rr] = keep ? a[rr] : 0.f; } } }
            tacc[it] = a; }
        if (wv < 4) {
            f32x4 a = {0.f, 0.f, 0.f, 0.f};
#pragma unroll
            for (int kk = 0; kk < 2; ++kk) a = MFMA16(frag_n(SLOT(S_A), 16 * wv, kk, lo), frag_n(SLOT(S_B), 16 * wv, kk, lo), a);
#pragma unroll
            for (int rr = 0; rr < 4; ++rr) a[rr] = (frv < 4 * fqv + rr) ? a[rr] : 0.f;
            float x[16];
            { LAS float* NS = (LAS float*)(SLOT(hnxt) + wv * 1024);
#pragma unroll
              for (int rr = 0; rr < 4; ++rr) NS[(4 * fqv + rr) * 16 + frv] = a[rr];
              asm volatile("s_waitcnt lgkmcnt(0)" ::: "memory");
#pragma unroll
              for (int rw = 0; rw < 16; ++rw) { float s = (rw == frv) ? 1.f : 0.f;
#pragma unroll
                  for (int sc = 0; sc < rw; ++sc) s += NS[rw * 16 + sc] * x[sc];
                  x[rw] = s; }
              asm volatile("s_waitcnt lgkmcnt(0)" ::: "memory"); }
            if (fqv == 0) { LAS unsigned char* dp = SLOT(S_D) + ((16 * wv + frv) * LP + 16 * wv) * 2;
                float lo8[8], hi8[8];
#pragma unroll
                for (int e = 0; e < 8; ++e) { lo8[e] = x[e]; hi8[e] = x[8 + e]; }
                *(LAS u32x4*)dp = pack8(lo8); *(LAS u32x4*)(dp + 16) = pack8(hi8); }
        }
#pragma unroll
        for (int it = 0; it < 6; ++it) { const int task = wv + 8 * it;
            if (task < 36) {
                int q, mn;
                if (task < 6) { q = 0; mn = (int)((0xEDC984ull >> (4 * task)) & 0xF); }
                else { q = 1 + (task - 6) / 10; mn = (int)((0xFEDCA98540ull >> (4 * ((task - 6) % 10))) & 0xF); }
                st_tile_T(SLOT((q == 0) ? S_MOFF : (q == 1) ? S_MAK : (q == 2) ? S_MRB : S_MRK), 16 * (mn >> 2), 16 * (mn & 3), lo, tacc[it < 5 ? it : 4]);
            } else if (task < 48) {
                const int z = task - 36; const int mn = (int)((0xB76321ull >> (4 * (z % 6))) & 0xF);
                st_tile_T(SLOT((z < 6) ? S_MAK : S_MRK), 16 * (mn >> 2), 16 * (mn & 3), lo, (f32x4){0.f, 0.f, 0.f, 0.f});
            } }
#else
        if (wv < 4) {
            f32x4 a = {0.f, 0.f, 0.f, 0.f};
#pragma unroll
            for (int kk = 0; kk < 2; ++kk) a = MFMA16(frag_n(SLOT(S_A), 16 * wv, kk, lo), frag_n(SLOT(S_B), 16 * wv, kk, lo), a);
#pragma unroll
            for (int rr = 0; rr < 4; ++rr) a[rr] = (frv < 4 * fqv + rr) ? a[rr] : 0.f;
            float x[16];
            { LAS float* NS = (LAS float*)(SLOT(hnxt) + wv * 1024);
#pragma unroll
              for (int rr = 0; rr < 4; ++rr) NS[(4 * fqv + rr) * 16 + frv] = a[rr];
              asm volatile("s_waitcnt lgkmcnt(0)" ::: "memory");
#pragma unroll
              for (int rw = 0; rw < 16; ++rw) { float s = (rw == frv) ? 1.f : 0.f;
#pragma unroll
                  for (int sc = 0; sc < rw; ++sc) s += NS[rw * 16 + sc] * x[sc];
                  x[rw] = s; }
              asm volatile("s_waitcnt lgkmcnt(0)" ::: "memory"); }
            if (fqv == 0) { LAS unsigned char* dp = SLOT(S_D) + ((16 * wv + frv) * LP + 16 * wv) * 2;
                float lo8[8], hi8[8];
#pragma unroll
                for (int e = 0; e < 8; ++e) { lo8[e] = x[e]; hi8[e] = x[8 + e]; }
                *(LAS u32x4*)dp = pack8(lo8); *(LAS u32x4*)(dp + 16) = pack8(hi8); }
        }
#pragma unroll
        for (int it = 0; it < 6; ++it) { const int task = wv + 8 * it;
            if (task < 36) {
                int q, mn;
                if (task < 6) { q = 0; mn = (int)((0xEDC984ull >> (4 * task)) & 0xF); }
                else { q = 1 + (task - 6) / 10; mn = (int)((0xFEDCA98540ull >> (4 * ((task - 6) % 10))) & 0xF); }
                const int m0 = 16 * (mn >> 2), n0 = 16 * (mn & 3);
                const LAS unsigned char* XA = (q < 2) ? SLOT(S_A) : SLOT(S_R); const LAS unsigned char* XB = (q & 1) ? SLOT(S_K) : SLOT(S_B);
                f32x4 a = {0.f, 0.f, 0.f, 0.f};
#pragma unroll
                for (int kk = 0; kk < 2; ++kk) a = MFMA16(frag_n(XA, m0, kk, lo), frag_n(XB, n0, kk, lo), a);
                if (m0 == n0) {
#pragma unroll
                    for (int rr = 0; rr < 4; ++rr) { const bool keep = (q < 2) ? (frv < 4 * fqv + rr) : (frv <= 4 * fqv + rr); a[rr] = keep ? a[rr] : 0.f; } }
                st_tile_T(SLOT((q == 0) ? S_MOFF : (q == 1) ? S_MAK : (q == 2) ? S_MRB : S_MRK), m0, n0, lo, a);
            } else if (task < 48) {
                const int z = task - 36; const int mn = (int)((0xB76321ull >> (4 * (z % 6))) & 0xF);
                st_tile_T(SLOT((z < 6) ? S_MAK : S_MRK), 16 * (mn >> 2), 16 * (mn & 3), lo, (f32x4){0.f, 0.f, 0.f, 0.f});
            } }
#endif
        __syncthreads();
        relaunder(lo);
        f32x4 yacc[4];
#ifdef U_P5
        if (w < 4) {
            f32x4 xr[4];
#pragma unroll
            for (int i = 0; i < 4; ++i) { f32x4 a = {0.f, 0.f, 0.f, 0.f};
#pragma unroll
                for (int kk = 0; kk < 2; ++kk) { if (32 * kk < 16 * i + 16) a = MFMA16(frag_t(SLOT(S_MAK), kk, 16 * i, lo), frag_t(SLOT(S_V), kk, cw, lo), a);
                    a = MFMA16(frag_n(SLOT(S_A), 16 * i, kk, lo), frag_n(SLOT(hcur), cw, kk, lo), a); }
                xr[i] = a; }
#pragma unroll
            for (int i = 0; i < 4; ++i) { f32x4 a = xr[i];
#pragma unroll
                for (int kk = 0; kk < 2; ++kk) if (32 * kk < 16 * i) a = MFMA16(frag_t(SLOT(S_MOFF), kk, 16 * i, lo), frag_n(SLOT(S_ZT), cw, kk, lo), a);
                st_tile_T(SLOT(S_ACC), 16 * i, cw, lo, a);
                asm volatile("" ::: "memory");
                const f32x4 z = MFMA16(frag_t(SLOT(S_D), i >> 1, 16 * i, lo), frag_n(SLOT(S_ACC), cw, i >> 1, lo), (f32x4){0.f, 0.f, 0.f, 0.f});
                st_tile_T(SLOT(S_ZT), 16 * i, cw, lo, z);
                asm volatile("" ::: "memory"); }
#else
        if (w < 4) {
#pragma unroll
            for (int i = 0; i < 4; ++i) { f32x4 a = {0.f, 0.f, 0.f, 0.f};
#pragma unroll
                for (int kk = 0; kk < 2; ++kk) { if (32 * kk < 16 * i + 16) a = MFMA16(frag_t(SLOT(S_MAK), kk, 16 * i, lo), frag_t(SLOT(S_V), kk, cw, lo), a);
                    a = MFMA16(frag_n(SLOT(S_A), 16 * i, kk, lo), frag_n(SLOT(hcur), cw, kk, lo), a); }
#pragma unroll
                for (int kk = 0; kk < 2; ++kk) if (32 * kk < 16 * i) a = MFMA16(frag_t(SLOT(S_MOFF), kk, 16 * i, lo), frag_n(SLOT(S_ZT), cw, kk, lo), a);
                st_tile_T(SLOT(S_ACC), 16 * i, cw, lo, a);
                const f32x4 z = MFMA16(frag_t(SLOT(S_D), i >> 1, 16 * i, lo), frag_n(SLOT(S_ACC), cw, i >> 1, lo), (f32x4){0.f, 0.f, 0.f, 0.f});
                st_tile_T(SLOT(S_ZT), 16 * i, cw, lo, z); }
#endif
        } else {
#pragma unroll
            for (int i = 0; i < 4; ++i) { f32x4 a = {0.f, 0.f, 0.f, 0.f};
#pragma unroll
                for (int kk = 0; kk < 2; ++kk) { if (32 * kk < 16 * i + 16) a = MFMA16(frag_t(SLOT(S_MRK), kk, 16 * i, lo), frag_t(SLOT(S_V), kk, cw, lo), a);
                    a = MFMA16(frag_n(SLOT(S_R), 16 * i, kk, lo), frag_n(SLOT(hcur), cw, kk, lo), a);
                }
                yacc[i] = a; }
        }
        __syncthreads();
        relaunder(lo);
        if (c + 1 < SEQ / 64) RWKV_LOAD(c + 1, tv, c8v);
#ifdef U_P7
        if (w >= 4) {
#pragma unroll
            for (int i = 0; i < 4; ++i) {
#pragma unroll
                for (int rr = 0; rr < 4; ++rr) hacc[i][rr] = hacc[i][rr] * ex2(((const LAS float*)(L + O_CL))[16 * i + 4 * fqv + rr]);
#pragma unroll
                for (int kk = 0; kk < 2; ++kk) { hacc[i] = MFMA16(frag_t(SLOT(S_KT), kk, 16 * i, lo), frag_t(SLOT(S_V), kk, cw, lo), hacc[i]);
                    hacc[i] = MFMA16(frag_t(SLOT(S_BT), kk, 16 * i, lo), frag_n(SLOT(S_ZT), cw, kk, lo), hacc[i]); }
#pragma unroll
                for (int kk = 0; kk < 2; ++kk) if (32 * kk < 16 * i + 16) yacc[i] = MFMA16(frag_t(SLOT(S_MRB), kk, 16 * i, lo), frag_n(SLOT(S_ZT), cw, kk, lo), yacc[i]); }
#pragma unroll
            for (int i = 0; i < 4; ++i) { st_tile_T(SLOT(hnxt), 16 * i, cw, lo, hacc[i]);
#pragma unroll
                for (int rr = 0; rr < 4; ++rr) ((LAS float*)(L + O_YB))[(16 * i + 4 * fqv + rr) * FP + cw + frv] = yacc[i][rr]; }
        }
#else
        if (w >= 4) {
#pragma unroll
            for (int i = 0; i < 4; ++i) {
#pragma unroll
                for (int rr = 0; rr < 4; ++rr) hacc[i][rr] = hacc[i][rr] * ex2(((const LAS float*)(L + O_CL))[16 * i + 4 * fqv + rr]);
#pragma unroll
                for (int kk = 0; kk < 2; ++kk) { hacc[i] = MFMA16(frag_t(SLOT(S_KT), kk, 16 * i, lo), frag_t(SLOT(S_V), kk, cw, lo), hacc[i]);
                    hacc[i] = MFMA16(frag_t(SLOT(S_BT), kk, 16 * i, lo), frag_n(SLOT(S_ZT), cw, kk, lo), hacc[i]); }
                st_tile_T(SLOT(hnxt), 16 * i, cw, lo, hacc[i]);
#pragma unroll
                for (int kk = 0; kk < 2; ++kk) if (32 * kk < 16 * i + 16) yacc[i] = MFMA16(frag_t(SLOT(S_MRB), kk, 16 * i, lo), frag_n(SLOT(S_ZT), cw, kk, lo), yacc[i]);
#pragma unroll
                for (int rr = 0; rr < 4; ++rr) ((LAS float*)(L + O_YB))[(16 * i + 4 * fqv + rr) * FP + cw + frv] = yacc[i][rr]; }
        }
#endif
        __syncthreads();
        { float y[8], g0[8], g1[8]; ld8l((const LAS float*)(L + O_YB) + tv * FP + c8v, y); ld8l((const LAS float*)(L + O_CST) + 10 * 64 + c8v, g0); ld8l((const LAS float*)(L + O_CST) + 11 * 64 + c8v, g1);
          float s = 0.f;
#pragma unroll
          for (int e = 0; e < 8; ++e) s += y[e];
          const float mean = sum8(s) * (1.f / 64.f); float q = 0.f;
#pragma unroll
          for (int e = 0; e < 8; ++e) { y[e] -= mean; q += y[e] * y[e]; }
          const float rs = rsqrtf(sum8(q) * (1.f / 64.f) + RWKV_GN_EPS);
#pragma unroll
          for (int e = 0; e < 8; ++e) y[e] = y[e] * rs * g0[e] + g1[e] + cb * v[e];
          *(u32x4*)(Yout + ((size_t)b * SEQ + c * 64 + tv) * 512 + h * 64 + c8v) = pack8(y); }
        { const int tmp = hcur; hcur = hnxt; hnxt = tmp; }
    }
    __syncthreads();
#undef SLOT
#undef RWKV_LOAD
}
}

namespace gla {
using rwkv::vtr; using rwkv::unpack8; using rwkv::pack8; using rwkv::ld8l; using rwkv::ex2; using rwkv::LOG2E; using rwkv::LN2; using rwkv::MFMA16;
constexpr int LP = 72, VP = 136, TB = 64 * LP * 2;
constexpr int B_QH = 0, B_KH = TB, B_KT = 2 * TB, B_PT = 3 * TB, B_VV = 4 * TB, B_ST = B_VV + 64 * VP * 2, B_OB = B_ST + 128 * LP * 2, B_WT = B_OB + 64 * 132 * 4,
              B_CL = B_WT + 8 * 64 * 4, B_AUP = B_CL + 64 * 4, B_AB = B_AUP + 16 * 64 * 4, B_GN = B_AB + 64 * 4, B_END = B_GN + 128 * 4;
static_assert(B_END <= 131072, "gla lds");
struct LaneOff { int bn, bt, btv, bs; };
__device__ __forceinline__ LaneOff lane_off(int fr, int fq) { LaneOff o; o.bn = (fr * LP + 8 * fq) * 2; o.bt = ((8 * fq + (fr >> 2)) * LP + 4 * (fr & 3)) * 2; o.btv = ((8 * fq + (fr >> 2)) * VP + 4 * (fr & 3)) * 2; o.bs = (fr * LP + 4 * fq) * 2; return o; }
__device__ __forceinline__ void relaunder(LaneOff& o) { asm volatile("" : "+v"(o.bn), "+v"(o.bt), "+v"(o.btv), "+v"(o.bs)); }
__device__ __forceinline__ bf16x8 frag_t(const LAS unsigned char* tile, int kk, int c0, const LaneOff& o) {
    const LAS unsigned char* q = tile + o.bt + (32 * kk * LP + c0) * 2; const s16x4 lo = vtr(q), hi = vtr(q + 4 * LP * 2); return (bf16x8){lo[0], lo[1], lo[2], lo[3], hi[0], hi[1], hi[2], hi[3]}; }
__device__ __forceinline__ bf16x8 frag_tv(const LAS unsigned char* tile, int kk, int c0, const LaneOff& o) {
    const LAS unsigned char* q = tile + o.btv + (32 * kk * VP + c0) * 2; const s16x4 lo = vtr(q), hi = vtr(q + 4 * VP * 2); return (bf16x8){lo[0], lo[1], lo[2], lo[3], hi[0], hi[1], hi[2], hi[3]}; }
__device__ __forceinline__ bf16x8 frag_n(const LAS unsigned char* tile, int r0, int kk, const LaneOff& o) { return *(const LAS bf16x8*)(tile + o.bn + (r0 * LP + 32 * kk) * 2); }
__device__ __forceinline__ void st_tile_T(LAS unsigned char* tile, int m0, int n0, const LaneOff& o, const f32x4 c) { u32x2 w; w.x = pk2(c[0], c[1]); w.y = pk2(c[2], c[3]); *(LAS u32x2*)(tile + o.bs + (n0 * LP + m0) * 2) = w; }

__device__ __forceinline__ void gla_unit(int l, int b, int h, LAS unsigned char* L, unsigned* done_ctr) {
    const Params p = load_params();
    const bf16_t* PA = (const bf16_t*)(p.ws + WS_PA); bf16_t* Yout = (bf16_t*)(p.ws + WS_YS) + (size_t)2 * T * 512;
    const int tid = opaque_tid(), lane = tid & 63, fr = lane & 15, fq = lane >> 4; const int w = __builtin_amdgcn_readfirstlane(tid >> 6);
    const int t = tid >> 3, c8 = (tid & 7) * 8;
    LaneOff lo = lane_off(fr, fq);
    for (int e = tid; e < 16 * 64; e += 512) ((LAS float*)(L + B_AUP))[e] = p.gla_a_up[(size_t)l * 16 * 256 + (e >> 6) * 256 + h * 64 + (e & 63)];
    if (tid < 64) ((LAS float*)(L + B_AB))[tid] = p.gla_a_b[l * 256 + h * 64 + tid];
    if (tid < 128) ((LAS float*)(L + B_GN))[tid] = p.gla_norm[l * 512 + h * 128 + tid];
    for (int e = tid; e < 128 * LP / 2; e += 512) ((LAS unsigned*)(L + B_ST))[e] = 0u;
    for (int e = tid; e < TB / 4; e += 512) ((LAS unsigned*)(L + B_PT))[e] = 0u;
    f32x4 sacc[4];
#pragma unroll
    for (int m = 0; m < 4; ++m) sacc[m] = (f32x4){0.f, 0.f, 0.f, 0.f};
    u32x4 rq, rk, rv0, rv1, rl0, rl1;
#define GLA_LOAD(c) do { const bf16_t* s_ = PA + ((size_t)b * SEQ + (c) * 64 + t) * NA; rq = *(const u32x4*)(s_ + GQ + h * 64 + c8); rk = *(const u32x4*)(s_ + GK + h * 64 + c8); \
        rv0 = *(const u32x4*)(s_ + GV + h * 128 + 2 * c8); rv1 = *(const u32x4*)(s_ + GV + h * 128 + 2 * c8 + 8); rl0 = *(const u32x4*)(s_ + GLAT); rl1 = *(const u32x4*)(s_ + GLAT + 8); } while (0)
    GLA_LOAD(0);
    __syncthreads();
    for (int c = 0; c < SEQ / 64; ++c) {
        int c8v = c8, tv = t, frv = fr, fqv = fq; asm volatile("" : "+v"(c8v), "+v"(tv), "+v"(frv), "+v"(fqv));
        const int twv = tv & 7;
        float cs[8];
        { float lat[16]; { float a8[8]; unpack8(rl0, a8);
#pragma unroll
              for (int j = 0; j < 8; ++j) lat[j] = a8[j];
              unpack8(rl1, a8);
#pragma unroll
              for (int j = 0; j < 8; ++j) lat[8 + j] = a8[j]; }
          float z[8]; ld8l((const LAS float*)(L + B_AB) + c8v, z);
#pragma unroll
          for (int j = 0; j < 16; ++j) { float a8[8]; ld8l((const LAS float*)(L + B_AUP) + j * 64 + c8v, a8);
#pragma unroll
              for (int e = 0; e < 8; ++e) z[e] += lat[j] * a8[e]; }
#pragma unroll
          for (int e = 0; e < 8; ++e) { const float x = -z[e]; const float sp = fmaxf(x, 0.f) + LN2 * __builtin_amdgcn_logf(1.0f + ex2(-fabsf(x) * LOG2E));
              float v_ = -sp * (LOG2E / 16.0f);
              float y = __shfl_up(v_, 8); if (twv >= 1) v_ += y;
              y = __shfl_up(v_, 16); if (twv >= 2) v_ += y;
              y = __shfl_up(v_, 32); if (twv >= 4) v_ += y;
              cs[e] = v_; }
          if (twv == 7) { LAS float* WT = (LAS float*)(L + B_WT) + w * 64 + c8v;
#pragma unroll
              for (int e = 0; e < 8; ++e) WT[e] = cs[e]; } }
        __syncthreads();
        { float off[8], tot[8];
#pragma unroll
          for (int e = 0; e < 8; ++e) { off[e] = 0.f; tot[e] = 0.f; }
#pragma unroll
          for (int g = 0; g < 8; ++g) { float x[8]; ld8l((const LAS float*)(L + B_WT) + g * 64 + c8v, x);
#pragma unroll
              for (int e = 0; e < 8; ++e) { if (g < w) off[e] += x[e]; tot[e] += x[e]; } }
          if (tv == 0) { LAS float* CL = (LAS float*)(L + B_CL) + c8v;
#pragma unroll
              for (int e = 0; e < 8; ++e) CL[e] = tot[e]; }
          float q8[8], k8[8], o[8], en[8]; unpack8(rq, q8); unpack8(rk, k8); const int toff = (tv * LP + c8v) * 2;
#pragma unroll
          for (int e = 0; e < 8; ++e) { cs[e] += off[e]; en[e] = ex2(-cs[e]); o[e] = q8[e] * 0.125f * __builtin_amdgcn_rcpf(en[e]); }
          *(LAS u32x4*)(L + B_QH + toff) = pack8(o);
#pragma unroll
          for (int e = 0; e < 8; ++e) o[e] = k8[e] * en[e];
          *(LAS u32x4*)(L + B_KH + toff) = pack8(o);
#pragma unroll
          for (int e = 0; e < 8; ++e) o[e] = k8[e] * ex2(tot[e] - cs[e]);
          *(LAS u32x4*)(L + B_KT + toff) = pack8(o);
          *(LAS u32x4*)(L + B_VV + (tv * VP + 2 * c8v) * 2) = rv0; *(LAS u32x4*)(L + B_VV + (tv * VP + 2 * c8v + 8) * 2) = rv1; }
        if (c + 1 < SEQ / 64) GLA_LOAD(c + 1);
        __syncthreads();
        relaunder(lo);
        { const int m0 = 16 * (w >> 1);
#pragma unroll
          for (int nn = 0; nn < 2; ++nn) { const int n0 = 32 * (w & 1) + 16 * nn;
              if (n0 <= m0) { f32x4 a = {0.f, 0.f, 0.f, 0.f};
#pragma unroll
                  for (int kk = 0; kk < 2; ++kk) a = MFMA16(frag_n(L + B_QH, m0, kk, lo), frag_n(L + B_KH, n0, kk, lo), a);
                  if (n0 == m0) {
#pragma unroll
                      for (int rr = 0; rr < 4; ++rr) a[rr] = (frv <= 4 * fqv + rr) ? a[rr] : 0.f; }
                  st_tile_T(L + B_PT, m0, n0, lo, a); } } }
        __syncthreads();
        relaunder(lo);
        { const int n0 = 16 * w;
#pragma unroll
          for (int m = 0; m < 4; ++m) { f32x4 a = {0.f, 0.f, 0.f, 0.f};
#pragma unroll
              for (int kk = 0; kk < 2; ++kk) { if (32 * kk < 16 * m + 16) a = MFMA16(frag_t(L + B_PT, kk, 16 * m, lo), frag_tv(L + B_VV, kk, n0, lo), a);
                  a = MFMA16(frag_n(L + B_QH, 16 * m, kk, lo), frag_n(L + B_ST, n0, kk, lo), a); }
#pragma unroll
              for (int rr = 0; rr < 4; ++rr) ((LAS float*)(L + B_OB))[(16 * m + 4 * fqv + rr) * 132 + n0 + frv] = a[rr]; }
          asm volatile("" ::: "memory");
#pragma unroll
          for (int m = 0; m < 4; ++m) { f32x4 a = sacc[m];
#pragma unroll
              for (int rr = 0; rr < 4; ++rr) a[rr] *= ex2(((const LAS float*)(L + B_CL))[16 * m + 4 * fqv + rr]);
#pragma unroll
              for (int kk = 0; kk < 2; ++kk) a = MFMA16(frag_t(L + B_KT, kk, 16 * m, lo), frag_tv(L + B_VV, kk, n0, lo), a);
              sacc[m] = a; st_tile_T(L + B_ST, 16 * m, n0, lo, a); } }
        __syncthreads();
        { float v0[8], v1[8], g0[8], g1[8]; float ss = 0.f; const LAS float* ob = (const LAS float*)(L + B_OB) + tv * 132 + 2 * c8v;
          ld8l(ob, v0); ld8l(ob + 8, v1);
#pragma unroll
          for (int e = 0; e < 8; ++e) ss += v0[e] * v0[e] + v1[e] * v1[e];
          ss = sum8(ss);
          const float rstd = rsqrtf(ss * (1.f / 128.f) + NORM_EPS);
          ld8l((const LAS float*)(L + B_GN) + 2 * c8v, g0); ld8l((const LAS float*)(L + B_GN) + 2 * c8v + 8, g1);
          float o0[8], o1[8];
#pragma unroll
          for (int e = 0; e < 8; ++e) { o0[e] = v0[e] * rstd * g0[e]; o1[e] = v1[e] * rstd * g1[e]; }
          bf16_t* dst = Yout + ((size_t)b * SEQ + c * 64 + tv) * 512 + h * 128 + 2 * c8v;
          *(u32x4*)dst = pack8(o0); *(u32x4*)(dst + 8) = pack8(o1); }
    }
    asm volatile("s_waitcnt vmcnt(0)" ::: "memory");
    __syncthreads();
    if (tid == 0) __hip_atomic_fetch_add(done_ctr, 1u, __ATOMIC_RELEASE, __HIP_MEMORY_SCOPE_AGENT);
#undef GLA_LOAD
}
}

#define XB_TMO      128
#define XB_XCNT(j)  (256  + 64 * (j))
#define XB_XSUB(j)  (1280 + 64 * (j))
#define XB_XGEN(j)  (2304 + 64 * (j))
#define XB_TOP      3328
#define XB_TOPGEN   3392
#define XCD_BAR_WORDS 3456
#define XB_SPIN_CAP (1u << 18)

__device__ __forceinline__ unsigned xb_ld(unsigned* p)              { return __hip_atomic_load(p, __ATOMIC_RELAXED, __HIP_MEMORY_SCOPE_AGENT); }
__device__ __forceinline__ unsigned xb_add(unsigned* p, unsigned v) { return __hip_atomic_fetch_add(p, v, __ATOMIC_RELAXED, __HIP_MEMORY_SCOPE_AGENT); }
__device__ __forceinline__ unsigned xb_xcc_id() { return (unsigned)__builtin_amdgcn_s_getreg((3 << 11) | 20) & 0xFu; }
#define XB_SPIN(cond, bar) do { unsigned _sp = 0; while (cond) { __builtin_amdgcn_s_sleep(1); \
    if ((++_sp & 255u) == 0u) { if (xb_ld(&(bar)[XB_TMO])) break; if (_sp > XB_SPIN_CAP) { atomicAdd(&(bar)[XB_TMO], 1u); break; } } } } while (0)

struct XcdBarrier {
    unsigned* bar; unsigned x;
    volatile LAS unsigned* st;
};

__device__ __forceinline__ XcdBarrier xcd_barrier_post(unsigned* bar, volatile LAS unsigned* st) {
    XcdBarrier b; b.bar = bar; b.x = xb_xcc_id(); b.st = st;
    if (threadIdx.x == 0) (void)xb_add(&bar[XB_XCNT(b.x)], 1u);
    return b;
}
__device__ __forceinline__ void xcd_barrier_complete(unsigned* bar, unsigned x, unsigned& nloc, unsigned& nx) {
    const unsigned G = gridDim.x * gridDim.y * gridDim.z;
    unsigned sum, cnt, mine, sp = 0u;
    for (;;) {
        sum = 0u; cnt = 0u; mine = 0u;
#pragma unroll
        for (unsigned j = 0; j < 16; ++j) { const unsigned c = xb_ld(&bar[XB_XCNT(j)]); sum += c; cnt += (c > 0u) ? 1u : 0u; mine = (j == x) ? c : mine; }
        if (sum == G) break;
        __builtin_amdgcn_s_sleep(1);
        if ((++sp & 255u) == 0u) { if (xb_ld(&bar[XB_TMO])) break; if (sp > XB_SPIN_CAP) { atomicAdd(&bar[XB_TMO], 1u); break; } }
    }
    nloc = mine > 0u ? mine : 1u; nx = cnt > 0u ? cnt : 1u;
}

__device__ __forceinline__ void xcd_barrier(const XcdBarrier& b) {
    asm volatile("s_waitcnt vmcnt(0)" ::: "memory");
    __syncthreads();
    if (threadIdx.x == 0) {
        unsigned* bar = b.bar;
        __builtin_amdgcn_s_waitcnt(0);
        unsigned nloc = b.st[0], nx = b.st[1];
        if (nloc == 0u) { xcd_barrier_complete(bar, b.x, nloc, nx); b.st[0] = nloc; b.st[1] = nx; }
        const unsigned old = xb_add(&bar[XB_XSUB(b.x)], 1u);
        const unsigned gen = old / nloc;
        if (old + 1u == (gen + 1u) * nloc) {
            __builtin_amdgcn_fence(__ATOMIC_RELEASE, "agent");
            asm volatile("s_waitcnt vmcnt(0)" ::: "memory");
            const unsigned og = xb_add(&bar[XB_TOP], 1u);
            const unsigned tg = og / nx;
            if (og + 1u == (tg + 1u) * nx) xb_add(&bar[XB_TOPGEN], 1u);
            else XB_SPIN(xb_ld(&bar[XB_TOPGEN]) == tg, bar);
            __builtin_amdgcn_fence(__ATOMIC_ACQUIRE, "agent");
            xb_add(&bar[XB_XGEN(b.x)], 1u);
            asm volatile("s_waitcnt vmcnt(0)" ::: "memory");
        } else {
            XB_SPIN(xb_ld(&bar[XB_XGEN(b.x)]) == gen, bar);
            __builtin_amdgcn_fence(__ATOMIC_ACQUIRE, "agent");
            asm volatile("s_waitcnt vmcnt(0)" ::: "memory");
        }
    }
    __syncthreads();
}

constexpr int NWAVES = 8, NTHREADS = 512;
constexpr int LDS_MISC = 155648, LDS_BYTES = 159744;
constexpr int PH_PER_LAYER = 8, N_PHASES = 1 + DEPTH * PH_PER_LAYER;
constexpr int CW_BAR = 4096;
constexpr int MG_BLOCKS = 192;
constexpr int RWKV_BLOCKS = 64, SUB_BLOCKS = 256 - RWKV_BLOCKS;
constexpr int N_ATT_UNITS = 64 * (SEQ / 512), N_MIX_ITEMS = 32 + N_ATT_UNITS;
#ifndef MK_MULTI_LAUNCH
#define MK_MULTI_LAUNCH 0
#endif

__device__ __forceinline__ void sub_barrier(unsigned* cnt, unsigned target) {
    asm volatile("s_waitcnt vmcnt(0)" ::: "memory");
    __syncthreads();
    if (threadIdx.x == 0) {
        __builtin_amdgcn_fence(__ATOMIC_RELEASE, "agent"); asm volatile("s_waitcnt vmcnt(0)" ::: "memory");
        __hip_atomic_fetch_add(cnt, 1u, __ATOMIC_RELAXED, __HIP_MEMORY_SCOPE_AGENT);
        unsigned sp = 0; while (__hip_atomic_load(cnt, __ATOMIC_RELAXED, __HIP_MEMORY_SCOPE_AGENT) < target && ++sp < (1u << 24)) __builtin_amdgcn_s_sleep(2);
        __builtin_amdgcn_fence(__ATOMIC_ACQUIRE, "agent"); asm volatile("s_waitcnt vmcnt(0)" ::: "memory");
    }
    __syncthreads();
}
__global__ void __launch_bounds__(NTHREADS, 2) hybrid_fwd(Params p_unused) {
    extern __shared__ __attribute__((aligned(16))) unsigned char lds[];
    cg::grid_group grid = cg::this_grid();
#define G ((int)gridDim.x)
#define bx ((int)blockIdx.x)
#define NGW (G * NWAVES)
#define PHASE_VARS const int tid = opaque_tid(), lane = tid & 63, wave = __builtin_amdgcn_readfirstlane(tid >> 6), gw = bx * NWAVES + wave; (void)lane; (void)gw
    LAS unsigned char* ldsl = (LAS unsigned char*)lds;
    { volatile LAS unsigned* misc = (volatile LAS unsigned*)(ldsl + LDS_MISC); if (threadIdx.x < 64) misc[threadIdx.x] = 0u; __syncthreads(); }
    (void)xcd_barrier_post((unsigned*)(kargs()->ws + WS_CTL) + CW_BAR, (volatile LAS unsigned*)(ldsl + LDS_MISC) + 8);
#define GRID_BAR() do { XcdBarrier xb_; xb_.bar = (unsigned*)(kargs()->ws + WS_CTL) + CW_BAR; xb_.x = xb_xcc_id(); xb_.st = (volatile LAS unsigned*)(ldsl + LDS_MISC) + 8; xcd_barrier(xb_); } while (0)
#ifndef EPI_ALIGN_PD1
#define EPI_ALIGN_PD1 true
#endif
#ifndef EPI_ALIGN_PA2
#define EPI_ALIGN_PA2 true
#endif
#ifndef REPEAT_PH
#define REPEAT_PH 0
#endif
#ifndef PH_MASK
#define PH_MASK 0xFFFF
#endif
#ifndef MIX_MASK
#define MIX_MASK 7
#endif
#define IN(k) true
#define EN(b) ((PH_MASK >> (b)) & 1)
#define SEAM(k) do { if (IN(k) && IN((k) + 1)) { if ((k) == 0) grid.sync(); else GRID_BAR(); } } while (0)
#define WSP(type, off) ((type*)(ws + (off)))

    if (EN(0) && IN(0)) { PHASE_VARS;
        convert_weights(0, lds, gw, NGW, wave, lane);
        KArgs kp = kargs(); unsigned char* ws = kp->ws; const int* positions = kp->positions; const float* x = kp->x; const float* g = kp->norm_pre;
        f32x2* ROPE = WSP(f32x2, WS_ROPE); bf16_t* HB = WSP(bf16_t, WS_HB);
        for (int i = bx * NTHREADS + tid; i < T * 16; i += G * NTHREADS) {
            const int t = i >> 4, j = i & 15; const float inv = exp2f(-(float)j * (13.287712379549449f / 16.0f));
            const float ang = (float)positions[t] * inv; const float k = rintf(ang * 0.15915494309189535f);
            float r = fmaf(-k, 6.2831854820251465f, ang); r = fmaf(-k, -1.7484555314695172e-7f, r);
            ROPE[i] = (f32x2){__cosf(r), __sinf(r)};
        }
        for (int m = gw; m < T; m += NGW) hb_row(x + (size_t)m * DM, g, HB + (size_t)m * DM, lane);
    }
    SEAM(0);
#ifdef EXTRA_SYNCS
    for (int i = 0; i < EXTRA_SYNCS; ++i) GRID_BAR();
#endif

    for (int l = 0; l < DEPTH; ++l) {
        const int P0 = 1 + l * PH_PER_LAYER;
        for (int rp = 0; rp < ((REPEAT_PH == 1) ? 2 : 1); ++rp) { if (rp) GRID_BAR();
        if (EN(1) && IN(P0 + 0)) {
            unsigned char* ws = kargs()->ws;
            pg8::PlainOrder S{(const char*)WSP(bf16_t, WS_HB), (const char*)WSP(bf16_t, WS_WIN), 1024, 1024, T / 256, NA / 256, G, bx, 0};
            EpiStore E{WSP(bf16_t, WS_PA), NA, ldsl};
#ifdef STAGGER_US
            if (bx >= 128) { const unsigned long long t0_ = __builtin_amdgcn_s_memrealtime(); while (__builtin_amdgcn_s_memrealtime() - t0_ < (unsigned long long)(STAGGER_US * 100)) __builtin_amdgcn_s_sleep(8); }
#endif
            pg8::gemm_phase<EpiStore, pg8::PlainOrder, true>(ldsl, pg8::Gemm{1024, 1024, 1024}, S, E);
#ifdef PROBE_PA1NULL
#endif
        }
        }
        SEAM(P0 + 0);
        if (EN(2) && IN(P0 + 1)) { PHASE_VARS;
            if (bx >= RWKV_BLOCKS) {
                unsigned char* ws = kargs()->ws; const int c2 = bx - RWKV_BLOCKS;
                { const bf16_t* PA = WSP(bf16_t, WS_PA); const f32x2* ROPE = WSP(f32x2, WS_ROPE); float* RSTDQ = WSP(float, WS_RSTD); float* RSTDKV = RSTDQ + T; bf16_t* Kb = WSP(bf16_t, WS_K);
                  for (int m = c2 * NWAVES + wave; m < T; m += SUB_BLOCKS * NWAVES) mla_prep_row(PA + (size_t)m * NA, ROPE + (size_t)m * 16, RSTDQ + m, RSTDKV + m, Kb + (size_t)m * KP, lane); }
                sub_barrier((unsigned*)(ws + WS_CTL) + 64 * 40, (unsigned)SUB_BLOCKS * (unsigned)(2 * l + 1));
                { pg8::PlainOrder S{(const char*)(WSP(bf16_t, WS_PA) + CQ), (const char*)WSP(bf16_t, WS_WUQ), NA, 256, T / 256, 3, SUB_BLOCKS, c2, 0};
                  EpiQ E{WSP(bf16_t, WS_Q), WSP(float, WS_RSTD), ldsl};
                  pg8::gemm_phase<EpiQ, pg8::PlainOrder, true>(ldsl, pg8::Gemm{NA, 256, 256}, S, E); }
                { pg8::PlainOrder S{(const char*)(WSP(bf16_t, WS_PA) + CKV), (const char*)WSP(bf16_t, WS_WUKV), NA, 256, T / 256, 4, SUB_BLOCKS, c2, 0};
                  EpiKV E{WSP(bf16_t, WS_K), WSP(bf16_t, WS_V), WSP(float, WS_RSTD) + T, ldsl};
                  pg8::gemm_phase<EpiKV, pg8::PlainOrder, true>(ldsl, pg8::Gemm{NA, 256, 256}, S, E); }
                sub_barrier((unsigned*)(kargs()->ws + WS_CTL) + 64 * 40, (unsigned)SUB_BLOCKS * (unsigned)(2 * l + 2));
            } else {
#ifdef RWKV_TWICE
#pragma unroll 1
                for (int rep_ = 0; rep_ < RWKV_TWICE; ++rep_) { rwkv::rwkv_unit(l, bx >> 3, bx & 7, ldsl); __syncthreads(); }
#else
                rwkv::rwkv_unit(l, bx >> 3, bx & 7, ldsl);
#endif
            }
        }
        if (EN(4) && IN(P0 + 3)) { PHASE_VARS;
            volatile LAS unsigned* qw = (volatile LAS unsigned*)(ldsl + LDS_MISC);
            for (;;) {
                __syncthreads();
                if (tid == 0) { unsigned* CTL = (unsigned*)(kargs()->ws + WS_CTL); qw[0] = atomicAdd(CTL + 64 * (1 + l), 1u); }
                __syncthreads();
                const int it = __builtin_amdgcn_readfirstlane((int)qw[0]);
                if (it >= N_MIX_ITEMS) break;
                if (it < 32) gla::gla_unit(l, it >> 2, it & 3, ldsl, (unsigned*)(kargs()->ws + WS_CTL) + 64 * (24 + l));
                else { const int a = it - 32; att::attn_unit((a & 63) >> 3, a & 7, (SEQ / 512 - 1) - (a >> 6), ldsl, (unsigned*)(kargs()->ws + WS_CTL) + 64 * (16 + l)); }
            }
            { unsigned* ctl = (unsigned*)(kargs()->ws + WS_CTL);
              __syncthreads();
              if (tid == 0) { const unsigned tk = __hip_atomic_fetch_add(ctl + 64 * (20 + l), 1u, __ATOMIC_RELAXED, __HIP_MEMORY_SCOPE_AGENT); qw[0] = tk;
                  if (tk < (unsigned)MG_BLOCKS) { unsigned sp = 0; while (__hip_atomic_load(ctl + 64 * (16 + l), __ATOMIC_RELAXED, __HIP_MEMORY_SCOPE_AGENT) < (unsigned)N_ATT_UNITS && ++sp < (1u << 22)) __builtin_amdgcn_s_sleep(8); }
                  __builtin_amdgcn_fence(__ATOMIC_ACQUIRE, "agent"); asm volatile("s_waitcnt vmcnt(0)" ::: "memory"); }
              __syncthreads();
              const int tk = __builtin_amdgcn_readfirstlane((int)qw[0]);
              if (tk < MG_BLOCKS) {
                  unsigned char* ws = kargs()->ws;
                  pg8::PlainOrder S{(const char*)WSP(bf16_t, WS_HB), (const char*)(WSP(bf16_t, WS_WIN) + (size_t)(NA + 1536) * 1024), 1024, 1024, T / 256, 12, MG_BLOCKS, tk, 0};
                  EpiGateMG8 E{WSP(unsigned char, WS_SMG8), ldsl};
                  pg8::gemm_phase<EpiGateMG8, pg8::PlainOrder, true>(ldsl, pg8::Gemm{1024, 1024, 1024}, S, E);
                  __syncthreads();
                  if (tid == 0) { unsigned sp = 0; while (__hip_atomic_load(ctl + 64 * (24 + l), __ATOMIC_RELAXED, __HIP_MEMORY_SCOPE_AGENT) < 32u && ++sp < (1u << 22)) __builtin_amdgcn_s_sleep(8);
                      __builtin_amdgcn_fence(__ATOMIC_ACQUIRE, "agent"); asm volatile("s_waitcnt vmcnt(0)" ::: "memory"); }
                  __syncthreads();
                  pg8::PlainOrder S2{(const char*)WSP(bf16_t, WS_HB), (const char*)(WSP(bf16_t, WS_WIN) + (size_t)NA * 1024), 1024, 1024, T / 256, 4, MG_BLOCKS, tk, 2};
                  EpiGateBG E2{WSP(bf16_t, WS_YS), 0, 2, ldsl};
                  pg8::gemm_phase<EpiGateBG, pg8::PlainOrder, true>(ldsl, pg8::Gemm{1024, 1024, 1024}, S2, E2);
              } }
        }
        SEAM(P0 + 3);
        if (EN(5) && IN(P0 + 4)) {
            unsigned char* ws = kargs()->ws;
            pg8::PlainOrder S{(const char*)WSP(bf16_t, WS_HB), (const char*)(WSP(bf16_t, WS_WIN) + (size_t)(NA + 512) * 1024), 1024, 1024, T / 256, 2, G, bx, 0};
            EpiGateBG E{WSP(bf16_t, WS_YS), 2, 0, ldsl};
            pg8::gemm_phase<EpiGateBG, pg8::PlainOrder, true>(ldsl, pg8::Gemm{1024, 1024, 1024}, S, E);
        }
        SEAM(P0 + 4);
        for (int rp = 0; rp < ((REPEAT_PH == 6 && l == 0) ? 2 : 1); ++rp) { if (rp) GRID_BAR();
        if (EN(6) && IN(P0 + 5)) {
            unsigned char* ws = kargs()->ws;
            pg8::GroupOrder3 S{(const char*)WSP(bf16_t, WS_YS), (const char*)WSP(bf16_t, WS_WBO), 512, 512, T / 256, 4, G, bx, (size_t)T * 512 * 2, (size_t)1024 * 512 * 2};
            EpiMerge E{WSP(bf16_t, WS_MG), WSP(unsigned char, WS_SMG8), ldsl};
            pg8::gemm_phase<EpiMerge, pg8::GroupOrder3, EPI_ALIGN_PD1>(ldsl, pg8::Gemm{512, 512, 512}, S, E);
        }
        }
        SEAM(P0 + 5);
        for (int rp = 0; rp < ((REPEAT_PH == 7 && l == 0) ? 2 : 1); ++rp) { if (rp) GRID_BAR();
        if (EN(7) && IN(P0 + 6)) {
            unsigned char* ws = kargs()->ws;
            pg8::PlainOrder S{(const char*)WSP(bf16_t, WS_MG), (const char*)WSP(bf16_t, WS_WOUT), 1024, 1024, T / 256, 4, G, bx, 0};
            EpiStore E{WSP(bf16_t, WS_OF), 1024, ldsl};
            pg8::gemm_phase<EpiStore, pg8::PlainOrder, true>(ldsl, pg8::Gemm{1024, 1024, 1024}, S, E);
        }
        }
        SEAM(P0 + 6);
        if (EN(8) && IN(P0 + 7)) { PHASE_VARS;
            const bool more = (l + 1 < DEPTH);
            if (more) convert_weights(l + 1, lds, gw, NGW, wave, lane);
            KArgs kp = kargs(); unsigned char* ws = kp->ws; float* out = kp->out; const float* xold = (l == 0) ? kp->x : out; const float* gpost = kp->norm_post + l * DM; const float* gnext = more ? kp->norm_pre + (l + 1) * DM : nullptr;
            const bf16_t* OF = WSP(bf16_t, WS_OF); bf16_t* HB = WSP(bf16_t, WS_HB);
            for (int m = gw; m < T; m += NGW)
                final_row(OF + (size_t)m * DM, xold + (size_t)m * DM, gpost, out + (size_t)m * DM, gnext, HB + (size_t)m * DM, lane);
        }
        if (l + 1 < DEPTH) SEAM(P0 + 7);
    }
#undef IN
#undef EN
#undef SEAM
#undef WSP
#undef PHASE_VARS
#undef G
#undef bx
#undef NGW
}

extern "C" void kernel_launch(void* const* d_in, const int* in_sizes, int n_in, void* d_out, int out_size, void* d_ws, size_t ws_size, hipStream_t stream) {
    static int grid = 0;
    if (grid == 0) {
        if (n_in != 24 || in_sizes[0] != T * DM || out_size != T * DM || ws_size < WS_END) {
            fprintf(stderr, "kernel_launch: unexpected shapes (n_in %d, in0 %d, out %d, ws %zu; need ws >= %zu); nothing launched\n", n_in, n_in > 0 ? in_sizes[0] : -1, out_size, ws_size, (size_t)WS_END);
            grid = -1; return; }
        int dev = 0, cus = 0, per_cu = 0;
        (void)hipGetDevice(&dev); (void)hipDeviceGetAttribute(&cus, hipDeviceAttributeMultiprocessorCount, dev);
        if (hipFuncSetAttribute((const void*)hybrid_fwd, hipFuncAttributeMaxDynamicSharedMemorySize, LDS_BYTES) != hipSuccess) { fprintf(stderr, "kernel_launch: hipFuncSetAttribute failed\n"); grid = -1; return; }
        if (hipOccupancyMaxActiveBlocksPerMultiprocessor(&per_cu, (const void*)hybrid_fwd, NTHREADS, LDS_BYTES) != hipSuccess || per_cu < 1) {
            fprintf(stderr, "kernel_launch: occupancy query reports %d blocks per CU\n", per_cu); per_cu = 1; }
        (void)hipGetLastError();
        grid = cus * (per_cu < 1 ? 1 : 1);
        fprintf(stderr, "kernel_launch: grid %d (cus %d, occupancy %d), ws %zu\n", grid, cus, per_cu, ws_size);
    }
    if (grid < 0) return;
    (void)hipMemsetAsync((char*)d_ws + WS_CTL, 0, 65536, stream);
    Params p{};
    p.x = (const float*)d_in[0]; p.positions = (const int*)d_in[1]; p.norm_pre = (const float*)d_in[2]; p.w_in = (const float*)d_in[3]; p.mla_q_norm = (const float*)d_in[4]; p.mla_kv_norm = (const float*)d_in[5];
    p.mla_w_uq = (const float*)d_in[6]; p.mla_w_ukv = (const float*)d_in[7]; p.rwkv_mu = (const float*)d_in[8]; p.rwkv_w0 = (const float*)d_in[9]; p.rwkv_w_up = (const float*)d_in[10]; p.rwkv_a0 = (const float*)d_in[11];
    p.rwkv_a_up = (const float*)d_in[12]; p.rwkv_k_k = (const float*)d_in[13]; p.rwkv_k_a = (const float*)d_in[14]; p.rwkv_r_k = (const float*)d_in[15]; p.rwkv_ln_w = (const float*)d_in[16]; p.rwkv_ln_b = (const float*)d_in[17];
    p.gla_a_up = (const float*)d_in[18]; p.gla_a_b = (const float*)d_in[19]; p.gla_norm = (const float*)d_in[20]; p.w_branch_out = (const float*)d_in[21]; p.w_out = (const float*)d_in[22]; p.norm_post = (const float*)d_in[23];
    p.out = (float*)d_out; p.ws = (unsigned char*)d_ws;
#if MK_MULTI_LAUNCH
    for (int ph = 0; ph < N_PHASES; ++ph) { p.ph_lo = ph; p.ph_hi = ph + 1; void* args[] = {&p};
        hipError_t e = hipLaunchCooperativeKernel((const void*)hybrid_fwd, dim3(grid), dim3(NTHREADS), args, LDS_BYTES, stream);
        if (e != hipSuccess) { fprintf(stderr, "kernel_launch: launch of phase %d failed: %s\n", ph, hipGetErrorString(e)); break; } }
#else
    p.ph_lo = 0; p.ph_hi = N_PHASES; void* args[] = {&p};
    hipError_t e = hipLaunchCooperativeKernel((const void*)hybrid_fwd, dim3(grid), dim3(NTHREADS), args, LDS_BYTES, stream);
    if (e != hipSuccess) fprintf(stderr, "kernel_launch: cooperative launch failed: %s (grid %d)\n", hipGetErrorString(e), grid);
#endif
}
```

```cpp
#include <hip/hip_runtime.h>
#include <hip/hip_cooperative_groups.h>
#include <cstdio>
#include <cstdint>
#include <cmath>
namespace cg = cooperative_groups;
#define U_P2 1
#define U_P5 1
#define U_P7 1
#define V_A 1
#define V_B 1
#define V_V 1
namespace pg8 {
#define PG8_LAS __attribute__((address_space(3)))
typedef unsigned short bf16_t;
typedef short bf16x8 __attribute__((ext_vector_type(8)));
typedef float f32x4 __attribute__((ext_vector_type(4)));
typedef unsigned u32x4 __attribute__((ext_vector_type(4)));
typedef unsigned u32x2 __attribute__((ext_vector_type(2)));
constexpr int BM = 256, BK = 64, HALF = 128, HTB = HALF * BK * 2  , STAGE_BYTES = 8 * HTB, NXCD = 8, WGM = 8;

__host__ __device__ __forceinline__ int lds_byte(int r, int c) { const int st = (r >> 4) * 2 + (c >> 5), rr = r & 15, cc = c & 31, ob = rr * 64 + cc * 2; return st * 1024 + (ob ^ (((ob >> 9) & 1) << 5)); }
__host__ __device__ __forceinline__ void stage_rc(int b, int& R, int& C) { const int st = b / 1024, sb = b % 1024, swz = sb ^ (((sb >> 9) & 1) << 5); R = (st >> 1) * 16 + swz / 64; C = (st & 1) * 32 + (swz % 64) / 2; }
__host__ __device__ __forceinline__ int perm32(int rho) { const int n = rho >> 4, i = rho & 15; return 8 * (i >> 2) + 4 * n + (i & 3); }

struct Unit { int pm, pn, aux; const char* A; const char* B; };
struct Gemm { int lda, ldb, K; };

__device__ __forceinline__ void tile_of(int L, int nM, int nN, int& pm, int& pn) {
    const int nwg = nM * nN; int wgid = L;
    { const int q = nwg / NXCD, r = nwg % NXCD, xcd = wgid % NXCD, off = wgid / NXCD; wgid = (xcd < r ? xcd * (q + 1) : r * (q + 1) + (xcd - r) * q) + off; }
    const int nig = WGM * nN, gid = wgid / nig, fm = gid * WGM, gsz = (nM - fm) < WGM ? (nM - fm) : WGM;
    pm = fm + ((wgid % nig) % gsz); pn = (wgid % nig) / gsz;
}
struct PlainOrder {
    const char* A; const char* Bt; int lda, ldb, nM, nN, G, c, bskip;
    __device__ __forceinline__ bool next(int i, Unit& u) const {
        const long L = (long)i * G + c; if (L >= (long)nM * nN) return false;
        tile_of((int)L, nM, nN, u.pm, u.pn); u.aux = 0;
        u.A = A + (size_t)u.pm * BM * lda * 2; u.B = Bt + (size_t)(u.pn + ((u.pn >= 2) ? bskip : 0)) * BM * ldb * 2; return true;
    }
};
struct GroupOrder3 {
    const char* A; const char* Bt; int lda, ldb, nM, nN, G, c; size_t a_gstride, b_gstride;
    __device__ __forceinline__ bool next(int i, Unit& u) const {
        const int n = i % 3; const long L = (long)(i / 3) * G + c; if (L >= (long)nM * nN) return false;
        tile_of((int)L, nM, nN, u.pm, u.pn); u.aux = n;
        u.A = A + n * a_gstride + (size_t)u.pm * BM * lda * 2; u.B = Bt + n * b_gstride + (size_t)u.pn * BM * ldb * 2; return true;
    }
};

template <class Epi, class Sched, bool ALIGN_EPI>
__device__ __forceinline__ void gemm_phase(PG8_LAS unsigned char* lds, const Gemm g, const Sched& S, const Epi& E) {
    int tid_ = threadIdx.x; asm volatile("" : "+v"(tid_));
    const int tid = tid_, wid = __builtin_amdgcn_readfirstlane(tid >> 6), lane = tid & 63, wr = wid >> 2, wc = wid & 3, fr = lane & 15, fq = lane >> 4;
    const int K = g.K, nt = K / BK;
    unsigned voffA[2], voffB[2];
#pragma unroll
    for (int i = 0; i < 2; ++i) { int R, C; stage_rc(tid * 16 + i * 8192, R, C); const int Rb = (int)Epi::PERM == 2 ? (64 * (R >> 5) + perm32(R & 31)) : (int)Epi::PERM == 1 ? ((R & ~31) + perm32(R & 31)) : R;
        voffA[i] = (unsigned)(R * g.lda + C) * 2u; voffB[i] = (unsigned)(Rb * g.ldb + C) * 2u; }
    const size_t kstep = (size_t)(BK * 2);
    const size_t hstepA = (size_t)HALF * g.lda * 2, hstepB = (size_t)((int)Epi::PERM == 2 ? 32 : HALF) * g.ldb * 2;
    const unsigned ldsw = (unsigned)wid * 1024u;
    const int aoff = lds_byte(wr * 64 + fr, fq * 8), boff = lds_byte(wc * 32 + fr, fq * 8);
#define PG8_SA(b, h) (((b) * 2 + (h)) * HTB)
#define PG8_SB(b, h) ((4 + (b) * 2 + (h)) * HTB)
#define PG8_STAGE(bufoff, gbase, voff) do { _Pragma("unroll") for (int _i = 0; _i < 2; ++_i) \
        __builtin_amdgcn_global_load_lds((const unsigned*)((const char*)(gbase) + (voff)[_i]), (PG8_LAS unsigned*)(lds + (bufoff) + ldsw + _i * 8192), 16, 0, 0); } while (0)
#define PG8_LDA(dst, b, h) do { _Pragma("unroll") for (int m = 0; m < 4; ++m) _Pragma("unroll") for (int k = 0; k < 2; ++k) dst[m][k] = *(const PG8_LAS bf16x8*)(lds + PG8_SA(b, h) + aoff + m * 2048 + k * 1024); } while (0)
#define PG8_LDB(dst, b, h) do { _Pragma("unroll") for (int n = 0; n < 2; ++n) _Pragma("unroll") for (int k = 0; k < 2; ++k) dst[n][k] = *(const PG8_LAS bf16x8*)(lds + PG8_SB(b, h) + boff + n * 2048 + k * 1024); } while (0)
#define PG8_MMA(ai, bj, At, Bt) do { __builtin_amdgcn_s_setprio(1); _Pragma("unroll") for (int m = 0; m < 4; ++m) _Pragma("unroll") for (int n = 0; n < 2; ++n) _Pragma("unroll") for (int k = 0; k < 2; ++k) \
        acc[ai][bj][m][n] = __builtin_amdgcn_mfma_f32_16x16x32_bf16(Bt[n][k], At[m][k], acc[ai][bj][m][n], 0, 0, 0); __builtin_amdgcn_s_setprio(0); } while (0)
#define PG8_WAIT_V(n) asm volatile("s_waitcnt vmcnt(" #n ")" ::: "memory")
#define PG8_WAIT_L(n) asm volatile("s_waitcnt lgkmcnt(" #n ")" ::: "memory")
#define PG8_BAR __builtin_amdgcn_s_barrier()
#define PG8_SCHED __builtin_amdgcn_sched_barrier(0)
    Unit cur, nxt; int ui = 0;
    if (!S.next(0, cur)) return;
    f32x4 acc[2][2][4][2];
#pragma unroll
    for (int a = 0; a < 2; ++a)
#pragma unroll
        for (int b = 0; b < 2; ++b)
#pragma unroll
            for (int m = 0; m < 4; ++m)
#pragma unroll
                for (int n = 0; n < 2; ++n) acc[a][b][m][n] = (f32x4){0.f, 0.f, 0.f, 0.f};
    bf16x8 At[4][2], B0[2][2], B1[2][2];
    const char* cA = cur.A; const char* cB = cur.B;
    PG8_STAGE(PG8_SB(0, 0), cB, voffB); PG8_STAGE(PG8_SB(0, 1), cB + hstepB, voffB); PG8_STAGE(PG8_SA(0, 0), cA, voffA); PG8_STAGE(PG8_SA(0, 1), cA + hstepA, voffA);
    if (wr == 1) PG8_BAR;
    PG8_WAIT_V(2); PG8_BAR;
    PG8_STAGE(PG8_SB(1, 0), cB + kstep, voffB); PG8_STAGE(PG8_SA(1, 0), cA + kstep, voffA); PG8_STAGE(PG8_SB(1, 1), cB + hstepB + kstep, voffB);
    PG8_WAIT_V(6); PG8_BAR;
    for (;;) {
        const bool has_next = S.next(ui + 1, nxt);
        const char* nA = has_next ? nxt.A : cA; const char* nB = has_next ? nxt.B : cB;
#pragma unroll 1
        for (int t = 0; t < nt; t += 2) {
            const bool last = (t == nt - 2);
            const char* a1 = cA + (size_t)(t + 1) * kstep;
            const char* a2 = last ? nA : cA + (size_t)(t + 2) * kstep; const char* b2 = last ? nB : cB + (size_t)(t + 2) * kstep;
            const char* a3 = a2 + kstep; const char* b3 = b2 + kstep;
            PG8_LDB(B0, 0, 0); PG8_LDB(B1, 0, 1); PG8_SCHED; PG8_LDA(At, 0, 0); PG8_STAGE(PG8_SA(1, 1), a1 + hstepA, voffA);
            PG8_WAIT_V(8); PG8_WAIT_L(0); PG8_BAR; PG8_MMA(0, 0, At, B0); PG8_MMA(0, 1, At, B1); PG8_BAR; PG8_SCHED;
            PG8_LDA(At, 0, 1); PG8_STAGE(PG8_SB(0, 0), b2, voffB); PG8_STAGE(PG8_SB(0, 1), b2 + hstepB, voffB); PG8_STAGE(PG8_SA(0, 0), a2, voffA);
            PG8_WAIT_V(8); PG8_WAIT_L(0); PG8_BAR; PG8_MMA(1, 0, At, B0); PG8_MMA(1, 1, At, B1); PG8_BAR; PG8_SCHED;
            PG8_LDB(B0, 1, 0); PG8_LDB(B1, 1, 1); PG8_SCHED; PG8_LDA(At, 1, 0); PG8_STAGE(PG8_SA(0, 1), a2 + hstepA, voffA);
            PG8_WAIT_V(8); PG8_WAIT_L(0); PG8_BAR; PG8_MMA(0, 0, At, B0); PG8_MMA(0, 1, At, B1); PG8_BAR; PG8_SCHED;
            PG8_LDA(At, 1, 1); PG8_STAGE(PG8_SB(1, 0), b3, voffB); PG8_STAGE(PG8_SB(1, 1), b3 + hstepB, voffB); PG8_STAGE(PG8_SA(1, 0), a3, voffA);
            PG8_WAIT_V(8); PG8_WAIT_L(0); PG8_BAR; PG8_MMA(1, 0, At, B0); PG8_MMA(1, 1, At, B1); PG8_BAR; PG8_SCHED;
        }
        if constexpr (ALIGN_EPI) { if (wr == 0) PG8_BAR; }
        E(acc, cur, wr, wc, fr, fq);
        if (!has_next) break;
#pragma unroll
        for (int a = 0; a < 2; ++a)
#pragma unroll
            for (int b = 0; b < 2; ++b)
#pragma unroll
                for (int m = 0; m < 4; ++m)
#pragma unroll
                    for (int n = 0; n < 2; ++n) acc[a][b][m][n] = (f32x4){0.f, 0.f, 0.f, 0.f};
        cur = nxt; cA = nA; cB = nB; ++ui;
        if constexpr (ALIGN_EPI) { if (wr == 1) PG8_BAR; }
    }
    PG8_WAIT_V(0);
    if constexpr (!ALIGN_EPI) { if (wr == 0) PG8_BAR; }
    PG8_BAR;
#undef PG8_SA
#undef PG8_SB
#undef PG8_STAGE
#undef PG8_LDA
#undef PG8_LDB
#undef PG8_MMA
#undef PG8_WAIT_V
#undef PG8_WAIT_L
#undef PG8_BAR
#undef PG8_SCHED
}
}
#define LAS __attribute__((address_space(3)))
typedef unsigned short bf16_t;
typedef short bf16x8 __attribute__((ext_vector_type(8)));
typedef short s16x4 __attribute__((ext_vector_type(4)));
typedef float f32x4 __attribute__((ext_vector_type(4)));
typedef float f32x2 __attribute__((ext_vector_type(2)));
typedef float f32x16 __attribute__((ext_vector_type(16)));
typedef unsigned u32x4 __attribute__((ext_vector_type(4)));
typedef unsigned u32x2 __attribute__((ext_vector_type(2)));
typedef __bf16 bf16x2_t __attribute__((ext_vector_type(2)));

constexpr int BATCH = 8, SEQ = 4096, DM = 1024, T = BATCH * SEQ, DEPTH = 2;
constexpr int N_IN = 7728, NA = 3328, NG = 4608, NALL = NA + NG;
constexpr int CQ = 0, CKV = 256, KROPE = 384, GLAT = 416, RW_R = 512, RW_K = 1024, RW_V = 1536, RW_LW = 2048, RW_LA = 2112, GQ = 2304, GK = 2560, GV = 2816;
constexpr int KP = 544;
constexpr float NORM_EPS = 1e-6f, RWKV_GN_EPS = 64e-5f;
constexpr float QSCALE = 0.10206207261596577f * 1.4426950408889634f;

constexpr size_t MiB = 1u << 20;
constexpr size_t WS_CTL = 0;
constexpr size_t WS_ROPE = 1 * MiB;
constexpr size_t WS_RSTD = 5 * MiB;
constexpr size_t WS_WIN = 6 * MiB;
constexpr size_t WS_WBO = WS_WIN + (size_t)NALL * 1024 * 2;
constexpr size_t WS_WOUT = WS_WBO + 3 * MiB;
constexpr size_t WS_WUQ = WS_WOUT + 2 * MiB;
constexpr size_t WS_WUKV = WS_WUQ + 768 * 256 * 2;
constexpr size_t WS_HB = 28 * MiB;
constexpr size_t WS_PA = 92 * MiB;
constexpr size_t WS_Q = 300 * MiB;
constexpr size_t WS_K = 348 * MiB;
constexpr size_t WS_V = 382 * MiB;
constexpr size_t WS_YS = 414 * MiB;
constexpr size_t WS_SMG8 = WS_Q;
constexpr size_t WS_MG = WS_PA, WS_OF = WS_PA + 64 * MiB;
constexpr size_t WS_END = 510 * MiB;
static_assert(WS_WUKV + 1024 * 256 * 2 <= WS_HB, "weights fit");

__device__ __forceinline__ unsigned pk2(float lo, float hi) { f32x2 v = {lo, hi}; bf16x2_t b = __builtin_convertvector(v, bf16x2_t); return __builtin_bit_cast(unsigned, b); }
__device__ __forceinline__ float bflo(unsigned w) { return __uint_as_float(w << 16); }
__device__ __forceinline__ float bfhi(unsigned w) { return __uint_as_float(w & 0xffff0000u); }
__device__ __forceinline__ float bf2f(bf16_t b) { return __uint_as_float((unsigned)b << 16); }
__device__ __forceinline__ bf16_t f2bf(float f) { return (bf16_t)(pk2(f, 0.f) & 0xffffu); }
__device__ __forceinline__ float wave_sum(float v) {
#pragma unroll
    for (int o = 1; o < 64; o <<= 1) v += __shfl_xor(v, o);
    return v;
}
__device__ __forceinline__ float fast_exp(float x) { return __builtin_amdgcn_exp2f(x * 1.4426950408889634f); }
__device__ __forceinline__ float fast_sigmoid(float x) { return __builtin_amdgcn_rcpf(1.0f + fast_exp(-x)); }
template <int CTRL> __device__ __forceinline__ float dpp_f(float x) { return __int_as_float(__builtin_amdgcn_update_dpp(0, __float_as_int(x), CTRL, 0xf, 0xf, false)); }
__device__ __forceinline__ float sum8(float x) { x += dpp_f<0xB1>(x); x += dpp_f<0x4E>(x); x += dpp_f<0x141>(x); return x; }
__device__ __forceinline__ float sum16(float x) { x += dpp_f<0xB1>(x); x += dpp_f<0x4E>(x); x += dpp_f<0x141>(x); x += dpp_f<0x140>(x); return x; }

struct Params {
    const float* x; const int* positions; const float* norm_pre; const float* w_in; const float* mla_q_norm; const float* mla_kv_norm; const float* mla_w_uq; const float* mla_w_ukv;
    const float* rwkv_mu; const float* rwkv_w0; const float* rwkv_w_up; const float* rwkv_a0; const float* rwkv_a_up; const float* rwkv_k_k; const float* rwkv_k_a; const float* rwkv_r_k;
    const float* rwkv_ln_w; const float* rwkv_ln_b; const float* gla_a_up; const float* gla_a_b; const float* gla_norm; const float* w_branch_out; const float* w_out; const float* norm_post;
    float* out; unsigned char* ws; int ph_lo, ph_hi;
};

typedef const __attribute__((address_space(4))) Params* KArgs;
__device__ __forceinline__ KArgs kargs() { KArgs kp = (KArgs)__builtin_amdgcn_kernarg_segment_ptr(); asm volatile("" : "+s"(kp)); return kp; }

__device__ __forceinline__ Params load_params() { Params p{}; KArgs kp = kargs(); p.x = kp->x; p.positions = kp->positions; p.norm_pre = kp->norm_pre; p.w_in = kp->w_in; p.mla_q_norm = kp->mla_q_norm; p.mla_kv_norm = kp->mla_kv_norm; p.mla_w_uq = kp->mla_w_uq; p.mla_w_ukv = kp->mla_w_ukv; p.rwkv_mu = kp->rwkv_mu; p.rwkv_w0 = kp->rwkv_w0; p.rwkv_w_up = kp->rwkv_w_up; p.rwkv_a0 = kp->rwkv_a0; p.rwkv_a_up = kp->rwkv_a_up; p.rwkv_k_k = kp->rwkv_k_k; p.rwkv_k_a = kp->rwkv_k_a; p.rwkv_r_k = kp->rwkv_r_k; p.rwkv_ln_w = kp->rwkv_ln_w; p.rwkv_ln_b = kp->rwkv_ln_b; p.gla_a_up = kp->gla_a_up; p.gla_a_b = kp->gla_a_b; p.gla_norm = kp->gla_norm; p.w_branch_out = kp->w_branch_out; p.w_out = kp->w_out; p.norm_post = kp->norm_post; p.out = kp->out; p.ws = kp->ws; p.ph_lo = kp->ph_lo; p.ph_hi = kp->ph_hi; return p; }
__device__ __forceinline__ int opaque_tid() { int t = threadIdx.x; asm volatile("" : "+v"(t)); return t; }

using pg8::Unit;
constexpr int EPI_SCR = 131072, EPI_SCR_WAVE = 2304, EPI_PITCH = 144;
struct EpiGeo { LAS unsigned char* wp; const LAS unsigned char* rp; int r8, p8; };
__device__ __forceinline__ EpiGeo epi_geo(LAS unsigned char* lds, int wr, int wc, int fr, int fq) {
    LAS unsigned char* scr = lds + EPI_SCR + (wr * 4 + wc) * EPI_SCR_WAVE; const int lane = fq * 16 + fr;
    return EpiGeo{scr + fr * EPI_PITCH + fq * 16, scr + (lane >> 3) * EPI_PITCH + (lane & 7) * 16, lane >> 3, lane & 7};
}
__device__ __forceinline__ void epi_xpose(const EpiGeo& g, const u32x4 w0, const u32x4 w1, u32x4& r0, u32x4& r1) {
    *(LAS u32x4*)g.wp = w0; *(LAS u32x4*)(g.wp + 64) = w1;
    asm volatile("" ::: "memory");
    r0 = *(const LAS u32x4*)g.rp; r1 = *(const LAS u32x4*)(g.rp + 8 * EPI_PITCH);
    asm volatile("" ::: "memory");
}
__device__ __forceinline__ u32x4 pack8(const f32x4 v0, const f32x4 v1) { u32x4 w; w.x = pk2(v0[0], v0[1]); w.y = pk2(v0[2], v0[3]); w.z = pk2(v1[0], v1[1]); w.w = pk2(v1[2], v1[3]); return w; }
struct EpiStore {
    static constexpr int PERM = 2; bf16_t* O; int ldc; LAS unsigned char* lds;
    __device__ __forceinline__ void operator()(const f32x4 (&acc)[2][2][4][2], const Unit& u, int wr, int wc, int fr, int fq) const {
        const EpiGeo G = epi_geo(lds, wr, wc, fr, fq);
        bf16_t* gp = O + (size_t)(u.pm * 256 + wr * 64 + G.r8) * ldc + u.pn * 256 + wc * 64 + G.p8 * 8;
#pragma unroll
        for (int ai = 0; ai < 2; ++ai)
#pragma unroll
            for (int m = 0; m < 4; ++m) { u32x4 r0, r1; epi_xpose(G, pack8(acc[ai][0][m][0], acc[ai][0][m][1]), pack8(acc[ai][1][m][0], acc[ai][1][m][1]), r0, r1);
                bf16_t* g = gp + (size_t)(ai * 128 + m * 16) * ldc;
                *(u32x4*)g = r0; *(u32x4*)(g + (size_t)8 * ldc) = r1; }
    }
};
struct EpiQ {
    static constexpr int PERM = 2; bf16_t* Q; const float* rstd; LAS unsigned char* lds;
    __device__ __forceinline__ void operator()(const f32x4 (&acc)[2][2][4][2], const Unit& u, int wr, int wc, int fr, int fq) const {
        const EpiGeo G = epi_geo(lds, wr, wc, fr, fq);
        const int row0 = u.pm * 256 + wr * 64 + fr;
        float rsv[2][4];
#pragma unroll
        for (int ai = 0; ai < 2; ++ai)
#pragma unroll
            for (int m = 0; m < 4; ++m) rsv[ai][m] = rstd[row0 + ai * 128 + m * 16];
        bf16_t* gp = Q + (size_t)(u.pm * 256 + wr * 64 + G.r8) * 768 + u.pn * 256 + wc * 64 + G.p8 * 8;
#pragma unroll
        for (int ai = 0; ai < 2; ++ai)
#pragma unroll
            for (int m = 0; m < 4; ++m) { const float rs = rsv[ai][m] * QSCALE; u32x4 r0, r1;
                epi_xpose(G, pack8(acc[ai][0][m][0] * rs, acc[ai][0][m][1] * rs), pack8(acc[ai][1][m][0] * rs, acc[ai][1][m][1] * rs), r0, r1);
                bf16_t* g = gp + (size_t)(ai * 128 + m * 16) * 768;
                *(u32x4*)g = r0; *(u32x4*)(g + (size_t)8 * 768) = r1; }
    }
};
struct EpiKV {
    static constexpr int PERM = 2; bf16_t* Kb; bf16_t* Vb; const float* rstd; LAS unsigned char* lds;
    __device__ __forceinline__ void operator()(const f32x4 (&acc)[2][2][4][2], const Unit& u, int wr, int wc, int fr, int fq) const {
        const EpiGeo G = epi_geo(lds, wr, wc, fr, fq);
        const int row0 = u.pm * 256 + wr * 64 + fr; const bool isv = u.pn >= 2; const int ldc = isv ? 512 : KP;
        float rsv[2][4];
#pragma unroll
        for (int ai = 0; ai < 2; ++ai)
#pragma unroll
            for (int m = 0; m < 4; ++m) rsv[ai][m] = rstd[row0 + ai * 128 + m * 16];
        bf16_t* gp = (isv ? Vb : Kb) + (size_t)(u.pm * 256 + wr * 64 + G.r8) * ldc + (u.pn & 1) * 256 + wc * 64 + G.p8 * 8;
#pragma unroll
        for (int ai = 0; ai < 2; ++ai)
#pragma unroll
            for (int m = 0; m < 4; ++m) { const float rs = rsv[ai][m]; u32x4 r0, r1;
                epi_xpose(G, pack8(acc[ai][0][m][0] * rs, acc[ai][0][m][1] * rs), pack8(acc[ai][1][m][0] * rs, acc[ai][1][m][1] * rs), r0, r1);
                bf16_t* g = gp + (size_t)(ai * 128 + m * 16) * ldc;
                *(u32x4*)g = r0; *(u32x4*)(g + (size_t)8 * ldc) = r1; }
    }
};
__device__ __forceinline__ unsigned q8(float s) { return (unsigned)(s * 255.0f + 0.5f); }
__device__ __forceinline__ f32x4 silu4(const f32x4 a) { f32x4 r; r[0] = fast_sigmoid(a[0]) * a[0]; r[1] = fast_sigmoid(a[1]) * a[1]; r[2] = fast_sigmoid(a[2]) * a[2]; r[3] = fast_sigmoid(a[3]) * a[3]; return r; }
struct EpiGateBG {
    static constexpr int PERM = 2; bf16_t* YS; int pn0, skip; LAS unsigned char* lds;
    __device__ __forceinline__ void operator()(const f32x4 (&acc)[2][2][4][2], const Unit& u, int wr, int wc, int fr, int fq) const {
        const int pn = pn0 + u.pn + ((u.pn >= 2) ? skip : 0);
        const EpiGeo G = epi_geo(lds, wr, wc, fr, fq);
        bf16_t* gp = YS + (size_t)(pn >> 1) * T * 512 + (size_t)(u.pm * 256 + wr * 64 + G.r8) * 512 + (pn & 1) * 256 + wc * 64 + G.p8 * 8;
#pragma unroll
        for (int ai = 0; ai < 2; ++ai) {
            u32x4 y[4][2];
#pragma unroll
            for (int m = 0; m < 4; ++m)
#pragma unroll
                for (int h = 0; h < 2; ++h) y[m][h] = *(const u32x4*)(gp + (size_t)(ai * 128 + m * 16 + 8 * h) * 512);
#pragma unroll
            for (int m = 0; m < 4; ++m) { u32x4 r[2];
                epi_xpose(G, pack8(silu4(acc[ai][0][m][0]), silu4(acc[ai][0][m][1])), pack8(silu4(acc[ai][1][m][0]), silu4(acc[ai][1][m][1])), r[0], r[1]);
#pragma unroll
                for (int h = 0; h < 2; ++h) { const u32x4 yy = y[m][h], gg = r[h];
                    u32x4 w; w.x = pk2(bflo(gg.x) * bflo(yy.x), bfhi(gg.x) * bfhi(yy.x)); w.y = pk2(bflo(gg.y) * bflo(yy.y), bfhi(gg.y) * bfhi(yy.y));
                    w.z = pk2(bflo(gg.z) * bflo(yy.z), bfhi(gg.z) * bfhi(yy.z)); w.w = pk2(bflo(gg.w) * bflo(yy.w), bfhi(gg.w) * bfhi(yy.w));
                    *(u32x4*)(gp + (size_t)(ai * 128 + m * 16 + 8 * h) * 512) = w; } }
        }
    }
};
struct EpiGateMG8 {
    static constexpr int PERM = 2; unsigned char* SMG; LAS unsigned char* lds;
    __device__ __forceinline__ void operator()(const f32x4 (&acc)[2][2][4][2], const Unit& u, int wr, int wc, int fr, int fq) const {
        LAS unsigned char* scr = lds + EPI_SCR + (wr * 4 + wc) * EPI_SCR_WAVE; const int lane = fq * 16 + fr;
        LAS unsigned char* wp = scr + fr * 72 + fq * 8; const LAS unsigned char* rp = scr + (lane >> 2) * 72 + (lane & 3) * 16;
        unsigned char* gp = SMG + (size_t)(u.pm * 256 + wr * 64 + (lane >> 2)) * 3072 + u.pn * 256 + wc * 64 + (lane & 3) * 16;
#pragma unroll
        for (int ai = 0; ai < 2; ++ai)
#pragma unroll
            for (int m = 0; m < 4; ++m) {
#pragma unroll
                for (int bj = 0; bj < 2; ++bj) { const f32x4 a0 = acc[ai][bj][m][0], a1 = acc[ai][bj][m][1];
                    u32x2 w = {0u, 0u};
#pragma unroll
                    for (int j = 0; j < 4; ++j) { w.x = __builtin_amdgcn_cvt_pk_u8_f32(255.0f * fast_sigmoid(a0[j]), j, w.x); w.y = __builtin_amdgcn_cvt_pk_u8_f32(255.0f * fast_sigmoid(a1[j]), j, w.y); }
                    *(LAS u32x2*)(wp + bj * 32) = w; }
                asm volatile("" ::: "memory");
                const u32x2 ra = *(const LAS u32x2*)rp, rb = *(const LAS u32x2*)(rp + 8);
                asm volatile("" ::: "memory");
                *(u32x4*)(gp + (size_t)(ai * 128 + m * 16) * 3072) = (u32x4){ra.x, ra.y, rb.x, rb.y}; }
    }
};
struct EpiMerge {
    static constexpr int PERM = 2; bf16_t* MG; const unsigned char* SMG; LAS unsigned char* lds;
    __device__ __forceinline__ void operator()(const f32x4 (&acc)[2][2][4][2], const Unit& u, int wr, int wc, int fr, int fq) const {
        const EpiGeo G = epi_geo(lds, wr, wc, fr, fq); const int n = u.aux; constexpr float S = 1.0f / 255.0f;
        const size_t rowb = (size_t)(u.pm * 256 + wr * 64 + G.r8); const int colb = u.pn * 256 + wc * 64 + G.p8 * 8;
        const unsigned char* sp = SMG + rowb * 3072 + n * 1024 + colb; bf16_t* mp = MG + rowb * 1024 + colb;
#pragma unroll
        for (int ai = 0; ai < 2; ++ai) {
            u32x2 g[4][2]; u32x4 y[4][2];
#pragma unroll
            for (int m = 0; m < 4; ++m)
#pragma unroll
                for (int h = 0; h < 2; ++h) { g[m][h] = *(const u32x2*)(sp + (size_t)(ai * 128 + m * 16 + 8 * h) * 3072); if (n > 0) y[m][h] = *(const u32x4*)(mp + (size_t)(ai * 128 + m * 16 + 8 * h) * 1024); }
#pragma unroll
            for (int m = 0; m < 4; ++m) { u32x4 r[2];
                epi_xpose(G, pack8(acc[ai][0][m][0], acc[ai][0][m][1]), pack8(acc[ai][1][m][0], acc[ai][1][m][1]), r[0], r[1]);
#pragma unroll
                for (int h = 0; h < 2; ++h) { const u32x2 gg = g[m][h]; const u32x4 aa = r[h];
                    float v[8] = {bflo(aa.x) * (S * (float)(gg.x & 0xffu)), bfhi(aa.x) * (S * (float)((gg.x >> 8) & 0xffu)), bflo(aa.y) * (S * (float)((gg.x >> 16) & 0xffu)), bfhi(aa.y) * (S * (float)(gg.x >> 24)),
                                  bflo(aa.z) * (S * (float)(gg.y & 0xffu)), bfhi(aa.z) * (S * (float)((gg.y >> 8) & 0xffu)), bflo(aa.w) * (S * (float)((gg.y >> 16) & 0xffu)), bfhi(aa.w) * (S * (float)(gg.y >> 24))};
                    if (n > 0) { const u32x4 yy = y[m][h];
                        v[0] += bflo(yy.x); v[1] += bfhi(yy.x); v[2] += bflo(yy.y); v[3] += bfhi(yy.y); v[4] += bflo(yy.z); v[5] += bfhi(yy.z); v[6] += bflo(yy.w); v[7] += bfhi(yy.w); }
                    u32x4 w; w.x = pk2(v[0], v[1]); w.y = pk2(v[2], v[3]); w.z = pk2(v[4], v[5]); w.w = pk2(v[6], v[7]);
                    *(u32x4*)(mp + (size_t)(ai * 128 + m * 16 + 8 * h) * 1024) = w; } }
        }
    }
};
struct EpiF32 {
    static constexpr bool PERM = false; float* O; int ldc;
    __device__ __forceinline__ void operator()(const f32x4 (&acc)[2][2][4][2], const Unit& u, int wr, int wc, int fr, int fq) const {
        const int row0 = u.pm * 256 + wr * 64 + fr, col0 = u.pn * 256 + wc * 32 + 4 * fq;
#pragma unroll
        for (int ai = 0; ai < 2; ++ai)
#pragma unroll
            for (int m = 0; m < 4; ++m) { float* rowp = O + (size_t)(row0 + ai * 128 + m * 16) * ldc + col0;
#pragma unroll
                for (int bj = 0; bj < 2; ++bj)
#pragma unroll
                    for (int n = 0; n < 2; ++n) *(f32x4*)(rowp + bj * 128 + n * 16) = acc[ai][bj][m][n]; }
    }
};

template <class SrcCol>
__device__ __forceinline__ void transpose_item(const float* W, int Ksrc, int Nsrc, bf16_t* WT, int Kdst, int item, int nblk, float* scr, int lane, SrcCol src, const float* kscale) {
    const int kb = item / nblk, nb = item % nblk, k0 = 64 * kb, n0 = 32 * nb;
    const int sc = src(n0 + (lane & 31));
#pragma unroll 8
    for (int i = 0; i < 32; ++i) { const int kk = 2 * i + (lane >> 5), k = k0 + kk; float v = 0.f;
        if (sc >= 0 && k < Ksrc) { v = W[(size_t)k * Nsrc + sc]; if (kscale) v *= kscale[k]; }
        scr[kk * 33 + (lane & 31)] = v; }
    asm volatile("s_waitcnt lgkmcnt(0)" ::: "memory");
    const int c = lane & 7;
#pragma unroll
    for (int j = 0; j < 4; ++j) { const int n = (lane >> 3) + 8 * j; const float* s = scr + (8 * c) * 33 + n;
        u32x4 o; o.x = pk2(s[0 * 33], s[1 * 33]); o.y = pk2(s[2 * 33], s[3 * 33]); o.z = pk2(s[4 * 33], s[5 * 33]); o.w = pk2(s[6 * 33], s[7 * 33]);
        *(u32x4*)(WT + (size_t)(n0 + n) * Kdst + k0 + 8 * c) = o; }
    asm volatile("s_waitcnt lgkmcnt(0)" ::: "memory");
}
__device__ __forceinline__ int win_src(int j) {
    if (j < 416) return j;
    if (j < 432) return 3104 + (j - 416);
    if (j < 512) return -1;
    if (j < 2048) return 416 + (j - 512);
    if (j < 2176) return 1952 + (j - 2048);
    if (j < 2304) return -1;
    if (j < 3328) return 2080 + (j - 2304);
    return 3120 + (j - 3328);
}
__device__ __forceinline__ int wuq_src(int j) { const int h = j / 96, c = j % 96; if (c < 64) return h * 96 + c; const int r = c - 64; return h * 96 + 64 + (r & 1) * 16 + (r >> 1); }
__device__ __forceinline__ int wukv_src(int j) { return j < 512 ? (j >> 6) * 128 + (j & 63) : ((j - 512) >> 6) * 128 + 64 + (j & 63); }

__device__ __forceinline__ void convert_weights(int l, unsigned char* lds, int gw, int NGW, int wave, int lane) {
    float* scr = (float*)(lds + wave * 8448); const Params p = load_params();
    bf16_t* WinT = (bf16_t*)(p.ws + WS_WIN); bf16_t* WboT = (bf16_t*)(p.ws + WS_WBO); bf16_t* WoutT = (bf16_t*)(p.ws + WS_WOUT); bf16_t* WuqT = (bf16_t*)(p.ws + WS_WUQ); bf16_t* WukvT = (bf16_t*)(p.ws + WS_WUKV);
    constexpr int I_IN = 16 * (NALL / 32), I_BO = 8 * 32, I_OUT = 16 * 32, I_UQ = 4 * 24, I_UKV = 4 * 32;
    constexpr int NITEMS = I_IN + 3 * I_BO + I_OUT + I_UQ + I_UKV;
    for (int it = gw; it < NITEMS; it += NGW) {
        int r = it;
        if (r < I_IN) { transpose_item(p.w_in + (size_t)l * 1024 * N_IN, 1024, N_IN, WinT, 1024, r, NALL / 32, scr, lane, [](int j) { return win_src(j); }, nullptr); continue; } r -= I_IN;
        if (r < 3 * I_BO) { const int n = r / I_BO; r -= n * I_BO;
            transpose_item(p.w_branch_out + ((size_t)l * 3 + n) * 512 * 1024, 512, 1024, WboT + (size_t)n * 1024 * 512, 512, r, 32, scr, lane, [](int j) { return j; }, nullptr); continue; } r -= 3 * I_BO;
        if (r < I_OUT) { transpose_item(p.w_out + (size_t)l * 1024 * 1024, 1024, 1024, WoutT, 1024, r, 32, scr, lane, [](int j) { return j; }, nullptr); continue; } r -= I_OUT;
        if (r < I_UQ) { transpose_item(p.mla_w_uq + (size_t)l * 256 * 768, 256, 768, WuqT, 256, r, 24, scr, lane, [](int j) { return wuq_src(j); }, p.mla_q_norm + l * 256); continue; } r -= I_UQ;
        transpose_item(p.mla_w_ukv + (size_t)l * 128 * 1024, 128, 1024, WukvT, 256, r, 32, scr, lane, [](int j) { return wukv_src(j); }, p.mla_kv_norm + l * 128);
    }
}
__device__ __forceinline__ void hb_row(const float* xrow, const float* g, bf16_t* orow, int lane) {
    const f32x4* xr = (const f32x4*)xrow + lane; const f32x4* gr = (const f32x4*)g + lane;
    f32x4 v[4]; float s = 0.f;
#pragma unroll
    for (int j = 0; j < 4; ++j) { v[j] = xr[64 * j]; s += (v[j].x * v[j].x + v[j].y * v[j].y) + (v[j].z * v[j].z + v[j].w * v[j].w); }
    const float rstd = rsqrtf(wave_sum(s) * (1.f / DM) + NORM_EPS);
    u32x2* o8 = (u32x2*)orow + lane;
#pragma unroll
    for (int j = 0; j < 4; ++j) { const f32x4 gg = gr[64 * j]; u32x2 w; w.x = pk2(v[j].x * rstd * gg.x, v[j].y * rstd * gg.y); w.y = pk2(v[j].z * rstd * gg.z, v[j].w * rstd * gg.w); o8[64 * j] = w; }
}
__device__ __forceinline__ void final_row(const bf16_t* orow, const float* xold, const float* gpost, float* xnew, const float* gnext, bf16_t* hbrow, int lane) {
    float o[16], x[16], g[16];
    { const u32x4 a = *((const u32x4*)orow + lane), b = *((const u32x4*)orow + 64 + lane);
      o[0] = bflo(a.x); o[1] = bfhi(a.x); o[2] = bflo(a.y); o[3] = bfhi(a.y); o[4] = bflo(a.z); o[5] = bfhi(a.z); o[6] = bflo(a.w); o[7] = bfhi(a.w);
      o[8] = bflo(b.x); o[9] = bfhi(b.x); o[10] = bflo(b.y); o[11] = bfhi(b.y); o[12] = bflo(b.z); o[13] = bfhi(b.z); o[14] = bflo(b.w); o[15] = bfhi(b.w); }
#pragma unroll
    for (int h = 0; h < 2; ++h)
#pragma unroll
        for (int q = 0; q < 2; ++q) { const f32x4 xv = *((const f32x4*)(xold + 512 * h + 8 * lane) + q), gv = *((const f32x4*)(gpost + 512 * h + 8 * lane) + q);
#pragma unroll
            for (int e = 0; e < 4; ++e) { x[8 * h + 4 * q + e] = xv[e]; g[8 * h + 4 * q + e] = gv[e]; } }
    float s = 0.f;
#pragma unroll
    for (int e = 0; e < 16; ++e) s += o[e] * o[e];
    const float rstd = rsqrtf(wave_sum(s) * (1.f / DM) + NORM_EPS);
    float s2 = 0.f;
#pragma unroll
    for (int e = 0; e < 16; ++e) { x[e] += o[e] * rstd * g[e]; s2 += x[e] * x[e]; }
#pragma unroll
    for (int h = 0; h < 2; ++h)
#pragma unroll
        for (int q = 0; q < 2; ++q) *((f32x4*)(xnew + 512 * h + 8 * lane) + q) = (f32x4){x[8 * h + 4 * q], x[8 * h + 4 * q + 1], x[8 * h + 4 * q + 2], x[8 * h + 4 * q + 3]};
    if (gnext) { const float rstd2 = rsqrtf(wave_sum(s2) * (1.f / DM) + NORM_EPS);
#pragma unroll
        for (int h = 0; h < 2; ++h) { const f32x4 g0 = *((const f32x4*)(gnext + 512 * h + 8 * lane)), g1 = *((const f32x4*)(gnext + 512 * h + 8 * lane) + 1);
            u32x4 w; w.x = pk2(x[8 * h] * rstd2 * g0[0], x[8 * h + 1] * rstd2 * g0[1]); w.y = pk2(x[8 * h + 2] * rstd2 * g0[2], x[8 * h + 3] * rstd2 * g0[3]);
            w.z = pk2(x[8 * h + 4] * rstd2 * g1[0], x[8 * h + 5] * rstd2 * g1[1]); w.w = pk2(x[8 * h + 6] * rstd2 * g1[2], x[8 * h + 7] * rstd2 * g1[3]);
            *((u32x4*)hbrow + 64 * h + lane) = w; } }
}
__device__ __forceinline__ void mla_prep_row(const bf16_t* prow, const f32x2* rope_t, float* rstdq, float* rstdkv, bf16_t* krow, int lane) {
    const u32x2 a = *((const u32x2*)(prow + CQ) + lane); const unsigned c = *((const unsigned*)(prow + CKV) + lane);
    float sq = bflo(a.x) * bflo(a.x) + bfhi(a.x) * bfhi(a.x) + bflo(a.y) * bflo(a.y) + bfhi(a.y) * bfhi(a.y);
    float sk = bflo(c) * bflo(c) + bfhi(c) * bfhi(c);
    sq = wave_sum(sq); sk = wave_sum(sk);
    if (lane == 0) { *rstdq = rsqrtf(sq * (1.f / 256.f) + NORM_EPS); *rstdkv = rsqrtf(sk * (1.f / 128.f) + NORM_EPS); }
    if (lane < 16) { const float x1 = bf2f(prow[KROPE + lane]), x2 = bf2f(prow[KROPE + 16 + lane]); const f32x2 cs = rope_t[lane];
        *((unsigned*)(krow + 512) + lane) = pk2(x1 * cs.x - x2 * cs.y, x2 * cs.x + x1 * cs.y); }
}

__device__ __forceinline__ void mla_prep_rows4(const bf16_t* PA, const f32x2* ROPE, float* RSTDQ, float* RSTDKV, bf16_t* Kb, int m, int stride, int lane) {
    u32x2 a[4]; unsigned c[4]; float x1[4], x2[4]; f32x2 cs[4];
#pragma unroll
    for (int j = 0; j < 4; ++j) { const int r = (m + j * stride < T) ? m + j * stride : m; const bf16_t* prow = PA + (size_t)r * NA;
        a[j] = *((const u32x2*)(prow + CQ) + lane); c[j] = *((const unsigned*)(prow + CKV) + lane);
        x1[j] = bf2f(prow[KROPE + (lane & 15)]); x2[j] = bf2f(prow[KROPE + 16 + (lane & 15)]); cs[j] = ROPE[(size_t)r * 16 + (lane & 15)]; }
#pragma unroll
    for (int j = 0; j < 4; ++j) { const int r = m + j * stride; if (r < T) {
        float sq = bflo(a[j].x) * bflo(a[j].x) + bfhi(a[j].x) * bfhi(a[j].x) + bflo(a[j].y) * bflo(a[j].y) + bfhi(a[j].y) * bfhi(a[j].y);
        float sk = bflo(c[j]) * bflo(c[j]) + bfhi(c[j]) * bfhi(c[j]);
        sq = wave_sum(sq); sk = wave_sum(sk);
        if (lane == 0) { RSTDQ[r] = rsqrtf(sq * (1.f / 256.f) + NORM_EPS); RSTDKV[r] = rsqrtf(sk * (1.f / 128.f) + NORM_EPS); }
        if (lane < 16) *((unsigned*)(Kb + (size_t)r * KP + 512) + lane) = pk2(x1[j] * cs[j].x - x2[j] * cs[j].y, x2[j] * cs[j].x + x1[j] * cs[j].y); } }
}

namespace att {
constexpr int KSLOT = 12288, VSLOT = 8192, BUFB = KSLOT + VSLOT, L_WS = 2 * BUFB, L_OST = L_WS + 8 * 128 * 4, L_END = L_OST + 8 * 4096;
constexpr int UNIT_ROWS = 512;
__device__ __forceinline__ int crow(int r, int hi) { return (r & 3) + 8 * (r >> 2) + 4 * hi; }
__device__ __forceinline__ s16x4 vtr(const LAS unsigned char* p) { return __builtin_bit_cast(s16x4, __builtin_amdgcn_ds_read_tr16_b64_v4i16((LAS s16x4*)p)); }
__device__ __forceinline__ void load_q(bf16x8 (&qr)[6], const bf16_t* Q, const f32x2* rope, size_t row, int h, int hi) {
    const bf16_t* Qw = Q + row * 768 + h * 96 + hi * 8;
#pragma unroll
    for (int s = 0; s < 6; ++s) qr[s] = *(const bf16x8*)(Qw + s * 16);
    const f32x4* rp = (const f32x4*)(rope + row * 16 + 4 * hi);
#pragma unroll
    for (int s = 4; s < 6; ++s) { const f32x4 c01 = rp[(s - 4) * 4], c23 = rp[(s - 4) * 4 + 1]; const u32x4 w = __builtin_bit_cast(u32x4, qr[s]); u32x4 o;
        { const float e = bflo(w.x), d = bfhi(w.x); o.x = pk2(e * c01[0] - d * c01[1], d * c01[0] + e * c01[1]); }
        { const float e = bflo(w.y), d = bfhi(w.y); o.y = pk2(e * c01[2] - d * c01[3], d * c01[2] + e * c01[3]); }
        { const float e = bflo(w.z), d = bfhi(w.z); o.z = pk2(e * c23[0] - d * c23[1], d * c23[0] + e * c23[1]); }
        { const float e = bflo(w.w), d = bfhi(w.w); o.w = pk2(e * c23[2] - d * c23[3], d * c23[2] + e * c23[3]); }
        qr[s] = __builtin_bit_cast(bf16x8, o); }
}
__device__ __forceinline__ void softmax_half(f32x16& p0, f32x16& p1, f32x16& o0, f32x16& o1, float& mrun, float& lrun, bf16x8 (&pa)[4],
                                             bool first, bool band, int kb0, int qrel, int r32, int hi, LAS float* wsf) {
    if (band) {
#pragma unroll
        for (int r = 0; r < 16; ++r) { const int kv = kb0 + (r & 3) + 8 * (r >> 2); if (kv > qrel) p0[r] = -INFINITY; if (kv + 32 > qrel) p1[r] = -INFINITY; } }
    float mx = fmaxf(p0[0], p1[0]);
#pragma unroll
    for (int r = 1; r < 16; ++r) mx = fmaxf(mx, fmaxf(p0[r], p1[r]));
    mx = fmaxf(mx, __shfl_xor(mx, 32));
    if (first || __any(mx > 8.0f)) {
        const float dl = first ? mx : fmaxf(mx, 0.f); mrun += dl;
#pragma unroll
        for (int r = 0; r < 16; ++r) { p0[r] -= dl; p1[r] -= dl; }
        const float alpha = __builtin_amdgcn_exp2f(-dl); lrun *= alpha;
        if (hi == 0) wsf[r32] = alpha;
#pragma unroll
        for (int r = 0; r < 16; ++r) { const float a = wsf[crow(r, hi)]; o0[r] *= a; o1[r] *= a; }
    }
    float ls = 0.f;
#pragma unroll
    for (int r = 0; r < 16; ++r) { p0[r] = __builtin_amdgcn_exp2f(p0[r]); p1[r] = __builtin_amdgcn_exp2f(p1[r]); ls += p0[r] + p1[r]; }
    lrun += ls;
#pragma unroll
    for (int s = 0; s < 4; ++s) { const int bb = 8 * (s & 1); u32x4 w;
        if (s < 2) { w.x = pk2(p0[bb], p0[bb + 1]); w.y = pk2(p0[bb + 2], p0[bb + 3]); w.z = pk2(p0[bb + 4], p0[bb + 5]); w.w = pk2(p0[bb + 6], p0[bb + 7]); }
        else { w.x = pk2(p1[bb], p1[bb + 1]); w.y = pk2(p1[bb + 2], p1[bb + 3]); w.z = pk2(p1[bb + 4], p1[bb + 5]); w.w = pk2(p1[bb + 6], p1[bb + 7]); }
        pa[s] = __builtin_bit_cast(bf16x8, w); }
}
__device__ __forceinline__ void attn_unit(int b, int h, int qb, LAS unsigned char* lds, unsigned* done_ctr) {
    KArgs kp = kargs(); unsigned char* ws_ = kp->ws;
    const bf16_t* Q = (const bf16_t*)(ws_ + WS_Q); const bf16_t* Kg = (const bf16_t*)(ws_ + WS_K); const bf16_t* Vg = (const bf16_t*)(ws_ + WS_V); bf16_t* O = (bf16_t*)(ws_ + WS_YS);
    const int tid = opaque_tid(), lane = tid & 63, r32 = lane & 31, hi = lane >> 5; const int wid = __builtin_amdgcn_readfirstlane(tid >> 6);
    const size_t rowbase = (size_t)b * SEQ; const int q0 = qb * UNIT_ROWS;
    bf16x8 qa[6], qb_[6];
    load_q(qa, Q, (const f32x2*)(ws_ + WS_ROPE), rowbase + q0 + wid * 64 + r32, h, hi);
    load_q(qb_, Q, (const f32x2*)(ws_ + WS_ROPE), rowbase + q0 + wid * 64 + 32 + r32, h, hi);
    const bf16_t* ksrc0 = Kg + (rowbase + (tid & 63)) * KP + h * 64 + (tid >> 6) * 8;
    const bf16_t* ksrc1 = Kg + (rowbase + (tid & 63)) * KP + 512 + (tid >> 6) * 8;
    const bf16_t* vsrc = Vg + (rowbase + ((tid & 255) >> 2)) * 512 + h * 64 + (tid >> 8) * 32 + (tid & 3) * 8;
    const int NT = (q0 + UNIT_ROWS) / 64;
    LAS float* wsf = (LAS float*)(lds + L_WS) + wid * 128;
    u32x4 sk0, sk1, sv;
    sk0 = *(const u32x4*)ksrc0; if (tid < 256) sk1 = *(const u32x4*)ksrc1; sv = *(const u32x4*)vsrc;
    *(LAS u32x4*)(lds + tid * 16) = sk0; if (tid < 256) *(LAS u32x4*)(lds + (tid + 512) * 16) = sk1; *(LAS u32x4*)(lds + KSLOT + tid * 16) = sv;
    __syncthreads();
    f32x16 oa0 = {}, oa1 = {}, ob0 = {}, ob1 = {}; float ma = 0.f, la = 0.f, mb = 0.f, lb = 0.f;
    const int qra = wid * 64 + r32, qrb = qra + 32;
    for (int t = 0; t < NT; ++t) {
        LAS unsigned char* buf = lds + (t & 1) * BUFB; LAS unsigned char* nbuf = lds + ((t + 1) & 1) * BUFB;
        if (t + 1 < NT) { sk0 = *(const u32x4*)(ksrc0 + (size_t)(t + 1) * 64 * KP); if (tid < 256) sk1 = *(const u32x4*)(ksrc1 + (size_t)(t + 1) * 64 * KP); sv = *(const u32x4*)(vsrc + (size_t)(t + 1) * 64 * 512); }
        f32x16 pa0, pa1, pb0, pb1;
#pragma unroll
        for (int r = 0; r < 16; ++r) { pa0[r] = -ma; pa1[r] = -ma; pb0[r] = -mb; pb1[r] = -mb; }
        { const LAS unsigned char* kb = buf + hi * 1024 + r32 * 16;
#pragma unroll
          for (int s = 0; s < 6; ++s) { const bf16x8 a0 = *(const LAS bf16x8*)(kb + s * 2048), a1 = *(const LAS bf16x8*)(kb + s * 2048 + 512);
              pa0 = __builtin_amdgcn_mfma_f32_32x32x16_bf16(a0, qa[s], pa0, 0, 0, 0); pa1 = __builtin_amdgcn_mfma_f32_32x32x16_bf16(a1, qa[s], pa1, 0, 0, 0);
              pb0 = __builtin_amdgcn_mfma_f32_32x32x16_bf16(a0, qb_[s], pb0, 0, 0, 0); pb1 = __builtin_amdgcn_mfma_f32_32x32x16_bf16(a1, qb_[s], pb1, 0, 0, 0); } }
        const bool band = t >= NT - 8; const int kb0 = 64 * (t - (NT - 8)) + 4 * hi;
        bf16x8 fa[4], fb[4];
        softmax_half(pa0, pa1, oa0, oa1, ma, la, fa, t == 0, band, kb0, qra, r32, hi, wsf);
        softmax_half(pb0, pb1, ob0, ob1, mb, lb, fb, t == 0, band, kb0, qrb, r32, hi, wsf + 64);
        { const LAS unsigned char* vb = buf + KSLOT + ((lane >> 4) & 1) * 32 + (lane & 3) * 8 + (4 * hi + ((lane & 15) >> 2)) * 64;
#pragma unroll
          for (int s = 0; s < 4; ++s) {
              { const s16x4 lo = vtr(vb + s * 1024), hh = vtr(vb + s * 1024 + 512); const bf16x8 vf = {lo[0], lo[1], lo[2], lo[3], hh[0], hh[1], hh[2], hh[3]};
                oa0 = __builtin_amdgcn_mfma_f32_32x32x16_bf16(fa[s], vf, oa0, 0, 0, 0); ob0 = __builtin_amdgcn_mfma_f32_32x32x16_bf16(fb[s], vf, ob0, 0, 0, 0); }
              { const s16x4 lo = vtr(vb + 4096 + s * 1024), hh = vtr(vb + 4096 + s * 1024 + 512); const bf16x8 vf = {lo[0], lo[1], lo[2], lo[3], hh[0], hh[1], hh[2], hh[3]};
                oa1 = __builtin_amdgcn_mfma_f32_32x32x16_bf16(fa[s], vf, oa1, 0, 0, 0); ob1 = __builtin_amdgcn_mfma_f32_32x32x16_bf16(fb[s], vf, ob1, 0, 0, 0); } } }
        if (t + 1 < NT) { *(LAS u32x4*)(nbuf + tid * 16) = sk0; if (tid < 256) *(LAS u32x4*)(nbuf + (tid + 512) * 16) = sk1; *(LAS u32x4*)(nbuf + KSLOT + tid * 16) = sv; }
        __syncthreads();
    }
    la += __shfl_xor(la, 32); lb += __shfl_xor(lb, 32);
    if (hi == 0) { wsf[32 + r32] = la; wsf[96 + r32] = lb; }
    LAS bf16_t* stg = (LAS bf16_t*)(lds + L_OST) + wid * 2048;
#pragma unroll
    for (int hf = 0; hf < 2; ++hf) {
#pragma unroll
        for (int r = 0; r < 16; ++r) { const int orow = crow(r, hi); const float rl = __builtin_amdgcn_rcpf(wsf[hf * 64 + 32 + orow]);
            stg[orow * 64 + r32] = f2bf((hf ? ob0[r] : oa0[r]) * rl); stg[orow * 64 + 32 + r32] = f2bf((hf ? ob1[r] : oa1[r]) * rl); }
        asm volatile("" ::: "memory");
        bf16_t* Ow = O + (rowbase + q0 + wid * 64 + hf * 32) * 512 + h * 64;
#pragma unroll
        for (int i = 0; i < 4; ++i) { const int row = i * 8 + (lane >> 3), ch = lane & 7; const u32x4 v = *(const LAS u32x4*)(stg + row * 64 + ch * 8); *(u32x4*)(Ow + (size_t)row * 512 + ch * 8) = v; }
        asm volatile("" ::: "memory");
    }
    asm volatile("s_waitcnt vmcnt(0)" ::: "memory");
    __syncthreads();
    if (tid == 0) __hip_atomic_fetch_add(done_ctr, 1u, __ATOMIC_RELEASE, __HIP_MEMORY_SCOPE_AGENT);
}
}

namespace rwkv {
constexpr int LP = 72, TB = 64 * LP * 2;
constexpr int S_HT0 = 0, S_HT1 = 1, S_A = 2  , S_B = 3  , S_K = 4, S_R = 5, S_BT = 6, S_KT = 7, S_V = 8,
              S_MOFF = 9, S_MAK = 10, S_MRK = 11, S_MRB = 12, S_D = 13, S_ZT = 14, S_ACC = 15, NSLOT = 16;
constexpr int FP = 68;
constexpr int O_ZW = S_K * TB, O_ZA = O_ZW + 64 * FP * 4, O_YB = S_MAK * TB, O_WT = NSLOT * TB, O_CL = O_WT + 8 * 64 * 4, O_CST = O_CL + 64 * 4, O_END = O_CST + 12 * 64 * 4, O_TT = O_END  ;
static_assert(O_ZA + 64 * FP * 4 <= (S_KT + 1) * TB && O_YB + 64 * FP * 4 <= (S_MRK + 1) * TB, "f32 aliases");
__device__ __forceinline__ s16x4 vtr(const LAS unsigned char* p) { return __builtin_bit_cast(s16x4, __builtin_amdgcn_ds_read_tr16_b64_v4i16((LAS s16x4*)p)); }
struct LaneOff { int bn, bt, bs; };
__device__ __forceinline__ LaneOff lane_off(int fr, int fq) { LaneOff o; o.bn = (fr * LP + 8 * fq) * 2; o.bt = ((8 * fq + (fr >> 2)) * LP + 4 * (fr & 3)) * 2; o.bs = (fr * LP + 4 * fq) * 2; return o; }
__device__ __forceinline__ void relaunder(LaneOff& o) { asm volatile("" : "+v"(o.bn), "+v"(o.bt), "+v"(o.bs)); }
__device__ __forceinline__ bf16x8 frag_t(const LAS unsigned char* tile, int kk, int c0, const LaneOff& o) {
    const LAS unsigned char* q = tile + o.bt + (32 * kk * LP + c0) * 2;
    const s16x4 lo = vtr(q), hi = vtr(q + 4 * LP * 2); return (bf16x8){lo[0], lo[1], lo[2], lo[3], hi[0], hi[1], hi[2], hi[3]};
}
__device__ __forceinline__ bf16x8 frag_n(const LAS unsigned char* tile, int r0, int kk, const LaneOff& o) { return *(const LAS bf16x8*)(tile + o.bn + (r0 * LP + 32 * kk) * 2); }
__device__ __forceinline__ f32x4 MFMA16(bf16x8 a, bf16x8 b, f32x4 c) { return __builtin_amdgcn_mfma_f32_16x16x32_bf16(a, b, c, 0, 0, 0); }
__device__ __forceinline__ void st_tile_T(LAS unsigned char* tile, int m0, int n0, const LaneOff& o, const f32x4 c) {
    u32x2 w; w.x = pk2(c[0], c[1]); w.y = pk2(c[2], c[3]); *(LAS u32x2*)(tile + o.bs + (n0 * LP + m0) * 2) = w;
}
__device__ __forceinline__ void unpack8(const u32x4 w, float (&f)[8]) { f[0] = bflo(w.x); f[1] = bfhi(w.x); f[2] = bflo(w.y); f[3] = bfhi(w.y); f[4] = bflo(w.z); f[5] = bfhi(w.z); f[6] = bflo(w.w); f[7] = bfhi(w.w); }
__device__ __forceinline__ u32x4 pack8(const float (&f)[8]) { u32x4 w; w.x = pk2(f[0], f[1]); w.y = pk2(f[2], f[3]); w.z = pk2(f[4], f[5]); w.w = pk2(f[6], f[7]); return w; }
__device__ __forceinline__ void ld8(const float* p, float (&f)[8]) { const f32x4 a = *(const f32x4*)p, b = *(const f32x4*)(p + 4); f[0] = a[0]; f[1] = a[1]; f[2] = a[2]; f[3] = a[3]; f[4] = b[0]; f[5] = b[1]; f[6] = b[2]; f[7] = b[3]; }
__device__ __forceinline__ void ld8l(const LAS float* p, float (&f)[8]) { const f32x4 a = *(const LAS f32x4*)p, b = *(const LAS f32x4*)(p + 4); f[0] = a[0]; f[1] = a[1]; f[2] = a[2]; f[3] = a[3]; f[4] = b[0]; f[5] = b[1]; f[6] = b[2]; f[7] = b[3]; }
__device__ __forceinline__ float ex2(float x) { return __builtin_amdgcn_exp2f(x); }
constexpr float LOG2E = 1.4426950408889634f, LN2 = 0.6931471805599453f;

__device__ __forceinline__ void rwkv_unit(int l, int b, int h, LAS unsigned char* L) {
    const int tid = opaque_tid(), lane = tid & 63, fr = lane & 15, fq = lane >> 4; const int w = __builtin_amdgcn_readfirstlane(tid >> 6);
    const Params p = load_params();
    const bf16_t* PA = (const bf16_t*)(p.ws + WS_PA); bf16_t* Yout = (bf16_t*)(p.ws + WS_YS) + (size_t)T * 512;
    const int t = tid >> 3, c8 = (tid & 7) * 8;
    const int tw = (lane >> 3);
    const int cw = 16 * (w & 3);
    const float* mu = p.rwkv_mu + l * 1664;
    LaneOff lo = lane_off(fr, fq);
#define SLOT(s) (L + (s) * TB)
    bf16x8 bup[2];
    { const float* U = ((w < 4) ? p.rwkv_w_up : p.rwkv_a_up) + (size_t)l * 64 * 512 + h * 64 + 16 * (w & 3) + fr;
#pragma unroll
      for (int kk = 0; kk < 2; ++kk) { float f[8];
#pragma unroll
          for (int e = 0; e < 8; ++e) f[e] = U[(size_t)(32 * kk + 8 * fq + e) * 512];
          bup[kk] = __builtin_bit_cast(bf16x8, pack8(f)); } }
    for (int e = tid; e < TB / 4; e += 512) { ((LAS unsigned*)SLOT(S_HT0))[e] = 0u; ((LAS unsigned*)SLOT(S_D))[e] = 0u; ((LAS unsigned*)SLOT(S_MOFF))[e] = 0u; ((LAS unsigned*)SLOT(S_MRB))[e] = 0u;
        ((LAS unsigned*)SLOT(S_ZT))[e] = 0u; ((LAS unsigned*)SLOT(S_ACC))[e] = 0u; }
    f32x4 hacc[4];
#pragma unroll
    for (int i = 0; i < 4; ++i) hacc[i] = (f32x4){0.f, 0.f, 0.f, 0.f};
    int hcur = S_HT0, hnxt = S_HT1;
    u32x4 raw[10];
#define RWKV_LOAD(c, t, c8) do { const size_t row_ = (size_t)b * SEQ + (c) * 64 + (t); const bf16_t* s_ = PA + row_ * NA; const bool hp_ = ((c) * 64 + (t)) > 0; const u32x4 z_ = {0u, 0u, 0u, 0u}; \
        raw[0] = *(const u32x4*)(s_ + RW_R + h * 64 + c8); raw[1] = hp_ ? *(const u32x4*)(s_ - NA + RW_R + h * 64 + c8) : z_; \
        raw[2] = *(const u32x4*)(s_ + RW_K + h * 64 + c8); raw[3] = hp_ ? *(const u32x4*)(s_ - NA + RW_K + h * 64 + c8) : z_; \
        raw[4] = *(const u32x4*)(s_ + RW_V + h * 64 + c8); raw[5] = hp_ ? *(const u32x4*)(s_ - NA + RW_V + h * 64 + c8) : z_; \
        raw[6] = *(const u32x4*)(s_ + RW_LW + c8); raw[7] = hp_ ? *(const u32x4*)(s_ - NA + RW_LW + c8) : z_; \
        raw[8] = *(const u32x4*)(s_ + RW_LA + c8); raw[9] = hp_ ? *(const u32x4*)(s_ - NA + RW_LA + c8) : z_; } while (0)
    for (int e = tid; e < 12 * 64; e += 512) { const int rw_ = e >> 6, i_ = e & 63; const int hci = l * 512 + h * 64 + i_; float val;
        switch (rw_) { case 0: val = mu[h * 64 + i_]; break; case 1: val = mu[512 + h * 64 + i_]; break; case 2: val = mu[1024 + h * 64 + i_]; break; case 3: val = mu[1536 + i_]; break; case 4: val = mu[1600 + i_]; break;
            case 5: val = p.rwkv_w0[hci]; break; case 6: val = p.rwkv_a0[hci]; break; case 7: val = p.rwkv_k_k[hci]; break; case 8: val = p.rwkv_k_a[hci]; break; case 9: val = p.rwkv_r_k[hci]; break;
            case 10: val = p.rwkv_ln_w[hci]; break; default: val = p.rwkv_ln_b[hci]; break; }
        ((LAS float*)(L + O_CST))[e] = val; }
#ifdef V_C
    if (tid < 48) { const int task = tid / 6 + 8 * (tid % 6); u32x4 d = {0u, 0u, 0u, 3u};
        if (task < 36) { int q, mn;
            if (task < 6) { q = 0; mn = (int)((0xEDC984ull >> (4 * task)) & 0xF); }
            else { q = 1 + (task - 6) / 10; mn = (int)((0xFEDCA98540ull >> (4 * ((task - 6) % 10))) & 0xF); }
            const int m0 = 16 * (mn >> 2), n0 = 16 * (mn & 3);
            d.x = (unsigned)(((q < 2) ? S_A : S_R) * TB + m0 * LP * 2); d.y = (unsigned)(((q & 1) ? S_K : S_B) * TB + n0 * LP * 2);
            d.z = (unsigned)(((q == 0) ? S_MOFF : (q == 1) ? S_MAK : (q == 2) ? S_MRB : S_MRK) * TB + (n0 * LP + m0) * 2);
            d.w = (m0 == n0) ? ((q < 2) ? 1u : 2u) : 0u;
        } else { const int z = task - 36; const int mn = (int)((0xB76321ull >> (4 * (z % 6))) & 0xF);
            d.z = (unsigned)(((z < 6) ? S_MAK : S_MRK) * TB + (16 * (mn & 3) * LP + 16 * (mn >> 2)) * 2); }
        *(LAS u32x2*)(L + O_TT + tid * 8) = (u32x2){(d.x >> 4) | ((d.y >> 4) << 16), (d.z >> 4) | (d.w << 16)}; }
#endif
    RWKV_LOAD(0, t, c8);
    __syncthreads();
    for (int c = 0; c < SEQ / 64; ++c) {
        int c8v = c8, tv = t, frv = fr, fqv = fq; asm volatile("" : "+v"(c8v), "+v"(tv), "+v"(frv), "+v"(fqv));
        const int twv = tv & 7;
        float r[8], kraw[8], v[8];
        { float cu[8], pr[8], m8[8], o[8];
          unpack8(raw[0], cu); unpack8(raw[1], pr); ld8l((const LAS float*)(L + O_CST) + 0 * 64 + c8v, m8);
#pragma unroll
          for (int e = 0; e < 8; ++e) r[e] = cu[e] + (pr[e] - cu[e]) * m8[e];
          unpack8(raw[2], cu); unpack8(raw[3], pr); ld8l((const LAS float*)(L + O_CST) + 1 * 64 + c8v, m8);
#pragma unroll
          for (int e = 0; e < 8; ++e) kraw[e] = cu[e] + (pr[e] - cu[e]) * m8[e];
          unpack8(raw[4], cu); unpack8(raw[5], pr); ld8l((const LAS float*)(L + O_CST) + 2 * 64 + c8v, m8);
#pragma unroll
          for (int e = 0; e < 8; ++e) v[e] = cu[e] + (pr[e] - cu[e]) * m8[e];
#ifdef V_V
          *(LAS u32x4*)(SLOT(S_V) + (tv * LP + c8v) * 2) = pack8(v);
#endif
          unpack8(raw[6], cu); unpack8(raw[7], pr); ld8l((const LAS float*)(L + O_CST) + 3 * 64 + c8v, m8);
#pragma unroll
          for (int e = 0; e < 8; ++e) { const float x = cu[e] + (pr[e] - cu[e]) * m8[e]; o[e] = 1.0f - 2.0f * __builtin_amdgcn_rcpf(ex2(x * (2.0f * LOG2E)) + 1.0f); }
          *(LAS u32x4*)(SLOT(S_A) + (tv * LP + c8v) * 2) = pack8(o);
          unpack8(raw[8], cu); unpack8(raw[9], pr); ld8l((const LAS float*)(L + O_CST) + 4 * 64 + c8v, m8);
#pragma unroll
          for (int e = 0; e < 8; ++e) o[e] = cu[e] + (pr[e] - cu[e]) * m8[e];
          *(LAS u32x4*)(SLOT(S_B) + (tv * LP + c8v) * 2) = pack8(o); }
        __syncthreads();
        relaunder(lo);
#ifdef U_P2
        { const LAS unsigned char* X = (w < 4) ? SLOT(S_A) : SLOT(S_B); LAS float* Z = (LAS float*)(L + ((w < 4) ? O_ZW : O_ZA));
          f32x4 zacc[4];
#pragma unroll
          for (int m = 0; m < 4; ++m) { f32x4 a = {0.f, 0.f, 0.f, 0.f};
#pragma unroll
              for (int kk = 0; kk < 2; ++kk) a = MFMA16(frag_n(X, 16 * m, kk, lo), bup[kk], a);
              zacc[m] = a; }
#pragma unroll
          for (int m = 0; m < 4; ++m)
#pragma unroll
              for (int rr = 0; rr < 4; ++rr) Z[(16 * m + 4 * fqv + rr) * FP + cw + frv] = zacc[m][rr]; }
#else
        { const LAS unsigned char* X = (w < 4) ? SLOT(S_A) : SLOT(S_B); LAS float* Z = (LAS float*)(L + ((w < 4) ? O_ZW : O_ZA));
#pragma unroll
          for (int m = 0; m < 4; ++m) { f32x4 a = {0.f, 0.f, 0.f, 0.f};
#pragma unroll
              for (int kk = 0; kk < 2; ++kk) a = MFMA16(frag_n(X, 16 * m, kk, lo), bup[kk], a);
#pragma unroll
              for (int rr = 0; rr < 4; ++rr) Z[(16 * m + 4 * fqv + rr) * FP + cw + frv] = a[rr]; } }
#endif
        __syncthreads();
        float kk_[8], kp[8], bb[8], lw[8], cs[8], cb;
        { float zw[8], za[8], c0[8], c1[8];
          ld8l((const LAS float*)(L + O_ZW) + tv * FP + c8v, zw); ld8l((const LAS float*)(L + O_ZA) + tv * FP + c8v, za);
          ld8l((const LAS float*)(L + O_CST) + 5 * 64 + c8v, c0); ld8l((const LAS float*)(L + O_CST) + 6 * 64 + c8v, c1);
          float av[8];
#pragma unroll
#ifdef V_A
          for (int e = 0; e < 8; ++e) { lw[e] = -(LOG2E * 0.6065306597126334f) * __builtin_amdgcn_rcpf(1.0f + ex2(-(zw[e] + c0[e]) * LOG2E));
              av[e] = __builtin_amdgcn_rcpf(1.0f + ex2(-(za[e] + c1[e]) * LOG2E)); }
#else
          for (int e = 0; e < 8; ++e) { const float x = -(zw[e] + c0[e]); const float sp = fmaxf(x, 0.f) + LN2 * __builtin_amdgcn_logf(1.0f + ex2(-fabsf(x) * LOG2E));
              lw[e] = -LOG2E * ex2((-sp - 0.5f) * LOG2E);
              av[e] = __builtin_amdgcn_rcpf(1.0f + ex2(-(za[e] + c1[e]) * LOG2E)); }
#endif
          ld8l((const LAS float*)(L + O_CST) + 7 * 64 + c8v, c0); ld8l((const LAS float*)(L + O_CST) + 8 * 64 + c8v, c1);
          float ss = 0.f;
#pragma unroll
          for (int e = 0; e < 8; ++e) { kk_[e] = kraw[e] * c0[e]; ss += kk_[e] * kk_[e]; kp[e] = kraw[e] * (1.0f + (av[e] - 1.0f) * c1[e]); }
          ss = sum8(ss);
          const float inv = 1.0f / fmaxf(sqrtf(ss), 1e-12f);
          ld8l((const LAS float*)(L + O_CST) + 9 * 64 + c8v, c0);
          float cp = 0.f;
#pragma unroll
          for (int e = 0; e < 8; ++e) { kk_[e] *= inv; bb[e] = kk_[e] * av[e]; cp += r[e] * kp[e] * c0[e]; }
          cb = sum8(cp);
#pragma unroll
          for (int e = 0; e < 8; ++e) { float x = lw[e];
              float y = __shfl_up(x, 8); if (twv >= 1) x += y;
              y = __shfl_up(x, 16); if (twv >= 2) x += y;
              y = __shfl_up(x, 32); if (twv >= 4) x += y;
              cs[e] = x; }
          if (twv == 7) { LAS float* WT = (LAS float*)(L + O_WT) + w * 64 + c8v;
#pragma unroll
              for (int e = 0; e < 8; ++e) WT[e] = cs[e]; } }
        __syncthreads();
        { float off[8], tot[8];
#pragma unroll
          for (int e = 0; e < 8; ++e) { off[e] = 0.f; tot[e] = 0.f; }
#ifdef V_B
          { int wq = w; asm volatile("" : "+s"(wq));
#pragma unroll
            for (int g = 0; g < 8; ++g) { float x[8]; ld8l((const LAS float*)(L + O_WT) + g * 64 + c8v, x); const float mk = (g < wq) ? 1.0f : 0.0f;
#pragma unroll
                for (int e = 0; e < 8; ++e) { off[e] = __builtin_fmaf(x[e], mk, off[e]); tot[e] += x[e]; }
                if (g & 1) __builtin_amdgcn_sched_barrier(0); } }
#else
#pragma unroll
          for (int g = 0; g < 8; ++g) { float x[8]; ld8l((const LAS float*)(L + O_WT) + g * 64 + c8v, x);
#pragma unroll
              for (int e = 0; e < 8; ++e) { if (g < w) off[e] += x[e]; tot[e] += x[e]; } }
#endif
          if (tv == 0) { LAS float* CL = (LAS float*)(L + O_CL) + c8v;
#pragma unroll
              for (int e = 0; e < 8; ++e) CL[e] = tot[e]; }
          float o[8], en[8], ep[8]; const int toff = (tv * LP + c8v) * 2;
#pragma unroll
          for (int e = 0; e < 8; ++e) { cs[e] += off[e]; en[e] = ex2(-cs[e]); ep[e] = __builtin_amdgcn_rcpf(en[e]); o[e] = -kk_[e] * ep[e] * ex2(-lw[e]); }
          *(LAS u32x4*)(SLOT(S_A) + toff) = pack8(o);
#pragma unroll
          for (int e = 0; e < 8; ++e) o[e] = bb[e] * en[e];
          *(LAS u32x4*)(SLOT(S_B) + toff) = pack8(o);
#pragma unroll
          for (int e = 0; e < 8; ++e) o[e] = kp[e] * en[e];
          *(LAS u32x4*)(SLOT(S_K) + toff) = pack8(o);
#pragma unroll
          for (int e = 0; e < 8; ++e) o[e] = r[e] * ep[e];
          *(LAS u32x4*)(SLOT(S_R) + toff) = pack8(o);
#pragma unroll
          for (int e = 0; e < 8; ++e) { en[e] = ex2(tot[e] - cs[e]); o[e] = bb[e] * en[e]; }
          *(LAS u32x4*)(SLOT(S_BT) + toff) = pack8(o);
#pragma unroll
          for (int e = 0; e < 8; ++e) o[e] = kp[e] * en[e];
          *(LAS u32x4*)(SLOT(S_KT) + toff) = pack8(o);
#ifndef V_V
          *(LAS u32x4*)(SLOT(S_V) + toff) = pack8(v);
#endif
        }
        __syncthreads();
        relaunder(lo);
        int wv = w; asm volatile("" : "+s"(wv));
#ifdef U_P4
        f32x4 tacc[5];
#pragma unroll
        for (int it = 0; it < 5; ++it) { const int task = wv + 8 * it; f32x4 a = {0.f, 0.f, 0.f, 0.f};
            if (task < 36) {
                int q, mn;
                if (task < 6) { q = 0; mn = (int)((0xEDC984ull >> (4 * task)) & 0xF); }
                else { q = 1 + (task - 6) / 10; mn = (int)((0xFEDCA98540ull >> (4 * ((task - 6) % 10))) & 0xF); }
                const int m0 = 16 * (mn >> 2), n0 = 16 * (mn & 3);
                const LAS unsigned char* XA = (q < 2) ? SLOT(S_A) : SLOT(S_R); const LAS unsigned char* XB = (q & 1) ? SLOT(S_K) : SLOT(S_B);
#pragma unroll
                for (int kk = 0; kk < 2; ++kk) a = MFMA16(frag_n(XA, m0, kk, lo), frag_n(XB, n0, kk, lo), a);
                if (m0 == n0) {
#pragma unroll
                    for (int rr = 0; rr < 4; ++rr) { const bool keep = (q < 2) ? (frv < 4 * fqv + rr) : (frv <= 4 * fqv + rr); a[rr] = keep ? a[rr] : 0.f; } } }
            tacc[it] = a; }
        if (wv < 4) {
            f32x4 a = {0.f, 0.f, 0.f, 0.f};
#pragma unroll
            for (int kk = 0; kk < 2; ++kk) a = MFMA16(frag_n(SLOT(S_A), 16 * wv, kk, lo), frag_n(SLOT(S_B), 16 * wv, kk, lo), a);
#pragma unroll
            for (int rr = 0; rr < 4; ++rr) a[rr] = (frv < 4 * fqv + rr) ? a[rr] : 0.f;
            float x[16];
            { LAS float* NS = (LAS float*)(SLOT(hnxt) + wv * 1024);
#pragma unroll
              for (int rr = 0; rr < 4; ++rr) NS[(4 * fqv + rr) * 16 + frv] = a[rr];
              asm volatile("s_waitcnt lgkmcnt(0)" ::: "memory");
#pragma unroll
              for (int rw = 0; rw < 16; ++rw) { float s = (rw == frv) ? 1.f : 0.f;
#pragma unroll
                  for (int sc = 0; sc < rw; ++sc) s = __builtin_fmaf(NS[rw * 16 + sc], x[sc], s);
                  x[rw] = s; }
              asm volatile("s_waitcnt lgkmcnt(0)" ::: "memory"); }
            if (fqv == 0) { LAS unsigned char* dp = SLOT(S_D) + ((16 * wv + frv) * LP + 16 * wv) * 2;
                float lo8[8], hi8[8];
#pragma unroll
                for (int e = 0; e < 8; ++e) { lo8[e] = x[e]; hi8[e] = x[8 + e]; }
                *(LAS u32x4*)dp = pack8(lo8); *(LAS u32x4*)(dp + 16) = pack8(hi8); }
        }
#pragma unroll
        for (int it = 0; it < 6; ++it) { const int task = wv + 8 * it;
            if (task < 36) {
                int q, mn;
                if (task < 6) { q = 0; mn = (int)((0xEDC984ull >> (4 * task)) & 0xF); }
                else { q = 1 + (task - 6) / 10; mn = (int)((0xFEDCA98540ull >> (4 * ((task - 6) % 10))) & 0xF); }
                st_tile_T(SLOT((q == 0) ? S_MOFF : (q == 1) ? S_MAK : (q == 2) ? S_MRB : S_MRK), 16 * (mn >> 2), 16 * (mn & 3), lo, tacc[it < 5 ? it : 4]);
            } else if (task < 48) {
                const int z = task - 36; const int mn = (int)((0xB76321ull >> (4 * (z % 6))) & 0xF);
                st_tile_T(SLOT((z < 6) ? S_MAK : S_MRK), 16 * (mn >> 2), 16 * (mn & 3), lo, (f32x4){0.f, 0.f, 0.f, 0.f});
            } }
#else
#ifdef V_C
        u32x4 dq[3];
#pragma unroll
        for (int j = 0; j < 3; ++j) dq[j] = *(const LAS u32x4*)(L + O_TT + wv * 48 + j * 16);
#endif
        if (wv < 4) {
            f32x4 a = {0.f, 0.f, 0.f, 0.f};
#pragma unroll
            for (int kk = 0; kk < 2; ++kk) a = MFMA16(frag_n(SLOT(S_A), 16 * wv, kk, lo), frag_n(SLOT(S_B), 16 * wv, kk, lo), a);
#pragma unroll
            for (int rr = 0; rr < 4; ++rr) a[rr] = (frv < 4 * fqv + rr) ? a[rr] : 0.f;
            float x[16];
            { LAS float* NS = (LAS float*)(SLOT(hnxt) + wv * 1024);
#pragma unroll
              for (int rr = 0; rr < 4; ++rr) NS[(4 * fqv + rr) * 16 + frv] = a[rr];
              asm volatile("s_waitcnt lgkmcnt(0)" ::: "memory");
#pragma unroll
              for (int rw = 0; rw < 16; ++rw) { float s = (rw == frv) ? 1.f : 0.f;
#pragma unroll
                  for (int sc = 0; sc < rw; ++sc) s = __builtin_fmaf(NS[rw * 16 + sc], x[sc], s);
                  x[rw] = s; }
              asm volatile("s_waitcnt lgkmcnt(0)" ::: "memory"); }
            if (fqv == 0) { LAS unsigned char* dp = SLOT(S_D) + ((16 * wv + frv) * LP + 16 * wv) * 2;
                float lo8[8], hi8[8];
#pragma unroll
                for (int e = 0; e < 8; ++e) { lo8[e] = x[e]; hi8[e] = x[8 + e]; }
                *(LAS u32x4*)dp = pack8(lo8); *(LAS u32x4*)(dp + 16) = pack8(hi8); }
        }
#ifdef V_C
        {
#pragma unroll
          for (int it = 0; it < 6; ++it) {
            const unsigned e0 = (unsigned)__builtin_amdgcn_readfirstlane((int)((it & 1) ? dq[it >> 1].z : dq[it >> 1].x)), e1 = (unsigned)__builtin_amdgcn_readfirstlane((int)((it & 1) ? dq[it >> 1].w : dq[it >> 1].y));
            const int mode = (int)(e1 >> 16); LAS unsigned char* dst = L + ((e1 & 0xffffu) << 4) + lo.bs;
            if (mode < 3) {
                const LAS unsigned char* pa = L + ((e0 & 0xffffu) << 4) + lo.bn; const LAS unsigned char* pb = L + ((e0 >> 16) << 4) + lo.bn;
                f32x4 a = MFMA16(*(const LAS bf16x8*)pa, *(const LAS bf16x8*)pb, (f32x4){0.f, 0.f, 0.f, 0.f});
                a = MFMA16(*(const LAS bf16x8*)(pa + 64), *(const LAS bf16x8*)(pb + 64), a);
                if (mode) { const int thr = frv + ((mode == 1) ? 1 : 0);
#pragma unroll
                    for (int rr = 0; rr < 4; ++rr) a[rr] = (thr <= 4 * fqv + rr) ? a[rr] : 0.f; }
                u32x2 wq_; wq_.x = pk2(a[0], a[1]); wq_.y = pk2(a[2], a[3]); *(LAS u32x2*)dst = wq_;
            } else { *(LAS u32x2*)dst = (u32x2){0u, 0u}; } } }
#else
#pragma unroll
        for (int it = 0; it < 6; ++it) { const int task = wv + 8 * it;
            if (task < 36) {
                int q, mn;
                if (task < 6) { q = 0; mn = (int)((0xEDC984ull >> (4 * task)) & 0xF); }
                else { q = 1 + (task - 6) / 10; mn = (int)((0xFEDCA98540ull >> (4 * ((task - 6) % 10))) & 0xF); }
                const int m0 = 16 * (mn >> 2), n0 = 16 * (mn & 3);
                const LAS unsigned char* XA = (q < 2) ? SLOT(S_A) : SLOT(S_R); const LAS unsigned char* XB = (q & 1) ? SLOT(S_K) : SLOT(S_B);
                f32x4 a = {0.f, 0.f, 0.f, 0.f};
#pragma unroll
                for (int kk = 0; kk < 2; ++kk) a = MFMA16(frag_n(XA, m0, kk, lo), frag_n(XB, n0, kk, lo), a);
                if (m0 == n0) {
#pragma unroll
                    for (int rr = 0; rr < 4; ++rr) { const bool keep = (q < 2) ? (frv < 4 * fqv + rr) : (frv <= 4 * fqv + rr); a[rr] = keep ? a[rr] : 0.f; } }
                st_tile_T(SLOT((q == 0) ? S_MOFF : (q == 1) ? S_MAK : (q == 2) ? S_MRB : S_MRK), m0, n0, lo, a);
            } else if (task < 48) {
                const int z = task - 36; const int mn = (int)((0xB76321ull >> (4 * (z % 6))) & 0xF);
                st_tile_T(SLOT((z < 6) ? S_MAK : S_MRK), 16 * (mn >> 2), 16 * (mn & 3), lo, (f32x4){0.f, 0.f, 0.f, 0.f});
            } }
#endif
#endif
        __syncthreads();
        relaunder(lo);
        f32x4 yacc[4];
#ifdef U_P5
        if (w < 4) {
            f32x4 xr[4];
#pragma unroll
            for (int i = 0; i < 4; ++i) { f32x4 a = {0.f, 0.f, 0.f, 0.f};
#pragma unroll
                for (int kk = 0; kk < 2; ++kk) { if (32 * kk < 16 * i + 16) a = MFMA16(frag_t(SLOT(S_MAK), kk, 16 * i, lo), frag_t(SLOT(S_V), kk, cw, lo), a);
                    a = MFMA16(frag_n(SLOT(S_A), 16 * i, kk, lo), frag_n(SLOT(hcur), cw, kk, lo), a); }
                xr[i] = a; }
#pragma unroll
            for (int i = 0; i < 4; ++i) { f32x4 a = xr[i];
#pragma unroll
                for (int kk = 0; kk < 2; ++kk) if (32 * kk < 16 * i) a = MFMA16(frag_t(SLOT(S_MOFF), kk, 16 * i, lo), frag_n(SLOT(S_ZT), cw, kk, lo), a);
                st_tile_T(SLOT(S_ACC), 16 * i, cw, lo, a);
                asm volatile("" ::: "memory");
                const f32x4 z = MFMA16(frag_t(SLOT(S_D), i >> 1, 16 * i, lo), frag_n(SLOT(S_ACC), cw, i >> 1, lo), (f32x4){0.f, 0.f, 0.f, 0.f});
                st_tile_T(SLOT(S_ZT), 16 * i, cw, lo, z);
                asm volatile("" ::: "memory"); }
#else
        if (w < 4) {
#pragma unroll
            for (int i = 0; i < 4; ++i) { f32x4 a = {0.f, 0.f, 0.f, 0.f};
#pragma unroll
                for (int kk = 0; kk < 2; ++kk) { if (32 * kk < 16 * i + 16) a = MFMA16(frag_t(SLOT(S_MAK), kk, 16 * i, lo), frag_t(SLOT(S_V), kk, cw, lo), a);
                    a = MFMA16(frag_n(SLOT(S_A), 16 * i, kk, lo), frag_n(SLOT(hcur), cw, kk, lo), a); }
#pragma unroll
                for (int kk = 0; kk < 2; ++kk) if (32 * kk < 16 * i) a = MFMA16(frag_t(SLOT(S_MOFF), kk, 16 * i, lo), frag_n(SLOT(S_ZT), cw, kk, lo), a);
                st_tile_T(SLOT(S_ACC), 16 * i, cw, lo, a);
                const f32x4 z = MFMA16(frag_t(SLOT(S_D), i >> 1, 16 * i, lo), frag_n(SLOT(S_ACC), cw, i >> 1, lo), (f32x4){0.f, 0.f, 0.f, 0.f});
                st_tile_T(SLOT(S_ZT), 16 * i, cw, lo, z); }
#endif
        } else {
#pragma unroll
            for (int i = 0; i < 4; ++i) { f32x4 a = {0.f, 0.f, 0.f, 0.f};
#pragma unroll
                for (int kk = 0; kk < 2; ++kk) { if (32 * kk < 16 * i + 16) a = MFMA16(frag_t(SLOT(S_MRK), kk, 16 * i, lo), frag_t(SLOT(S_V), kk, cw, lo), a);
                    a = MFMA16(frag_n(SLOT(S_R), 16 * i, kk, lo), frag_n(SLOT(hcur), cw, kk, lo), a);
                }
                yacc[i] = a; }
        }
        __syncthreads();
        relaunder(lo);
        if (c + 1 < SEQ / 64) RWKV_LOAD(c + 1, tv, c8v);
#ifdef U_P7
        if (w >= 4) {
#pragma unroll
            for (int i = 0; i < 4; ++i) {
#pragma unroll
                for (int rr = 0; rr < 4; ++rr) hacc[i][rr] = hacc[i][rr] * ex2(((const LAS float*)(L + O_CL))[16 * i + 4 * fqv + rr]);
#pragma unroll
                for (int kk = 0; kk < 2; ++kk) { hacc[i] = MFMA16(frag_t(SLOT(S_KT), kk, 16 * i, lo), frag_t(SLOT(S_V), kk, cw, lo), hacc[i]);
                    hacc[i] = MFMA16(frag_t(SLOT(S_BT), kk, 16 * i, lo), frag_n(SLOT(S_ZT), cw, kk, lo), hacc[i]); }
#pragma unroll
                for (int kk = 0; kk < 2; ++kk) if (32 * kk < 16 * i + 16) yacc[i] = MFMA16(frag_t(SLOT(S_MRB), kk, 16 * i, lo), frag_n(SLOT(S_ZT), cw, kk, lo), yacc[i]); }
#pragma unroll
            for (int i = 0; i < 4; ++i) { st_tile_T(SLOT(hnxt), 16 * i, cw, lo, hacc[i]);
#pragma unroll
                for (int rr = 0; rr < 4; ++rr) ((LAS float*)(L + O_YB))[(16 * i + 4 * fqv + rr) * FP + cw + frv] = yacc[i][rr]; }
        }
#else
        if (w >= 4) {
#pragma unroll
            for (int i = 0; i < 4; ++i) {
#pragma unroll
                for (int rr = 0; rr < 4; ++rr) hacc[i][rr] = hacc[i][rr] * ex2(((const LAS float*)(L + O_CL))[16 * i + 4 * fqv + rr]);
#pragma unroll
                for (int kk = 0; kk < 2; ++kk) { hacc[i] = MFMA16(frag_t(SLOT(S_KT), kk, 16 * i, lo), frag_t(SLOT(S_V), kk, cw, lo), hacc[i]);
                    hacc[i] = MFMA16(frag_t(SLOT(S_BT), kk, 16 * i, lo), frag_n(SLOT(S_ZT), cw, kk, lo), hacc[i]); }
                st_tile_T(SLOT(hnxt), 16 * i, cw, lo, hacc[i]);
#pragma unroll
                for (int kk = 0; kk < 2; ++kk) if (32 * kk < 16 * i + 16) yacc[i] = MFMA16(frag_t(SLOT(S_MRB), kk, 16 * i, lo), frag_n(SLOT(S_ZT), cw, kk, lo), yacc[i]);
#pragma unroll
                for (int rr = 0; rr < 4; ++rr) ((LAS float*)(L + O_YB))[(16 * i + 4 * fqv + rr) * FP + cw + frv] = yacc[i][rr]; }
        }
#endif
        __syncthreads();
        { float y[8], g0[8], g1[8]; ld8l((const LAS float*)(L + O_YB) + tv * FP + c8v, y); ld8l((const LAS float*)(L + O_CST) + 10 * 64 + c8v, g0); ld8l((const LAS float*)(L + O_CST) + 11 * 64 + c8v, g1);
          float s = 0.f;
#pragma unroll
          for (int e = 0; e < 8; ++e) s += y[e];
          const float mean = sum8(s) * (1.f / 64.f); float q = 0.f;
#pragma unroll
          for (int e = 0; e < 8; ++e) { y[e] -= mean; q += y[e] * y[e]; }
          const float rs = rsqrtf(sum8(q) * (1.f / 64.f) + RWKV_GN_EPS);
#ifdef V_V
          float vv[8]; unpack8(*(const LAS u32x4*)(SLOT(S_V) + (tv * LP + c8v) * 2), vv);
#pragma unroll
          for (int e = 0; e < 8; ++e) y[e] = y[e] * rs * g0[e] + g1[e] + cb * vv[e];
#else
#pragma unroll
          for (int e = 0; e < 8; ++e) y[e] = y[e] * rs * g0[e] + g1[e] + cb * v[e];
#endif
          *(u32x4*)(Yout + ((size_t)b * SEQ + c * 64 + tv) * 512 + h * 64 + c8v) = pack8(y); }
        { const int tmp = hcur; hcur = hnxt; hnxt = tmp; }
    }
    __syncthreads();
#undef SLOT
#undef RWKV_LOAD
}
}

namespace gla {
using rwkv::vtr; using rwkv::unpack8; using rwkv::pack8; using rwkv::ld8l; using rwkv::ex2; using rwkv::LOG2E; using rwkv::LN2; using rwkv::MFMA16;
constexpr int LP = 72, VP = 136, TB = 64 * LP * 2;
constexpr int B_QH = 0, B_KH = TB, B_KT = 2 * TB, B_PT = 3 * TB, B_VV = 4 * TB, B_ST = B_VV + 64 * VP * 2, B_OB = B_ST + 128 * LP * 2, B_WT = B_OB + 64 * 132 * 4,
              B_CL = B_WT + 8 * 64 * 4, B_AUP = B_CL + 64 * 4, B_AB = B_AUP + 16 * 64 * 4, B_GN = B_AB + 64 * 4, B_END = B_GN + 128 * 4;
static_assert(B_END <= 131072, "gla lds");
struct LaneOff { int bn, bt, btv, bs; };
__device__ __forceinline__ LaneOff lane_off(int fr, int fq) { LaneOff o; o.bn = (fr * LP + 8 * fq) * 2; o.bt = ((8 * fq + (fr >> 2)) * LP + 4 * (fr & 3)) * 2; o.btv = ((8 * fq + (fr >> 2)) * VP + 4 * (fr & 3)) * 2; o.bs = (fr * LP + 4 * fq) * 2; return o; }
__device__ __forceinline__ void relaunder(LaneOff& o) { asm volatile("" : "+v"(o.bn), "+v"(o.bt), "+v"(o.btv), "+v"(o.bs)); }
__device__ __forceinline__ bf16x8 frag_t(const LAS unsigned char* tile, int kk, int c0, const LaneOff& o) {
    const LAS unsigned char* q = tile + o.bt + (32 * kk * LP + c0) * 2; const s16x4 lo = vtr(q), hi = vtr(q + 4 * LP * 2); return (bf16x8){lo[0], lo[1], lo[2], lo[3], hi[0], hi[1], hi[2], hi[3]}; }
__device__ __forceinline__ bf16x8 frag_tv(const LAS unsigned char* tile, int kk, int c0, const LaneOff& o) {
    const LAS unsigned char* q = tile + o.btv + (32 * kk * VP + c0) * 2; const s16x4 lo = vtr(q), hi = vtr(q + 4 * VP * 2); return (bf16x8){lo[0], lo[1], lo[2], lo[3], hi[0], hi[1], hi[2], hi[3]}; }
__device__ __forceinline__ bf16x8 frag_n(const LAS unsigned char* tile, int r0, int kk, const LaneOff& o) { return *(const LAS bf16x8*)(tile + o.bn + (r0 * LP + 32 * kk) * 2); }
__device__ __forceinline__ void st_tile_T(LAS unsigned char* tile, int m0, int n0, const LaneOff& o, const f32x4 c) { u32x2 w; w.x = pk2(c[0], c[1]); w.y = pk2(c[2], c[3]); *(LAS u32x2*)(tile + o.bs + (n0 * LP + m0) * 2) = w; }

__device__ __forceinline__ void gla_unit(int l, int b, int h, LAS unsigned char* L, unsigned* done_ctr) {
    const Params p = load_params();
    const bf16_t* PA = (const bf16_t*)(p.ws + WS_PA); bf16_t* Yout = (bf16_t*)(p.ws + WS_YS) + (size_t)2 * T * 512;
    const int tid = opaque_tid(), lane = tid & 63, fr = lane & 15, fq = lane >> 4; const int w = __builtin_amdgcn_readfirstlane(tid >> 6);
    const int t = tid >> 3, c8 = (tid & 7) * 8;
    LaneOff lo = lane_off(fr, fq);
    for (int e = tid; e < 16 * 64; e += 512) ((LAS float*)(L + B_AUP))[e] = p.gla_a_up[(size_t)l * 16 * 256 + (e >> 6) * 256 + h * 64 + (e & 63)];
    if (tid < 64) ((LAS float*)(L + B_AB))[tid] = p.gla_a_b[l * 256 + h * 64 + tid];
    if (tid < 128) ((LAS float*)(L + B_GN))[tid] = p.gla_norm[l * 512 + h * 128 + tid];
    for (int e = tid; e < 128 * LP / 2; e += 512) ((LAS unsigned*)(L + B_ST))[e] = 0u;
    for (int e = tid; e < TB / 4; e += 512) ((LAS unsigned*)(L + B_PT))[e] = 0u;
    f32x4 sacc[4];
#pragma unroll
    for (int m = 0; m < 4; ++m) sacc[m] = (f32x4){0.f, 0.f, 0.f, 0.f};
    u32x4 rq, rk, rv0, rv1, rl0, rl1;
#define GLA_LOAD(c) do { const bf16_t* s_ = PA + ((size_t)b * SEQ + (c) * 64 + t) * NA; rq = *(const u32x4*)(s_ + GQ + h * 64 + c8); rk = *(const u32x4*)(s_ + GK + h * 64 + c8); \
        rv0 = *(const u32x4*)(s_ + GV + h * 128 + 2 * c8); rv1 = *(const u32x4*)(s_ + GV + h * 128 + 2 * c8 + 8); rl0 = *(const u32x4*)(s_ + GLAT); rl1 = *(const u32x4*)(s_ + GLAT + 8); } while (0)
    GLA_LOAD(0);
    __syncthreads();
    for (int c = 0; c < SEQ / 64; ++c) {
        int c8v = c8, tv = t, frv = fr, fqv = fq; asm volatile("" : "+v"(c8v), "+v"(tv), "+v"(frv), "+v"(fqv));
        const int twv = tv & 7;
        float cs[8];
        { float lat[16]; { float a8[8]; unpack8(rl0, a8);
#pragma unroll
              for (int j = 0; j < 8; ++j) lat[j] = a8[j];
              unpack8(rl1, a8);
#pragma unroll
              for (int j = 0; j < 8; ++j) lat[8 + j] = a8[j]; }
          float z[8]; ld8l((const LAS float*)(L + B_AB) + c8v, z);
#pragma unroll
          for (int j = 0; j < 16; ++j) { float a8[8]; ld8l((const LAS float*)(L + B_AUP) + j * 64 + c8v, a8);
#pragma unroll
              for (int e = 0; e < 8; ++e) z[e] += lat[j] * a8[e]; }
#pragma unroll
          for (int e = 0; e < 8; ++e) { const float x = -z[e]; const float sp = fmaxf(x, 0.f) + LN2 * __builtin_amdgcn_logf(1.0f + ex2(-fabsf(x) * LOG2E));
              float v_ = -sp * (LOG2E / 16.0f);
              float y = __shfl_up(v_, 8); if (twv >= 1) v_ += y;
              y = __shfl_up(v_, 16); if (twv >= 2) v_ += y;
              y = __shfl_up(v_, 32); if (twv >= 4) v_ += y;
              cs[e] = v_; }
          if (twv == 7) { LAS float* WT = (LAS float*)(L + B_WT) + w * 64 + c8v;
#pragma unroll
              for (int e = 0; e < 8; ++e) WT[e] = cs[e]; } }
        __syncthreads();
        { float off[8], tot[8];
#pragma unroll
          for (int e = 0; e < 8; ++e) { off[e] = 0.f; tot[e] = 0.f; }
#pragma unroll
          for (int g = 0; g < 8; ++g) { float x[8]; ld8l((const LAS float*)(L + B_WT) + g * 64 + c8v, x);
#pragma unroll
              for (int e = 0; e < 8; ++e) { if (g < w) off[e] += x[e]; tot[e] += x[e]; } }
          if (tv == 0) { LAS float* CL = (LAS float*)(L + B_CL) + c8v;
#pragma unroll
              for (int e = 0; e < 8; ++e) CL[e] = tot[e]; }
          float q8[8], k8[8], o[8], en[8]; unpack8(rq, q8); unpack8(rk, k8); const int toff = (tv * LP + c8v) * 2;
#pragma unroll
          for (int e = 0; e < 8; ++e) { cs[e] += off[e]; en[e] = ex2(-cs[e]); o[e] = q8[e] * 0.125f * __builtin_amdgcn_rcpf(en[e]); }
          *(LAS u32x4*)(L + B_QH + toff) = pack8(o);
#pragma unroll
          for (int e = 0; e < 8; ++e) o[e] = k8[e] * en[e];
          *(LAS u32x4*)(L + B_KH + toff) = pack8(o);
#pragma unroll
          for (int e = 0; e < 8; ++e) o[e] = k8[e] * ex2(tot[e] - cs[e]);
          *(LAS u32x4*)(L + B_KT + toff) = pack8(o);
          *(LAS u32x4*)(L + B_VV + (tv * VP + 2 * c8v) * 2) = rv0; *(LAS u32x4*)(L + B_VV + (tv * VP + 2 * c8v + 8) * 2) = rv1; }
        if (c + 1 < SEQ / 64) GLA_LOAD(c + 1);
        __syncthreads();
        relaunder(lo);
        { const int m0 = 16 * (w >> 1);
#pragma unroll
          for (int nn = 0; nn < 2; ++nn) { const int n0 = 32 * (w & 1) + 16 * nn;
              if (n0 <= m0) { f32x4 a = {0.f, 0.f, 0.f, 0.f};
#pragma unroll
                  for (int kk = 0; kk < 2; ++kk) a = MFMA16(frag_n(L + B_QH, m0, kk, lo), frag_n(L + B_KH, n0, kk, lo), a);
                  if (n0 == m0) {
#pragma unroll
                      for (int rr = 0; rr < 4; ++rr) a[rr] = (frv <= 4 * fqv + rr) ? a[rr] : 0.f; }
                  st_tile_T(L + B_PT, m0, n0, lo, a); } } }
        __syncthreads();
        relaunder(lo);
        { const int n0 = 16 * w;
#pragma unroll
          for (int m = 0; m < 4; ++m) { f32x4 a = {0.f, 0.f, 0.f, 0.f};
#pragma unroll
              for (int kk = 0; kk < 2; ++kk) { if (32 * kk < 16 * m + 16) a = MFMA16(frag_t(L + B_PT, kk, 16 * m, lo), frag_tv(L + B_VV, kk, n0, lo), a);
                  a = MFMA16(frag_n(L + B_QH, 16 * m, kk, lo), frag_n(L + B_ST, n0, kk, lo), a); }
#pragma unroll
              for (int rr = 0; rr < 4; ++rr) ((LAS float*)(L + B_OB))[(16 * m + 4 * fqv + rr) * 132 + n0 + frv] = a[rr]; }
          asm volatile("" ::: "memory");
#pragma unroll
          for (int m = 0; m < 4; ++m) { f32x4 a = sacc[m];
#pragma unroll
              for (int rr = 0; rr < 4; ++rr) a[rr] *= ex2(((const LAS float*)(L + B_CL))[16 * m + 4 * fqv + rr]);
#pragma unroll
              for (int kk = 0; kk < 2; ++kk) a = MFMA16(frag_t(L + B_KT, kk, 16 * m, lo), frag_tv(L + B_VV, kk, n0, lo), a);
              sacc[m] = a; st_tile_T(L + B_ST, 16 * m, n0, lo, a); } }
        __syncthreads();
        { float v0[8], v1[8], g0[8], g1[8]; float ss = 0.f; const LAS float* ob = (const LAS float*)(L + B_OB) + tv * 132 + 2 * c8v;
          ld8l(ob, v0); ld8l(ob + 8, v1);
#pragma unroll
          for (int e = 0; e < 8; ++e) ss += v0[e] * v0[e] + v1[e] * v1[e];
          ss = sum8(ss);
          const float rstd = rsqrtf(ss * (1.f / 128.f) + NORM_EPS);
          ld8l((const LAS float*)(L + B_GN) + 2 * c8v, g0); ld8l((const LAS float*)(L + B_GN) + 2 * c8v + 8, g1);
          float o0[8], o1[8];
#pragma unroll
          for (int e = 0; e < 8; ++e) { o0[e] = v0[e] * rstd * g0[e]; o1[e] = v1[e] * rstd * g1[e]; }
          bf16_t* dst = Yout + ((size_t)b * SEQ + c * 64 + tv) * 512 + h * 128 + 2 * c8v;
          *(u32x4*)dst = pack8(o0); *(u32x4*)(dst + 8) = pack8(o1); }
    }
    asm volatile("s_waitcnt vmcnt(0)" ::: "memory");
    __syncthreads();
    if (tid == 0) __hip_atomic_fetch_add(done_ctr, 1u, __ATOMIC_RELEASE, __HIP_MEMORY_SCOPE_AGENT);
#undef GLA_LOAD
}
}

#define XB_TMO      128
#define XB_XCNT(j)  (256  + 64 * (j))
#define XB_XSUB(j)  (1280 + 64 * (j))
#define XB_XGEN(j)  (2304 + 64 * (j))
#define XB_TOP      3328
#define XB_TOPGEN   3392
#define XCD_BAR_WORDS 3456
#define XB_SPIN_CAP (1u << 18)

__device__ __forceinline__ unsigned xb_ld(unsigned* p)              { return __hip_atomic_load(p, __ATOMIC_RELAXED, __HIP_MEMORY_SCOPE_AGENT); }
__device__ __forceinline__ unsigned xb_add(unsigned* p, unsigned v) { return __hip_atomic_fetch_add(p, v, __ATOMIC_RELAXED, __HIP_MEMORY_SCOPE_AGENT); }
__device__ __forceinline__ unsigned xb_xcc_id() { return (unsigned)__builtin_amdgcn_s_getreg((3 << 11) | 20) & 0xFu; }
#define XB_SPIN(cond, bar) do { unsigned _sp = 0; while (cond) { __builtin_amdgcn_s_sleep(1); \
    if ((++_sp & 255u) == 0u) { if (xb_ld(&(bar)[XB_TMO])) break; if (_sp > XB_SPIN_CAP) { atomicAdd(&(bar)[XB_TMO], 1u); break; } } } } while (0)

struct XcdBarrier {
    unsigned* bar; unsigned x;
    volatile LAS unsigned* st;
};

__device__ __forceinline__ XcdBarrier xcd_barrier_post(unsigned* bar, volatile LAS unsigned* st) {
    XcdBarrier b; b.bar = bar; b.x = xb_xcc_id(); b.st = st;
    if (threadIdx.x == 0) (void)xb_add(&bar[XB_XCNT(b.x)], 1u);
    return b;
}
__device__ __forceinline__ void xcd_barrier_complete(unsigned* bar, unsigned x, unsigned& nloc, unsigned& nx) {
    const unsigned G = gridDim.x * gridDim.y * gridDim.z;
    unsigned sum, cnt, mine, sp = 0u;
    for (;;) {
        sum = 0u; cnt = 0u; mine = 0u;
#pragma unroll
        for (unsigned j = 0; j < 16; ++j) { const unsigned c = xb_ld(&bar[XB_XCNT(j)]); sum += c; cnt += (c > 0u) ? 1u : 0u; mine = (j == x) ? c : mine; }
        if (sum == G) break;
        __builtin_amdgcn_s_sleep(1);
        if ((++sp & 255u) == 0u) { if (xb_ld(&bar[XB_TMO])) break; if (sp > XB_SPIN_CAP) { atomicAdd(&bar[XB_TMO], 1u); break; } }
    }
    nloc = mine > 0u ? mine : 1u; nx = cnt > 0u ? cnt : 1u;
}

__device__ __forceinline__ void xcd_barrier(const XcdBarrier& b) {
    asm volatile("s_waitcnt vmcnt(0)" ::: "memory");
    __syncthreads();
    if (threadIdx.x == 0) {
        unsigned* bar = b.bar;
        __builtin_amdgcn_s_waitcnt(0);
        unsigned nloc = b.st[0], nx = b.st[1];
        if (nloc == 0u) { xcd_barrier_complete(bar, b.x, nloc, nx); b.st[0] = nloc; b.st[1] = nx; }
        const unsigned old = xb_add(&bar[XB_XSUB(b.x)], 1u);
        const unsigned gen = old / nloc;
        if (old + 1u == (gen + 1u) * nloc) {
            __builtin_amdgcn_fence(__ATOMIC_RELEASE, "agent");
            asm volatile("s_waitcnt vmcnt(0)" ::: "memory");
            const unsigned og = xb_add(&bar[XB_TOP], 1u);
            const unsigned tg = og / nx;
            if (og + 1u == (tg + 1u) * nx) xb_add(&bar[XB_TOPGEN], 1u);
            else XB_SPIN(xb_ld(&bar[XB_TOPGEN]) == tg, bar);
            __builtin_amdgcn_fence(__ATOMIC_ACQUIRE, "agent");
            xb_add(&bar[XB_XGEN(b.x)], 1u);
            asm volatile("s_waitcnt vmcnt(0)" ::: "memory");
        } else {
            XB_SPIN(xb_ld(&bar[XB_XGEN(b.x)]) == gen, bar);
            __builtin_amdgcn_fence(__ATOMIC_ACQUIRE, "agent");
            asm volatile("s_waitcnt vmcnt(0)" ::: "memory");
        }
    }
    __syncthreads();
}

constexpr int NWAVES = 8, NTHREADS = 512;
constexpr int LDS_MISC = 155648, LDS_BYTES = 159744;
constexpr int PH_PER_LAYER = 8, N_PHASES = 1 + DEPTH * PH_PER_LAYER;
constexpr int CW_BAR = 4096;
constexpr int MG_BLOCKS = 192;
constexpr int RWKV_BLOCKS = 64, SUB_BLOCKS = 256 - RWKV_BLOCKS;
constexpr int N_ATT_UNITS = 64 * (SEQ / 512), N_MIX_ITEMS = 32 + N_ATT_UNITS;
#ifndef MK_MULTI_LAUNCH
#define MK_MULTI_LAUNCH 0
#endif

__device__ __forceinline__ void sub_barrier(unsigned* cnt, unsigned target) {
    asm volatile("s_waitcnt vmcnt(0)" ::: "memory");
    __syncthreads();
    if (threadIdx.x == 0) {
        __builtin_amdgcn_fence(__ATOMIC_RELEASE, "agent"); asm volatile("s_waitcnt vmcnt(0)" ::: "memory");
        __hip_atomic_fetch_add(cnt, 1u, __ATOMIC_RELAXED, __HIP_MEMORY_SCOPE_AGENT);
        unsigned sp = 0; while (__hip_atomic_load(cnt, __ATOMIC_RELAXED, __HIP_MEMORY_SCOPE_AGENT) < target && ++sp < (1u << 24)) __builtin_amdgcn_s_sleep(2);
        __builtin_amdgcn_fence(__ATOMIC_ACQUIRE, "agent"); asm volatile("s_waitcnt vmcnt(0)" ::: "memory");
    }
    __syncthreads();
}
__global__ void __launch_bounds__(NTHREADS, 2) hybrid_fwd(Params p_unused) {
    extern __shared__ __attribute__((aligned(16))) unsigned char lds[];
    cg::grid_group grid = cg::this_grid();
#define G ((int)gridDim.x)
#define bx ((int)blockIdx.x)
#define NGW (G * NWAVES)
#define PHASE_VARS const int tid = opaque_tid(), lane = tid & 63, wave = __builtin_amdgcn_readfirstlane(tid >> 6), gw = bx * NWAVES + wave; (void)lane; (void)gw
    LAS unsigned char* ldsl = (LAS unsigned char*)lds;
    { volatile LAS unsigned* misc = (volatile LAS unsigned*)(ldsl + LDS_MISC); if (threadIdx.x < 64) misc[threadIdx.x] = 0u; __syncthreads(); }
    (void)xcd_barrier_post((unsigned*)(kargs()->ws + WS_CTL) + CW_BAR, (volatile LAS unsigned*)(ldsl + LDS_MISC) + 8);
#define GRID_BAR() do { XcdBarrier xb_; xb_.bar = (unsigned*)(kargs()->ws + WS_CTL) + CW_BAR; xb_.x = xb_xcc_id(); xb_.st = (volatile LAS unsigned*)(ldsl + LDS_MISC) + 8; xcd_barrier(xb_); } while (0)
#ifndef EPI_ALIGN_PD1
#define EPI_ALIGN_PD1 true
#endif
#ifndef EPI_ALIGN_PA2
#define EPI_ALIGN_PA2 true
#endif
#ifndef REPEAT_PH
#define REPEAT_PH 0
#endif
#ifndef PH_MASK
#define PH_MASK 0xFFFF
#endif
#ifndef MIX_MASK
#define MIX_MASK 7
#endif
#define IN(k) true
#define EN(b) ((PH_MASK >> (b)) & 1)
#define SEAM(k) do { if (IN(k) && IN((k) + 1)) { if ((k) == 0) grid.sync(); else GRID_BAR(); } } while (0)
#define WSP(type, off) ((type*)(ws + (off)))

    if (EN(0) && IN(0)) { PHASE_VARS;
        convert_weights(0, lds, gw, NGW, wave, lane);
        KArgs kp = kargs(); unsigned char* ws = kp->ws; const int* positions = kp->positions; const float* x = kp->x; const float* g = kp->norm_pre;
        f32x2* ROPE = WSP(f32x2, WS_ROPE); bf16_t* HB = WSP(bf16_t, WS_HB);
        for (int i = bx * NTHREADS + tid; i < T * 16; i += G * NTHREADS) {
            const int t = i >> 4, j = i & 15; const float inv = exp2f(-(float)j * (13.287712379549449f / 16.0f));
            const float ang = (float)positions[t] * inv; const float k = rintf(ang * 0.15915494309189535f);
            float r = fmaf(-k, 6.2831854820251465f, ang); r = fmaf(-k, -1.7484555314695172e-7f, r);
            ROPE[i] = (f32x2){__cosf(r), __sinf(r)};
        }
        for (int m = gw; m < T; m += NGW) hb_row(x + (size_t)m * DM, g, HB + (size_t)m * DM, lane);
    }
    SEAM(0);
#ifdef EXTRA_SYNCS
    for (int i = 0; i < EXTRA_SYNCS; ++i) GRID_BAR();
#endif

    for (int l = 0; l < DEPTH; ++l) {
        const int P0 = 1 + l * PH_PER_LAYER;
        for (int rp = 0; rp < ((REPEAT_PH == 1) ? 2 : 1); ++rp) { if (rp) GRID_BAR();
        if (EN(1) && IN(P0 + 0)) {
            unsigned char* ws = kargs()->ws;
            pg8::PlainOrder S{(const char*)WSP(bf16_t, WS_HB), (const char*)WSP(bf16_t, WS_WIN), 1024, 1024, T / 256, NA / 256, G, bx, 0};
            EpiStore E{WSP(bf16_t, WS_PA), NA, ldsl};
#ifdef STAGGER_US
            if (bx >= 128) { const unsigned long long t0_ = __builtin_amdgcn_s_memrealtime(); while (__builtin_amdgcn_s_memrealtime() - t0_ < (unsigned long long)(STAGGER_US * 100)) __builtin_amdgcn_s_sleep(8); }
#endif
            pg8::gemm_phase<EpiStore, pg8::PlainOrder, true>(ldsl, pg8::Gemm{1024, 1024, 1024}, S, E);
#ifdef PROBE_PA1NULL
#endif
        }
        }
        SEAM(P0 + 0);
        if (EN(2) && IN(P0 + 1)) { PHASE_VARS;
            if (bx >= RWKV_BLOCKS) {
                unsigned char* ws = kargs()->ws; const int c2 = bx - RWKV_BLOCKS;
                { const bf16_t* PA = WSP(bf16_t, WS_PA); const f32x2* ROPE = WSP(f32x2, WS_ROPE); float* RSTDQ = WSP(float, WS_RSTD); float* RSTDKV = RSTDQ + T; bf16_t* Kb = WSP(bf16_t, WS_K);
                  for (int m = c2 * NWAVES + wave; m < T; m += 4 * SUB_BLOCKS * NWAVES) mla_prep_rows4(PA, ROPE, RSTDQ, RSTDKV, Kb, m, SUB_BLOCKS * NWAVES, lane); }
                sub_barrier((unsigned*)(ws + WS_CTL) + 64 * 40, (unsigned)SUB_BLOCKS * (unsigned)(2 * l + 1));
                { pg8::PlainOrder S{(const char*)(WSP(bf16_t, WS_PA) + CQ), (const char*)WSP(bf16_t, WS_WUQ), NA, 256, T / 256, 3, SUB_BLOCKS, c2, 0};
                  EpiQ E{WSP(bf16_t, WS_Q), WSP(float, WS_RSTD), ldsl};
                  pg8::gemm_phase<EpiQ, pg8::PlainOrder, true>(ldsl, pg8::Gemm{NA, 256, 256}, S, E); }
                { pg8::PlainOrder S{(const char*)(WSP(bf16_t, WS_PA) + CKV), (const char*)WSP(bf16_t, WS_WUKV), NA, 256, T / 256, 4, SUB_BLOCKS, c2, 0};
                  EpiKV E{WSP(bf16_t, WS_K), WSP(bf16_t, WS_V), WSP(float, WS_RSTD) + T, ldsl};
                  pg8::gemm_phase<EpiKV, pg8::PlainOrder, true>(ldsl, pg8::Gemm{NA, 256, 256}, S, E); }
                sub_barrier((unsigned*)(kargs()->ws + WS_CTL) + 64 * 40, (unsigned)SUB_BLOCKS * (unsigned)(2 * l + 2));
            } else {
#ifdef RWKV_TWICE
#pragma unroll 1
                for (int rep_ = 0; rep_ < RWKV_TWICE; ++rep_) { rwkv::rwkv_unit(l, bx >> 3, bx & 7, ldsl); __syncthreads(); }
#else
                rwkv::rwkv_unit(l, bx >> 3, bx & 7, ldsl);
#endif
                if (threadIdx.x == 0) { unsigned* cnt = (unsigned*)(kargs()->ws + WS_CTL) + 64 * 40; unsigned sp = 0;
                    while (__hip_atomic_load(cnt, __ATOMIC_RELAXED, __HIP_MEMORY_SCOPE_AGENT) < (unsigned)SUB_BLOCKS * (unsigned)(2 * l + 2) && ++sp < (1u << 24)) __builtin_amdgcn_s_sleep(2);
                    __builtin_amdgcn_fence(__ATOMIC_ACQUIRE, "agent"); asm volatile("s_waitcnt vmcnt(0)" ::: "memory"); }
                __syncthreads();
            }
        }
        if (EN(4) && IN(P0 + 3)) { PHASE_VARS;
            volatile LAS unsigned* qw = (volatile LAS unsigned*)(ldsl + LDS_MISC);
            for (;;) {
                __syncthreads();
                if (tid == 0) { unsigned* CTL = (unsigned*)(kargs()->ws + WS_CTL); qw[0] = atomicAdd(CTL + 64 * (1 + l), 1u); }
                __syncthreads();
                const int it = __builtin_amdgcn_readfirstlane((int)qw[0]);
                if (it >= N_MIX_ITEMS) break;
                if (it < 32) gla::gla_unit(l, it >> 2, it & 3, ldsl, (unsigned*)(kargs()->ws + WS_CTL) + 64 * (24 + l));
                else { const int a = it - 32; att::attn_unit((a & 63) >> 3, a & 7, (SEQ / 512 - 1) - (a >> 6), ldsl, (unsigned*)(kargs()->ws + WS_CTL) + 64 * (16 + l)); }
            }
            { unsigned* ctl = (unsigned*)(kargs()->ws + WS_CTL);
              __syncthreads();
              if (tid == 0) { const unsigned tk = __hip_atomic_fetch_add(ctl + 64 * (20 + l), 1u, __ATOMIC_RELAXED, __HIP_MEMORY_SCOPE_AGENT); qw[0] = tk;
                  if (tk < (unsigned)MG_BLOCKS) { unsigned sp = 0; while (__hip_atomic_load(ctl + 64 * (16 + l), __ATOMIC_RELAXED, __HIP_MEMORY_SCOPE_AGENT) < (unsigned)N_ATT_UNITS && ++sp < (1u << 22)) __builtin_amdgcn_s_sleep(8); }
                  __builtin_amdgcn_fence(__ATOMIC_ACQUIRE, "agent"); asm volatile("s_waitcnt vmcnt(0)" ::: "memory"); }
              __syncthreads();
              const int tk = __builtin_amdgcn_readfirstlane((int)qw[0]);
              if (tk < MG_BLOCKS) {
                  unsigned char* ws = kargs()->ws;
                  pg8::PlainOrder S{(const char*)WSP(bf16_t, WS_HB), (const char*)(WSP(bf16_t, WS_WIN) + (size_t)(NA + 1536) * 1024), 1024, 1024, T / 256, 12, MG_BLOCKS, tk, 0};
                  EpiGateMG8 E{WSP(unsigned char, WS_SMG8), ldsl};
                  pg8::gemm_phase<EpiGateMG8, pg8::PlainOrder, true>(ldsl, pg8::Gemm{1024, 1024, 1024}, S, E);
                  __syncthreads();
                  if (tid == 0) { unsigned sp = 0; while (__hip_atomic_load(ctl + 64 * (24 + l), __ATOMIC_RELAXED, __HIP_MEMORY_SCOPE_AGENT) < 32u && ++sp < (1u << 22)) __builtin_amdgcn_s_sleep(8);
                      __builtin_amdgcn_fence(__ATOMIC_ACQUIRE, "agent"); asm volatile("s_waitcnt vmcnt(0)" ::: "memory"); }
                  __syncthreads();
                  pg8::PlainOrder S2{(const char*)WSP(bf16_t, WS_HB), (const char*)(WSP(bf16_t, WS_WIN) + (size_t)NA * 1024), 1024, 1024, T / 256, 4, MG_BLOCKS, tk, 2};
                  EpiGateBG E2{WSP(bf16_t, WS_YS), 0, 2, ldsl};
                  pg8::gemm_phase<EpiGateBG, pg8::PlainOrder, true>(ldsl, pg8::Gemm{1024, 1024, 1024}, S2, E2);
              } }
        }
        SEAM(P0 + 3);
        if (EN(5) && IN(P0 + 4)) {
            unsigned char* ws = kargs()->ws;
            pg8::PlainOrder S{(const char*)WSP(bf16_t, WS_HB), (const char*)(WSP(bf16_t, WS_WIN) + (size_t)(NA + 512) * 1024), 1024, 1024, T / 256, 2, G, bx, 0};
            EpiGateBG E{WSP(bf16_t, WS_YS), 2, 0, ldsl};
            pg8::gemm_phase<EpiGateBG, pg8::PlainOrder, true>(ldsl, pg8::Gemm{1024, 1024, 1024}, S, E);
        }
        SEAM(P0 + 4);
        for (int rp = 0; rp < ((REPEAT_PH == 6 && l == 0) ? 2 : 1); ++rp) { if (rp) GRID_BAR();
        if (EN(6) && IN(P0 + 5)) {
            unsigned char* ws = kargs()->ws;
            pg8::GroupOrder3 S{(const char*)WSP(bf16_t, WS_YS), (const char*)WSP(bf16_t, WS_WBO), 512, 512, T / 256, 4, G, bx, (size_t)T * 512 * 2, (size_t)1024 * 512 * 2};
            EpiMerge E{WSP(bf16_t, WS_MG), WSP(unsigned char, WS_SMG8), ldsl};
            pg8::gemm_phase<EpiMerge, pg8::GroupOrder3, EPI_ALIGN_PD1>(ldsl, pg8::Gemm{512, 512, 512}, S, E);
        }
        }
        SEAM(P0 + 5);
        for (int rp = 0; rp < ((REPEAT_PH == 7 && l == 0) ? 2 : 1); ++rp) { if (rp) GRID_BAR();
        if (EN(7) && IN(P0 + 6)) {
            unsigned char* ws = kargs()->ws;
            pg8::PlainOrder S{(const char*)WSP(bf16_t, WS_MG), (const char*)WSP(bf16_t, WS_WOUT), 1024, 1024, T / 256, 4, G, bx, 0};
            EpiStore E{WSP(bf16_t, WS_OF), 1024, ldsl};
            pg8::gemm_phase<EpiStore, pg8::PlainOrder, true>(ldsl, pg8::Gemm{1024, 1024, 1024}, S, E);
        }
        }
        SEAM(P0 + 6);
        if (EN(8) && IN(P0 + 7)) { PHASE_VARS;
            const bool more = (l + 1 < DEPTH);
            if (more) convert_weights(l + 1, lds, gw, NGW, wave, lane);
            KArgs kp = kargs(); unsigned char* ws = kp->ws; float* out = kp->out; const float* xold = (l == 0) ? kp->x : out; const float* gpost = kp->norm_post + l * DM; const float* gnext = more ? kp->norm_pre + (l + 1) * DM : nullptr;
            const bf16_t* OF = WSP(bf16_t, WS_OF); bf16_t* HB = WSP(bf16_t, WS_HB);
            for (int m = gw; m < T; m += NGW)
                final_row(OF + (size_t)m * DM, xold + (size_t)m * DM, gpost, out + (size_t)m * DM, gnext, HB + (size_t)m * DM, lane);
        }
        if (l + 1 < DEPTH) SEAM(P0 + 7);
    }
#undef IN
#undef EN
#undef SEAM
#undef WSP
#undef PHASE_VARS
#undef G
#undef bx
#undef NGW
}

extern "C" void kernel_launch(void* const* d_in, const int* in_sizes, int n_in, void* d_out, int out_size, void* d_ws, size_t ws_size, hipStream_t stream) {
    static int grid = 0;
    if (grid == 0) {
        if (n_in != 24 || in_sizes[0] != T * DM || out_size != T * DM || ws_size < WS_END) {
            fprintf(stderr, "kernel_launch: unexpected shapes (n_in %d, in0 %d, out %d, ws %zu; need ws >= %zu); nothing launched\n", n_in, n_in > 0 ? in_sizes[0] : -1, out_size, ws_size, (size_t)WS_END);
            grid = -1; return; }
        int dev = 0, cus = 0, per_cu = 0;
        (void)hipGetDevice(&dev); (void)hipDeviceGetAttribute(&cus, hipDeviceAttributeMultiprocessorCount, dev);
        if (hipFuncSetAttribute((const void*)hybrid_fwd, hipFuncAttributeMaxDynamicSharedMemorySize, LDS_BYTES) != hipSuccess) { fprintf(stderr, "kernel_launch: hipFuncSetAttribute failed\n"); grid = -1; return; }
        if (hipOccupancyMaxActiveBlocksPerMultiprocessor(&per_cu, (const void*)hybrid_fwd, NTHREADS, LDS_BYTES) != hipSuccess || per_cu < 1) {
            fprintf(stderr, "kernel_launch: occupancy query reports %d blocks per CU\n", per_cu); per_cu = 1; }
        (void)hipGetLastError();
        grid = cus * (per_cu < 1 ? 1 : 1);
        fprintf(stderr, "kernel_launch: grid %d (cus %d, occupancy %d), ws %zu\n", grid, cus, per_cu, ws_size);
    }
    if (grid < 0) return;
    (void)hipMemsetAsync((char*)d_ws + WS_CTL, 0, 65536, stream);
    Params p{};
    p.x = (const float*)d_in[0]; p.positions = (const int*)d_in[1]; p.norm_pre = (const float*)d_in[2]; p.w_in = (const float*)d_in[3]; p.mla_q_norm = (const float*)d_in[4]; p.mla_kv_norm = (const float*)d_in[5];
    p.mla_w_uq = (const float*)d_in[6]; p.mla_w_ukv = (const float*)d_in[7]; p.rwkv_mu = (const float*)d_in[8]; p.rwkv_w0 = (const float*)d_in[9]; p.rwkv_w_up = (const float*)d_in[10]; p.rwkv_a0 = (const float*)d_in[11];
    p.rwkv_a_up = (const float*)d_in[12]; p.rwkv_k_k = (const float*)d_in[13]; p.rwkv_k_a = (const float*)d_in[14]; p.rwkv_r_k = (const float*)d_in[15]; p.rwkv_ln_w = (const float*)d_in[16]; p.rwkv_ln_b = (const float*)d_in[17];
    p.gla_a_up = (const float*)d_in[18]; p.gla_a_b = (const float*)d_in[19]; p.gla_norm = (const float*)d_in[20]; p.w_branch_out = (const float*)d_in[21]; p.w_out = (const float*)d_in[22]; p.norm_post = (const float*)d_in[23];
    p.out = (float*)d_out; p.ws = (unsigned char*)d_ws;
#if MK_MULTI_LAUNCH
    for (int ph = 0; ph < N_PHASES; ++ph) { p.ph_lo = ph; p.ph_hi = ph + 1; void* args[] = {&p};
        hipError_t e = hipLaunchCooperativeKernel((const void*)hybrid_fwd, dim3(grid), dim3(NTHREADS), args, LDS_BYTES, stream);
        if (e != hipSuccess) { fprintf(stderr, "kernel_launch: launch of phase %d failed: %s\n", ph, hipGetErrorString(e)); break; } }
#else
    p.ph_lo = 0; p.ph_hi = N_PHASES; void* args[] = {&p};
    hipError_t e = hipLaunchCooperativeKernel((const void*)hybrid_fwd, dim3(grid), dim3(NTHREADS), args, LDS_BYTES, stream);
    if (e != hipSuccess) fprintf(stderr, "kernel_launch: cooperative launch failed: %s (grid %d)\n", hipGetErrorString(e), grid);
#endif
}
```

```cpp
#include <hip/hip_runtime.h>
#include <hip/hip_cooperative_groups.h>
#include <cstdio>
#include <cstdint>
#include <cmath>
namespace cg = cooperative_groups;
#define U_P2 1
#define U_P5 1
#define U_P7 1
#define V_A 1
#define V_B 1
#define V_V 1
namespace pg8 {
#define PG8_LAS __attribute__((address_space(3)))
typedef unsigned short bf16_t;
typedef short bf16x8 __attribute__((ext_vector_type(8)));
typedef float f32x4 __attribute__((ext_vector_type(4)));
typedef unsigned u32x4 __attribute__((ext_vector_type(4)));
typedef unsigned u32x2 __attribute__((ext_vector_type(2)));
constexpr int BM = 256, BK = 64, HALF = 128, HTB = HALF * BK * 2  , STAGE_BYTES = 8 * HTB, NXCD = 8, WGM = 8;

__host__ __device__ __forceinline__ int lds_byte(int r, int c) { const int st = (r >> 4) * 2 + (c >> 5), rr = r & 15, cc = c & 31, ob = rr * 64 + cc * 2; return st * 1024 + (ob ^ (((ob >> 9) & 1) << 5)); }
__host__ __device__ __forceinline__ void stage_rc(int b, int& R, int& C) { const int st = b / 1024, sb = b % 1024, swz = sb ^ (((sb >> 9) & 1) << 5); R = (st >> 1) * 16 + swz / 64; C = (st & 1) * 32 + (swz % 64) / 2; }
__host__ __device__ __forceinline__ int perm32(int rho) { const int n = rho >> 4, i = rho & 15; return 8 * (i >> 2) + 4 * n + (i & 3); }

struct Unit { int pm, pn, aux; const char* A; const char* B; };
struct Gemm { int lda, ldb, K; };

__device__ __forceinline__ void tile_of(int L, int nM, int nN, int& pm, int& pn) {
    const int nwg = nM * nN; int wgid = L;
    { const int q = nwg / NXCD, r = nwg % NXCD, xcd = wgid % NXCD, off = wgid / NXCD; wgid = (xcd < r ? xcd * (q + 1) : r * (q + 1) + (xcd - r) * q) + off; }
    const int nig = WGM * nN, gid = wgid / nig, fm = gid * WGM, gsz = (nM - fm) < WGM ? (nM - fm) : WGM;
    pm = fm + ((wgid % nig) % gsz); pn = (wgid % nig) / gsz;
}
struct PlainOrder {
    const char* A; const char* Bt; int lda, ldb, nM, nN, G, c, bskip;
    int base = 0, cnt = -1;
    __device__ __forceinline__ bool next(int i, Unit& u) const {
        const long Lr = (long)i * G + c; if (Lr >= (long)(cnt >= 0 ? cnt : nM * nN)) return false;
        const long L = Lr + base;
        tile_of((int)L, nM, nN, u.pm, u.pn); u.aux = 0;
        u.A = A + (size_t)u.pm * BM * lda * 2; u.B = Bt + (size_t)(u.pn + ((u.pn >= 2) ? bskip : 0)) * BM * ldb * 2; return true;
    }
};
struct GroupOrder3 {
    const char* A; const char* Bt; int lda, ldb, nM, nN, G, c; size_t a_gstride, b_gstride;
    __device__ __forceinline__ bool next(int i, Unit& u) const {
        const int n = i % 3; const long L = (long)(i / 3) * G + c; if (L >= (long)nM * nN) return false;
        tile_of((int)L, nM, nN, u.pm, u.pn); u.aux = n;
        u.A = A + n * a_gstride + (size_t)u.pm * BM * lda * 2; u.B = Bt + n * b_gstride + (size_t)u.pn * BM * ldb * 2; return true;
    }
};

template <class Epi, class Sched, bool ALIGN_EPI>
__device__ __forceinline__ void gemm_phase(PG8_LAS unsigned char* lds, const Gemm g, const Sched& S, const Epi& E) {
    int tid_ = threadIdx.x; asm volatile("" : "+v"(tid_));
    const int tid = tid_, wid = __builtin_amdgcn_readfirstlane(tid >> 6), lane = tid & 63, wr = wid >> 2, wc = wid & 3, fr = lane & 15, fq = lane >> 4;
    const int K = g.K, nt = K / BK;
    unsigned voffA[2], voffB[2];
#pragma unroll
    for (int i = 0; i < 2; ++i) { int R, C; stage_rc(tid * 16 + i * 8192, R, C); const int Rb = (int)Epi::PERM == 2 ? (64 * (R >> 5) + perm32(R & 31)) : (int)Epi::PERM == 1 ? ((R & ~31) + perm32(R & 31)) : R;
        voffA[i] = (unsigned)(R * g.lda + C) * 2u; voffB[i] = (unsigned)(Rb * g.ldb + C) * 2u; }
    const size_t kstep = (size_t)(BK * 2);
    const size_t hstepA = (size_t)HALF * g.lda * 2, hstepB = (size_t)((int)Epi::PERM == 2 ? 32 : HALF) * g.ldb * 2;
    const unsigned ldsw = (unsigned)wid * 1024u;
    const int aoff = lds_byte(wr * 64 + fr, fq * 8), boff = lds_byte(wc * 32 + fr, fq * 8);
#define PG8_SA(b, h) (((b) * 2 + (h)) * HTB)
#define PG8_SB(b, h) ((4 + (b) * 2 + (h)) * HTB)
#define PG8_STAGE(bufoff, gbase, voff) do { _Pragma("unroll") for (int _i = 0; _i < 2; ++_i) \
        __builtin_amdgcn_global_load_lds((const unsigned*)((const char*)(gbase) + (voff)[_i]), (PG8_LAS unsigned*)(lds + (bufoff) + ldsw + _i * 8192), 16, 0, 0); } while (0)
#define PG8_LDA(dst, b, h) do { _Pragma("unroll") for (int m = 0; m < 4; ++m) _Pragma("unroll") for (int k = 0; k < 2; ++k) dst[m][k] = *(const PG8_LAS bf16x8*)(lds + PG8_SA(b, h) + aoff + m * 2048 + k * 1024); } while (0)
#define PG8_LDB(dst, b, h) do { _Pragma("unroll") for (int n = 0; n < 2; ++n) _Pragma("unroll") for (int k = 0; k < 2; ++k) dst[n][k] = *(const PG8_LAS bf16x8*)(lds + PG8_SB(b, h) + boff + n * 2048 + k * 1024); } while (0)
#define PG8_MMA(ai, bj, At, Bt) do { __builtin_amdgcn_s_setprio(1); _Pragma("unroll") for (int m = 0; m < 4; ++m) _Pragma("unroll") for (int n = 0; n < 2; ++n) _Pragma("unroll") for (int k = 0; k < 2; ++k) \
        acc[ai][bj][m][n] = __builtin_amdgcn_mfma_f32_16x16x32_bf16(Bt[n][k], At[m][k], acc[ai][bj][m][n], 0, 0, 0); __builtin_amdgcn_s_setprio(0); } while (0)
#define PG8_WAIT_V(n) asm volatile("s_waitcnt vmcnt(" #n ")" ::: "memory")
#define PG8_WAIT_L(n) asm volatile("s_waitcnt lgkmcnt(" #n ")" ::: "memory")
#define PG8_BAR __builtin_amdgcn_s_barrier()
#define PG8_SCHED __builtin_amdgcn_sched_barrier(0)
    Unit cur, nxt; int ui = 0;
    if (!S.next(0, cur)) return;
    f32x4 acc[2][2][4][2];
#pragma unroll
    for (int a = 0; a < 2; ++a)
#pragma unroll
        for (int b = 0; b < 2; ++b)
#pragma unroll
            for (int m = 0; m < 4; ++m)
#pragma unroll
                for (int n = 0; n < 2; ++n) acc[a][b][m][n] = (f32x4){0.f, 0.f, 0.f, 0.f};
    bf16x8 At[4][2], B0[2][2], B1[2][2];
    const char* cA = cur.A; const char* cB = cur.B;
    PG8_STAGE(PG8_SB(0, 0), cB, voffB); PG8_STAGE(PG8_SB(0, 1), cB + hstepB, voffB); PG8_STAGE(PG8_SA(0, 0), cA, voffA); PG8_STAGE(PG8_SA(0, 1), cA + hstepA, voffA);
    if (wr == 1) PG8_BAR;
    PG8_WAIT_V(2); PG8_BAR;
    PG8_STAGE(PG8_SB(1, 0), cB + kstep, voffB); PG8_STAGE(PG8_SA(1, 0), cA + kstep, voffA); PG8_STAGE(PG8_SB(1, 1), cB + hstepB + kstep, voffB);
    PG8_WAIT_V(6); PG8_BAR;
    for (;;) {
        const bool has_next = S.next(ui + 1, nxt);
        const char* nA = has_next ? nxt.A : cA; const char* nB = has_next ? nxt.B : cB;
#pragma unroll 1
        for (int t = 0; t < nt; t += 2) {
            const bool last = (t == nt - 2);
            const char* a1 = cA + (size_t)(t + 1) * kstep;
            const char* a2 = last ? nA : cA + (size_t)(t + 2) * kstep; const char* b2 = last ? nB : cB + (size_t)(t + 2) * kstep;
            const char* a3 = a2 + kstep; const char* b3 = b2 + kstep;
            PG8_LDB(B0, 0, 0); PG8_LDB(B1, 0, 1); PG8_SCHED; PG8_LDA(At, 0, 0); PG8_STAGE(PG8_SA(1, 1), a1 + hstepA, voffA);
            PG8_WAIT_V(8); PG8_WAIT_L(0); PG8_BAR; PG8_MMA(0, 0, At, B0); PG8_MMA(0, 1, At, B1); PG8_BAR; PG8_SCHED;
            PG8_LDA(At, 0, 1); PG8_STAGE(PG8_SB(0, 0), b2, voffB); PG8_STAGE(PG8_SB(0, 1), b2 + hstepB, voffB); PG8_STAGE(PG8_SA(0, 0), a2, voffA);
            PG8_WAIT_V(8); PG8_WAIT_L(0); PG8_BAR; PG8_MMA(1, 0, At, B0); PG8_MMA(1, 1, At, B1); PG8_BAR; PG8_SCHED;
            PG8_LDB(B0, 1, 0); PG8_LDB(B1, 1, 1); PG8_SCHED; PG8_LDA(At, 1, 0); PG8_STAGE(PG8_SA(0, 1), a2 + hstepA, voffA);
            PG8_WAIT_V(8); PG8_WAIT_L(0); PG8_BAR; PG8_MMA(0, 0, At, B0); PG8_MMA(0, 1, At, B1); PG8_BAR; PG8_SCHED;
            PG8_LDA(At, 1, 1); PG8_STAGE(PG8_SB(1, 0), b3, voffB); PG8_STAGE(PG8_SB(1, 1), b3 + hstepB, voffB); PG8_STAGE(PG8_SA(1, 0), a3, voffA);
            PG8_WAIT_V(8); PG8_WAIT_L(0); PG8_BAR; PG8_MMA(1, 0, At, B0); PG8_MMA(1, 1, At, B1); PG8_BAR; PG8_SCHED;
        }
        if constexpr (ALIGN_EPI) { if (wr == 0) PG8_BAR; }
        E(acc, cur, wr, wc, fr, fq);
        if (!has_next) break;
#pragma unroll
        for (int a = 0; a < 2; ++a)
#pragma unroll
            for (int b = 0; b < 2; ++b)
#pragma unroll
                for (int m = 0; m < 4; ++m)
#pragma unroll
                    for (int n = 0; n < 2; ++n) acc[a][b][m][n] = (f32x4){0.f, 0.f, 0.f, 0.f};
        cur = nxt; cA = nA; cB = nB; ++ui;
        if constexpr (ALIGN_EPI) { if (wr == 1) PG8_BAR; }
    }
    PG8_WAIT_V(0);
    if constexpr (!ALIGN_EPI) { if (wr == 0) PG8_BAR; }
    PG8_BAR;
#undef PG8_SA
#undef PG8_SB
#undef PG8_STAGE
#undef PG8_LDA
#undef PG8_LDB
#undef PG8_MMA
#undef PG8_WAIT_V
#undef PG8_WAIT_L
#undef PG8_BAR
#undef PG8_SCHED
}
}
#define LAS __attribute__((address_space(3)))
typedef unsigned short bf16_t;
typedef short bf16x8 __attribute__((ext_vector_type(8)));
typedef short s16x4 __attribute__((ext_vector_type(4)));
typedef float f32x4 __attribute__((ext_vector_type(4)));
typedef float f32x2 __attribute__((ext_vector_type(2)));
typedef float f32x16 __attribute__((ext_vector_type(16)));
typedef unsigned u32x4 __attribute__((ext_vector_type(4)));
typedef unsigned u32x2 __attribute__((ext_vector_type(2)));
typedef __bf16 bf16x2_t __attribute__((ext_vector_type(2)));

constexpr int BATCH = 8, SEQ = 4096, DM = 1024, T = BATCH * SEQ, DEPTH = 2;
constexpr int N_IN = 7728, NA = 3328, NG = 4608, NALL = NA + NG;
constexpr int CQ = 0, CKV = 256, KROPE = 384, GLAT = 416, RW_R = 512, RW_K = 1024, RW_V = 1536, RW_LW = 2048, RW_LA = 2112, GQ = 2304, GK = 2560, GV = 2816;
constexpr int KP = 544;
constexpr float NORM_EPS = 1e-6f, RWKV_GN_EPS = 64e-5f;
constexpr float QSCALE = 0.10206207261596577f * 1.4426950408889634f;

constexpr size_t MiB = 1u << 20;
constexpr size_t WS_CTL = 0;
constexpr size_t WS_ROPE = 1 * MiB;
constexpr size_t WS_RSTD = 5 * MiB;
constexpr size_t WS_WIN = 6 * MiB;
constexpr size_t WS_WBO = WS_WIN + (size_t)NALL * 1024 * 2;
constexpr size_t WS_WOUT = WS_WBO + 3 * MiB;
constexpr size_t WS_WUQ = WS_WOUT + 2 * MiB;
constexpr size_t WS_WUKV = WS_WUQ + 768 * 256 * 2;
constexpr size_t WS_HB = 28 * MiB;
constexpr size_t WS_PA = 92 * MiB;
constexpr size_t WS_Q = 300 * MiB;
constexpr size_t WS_K = 348 * MiB;
constexpr size_t WS_V = 382 * MiB;
constexpr size_t WS_YS = 414 * MiB;
constexpr size_t WS_SMG8 = WS_Q;
constexpr size_t WS_MG = WS_PA, WS_OF = WS_PA + 64 * MiB;
constexpr size_t WS_END = 510 * MiB;
static_assert(WS_WUKV + 1024 * 256 * 2 <= WS_HB, "weights fit");

__device__ __forceinline__ unsigned pk2(float lo, float hi) { f32x2 v = {lo, hi}; bf16x2_t b = __builtin_convertvector(v, bf16x2_t); return __builtin_bit_cast(unsigned, b); }
__device__ __forceinline__ float bflo(unsigned w) { return __uint_as_float(w << 16); }
__device__ __forceinline__ float bfhi(unsigned w) { return __uint_as_float(w & 0xffff0000u); }
__device__ __forceinline__ float bf2f(bf16_t b) { return __uint_as_float((unsigned)b << 16); }
__device__ __forceinline__ bf16_t f2bf(float f) { return (bf16_t)(pk2(f, 0.f) & 0xffffu); }
__device__ __forceinline__ float wave_sum(float v) {
#pragma unroll
    for (int o = 1; o < 64; o <<= 1) v += __shfl_xor(v, o);
    return v;
}
__device__ __forceinline__ float fast_exp(float x) { return __builtin_amdgcn_exp2f(x * 1.4426950408889634f); }
__device__ __forceinline__ float fast_sigmoid(float x) { return __builtin_amdgcn_rcpf(1.0f + fast_exp(-x)); }
template <int CTRL> __device__ __forceinline__ float dpp_f(float x) { return __int_as_float(__builtin_amdgcn_update_dpp(0, __float_as_int(x), CTRL, 0xf, 0xf, false)); }
__device__ __forceinline__ float sum8(float x) { x += dpp_f<0xB1>(x); x += dpp_f<0x4E>(x); x += dpp_f<0x141>(x); return x; }
__device__ __forceinline__ float sum16(float x) { x += dpp_f<0xB1>(x); x += dpp_f<0x4E>(x); x += dpp_f<0x141>(x); x += dpp_f<0x140>(x); return x; }

struct Params {
    const float* x; const int* positions; const float* norm_pre; const float* w_in; const float* mla_q_norm; const float* mla_kv_norm; const float* mla_w_uq; const float* mla_w_ukv;
    const float* rwkv_mu; const float* rwkv_w0; const float* rwkv_w_up; const float* rwkv_a0; const float* rwkv_a_up; const float* rwkv_k_k; const float* rwkv_k_a; const float* rwkv_r_k;
    const float* rwkv_ln_w; const float* rwkv_ln_b; const float* gla_a_up; const float* gla_a_b; const float* gla_norm; const float* w_branch_out; const float* w_out; const float* norm_post;
    float* out; unsigned char* ws; int ph_lo, ph_hi;
};

typedef const __attribute__((address_space(4))) Params* KArgs;
__device__ __forceinline__ KArgs kargs() { KArgs kp = (KArgs)__builtin_amdgcn_kernarg_segment_ptr(); asm volatile("" : "+s"(kp)); return kp; }

__device__ __forceinline__ Params load_params() { Params p{}; KArgs kp = kargs(); p.x = kp->x; p.positions = kp->positions; p.norm_pre = kp->norm_pre; p.w_in = kp->w_in; p.mla_q_norm = kp->mla_q_norm; p.mla_kv_norm = kp->mla_kv_norm; p.mla_w_uq = kp->mla_w_uq; p.mla_w_ukv = kp->mla_w_ukv; p.rwkv_mu = kp->rwkv_mu; p.rwkv_w0 = kp->rwkv_w0; p.rwkv_w_up = kp->rwkv_w_up; p.rwkv_a0 = kp->rwkv_a0; p.rwkv_a_up = kp->rwkv_a_up; p.rwkv_k_k = kp->rwkv_k_k; p.rwkv_k_a = kp->rwkv_k_a; p.rwkv_r_k = kp->rwkv_r_k; p.rwkv_ln_w = kp->rwkv_ln_w; p.rwkv_ln_b = kp->rwkv_ln_b; p.gla_a_up = kp->gla_a_up; p.gla_a_b = kp->gla_a_b; p.gla_norm = kp->gla_norm; p.w_branch_out = kp->w_branch_out; p.w_out = kp->w_out; p.norm_post = kp->norm_post; p.out = kp->out; p.ws = kp->ws; p.ph_lo = kp->ph_lo; p.ph_hi = kp->ph_hi; return p; }
__device__ __forceinline__ int opaque_tid() { int t = threadIdx.x; asm volatile("" : "+v"(t)); return t; }

using pg8::Unit;
constexpr int EPI_SCR = 131072, EPI_SCR_WAVE = 2304, EPI_PITCH = 144;
struct EpiGeo { LAS unsigned char* wp; const LAS unsigned char* rp; int r8, p8; };
__device__ __forceinline__ EpiGeo epi_geo(LAS unsigned char* lds, int wr, int wc, int fr, int fq) {
    LAS unsigned char* scr = lds + EPI_SCR + (wr * 4 + wc) * EPI_SCR_WAVE; const int lane = fq * 16 + fr;
    return EpiGeo{scr + fr * EPI_PITCH + fq * 16, scr + (lane >> 3) * EPI_PITCH + (lane & 7) * 16, lane >> 3, lane & 7};
}
__device__ __forceinline__ void epi_xpose(const EpiGeo& g, const u32x4 w0, const u32x4 w1, u32x4& r0, u32x4& r1) {
    *(LAS u32x4*)g.wp = w0; *(LAS u32x4*)(g.wp + 64) = w1;
    asm volatile("" ::: "memory");
    r0 = *(const LAS u32x4*)g.rp; r1 = *(const LAS u32x4*)(g.rp + 8 * EPI_PITCH);
    asm volatile("" ::: "memory");
}
__device__ __forceinline__ u32x4 pack8(const f32x4 v0, const f32x4 v1) { u32x4 w; w.x = pk2(v0[0], v0[1]); w.y = pk2(v0[2], v0[3]); w.z = pk2(v1[0], v1[1]); w.w = pk2(v1[2], v1[3]); return w; }
struct EpiStore {
    static constexpr int PERM = 2; bf16_t* O; int ldc; LAS unsigned char* lds; int skip;
    __device__ __forceinline__ void operator()(const f32x4 (&acc)[2][2][4][2], const Unit& u, int wr, int wc, int fr, int fq) const {
        const EpiGeo G = epi_geo(lds, wr, wc, fr, fq);
        bf16_t* gp = O + (size_t)(u.pm * 256 + wr * 64 + G.r8) * ldc + (u.pn + ((u.pn >= 2) ? skip : 0)) * 256 + wc * 64 + G.p8 * 8;
#pragma unroll
        for (int ai = 0; ai < 2; ++ai)
#pragma unroll
            for (int m = 0; m < 4; ++m) { u32x4 r0, r1; epi_xpose(G, pack8(acc[ai][0][m][0], acc[ai][0][m][1]), pack8(acc[ai][1][m][0], acc[ai][1][m][1]), r0, r1);
                bf16_t* g = gp + (size_t)(ai * 128 + m * 16) * ldc;
                *(u32x4*)g = r0; *(u32x4*)(g + (size_t)8 * ldc) = r1; }
    }
};
struct EpiQ {
    static constexpr int PERM = 2; bf16_t* Q; const float* rstd; LAS unsigned char* lds;
    __device__ __forceinline__ void operator()(const f32x4 (&acc)[2][2][4][2], const Unit& u, int wr, int wc, int fr, int fq) const {
        const EpiGeo G = epi_geo(lds, wr, wc, fr, fq);
        const int row0 = u.pm * 256 + wr * 64 + fr;
        float rsv[2][4];
#pragma unroll
        for (int ai = 0; ai < 2; ++ai)
#pragma unroll
            for (int m = 0; m < 4; ++m) rsv[ai][m] = rstd[row0 + ai * 128 + m * 16];
        bf16_t* gp = Q + (size_t)(u.pm * 256 + wr * 64 + G.r8) * 768 + u.pn * 256 + wc * 64 + G.p8 * 8;
#pragma unroll
        for (int ai = 0; ai < 2; ++ai)
#pragma unroll
            for (int m = 0; m < 4; ++m) { const float rs = rsv[ai][m] * QSCALE; u32x4 r0, r1;
                epi_xpose(G, pack8(acc[ai][0][m][0] * rs, acc[ai][0][m][1] * rs), pack8(acc[ai][1][m][0] * rs, acc[ai][1][m][1] * rs), r0, r1);
                bf16_t* g = gp + (size_t)(ai * 128 + m * 16) * 768;
                *(u32x4*)g = r0; *(u32x4*)(g + (size_t)8 * 768) = r1; }
    }
};
struct EpiKV {
    static constexpr int PERM = 2; bf16_t* Kb; bf16_t* Vb; const float* rstd; LAS unsigned char* lds;
    __device__ __forceinline__ void operator()(const f32x4 (&acc)[2][2][4][2], const Unit& u, int wr, int wc, int fr, int fq) const {
        const EpiGeo G = epi_geo(lds, wr, wc, fr, fq);
        const int row0 = u.pm * 256 + wr * 64 + fr; const bool isv = u.pn >= 2; const int ldc = isv ? 512 : KP;
        float rsv[2][4];
#pragma unroll
        for (int ai = 0; ai < 2; ++ai)
#pragma unroll
            for (int m = 0; m < 4; ++m) rsv[ai][m] = rstd[row0 + ai * 128 + m * 16];
        bf16_t* gp = (isv ? Vb : Kb) + (size_t)(u.pm * 256 + wr * 64 + G.r8) * ldc + (u.pn & 1) * 256 + wc * 64 + G.p8 * 8;
#pragma unroll
        for (int ai = 0; ai < 2; ++ai)
#pragma unroll
            for (int m = 0; m < 4; ++m) { const float rs = rsv[ai][m]; u32x4 r0, r1;
                epi_xpose(G, pack8(acc[ai][0][m][0] * rs, acc[ai][0][m][1] * rs), pack8(acc[ai][1][m][0] * rs, acc[ai][1][m][1] * rs), r0, r1);
                bf16_t* g = gp + (size_t)(ai * 128 + m * 16) * ldc;
                *(u32x4*)g = r0; *(u32x4*)(g + (size_t)8 * ldc) = r1; }
    }
};
__device__ __forceinline__ unsigned q8(float s) { return (unsigned)(s * 255.0f + 0.5f); }
__device__ __forceinline__ f32x4 silu4(const f32x4 a) { f32x4 r; r[0] = fast_sigmoid(a[0]) * a[0]; r[1] = fast_sigmoid(a[1]) * a[1]; r[2] = fast_sigmoid(a[2]) * a[2]; r[3] = fast_sigmoid(a[3]) * a[3]; return r; }
struct EpiGateBG {
    static constexpr int PERM = 2; bf16_t* YS; int pn0, skip; LAS unsigned char* lds;
    __device__ __forceinline__ void operator()(const f32x4 (&acc)[2][2][4][2], const Unit& u, int wr, int wc, int fr, int fq) const {
        const int pn = pn0 + u.pn + ((u.pn >= 2) ? skip : 0);
        const EpiGeo G = epi_geo(lds, wr, wc, fr, fq);
        bf16_t* gp = YS + (size_t)(pn >> 1) * T * 512 + (size_t)(u.pm * 256 + wr * 64 + G.r8) * 512 + (pn & 1) * 256 + wc * 64 + G.p8 * 8;
#pragma unroll
        for (int ai = 0; ai < 2; ++ai) {
            u32x4 y[4][2];
#pragma unroll
            for (int m = 0; m < 4; ++m)
#pragma unroll
                for (int h = 0; h < 2; ++h) y[m][h] = *(const u32x4*)(gp + (size_t)(ai * 128 + m * 16 + 8 * h) * 512);
#pragma unroll
            for (int m = 0; m < 4; ++m) { u32x4 r[2];
                epi_xpose(G, pack8(silu4(acc[ai][0][m][0]), silu4(acc[ai][0][m][1])), pack8(silu4(acc[ai][1][m][0]), silu4(acc[ai][1][m][1])), r[0], r[1]);
#pragma unroll
                for (int h = 0; h < 2; ++h) { const u32x4 yy = y[m][h], gg = r[h];
                    u32x4 w; w.x = pk2(bflo(gg.x) * bflo(yy.x), bfhi(gg.x) * bfhi(yy.x)); w.y = pk2(bflo(gg.y) * bflo(yy.y), bfhi(gg.y) * bfhi(yy.y));
                    w.z = pk2(bflo(gg.z) * bflo(yy.z), bfhi(gg.z) * bfhi(yy.z)); w.w = pk2(bflo(gg.w) * bflo(yy.w), bfhi(gg.w) * bfhi(yy.w));
                    *(u32x4*)(gp + (size_t)(ai * 128 + m * 16 + 8 * h) * 512) = w; } }
        }
    }
};
struct EpiGateMG8 {
    static constexpr int PERM = 2; unsigned char* SMG; LAS unsigned char* lds;
    __device__ __forceinline__ void operator()(const f32x4 (&acc)[2][2][4][2], const Unit& u, int wr, int wc, int fr, int fq) const {
        LAS unsigned char* scr = lds + EPI_SCR + (wr * 4 + wc) * EPI_SCR_WAVE; const int lane = fq * 16 + fr;
        LAS unsigned char* wp = scr + fr * 72 + fq * 8; const LAS unsigned char* rp = scr + (lane >> 2) * 72 + (lane & 3) * 16;
        unsigned char* gp = SMG + (size_t)((u.pm * 256 + wr * 64) >> 1) * 6144 + (size_t)(lane >> 3) * 6144 + (u.pn * 4 + wc) * 128 + ((lane >> 2) & 1) * 64 + (lane & 3) * 16;
#pragma unroll
        for (int ai = 0; ai < 2; ++ai)
#pragma unroll
            for (int m = 0; m < 4; ++m) {
#pragma unroll
                for (int bj = 0; bj < 2; ++bj) { const f32x4 a0 = acc[ai][bj][m][0], a1 = acc[ai][bj][m][1];
                    u32x2 w = {0u, 0u};
#pragma unroll
                    for (int j = 0; j < 4; ++j) { w.x = __builtin_amdgcn_cvt_pk_u8_f32(255.0f * fast_sigmoid(a0[j]), j, w.x); w.y = __builtin_amdgcn_cvt_pk_u8_f32(255.0f * fast_sigmoid(a1[j]), j, w.y); }
                    *(LAS u32x2*)(wp + bj * 32) = w; }
                asm volatile("" ::: "memory");
                const u32x2 ra = *(const LAS u32x2*)rp, rb = *(const LAS u32x2*)(rp + 8);
                asm volatile("" ::: "memory");
                *(u32x4*)(gp + (size_t)(ai * 64 + m * 8) * 6144) = (u32x4){ra.x, ra.y, rb.x, rb.y}; }
    }
};
struct EpiMerge {
    static constexpr int PERM = 2; bf16_t* MG; const unsigned char* SMG; LAS unsigned char* lds;
    __device__ __forceinline__ void operator()(const f32x4 (&acc)[2][2][4][2], const Unit& u, int wr, int wc, int fr, int fq) const {
        const EpiGeo G = epi_geo(lds, wr, wc, fr, fq); const int n = u.aux; constexpr float S = 1.0f / 255.0f;
        const size_t rowb = (size_t)(u.pm * 256 + wr * 64 + G.r8); const int colb = u.pn * 256 + wc * 64 + G.p8 * 8;
        const unsigned char* sp = SMG + (rowb >> 1) * 6144 + (size_t)(n * 16 + u.pn * 4 + wc) * 128 + (rowb & 1) * 64 + G.p8 * 8; bf16_t* mp = MG + rowb * 1024 + colb;
#pragma unroll
        for (int ai = 0; ai < 2; ++ai) {
            u32x2 g[4][2]; u32x4 y[4][2];
#pragma unroll
            for (int m = 0; m < 4; ++m)
#pragma unroll
                for (int h = 0; h < 2; ++h) { g[m][h] = *(const u32x2*)(sp + (size_t)(ai * 64 + m * 8 + 4 * h) * 6144); if (n > 0) y[m][h] = *(const u32x4*)(mp + (size_t)(ai * 128 + m * 16 + 8 * h) * 1024); }
#pragma unroll
            for (int m = 0; m < 4; ++m) { u32x4 r[2];
                epi_xpose(G, pack8(acc[ai][0][m][0], acc[ai][0][m][1]), pack8(acc[ai][1][m][0], acc[ai][1][m][1]), r[0], r[1]);
#pragma unroll
                for (int h = 0; h < 2; ++h) { const u32x2 gg = g[m][h]; const u32x4 aa = r[h];
                    float v[8] = {bflo(aa.x) * (S * (float)(gg.x & 0xffu)), bfhi(aa.x) * (S * (float)((gg.x >> 8) & 0xffu)), bflo(aa.y) * (S * (float)((gg.x >> 16) & 0xffu)), bfhi(aa.y) * (S * (float)(gg.x >> 24)),
                                  bflo(aa.z) * (S * (float)(gg.y & 0xffu)), bfhi(aa.z) * (S * (float)((gg.y >> 8) & 0xffu)), bflo(aa.w) * (S * (float)((gg.y >> 16) & 0xffu)), bfhi(aa.w) * (S * (float)(gg.y >> 24))};
                    if (n > 0) { const u32x4 yy = y[m][h];
                        v[0] += bflo(yy.x); v[1] += bfhi(yy.x); v[2] += bflo(yy.y); v[3] += bfhi(yy.y); v[4] += bflo(yy.z); v[5] += bfhi(yy.z); v[6] += bflo(yy.w); v[7] += bfhi(yy.w); }
                    u32x4 w; w.x = pk2(v[0], v[1]); w.y = pk2(v[2], v[3]); w.z = pk2(v[4], v[5]); w.w = pk2(v[6], v[7]);
                    *(u32x4*)(mp + (size_t)(ai * 128 + m * 16 + 8 * h) * 1024) = w; } }
        }
    }
};
struct EpiF32 {
    static constexpr bool PERM = false; float* O; int ldc;
    __device__ __forceinline__ void operator()(const f32x4 (&acc)[2][2][4][2], const Unit& u, int wr, int wc, int fr, int fq) const {
        const int row0 = u.pm * 256 + wr * 64 + fr, col0 = u.pn * 256 + wc * 32 + 4 * fq;
#pragma unroll
        for (int ai = 0; ai < 2; ++ai)
#pragma unroll
            for (int m = 0; m < 4; ++m) { float* rowp = O + (size_t)(row0 + ai * 128 + m * 16) * ldc + col0;
#pragma unroll
                for (int bj = 0; bj < 2; ++bj)
#pragma unroll
                    for (int n = 0; n < 2; ++n) *(f32x4*)(rowp + bj * 128 + n * 16) = acc[ai][bj][m][n]; }
    }
};

template <class SrcCol>
__device__ __forceinline__ void transpose_item(const float* W, int Ksrc, int Nsrc, bf16_t* WT, int Kdst, int item, int nblk, float* scr, int lane, SrcCol src, const float* kscale) {
    const int kb = item / nblk, nb = item % nblk, k0 = 64 * kb, n0 = 32 * nb;
    const int sc = src(n0 + (lane & 31));
#pragma unroll 8
    for (int i = 0; i < 32; ++i) { const int kk = 2 * i + (lane >> 5), k = k0 + kk; float v = 0.f;
        if (sc >= 0 && k < Ksrc) { v = W[(size_t)k * Nsrc + sc]; if (kscale) v *= kscale[k]; }
        scr[kk * 33 + (lane & 31)] = v; }
    asm volatile("s_waitcnt lgkmcnt(0)" ::: "memory");
    const int c = lane & 7;
#pragma unroll
    for (int j = 0; j < 4; ++j) { const int n = (lane >> 3) + 8 * j; const float* s = scr + (8 * c) * 33 + n;
        u32x4 o; o.x = pk2(s[0 * 33], s[1 * 33]); o.y = pk2(s[2 * 33], s[3 * 33]); o.z = pk2(s[4 * 33], s[5 * 33]); o.w = pk2(s[6 * 33], s[7 * 33]);
        *(u32x4*)(WT + (size_t)(n0 + n) * Kdst + k0 + 8 * c) = o; }
    asm volatile("s_waitcnt lgkmcnt(0)" ::: "memory");
}
__device__ __forceinline__ int win_src(int j) {
    if (j < 416) return j;
    if (j < 432) return 3104 + (j - 416);
    if (j < 512) return -1;
    if (j < 2048) return 416 + (j - 512);
    if (j < 2176) return 1952 + (j - 2048);
    if (j < 2304) return -1;
    if (j < 3328) return 2080 + (j - 2304);
    return 3120 + (j - 3328);
}
__device__ __forceinline__ int wuq_src(int j) { const int h = j / 96, c = j % 96; if (c < 64) return h * 96 + c; const int r = c - 64; return h * 96 + 64 + (r & 1) * 16 + (r >> 1); }
__device__ __forceinline__ int wukv_src(int j) { return j < 512 ? (j >> 6) * 128 + (j & 63) : ((j - 512) >> 6) * 128 + 64 + (j & 63); }

__device__ __forceinline__ void convert_weights(int l, unsigned char* lds, int gw, int NGW, int wave, int lane) {
    float* scr = (float*)(lds + wave * 8448); const Params p = load_params();
    bf16_t* WinT = (bf16_t*)(p.ws + WS_WIN); bf16_t* WboT = (bf16_t*)(p.ws + WS_WBO); bf16_t* WoutT = (bf16_t*)(p.ws + WS_WOUT); bf16_t* WuqT = (bf16_t*)(p.ws + WS_WUQ); bf16_t* WukvT = (bf16_t*)(p.ws + WS_WUKV);
    constexpr int I_IN = 16 * (NALL / 32), I_BO = 8 * 32, I_OUT = 16 * 32, I_UQ = 4 * 24, I_UKV = 4 * 32;
    constexpr int NITEMS = I_IN + 3 * I_BO + I_OUT + I_UQ + I_UKV;
    for (int it = gw; it < NITEMS; it += NGW) {
        int r = it;
        if (r < I_IN) { transpose_item(p.w_in + (size_t)l * 1024 * N_IN, 1024, N_IN, WinT, 1024, r, NALL / 32, scr, lane, [](int j) { return win_src(j); }, nullptr); continue; } r -= I_IN;
        if (r < 3 * I_BO) { const int n = r / I_BO; r -= n * I_BO;
            transpose_item(p.w_branch_out + ((size_t)l * 3 + n) * 512 * 1024, 512, 1024, WboT + (size_t)n * 1024 * 512, 512, r, 32, scr, lane, [](int j) { return j; }, nullptr); continue; } r -= 3 * I_BO;
        if (r < I_OUT) { transpose_item(p.w_out + (size_t)l * 1024 * 1024, 1024, 1024, WoutT, 1024, r, 32, scr, lane, [](int j) { return j; }, nullptr); continue; } r -= I_OUT;
        if (r < I_UQ) { transpose_item(p.mla_w_uq + (size_t)l * 256 * 768, 256, 768, WuqT, 256, r, 24, scr, lane, [](int j) { return wuq_src(j); }, p.mla_q_norm + l * 256); continue; } r -= I_UQ;
        transpose_item(p.mla_w_ukv + (size_t)l * 128 * 1024, 128, 1024, WukvT, 256, r, 32, scr, lane, [](int j) { return wukv_src(j); }, p.mla_kv_norm + l * 128);
    }
}
__device__ __forceinline__ void hb_row(const float* xrow, const float* g, bf16_t* orow, int lane) {
    const f32x4* xr = (const f32x4*)xrow + lane; const f32x4* gr = (const f32x4*)g + lane;
    f32x4 v[4]; float s = 0.f;
#pragma unroll
    for (int j = 0; j < 4; ++j) { v[j] = xr[64 * j]; s += (v[j].x * v[j].x + v[j].y * v[j].y) + (v[j].z * v[j].z + v[j].w * v[j].w); }
    const float rstd = rsqrtf(wave_sum(s) * (1.f / DM) + NORM_EPS);
    u32x2* o8 = (u32x2*)orow + lane;
#pragma unroll
    for (int j = 0; j < 4; ++j) { const f32x4 gg = gr[64 * j]; u32x2 w; w.x = pk2(v[j].x * rstd * gg.x, v[j].y * rstd * gg.y); w.y = pk2(v[j].z * rstd * gg.z, v[j].w * rstd * gg.w); o8[64 * j] = w; }
}
__device__ __forceinline__ void hb_rows4(const float* x, const float* g, bf16_t* HB, int m, int stride, int lane) {
    f32x4 v[4][4];
#pragma unroll
    for (int r = 0; r < 4; ++r) { const f32x4* xr = (const f32x4*)(x + (size_t)(m + r * stride) * DM) + lane;
#pragma unroll
        for (int j = 0; j < 4; ++j) v[r][j] = xr[64 * j]; }
    const f32x4* gr = (const f32x4*)g + lane;
#pragma unroll
    for (int r = 0; r < 4; ++r) { float s = 0.f;
#pragma unroll
        for (int j = 0; j < 4; ++j) s += (v[r][j].x * v[r][j].x + v[r][j].y * v[r][j].y) + (v[r][j].z * v[r][j].z + v[r][j].w * v[r][j].w);
        const float rstd = rsqrtf(wave_sum(s) * (1.f / DM) + NORM_EPS);
        u32x2* o8 = (u32x2*)(HB + (size_t)(m + r * stride) * DM) + lane;
#pragma unroll
        for (int j = 0; j < 4; ++j) { const f32x4 gg = gr[64 * j]; u32x2 w; w.x = pk2(v[r][j].x * rstd * gg.x, v[r][j].y * rstd * gg.y); w.y = pk2(v[r][j].z * rstd * gg.z, v[r][j].w * rstd * gg.w); o8[64 * j] = w; } }
}
template <bool XIN16> struct RowIn { u32x4 oa, ob, xa, xb; f32x4 xv[4]; };
template <bool XIN16> __device__ __forceinline__ void final_load(RowIn<XIN16>& r, const bf16_t* orow, const float* xold, int lane) {
    r.oa = *((const u32x4*)orow + lane); r.ob = *((const u32x4*)orow + 64 + lane);
    if (XIN16) { r.xa = *((const u32x4*)xold + lane); r.xb = *((const u32x4*)xold + 64 + lane); }
    else {
#pragma unroll
        for (int h = 0; h < 2; ++h)
#pragma unroll
            for (int q = 0; q < 2; ++q) r.xv[2 * h + q] = *((const f32x4*)(xold + 512 * h + 8 * lane) + q); }
}
template <bool XIN16, bool XOUT16>
__device__ __forceinline__ void final_row(const RowIn<XIN16>& r, const float* gpost, float* xnew, const float* gnext, bf16_t* hbrow, int lane) {
    float o[16], x[16], g[16];
    { const u32x4 a = r.oa, b = r.ob;
      o[0] = bflo(a.x); o[1] = bfhi(a.x); o[2] = bflo(a.y); o[3] = bfhi(a.y); o[4] = bflo(a.z); o[5] = bfhi(a.z); o[6] = bflo(a.w); o[7] = bfhi(a.w);
      o[8] = bflo(b.x); o[9] = bfhi(b.x); o[10] = bflo(b.y); o[11] = bfhi(b.y); o[12] = bflo(b.z); o[13] = bfhi(b.z); o[14] = bflo(b.w); o[15] = bfhi(b.w); }
    if (XIN16) { const u32x4 a = r.xa, b = r.xb;
      x[0] = bflo(a.x); x[1] = bfhi(a.x); x[2] = bflo(a.y); x[3] = bfhi(a.y); x[4] = bflo(a.z); x[5] = bfhi(a.z); x[6] = bflo(a.w); x[7] = bfhi(a.w);
      x[8] = bflo(b.x); x[9] = bfhi(b.x); x[10] = bflo(b.y); x[11] = bfhi(b.y); x[12] = bflo(b.z); x[13] = bfhi(b.z); x[14] = bflo(b.w); x[15] = bfhi(b.w); }
#pragma unroll
    for (int h = 0; h < 2; ++h)
#pragma unroll
        for (int q = 0; q < 2; ++q) { const f32x4 gv = *((const f32x4*)(gpost + 512 * h + 8 * lane) + q);
            if (!XIN16) {
#pragma unroll
                for (int e = 0; e < 4; ++e) x[8 * h + 4 * q + e] = r.xv[2 * h + q][e]; }
#pragma unroll
            for (int e = 0; e < 4; ++e) g[8 * h + 4 * q + e] = gv[e]; }
    float s = 0.f;
#pragma unroll
    for (int e = 0; e < 16; ++e) s += o[e] * o[e];
    const float rstd = rsqrtf(wave_sum(s) * (1.f / DM) + NORM_EPS);
    float s2 = 0.f;
#pragma unroll
    for (int e = 0; e < 16; ++e) { x[e] += o[e] * rstd * g[e]; s2 += x[e] * x[e]; }
    if (XOUT16) {
#pragma unroll
        for (int h = 0; h < 2; ++h) { u32x4 w; w.x = pk2(x[8 * h], x[8 * h + 1]); w.y = pk2(x[8 * h + 2], x[8 * h + 3]); w.z = pk2(x[8 * h + 4], x[8 * h + 5]); w.w = pk2(x[8 * h + 6], x[8 * h + 7]);
            *((u32x4*)xnew + 64 * h + lane) = w; }
    } else {
#pragma unroll
        for (int h = 0; h < 2; ++h)
#pragma unroll
            for (int q = 0; q < 2; ++q) *((f32x4*)(xnew + 512 * h + 8 * lane) + q) = (f32x4){x[8 * h + 4 * q], x[8 * h + 4 * q + 1], x[8 * h + 4 * q + 2], x[8 * h + 4 * q + 3]};
    }
    if (gnext) { const float rstd2 = rsqrtf(wave_sum(s2) * (1.f / DM) + NORM_EPS);
#pragma unroll
        for (int h = 0; h < 2; ++h) { const f32x4 g0 = *((const f32x4*)(gnext + 512 * h + 8 * lane)), g1 = *((const f32x4*)(gnext + 512 * h + 8 * lane) + 1);
            u32x4 w; w.x = pk2(x[8 * h] * rstd2 * g0[0], x[8 * h + 1] * rstd2 * g0[1]); w.y = pk2(x[8 * h + 2] * rstd2 * g0[2], x[8 * h + 3] * rstd2 * g0[3]);
            w.z = pk2(x[8 * h + 4] * rstd2 * g1[0], x[8 * h + 5] * rstd2 * g1[1]); w.w = pk2(x[8 * h + 6] * rstd2 * g1[2], x[8 * h + 7] * rstd2 * g1[3]);
            *((u32x4*)hbrow + 64 * h + lane) = w; } }
}
__device__ __forceinline__ void mla_prep_row(const bf16_t* prow, const f32x2* rope_t, float* rstdq, float* rstdkv, bf16_t* krow, int lane) {
    const u32x2 a = *((const u32x2*)(prow + CQ) + lane); const unsigned c = *((const unsigned*)(prow + CKV) + lane);
    float sq = bflo(a.x) * bflo(a.x) + bfhi(a.x) * bfhi(a.x) + bflo(a.y) * bflo(a.y) + bfhi(a.y) * bfhi(a.y);
    float sk = bflo(c) * bflo(c) + bfhi(c) * bfhi(c);
    sq = wave_sum(sq); sk = wave_sum(sk);
    if (lane == 0) { *rstdq = rsqrtf(sq * (1.f / 256.f) + NORM_EPS); *rstdkv = rsqrtf(sk * (1.f / 128.f) + NORM_EPS); }
    if (lane < 16) { const float x1 = bf2f(prow[KROPE + lane]), x2 = bf2f(prow[KROPE + 16 + lane]); const f32x2 cs = rope_t[lane];
        *((unsigned*)(krow + 512) + lane) = pk2(x1 * cs.x - x2 * cs.y, x2 * cs.x + x1 * cs.y); }
}

__device__ __forceinline__ void mla_prep_rows4(const bf16_t* PA, const f32x2* ROPE, float* RSTDQ, float* RSTDKV, bf16_t* Kb, int m, int stride, int lane) {
    u32x2 a[4]; unsigned c[4]; float x1[4], x2[4]; f32x2 cs[4];
#pragma unroll
    for (int j = 0; j < 4; ++j) { const int r = (m + j * stride < T) ? m + j * stride : m; const bf16_t* prow = PA + (size_t)r * NA;
        a[j] = *((const u32x2*)(prow + CQ) + lane); c[j] = *((const unsigned*)(prow + CKV) + lane);
        x1[j] = bf2f(prow[KROPE + (lane & 15)]); x2[j] = bf2f(prow[KROPE + 16 + (lane & 15)]); cs[j] = ROPE[(size_t)r * 16 + (lane & 15)]; }
#pragma unroll
    for (int j = 0; j < 4; ++j) { const int r = m + j * stride; if (r < T) {
        float sq = bflo(a[j].x) * bflo(a[j].x) + bfhi(a[j].x) * bfhi(a[j].x) + bflo(a[j].y) * bflo(a[j].y) + bfhi(a[j].y) * bfhi(a[j].y);
        float sk = bflo(c[j]) * bflo(c[j]) + bfhi(c[j]) * bfhi(c[j]);
        sq = wave_sum(sq); sk = wave_sum(sk);
        if (lane == 0) { RSTDQ[r] = rsqrtf(sq * (1.f / 256.f) + NORM_EPS); RSTDKV[r] = rsqrtf(sk * (1.f / 128.f) + NORM_EPS); }
        if (lane < 16) *((unsigned*)(Kb + (size_t)r * KP + 512) + lane) = pk2(x1[j] * cs[j].x - x2[j] * cs[j].y, x2[j] * cs[j].x + x1[j] * cs[j].y); } }
}

#ifdef BANDSKIP
namespace att {
constexpr int KSLOT = 12288, VSLOT = 8192, BUFB = KSLOT + VSLOT, L_WS = 2 * BUFB, L_OST = L_WS + 8 * 128 * 4, L_END = L_OST + 8 * 4096;
constexpr int UNIT_ROWS = 512;
__device__ __forceinline__ int crow(int r, int hi) { return (r & 3) + 8 * (r >> 2) + 4 * hi; }
__device__ __forceinline__ s16x4 vtr(const LAS unsigned char* p) { return __builtin_bit_cast(s16x4, __builtin_amdgcn_ds_read_tr16_b64_v4i16((LAS s16x4*)p)); }
__device__ __forceinline__ void load_q(bf16x8 (&qr)[6], const bf16_t* Q, const f32x2* rope, size_t row, int h, int hi) {
    const bf16_t* Qw = Q + row * 768 + h * 96 + hi * 8;
#pragma unroll
    for (int s = 0; s < 6; ++s) qr[s] = *(const bf16x8*)(Qw + s * 16);
    const f32x4* rp = (const f32x4*)(rope + row * 16 + 4 * hi);
#pragma unroll
    for (int s = 4; s < 6; ++s) { const f32x4 c01 = rp[(s - 4) * 4], c23 = rp[(s - 4) * 4 + 1]; const u32x4 w = __builtin_bit_cast(u32x4, qr[s]); u32x4 o;
        { const float e = bflo(w.x), d = bfhi(w.x); o.x = pk2(e * c01[0] - d * c01[1], d * c01[0] + e * c01[1]); }
        { const float e = bflo(w.y), d = bfhi(w.y); o.y = pk2(e * c01[2] - d * c01[3], d * c01[2] + e * c01[3]); }
        { const float e = bflo(w.z), d = bfhi(w.z); o.z = pk2(e * c23[0] - d * c23[1], d * c23[0] + e * c23[1]); }
        { const float e = bflo(w.w), d = bfhi(w.w); o.w = pk2(e * c23[2] - d * c23[3], d * c23[2] + e * c23[3]); }
        qr[s] = __builtin_bit_cast(bf16x8, o); }
}
__device__ __forceinline__ void softmax_half(f32x16& p0, f32x16& p1, f32x16& o0, f32x16& o1, float& mrun, float& lrun, bf16x8 (&pa)[4],
                                             bool first, bool band, int kb0, int qrel, int r32, int hi, LAS float* wsf) {
    if (band) {
#pragma unroll
        for (int r = 0; r < 16; ++r) { const int kv = kb0 + (r & 3) + 8 * (r >> 2); if (kv > qrel) p0[r] = -INFINITY; if (kv + 32 > qrel) p1[r] = -INFINITY; } }
    float mx = fmaxf(p0[0], p1[0]);
#pragma unroll
    for (int r = 1; r < 16; ++r) mx = fmaxf(mx, fmaxf(p0[r], p1[r]));
    mx = fmaxf(mx, __shfl_xor(mx, 32));
    if (first || __any(mx > 8.0f)) {
        const float dl = first ? mx : fmaxf(mx, 0.f); mrun += dl;
#pragma unroll
        for (int r = 0; r < 16; ++r) { p0[r] -= dl; p1[r] -= dl; }
        const float alpha = __builtin_amdgcn_exp2f(-dl); lrun *= alpha;
        if (hi == 0) wsf[r32] = alpha;
#pragma unroll
        for (int r = 0; r < 16; ++r) { const float a = wsf[crow(r, hi)]; o0[r] *= a; o1[r] *= a; }
    }
    float ls = 0.f;
#pragma unroll
    for (int r = 0; r < 16; ++r) { p0[r] = __builtin_amdgcn_exp2f(p0[r]); p1[r] = __builtin_amdgcn_exp2f(p1[r]); ls += p0[r] + p1[r]; }
    lrun += ls;
#pragma unroll
    for (int s = 0; s < 4; ++s) { const int bb = 8 * (s & 1); u32x4 w;
        if (s < 2) { w.x = pk2(p0[bb], p0[bb + 1]); w.y = pk2(p0[bb + 2], p0[bb + 3]); w.z = pk2(p0[bb + 4], p0[bb + 5]); w.w = pk2(p0[bb + 6], p0[bb + 7]); }
        else { w.x = pk2(p1[bb], p1[bb + 1]); w.y = pk2(p1[bb + 2], p1[bb + 3]); w.z = pk2(p1[bb + 4], p1[bb + 5]); w.w = pk2(p1[bb + 6], p1[bb + 7]); }
        pa[s] = __builtin_bit_cast(bf16x8, w); }
}
__device__ __forceinline__ void attn_unit(int b, int h, int qb, LAS unsigned char* lds, unsigned* done_ctr) {
    KArgs kp = kargs(); unsigned char* ws_ = kp->ws;
    const bf16_t* Q = (const bf16_t*)(ws_ + WS_Q); const bf16_t* Kg = (const bf16_t*)(ws_ + WS_K); const bf16_t* Vg = (const bf16_t*)(ws_ + WS_V); bf16_t* O = (bf16_t*)(ws_ + WS_YS);
    const int tid = opaque_tid(), lane = tid & 63, r32 = lane & 31, hi = lane >> 5; const int wid = __builtin_amdgcn_readfirstlane(tid >> 6);
    const size_t rowbase = (size_t)b * SEQ; const int q0 = qb * UNIT_ROWS;
    bf16x8 qa[6], qb_[6];
    const int rba = 32 * wid, rbb = 32 * (15 - wid);
    load_q(qa, Q, (const f32x2*)(ws_ + WS_ROPE), rowbase + q0 + rba + r32, h, hi);
    load_q(qb_, Q, (const f32x2*)(ws_ + WS_ROPE), rowbase + q0 + rbb + r32, h, hi);
    const char* kbase0 = (const char*)(Kg + rowbase * KP + h * 64); const char* kbase1 = (const char*)(Kg + rowbase * KP + 512);
    const char* vbase = (const char*)(Vg + rowbase * 512 + h * 64);
    const unsigned kof = (unsigned)(((tid & 63) * KP + (tid >> 6) * 8) * 2), vof = (unsigned)((((tid & 255) >> 2) * 512 + (tid >> 8) * 32 + (tid & 3) * 8) * 2);
    const int NT = (q0 + UNIT_ROWS) / 64;
    LAS float* wsf = (LAS float*)(lds + L_WS) + wid * 128;
    u32x4 sk0, sk1, sv;
    sk0 = *(const u32x4*)(kbase0 + kof); if (tid < 256) sk1 = *(const u32x4*)(kbase1 + kof); sv = *(const u32x4*)(vbase + vof);
    *(LAS u32x4*)(lds + tid * 16) = sk0; if (tid < 256) *(LAS u32x4*)(lds + (tid + 512) * 16) = sk1; *(LAS u32x4*)(lds + KSLOT + tid * 16) = sv;
    __syncthreads();
    f32x16 oa0 = {}, oa1 = {}, ob0 = {}, ob1 = {}; float ma = 0.f, la = 0.f, mb = 0.f, lb = 0.f;
    const int qra = rba + r32, qrb = rbb + r32;
    const int tlastA = NT - 8 + ((rba + 31) >> 6), tlastB = NT - 8 + ((rbb + 31) >> 6);
    for (int t = 0; t < NT; ++t) {
        int tidv = tid; asm volatile("" : "+v"(tidv));
        const int lanev = tidv & 63, r32v = lanev & 31, hiv = lanev >> 5;
        const unsigned kofv = (unsigned)(((tidv & 63) * KP + (tidv >> 6) * 8) * 2), vofv = (unsigned)((((tidv & 255) >> 2) * 512 + (tidv >> 8) * 32 + (tidv & 3) * 8) * 2);
        LAS unsigned char* buf = lds + (t & 1) * BUFB; LAS unsigned char* nbuf = lds + ((t + 1) & 1) * BUFB;
        if (t + 1 < NT) { const size_t ko = (size_t)(t + 1) * 64 * KP * 2, vo = (size_t)(t + 1) * 64 * 512 * 2;
            sk0 = *(const u32x4*)(kbase0 + ko + kofv); if (tidv < 256) sk1 = *(const u32x4*)(kbase1 + ko + kofv); sv = *(const u32x4*)(vbase + vo + vofv); }
        const bool band = t >= NT - 8; const int kb0 = 64 * (t - (NT - 8)) + 4 * hiv;
        const bool doA = t <= tlastA, doB = t <= tlastB;
        f32x16 pa0, pa1, pb0, pb1;
#pragma unroll
        for (int r = 0; r < 16; ++r) { pa0[r] = -ma; pa1[r] = -ma; pb0[r] = -mb; pb1[r] = -mb; }
        { const LAS unsigned char* kb = buf + hiv * 1024 + r32v * 16;
#pragma unroll
          for (int s = 0; s < 6; ++s) { const bf16x8 a0 = *(const LAS bf16x8*)(kb + s * 2048), a1 = *(const LAS bf16x8*)(kb + s * 2048 + 512);
              if (doA) { pa0 = __builtin_amdgcn_mfma_f32_32x32x16_bf16(a0, qa[s], pa0, 0, 0, 0); pa1 = __builtin_amdgcn_mfma_f32_32x32x16_bf16(a1, qa[s], pa1, 0, 0, 0); }
              if (doB) { pb0 = __builtin_amdgcn_mfma_f32_32x32x16_bf16(a0, qb_[s], pb0, 0, 0, 0); pb1 = __builtin_amdgcn_mfma_f32_32x32x16_bf16(a1, qb_[s], pb1, 0, 0, 0); } } }
        bf16x8 fa[4], fb[4];
        if (doA) softmax_half(pa0, pa1, oa0, oa1, ma, la, fa, t == 0, band, kb0, (rba + r32v), r32v, hiv, wsf);
        if (doB) softmax_half(pb0, pb1, ob0, ob1, mb, lb, fb, t == 0, band, kb0, (rbb + r32v), r32v, hiv, wsf + 64);
        { const LAS unsigned char* vb = buf + KSLOT + ((lanev >> 4) & 1) * 32 + (lanev & 3) * 8 + (4 * hiv + ((lanev & 15) >> 2)) * 64;
#pragma unroll
          for (int s = 0; s < 4; ++s) {
              { const s16x4 lo = vtr(vb + s * 1024), hh = vtr(vb + s * 1024 + 512); const bf16x8 vf = {lo[0], lo[1], lo[2], lo[3], hh[0], hh[1], hh[2], hh[3]};
                if (doA) oa0 = __builtin_amdgcn_mfma_f32_32x32x16_bf16(fa[s], vf, oa0, 0, 0, 0); if (doB) ob0 = __builtin_amdgcn_mfma_f32_32x32x16_bf16(fb[s], vf, ob0, 0, 0, 0); }
              { const s16x4 lo = vtr(vb + 4096 + s * 1024), hh = vtr(vb + 4096 + s * 1024 + 512); const bf16x8 vf = {lo[0], lo[1], lo[2], lo[3], hh[0], hh[1], hh[2], hh[3]};
                if (doA) oa1 = __builtin_amdgcn_mfma_f32_32x32x16_bf16(fa[s], vf, oa1, 0, 0, 0); if (doB) ob1 = __builtin_amdgcn_mfma_f32_32x32x16_bf16(fb[s], vf, ob1, 0, 0, 0); } } }
        if (t + 1 < NT) { *(LAS u32x4*)(nbuf + tidv * 16) = sk0; if (tidv < 256) *(LAS u32x4*)(nbuf + (tidv + 512) * 16) = sk1; *(LAS u32x4*)(nbuf + KSLOT + tidv * 16) = sv; }
        __syncthreads();
    }
    la += __shfl_xor(la, 32); lb += __shfl_xor(lb, 32);
    if (hi == 0) { wsf[32 + r32] = la; wsf[96 + r32] = lb; }
    LAS bf16_t* stg = (LAS bf16_t*)(lds + L_OST) + wid * 2048;
#pragma unroll
    for (int hf = 0; hf < 2; ++hf) {
#pragma unroll
        for (int r = 0; r < 16; ++r) { const int orow = crow(r, hi); const float rl = __builtin_amdgcn_rcpf(wsf[hf * 64 + 32 + orow]);
            stg[orow * 64 + r32] = f2bf((hf ? ob0[r] : oa0[r]) * rl); stg[orow * 64 + 32 + r32] = f2bf((hf ? ob1[r] : oa1[r]) * rl); }
        asm volatile("" ::: "memory");
        bf16_t* Ow = O + (rowbase + q0 + (hf ? rbb : rba)) * 512 + h * 64;
#pragma unroll
        for (int i = 0; i < 4; ++i) { const int row = i * 8 + (lane >> 3), ch = lane & 7; const u32x4 v = *(const LAS u32x4*)(stg + row * 64 + ch * 8); *(u32x4*)(Ow + (size_t)row * 512 + ch * 8) = v; }
        asm volatile("" ::: "memory");
    }
    asm volatile("s_waitcnt vmcnt(0)" ::: "memory");
    __syncthreads();
    if (tid == 0) __hip_atomic_fetch_add(done_ctr, 1u, __ATOMIC_RELEASE, __HIP_MEMORY_SCOPE_AGENT);
}
}
#else
namespace att {
constexpr int KSLOT = 12288, VSLOT = 8192, BUFB = KSLOT + VSLOT, L_WS = 2 * BUFB, L_OST = L_WS + 8 * 128 * 4, L_END = L_OST + 8 * 4096;
constexpr int UNIT_ROWS = 512;
__device__ __forceinline__ int crow(int r, int hi) { return (r & 3) + 8 * (r >> 2) + 4 * hi; }
__device__ __forceinline__ s16x4 vtr(const LAS unsigned char* p) { return __builtin_bit_cast(s16x4, __builtin_amdgcn_ds_read_tr16_b64_v4i16((LAS s16x4*)p)); }
__device__ __forceinline__ void load_q(bf16x8 (&qr)[6], const bf16_t* Q, const f32x2* rope, size_t row, int h, int hi) {
    const bf16_t* Qw = Q + row * 768 + h * 96 + hi * 8;
#pragma unroll
    for (int s = 0; s < 6; ++s) qr[s] = *(const bf16x8*)(Qw + s * 16);
    const f32x4* rp = (const f32x4*)(rope + row * 16 + 4 * hi);
#pragma unroll
    for (int s = 4; s < 6; ++s) { const f32x4 c01 = rp[(s - 4) * 4], c23 = rp[(s - 4) * 4 + 1]; const u32x4 w = __builtin_bit_cast(u32x4, qr[s]); u32x4 o;
        { const float e = bflo(w.x), d = bfhi(w.x); o.x = pk2(e * c01[0] - d * c01[1], d * c01[0] + e * c01[1]); }
        { const float e = bflo(w.y), d = bfhi(w.y); o.y = pk2(e * c01[2] - d * c01[3], d * c01[2] + e * c01[3]); }
        { const float e = bflo(w.z), d = bfhi(w.z); o.z = pk2(e * c23[0] - d * c23[1], d * c23[0] + e * c23[1]); }
        { const float e = bflo(w.w), d = bfhi(w.w); o.w = pk2(e * c23[2] - d * c23[3], d * c23[2] + e * c23[3]); }
        qr[s] = __builtin_bit_cast(bf16x8, o); }
}
__device__ __forceinline__ void softmax_half(f32x16& p0, f32x16& p1, f32x16& o0, f32x16& o1, float& mrun, float& lrun, bf16x8 (&pa)[4],
                                             bool first, bool band, int kb0, int qrel, int r32, int hi, LAS float* wsf) {
    if (band) {
#pragma unroll
        for (int r = 0; r < 16; ++r) { const int kv = kb0 + (r & 3) + 8 * (r >> 2); if (kv > qrel) p0[r] = -INFINITY; if (kv + 32 > qrel) p1[r] = -INFINITY; } }
    float mx = fmaxf(p0[0], p1[0]);
#pragma unroll
    for (int r = 1; r < 16; ++r) mx = fmaxf(mx, fmaxf(p0[r], p1[r]));
    mx = fmaxf(mx, __shfl_xor(mx, 32));
    if (first || __any(mx > 8.0f)) {
        const float dl = first ? mx : fmaxf(mx, 0.f); mrun += dl;
#pragma unroll
        for (int r = 0; r < 16; ++r) { p0[r] -= dl; p1[r] -= dl; }
        const float alpha = __builtin_amdgcn_exp2f(-dl); lrun *= alpha;
        if (hi == 0) wsf[r32] = alpha;
#pragma unroll
        for (int r = 0; r < 16; ++r) { const float a = wsf[crow(r, hi)]; o0[r] *= a; o1[r] *= a; }
    }
    float ls = 0.f;
#pragma unroll
    for (int r = 0; r < 16; ++r) { p0[r] = __builtin_amdgcn_exp2f(p0[r]); p1[r] = __builtin_amdgcn_exp2f(p1[r]); ls += p0[r] + p1[r]; }
    lrun += ls;
#pragma unroll
    for (int s = 0; s < 4; ++s) { const int bb = 8 * (s & 1); u32x4 w;
        if (s < 2) { w.x = pk2(p0[bb], p0[bb + 1]); w.y = pk2(p0[bb + 2], p0[bb + 3]); w.z = pk2(p0[bb + 4], p0[bb + 5]); w.w = pk2(p0[bb + 6], p0[bb + 7]); }
        else { w.x = pk2(p1[bb], p1[bb + 1]); w.y = pk2(p1[bb + 2], p1[bb + 3]); w.z = pk2(p1[bb + 4], p1[bb + 5]); w.w = pk2(p1[bb + 6], p1[bb + 7]); }
        pa[s] = __builtin_bit_cast(bf16x8, w); }
}
__device__ __forceinline__ void attn_unit(int b, int h, int qb, LAS unsigned char* lds, unsigned* done_ctr) {
    KArgs kp = kargs(); unsigned char* ws_ = kp->ws;
    const bf16_t* Q = (const bf16_t*)(ws_ + WS_Q); const bf16_t* Kg = (const bf16_t*)(ws_ + WS_K); const bf16_t* Vg = (const bf16_t*)(ws_ + WS_V); bf16_t* O = (bf16_t*)(ws_ + WS_YS);
    const int tid = opaque_tid(), lane = tid & 63, r32 = lane & 31, hi = lane >> 5; const int wid = __builtin_amdgcn_readfirstlane(tid >> 6);
    const size_t rowbase = (size_t)b * SEQ; const int q0 = qb * UNIT_ROWS;
    bf16x8 qa[6], qb_[6];
    load_q(qa, Q, (const f32x2*)(ws_ + WS_ROPE), rowbase + q0 + wid * 64 + r32, h, hi);
    load_q(qb_, Q, (const f32x2*)(ws_ + WS_ROPE), rowbase + q0 + wid * 64 + 32 + r32, h, hi);
    const bf16_t* ksrc0 = Kg + (rowbase + (tid & 63)) * KP + h * 64 + (tid >> 6) * 8;
    const bf16_t* ksrc1 = Kg + (rowbase + (tid & 63)) * KP + 512 + (tid >> 6) * 8;
    const bf16_t* vsrc = Vg + (rowbase + ((tid & 255) >> 2)) * 512 + h * 64 + (tid >> 8) * 32 + (tid & 3) * 8;
    const int NT = (q0 + UNIT_ROWS) / 64;
    LAS float* wsf = (LAS float*)(lds + L_WS) + wid * 128;
    u32x4 sk0, sk1, sv;
    sk0 = *(const u32x4*)ksrc0; if (tid < 256) sk1 = *(const u32x4*)ksrc1; sv = *(const u32x4*)vsrc;
    *(LAS u32x4*)(lds + tid * 16) = sk0; if (tid < 256) *(LAS u32x4*)(lds + (tid + 512) * 16) = sk1; *(LAS u32x4*)(lds + KSLOT + tid * 16) = sv;
    __syncthreads();
    f32x16 oa0 = {}, oa1 = {}, ob0 = {}, ob1 = {}; float ma = 0.f, la = 0.f, mb = 0.f, lb = 0.f;
    const int qra = wid * 64 + r32, qrb = qra + 32;
    for (int t = 0; t < NT; ++t) {
        LAS unsigned char* buf = lds + (t & 1) * BUFB; LAS unsigned char* nbuf = lds + ((t + 1) & 1) * BUFB;
        if (t + 1 < NT) { sk0 = *(const u32x4*)(ksrc0 + (size_t)(t + 1) * 64 * KP); if (tid < 256) sk1 = *(const u32x4*)(ksrc1 + (size_t)(t + 1) * 64 * KP); sv = *(const u32x4*)(vsrc + (size_t)(t + 1) * 64 * 512); }
        f32x16 pa0, pa1, pb0, pb1;
#pragma unroll
        for (int r = 0; r < 16; ++r) { pa0[r] = -ma; pa1[r] = -ma; pb0[r] = -mb; pb1[r] = -mb; }
        { const LAS unsigned char* kb = buf + hi * 1024 + r32 * 16;
#pragma unroll
          for (int s = 0; s < 6; ++s) { const bf16x8 a0 = *(const LAS bf16x8*)(kb + s * 2048), a1 = *(const LAS bf16x8*)(kb + s * 2048 + 512);
              pa0 = __builtin_amdgcn_mfma_f32_32x32x16_bf16(a0, qa[s], pa0, 0, 0, 0); pa1 = __builtin_amdgcn_mfma_f32_32x32x16_bf16(a1, qa[s], pa1, 0, 0, 0);
              pb0 = __builtin_amdgcn_mfma_f32_32x32x16_bf16(a0, qb_[s], pb0, 0, 0, 0); pb1 = __builtin_amdgcn_mfma_f32_32x32x16_bf16(a1, qb_[s], pb1, 0, 0, 0); } }
        const bool band = t >= NT - 8; const int kb0 = 64 * (t - (NT - 8)) + 4 * hi;
        bf16x8 fa[4], fb[4];
        softmax_half(pa0, pa1, oa0, oa1, ma, la, fa, t == 0, band, kb0, qra, r32, hi, wsf);
        softmax_half(pb0, pb1, ob0, ob1, mb, lb, fb, t == 0, band, kb0, qrb, r32, hi, wsf + 64);
        { const LAS unsigned char* vb = buf + KSLOT + ((lane >> 4) & 1) * 32 + (lane & 3) * 8 + (4 * hi + ((lane & 15) >> 2)) * 64;
#pragma unroll
          for (int s = 0; s < 4; ++s) {
              { const s16x4 lo = vtr(vb + s * 1024), hh = vtr(vb + s * 1024 + 512); const bf16x8 vf = {lo[0], lo[1], lo[2], lo[3], hh[0], hh[1], hh[2], hh[3]};
                oa0 = __builtin_amdgcn_mfma_f32_32x32x16_bf16(fa[s], vf, oa0, 0, 0, 0); ob0 = __builtin_amdgcn_mfma_f32_32x32x16_bf16(fb[s], vf, ob0, 0, 0, 0); }
              { const s16x4 lo = vtr(vb + 4096 + s * 1024), hh = vtr(vb + 4096 + s * 1024 + 512); const bf16x8 vf = {lo[0], lo[1], lo[2], lo[3], hh[0], hh[1], hh[2], hh[3]};
                oa1 = __builtin_amdgcn_mfma_f32_32x32x16_bf16(fa[s], vf, oa1, 0, 0, 0); ob1 = __builtin_amdgcn_mfma_f32_32x32x16_bf16(fb[s], vf, ob1, 0, 0, 0); } } }
        if (t + 1 < NT) { *(LAS u32x4*)(nbuf + tid * 16) = sk0; if (tid < 256) *(LAS u32x4*)(nbuf + (tid + 512) * 16) = sk1; *(LAS u32x4*)(nbuf + KSLOT + tid * 16) = sv; }
        __syncthreads();
    }
    la += __shfl_xor(la, 32); lb += __shfl_xor(lb, 32);
    if (hi == 0) { wsf[32 + r32] = la; wsf[96 + r32] = lb; }
    LAS bf16_t* stg = (LAS bf16_t*)(lds + L_OST) + wid * 2048;
#pragma unroll
    for (int hf = 0; hf < 2; ++hf) {
#pragma unroll
        for (int r = 0; r < 16; ++r) { const int orow = crow(r, hi); const float rl = __builtin_amdgcn_rcpf(wsf[hf * 64 + 32 + orow]);
            stg[orow * 64 + r32] = f2bf((hf ? ob0[r] : oa0[r]) * rl); stg[orow * 64 + 32 + r32] = f2bf((hf ? ob1[r] : oa1[r]) * rl); }
        asm volatile("" ::: "memory");
        bf16_t* Ow = O + (rowbase + q0 + wid * 64 + hf * 32) * 512 + h * 64;
#pragma unroll
        for (int i = 0; i < 4; ++i) { const int row = i * 8 + (lane >> 3), ch = lane & 7; const u32x4 v = *(const LAS u32x4*)(stg + row * 64 + ch * 8); *(u32x4*)(Ow + (size_t)row * 512 + ch * 8) = v; }
        asm volatile("" ::: "memory");
    }
    asm volatile("s_waitcnt vmcnt(0)" ::: "memory");
    __syncthreads();
    if (tid == 0) __hip_atomic_fetch_add(done_ctr, 1u, __ATOMIC_RELEASE, __HIP_MEMORY_SCOPE_AGENT);
}
}
#endif

namespace rwkv {
constexpr int LP = 72, TB = 64 * LP * 2;
constexpr int S_HT0 = 0, S_HT1 = 1, S_A = 2  , S_B = 3  , S_K = 4, S_R = 5, S_BT = 6, S_KT = 7, S_V = 8,
              S_MOFF = 9, S_MAK = 10, S_MRK = 11, S_MRB = 12, S_D = 13, S_ZT = 14, S_ACC = 15, NSLOT = 16;
constexpr int FP = 68;
constexpr int O_ZW = S_K * TB, O_ZA = O_ZW + 64 * FP * 4, O_YB = S_MAK * TB, O_WT = NSLOT * TB, O_CL = O_WT + 8 * 64 * 4, O_CST = O_CL + 64 * 4, O_END = O_CST + 12 * 64 * 4, O_TT = O_END  ;
static_assert(O_ZA + 64 * FP * 4 <= (S_KT + 1) * TB && O_YB + 64 * FP * 4 <= (S_MRK + 1) * TB, "f32 aliases");
__device__ __forceinline__ s16x4 vtr(const LAS unsigned char* p) { return __builtin_bit_cast(s16x4, __builtin_amdgcn_ds_read_tr16_b64_v4i16((LAS s16x4*)p)); }
struct LaneOff { int bn, bt, bs; };
__device__ __forceinline__ LaneOff lane_off(int fr, int fq) { LaneOff o; o.bn = (fr * LP + 8 * fq) * 2; o.bt = ((8 * fq + (fr >> 2)) * LP + 4 * (fr & 3)) * 2; o.bs = (fr * LP + 4 * fq) * 2; return o; }
__device__ __forceinline__ void relaunder(LaneOff& o) { asm volatile("" : "+v"(o.bn), "+v"(o.bt), "+v"(o.bs)); }
__device__ __forceinline__ bf16x8 frag_t(const LAS unsigned char* tile, int kk, int c0, const LaneOff& o) {
    const LAS unsigned char* q = tile + o.bt + (32 * kk * LP + c0) * 2;
    const s16x4 lo = vtr(q), hi = vtr(q + 4 * LP * 2); return (bf16x8){lo[0], lo[1], lo[2], lo[3], hi[0], hi[1], hi[2], hi[3]};
}
__device__ __forceinline__ bf16x8 frag_n(const LAS unsigned char* tile, int r0, int kk, const LaneOff& o) { return *(const LAS bf16x8*)(tile + o.bn + (r0 * LP + 32 * kk) * 2); }
__device__ __forceinline__ f32x4 MFMA16(bf16x8 a, bf16x8 b, f32x4 c) { return __builtin_amdgcn_mfma_f32_16x16x32_bf16(a, b, c, 0, 0, 0); }
__device__ __forceinline__ void st_tile_T(LAS unsigned char* tile, int m0, int n0, const LaneOff& o, const f32x4 c) {
    u32x2 w; w.x = pk2(c[0], c[1]); w.y = pk2(c[2], c[3]); *(LAS u32x2*)(tile + o.bs + (n0 * LP + m0) * 2) = w;
}
__device__ __forceinline__ void unpack8(const u32x4 w, float (&f)[8]) { f[0] = bflo(w.x); f[1] = bfhi(w.x); f[2] = bflo(w.y); f[3] = bfhi(w.y); f[4] = bflo(w.z); f[5] = bfhi(w.z); f[6] = bflo(w.w); f[7] = bfhi(w.w); }
__device__ __forceinline__ u32x4 pack8(const float (&f)[8]) { u32x4 w; w.x = pk2(f[0], f[1]); w.y = pk2(f[2], f[3]); w.z = pk2(f[4], f[5]); w.w = pk2(f[6], f[7]); return w; }
__device__ __forceinline__ void ld8(const float* p, float (&f)[8]) { const f32x4 a = *(const f32x4*)p, b = *(const f32x4*)(p + 4); f[0] = a[0]; f[1] = a[1]; f[2] = a[2]; f[3] = a[3]; f[4] = b[0]; f[5] = b[1]; f[6] = b[2]; f[7] = b[3]; }
__device__ __forceinline__ void ld8l(const LAS float* p, float (&f)[8]) { const f32x4 a = *(const LAS f32x4*)p, b = *(const LAS f32x4*)(p + 4); f[0] = a[0]; f[1] = a[1]; f[2] = a[2]; f[3] = a[3]; f[4] = b[0]; f[5] = b[1]; f[6] = b[2]; f[7] = b[3]; }
__device__ __forceinline__ float ex2(float x) { return __builtin_amdgcn_exp2f(x); }
constexpr float LOG2E = 1.4426950408889634f, LN2 = 0.6931471805599453f;

__device__ __forceinline__ void rwkv_unit(int l, int b, int h, LAS unsigned char* L) {
    const int tid = opaque_tid(), lane = tid & 63, fr = lane & 15, fq = lane >> 4; const int w = __builtin_amdgcn_readfirstlane(tid >> 6);
    const Params p = load_params();
    const bf16_t* PA = (const bf16_t*)(p.ws + WS_PA); bf16_t* Yout = (bf16_t*)(p.ws + WS_YS) + (size_t)T * 512;
    const int t = tid >> 3, c8 = (tid & 7) * 8;
    const int tw = (lane >> 3);
    const int cw = 16 * (w & 3);
    const float* mu = p.rwkv_mu + l * 1664;
    LaneOff lo = lane_off(fr, fq);
#define SLOT(s) (L + (s) * TB)
    bf16x8 bup[2];
    { const float* U = ((w < 4) ? p.rwkv_w_up : p.rwkv_a_up) + (size_t)l * 64 * 512 + h * 64 + 16 * (w & 3) + fr;
#pragma unroll
      for (int kk = 0; kk < 2; ++kk) { float f[8];
#pragma unroll
          for (int e = 0; e < 8; ++e) f[e] = U[(size_t)(32 * kk + 8 * fq + e) * 512];
          bup[kk] = __builtin_bit_cast(bf16x8, pack8(f)); } }
    for (int e = tid; e < TB / 4; e += 512) { ((LAS unsigned*)SLOT(S_HT0))[e] = 0u; ((LAS unsigned*)SLOT(S_D))[e] = 0u; ((LAS unsigned*)SLOT(S_MOFF))[e] = 0u; ((LAS unsigned*)SLOT(S_MRB))[e] = 0u;
        ((LAS unsigned*)SLOT(S_ZT))[e] = 0u; ((LAS unsigned*)SLOT(S_ACC))[e] = 0u; }
    f32x4 hacc[4];
#pragma unroll
    for (int i = 0; i < 4; ++i) hacc[i] = (f32x4){0.f, 0.f, 0.f, 0.f};
    int hcur = S_HT0, hnxt = S_HT1;
    u32x4 raw[10];
#define RWKV_LOAD(c, t, c8) do { const size_t row_ = (size_t)b * SEQ + (c) * 64 + (t); const bf16_t* s_ = PA + row_ * NA; const bool hp_ = ((c) * 64 + (t)) > 0; const u32x4 z_ = {0u, 0u, 0u, 0u}; \
        raw[0] = *(const u32x4*)(s_ + RW_R + h * 64 + c8); raw[1] = hp_ ? *(const u32x4*)(s_ - NA + RW_R + h * 64 + c8) : z_; \
        raw[2] = *(const u32x4*)(s_ + RW_K + h * 64 + c8); raw[3] = hp_ ? *(const u32x4*)(s_ - NA + RW_K + h * 64 + c8) : z_; \
        raw[4] = *(const u32x4*)(s_ + RW_V + h * 64 + c8); raw[5] = hp_ ? *(const u32x4*)(s_ - NA + RW_V + h * 64 + c8) : z_; \
        raw[6] = *(const u32x4*)(s_ + RW_LW + c8); raw[7] = hp_ ? *(const u32x4*)(s_ - NA + RW_LW + c8) : z_; \
        raw[8] = *(const u32x4*)(s_ + RW_LA + c8); raw[9] = hp_ ? *(const u32x4*)(s_ - NA + RW_LA + c8) : z_; } while (0)
    for (int e = tid; e < 12 * 64; e += 512) { const int rw_ = e >> 6, i_ = e & 63; const int hci = l * 512 + h * 64 + i_; float val;
        switch (rw_) { case 0: val = mu[h * 64 + i_]; break; case 1: val = mu[512 + h * 64 + i_]; break; case 2: val = mu[1024 + h * 64 + i_]; break; case 3: val = mu[1536 + i_]; break; case 4: val = mu[1600 + i_]; break;
            case 5: val = p.rwkv_w0[hci]; break; case 6: val = p.rwkv_a0[hci]; break; case 7: val = p.rwkv_k_k[hci]; break; case 8: val = p.rwkv_k_a[hci]; break; case 9: val = p.rwkv_r_k[hci]; break;
            case 10: val = p.rwkv_ln_w[hci]; break; default: val = p.rwkv_ln_b[hci]; break; }
        ((LAS float*)(L + O_CST))[e] = val; }
#ifdef V_C
    if (tid < 48) { const int task = tid / 6 + 8 * (tid % 6); u32x4 d = {0u, 0u, 0u, 3u};
        if (task < 36) { int q, mn;
            if (task < 6) { q = 0; mn = (int)((0xEDC984ull >> (4 * task)) & 0xF); }
            else { q = 1 + (task - 6) / 10; mn = (int)((0xFEDCA98540ull >> (4 * ((task - 6) % 10))) & 0xF); }
            const int m0 = 16 * (mn >> 2), n0 = 16 * (mn & 3);
            d.x = (unsigned)(((q < 2) ? S_A : S_R) * TB + m0 * LP * 2); d.y = (unsigned)(((q & 1) ? S_K : S_B) * TB + n0 * LP * 2);
            d.z = (unsigned)(((q == 0) ? S_MOFF : (q == 1) ? S_MAK : (q == 2) ? S_MRB : S_MRK) * TB + (n0 * LP + m0) * 2);
            d.w = (m0 == n0) ? ((q < 2) ? 1u : 2u) : 0u;
        } else { const int z = task - 36; const int mn = (int)((0xB76321ull >> (4 * (z % 6))) & 0xF);
            d.z = (unsigned)(((z < 6) ? S_MAK : S_MRK) * TB + (16 * (mn & 3) * LP + 16 * (mn >> 2)) * 2); }
        *(LAS u32x2*)(L + O_TT + tid * 8) = (u32x2){(d.x >> 4) | ((d.y >> 4) << 16), (d.z >> 4) | (d.w << 16)}; }
#endif
    RWKV_LOAD(0, t, c8);
    __syncthreads();
    for (int c = 0; c < SEQ / 64; ++c) {
        int c8v = c8, tv = t, frv = fr, fqv = fq; asm volatile("" : "+v"(c8v), "+v"(tv), "+v"(frv), "+v"(fqv));
        const int twv = tv & 7;
        float r[8], kraw[8], v[8];
        { float cu[8], pr[8], m8[8], o[8];
          unpack8(raw[0], cu); unpack8(raw[1], pr); ld8l((const LAS float*)(L + O_CST) + 0 * 64 + c8v, m8);
#pragma unroll
          for (int e = 0; e < 8; ++e) r[e] = cu[e] + (pr[e] - cu[e]) * m8[e];
          unpack8(raw[2], cu); unpack8(raw[3], pr); ld8l((const LAS float*)(L + O_CST) + 1 * 64 + c8v, m8);
#pragma unroll
          for (int e = 0; e < 8; ++e) kraw[e] = cu[e] + (pr[e] - cu[e]) * m8[e];
          unpack8(raw[4], cu); unpack8(raw[5], pr); ld8l((const LAS float*)(L + O_CST) + 2 * 64 + c8v, m8);
#pragma unroll
          for (int e = 0; e < 8; ++e) v[e] = cu[e] + (pr[e] - cu[e]) * m8[e];
#ifdef V_V
          *(LAS u32x4*)(SLOT(S_V) + (tv * LP + c8v) * 2) = pack8(v);
#endif
          unpack8(raw[6], cu); unpack8(raw[7], pr); ld8l((const LAS float*)(L + O_CST) + 3 * 64 + c8v, m8);
#pragma unroll
          for (int e = 0; e < 8; ++e) { const float x = cu[e] + (pr[e] - cu[e]) * m8[e]; o[e] = 1.0f - 2.0f * __builtin_amdgcn_rcpf(ex2(x * (2.0f * LOG2E)) + 1.0f); }
          *(LAS u32x4*)(SLOT(S_A) + (tv * LP + c8v) * 2) = pack8(o);
          unpack8(raw[8], cu); unpack8(raw[9], pr); ld8l((const LAS float*)(L + O_CST) + 4 * 64 + c8v, m8);
#pragma unroll
          for (int e = 0; e < 8; ++e) o[e] = cu[e] + (pr[e] - cu[e]) * m8[e];
          *(LAS u32x4*)(SLOT(S_B) + (tv * LP + c8v) * 2) = pack8(o); }
        __syncthreads();
        relaunder(lo);
#ifdef U_P2
        { const LAS unsigned char* X = (w < 4) ? SLOT(S_A) : SLOT(S_B); LAS float* Z = (LAS float*)(L + ((w < 4) ? O_ZW : O_ZA));
          f32x4 zacc[4];
#pragma unroll
          for (int m = 0; m < 4; ++m) { f32x4 a = {0.f, 0.f, 0.f, 0.f};
#pragma unroll
              for (int kk = 0; kk < 2; ++kk) a = MFMA16(frag_n(X, 16 * m, kk, lo), bup[kk], a);
              zacc[m] = a; }
#pragma unroll
          for (int m = 0; m < 4; ++m)
#pragma unroll
              for (int rr = 0; rr < 4; ++rr) Z[(16 * m + 4 * fqv + rr) * FP + cw + frv] = zacc[m][rr]; }
#else
        { const LAS unsigned char* X = (w < 4) ? SLOT(S_A) : SLOT(S_B); LAS float* Z = (LAS float*)(L + ((w < 4) ? O_ZW : O_ZA));
#pragma unroll
          for (int m = 0; m < 4; ++m) { f32x4 a = {0.f, 0.f, 0.f, 0.f};
#pragma unroll
              for (int kk = 0; kk < 2; ++kk) a = MFMA16(frag_n(X, 16 * m, kk, lo), bup[kk], a);
#pragma unroll
              for (int rr = 0; rr < 4; ++rr) Z[(16 * m + 4 * fqv + rr) * FP + cw + frv] = a[rr]; } }
#endif
        __syncthreads();
        float kk_[8], kp[8], bb[8], lw[8], cs[8], cb;
        { float zw[8], za[8], c0[8], c1[8];
          ld8l((const LAS float*)(L + O_ZW) + tv * FP + c8v, zw); ld8l((const LAS float*)(L + O_ZA) + tv * FP + c8v, za);
          ld8l((const LAS float*)(L + O_CST) + 5 * 64 + c8v, c0); ld8l((const LAS float*)(L + O_CST) + 6 * 64 + c8v, c1);
          float av[8];
#pragma unroll
#ifdef V_A
          for (int e = 0; e < 8; ++e) { lw[e] = -(LOG2E * 0.6065306597126334f) * __builtin_amdgcn_rcpf(1.0f + ex2(-(zw[e] + c0[e]) * LOG2E));
              av[e] = __builtin_amdgcn_rcpf(1.0f + ex2(-(za[e] + c1[e]) * LOG2E)); }
#else
          for (int e = 0; e < 8; ++e) { const float x = -(zw[e] + c0[e]); const float sp = fmaxf(x, 0.f) + LN2 * __builtin_amdgcn_logf(1.0f + ex2(-fabsf(x) * LOG2E));
              lw[e] = -LOG2E * ex2((-sp - 0.5f) * LOG2E);
              av[e] = __builtin_amdgcn_rcpf(1.0f + ex2(-(za[e] + c1[e]) * LOG2E)); }
#endif
          ld8l((const LAS float*)(L + O_CST) + 7 * 64 + c8v, c0); ld8l((const LAS float*)(L + O_CST) + 8 * 64 + c8v, c1);
          float ss = 0.f;
#pragma unroll
          for (int e = 0; e < 8; ++e) { kk_[e] = kraw[e] * c0[e]; ss += kk_[e] * kk_[e]; kp[e] = kraw[e] * (1.0f + (av[e] - 1.0f) * c1[e]); }
          ss = sum8(ss);
          const float inv = 1.0f / fmaxf(sqrtf(ss), 1e-12f);
          ld8l((const LAS float*)(L + O_CST) + 9 * 64 + c8v, c0);
          float cp = 0.f;
#pragma unroll
          for (int e = 0; e < 8; ++e) { kk_[e] *= inv; bb[e] = kk_[e] * av[e]; cp += r[e] * kp[e] * c0[e]; }
          cb = sum8(cp);
#pragma unroll
          for (int e = 0; e < 8; ++e) { float x = lw[e];
              float y = __shfl_up(x, 8); if (twv >= 1) x += y;
              y = __shfl_up(x, 16); if (twv >= 2) x += y;
              y = __shfl_up(x, 32); if (twv >= 4) x += y;
              cs[e] = x; }
          if (twv == 7) { LAS float* WT = (LAS float*)(L + O_WT) + w * 64 + c8v;
#pragma unroll
              for (int e = 0; e < 8; ++e) WT[e] = cs[e]; } }
        __syncthreads();
        { float off[8], tot[8];
#pragma unroll
          for (int e = 0; e < 8; ++e) { off[e] = 0.f; tot[e] = 0.f; }
#ifdef V_B
          { int wq = w; asm volatile("" : "+s"(wq));
#pragma unroll
            for (int g = 0; g < 8; ++g) { float x[8]; ld8l((const LAS float*)(L + O_WT) + g * 64 + c8v, x); const float mk = (g < wq) ? 1.0f : 0.0f;
#pragma unroll
                for (int e = 0; e < 8; ++e) { off[e] = __builtin_fmaf(x[e], mk, off[e]); tot[e] += x[e]; }
                if (g & 1) __builtin_amdgcn_sched_barrier(0); } }
#else
#pragma unroll
          for (int g = 0; g < 8; ++g) { float x[8]; ld8l((const LAS float*)(L + O_WT) + g * 64 + c8v, x);
#pragma unroll
              for (int e = 0; e < 8; ++e) { if (g < w) off[e] += x[e]; tot[e] += x[e]; } }
#endif
          if (tv == 0) { LAS float* CL = (LAS float*)(L + O_CL) + c8v;
#pragma unroll
              for (int e = 0; e < 8; ++e) CL[e] = tot[e]; }
          float o[8], en[8], ep[8]; const int toff = (tv * LP + c8v) * 2;
#pragma unroll
          for (int e = 0; e < 8; ++e) { cs[e] += off[e]; en[e] = ex2(-cs[e]); ep[e] = __builtin_amdgcn_rcpf(en[e]); o[e] = -kk_[e] * ep[e] * ex2(-lw[e]); }
          *(LAS u32x4*)(SLOT(S_A) + toff) = pack8(o);
#pragma unroll
          for (int e = 0; e < 8; ++e) o[e] = bb[e] * en[e];
          *(LAS u32x4*)(SLOT(S_B) + toff) = pack8(o);
#pragma unroll
          for (int e = 0; e < 8; ++e) o[e] = kp[e] * en[e];
          *(LAS u32x4*)(SLOT(S_K) + toff) = pack8(o);
#pragma unroll
          for (int e = 0; e < 8; ++e) o[e] = r[e] * ep[e];
          *(LAS u32x4*)(SLOT(S_R) + toff) = pack8(o);
#pragma unroll
          for (int e = 0; e < 8; ++e) { en[e] = ex2(tot[e] - cs[e]); o[e] = bb[e] * en[e]; }
          *(LAS u32x4*)(SLOT(S_BT) + toff) = pack8(o);
#pragma unroll
          for (int e = 0; e < 8; ++e) o[e] = kp[e] * en[e];
          *(LAS u32x4*)(SLOT(S_KT) + toff) = pack8(o);
#ifndef V_V
          *(LAS u32x4*)(SLOT(S_V) + toff) = pack8(v);
#endif
        }
        __syncthreads();
        relaunder(lo);
        int wv = w; asm volatile("" : "+s"(wv));
#if defined(LOAD_AT) && LOAD_AT == 4
        if (c + 1 < SEQ / 64) RWKV_LOAD(c + 1, tv, c8v);
#endif
#ifdef U_P4
        f32x4 tacc[5];
#pragma unroll
        for (int it = 0; it < 5; ++it) { const int task = wv + 8 * it; f32x4 a = {0.f, 0.f, 0.f, 0.f};
            if (task < 36) {
                int q, mn;
                if (task < 6) { q = 0; mn = (int)((0xEDC984ull >> (4 * task)) & 0xF); }
                else { q = 1 + (task - 6) / 10; mn = (int)((0xFEDCA98540ull >> (4 * ((task - 6) % 10))) & 0xF); }
                const int m0 = 16 * (mn >> 2), n0 = 16 * (mn & 3);
                const LAS unsigned char* XA = (q < 2) ? SLOT(S_A) : SLOT(S_R); const LAS unsigned char* XB = (q & 1) ? SLOT(S_K) : SLOT(S_B);
#pragma unroll
                for (int kk = 0; kk < 2; ++kk) a = MFMA16(frag_n(XA, m0, kk, lo), frag_n(XB, n0, kk, lo), a);
                if (m0 == n0) {
#pragma unroll
                    for (int rr = 0; rr < 4; ++rr) { const bool keep = (q < 2) ? (frv < 4 * fqv + rr) : (frv <= 4 * fqv + rr); a[rr] = keep ? a[rr] : 0.f; } } }
            tacc[it] = a; }
        if (wv < 4) {
            f32x4 a = {0.f, 0.f, 0.f, 0.f};
#pragma unroll
            for (int kk = 0; kk < 2; ++kk) a = MFMA16(frag_n(SLOT(S_A), 16 * wv, kk, lo), frag_n(SLOT(S_B), 16 * wv, kk, lo), a);
#pragma unroll
            for (int rr = 0; rr < 4; ++rr) a[rr] = (frv < 4 * fqv + rr) ? a[rr] : 0.f;
            float x[16];
            { LAS float* NS = (LAS float*)(SLOT(hnxt) + wv * 1024);
#pragma unroll
              for (int rr = 0; rr < 4; ++rr) NS[(4 * fqv + rr) * 16 + frv] = a[rr];
              asm volatile("s_waitcnt lgkmcnt(0)" ::: "memory");
#pragma unroll
              for (int rw = 0; rw < 16; ++rw) { float s = (rw == frv) ? 1.f : 0.f;
#pragma unroll
                  for (int sc = 0; sc < rw; ++sc) s = __builtin_fmaf(NS[rw * 16 + sc], x[sc], s);
                  x[rw] = s; }
              asm volatile("s_waitcnt lgkmcnt(0)" ::: "memory"); }
            if (fqv == 0) { LAS unsigned char* dp = SLOT(S_D) + ((16 * wv + frv) * LP + 16 * wv) * 2;
                float lo8[8], hi8[8];
#pragma unroll
                for (int e = 0; e < 8; ++e) { lo8[e] = x[e]; hi8[e] = x[8 + e]; }
                *(LAS u32x4*)dp = pack8(lo8); *(LAS u32x4*)(dp + 16) = pack8(hi8); }
        }
#pragma unroll
        for (int it = 0; it < 6; ++it) { const int task = wv + 8 * it;
            if (task < 36) {
                int q, mn;
                if (task < 6) { q = 0; mn = (int)((0xEDC984ull >> (4 * task)) & 0xF); }
                else { q = 1 + (task - 6) / 10; mn = (int)((0xFEDCA98540ull >> (4 * ((task - 6) % 10))) & 0xF); }
                st_tile_T(SLOT((q == 0) ? S_MOFF : (q == 1) ? S_MAK : (q == 2) ? S_MRB : S_MRK), 16 * (mn >> 2), 16 * (mn & 3), lo, tacc[it < 5 ? it : 4]);
            } else if (task < 48) {
                const int z = task - 36; const int mn = (int)((0xB76321ull >> (4 * (z % 6))) & 0xF);
                st_tile_T(SLOT((z < 6) ? S_MAK : S_MRK), 16 * (mn >> 2), 16 * (mn & 3), lo, (f32x4){0.f, 0.f, 0.f, 0.f});
            } }
#else
#ifdef V_C
        u32x4 dq[3];
#pragma unroll
        for (int j = 0; j < 3; ++j) dq[j] = *(const LAS u32x4*)(L + O_TT + wv * 48 + j * 16);
#endif
        if (wv < 4) {
            f32x4 a = {0.f, 0.f, 0.f, 0.f};
#pragma unroll
            for (int kk = 0; kk < 2; ++kk) a = MFMA16(frag_n(SLOT(S_A), 16 * wv, kk, lo), frag_n(SLOT(S_B), 16 * wv, kk, lo), a);
#pragma unroll
            for (int rr = 0; rr < 4; ++rr) a[rr] = (frv < 4 * fqv + rr) ? a[rr] : 0.f;
            float x[16];
            { LAS float* NS = (LAS float*)(SLOT(hnxt) + wv * 1024);
#pragma unroll
              for (int rr = 0; rr < 4; ++rr) NS[(4 * fqv + rr) * 16 + frv] = a[rr];
              asm volatile("s_waitcnt lgkmcnt(0)" ::: "memory");
#pragma unroll
              for (int rw = 0; rw < 16; ++rw) { float s = (rw == frv) ? 1.f : 0.f;
#pragma unroll
                  for (int sc = 0; sc < rw; ++sc) s = __builtin_fmaf(NS[rw * 16 + sc], x[sc], s);
                  x[rw] = s; }
              asm volatile("s_waitcnt lgkmcnt(0)" ::: "memory"); }
            if (fqv == 0) { LAS unsigned char* dp = SLOT(S_D) + ((16 * wv + frv) * LP + 16 * wv) * 2;
                float lo8[8], hi8[8];
#pragma unroll
                for (int e = 0; e < 8; ++e) { lo8[e] = x[e]; hi8[e] = x[8 + e]; }
                *(LAS u32x4*)dp = pack8(lo8); *(LAS u32x4*)(dp + 16) = pack8(hi8); }
        }
#ifdef V_C
        {
#pragma unroll
          for (int it = 0; it < 6; ++it) {
            const unsigned e0 = (unsigned)__builtin_amdgcn_readfirstlane((int)((it & 1) ? dq[it >> 1].z : dq[it >> 1].x)), e1 = (unsigned)__builtin_amdgcn_readfirstlane((int)((it & 1) ? dq[it >> 1].w : dq[it >> 1].y));
            const int mode = (int)(e1 >> 16); LAS unsigned char* dst = L + ((e1 & 0xffffu) << 4) + lo.bs;
            if (mode < 3) {
                const LAS unsigned char* pa = L + ((e0 & 0xffffu) << 4) + lo.bn; const LAS unsigned char* pb = L + ((e0 >> 16) << 4) + lo.bn;
                f32x4 a = MFMA16(*(const LAS bf16x8*)pa, *(const LAS bf16x8*)pb, (f32x4){0.f, 0.f, 0.f, 0.f});
                a = MFMA16(*(const LAS bf16x8*)(pa + 64), *(const LAS bf16x8*)(pb + 64), a);
                if (mode) { const int thr = frv + ((mode == 1) ? 1 : 0);
#pragma unroll
                    for (int rr = 0; rr < 4; ++rr) a[rr] = (thr <= 4 * fqv + rr) ? a[rr] : 0.f; }
                u32x2 wq_; wq_.x = pk2(a[0], a[1]); wq_.y = pk2(a[2], a[3]); *(LAS u32x2*)dst = wq_;
            } else { *(LAS u32x2*)dst = (u32x2){0u, 0u}; } } }
#else
#pragma unroll
        for (int it = 0; it < 6; ++it) { const int task = wv + 8 * it;
            if (task < 36) {
                int q, mn;
                if (task < 6) { q = 0; mn = (int)((0xEDC984ull >> (4 * task)) & 0xF); }
                else { q = 1 + (task - 6) / 10; mn = (int)((0xFEDCA98540ull >> (4 * ((task - 6) % 10))) & 0xF); }
                const int m0 = 16 * (mn >> 2), n0 = 16 * (mn & 3);
                const LAS unsigned char* XA = (q < 2) ? SLOT(S_A) : SLOT(S_R); const LAS unsigned char* XB = (q & 1) ? SLOT(S_K) : SLOT(S_B);
                f32x4 a = {0.f, 0.f, 0.f, 0.f};
#pragma unroll
                for (int kk = 0; kk < 2; ++kk) a = MFMA16(frag_n(XA, m0, kk, lo), frag_n(XB, n0, kk, lo), a);
                if (m0 == n0) {
#pragma unroll
                    for (int rr = 0; rr < 4; ++rr) { const bool keep = (q < 2) ? (frv < 4 * fqv + rr) : (frv <= 4 * fqv + rr); a[rr] = keep ? a[rr] : 0.f; } }
                st_tile_T(SLOT((q == 0) ? S_MOFF : (q == 1) ? S_MAK : (q == 2) ? S_MRB : S_MRK), m0, n0, lo, a);
            } else if (task < 48) {
                const int z = task - 36; const int mn = (int)((0xB76321ull >> (4 * (z % 6))) & 0xF);
                st_tile_T(SLOT((z < 6) ? S_MAK : S_MRK), 16 * (mn >> 2), 16 * (mn & 3), lo, (f32x4){0.f, 0.f, 0.f, 0.f});
            } }
#endif
#endif
        __syncthreads();
        relaunder(lo);
#if defined(LOAD_AT) && LOAD_AT == 5
        if (c + 1 < SEQ / 64) RWKV_LOAD(c + 1, tv, c8v);
#endif
        f32x4 yacc[4];
#ifdef U_P5
        if (w < 4) {
            f32x4 xr[4];
#pragma unroll
            for (int i = 0; i < 4; ++i) { f32x4 a = {0.f, 0.f, 0.f, 0.f};
#pragma unroll
                for (int kk = 0; kk < 2; ++kk) { if (32 * kk < 16 * i + 16) a = MFMA16(frag_t(SLOT(S_MAK), kk, 16 * i, lo), frag_t(SLOT(S_V), kk, cw, lo), a);
                    a = MFMA16(frag_n(SLOT(S_A), 16 * i, kk, lo), frag_n(SLOT(hcur), cw, kk, lo), a); }
                xr[i] = a; }
#pragma unroll
            for (int i = 0; i < 4; ++i) { f32x4 a = xr[i];
#pragma unroll
                for (int kk = 0; kk < 2; ++kk) if (32 * kk < 16 * i) a = MFMA16(frag_t(SLOT(S_MOFF), kk, 16 * i, lo), frag_n(SLOT(S_ZT), cw, kk, lo), a);
                st_tile_T(SLOT(S_ACC), 16 * i, cw, lo, a);
                asm volatile("" ::: "memory");
                const f32x4 z = MFMA16(frag_t(SLOT(S_D), i >> 1, 16 * i, lo), frag_n(SLOT(S_ACC), cw, i >> 1, lo), (f32x4){0.f, 0.f, 0.f, 0.f});
                st_tile_T(SLOT(S_ZT), 16 * i, cw, lo, z);
                asm volatile("" ::: "memory"); }
#else
        if (w < 4) {
#pragma unroll
            for (int i = 0; i < 4; ++i) { f32x4 a = {0.f, 0.f, 0.f, 0.f};
#pragma unroll
                for (int kk = 0; kk < 2; ++kk) { if (32 * kk < 16 * i + 16) a = MFMA16(frag_t(SLOT(S_MAK), kk, 16 * i, lo), frag_t(SLOT(S_V), kk, cw, lo), a);
                    a = MFMA16(frag_n(SLOT(S_A), 16 * i, kk, lo), frag_n(SLOT(hcur), cw, kk, lo), a); }
#pragma unroll
                for (int kk = 0; kk < 2; ++kk) if (32 * kk < 16 * i) a = MFMA16(frag_t(SLOT(S_MOFF), kk, 16 * i, lo), frag_n(SLOT(S_ZT), cw, kk, lo), a);
                st_tile_T(SLOT(S_ACC), 16 * i, cw, lo, a);
                const f32x4 z = MFMA16(frag_t(SLOT(S_D), i >> 1, 16 * i, lo), frag_n(SLOT(S_ACC), cw, i >> 1, lo), (f32x4){0.f, 0.f, 0.f, 0.f});
                st_tile_T(SLOT(S_ZT), 16 * i, cw, lo, z); }
#endif
        } else {
#pragma unroll
            for (int i = 0; i < 4; ++i) { f32x4 a = {0.f, 0.f, 0.f, 0.f};
#pragma unroll
                for (int kk = 0; kk < 2; ++kk) { if (32 * kk < 16 * i + 16) a = MFMA16(frag_t(SLOT(S_MRK), kk, 16 * i, lo), frag_t(SLOT(S_V), kk, cw, lo), a);
                    a = MFMA16(frag_n(SLOT(S_R), 16 * i, kk, lo), frag_n(SLOT(hcur), cw, kk, lo), a);
                }
                yacc[i] = a; }
        }
        __syncthreads();
        relaunder(lo);
#if !defined(LOAD_AT)
        if (c + 1 < SEQ / 64) RWKV_LOAD(c + 1, tv, c8v);
#endif
#ifdef U_P7
        if (w >= 4) {
#pragma unroll
            for (int i = 0; i < 4; ++i) {
#pragma unroll
                for (int rr = 0; rr < 4; ++rr) hacc[i][rr] = hacc[i][rr] * ex2(((const LAS float*)(L + O_CL))[16 * i + 4 * fqv + rr]);
#pragma unroll
                for (int kk = 0; kk < 2; ++kk) { hacc[i] = MFMA16(frag_t(SLOT(S_KT), kk, 16 * i, lo), frag_t(SLOT(S_V), kk, cw, lo), hacc[i]);
                    hacc[i] = MFMA16(frag_t(SLOT(S_BT), kk, 16 * i, lo), frag_n(SLOT(S_ZT), cw, kk, lo), hacc[i]); }
#pragma unroll
                for (int kk = 0; kk < 2; ++kk) if (32 * kk < 16 * i + 16) yacc[i] = MFMA16(frag_t(SLOT(S_MRB), kk, 16 * i, lo), frag_n(SLOT(S_ZT), cw, kk, lo), yacc[i]); }
#pragma unroll
            for (int i = 0; i < 4; ++i) { st_tile_T(SLOT(hnxt), 16 * i, cw, lo, hacc[i]);
#pragma unroll
                for (int rr = 0; rr < 4; ++rr) ((LAS float*)(L + O_YB))[(16 * i + 4 * fqv + rr) * FP + cw + frv] = yacc[i][rr]; }
        }
#else
        if (w >= 4) {
#pragma unroll
            for (int i = 0; i < 4; ++i) {
#pragma unroll
                for (int rr = 0; rr < 4; ++rr) hacc[i][rr] = hacc[i][rr] * ex2(((const LAS float*)(L + O_CL))[16 * i + 4 * fqv + rr]);
#pragma unroll
                for (int kk = 0; kk < 2; ++kk) { hacc[i] = MFMA16(frag_t(SLOT(S_KT), kk, 16 * i, lo), frag_t(SLOT(S_V), kk, cw, lo), hacc[i]);
                    hacc[i] = MFMA16(frag_t(SLOT(S_BT), kk, 16 * i, lo), frag_n(SLOT(S_ZT), cw, kk, lo), hacc[i]); }
                st_tile_T(SLOT(hnxt), 16 * i, cw, lo, hacc[i]);
#pragma unroll
                for (int kk = 0; kk < 2; ++kk) if (32 * kk < 16 * i + 16) yacc[i] = MFMA16(frag_t(SLOT(S_MRB), kk, 16 * i, lo), frag_n(SLOT(S_ZT), cw, kk, lo), yacc[i]);
#pragma unroll
                for (int rr = 0; rr < 4; ++rr) ((LAS float*)(L + O_YB))[(16 * i + 4 * fqv + rr) * FP + cw + frv] = yacc[i][rr]; }
        }
#endif
        __syncthreads();
        { float y[8], g0[8], g1[8]; ld8l((const LAS float*)(L + O_YB) + tv * FP + c8v, y); ld8l((const LAS float*)(L + O_CST) + 10 * 64 + c8v, g0); ld8l((const LAS float*)(L + O_CST) + 11 * 64 + c8v, g1);
          float s = 0.f;
#pragma unroll
          for (int e = 0; e < 8; ++e) s += y[e];
          const float mean = sum8(s) * (1.f / 64.f); float q = 0.f;
#pragma unroll
          for (int e = 0; e < 8; ++e) { y[e] -= mean; q += y[e] * y[e]; }
          const float rs = rsqrtf(sum8(q) * (1.f / 64.f) + RWKV_GN_EPS);
#ifdef V_V
          float vv[8]; unpack8(*(const LAS u32x4*)(SLOT(S_V) + (tv * LP + c8v) * 2), vv);
#pragma unroll
          for (int e = 0; e < 8; ++e) y[e] = y[e] * rs * g0[e] + g1[e] + cb * vv[e];
#else
#pragma unroll
          for (int e = 0; e < 8; ++e) y[e] = y[e] * rs * g0[e] + g1[e] + cb * v[e];
#endif
          *(u32x4*)(Yout + ((size_t)b * SEQ + c * 64 + tv) * 512 + h * 64 + c8v) = pack8(y); }
        { const int tmp = hcur; hcur = hnxt; hnxt = tmp; }
    }
    __syncthreads();
#undef SLOT
#undef RWKV_LOAD
}
}

namespace gla {
using rwkv::vtr; using rwkv::unpack8; using rwkv::pack8; using rwkv::ld8l; using rwkv::ex2; using rwkv::LOG2E; using rwkv::LN2; using rwkv::MFMA16;
constexpr int LP = 72, VP = 136, TB = 64 * LP * 2;
constexpr int B_QH = 0, B_KH = TB, B_KT = 2 * TB, B_PT = 3 * TB, B_VV = 4 * TB, B_ST = B_VV + 64 * VP * 2, B_OB = B_ST + 128 * LP * 2, B_WT = B_OB + 64 * 132 * 4,
              B_CL = B_WT + 8 * 64 * 4, B_AUP = B_CL + 64 * 4, B_AB = B_AUP + 16 * 64 * 4, B_GN = B_AB + 64 * 4, B_END = B_GN + 128 * 4;
static_assert(B_END <= 131072, "gla lds");
struct LaneOff { int bn, bt, btv, bs; };
__device__ __forceinline__ LaneOff lane_off(int fr, int fq) { LaneOff o; o.bn = (fr * LP + 8 * fq) * 2; o.bt = ((8 * fq + (fr >> 2)) * LP + 4 * (fr & 3)) * 2; o.btv = ((8 * fq + (fr >> 2)) * VP + 4 * (fr & 3)) * 2; o.bs = (fr * LP + 4 * fq) * 2; return o; }
__device__ __forceinline__ void relaunder(LaneOff& o) { asm volatile("" : "+v"(o.bn), "+v"(o.bt), "+v"(o.btv), "+v"(o.bs)); }
__device__ __forceinline__ bf16x8 frag_t(const LAS unsigned char* tile, int kk, int c0, const LaneOff& o) {
    const LAS unsigned char* q = tile + o.bt + (32 * kk * LP + c0) * 2; const s16x4 lo = vtr(q), hi = vtr(q + 4 * LP * 2); return (bf16x8){lo[0], lo[1], lo[2], lo[3], hi[0], hi[1], hi[2], hi[3]}; }
__device__ __forceinline__ bf16x8 frag_tv(const LAS unsigned char* tile, int kk, int c0, const LaneOff& o) {
    const LAS unsigned char* q = tile + o.btv + (32 * kk * VP + c0) * 2; const s16x4 lo = vtr(q), hi = vtr(q + 4 * VP * 2); return (bf16x8){lo[0], lo[1], lo[2], lo[3], hi[0], hi[1], hi[2], hi[3]}; }
__device__ __forceinline__ bf16x8 frag_n(const LAS unsigned char* tile, int r0, int kk, const LaneOff& o) { return *(const LAS bf16x8*)(tile + o.bn + (r0 * LP + 32 * kk) * 2); }
__device__ __forceinline__ void st_tile_T(LAS unsigned char* tile, int m0, int n0, const LaneOff& o, const f32x4 c) { u32x2 w; w.x = pk2(c[0], c[1]); w.y = pk2(c[2], c[3]); *(LAS u32x2*)(tile + o.bs + (n0 * LP + m0) * 2) = w; }

__device__ __forceinline__ void gla_unit(int l, int b, int h, LAS unsigned char* L, unsigned* done_ctr) {
    const Params p = load_params();
    const bf16_t* PA = (const bf16_t*)(p.ws + WS_PA); bf16_t* Yout = (bf16_t*)(p.ws + WS_YS) + (size_t)2 * T * 512;
    const int tid = opaque_tid(), lane = tid & 63, fr = lane & 15, fq = lane >> 4; const int w = __builtin_amdgcn_readfirstlane(tid >> 6);
    const int t = tid >> 3, c8 = (tid & 7) * 8;
    LaneOff lo = lane_off(fr, fq);
    for (int e = tid; e < 16 * 64; e += 512) ((LAS float*)(L + B_AUP))[e] = p.gla_a_up[(size_t)l * 16 * 256 + (e >> 6) * 256 + h * 64 + (e & 63)];
    if (tid < 64) ((LAS float*)(L + B_AB))[tid] = p.gla_a_b[l * 256 + h * 64 + tid];
    if (tid < 128) ((LAS float*)(L + B_GN))[tid] = p.gla_norm[l * 512 + h * 128 + tid];
    for (int e = tid; e < 128 * LP / 2; e += 512) ((LAS unsigned*)(L + B_ST))[e] = 0u;
    for (int e = tid; e < TB / 4; e += 512) ((LAS unsigned*)(L + B_PT))[e] = 0u;
    f32x4 sacc[4];
#pragma unroll
    for (int m = 0; m < 4; ++m) sacc[m] = (f32x4){0.f, 0.f, 0.f, 0.f};
    u32x4 rq, rk, rv0, rv1, rl0, rl1;
#define GLA_LOAD(c) do { const bf16_t* s_ = PA + ((size_t)b * SEQ + (c) * 64 + t) * NA; rq = *(const u32x4*)(s_ + GQ + h * 64 + c8); rk = *(const u32x4*)(s_ + GK + h * 64 + c8); \
        rv0 = *(const u32x4*)(s_ + GV + h * 128 + 2 * c8); rv1 = *(const u32x4*)(s_ + GV + h * 128 + 2 * c8 + 8); rl0 = *(const u32x4*)(s_ + GLAT); rl1 = *(const u32x4*)(s_ + GLAT + 8); } while (0)
    GLA_LOAD(0);
    __syncthreads();
    for (int c = 0; c < SEQ / 64; ++c) {
        int c8v = c8, tv = t, frv = fr, fqv = fq; asm volatile("" : "+v"(c8v), "+v"(tv), "+v"(frv), "+v"(fqv));
        const int twv = tv & 7;
        float cs[8];
        { float lat[16]; { float a8[8]; unpack8(rl0, a8);
#pragma unroll
              for (int j = 0; j < 8; ++j) lat[j] = a8[j];
              unpack8(rl1, a8);
#pragma unroll
              for (int j = 0; j < 8; ++j) lat[8 + j] = a8[j]; }
          float z[8]; ld8l((const LAS float*)(L + B_AB) + c8v, z);
#pragma unroll
          for (int j = 0; j < 16; ++j) { float a8[8]; ld8l((const LAS float*)(L + B_AUP) + j * 64 + c8v, a8);
#pragma unroll
              for (int e = 0; e < 8; ++e) z[e] += lat[j] * a8[e]; }
#pragma unroll
          for (int e = 0; e < 8; ++e) { const float x = -z[e]; const float sp = fmaxf(x, 0.f) + LN2 * __builtin_amdgcn_logf(1.0f + ex2(-fabsf(x) * LOG2E));
              float v_ = -sp * (LOG2E / 16.0f);
              float y = __shfl_up(v_, 8); if (twv >= 1) v_ += y;
              y = __shfl_up(v_, 16); if (twv >= 2) v_ += y;
              y = __shfl_up(v_, 32); if (twv >= 4) v_ += y;
              cs[e] = v_; }
          if (twv == 7) { LAS float* WT = (LAS float*)(L + B_WT) + w * 64 + c8v;
#pragma unroll
              for (int e = 0; e < 8; ++e) WT[e] = cs[e]; } }
        __syncthreads();
        { float off[8], tot[8];
#pragma unroll
          for (int e = 0; e < 8; ++e) { off[e] = 0.f; tot[e] = 0.f; }
#pragma unroll
          for (int g = 0; g < 8; ++g) { float x[8]; ld8l((const LAS float*)(L + B_WT) + g * 64 + c8v, x);
#pragma unroll
              for (int e = 0; e < 8; ++e) { if (g < w) off[e] += x[e]; tot[e] += x[e]; } }
          if (tv == 0) { LAS float* CL = (LAS float*)(L + B_CL) + c8v;
#pragma unroll
              for (int e = 0; e < 8; ++e) CL[e] = tot[e]; }
          float q8[8], k8[8], o[8], en[8]; unpack8(rq, q8); unpack8(rk, k8); const int toff = (tv * LP + c8v) * 2;
#pragma unroll
          for (int e = 0; e < 8; ++e) { cs[e] += off[e]; en[e] = ex2(-cs[e]); o[e] = q8[e] * 0.125f * __builtin_amdgcn_rcpf(en[e]); }
          *(LAS u32x4*)(L + B_QH + toff) = pack8(o);
#pragma unroll
          for (int e = 0; e < 8; ++e) o[e] = k8[e] * en[e];
          *(LAS u32x4*)(L + B_KH + toff) = pack8(o);
#pragma unroll
          for (int e = 0; e < 8; ++e) o[e] = k8[e] * ex2(tot[e] - cs[e]);
          *(LAS u32x4*)(L + B_KT + toff) = pack8(o);
          *(LAS u32x4*)(L + B_VV + (tv * VP + 2 * c8v) * 2) = rv0; *(LAS u32x4*)(L + B_VV + (tv * VP + 2 * c8v + 8) * 2) = rv1; }
        if (c + 1 < SEQ / 64) GLA_LOAD(c + 1);
        __syncthreads();
        relaunder(lo);
        { const int m0 = 16 * (w >> 1);
#pragma unroll
          for (int nn = 0; nn < 2; ++nn) { const int n0 = 32 * (w & 1) + 16 * nn;
              if (n0 <= m0) { f32x4 a = {0.f, 0.f, 0.f, 0.f};
#pragma unroll
                  for (int kk = 0; kk < 2; ++kk) a = MFMA16(frag_n(L + B_QH, m0, kk, lo), frag_n(L + B_KH, n0, kk, lo), a);
                  if (n0 == m0) {
#pragma unroll
                      for (int rr = 0; rr < 4; ++rr) a[rr] = (frv <= 4 * fqv + rr) ? a[rr] : 0.f; }
                  st_tile_T(L + B_PT, m0, n0, lo, a); } } }
        __syncthreads();
        relaunder(lo);
        { const int n0 = 16 * w;
#pragma unroll
          for (int m = 0; m < 4; ++m) { f32x4 a = {0.f, 0.f, 0.f, 0.f};
#pragma unroll
              for (int kk = 0; kk < 2; ++kk) { if (32 * kk < 16 * m + 16) a = MFMA16(frag_t(L + B_PT, kk, 16 * m, lo), frag_tv(L + B_VV, kk, n0, lo), a);
                  a = MFMA16(frag_n(L + B_QH, 16 * m, kk, lo), frag_n(L + B_ST, n0, kk, lo), a); }
#pragma unroll
              for (int rr = 0; rr < 4; ++rr) ((LAS float*)(L + B_OB))[(16 * m + 4 * fqv + rr) * 132 + n0 + frv] = a[rr]; }
          asm volatile("" ::: "memory");
#pragma unroll
          for (int m = 0; m < 4; ++m) { f32x4 a = sacc[m];
#pragma unroll
              for (int rr = 0; rr < 4; ++rr) a[rr] *= ex2(((const LAS float*)(L + B_CL))[16 * m + 4 * fqv + rr]);
#pragma unroll
              for (int kk = 0; kk < 2; ++kk) a = MFMA16(frag_t(L + B_KT, kk, 16 * m, lo), frag_tv(L + B_VV, kk, n0, lo), a);
              sacc[m] = a; st_tile_T(L + B_ST, 16 * m, n0, lo, a); } }
        __syncthreads();
        { float v0[8], v1[8], g0[8], g1[8]; float ss = 0.f; const LAS float* ob = (const LAS float*)(L + B_OB) + tv * 132 + 2 * c8v;
          ld8l(ob, v0); ld8l(ob + 8, v1);
#pragma unroll
          for (int e = 0; e < 8; ++e) ss += v0[e] * v0[e] + v1[e] * v1[e];
          ss = sum8(ss);
          const float rstd = rsqrtf(ss * (1.f / 128.f) + NORM_EPS);
          ld8l((const LAS float*)(L + B_GN) + 2 * c8v, g0); ld8l((const LAS float*)(L + B_GN) + 2 * c8v + 8, g1);
          float o0[8], o1[8];
#pragma unroll
          for (int e = 0; e < 8; ++e) { o0[e] = v0[e] * rstd * g0[e]; o1[e] = v1[e] * rstd * g1[e]; }
          bf16_t* dst = Yout + ((size_t)b * SEQ + c * 64 + tv) * 512 + h * 128 + 2 * c8v;
          *(u32x4*)dst = pack8(o0); *(u32x4*)(dst + 8) = pack8(o1); }
    }
    asm volatile("s_waitcnt vmcnt(0)" ::: "memory");
    __syncthreads();
    if (tid == 0) __hip_atomic_fetch_add(done_ctr, 1u, __ATOMIC_RELEASE, __HIP_MEMORY_SCOPE_AGENT);
#undef GLA_LOAD
}
}

#define XB_TMO      128
#define XB_XCNT(j)  (256  + 64 * (j))
#define XB_XSUB(j)  (1280 + 64 * (j))
#define XB_XGEN(j)  (2304 + 64 * (j))
#define XB_TOP      3328
#define XB_TOPGEN   3392
#define XCD_BAR_WORDS 3456
#define XB_SPIN_CAP (1u << 18)

__device__ __forceinline__ unsigned xb_ld(unsigned* p)              { return __hip_atomic_load(p, __ATOMIC_RELAXED, __HIP_MEMORY_SCOPE_AGENT); }
__device__ __forceinline__ unsigned xb_add(unsigned* p, unsigned v) { return __hip_atomic_fetch_add(p, v, __ATOMIC_RELAXED, __HIP_MEMORY_SCOPE_AGENT); }
__device__ __forceinline__ unsigned xb_xcc_id() { return (unsigned)__builtin_amdgcn_s_getreg((3 << 11) | 20) & 0xFu; }
#define XB_SPIN(cond, bar) do { unsigned _sp = 0; while (cond) { __builtin_amdgcn_s_sleep(1); \
    if ((++_sp & 255u) == 0u) { if (xb_ld(&(bar)[XB_TMO])) break; if (_sp > XB_SPIN_CAP) { atomicAdd(&(bar)[XB_TMO], 1u); break; } } } } while (0)

struct XcdBarrier {
    unsigned* bar; unsigned x;
    volatile LAS unsigned* st;
};

__device__ __forceinline__ XcdBarrier xcd_barrier_post(unsigned* bar, volatile LAS unsigned* st) {
    XcdBarrier b; b.bar = bar; b.x = xb_xcc_id(); b.st = st;
    if (threadIdx.x == 0) (void)xb_add(&bar[XB_XCNT(b.x)], 1u);
    return b;
}
__device__ __forceinline__ void xcd_barrier_complete(unsigned* bar, unsigned x, unsigned& nloc, unsigned& nx) {
    const unsigned G = gridDim.x * gridDim.y * gridDim.z;
    unsigned sum, cnt, mine, sp = 0u;
    for (;;) {
        sum = 0u; cnt = 0u; mine = 0u;
#pragma unroll
        for (unsigned j = 0; j < 16; ++j) { const unsigned c = xb_ld(&bar[XB_XCNT(j)]); sum += c; cnt += (c > 0u) ? 1u : 0u; mine = (j == x) ? c : mine; }
        if (sum == G) break;
        __builtin_amdgcn_s_sleep(1);
        if ((++sp & 255u) == 0u) { if (xb_ld(&bar[XB_TMO])) break; if (sp > XB_SPIN_CAP) { atomicAdd(&bar[XB_TMO], 1u); break; } }
    }
    nloc = mine > 0u ? mine : 1u; nx = cnt > 0u ? cnt : 1u;
}

__device__ __forceinline__ void xcd_barrier(const XcdBarrier& b) {
    asm volatile("s_waitcnt vmcnt(0)" ::: "memory");
    __syncthreads();
    if (threadIdx.x == 0) {
        unsigned* bar = b.bar;
        __builtin_amdgcn_s_waitcnt(0);
        unsigned nloc = b.st[0], nx = b.st[1];
        if (nloc == 0u) { xcd_barrier_complete(bar, b.x, nloc, nx); b.st[0] = nloc; b.st[1] = nx; }
        const unsigned old = xb_add(&bar[XB_XSUB(b.x)], 1u);
        const unsigned gen = old / nloc;
        if (old + 1u == (gen + 1u) * nloc) {
            __builtin_amdgcn_fence(__ATOMIC_RELEASE, "agent");
            asm volatile("s_waitcnt vmcnt(0)" ::: "memory");
            const unsigned og = xb_add(&bar[XB_TOP], 1u);
            const unsigned tg = og / nx;
            if (og + 1u == (tg + 1u) * nx) xb_add(&bar[XB_TOPGEN], 1u);
            else XB_SPIN(xb_ld(&bar[XB_TOPGEN]) == tg, bar);
            __builtin_amdgcn_fence(__ATOMIC_ACQUIRE, "agent");
            xb_add(&bar[XB_XGEN(b.x)], 1u);
            asm volatile("s_waitcnt vmcnt(0)" ::: "memory");
        } else {
            XB_SPIN(xb_ld(&bar[XB_XGEN(b.x)]) == gen, bar);
            __builtin_amdgcn_fence(__ATOMIC_ACQUIRE, "agent");
            asm volatile("s_waitcnt vmcnt(0)" ::: "memory");
        }
    }
    __syncthreads();
}

constexpr int NWAVES = 8, NTHREADS = 512;
constexpr int LDS_MISC = 155648, LDS_BYTES = 159744;
constexpr int PH_PER_LAYER = 8, N_PHASES = 1 + DEPTH * PH_PER_LAYER;
constexpr int CW_BAR = 4096;
constexpr int MG_BLOCKS = 192;
constexpr int RWKV_BLOCKS = 64, SUB_BLOCKS = 256 - RWKV_BLOCKS;
constexpr int N_ATT_UNITS = 64 * (SEQ / 512), N_MIX_ITEMS = 32 + N_ATT_UNITS;
#ifndef MK_MULTI_LAUNCH
#define MK_MULTI_LAUNCH 0
#endif

__device__ __forceinline__ void sub_barrier(unsigned* cnt, unsigned target) {
    asm volatile("s_waitcnt vmcnt(0)" ::: "memory");
    __syncthreads();
    if (threadIdx.x == 0) {
        __builtin_amdgcn_fence(__ATOMIC_RELEASE, "agent"); asm volatile("s_waitcnt vmcnt(0)" ::: "memory");
        __hip_atomic_fetch_add(cnt, 1u, __ATOMIC_RELAXED, __HIP_MEMORY_SCOPE_AGENT);
        unsigned sp = 0; while (__hip_atomic_load(cnt, __ATOMIC_RELAXED, __HIP_MEMORY_SCOPE_AGENT) < target && ++sp < (1u << 24)) __builtin_amdgcn_s_sleep(2);
        __builtin_amdgcn_fence(__ATOMIC_ACQUIRE, "agent"); asm volatile("s_waitcnt vmcnt(0)" ::: "memory");
    }
    __syncthreads();
}
__global__ void __launch_bounds__(NTHREADS, 2) hybrid_fwd(Params p_unused) {
    extern __shared__ __attribute__((aligned(16))) unsigned char lds[];
    cg::grid_group grid = cg::this_grid();
#define G ((int)gridDim.x)
#define bx ((int)blockIdx.x)
#define NGW (G * NWAVES)
#define PHASE_VARS const int tid = opaque_tid(), lane = tid & 63, wave = __builtin_amdgcn_readfirstlane(tid >> 6), gw = bx * NWAVES + wave; (void)lane; (void)gw
    LAS unsigned char* ldsl = (LAS unsigned char*)lds;
    { volatile LAS unsigned* misc = (volatile LAS unsigned*)(ldsl + LDS_MISC); if (threadIdx.x < 64) misc[threadIdx.x] = 0u; __syncthreads(); }
    (void)xcd_barrier_post((unsigned*)(kargs()->ws + WS_CTL) + CW_BAR, (volatile LAS unsigned*)(ldsl + LDS_MISC) + 8);
#define GRID_BAR() do { XcdBarrier xb_; xb_.bar = (unsigned*)(kargs()->ws + WS_CTL) + CW_BAR; xb_.x = xb_xcc_id(); xb_.st = (volatile LAS unsigned*)(ldsl + LDS_MISC) + 8; xcd_barrier(xb_); } while (0)
#ifndef EPI_ALIGN_PD1
#define EPI_ALIGN_PD1 true
#endif
#ifndef EPI_ALIGN_PA2
#define EPI_ALIGN_PA2 true
#endif
#ifndef REPEAT_PH
#define REPEAT_PH 0
#endif
#ifndef PH_MASK
#define PH_MASK 0xFFFF
#endif
#ifndef MIX_MASK
#define MIX_MASK 7
#endif
#define IN(k) true
#define EN(b) ((PH_MASK >> (b)) & 1)
#define SEAM(k) do { if (IN(k) && IN((k) + 1)) { if ((k) == 0) grid.sync(); else GRID_BAR(); } } while (0)
#define WSP(type, off) ((type*)(ws + (off)))

    if (EN(0) && IN(0)) { PHASE_VARS;
        convert_weights(0, lds, gw, NGW, wave, lane);
        KArgs kp = kargs(); unsigned char* ws = kp->ws; const int* positions = kp->positions; const float* x = kp->x; const float* g = kp->norm_pre;
        f32x2* ROPE = WSP(f32x2, WS_ROPE); bf16_t* HB = WSP(bf16_t, WS_HB);
        for (int i = bx * NTHREADS + tid; i < T * 16; i += G * NTHREADS) {
            const int t = i >> 4, j = i & 15; const float inv = exp2f(-(float)j * (13.287712379549449f / 16.0f));
            const float ang = (float)positions[t] * inv; const float k = rintf(ang * 0.15915494309189535f);
            float r = fmaf(-k, 6.2831854820251465f, ang); r = fmaf(-k, -1.7484555314695172e-7f, r);
            ROPE[i] = (f32x2){__cosf(r), __sinf(r)};
        }
        for (int m = gw; m < T; m += 4 * NGW) hb_rows4(x, g, HB, m, NGW, lane);
    }
    SEAM(0);
#ifdef EXTRA_SYNCS
    for (int i = 0; i < EXTRA_SYNCS; ++i) GRID_BAR();
#endif

    for (int l = 0; l < DEPTH; ++l) {
        const int P0 = 1 + l * PH_PER_LAYER;
        for (int rp = 0; rp < ((REPEAT_PH == 1) ? 2 : 1); ++rp) { if (rp) GRID_BAR();
        if (EN(1) && IN(P0 + 0)) {
            unsigned char* ws = kargs()->ws;
            pg8::PlainOrder S{(const char*)WSP(bf16_t, WS_HB), (const char*)WSP(bf16_t, WS_WIN), 1024, 1024, T / 256, NA / 256, G, bx, 0};
            EpiStore E{WSP(bf16_t, WS_PA), NA, ldsl};
#ifdef STAGGER_US
            if (bx >= 128) { const unsigned long long t0_ = __builtin_amdgcn_s_memrealtime(); while (__builtin_amdgcn_s_memrealtime() - t0_ < (unsigned long long)(STAGGER_US * 100)) __builtin_amdgcn_s_sleep(8); }
#endif
            pg8::gemm_phase<EpiStore, pg8::PlainOrder, true>(ldsl, pg8::Gemm{1024, 1024, 1024}, S, E);
#ifdef PROBE_PA1NULL
#endif
        }
        }
        SEAM(P0 + 0);
        if (EN(2) && IN(P0 + 1)) { PHASE_VARS;
            if (bx >= RWKV_BLOCKS) {
                unsigned char* ws = kargs()->ws; const int c2 = bx - RWKV_BLOCKS;
                { const bf16_t* PA = WSP(bf16_t, WS_PA); const f32x2* ROPE = WSP(f32x2, WS_ROPE); float* RSTDQ = WSP(float, WS_RSTD); float* RSTDKV = RSTDQ + T; bf16_t* Kb = WSP(bf16_t, WS_K);
                  for (int m = c2 * NWAVES + wave; m < T; m += 4 * SUB_BLOCKS * NWAVES) mla_prep_rows4(PA, ROPE, RSTDQ, RSTDKV, Kb, m, SUB_BLOCKS * NWAVES, lane); }
                sub_barrier((unsigned*)(ws + WS_CTL) + 64 * 40, (unsigned)SUB_BLOCKS * (unsigned)(2 * l + 1));
                { pg8::PlainOrder S{(const char*)(WSP(bf16_t, WS_PA) + CQ), (const char*)WSP(bf16_t, WS_WUQ), NA, 256, T / 256, 3, SUB_BLOCKS, c2, 0};
                  EpiQ E{WSP(bf16_t, WS_Q), WSP(float, WS_RSTD), ldsl};
                  pg8::gemm_phase<EpiQ, pg8::PlainOrder, true>(ldsl, pg8::Gemm{NA, 256, 256}, S, E); }
                { pg8::PlainOrder S{(const char*)(WSP(bf16_t, WS_PA) + CKV), (const char*)WSP(bf16_t, WS_WUKV), NA, 256, T / 256, 4, SUB_BLOCKS, c2, 0};
                  EpiKV E{WSP(bf16_t, WS_K), WSP(bf16_t, WS_V), WSP(float, WS_RSTD) + T, ldsl};
                  pg8::gemm_phase<EpiKV, pg8::PlainOrder, true>(ldsl, pg8::Gemm{NA, 256, 256}, S, E); }
                sub_barrier((unsigned*)(kargs()->ws + WS_CTL) + 64 * 40, (unsigned)SUB_BLOCKS * (unsigned)(2 * l + 2));
            } else {
#ifdef RWKV_TWICE
#pragma unroll 1
                for (int rep_ = 0; rep_ < RWKV_TWICE; ++rep_) { rwkv::rwkv_unit(l, bx >> 3, bx & 7, ldsl); __syncthreads(); }
#else
                rwkv::rwkv_unit(l, bx >> 3, bx & 7, ldsl);
#endif
                if (threadIdx.x == 0) { unsigned* cnt = (unsigned*)(kargs()->ws + WS_CTL) + 64 * 40; unsigned sp = 0;
                    while (__hip_atomic_load(cnt, __ATOMIC_RELAXED, __HIP_MEMORY_SCOPE_AGENT) < (unsigned)SUB_BLOCKS * (unsigned)(2 * l + 2) && ++sp < (1u << 24)) __builtin_amdgcn_s_sleep(2);
                    __builtin_amdgcn_fence(__ATOMIC_ACQUIRE, "agent"); asm volatile("s_waitcnt vmcnt(0)" ::: "memory"); }
                __syncthreads();
            }
        }
        if (EN(4) && IN(P0 + 3)) { PHASE_VARS;
            volatile LAS unsigned* qw = (volatile LAS unsigned*)(ldsl + LDS_MISC);
            for (;;) {
                __syncthreads();
                if (tid == 0) { unsigned* CTL = (unsigned*)(kargs()->ws + WS_CTL); qw[0] = atomicAdd(CTL + 64 * (1 + l), 1u); }
                __syncthreads();
                const int it = __builtin_amdgcn_readfirstlane((int)qw[0]);
                if (it >= N_MIX_ITEMS) break;
                if (it < 32) gla::gla_unit(l, it >> 2, it & 3, ldsl, (unsigned*)(kargs()->ws + WS_CTL) + 64 * (24 + l));
                else { const int a = it - 32; att::attn_unit((a & 63) >> 3, a & 7, (SEQ / 512 - 1) - (a >> 6), ldsl, (unsigned*)(kargs()->ws + WS_CTL) + 64 * (16 + l)); }
            }
            { unsigned* ctl = (unsigned*)(kargs()->ws + WS_CTL);
              __syncthreads();
              if (tid == 0) { const unsigned tk = __hip_atomic_fetch_add(ctl + 64 * (20 + l), 1u, __ATOMIC_RELAXED, __HIP_MEMORY_SCOPE_AGENT); qw[0] = tk;
                  if (tk < (unsigned)MG_BLOCKS) { unsigned sp = 0; while (__hip_atomic_load(ctl + 64 * (16 + l), __ATOMIC_RELAXED, __HIP_MEMORY_SCOPE_AGENT) < (unsigned)N_ATT_UNITS && ++sp < (1u << 22)) __builtin_amdgcn_s_sleep(8); }
                  __builtin_amdgcn_fence(__ATOMIC_ACQUIRE, "agent"); asm volatile("s_waitcnt vmcnt(0)" ::: "memory"); }
              __syncthreads();
              const int tk = __builtin_amdgcn_readfirstlane((int)qw[0]);
              if (tk < MG_BLOCKS) {
                  unsigned char* ws = kargs()->ws;
                  pg8::PlainOrder S{(const char*)WSP(bf16_t, WS_HB), (const char*)(WSP(bf16_t, WS_WIN) + (size_t)(NA + 1536) * 1024), 1024, 1024, T / 256, 12, MG_BLOCKS, tk, 0};
                  EpiGateMG8 E{WSP(unsigned char, WS_SMG8), ldsl};
                  pg8::gemm_phase<EpiGateMG8, pg8::PlainOrder, true>(ldsl, pg8::Gemm{1024, 1024, 1024}, S, E);
                  __syncthreads();
                  if (tid == 0) { unsigned sp = 0; while (__hip_atomic_load(ctl + 64 * (24 + l), __ATOMIC_RELAXED, __HIP_MEMORY_SCOPE_AGENT) < 32u && ++sp < (1u << 22)) __builtin_amdgcn_s_sleep(8);
                      __builtin_amdgcn_fence(__ATOMIC_ACQUIRE, "agent"); asm volatile("s_waitcnt vmcnt(0)" ::: "memory"); }
                  __syncthreads();
                  pg8::PlainOrder S2{(const char*)WSP(bf16_t, WS_HB), (const char*)(WSP(bf16_t, WS_WIN) + (size_t)NA * 1024), 1024, 1024, T / 256, 4, MG_BLOCKS, tk, 2};
                  EpiGateBG E2{WSP(bf16_t, WS_YS), 0, 2, ldsl};
                  pg8::gemm_phase<EpiGateBG, pg8::PlainOrder, true>(ldsl, pg8::Gemm{1024, 1024, 1024}, S2, E2);
              } }
        }
        SEAM(P0 + 3);
        if (EN(5) && IN(P0 + 4)) {
            unsigned char* ws = kargs()->ws;
            pg8::PlainOrder S{(const char*)WSP(bf16_t, WS_HB), (const char*)(WSP(bf16_t, WS_WIN) + (size_t)(NA + 512) * 1024), 1024, 1024, T / 256, 2, G, bx, 0};
            EpiGateBG E{WSP(bf16_t, WS_YS), 2, 0, ldsl};
            pg8::gemm_phase<EpiGateBG, pg8::PlainOrder, true>(ldsl, pg8::Gemm{1024, 1024, 1024}, S, E);
        }
        SEAM(P0 + 4);
        for (int rp = 0; rp < ((REPEAT_PH == 6 && l == 0) ? 2 : 1); ++rp) { if (rp) GRID_BAR();
        if (EN(6) && IN(P0 + 5)) {
            unsigned char* ws = kargs()->ws;
            pg8::GroupOrder3 S{(const char*)WSP(bf16_t, WS_YS), (const char*)WSP(bf16_t, WS_WBO), 512, 512, T / 256, 4, G, bx, (size_t)T * 512 * 2, (size_t)1024 * 512 * 2};
            EpiMerge E{WSP(bf16_t, WS_MG), WSP(unsigned char, WS_SMG8), ldsl};
            pg8::gemm_phase<EpiMerge, pg8::GroupOrder3, EPI_ALIGN_PD1>(ldsl, pg8::Gemm{512, 512, 512}, S, E);
        }
        }
        SEAM(P0 + 5);
        for (int rp = 0; rp < ((REPEAT_PH == 7 && l == 0) ? 2 : 1); ++rp) { if (rp) GRID_BAR();
        if (EN(7) && IN(P0 + 6)) {
            unsigned char* ws = kargs()->ws;
            pg8::PlainOrder S{(const char*)WSP(bf16_t, WS_MG), (const char*)WSP(bf16_t, WS_WOUT), 1024, 1024, T / 256, 4, G, bx, 0};
            EpiStore E{WSP(bf16_t, WS_OF), 1024, ldsl};
            pg8::gemm_phase<EpiStore, pg8::PlainOrder, true>(ldsl, pg8::Gemm{1024, 1024, 1024}, S, E);
        }
        }
        SEAM(P0 + 6);
        if (EN(8) && IN(P0 + 7)) { PHASE_VARS;
            const bool more = (l + 1 < DEPTH);
            if (more) convert_weights(l + 1, lds, gw, NGW, wave, lane);
            KArgs kp = kargs(); unsigned char* ws = kp->ws; float* out = kp->out; const float* xold = (l == 0) ? kp->x : out; const float* gpost = kp->norm_post + l * DM; const float* gnext = more ? kp->norm_pre + (l + 1) * DM : nullptr;
            const bf16_t* OF = WSP(bf16_t, WS_OF); bf16_t* HB = WSP(bf16_t, WS_HB);
#define PD3_LOOP(XI, XO) for (int m = gw; m < T; m += 4 * NGW) { RowIn<XI> rr_[4];     \
                _Pragma("unroll") for (int q_ = 0; q_ < 4; ++q_) final_load<XI>(rr_[q_], OF + (size_t)(m + q_ * NGW) * DM, xold + (size_t)(m + q_ * NGW) * DM, lane); \
                _Pragma("unroll") for (int q_ = 0; q_ < 4; ++q_) final_row<XI, XO>(rr_[q_], gpost, out + (size_t)(m + q_ * NGW) * DM, gnext, HB + (size_t)(m + q_ * NGW) * DM, lane); }
            if (l == 0) { if (more) { PD3_LOOP(false, true) } else { PD3_LOOP(false, false) } }
            else        { if (more) { PD3_LOOP(true, true) } else { PD3_LOOP(true, false) } }
#undef PD3_LOOP
        }
        if (l + 1 < DEPTH) SEAM(P0 + 7);
    }
#undef IN
#undef EN
#undef SEAM
#undef WSP
#undef PHASE_VARS
#undef G
#undef bx
#undef NGW
}

extern "C" void kernel_launch(void* const* d_in, const int* in_sizes, int n_in, void* d_out, int out_size, void* d_ws, size_t ws_size, hipStream_t stream) {
    static int grid = 0;
    if (grid == 0) {
        if (n_in != 24 || in_sizes[0] != T * DM || out_size != T * DM || ws_size < WS_END) {
            fprintf(stderr, "kernel_launch: unexpected shapes (n_in %d, in0 %d, out %d, ws %zu; need ws >= %zu); nothing launched\n", n_in, n_in > 0 ? in_sizes[0] : -1, out_size, ws_size, (size_t)WS_END);
            grid = -1; return; }
        int dev = 0, cus = 0, per_cu = 0;
        (void)hipGetDevice(&dev); (void)hipDeviceGetAttribute(&cus, hipDeviceAttributeMultiprocessorCount, dev);
        if (hipFuncSetAttribute((const void*)hybrid_fwd, hipFuncAttributeMaxDynamicSharedMemorySize, LDS_BYTES) != hipSuccess) { fprintf(stderr, "kernel_launch: hipFuncSetAttribute failed\n"); grid = -1; return; }
        if (hipOccupancyMaxActiveBlocksPerMultiprocessor(&per_cu, (const void*)hybrid_fwd, NTHREADS, LDS_BYTES) != hipSuccess || per_cu < 1) {
            fprintf(stderr, "kernel_launch: occupancy query reports %d blocks per CU\n", per_cu); per_cu = 1; }
        (void)hipGetLastError();
        grid = cus * (per_cu < 1 ? 1 : 1);
        fprintf(stderr, "kernel_launch: grid %d (cus %d, occupancy %d), ws %zu\n", grid, cus, per_cu, ws_size);
    }
    if (grid < 0) return;
    (void)hipMemsetAsync((char*)d_ws + WS_CTL, 0, 65536, stream);
    Params p{};
    p.x = (const float*)d_in[0]; p.positions = (const int*)d_in[1]; p.norm_pre = (const float*)d_in[2]; p.w_in = (const float*)d_in[3]; p.mla_q_norm = (const float*)d_in[4]; p.mla_kv_norm = (const float*)d_in[5];
    p.mla_w_uq = (const float*)d_in[6]; p.mla_w_ukv = (const float*)d_in[7]; p.rwkv_mu = (const float*)d_in[8]; p.rwkv_w0 = (const float*)d_in[9]; p.rwkv_w_up = (const float*)d_in[10]; p.rwkv_a0 = (const float*)d_in[11];
    p.rwkv_a_up = (const float*)d_in[12]; p.rwkv_k_k = (const float*)d_in[13]; p.rwkv_k_a = (const float*)d_in[14]; p.rwkv_r_k = (const float*)d_in[15]; p.rwkv_ln_w = (const float*)d_in[16]; p.rwkv_ln_b = (const float*)d_in[17];
    p.gla_a_up = (const float*)d_in[18]; p.gla_a_b = (const float*)d_in[19]; p.gla_norm = (const float*)d_in[20]; p.w_branch_out = (const float*)d_in[21]; p.w_out = (const float*)d_in[22]; p.norm_post = (const float*)d_in[23];
    p.out = (float*)d_out; p.ws = (unsigned char*)d_ws;
#if MK_MULTI_LAUNCH
    for (int ph = 0; ph < N_PHASES; ++ph) { p.ph_lo = ph; p.ph_hi = ph + 1; void* args[] = {&p};
        hipError_t e = hipLaunchCooperativeKernel((const void*)hybrid_fwd, dim3(grid), dim3(NTHREADS), args, LDS_BYTES, stream);
        if (e != hipSuccess) { fprintf(stderr, "kernel_launch: launch of phase %d failed: %s\n", ph, hipGetErrorString(e)); break; } }
#else
    p.ph_lo = 0; p.ph_hi = N_PHASES; void* args[] = {&p};
    hipError_t e = hipLaunchCooperativeKernel((const void*)hybrid_fwd, dim3(grid), dim3(NTHREADS), args, LDS_BYTES, stream);
    if (e != hipSuccess) fprintf(stderr, "kernel_launch: cooperative launch failed: %s (grid %d)\n", hipGetErrorString(e), grid);
#endif
}
```

```cpp
#include <hip/hip_runtime.h>
#include <hip/hip_cooperative_groups.h>
#include <cstdio>
#include <cstdint>
#include <cmath>
namespace cg = cooperative_groups;
#define U_P2 1
#define U_P5 1
#define U_P7 1
#define V_A 1
#define V_B 1
#define V_V 1
namespace pg8 {
#define PG8_LAS __attribute__((address_space(3)))
typedef unsigned short bf16_t;
typedef short bf16x8 __attribute__((ext_vector_type(8)));
typedef float f32x4 __attribute__((ext_vector_type(4)));
typedef unsigned u32x4 __attribute__((ext_vector_type(4)));
typedef unsigned u32x2 __attribute__((ext_vector_type(2)));
constexpr int BM = 256, BK = 64, HALF = 128, HTB = HALF * BK * 2  , STAGE_BYTES = 8 * HTB, NXCD = 8, WGM = 8;

__host__ __device__ __forceinline__ int lds_byte(int r, int c) { const int st = (r >> 4) * 2 + (c >> 5), rr = r & 15, cc = c & 31, ob = rr * 64 + cc * 2; return st * 1024 + (ob ^ (((ob >> 9) & 1) << 5)); }
__host__ __device__ __forceinline__ void stage_rc(int b, int& R, int& C) { const int st = b / 1024, sb = b % 1024, swz = sb ^ (((sb >> 9) & 1) << 5); R = (st >> 1) * 16 + swz / 64; C = (st & 1) * 32 + (swz % 64) / 2; }
__host__ __device__ __forceinline__ int perm32(int rho) { const int n = rho >> 4, i = rho & 15; return 8 * (i >> 2) + 4 * n + (i & 3); }

struct Unit { int pm, pn, aux; const char* A; const char* B; };
struct Gemm { int lda, ldb, K; };

__device__ __forceinline__ void tile_of(int L, int nM, int nN, int& pm, int& pn) {
    const int nwg = nM * nN; int wgid = L;
    { const int q = nwg / NXCD, r = nwg % NXCD, xcd = wgid % NXCD, off = wgid / NXCD; wgid = (xcd < r ? xcd * (q + 1) : r * (q + 1) + (xcd - r) * q) + off; }
    const int nig = WGM * nN, gid = wgid / nig, fm = gid * WGM, gsz = (nM - fm) < WGM ? (nM - fm) : WGM;
    pm = fm + ((wgid % nig) % gsz); pn = (wgid % nig) / gsz;
}
struct PlainOrder {
    const char* A; const char* Bt; int lda, ldb, nM, nN, G, c, bskip;
    int base = 0, cnt = -1;
    __device__ __forceinline__ bool next(int i, Unit& u) const {
        const long Lr = (long)i * G + c; if (Lr >= (long)(cnt >= 0 ? cnt : nM * nN)) return false;
        const long L = Lr + base;
        tile_of((int)L, nM, nN, u.pm, u.pn); u.aux = 0;
        u.A = A + (size_t)u.pm * BM * lda * 2; u.B = Bt + (size_t)(u.pn + ((u.pn >= 2) ? bskip : 0)) * BM * ldb * 2; return true;
    }
};
struct GroupOrder3 {
    const char* A; const char* Bt; int lda, ldb, nM, nN, G, c; size_t a_gstride, b_gstride;
    __device__ __forceinline__ bool next(int i, Unit& u) const {
        const int n = i % 3; const long L = (long)(i / 3) * G + c; if (L >= (long)nM * nN) return false;
        tile_of((int)L, nM, nN, u.pm, u.pn); u.aux = n;
        u.A = A + n * a_gstride + (size_t)u.pm * BM * lda * 2; u.B = Bt + n * b_gstride + (size_t)u.pn * BM * ldb * 2; return true;
    }
};

template <class Epi, class Sched, bool ALIGN_EPI>
__device__ __forceinline__ void gemm_phase(PG8_LAS unsigned char* lds, const Gemm g, const Sched& S, const Epi& E) {
    int tid_ = threadIdx.x; asm volatile("" : "+v"(tid_));
    const int tid = tid_, wid = __builtin_amdgcn_readfirstlane(tid >> 6), lane = tid & 63, wr = wid >> 2, wc = wid & 3, fr = lane & 15, fq = lane >> 4;
    const int K = g.K, nt = K / BK;
    unsigned voffA[2], voffB[2];
#pragma unroll
    for (int i = 0; i < 2; ++i) { int R, C; stage_rc(tid * 16 + i * 8192, R, C); const int Rb = (int)Epi::PERM == 2 ? (64 * (R >> 5) + perm32(R & 31)) : (int)Epi::PERM == 1 ? ((R & ~31) + perm32(R & 31)) : R;
        voffA[i] = (unsigned)(R * g.lda + C) * 2u; voffB[i] = (unsigned)(Rb * g.ldb + C) * 2u; }
    const size_t kstep = (size_t)(BK * 2);
    const size_t hstepA = (size_t)HALF * g.lda * 2, hstepB = (size_t)((int)Epi::PERM == 2 ? 32 : HALF) * g.ldb * 2;
    const unsigned ldsw = (unsigned)wid * 1024u;
    const int aoff = lds_byte(wr * 64 + fr, fq * 8), boff = lds_byte(wc * 32 + fr, fq * 8);
#define PG8_SA(b, h) (((b) * 2 + (h)) * HTB)
#define PG8_SB(b, h) ((4 + (b) * 2 + (h)) * HTB)
#define PG8_STAGE(bufoff, gbase, voff) do { _Pragma("unroll") for (int _i = 0; _i < 2; ++_i) \
        __builtin_amdgcn_global_load_lds((const unsigned*)((const char*)(gbase) + (voff)[_i]), (PG8_LAS unsigned*)(lds + (bufoff) + ldsw + _i * 8192), 16, 0, 0); } while (0)
#define PG8_LDA(dst, b, h) do { _Pragma("unroll") for (int m = 0; m < 4; ++m) _Pragma("unroll") for (int k = 0; k < 2; ++k) dst[m][k] = *(const PG8_LAS bf16x8*)(lds + PG8_SA(b, h) + aoff + m * 2048 + k * 1024); } while (0)
#define PG8_LDB(dst, b, h) do { _Pragma("unroll") for (int n = 0; n < 2; ++n) _Pragma("unroll") for (int k = 0; k < 2; ++k) dst[n][k] = *(const PG8_LAS bf16x8*)(lds + PG8_SB(b, h) + boff + n * 2048 + k * 1024); } while (0)
#define PG8_MMA(ai, bj, At, Bt) do { __builtin_amdgcn_s_setprio(1); _Pragma("unroll") for (int m = 0; m < 4; ++m) _Pragma("unroll") for (int n = 0; n < 2; ++n) _Pragma("unroll") for (int k = 0; k < 2; ++k) \
        acc[ai][bj][m][n] = __builtin_amdgcn_mfma_f32_16x16x32_bf16(Bt[n][k], At[m][k], acc[ai][bj][m][n], 0, 0, 0); __builtin_amdgcn_s_setprio(0); } while (0)
#define PG8_WAIT_V(n) asm volatile("s_waitcnt vmcnt(" #n ")" ::: "memory")
#define PG8_WAIT_L(n) asm volatile("s_waitcnt lgkmcnt(" #n ")" ::: "memory")
#define PG8_BAR __builtin_amdgcn_s_barrier()
#define PG8_SCHED __builtin_amdgcn_sched_barrier(0)
    Unit cur, nxt; int ui = 0;
    if (!S.next(0, cur)) return;
    f32x4 acc[2][2][4][2];
#pragma unroll
    for (int a = 0; a < 2; ++a)
#pragma unroll
        for (int b = 0; b < 2; ++b)
#pragma unroll
            for (int m = 0; m < 4; ++m)
#pragma unroll
                for (int n = 0; n < 2; ++n) acc[a][b][m][n] = (f32x4){0.f, 0.f, 0.f, 0.f};
    bf16x8 At[4][2], B0[2][2], B1[2][2];
    const char* cA = cur.A; const char* cB = cur.B;
    PG8_STAGE(PG8_SB(0, 0), cB, voffB); PG8_STAGE(PG8_SB(0, 1), cB + hstepB, voffB); PG8_STAGE(PG8_SA(0, 0), cA, voffA); PG8_STAGE(PG8_SA(0, 1), cA + hstepA, voffA);
    if (wr == 1) PG8_BAR;
    PG8_WAIT_V(2); PG8_BAR;
    PG8_STAGE(PG8_SB(1, 0), cB + kstep, voffB); PG8_STAGE(PG8_SA(1, 0), cA + kstep, voffA); PG8_STAGE(PG8_SB(1, 1), cB + hstepB + kstep, voffB);
    PG8_WAIT_V(6); PG8_BAR;
    for (;;) {
        const bool has_next = S.next(ui + 1, nxt);
        const char* nA = has_next ? nxt.A : cA; const char* nB = has_next ? nxt.B : cB;
#pragma unroll 1
        for (int t = 0; t < nt; t += 2) {
            const bool last = (t == nt - 2);
            const char* a1 = cA + (size_t)(t + 1) * kstep;
            const char* a2 = last ? nA : cA + (size_t)(t + 2) * kstep; const char* b2 = last ? nB : cB + (size_t)(t + 2) * kstep;
            const char* a3 = a2 + kstep; const char* b3 = b2 + kstep;
            PG8_LDB(B0, 0, 0); PG8_LDB(B1, 0, 1); PG8_SCHED; PG8_LDA(At, 0, 0); PG8_STAGE(PG8_SA(1, 1), a1 + hstepA, voffA);
            PG8_WAIT_V(8); PG8_WAIT_L(0); PG8_BAR; PG8_MMA(0, 0, At, B0); PG8_MMA(0, 1, At, B1); PG8_BAR; PG8_SCHED;
            PG8_LDA(At, 0, 1); PG8_STAGE(PG8_SB(0, 0), b2, voffB); PG8_STAGE(PG8_SB(0, 1), b2 + hstepB, voffB); PG8_STAGE(PG8_SA(0, 0), a2, voffA);
            PG8_WAIT_V(8); PG8_WAIT_L(0); PG8_BAR; PG8_MMA(1, 0, At, B0); PG8_MMA(1, 1, At, B1); PG8_BAR; PG8_SCHED;
            PG8_LDB(B0, 1, 0); PG8_LDB(B1, 1, 1); PG8_SCHED; PG8_LDA(At, 1, 0); PG8_STAGE(PG8_SA(0, 1), a2 + hstepA, voffA);
            PG8_WAIT_V(8); PG8_WAIT_L(0); PG8_BAR; PG8_MMA(0, 0, At, B0); PG8_MMA(0, 1, At, B1); PG8_BAR; PG8_SCHED;
            PG8_LDA(At, 1, 1); PG8_STAGE(PG8_SB(1, 0), b3, voffB); PG8_STAGE(PG8_SB(1, 1), b3 + hstepB, voffB); PG8_STAGE(PG8_SA(1, 0), a3, voffA);
            PG8_WAIT_V(8); PG8_WAIT_L(0); PG8_BAR; PG8_MMA(1, 0, At, B0); PG8_MMA(1, 1, At, B1); PG8_BAR; PG8_SCHED;
        }
        if constexpr (ALIGN_EPI) { if (wr == 0) PG8_BAR; }
        E(acc, cur, wr, wc, fr, fq);
        if (!has_next) break;
#pragma unroll
        for (int a = 0; a < 2; ++a)
#pragma unroll
            for (int b = 0; b < 2; ++b)
#pragma unroll
                for (int m = 0; m < 4; ++m)
#pragma unroll
                    for (int n = 0; n < 2; ++n) acc[a][b][m][n] = (f32x4){0.f, 0.f, 0.f, 0.f};
        cur = nxt; cA = nA; cB = nB; ++ui;
        if constexpr (ALIGN_EPI) { if (wr == 1) PG8_BAR; }
    }
    PG8_WAIT_V(0);
    if constexpr (!ALIGN_EPI) { if (wr == 0) PG8_BAR; }
    PG8_BAR;
#undef PG8_SA
#undef PG8_SB
#undef PG8_STAGE
#undef PG8_LDA
#undef PG8_LDB
#undef PG8_MMA
#undef PG8_WAIT_V
#undef PG8_WAIT_L
#undef PG8_BAR
#undef PG8_SCHED
}
}
#define LAS __attribute__((address_space(3)))
typedef unsigned short bf16_t;
typedef short bf16x8 __attribute__((ext_vector_type(8)));
typedef short s16x4 __attribute__((ext_vector_type(4)));
typedef float f32x4 __attribute__((ext_vector_type(4)));
typedef float f32x2 __attribute__((ext_vector_type(2)));
typedef float f32x16 __attribute__((ext_vector_type(16)));
typedef unsigned u32x4 __attribute__((ext_vector_type(4)));
typedef unsigned u32x2 __attribute__((ext_vector_type(2)));
typedef __bf16 bf16x2_t __attribute__((ext_vector_type(2)));

constexpr int BATCH = 8, SEQ = 4096, DM = 1024, T = BATCH * SEQ, DEPTH = 2;
constexpr int N_IN = 7728, NA = 3328, NG = 4608, NALL = NA + NG;
constexpr int CQ = 0, CKV = 256, KROPE = 384, GLAT = 416, RW_R = 512, RW_K = 1024, RW_V = 1536, RW_LW = 2048, RW_LA = 2112, GQ = 2304, GK = 2560, GV = 2816;
constexpr int KP = 544;
constexpr float NORM_EPS = 1e-6f, RWKV_GN_EPS = 64e-5f;
constexpr float QSCALE = 0.10206207261596577f * 1.4426950408889634f;

constexpr size_t MiB = 1u << 20;
constexpr size_t WS_CTL = 0;
constexpr size_t WS_ROPE = 1 * MiB;
constexpr size_t WS_RSTD = 5 * MiB;
constexpr size_t WS_WIN = 6 * MiB;
constexpr size_t WS_WBO = WS_WIN + (size_t)NALL * 1024 * 2;
constexpr size_t WS_WOUT = WS_WBO + 3 * MiB;
constexpr size_t WS_WUQ = WS_WOUT + 2 * MiB;
constexpr size_t WS_WUKV = WS_WUQ + 768 * 256 * 2;
constexpr size_t WS_HB = 28 * MiB;
constexpr size_t WS_PA = 92 * MiB;
constexpr size_t WS_Q = 300 * MiB;
constexpr size_t WS_K = 348 * MiB;
constexpr size_t WS_V = 382 * MiB;
constexpr size_t WS_YS = 414 * MiB;
constexpr size_t WS_SMG8 = WS_Q;
constexpr size_t WS_MG = WS_PA, WS_OF = WS_PA + 64 * MiB;
constexpr size_t WS_END = 510 * MiB;
static_assert(WS_WUKV + 1024 * 256 * 2 <= WS_HB, "weights fit");

__device__ __forceinline__ unsigned pk2(float lo, float hi) { f32x2 v = {lo, hi}; bf16x2_t b = __builtin_convertvector(v, bf16x2_t); return __builtin_bit_cast(unsigned, b); }
__device__ __forceinline__ float bflo(unsigned w) { return __uint_as_float(w << 16); }
__device__ __forceinline__ float bfhi(unsigned w) { return __uint_as_float(w & 0xffff0000u); }
__device__ __forceinline__ float bf2f(bf16_t b) { return __uint_as_float((unsigned)b << 16); }
__device__ __forceinline__ bf16_t f2bf(float f) { return (bf16_t)(pk2(f, 0.f) & 0xffffu); }
__device__ __forceinline__ float wave_sum(float v) {
#pragma unroll
    for (int o = 1; o < 64; o <<= 1) v += __shfl_xor(v, o);
    return v;
}
__device__ __forceinline__ float fast_exp(float x) { return __builtin_amdgcn_exp2f(x * 1.4426950408889634f); }
__device__ __forceinline__ float fast_sigmoid(float x) { return __builtin_amdgcn_rcpf(1.0f + fast_exp(-x)); }
template <int CTRL> __device__ __forceinline__ float dpp_f(float x) { return __int_as_float(__builtin_amdgcn_update_dpp(0, __float_as_int(x), CTRL, 0xf, 0xf, false)); }
__device__ __forceinline__ float sum8(float x) { x += dpp_f<0xB1>(x); x += dpp_f<0x4E>(x); x += dpp_f<0x141>(x); return x; }
__device__ __forceinline__ float sum16(float x) { x += dpp_f<0xB1>(x); x += dpp_f<0x4E>(x); x += dpp_f<0x141>(x); x += dpp_f<0x140>(x); return x; }

struct Params {
    const float* x; const int* positions; const float* norm_pre; const float* w_in; const float* mla_q_norm; const float* mla_kv_norm; const float* mla_w_uq; const float* mla_w_ukv;
    const float* rwkv_mu; const float* rwkv_w0; const float* rwkv_w_up; const float* rwkv_a0; const float* rwkv_a_up; const float* rwkv_k_k; const float* rwkv_k_a; const float* rwkv_r_k;
    const float* rwkv_ln_w; const float* rwkv_ln_b; const float* gla_a_up; const float* gla_a_b; const float* gla_norm; const float* w_branch_out; const float* w_out; const float* norm_post;
    float* out; unsigned char* ws; int ph_lo, ph_hi;
};

typedef const __attribute__((address_space(4))) Params* KArgs;
__device__ __forceinline__ KArgs kargs() { KArgs kp = (KArgs)__builtin_amdgcn_kernarg_segment_ptr(); asm volatile("" : "+s"(kp)); return kp; }

__device__ __forceinline__ Params load_params() { Params p{}; KArgs kp = kargs(); p.x = kp->x; p.positions = kp->positions; p.norm_pre = kp->norm_pre; p.w_in = kp->w_in; p.mla_q_norm = kp->mla_q_norm; p.mla_kv_norm = kp->mla_kv_norm; p.mla_w_uq = kp->mla_w_uq; p.mla_w_ukv = kp->mla_w_ukv; p.rwkv_mu = kp->rwkv_mu; p.rwkv_w0 = kp->rwkv_w0; p.rwkv_w_up = kp->rwkv_w_up; p.rwkv_a0 = kp->rwkv_a0; p.rwkv_a_up = kp->rwkv_a_up; p.rwkv_k_k = kp->rwkv_k_k; p.rwkv_k_a = kp->rwkv_k_a; p.rwkv_r_k = kp->rwkv_r_k; p.rwkv_ln_w = kp->rwkv_ln_w; p.rwkv_ln_b = kp->rwkv_ln_b; p.gla_a_up = kp->gla_a_up; p.gla_a_b = kp->gla_a_b; p.gla_norm = kp->gla_norm; p.w_branch_out = kp->w_branch_out; p.w_out = kp->w_out; p.norm_post = kp->norm_post; p.out = kp->out; p.ws = kp->ws; p.ph_lo = kp->ph_lo; p.ph_hi = kp->ph_hi; return p; }
__device__ __forceinline__ int opaque_tid() { int t = threadIdx.x; asm volatile("" : "+v"(t)); return t; }

using pg8::Unit;
constexpr int EPI_SCR = 131072, EPI_SCR_WAVE = 2304, EPI_PITCH = 144;
struct EpiGeo { LAS unsigned char* wp; const LAS unsigned char* rp; int r8, p8; };
__device__ __forceinline__ EpiGeo epi_geo(LAS unsigned char* lds, int wr, int wc, int fr, int fq) {
    LAS unsigned char* scr = lds + EPI_SCR + (wr * 4 + wc) * EPI_SCR_WAVE; const int lane = fq * 16 + fr;
    return EpiGeo{scr + fr * EPI_PITCH + fq * 16, scr + (lane >> 3) * EPI_PITCH + (lane & 7) * 16, lane >> 3, lane & 7};
}
__device__ __forceinline__ void epi_xpose(const EpiGeo& g, const u32x4 w0, const u32x4 w1, u32x4& r0, u32x4& r1) {
    *(LAS u32x4*)g.wp = w0; *(LAS u32x4*)(g.wp + 64) = w1;
    asm volatile("" ::: "memory");
    r0 = *(const LAS u32x4*)g.rp; r1 = *(const LAS u32x4*)(g.rp + 8 * EPI_PITCH);
    asm volatile("" ::: "memory");
}
__device__ __forceinline__ u32x4 pack8(const f32x4 v0, const f32x4 v1) { u32x4 w; w.x = pk2(v0[0], v0[1]); w.y = pk2(v0[2], v0[3]); w.z = pk2(v1[0], v1[1]); w.w = pk2(v1[2], v1[3]); return w; }
struct EpiStore {
    static constexpr int PERM = 2; bf16_t* O; int ldc; LAS unsigned char* lds; int skip;
    __device__ __forceinline__ void operator()(const f32x4 (&acc)[2][2][4][2], const Unit& u, int wr, int wc, int fr, int fq) const {
        const EpiGeo G = epi_geo(lds, wr, wc, fr, fq);
        bf16_t* gp = O + (size_t)(u.pm * 256 + wr * 64 + G.r8) * ldc + (u.pn + ((u.pn >= 2) ? skip : 0)) * 256 + wc * 64 + G.p8 * 8;
#pragma unroll
        for (int ai = 0; ai < 2; ++ai)
#pragma unroll
            for (int m = 0; m < 4; ++m) { u32x4 r0, r1; epi_xpose(G, pack8(acc[ai][0][m][0], acc[ai][0][m][1]), pack8(acc[ai][1][m][0], acc[ai][1][m][1]), r0, r1);
                bf16_t* g = gp + (size_t)(ai * 128 + m * 16) * ldc;
                *(u32x4*)g = r0; *(u32x4*)(g + (size_t)8 * ldc) = r1; }
    }
};
struct EpiQ {
    static constexpr int PERM = 2; bf16_t* Q; const float* rstd; LAS unsigned char* lds;
    __device__ __forceinline__ void operator()(const f32x4 (&acc)[2][2][4][2], const Unit& u, int wr, int wc, int fr, int fq) const {
        const EpiGeo G = epi_geo(lds, wr, wc, fr, fq);
        const int row0 = u.pm * 256 + wr * 64 + fr;
        float rsv[2][4];
#pragma unroll
        for (int ai = 0; ai < 2; ++ai)
#pragma unroll
            for (int m = 0; m < 4; ++m) rsv[ai][m] = rstd[row0 + ai * 128 + m * 16];
        bf16_t* gp = Q + (size_t)(u.pm * 256 + wr * 64 + G.r8) * 768 + u.pn * 256 + wc * 64 + G.p8 * 8;
#pragma unroll
        for (int ai = 0; ai < 2; ++ai)
#pragma unroll
            for (int m = 0; m < 4; ++m) { const float rs = rsv[ai][m] * QSCALE; u32x4 r0, r1;
                epi_xpose(G, pack8(acc[ai][0][m][0] * rs, acc[ai][0][m][1] * rs), pack8(acc[ai][1][m][0] * rs, acc[ai][1][m][1] * rs), r0, r1);
                bf16_t* g = gp + (size_t)(ai * 128 + m * 16) * 768;
                *(u32x4*)g = r0; *(u32x4*)(g + (size_t)8 * 768) = r1; }
    }
};
struct EpiKV {
    static constexpr int PERM = 2; bf16_t* Kb; bf16_t* Vb; const float* rstd; LAS unsigned char* lds;
    __device__ __forceinline__ void operator()(const f32x4 (&acc)[2][2][4][2], const Unit& u, int wr, int wc, int fr, int fq) const {
        const EpiGeo G = epi_geo(lds, wr, wc, fr, fq);
        const int row0 = u.pm * 256 + wr * 64 + fr; const bool isv = u.pn >= 2; const int ldc = isv ? 512 : KP;
        float rsv[2][4];
#pragma unroll
        for (int ai = 0; ai < 2; ++ai)
#pragma unroll
            for (int m = 0; m < 4; ++m) rsv[ai][m] = rstd[row0 + ai * 128 + m * 16];
        bf16_t* gp = (isv ? Vb : Kb) + (size_t)(u.pm * 256 + wr * 64 + G.r8) * ldc + (u.pn & 1) * 256 + wc * 64 + G.p8 * 8;
#pragma unroll
        for (int ai = 0; ai < 2; ++ai)
#pragma unroll
            for (int m = 0; m < 4; ++m) { const float rs = rsv[ai][m]; u32x4 r0, r1;
                epi_xpose(G, pack8(acc[ai][0][m][0] * rs, acc[ai][0][m][1] * rs), pack8(acc[ai][1][m][0] * rs, acc[ai][1][m][1] * rs), r0, r1);
                bf16_t* g = gp + (size_t)(ai * 128 + m * 16) * ldc;
                *(u32x4*)g = r0; *(u32x4*)(g + (size_t)8 * ldc) = r1; }
    }
};
__device__ __forceinline__ unsigned q8(float s) { return (unsigned)(s * 255.0f + 0.5f); }
__device__ __forceinline__ f32x4 silu4(const f32x4 a) { f32x4 r; r[0] = fast_sigmoid(a[0]) * a[0]; r[1] = fast_sigmoid(a[1]) * a[1]; r[2] = fast_sigmoid(a[2]) * a[2]; r[3] = fast_sigmoid(a[3]) * a[3]; return r; }
struct EpiGateBG {
    static constexpr int PERM = 2; bf16_t* YS; int pn0, skip; LAS unsigned char* lds;
    __device__ __forceinline__ void operator()(const f32x4 (&acc)[2][2][4][2], const Unit& u, int wr, int wc, int fr, int fq) const {
        const int pn = pn0 + u.pn + ((u.pn >= 2) ? skip : 0);
        const EpiGeo G = epi_geo(lds, wr, wc, fr, fq);
        bf16_t* gp = YS + (size_t)(pn >> 1) * T * 512 + (size_t)(u.pm * 256 + wr * 64 + G.r8) * 512 + (pn & 1) * 256 + wc * 64 + G.p8 * 8;
#pragma unroll
        for (int ai = 0; ai < 2; ++ai) {
            u32x4 y[4][2];
#pragma unroll
            for (int m = 0; m < 4; ++m)
#pragma unroll
                for (int h = 0; h < 2; ++h) y[m][h] = *(const u32x4*)(gp + (size_t)(ai * 128 + m * 16 + 8 * h) * 512);
#pragma unroll
            for (int m = 0; m < 4; ++m) { u32x4 r[2];
                epi_xpose(G, pack8(silu4(acc[ai][0][m][0]), silu4(acc[ai][0][m][1])), pack8(silu4(acc[ai][1][m][0]), silu4(acc[ai][1][m][1])), r[0], r[1]);
#pragma unroll
                for (int h = 0; h < 2; ++h) { const u32x4 yy = y[m][h], gg = r[h];
                    u32x4 w; w.x = pk2(bflo(gg.x) * bflo(yy.x), bfhi(gg.x) * bfhi(yy.x)); w.y = pk2(bflo(gg.y) * bflo(yy.y), bfhi(gg.y) * bfhi(yy.y));
                    w.z = pk2(bflo(gg.z) * bflo(yy.z), bfhi(gg.z) * bfhi(yy.z)); w.w = pk2(bflo(gg.w) * bflo(yy.w), bfhi(gg.w) * bfhi(yy.w));
                    *(u32x4*)(gp + (size_t)(ai * 128 + m * 16 + 8 * h) * 512) = w; } }
        }
    }
};
struct EpiGateMG8 {
    static constexpr int PERM = 2; unsigned char* SMG; LAS unsigned char* lds;
    __device__ __forceinline__ void operator()(const f32x4 (&acc)[2][2][4][2], const Unit& u, int wr, int wc, int fr, int fq) const {
        LAS unsigned char* scr = lds + EPI_SCR + (wr * 4 + wc) * EPI_SCR_WAVE; const int lane = fq * 16 + fr;
        LAS unsigned char* wp = scr + fr * 72 + fq * 8; const LAS unsigned char* rp = scr + (lane >> 2) * 72 + (lane & 3) * 16;
        unsigned char* gp = SMG + (size_t)((u.pm * 256 + wr * 64) >> 1) * 6144 + (size_t)(lane >> 3) * 6144 + (u.pn * 4 + wc) * 128 + ((lane >> 2) & 1) * 64 + (lane & 3) * 16;
#pragma unroll
        for (int ai = 0; ai < 2; ++ai)
#pragma unroll
            for (int m = 0; m < 4; ++m) {
#pragma unroll
                for (int bj = 0; bj < 2; ++bj) { const f32x4 a0 = acc[ai][bj][m][0], a1 = acc[ai][bj][m][1];
                    u32x2 w = {0u, 0u};
#pragma unroll
                    for (int j = 0; j < 4; ++j) { w.x = __builtin_amdgcn_cvt_pk_u8_f32(255.0f * fast_sigmoid(a0[j]), j, w.x); w.y = __builtin_amdgcn_cvt_pk_u8_f32(255.0f * fast_sigmoid(a1[j]), j, w.y); }
                    *(LAS u32x2*)(wp + bj * 32) = w; }
                asm volatile("" ::: "memory");
                const u32x2 ra = *(const LAS u32x2*)rp, rb = *(const LAS u32x2*)(rp + 8);
                asm volatile("" ::: "memory");
                *(u32x4*)(gp + (size_t)(ai * 64 + m * 8) * 6144) = (u32x4){ra.x, ra.y, rb.x, rb.y}; }
    }
};
struct EpiMerge {
    static constexpr int PERM = 2; bf16_t* MG; const unsigned char* SMG; LAS unsigned char* lds;
    __device__ __forceinline__ void operator()(const f32x4 (&acc)[2][2][4][2], const Unit& u, int wr, int wc, int fr, int fq) const {
        const EpiGeo G = epi_geo(lds, wr, wc, fr, fq); const int n = u.aux; constexpr float S = 1.0f / 255.0f;
        const size_t rowb = (size_t)(u.pm * 256 + wr * 64 + G.r8); const int colb = u.pn * 256 + wc * 64 + G.p8 * 8;
        const unsigned char* sp = SMG + (rowb >> 1) * 6144 + (size_t)(n * 16 + u.pn * 4 + wc) * 128 + (rowb & 1) * 64 + G.p8 * 8; bf16_t* mp = MG + rowb * 1024 + colb;
#pragma unroll
        for (int ai = 0; ai < 2; ++ai) {
            u32x2 g[4][2]; u32x4 y[4][2];
#pragma unroll
            for (int m = 0; m < 4; ++m)
#pragma unroll
                for (int h = 0; h < 2; ++h) { g[m][h] = *(const u32x2*)(sp + (size_t)(ai * 64 + m * 8 + 4 * h) * 6144); if (n > 0) y[m][h] = *(const u32x4*)(mp + (size_t)(ai * 128 + m * 16 + 8 * h) * 1024); }
#pragma unroll
            for (int m = 0; m < 4; ++m) { u32x4 r[2];
                epi_xpose(G, pack8(acc[ai][0][m][0], acc[ai][0][m][1]), pack8(acc[ai][1][m][0], acc[ai][1][m][1]), r[0], r[1]);
#pragma unroll
                for (int h = 0; h < 2; ++h) { const u32x2 gg = g[m][h]; const u32x4 aa = r[h];
                    float v[8] = {bflo(aa.x) * (S * (float)(gg.x & 0xffu)), bfhi(aa.x) * (S * (float)((gg.x >> 8) & 0xffu)), bflo(aa.y) * (S * (float)((gg.x >> 16) & 0xffu)), bfhi(aa.y) * (S * (float)(gg.x >> 24)),
                                  bflo(aa.z) * (S * (float)(gg.y & 0xffu)), bfhi(aa.z) * (S * (float)((gg.y >> 8) & 0xffu)), bflo(aa.w) * (S * (float)((gg.y >> 16) & 0xffu)), bfhi(aa.w) * (S * (float)(gg.y >> 24))};
                    if (n > 0) { const u32x4 yy = y[m][h];
                        v[0] += bflo(yy.x); v[1] += bfhi(yy.x); v[2] += bflo(yy.y); v[3] += bfhi(yy.y); v[4] += bflo(yy.z); v[5] += bfhi(yy.z); v[6] += bflo(yy.w); v[7] += bfhi(yy.w); }
                    u32x4 w; w.x = pk2(v[0], v[1]); w.y = pk2(v[2], v[3]); w.z = pk2(v[4], v[5]); w.w = pk2(v[6], v[7]);
                    *(u32x4*)(mp + (size_t)(ai * 128 + m * 16 + 8 * h) * 1024) = w; } }
        }
    }
};
struct EpiF32 {
    static constexpr bool PERM = false; float* O; int ldc;
    __device__ __forceinline__ void operator()(const f32x4 (&acc)[2][2][4][2], const Unit& u, int wr, int wc, int fr, int fq) const {
        const int row0 = u.pm * 256 + wr * 64 + fr, col0 = u.pn * 256 + wc * 32 + 4 * fq;
#pragma unroll
        for (int ai = 0; ai < 2; ++ai)
#pragma unroll
            for (int m = 0; m < 4; ++m) { float* rowp = O + (size_t)(row0 + ai * 128 + m * 16) * ldc + col0;
#pragma unroll
                for (int bj = 0; bj < 2; ++bj)
#pragma unroll
                    for (int n = 0; n < 2; ++n) *(f32x4*)(rowp + bj * 128 + n * 16) = acc[ai][bj][m][n]; }
    }
};

template <class SrcCol>
__device__ __forceinline__ void transpose_item(const float* W, int Ksrc, int Nsrc, bf16_t* WT, int Kdst, int item, int nblk, float* scr, int lane, SrcCol src, const float* kscale) {
    const int kb = item / nblk, nb = item % nblk, k0 = 64 * kb, n0 = 32 * nb;
    const int sc = src(n0 + (lane & 31));
    float vv[32];
#pragma unroll
    for (int i = 0; i < 32; ++i) { const int k = k0 + 2 * i + (lane >> 5); float v = 0.f;
        if (sc >= 0 && k < Ksrc) { v = W[(size_t)k * Nsrc + sc]; if (kscale) v *= kscale[k]; }
        vv[i] = v; }
#pragma unroll
    for (int i = 0; i < 32; ++i) scr[(2 * i + (lane >> 5)) * 33 + (lane & 31)] = vv[i];
    asm volatile("s_waitcnt lgkmcnt(0)" ::: "memory");
    const int c = lane & 7;
#pragma unroll
    for (int j = 0; j < 4; ++j) { const int n = (lane >> 3) + 8 * j; const float* s = scr + (8 * c) * 33 + n;
        u32x4 o; o.x = pk2(s[0 * 33], s[1 * 33]); o.y = pk2(s[2 * 33], s[3 * 33]); o.z = pk2(s[4 * 33], s[5 * 33]); o.w = pk2(s[6 * 33], s[7 * 33]);
        *(u32x4*)(WT + (size_t)(n0 + n) * Kdst + k0 + 8 * c) = o; }
    asm volatile("s_waitcnt lgkmcnt(0)" ::: "memory");
}
__device__ __forceinline__ int win_src(int j) {
    if (j < 416) return j;
    if (j < 432) return 3104 + (j - 416);
    if (j < 512) return -1;
    if (j < 2048) return 416 + (j - 512);
    if (j < 2176) return 1952 + (j - 2048);
    if (j < 2304) return -1;
    if (j < 3328) return 2080 + (j - 2304);
    return 3120 + (j - 3328);
}
__device__ __forceinline__ int wuq_src(int j) { const int h = j / 96, c = j % 96; if (c < 64) return h * 96 + c; const int r = c - 64; return h * 96 + 64 + (r & 1) * 16 + (r >> 1); }
__device__ __forceinline__ int wukv_src(int j) { return j < 512 ? (j >> 6) * 128 + (j & 63) : ((j - 512) >> 6) * 128 + 64 + (j & 63); }

__device__ __forceinline__ void convert_weights(int l, unsigned char* lds, int gw, int NGW, int wave, int lane) {
    float* scr = (float*)(lds + wave * 8448); const Params p = load_params();
    bf16_t* WinT = (bf16_t*)(p.ws + WS_WIN); bf16_t* WboT = (bf16_t*)(p.ws + WS_WBO); bf16_t* WoutT = (bf16_t*)(p.ws + WS_WOUT); bf16_t* WuqT = (bf16_t*)(p.ws + WS_WUQ); bf16_t* WukvT = (bf16_t*)(p.ws + WS_WUKV);
    constexpr int I_IN = 16 * (NALL / 32), I_BO = 8 * 32, I_OUT = 16 * 32, I_UQ = 4 * 24, I_UKV = 4 * 32;
    constexpr int NITEMS = I_IN + 3 * I_BO + I_OUT + I_UQ + I_UKV;
    for (int it = gw; it < NITEMS; it += NGW) {
        int r = it;
        if (r < I_IN) { transpose_item(p.w_in + (size_t)l * 1024 * N_IN, 1024, N_IN, WinT, 1024, r, NALL / 32, scr, lane, [](int j) { return win_src(j); }, nullptr); continue; } r -= I_IN;
        if (r < 3 * I_BO) { const int n = r / I_BO; r -= n * I_BO;
            transpose_item(p.w_branch_out + ((size_t)l * 3 + n) * 512 * 1024, 512, 1024, WboT + (size_t)n * 1024 * 512, 512, r, 32, scr, lane, [](int j) { return j; }, nullptr); continue; } r -= 3 * I_BO;
        if (r < I_OUT) { transpose_item(p.w_out + (size_t)l * 1024 * 1024, 1024, 1024, WoutT, 1024, r, 32, scr, lane, [](int j) { return j; }, nullptr); continue; } r -= I_OUT;
        if (r < I_UQ) { transpose_item(p.mla_w_uq + (size_t)l * 256 * 768, 256, 768, WuqT, 256, r, 24, scr, lane, [](int j) { return wuq_src(j); }, p.mla_q_norm + l * 256); continue; } r -= I_UQ;
        transpose_item(p.mla_w_ukv + (size_t)l * 128 * 1024, 128, 1024, WukvT, 256, r, 32, scr, lane, [](int j) { return wukv_src(j); }, p.mla_kv_norm + l * 128);
    }
}
__device__ __forceinline__ void hb_row(const float* xrow, const float* g, bf16_t* orow, int lane) {
    const f32x4* xr = (const f32x4*)xrow + lane; const f32x4* gr = (const f32x4*)g + lane;
    f32x4 v[4]; float s = 0.f;
#pragma unroll
    for (int j = 0; j < 4; ++j) { v[j] = xr[64 * j]; s += (v[j].x * v[j].x + v[j].y * v[j].y) + (v[j].z * v[j].z + v[j].w * v[j].w); }
    const float rstd = rsqrtf(wave_sum(s) * (1.f / DM) + NORM_EPS);
    u32x2* o8 = (u32x2*)orow + lane;
#pragma unroll
    for (int j = 0; j < 4; ++j) { const f32x4 gg = gr[64 * j]; u32x2 w; w.x = pk2(v[j].x * rstd * gg.x, v[j].y * rstd * gg.y); w.y = pk2(v[j].z * rstd * gg.z, v[j].w * rstd * gg.w); o8[64 * j] = w; }
}
__device__ __forceinline__ void hb_rows4(const float* x, const float* g, bf16_t* HB, int m, int stride, int lane) {
    f32x4 v[4][4];
#pragma unroll
    for (int r = 0; r < 4; ++r) { const f32x4* xr = (const f32x4*)(x + (size_t)(m + r * stride) * DM) + lane;
#pragma unroll
        for (int j = 0; j < 4; ++j) v[r][j] = xr[64 * j]; }
    const f32x4* gr = (const f32x4*)g + lane;
#pragma unroll
    for (int r = 0; r < 4; ++r) { float s = 0.f;
#pragma unroll
        for (int j = 0; j < 4; ++j) s += (v[r][j].x * v[r][j].x + v[r][j].y * v[r][j].y) + (v[r][j].z * v[r][j].z + v[r][j].w * v[r][j].w);
        const float rstd = rsqrtf(wave_sum(s) * (1.f / DM) + NORM_EPS);
        u32x2* o8 = (u32x2*)(HB + (size_t)(m + r * stride) * DM) + lane;
#pragma unroll
        for (int j = 0; j < 4; ++j) { const f32x4 gg = gr[64 * j]; u32x2 w; w.x = pk2(v[r][j].x * rstd * gg.x, v[r][j].y * rstd * gg.y); w.y = pk2(v[r][j].z * rstd * gg.z, v[r][j].w * rstd * gg.w); o8[64 * j] = w; } }
}
template <bool XIN16> struct RowIn { u32x4 oa, ob, xa, xb; f32x4 xv[4]; };
template <bool XIN16> __device__ __forceinline__ void final_load(RowIn<XIN16>& r, const bf16_t* orow, const float* xold, int lane) {
    r.oa = *((const u32x4*)orow + lane); r.ob = *((const u32x4*)orow + 64 + lane);
    if (XIN16) { r.xa = *((const u32x4*)xold + lane); r.xb = *((const u32x4*)xold + 64 + lane); }
    else {
#pragma unroll
        for (int h = 0; h < 2; ++h)
#pragma unroll
            for (int q = 0; q < 2; ++q) r.xv[2 * h + q] = *((const f32x4*)(xold + 512 * h + 8 * lane) + q); }
}
template <bool XIN16, bool XOUT16>
__device__ __forceinline__ void final_row(const RowIn<XIN16>& r, const float* gpost, float* xnew, const float* gnext, bf16_t* hbrow, int lane) {
    float o[16], x[16], g[16];
    { const u32x4 a = r.oa, b = r.ob;
      o[0] = bflo(a.x); o[1] = bfhi(a.x); o[2] = bflo(a.y); o[3] = bfhi(a.y); o[4] = bflo(a.z); o[5] = bfhi(a.z); o[6] = bflo(a.w); o[7] = bfhi(a.w);
      o[8] = bflo(b.x); o[9] = bfhi(b.x); o[10] = bflo(b.y); o[11] = bfhi(b.y); o[12] = bflo(b.z); o[13] = bfhi(b.z); o[14] = bflo(b.w); o[15] = bfhi(b.w); }
    if (XIN16) { const u32x4 a = r.xa, b = r.xb;
      x[0] = bflo(a.x); x[1] = bfhi(a.x); x[2] = bflo(a.y); x[3] = bfhi(a.y); x[4] = bflo(a.z); x[5] = bfhi(a.z); x[6] = bflo(a.w); x[7] = bfhi(a.w);
      x[8] = bflo(b.x); x[9] = bfhi(b.x); x[10] = bflo(b.y); x[11] = bfhi(b.y); x[12] = bflo(b.z); x[13] = bfhi(b.z); x[14] = bflo(b.w); x[15] = bfhi(b.w); }
#pragma unroll
    for (int h = 0; h < 2; ++h)
#pragma unroll
        for (int q = 0; q < 2; ++q) { const f32x4 gv = *((const f32x4*)(gpost + 512 * h + 8 * lane) + q);
            if (!XIN16) {
#pragma unroll
                for (int e = 0; e < 4; ++e) x[8 * h + 4 * q + e] = r.xv[2 * h + q][e]; }
#pragma unroll
            for (int e = 0; e < 4; ++e) g[8 * h + 4 * q + e] = gv[e]; }
    float s = 0.f;
#pragma unroll
    for (int e = 0; e < 16; ++e) s += o[e] * o[e];
    const float rstd = rsqrtf(wave_sum(s) * (1.f / DM) + NORM_EPS);
    float s2 = 0.f;
#pragma unroll
    for (int e = 0; e < 16; ++e) { x[e] += o[e] * rstd * g[e]; s2 += x[e] * x[e]; }
    if (XOUT16) {
#pragma unroll
        for (int h = 0; h < 2; ++h) { u32x4 w; w.x = pk2(x[8 * h], x[8 * h + 1]); w.y = pk2(x[8 * h + 2], x[8 * h + 3]); w.z = pk2(x[8 * h + 4], x[8 * h + 5]); w.w = pk2(x[8 * h + 6], x[8 * h + 7]);
            *((u32x4*)xnew + 64 * h + lane) = w; }
    } else {
#pragma unroll
        for (int h = 0; h < 2; ++h)
#pragma unroll
            for (int q = 0; q < 2; ++q) *((f32x4*)(xnew + 512 * h + 8 * lane) + q) = (f32x4){x[8 * h + 4 * q], x[8 * h + 4 * q + 1], x[8 * h + 4 * q + 2], x[8 * h + 4 * q + 3]};
    }
    if (gnext) { const float rstd2 = rsqrtf(wave_sum(s2) * (1.f / DM) + NORM_EPS);
#pragma unroll
        for (int h = 0; h < 2; ++h) { const f32x4 g0 = *((const f32x4*)(gnext + 512 * h + 8 * lane)), g1 = *((const f32x4*)(gnext + 512 * h + 8 * lane) + 1);
            u32x4 w; w.x = pk2(x[8 * h] * rstd2 * g0[0], x[8 * h + 1] * rstd2 * g0[1]); w.y = pk2(x[8 * h + 2] * rstd2 * g0[2], x[8 * h + 3] * rstd2 * g0[3]);
            w.z = pk2(x[8 * h + 4] * rstd2 * g1[0], x[8 * h + 5] * rstd2 * g1[1]); w.w = pk2(x[8 * h + 6] * rstd2 * g1[2], x[8 * h + 7] * rstd2 * g1[3]);
            *((u32x4*)hbrow + 64 * h + lane) = w; } }
}
__device__ __forceinline__ void mla_prep_row(const bf16_t* prow, const f32x2* rope_t, float* rstdq, float* rstdkv, bf16_t* krow, int lane) {
    const u32x2 a = *((const u32x2*)(prow + CQ) + lane); const unsigned c = *((const unsigned*)(prow + CKV) + lane);
    float sq = bflo(a.x) * bflo(a.x) + bfhi(a.x) * bfhi(a.x) + bflo(a.y) * bflo(a.y) + bfhi(a.y) * bfhi(a.y);
    float sk = bflo(c) * bflo(c) + bfhi(c) * bfhi(c);
    sq = wave_sum(sq); sk = wave_sum(sk);
    if (lane == 0) { *rstdq = rsqrtf(sq * (1.f / 256.f) + NORM_EPS); *rstdkv = rsqrtf(sk * (1.f / 128.f) + NORM_EPS); }
    if (lane < 16) { const float x1 = bf2f(prow[KROPE + lane]), x2 = bf2f(prow[KROPE + 16 + lane]); const f32x2 cs = rope_t[lane];
        *((unsigned*)(krow + 512) + lane) = pk2(x1 * cs.x - x2 * cs.y, x2 * cs.x + x1 * cs.y); }
}

__device__ __forceinline__ void mla_prep_rows4(const bf16_t* PA, const f32x2* ROPE, float* RSTDQ, float* RSTDKV, bf16_t* Kb, int m, int stride, int lane) {
    u32x2 a[4]; unsigned c[4]; float x1[4], x2[4]; f32x2 cs[4];
#pragma unroll
    for (int j = 0; j < 4; ++j) { const int r = (m + j * stride < T) ? m + j * stride : m; const bf16_t* prow = PA + (size_t)r * NA;
        a[j] = *((const u32x2*)(prow + CQ) + lane); c[j] = *((const unsigned*)(prow + CKV) + lane);
        x1[j] = bf2f(prow[KROPE + (lane & 15)]); x2[j] = bf2f(prow[KROPE + 16 + (lane & 15)]); cs[j] = ROPE[(size_t)r * 16 + (lane & 15)]; }
#pragma unroll
    for (int j = 0; j < 4; ++j) { const int r = m + j * stride; if (r < T) {
        float sq = bflo(a[j].x) * bflo(a[j].x) + bfhi(a[j].x) * bfhi(a[j].x) + bflo(a[j].y) * bflo(a[j].y) + bfhi(a[j].y) * bfhi(a[j].y);
        float sk = bflo(c[j]) * bflo(c[j]) + bfhi(c[j]) * bfhi(c[j]);
        sq = wave_sum(sq); sk = wave_sum(sk);
        if (lane == 0) { RSTDQ[r] = rsqrtf(sq * (1.f / 256.f) + NORM_EPS); RSTDKV[r] = rsqrtf(sk * (1.f / 128.f) + NORM_EPS); }
        if (lane < 16) *((unsigned*)(Kb + (size_t)r * KP + 512) + lane) = pk2(x1[j] * cs[j].x - x2[j] * cs[j].y, x2[j] * cs[j].x + x1[j] * cs[j].y); } }
}

#ifdef BANDSKIP
namespace att {
constexpr int KSLOT = 12288, VSLOT = 8192, BUFB = KSLOT + VSLOT, L_WS = 2 * BUFB, L_OST = L_WS + 8 * 128 * 4, L_END = L_OST + 8 * 4096;
constexpr int UNIT_ROWS = 512;
__device__ __forceinline__ int crow(int r, int hi) { return (r & 3) + 8 * (r >> 2) + 4 * hi; }
__device__ __forceinline__ s16x4 vtr(const LAS unsigned char* p) { return __builtin_bit_cast(s16x4, __builtin_amdgcn_ds_read_tr16_b64_v4i16((LAS s16x4*)p)); }
__device__ __forceinline__ void load_q(bf16x8 (&qr)[6], const bf16_t* Q, const f32x2* rope, size_t row, int h, int hi) {
    const bf16_t* Qw = Q + row * 768 + h * 96 + hi * 8;
#pragma unroll
    for (int s = 0; s < 6; ++s) qr[s] = *(const bf16x8*)(Qw + s * 16);
    const f32x4* rp = (const f32x4*)(rope + row * 16 + 4 * hi);
#pragma unroll
    for (int s = 4; s < 6; ++s) { const f32x4 c01 = rp[(s - 4) * 4], c23 = rp[(s - 4) * 4 + 1]; const u32x4 w = __builtin_bit_cast(u32x4, qr[s]); u32x4 o;
        { const float e = bflo(w.x), d = bfhi(w.x); o.x = pk2(e * c01[0] - d * c01[1], d * c01[0] + e * c01[1]); }
        { const float e = bflo(w.y), d = bfhi(w.y); o.y = pk2(e * c01[2] - d * c01[3], d * c01[2] + e * c01[3]); }
        { const float e = bflo(w.z), d = bfhi(w.z); o.z = pk2(e * c23[0] - d * c23[1], d * c23[0] + e * c23[1]); }
        { const float e = bflo(w.w), d = bfhi(w.w); o.w = pk2(e * c23[2] - d * c23[3], d * c23[2] + e * c23[3]); }
        qr[s] = __builtin_bit_cast(bf16x8, o); }
}
__device__ __forceinline__ void softmax_half(f32x16& p0, f32x16& p1, f32x16& o0, f32x16& o1, float& mrun, float& lrun, bf16x8 (&pa)[4],
                                             bool first, bool band, int kb0, int qrel, int r32, int hi, LAS float* wsf) {
    if (band) {
#pragma unroll
        for (int r = 0; r < 16; ++r) { const int kv = kb0 + (r & 3) + 8 * (r >> 2); if (kv > qrel) p0[r] = -INFINITY; if (kv + 32 > qrel) p1[r] = -INFINITY; } }
    float mx = fmaxf(p0[0], p1[0]);
#pragma unroll
    for (int r = 1; r < 16; ++r) mx = fmaxf(mx, fmaxf(p0[r], p1[r]));
    mx = fmaxf(mx, __shfl_xor(mx, 32));
    if (first || __any(mx > 8.0f)) {
        const float dl = first ? mx : fmaxf(mx, 0.f); mrun += dl;
#pragma unroll
        for (int r = 0; r < 16; ++r) { p0[r] -= dl; p1[r] -= dl; }
        const float alpha = __builtin_amdgcn_exp2f(-dl); lrun *= alpha;
        if (hi == 0) wsf[r32] = alpha;
#pragma unroll
        for (int r = 0; r < 16; ++r) { const float a = wsf[crow(r, hi)]; o0[r] *= a; o1[r] *= a; }
    }
    float ls = 0.f;
#pragma unroll
    for (int r = 0; r < 16; ++r) { p0[r] = __builtin_amdgcn_exp2f(p0[r]); p1[r] = __builtin_amdgcn_exp2f(p1[r]); ls += p0[r] + p1[r]; }
    lrun += ls;
#pragma unroll
    for (int s = 0; s < 4; ++s) { const int bb = 8 * (s & 1); u32x4 w;
        if (s < 2) { w.x = pk2(p0[bb], p0[bb + 1]); w.y = pk2(p0[bb + 2], p0[bb + 3]); w.z = pk2(p0[bb + 4], p0[bb + 5]); w.w = pk2(p0[bb + 6], p0[bb + 7]); }
        else { w.x = pk2(p1[bb], p1[bb + 1]); w.y = pk2(p1[bb + 2], p1[bb + 3]); w.z = pk2(p1[bb + 4], p1[bb + 5]); w.w = pk2(p1[bb + 6], p1[bb + 7]); }
        pa[s] = __builtin_bit_cast(bf16x8, w); }
}
__device__ __forceinline__ void attn_unit(int b, int h, int qb, LAS unsigned char* lds, unsigned* done_ctr) {
    KArgs kp = kargs(); unsigned char* ws_ = kp->ws;
    const bf16_t* Q = (const bf16_t*)(ws_ + WS_Q); const bf16_t* Kg = (const bf16_t*)(ws_ + WS_K); const bf16_t* Vg = (const bf16_t*)(ws_ + WS_V); bf16_t* O = (bf16_t*)(ws_ + WS_YS);
    const int tid = opaque_tid(), lane = tid & 63, r32 = lane & 31, hi = lane >> 5; const int wid = __builtin_amdgcn_readfirstlane(tid >> 6);
    const size_t rowbase = (size_t)b * SEQ; const int q0 = qb * UNIT_ROWS;
    bf16x8 qa[6], qb_[6];
    const int rba = 32 * wid, rbb = 32 * (15 - wid);
    load_q(qa, Q, (const f32x2*)(ws_ + WS_ROPE), rowbase + q0 + rba + r32, h, hi);
    load_q(qb_, Q, (const f32x2*)(ws_ + WS_ROPE), rowbase + q0 + rbb + r32, h, hi);
    const char* kbase0 = (const char*)(Kg + rowbase * KP + h * 64); const char* kbase1 = (const char*)(Kg + rowbase * KP + 512);
    const char* vbase = (const char*)(Vg + rowbase * 512 + h * 64);
    const unsigned kof = (unsigned)(((tid & 63) * KP + (tid >> 6) * 8) * 2), vof = (unsigned)((((tid & 255) >> 2) * 512 + (tid >> 8) * 32 + (tid & 3) * 8) * 2);
    const int NT = (q0 + UNIT_ROWS) / 64;
    LAS float* wsf = (LAS float*)(lds + L_WS) + wid * 128;
    u32x4 sk0, sk1, sv;
    sk0 = *(const u32x4*)(kbase0 + kof); if (tid < 256) sk1 = *(const u32x4*)(kbase1 + kof); sv = *(const u32x4*)(vbase + vof);
    *(LAS u32x4*)(lds + tid * 16) = sk0; if (tid < 256) *(LAS u32x4*)(lds + (tid + 512) * 16) = sk1; *(LAS u32x4*)(lds + KSLOT + tid * 16) = sv;
    __syncthreads();
    f32x16 oa0 = {}, oa1 = {}, ob0 = {}, ob1 = {}; float ma = 0.f, la = 0.f, mb = 0.f, lb = 0.f;
    const int qra = rba + r32, qrb = rbb + r32;
    const int tlastA = NT - 8 + ((rba + 31) >> 6), tlastB = NT - 8 + ((rbb + 31) >> 6);
    for (int t = 0; t < NT; ++t) {
        int tidv = tid; asm volatile("" : "+v"(tidv));
        const int lanev = tidv & 63, r32v = lanev & 31, hiv = lanev >> 5;
        const unsigned kofv = (unsigned)(((tidv & 63) * KP + (tidv >> 6) * 8) * 2), vofv = (unsigned)((((tidv & 255) >> 2) * 512 + (tidv >> 8) * 32 + (tidv & 3) * 8) * 2);
        LAS unsigned char* buf = lds + (t & 1) * BUFB; LAS unsigned char* nbuf = lds + ((t + 1) & 1) * BUFB;
        if (t + 1 < NT) { const size_t ko = (size_t)(t + 1) * 64 * KP * 2, vo = (size_t)(t + 1) * 64 * 512 * 2;
            sk0 = *(const u32x4*)(kbase0 + ko + kofv); if (tidv < 256) sk1 = *(const u32x4*)(kbase1 + ko + kofv); sv = *(const u32x4*)(vbase + vo + vofv); }
        const bool band = t >= NT - 8; const int kb0 = 64 * (t - (NT - 8)) + 4 * hiv;
        const bool doA = t <= tlastA, doB = t <= tlastB;
        f32x16 pa0, pa1, pb0, pb1;
#pragma unroll
        for (int r = 0; r < 16; ++r) { pa0[r] = -ma; pa1[r] = -ma; pb0[r] = -mb; pb1[r] = -mb; }
        { const LAS unsigned char* kb = buf + hiv * 1024 + r32v * 16;
#pragma unroll
          for (int s = 0; s < 6; ++s) { const bf16x8 a0 = *(const LAS bf16x8*)(kb + s * 2048), a1 = *(const LAS bf16x8*)(kb + s * 2048 + 512);
              if (doA) { pa0 = __builtin_amdgcn_mfma_f32_32x32x16_bf16(a0, qa[s], pa0, 0, 0, 0); pa1 = __builtin_amdgcn_mfma_f32_32x32x16_bf16(a1, qa[s], pa1, 0, 0, 0); }
              if (doB) { pb0 = __builtin_amdgcn_mfma_f32_32x32x16_bf16(a0, qb_[s], pb0, 0, 0, 0); pb1 = __builtin_amdgcn_mfma_f32_32x32x16_bf16(a1, qb_[s], pb1, 0, 0, 0); } } }
        bf16x8 fa[4], fb[4];
        if (doA) softmax_half(pa0, pa1, oa0, oa1, ma, la, fa, t == 0, band, kb0, (rba + r32v), r32v, hiv, wsf);
        if (doB) softmax_half(pb0, pb1, ob0, ob1, mb, lb, fb, t == 0, band, kb0, (rbb + r32v), r32v, hiv, wsf + 64);
        { const LAS unsigned char* vb = buf + KSLOT + ((lanev >> 4) & 1) * 32 + (lanev & 3) * 8 + (4 * hiv + ((lanev & 15) >> 2)) * 64;
#pragma unroll
          for (int s = 0; s < 4; ++s) {
              { const s16x4 lo = vtr(vb + s * 1024), hh = vtr(vb + s * 1024 + 512); const bf16x8 vf = {lo[0], lo[1], lo[2], lo[3], hh[0], hh[1], hh[2], hh[3]};
                if (doA) oa0 = __builtin_amdgcn_mfma_f32_32x32x16_bf16(fa[s], vf, oa0, 0, 0, 0); if (doB) ob0 = __builtin_amdgcn_mfma_f32_32x32x16_bf16(fb[s], vf, ob0, 0, 0, 0); }
              { const s16x4 lo = vtr(vb + 4096 + s * 1024), hh = vtr(vb + 4096 + s * 1024 + 512); const bf16x8 vf = {lo[0], lo[1], lo[2], lo[3], hh[0], hh[1], hh[2], hh[3]};
                if (doA) oa1 = __builtin_amdgcn_mfma_f32_32x32x16_bf16(fa[s], vf, oa1, 0, 0, 0); if (doB) ob1 = __builtin_amdgcn_mfma_f32_32x32x16_bf16(fb[s], vf, ob1, 0, 0, 0); } } }
        if (t + 1 < NT) { *(LAS u32x4*)(nbuf + tidv * 16) = sk0; if (tidv < 256) *(LAS u32x4*)(nbuf + (tidv + 512) * 16) = sk1; *(LAS u32x4*)(nbuf + KSLOT + tidv * 16) = sv; }
        __syncthreads();
    }
    la += __shfl_xor(la, 32); lb += __shfl_xor(lb, 32);
    if (hi == 0) { wsf[32 + r32] = la; wsf[96 + r32] = lb; }
    LAS bf16_t* stg = (LAS bf16_t*)(lds + L_OST) + wid * 2048;
#pragma unroll
    for (int hf = 0; hf < 2; ++hf) {
#pragma unroll
        for (int r = 0; r < 16; ++r) { const int orow = crow(r, hi); const float rl = __builtin_amdgcn_rcpf(wsf[hf * 64 + 32 + orow]);
            stg[orow * 64 + r32] = f2bf((hf ? ob0[r] : oa0[r]) * rl); stg[orow * 64 + 32 + r32] = f2bf((hf ? ob1[r] : oa1[r]) * rl); }
        asm volatile("" ::: "memory");
        bf16_t* Ow = O + (rowbase + q0 + (hf ? rbb : rba)) * 512 + h * 64;
#pragma unroll
        for (int i = 0; i < 4; ++i) { const int row = i * 8 + (lane >> 3), ch = lane & 7; const u32x4 v = *(const LAS u32x4*)(stg + row * 64 + ch * 8); *(u32x4*)(Ow + (size_t)row * 512 + ch * 8) = v; }
        asm volatile("" ::: "memory");
    }
    asm volatile("s_waitcnt vmcnt(0)" ::: "memory");
    __syncthreads();
    if (tid == 0) __hip_atomic_fetch_add(done_ctr, 1u, __ATOMIC_RELEASE, __HIP_MEMORY_SCOPE_AGENT);
}
}
#else
namespace att {
constexpr int KSLOT = 12288, VSLOT = 8192, BUFB = KSLOT + VSLOT, L_WS = 2 * BUFB, L_OST = L_WS + 8 * 128 * 4, L_END = L_OST + 8 * 4096;
constexpr int UNIT_ROWS = 512;
__device__ __forceinline__ int crow(int r, int hi) { return (r & 3) + 8 * (r >> 2) + 4 * hi; }
__device__ __forceinline__ s16x4 vtr(const LAS unsigned char* p) { return __builtin_bit_cast(s16x4, __builtin_amdgcn_ds_read_tr16_b64_v4i16((LAS s16x4*)p)); }
__device__ __forceinline__ void load_q(bf16x8 (&qr)[6], const bf16_t* Q, const f32x2* rope, size_t row, int h, int hi) {
    const bf16_t* Qw = Q + row * 768 + h * 96 + hi * 8;
#pragma unroll
    for (int s = 0; s < 6; ++s) qr[s] = *(const bf16x8*)(Qw + s * 16);
    const f32x4* rp = (const f32x4*)(rope + row * 16 + 4 * hi);
#pragma unroll
    for (int s = 4; s < 6; ++s) { const f32x4 c01 = rp[(s - 4) * 4], c23 = rp[(s - 4) * 4 + 1]; const u32x4 w = __builtin_bit_cast(u32x4, qr[s]); u32x4 o;
        { const float e = bflo(w.x), d = bfhi(w.x); o.x = pk2(e * c01[0] - d * c01[1], d * c01[0] + e * c01[1]); }
        { const float e = bflo(w.y), d = bfhi(w.y); o.y = pk2(e * c01[2] - d * c01[3], d * c01[2] + e * c01[3]); }
        { const float e = bflo(w.z), d = bfhi(w.z); o.z = pk2(e * c23[0] - d * c23[1], d * c23[0] + e * c23[1]); }
        { const float e = bflo(w.w), d = bfhi(w.w); o.w = pk2(e * c23[2] - d * c23[3], d * c23[2] + e * c23[3]); }
        qr[s] = __builtin_bit_cast(bf16x8, o); }
}
__device__ __forceinline__ void softmax_half(f32x16& p0, f32x16& p1, f32x16& o0, f32x16& o1, float& mrun, float& lrun, bf16x8 (&pa)[4],
                                             bool first, bool band, int kb0, int qrel, int r32, int hi, LAS float* wsf) {
    if (band) {
#pragma unroll
        for (int r = 0; r < 16; ++r) { const int kv = kb0 + (r & 3) + 8 * (r >> 2); if (kv > qrel) p0[r] = -INFINITY; if (kv + 32 > qrel) p1[r] = -INFINITY; } }
    float mx = fmaxf(p0[0], p1[0]);
#pragma unroll
    for (int r = 1; r < 16; ++r) mx = fmaxf(mx, fmaxf(p0[r], p1[r]));
    mx = fmaxf(mx, __shfl_xor(mx, 32));
    if (first || __any(mx > 8.0f)) {
        const float dl = first ? mx : fmaxf(mx, 0.f); mrun += dl;
#pragma unroll
        for (int r = 0; r < 16; ++r) { p0[r] -= dl; p1[r] -= dl; }
        const float alpha = __builtin_amdgcn_exp2f(-dl); lrun *= alpha;
        if (hi == 0) wsf[r32] = alpha;
#pragma unroll
        for (int r = 0; r < 16; ++r) { const float a = wsf[crow(r, hi)]; o0[r] *= a; o1[r] *= a; }
    }
    float ls = 0.f;
#pragma unroll
    for (int r = 0; r < 16; ++r) { p0[r] = __builtin_amdgcn_exp2f(p0[r]); p1[r] = __builtin_amdgcn_exp2f(p1[r]); ls += p0[r] + p1[r]; }
    lrun += ls;
#pragma unroll
    for (int s = 0; s < 4; ++s) { const int bb = 8 * (s & 1); u32x4 w;
        if (s < 2) { w.x = pk2(p0[bb], p0[bb + 1]); w.y = pk2(p0[bb + 2], p0[bb + 3]); w.z = pk2(p0[bb + 4], p0[bb + 5]); w.w = pk2(p0[bb + 6], p0[bb + 7]); }
        else { w.x = pk2(p1[bb], p1[bb + 1]); w.y = pk2(p1[bb + 2], p1[bb + 3]); w.z = pk2(p1[bb + 4], p1[bb + 5]); w.w = pk2(p1[bb + 6], p1[bb + 7]); }
        pa[s] = __builtin_bit_cast(bf16x8, w); }
}
__device__ __forceinline__ void attn_unit(int b, int h, int qb, LAS unsigned char* lds, unsigned* done_ctr) {
    KArgs kp = kargs(); unsigned char* ws_ = kp->ws;
    const bf16_t* Q = (const bf16_t*)(ws_ + WS_Q); const bf16_t* Kg = (const bf16_t*)(ws_ + WS_K); const bf16_t* Vg = (const bf16_t*)(ws_ + WS_V); bf16_t* O = (bf16_t*)(ws_ + WS_YS);
    const int tid = opaque_tid(), lane = tid & 63, r32 = lane & 31, hi = lane >> 5; const int wid = __builtin_amdgcn_readfirstlane(tid >> 6);
    const size_t rowbase = (size_t)b * SEQ; const int q0 = qb * UNIT_ROWS;
    bf16x8 qa[6], qb_[6];
    load_q(qa, Q, (const f32x2*)(ws_ + WS_ROPE), rowbase + q0 + wid * 64 + r32, h, hi);
    load_q(qb_, Q, (const f32x2*)(ws_ + WS_ROPE), rowbase + q0 + wid * 64 + 32 + r32, h, hi);
    const bf16_t* ksrc0 = Kg + (rowbase + (tid & 63)) * KP + h * 64 + (tid >> 6) * 8;
    const bf16_t* ksrc1 = Kg + (rowbase + (tid & 63)) * KP + 512 + (tid >> 6) * 8;
    const bf16_t* vsrc = Vg + (rowbase + ((tid & 255) >> 2)) * 512 + h * 64 + (tid >> 8) * 32 + (tid & 3) * 8;
    const int NT = (q0 + UNIT_ROWS) / 64;
    LAS float* wsf = (LAS float*)(lds + L_WS) + wid * 128;
    u32x4 sk0, sk1, sv;
    sk0 = *(const u32x4*)ksrc0; if (tid < 256) sk1 = *(const u32x4*)ksrc1; sv = *(const u32x4*)vsrc;
    *(LAS u32x4*)(lds + tid * 16) = sk0; if (tid < 256) *(LAS u32x4*)(lds + (tid + 512) * 16) = sk1; *(LAS u32x4*)(lds + KSLOT + tid * 16) = sv;
    __syncthreads();
    f32x16 oa0 = {}, oa1 = {}, ob0 = {}, ob1 = {}; float ma = 0.f, la = 0.f, mb = 0.f, lb = 0.f;
    const int qra = wid * 64 + r32, qrb = qra + 32;
    for (int t = 0; t < NT; ++t) {
        LAS unsigned char* buf = lds + (t & 1) * BUFB; LAS unsigned char* nbuf = lds + ((t + 1) & 1) * BUFB;
        if (t + 1 < NT) { sk0 = *(const u32x4*)(ksrc0 + (size_t)(t + 1) * 64 * KP); if (tid < 256) sk1 = *(const u32x4*)(ksrc1 + (size_t)(t + 1) * 64 * KP); sv = *(const u32x4*)(vsrc + (size_t)(t + 1) * 64 * 512); }
        f32x16 pa0, pa1, pb0, pb1;
#pragma unroll
        for (int r = 0; r < 16; ++r) { pa0[r] = -ma; pa1[r] = -ma; pb0[r] = -mb; pb1[r] = -mb; }
        { const LAS unsigned char* kb = buf + hi * 1024 + r32 * 16;
#pragma unroll
          for (int s = 0; s < 6; ++s) { const bf16x8 a0 = *(const LAS bf16x8*)(kb + s * 2048), a1 = *(const LAS bf16x8*)(kb + s * 2048 + 512);
              pa0 = __builtin_amdgcn_mfma_f32_32x32x16_bf16(a0, qa[s], pa0, 0, 0, 0); pa1 = __builtin_amdgcn_mfma_f32_32x32x16_bf16(a1, qa[s], pa1, 0, 0, 0);
              pb0 = __builtin_amdgcn_mfma_f32_32x32x16_bf16(a0, qb_[s], pb0, 0, 0, 0); pb1 = __builtin_amdgcn_mfma_f32_32x32x16_bf16(a1, qb_[s], pb1, 0, 0, 0); } }
        const bool band = t >= NT - 8; const int kb0 = 64 * (t - (NT - 8)) + 4 * hi;
        bf16x8 fa[4], fb[4];
        softmax_half(pa0, pa1, oa0, oa1, ma, la, fa, t == 0, band, kb0, qra, r32, hi, wsf);
        softmax_half(pb0, pb1, ob0, ob1, mb, lb, fb, t == 0, band, kb0, qrb, r32, hi, wsf + 64);
        { const LAS unsigned char* vb = buf + KSLOT + ((lane >> 4) & 1) * 32 + (lane & 3) * 8 + (4 * hi + ((lane & 15) >> 2)) * 64;
#pragma unroll
          for (int s = 0; s < 4; ++s) {
              { const s16x4 lo = vtr(vb + s * 1024), hh = vtr(vb + s * 1024 + 512); const bf16x8 vf = {lo[0], lo[1], lo[2], lo[3], hh[0], hh[1], hh[2], hh[3]};
                oa0 = __builtin_amdgcn_mfma_f32_32x32x16_bf16(fa[s], vf, oa0, 0, 0, 0); ob0 = __builtin_amdgcn_mfma_f32_32x32x16_bf16(fb[s], vf, ob0, 0, 0, 0); }
              { const s16x4 lo = vtr(vb + 4096 + s * 1024), hh = vtr(vb + 4096 + s * 1024 + 512); const bf16x8 vf = {lo[0], lo[1], lo[2], lo[3], hh[0], hh[1], hh[2], hh[3]};
                oa1 = __builtin_amdgcn_mfma_f32_32x32x16_bf16(fa[s], vf, oa1, 0, 0, 0); ob1 = __builtin_amdgcn_mfma_f32_32x32x16_bf16(fb[s], vf, ob1, 0, 0, 0); } } }
        if (t + 1 < NT) { *(LAS u32x4*)(nbuf + tid * 16) = sk0; if (tid < 256) *(LAS u32x4*)(nbuf + (tid + 512) * 16) = sk1; *(LAS u32x4*)(nbuf + KSLOT + tid * 16) = sv; }
        __syncthreads();
    }
    la += __shfl_xor(la, 32); lb += __shfl_xor(lb, 32);
    if (hi == 0) { wsf[32 + r32] = la; wsf[96 + r32] = lb; }
    LAS bf16_t* stg = (LAS bf16_t*)(lds + L_OST) + wid * 2048;
#pragma unroll
    for (int hf = 0; hf < 2; ++hf) {
#pragma unroll
        for (int r = 0; r < 16; ++r) { const int orow = crow(r, hi); const float rl = __builtin_amdgcn_rcpf(wsf[hf * 64 + 32 + orow]);
            stg[orow * 64 + r32] = f2bf((hf ? ob0[r] : oa0[r]) * rl); stg[orow * 64 + 32 + r32] = f2bf((hf ? ob1[r] : oa1[r]) * rl); }
        asm volatile("" ::: "memory");
        bf16_t* Ow = O + (rowbase + q0 + wid * 64 + hf * 32) * 512 + h * 64;
#pragma unroll
        for (int i = 0; i < 4; ++i) { const int row = i * 8 + (lane >> 3), ch = lane & 7; const u32x4 v = *(const LAS u32x4*)(stg + row * 64 + ch * 8); *(u32x4*)(Ow + (size_t)row * 512 + ch * 8) = v; }
        asm volatile("" ::: "memory");
    }
    asm volatile("s_waitcnt vmcnt(0)" ::: "memory");
    __syncthreads();
    if (tid == 0) __hip_atomic_fetch_add(done_ctr, 1u, __ATOMIC_RELEASE, __HIP_MEMORY_SCOPE_AGENT);
}
}
#endif

namespace rwkv {
constexpr int LP = 72, TB = 64 * LP * 2;
constexpr int S_HT0 = 0, S_HT1 = 1, S_A = 2  , S_B = 3  , S_K = 4, S_R = 5, S_BT = 6, S_KT = 7, S_V = 8,
              S_MOFF = 9, S_MAK = 10, S_MRK = 11, S_MRB = 12, S_D = 13, S_ZT = 14, S_ACC = 15, NSLOT = 16;
constexpr int FP = 68;
constexpr int O_ZW = S_K * TB, O_ZA = O_ZW + 64 * FP * 4, O_YB = S_MAK * TB, O_WT = NSLOT * TB, O_CL = O_WT + 8 * 64 * 4, O_CST = O_CL + 64 * 4, O_END = O_CST + 12 * 64 * 4, O_TT = O_END  ;
static_assert(O_ZA + 64 * FP * 4 <= (S_KT + 1) * TB && O_YB + 64 * FP * 4 <= (S_MRK + 1) * TB, "f32 aliases");
__device__ __forceinline__ s16x4 vtr(const LAS unsigned char* p) { return __builtin_bit_cast(s16x4, __builtin_amdgcn_ds_read_tr16_b64_v4i16((LAS s16x4*)p)); }
struct LaneOff { int bn, bt, bs; };
__device__ __forceinline__ LaneOff lane_off(int fr, int fq) { LaneOff o; o.bn = (fr * LP + 8 * fq) * 2; o.bt = ((8 * fq + (fr >> 2)) * LP + 4 * (fr & 3)) * 2; o.bs = (fr * LP + 4 * fq) * 2; return o; }
__device__ __forceinline__ void relaunder(LaneOff& o) { asm volatile("" : "+v"(o.bn), "+v"(o.bt), "+v"(o.bs)); }
__device__ __forceinline__ bf16x8 frag_t(const LAS unsigned char* tile, int kk, int c0, const LaneOff& o) {
    const LAS unsigned char* q = tile + o.bt + (32 * kk * LP + c0) * 2;
    const s16x4 lo = vtr(q), hi = vtr(q + 4 * LP * 2); return (bf16x8){lo[0], lo[1], lo[2], lo[3], hi[0], hi[1], hi[2], hi[3]};
}
__device__ __forceinline__ bf16x8 frag_n(const LAS unsigned char* tile, int r0, int kk, const LaneOff& o) { return *(const LAS bf16x8*)(tile + o.bn + (r0 * LP + 32 * kk) * 2); }
__device__ __forceinline__ f32x4 MFMA16(bf16x8 a, bf16x8 b, f32x4 c) { return __builtin_amdgcn_mfma_f32_16x16x32_bf16(a, b, c, 0, 0, 0); }
__device__ __forceinline__ void st_tile_T(LAS unsigned char* tile, int m0, int n0, const LaneOff& o, const f32x4 c) {
    u32x2 w; w.x = pk2(c[0], c[1]); w.y = pk2(c[2], c[3]); *(LAS u32x2*)(tile + o.bs + (n0 * LP + m0) * 2) = w;
}
__device__ __forceinline__ void unpack8(const u32x4 w, float (&f)[8]) { f[0] = bflo(w.x); f[1] = bfhi(w.x); f[2] = bflo(w.y); f[3] = bfhi(w.y); f[4] = bflo(w.z); f[5] = bfhi(w.z); f[6] = bflo(w.w); f[7] = bfhi(w.w); }
__device__ __forceinline__ u32x4 pack8(const float (&f)[8]) { u32x4 w; w.x = pk2(f[0], f[1]); w.y = pk2(f[2], f[3]); w.z = pk2(f[4], f[5]); w.w = pk2(f[6], f[7]); return w; }
__device__ __forceinline__ void ld8(const float* p, float (&f)[8]) { const f32x4 a = *(const f32x4*)p, b = *(const f32x4*)(p + 4); f[0] = a[0]; f[1] = a[1]; f[2] = a[2]; f[3] = a[3]; f[4] = b[0]; f[5] = b[1]; f[6] = b[2]; f[7] = b[3]; }
__device__ __forceinline__ void ld8l(const LAS float* p, float (&f)[8]) { const f32x4 a = *(const LAS f32x4*)p, b = *(const LAS f32x4*)(p + 4); f[0] = a[0]; f[1] = a[1]; f[2] = a[2]; f[3] = a[3]; f[4] = b[0]; f[5] = b[1]; f[6] = b[2]; f[7] = b[3]; }
__device__ __forceinline__ float ex2(float x) { return __builtin_amdgcn_exp2f(x); }
constexpr float LOG2E = 1.4426950408889634f, LN2 = 0.6931471805599453f;

__device__ __forceinline__ void rwkv_unit(int l, int b, int h, LAS unsigned char* L) {
    const int tid = opaque_tid(), lane = tid & 63, fr = lane & 15, fq = lane >> 4; const int w = __builtin_amdgcn_readfirstlane(tid >> 6);
    const Params p = load_params();
    const bf16_t* PA = (const bf16_t*)(p.ws + WS_PA); bf16_t* Yout = (bf16_t*)(p.ws + WS_YS) + (size_t)T * 512;
    const int t = tid >> 3, c8 = (tid & 7) * 8;
    const int tw = (lane >> 3);
    const int cw = 16 * (w & 3);
    const float* mu = p.rwkv_mu + l * 1664;
    LaneOff lo = lane_off(fr, fq);
#define SLOT(s) (L + (s) * TB)
    bf16x8 bup[2];
    { const float* U = ((w < 4) ? p.rwkv_w_up : p.rwkv_a_up) + (size_t)l * 64 * 512 + h * 64 + 16 * (w & 3) + fr;
#pragma unroll
      for (int kk = 0; kk < 2; ++kk) { float f[8];
#pragma unroll
          for (int e = 0; e < 8; ++e) f[e] = U[(size_t)(32 * kk + 8 * fq + e) * 512];
          bup[kk] = __builtin_bit_cast(bf16x8, pack8(f)); } }
    for (int e = tid; e < TB / 4; e += 512) { ((LAS unsigned*)SLOT(S_HT0))[e] = 0u; ((LAS unsigned*)SLOT(S_D))[e] = 0u; ((LAS unsigned*)SLOT(S_MOFF))[e] = 0u; ((LAS unsigned*)SLOT(S_MRB))[e] = 0u;
        ((LAS unsigned*)SLOT(S_ZT))[e] = 0u; ((LAS unsigned*)SLOT(S_ACC))[e] = 0u; }
    f32x4 hacc[4];
#pragma unroll
    for (int i = 0; i < 4; ++i) hacc[i] = (f32x4){0.f, 0.f, 0.f, 0.f};
    int hcur = S_HT0, hnxt = S_HT1;
    u32x4 raw[10];
#define RWKV_LOAD(c, t, c8) do { const size_t row_ = (size_t)b * SEQ + (c) * 64 + (t); const bf16_t* s_ = PA + row_ * NA; const bool hp_ = ((c) * 64 + (t)) > 0; const u32x4 z_ = {0u, 0u, 0u, 0u}; \
        raw[0] = *(const u32x4*)(s_ + RW_R + h * 64 + c8); raw[1] = hp_ ? *(const u32x4*)(s_ - NA + RW_R + h * 64 + c8) : z_; \
        raw[2] = *(const u32x4*)(s_ + RW_K + h * 64 + c8); raw[3] = hp_ ? *(const u32x4*)(s_ - NA + RW_K + h * 64 + c8) : z_; \
        raw[4] = *(const u32x4*)(s_ + RW_V + h * 64 + c8); raw[5] = hp_ ? *(const u32x4*)(s_ - NA + RW_V + h * 64 + c8) : z_; \
        raw[6] = *(const u32x4*)(s_ + RW_LW + c8); raw[7] = hp_ ? *(const u32x4*)(s_ - NA + RW_LW + c8) : z_; \
        raw[8] = *(const u32x4*)(s_ + RW_LA + c8); raw[9] = hp_ ? *(const u32x4*)(s_ - NA + RW_LA + c8) : z_; } while (0)
    for (int e = tid; e < 12 * 64; e += 512) { const int rw_ = e >> 6, i_ = e & 63; const int hci = l * 512 + h * 64 + i_; float val;
        switch (rw_) { case 0: val = mu[h * 64 + i_]; break; case 1: val = mu[512 + h * 64 + i_]; break; case 2: val = mu[1024 + h * 64 + i_]; break; case 3: val = mu[1536 + i_]; break; case 4: val = mu[1600 + i_]; break;
            case 5: val = p.rwkv_w0[hci]; break; case 6: val = p.rwkv_a0[hci]; break; case 7: val = p.rwkv_k_k[hci]; break; case 8: val = p.rwkv_k_a[hci]; break; case 9: val = p.rwkv_r_k[hci]; break;
            case 10: val = p.rwkv_ln_w[hci]; break; default: val = p.rwkv_ln_b[hci]; break; }
        ((LAS float*)(L + O_CST))[e] = val; }
#ifdef V_C
    if (tid < 48) { const int task = tid / 6 + 8 * (tid % 6); u32x4 d = {0u, 0u, 0u, 3u};
        if (task < 36) { int q, mn;
            if (task < 6) { q = 0; mn = (int)((0xEDC984ull >> (4 * task)) & 0xF); }
            else { q = 1 + (task - 6) / 10; mn = (int)((0xFEDCA98540ull >> (4 * ((task - 6) % 10))) & 0xF); }
            const int m0 = 16 * (mn >> 2), n0 = 16 * (mn & 3);
            d.x = (unsigned)(((q < 2) ? S_A : S_R) * TB + m0 * LP * 2); d.y = (unsigned)(((q & 1) ? S_K : S_B) * TB + n0 * LP * 2);
            d.z = (unsigned)(((q == 0) ? S_MOFF : (q == 1) ? S_MAK : (q == 2) ? S_MRB : S_MRK) * TB + (n0 * LP + m0) * 2);
            d.w = (m0 == n0) ? ((q < 2) ? 1u : 2u) : 0u;
        } else { const int z = task - 36; const int mn = (int)((0xB76321ull >> (4 * (z % 6))) & 0xF);
            d.z = (unsigned)(((z < 6) ? S_MAK : S_MRK) * TB + (16 * (mn & 3) * LP + 16 * (mn >> 2)) * 2); }
        *(LAS u32x2*)(L + O_TT + tid * 8) = (u32x2){(d.x >> 4) | ((d.y >> 4) << 16), (d.z >> 4) | (d.w << 16)}; }
#endif
    RWKV_LOAD(0, t, c8);
    __syncthreads();
    for (int c = 0; c < SEQ / 64; ++c) {
        int c8v = c8, tv = t, frv = fr, fqv = fq; asm volatile("" : "+v"(c8v), "+v"(tv), "+v"(frv), "+v"(fqv));
        const int twv = tv & 7;
        float r[8], kraw[8], v[8];
        { float cu[8], pr[8], m8[8], o[8];
          unpack8(raw[0], cu); unpack8(raw[1], pr); ld8l((const LAS float*)(L + O_CST) + 0 * 64 + c8v, m8);
#pragma unroll
          for (int e = 0; e < 8; ++e) r[e] = cu[e] + (pr[e] - cu[e]) * m8[e];
          unpack8(raw[2], cu); unpack8(raw[3], pr); ld8l((const LAS float*)(L + O_CST) + 1 * 64 + c8v, m8);
#pragma unroll
          for (int e = 0; e < 8; ++e) kraw[e] = cu[e] + (pr[e] - cu[e]) * m8[e];
          unpack8(raw[4], cu); unpack8(raw[5], pr); ld8l((const LAS float*)(L + O_CST) + 2 * 64 + c8v, m8);
#pragma unroll
          for (int e = 0; e < 8; ++e) v[e] = cu[e] + (pr[e] - cu[e]) * m8[e];
#ifdef V_V
          *(LAS u32x4*)(SLOT(S_V) + (tv * LP + c8v) * 2) = pack8(v);
#endif
          unpack8(raw[6], cu); unpack8(raw[7], pr); ld8l((const LAS float*)(L + O_CST) + 3 * 64 + c8v, m8);
#pragma unroll
          for (int e = 0; e < 8; ++e) { const float x = cu[e] + (pr[e] - cu[e]) * m8[e]; o[e] = 1.0f - 2.0f * __builtin_amdgcn_rcpf(ex2(x * (2.0f * LOG2E)) + 1.0f); }
          *(LAS u32x4*)(SLOT(S_A) + (tv * LP + c8v) * 2) = pack8(o);
          unpack8(raw[8], cu); unpack8(raw[9], pr); ld8l((const LAS float*)(L + O_CST) + 4 * 64 + c8v, m8);
#pragma unroll
          for (int e = 0; e < 8; ++e) o[e] = cu[e] + (pr[e] - cu[e]) * m8[e];
          *(LAS u32x4*)(SLOT(S_B) + (tv * LP + c8v) * 2) = pack8(o); }
        __syncthreads();
        relaunder(lo);
#ifdef U_P2
        { const LAS unsigned char* X = (w < 4) ? SLOT(S_A) : SLOT(S_B); LAS float* Z = (LAS float*)(L + ((w < 4) ? O_ZW : O_ZA));
          f32x4 zacc[4];
#pragma unroll
          for (int m = 0; m < 4; ++m) { f32x4 a = {0.f, 0.f, 0.f, 0.f};
#pragma unroll
              for (int kk = 0; kk < 2; ++kk) a = MFMA16(frag_n(X, 16 * m, kk, lo), bup[kk], a);
              zacc[m] = a; }
#pragma unroll
          for (int m = 0; m < 4; ++m)
#pragma unroll
              for (int rr = 0; rr < 4; ++rr) Z[(16 * m + 4 * fqv + rr) * FP + cw + frv] = zacc[m][rr]; }
#else
        { const LAS unsigned char* X = (w < 4) ? SLOT(S_A) : SLOT(S_B); LAS float* Z = (LAS float*)(L + ((w < 4) ? O_ZW : O_ZA));
#pragma unroll
          for (int m = 0; m < 4; ++m) { f32x4 a = {0.f, 0.f, 0.f, 0.f};
#pragma unroll
              for (int kk = 0; kk < 2; ++kk) a = MFMA16(frag_n(X, 16 * m, kk, lo), bup[kk], a);
#pragma unroll
              for (int rr = 0; rr < 4; ++rr) Z[(16 * m + 4 * fqv + rr) * FP + cw + frv] = a[rr]; } }
#endif
        __syncthreads();
        float kk_[8], kp[8], bb[8], lw[8], cs[8], cb;
        { float zw[8], za[8], c0[8], c1[8];
          ld8l((const LAS float*)(L + O_ZW) + tv * FP + c8v, zw); ld8l((const LAS float*)(L + O_ZA) + tv * FP + c8v, za);
          ld8l((const LAS float*)(L + O_CST) + 5 * 64 + c8v, c0); ld8l((const LAS float*)(L + O_CST) + 6 * 64 + c8v, c1);
          float av[8];
#pragma unroll
#ifdef V_A
          for (int e = 0; e < 8; ++e) { lw[e] = -(LOG2E * 0.6065306597126334f) * __builtin_amdgcn_rcpf(1.0f + ex2(-(zw[e] + c0[e]) * LOG2E));
              av[e] = __builtin_amdgcn_rcpf(1.0f + ex2(-(za[e] + c1[e]) * LOG2E)); }
#else
          for (int e = 0; e < 8; ++e) { const float x = -(zw[e] + c0[e]); const float sp = fmaxf(x, 0.f) + LN2 * __builtin_amdgcn_logf(1.0f + ex2(-fabsf(x) * LOG2E));
              lw[e] = -LOG2E * ex2((-sp - 0.5f) * LOG2E);
              av[e] = __builtin_amdgcn_rcpf(1.0f + ex2(-(za[e] + c1[e]) * LOG2E)); }
#endif
          ld8l((const LAS float*)(L + O_CST) + 7 * 64 + c8v, c0); ld8l((const LAS float*)(L + O_CST) + 8 * 64 + c8v, c1);
          float ss = 0.f;
#pragma unroll
          for (int e = 0; e < 8; ++e) { kk_[e] = kraw[e] * c0[e]; ss += kk_[e] * kk_[e]; kp[e] = kraw[e] * (1.0f + (av[e] - 1.0f) * c1[e]); }
          ss = sum8(ss);
          const float inv = 1.0f / fmaxf(sqrtf(ss), 1e-12f);
          ld8l((const LAS float*)(L + O_CST) + 9 * 64 + c8v, c0);
          float cp = 0.f;
#pragma unroll
          for (int e = 0; e < 8; ++e) { kk_[e] *= inv; bb[e] = kk_[e] * av[e]; cp += r[e] * kp[e] * c0[e]; }
          cb = sum8(cp);
#pragma unroll
          for (int e = 0; e < 8; ++e) { float x = lw[e];
              float y = __shfl_up(x, 8); if (twv >= 1) x += y;
              y = __shfl_up(x, 16); if (twv >= 2) x += y;
              y = __shfl_up(x, 32); if (twv >= 4) x += y;
              cs[e] = x; }
          if (twv == 7) { LAS float* WT = (LAS float*)(L + O_WT) + w * 64 + c8v;
#pragma unroll
              for (int e = 0; e < 8; ++e) WT[e] = cs[e]; } }
        __syncthreads();
        { float off[8], tot[8];
#pragma unroll
          for (int e = 0; e < 8; ++e) { off[e] = 0.f; tot[e] = 0.f; }
#ifdef V_B
          { int wq = w; asm volatile("" : "+s"(wq));
#pragma unroll
            for (int g = 0; g < 8; ++g) { float x[8]; ld8l((const LAS float*)(L + O_WT) + g * 64 + c8v, x); const float mk = (g < wq) ? 1.0f : 0.0f;
#pragma unroll
                for (int e = 0; e < 8; ++e) { off[e] = __builtin_fmaf(x[e], mk, off[e]); tot[e] += x[e]; }
                if (g & 1) __builtin_amdgcn_sched_barrier(0); } }
#else
#pragma unroll
          for (int g = 0; g < 8; ++g) { float x[8]; ld8l((const LAS float*)(L + O_WT) + g * 64 + c8v, x);
#pragma unroll
              for (int e = 0; e < 8; ++e) { if (g < w) off[e] += x[e]; tot[e] += x[e]; } }
#endif
          if (tv == 0) { LAS float* CL = (LAS float*)(L + O_CL) + c8v;
#pragma unroll
              for (int e = 0; e < 8; ++e) CL[e] = tot[e]; }
          float o[8], en[8], ep[8]; const int toff = (tv * LP + c8v) * 2;
#pragma unroll
          for (int e = 0; e < 8; ++e) { cs[e] += off[e]; en[e] = ex2(-cs[e]); ep[e] = __builtin_amdgcn_rcpf(en[e]); o[e] = -kk_[e] * ep[e] * ex2(-lw[e]); }
          *(LAS u32x4*)(SLOT(S_A) + toff) = pack8(o);
#pragma unroll
          for (int e = 0; e < 8; ++e) o[e] = bb[e] * en[e];
          *(LAS u32x4*)(SLOT(S_B) + toff) = pack8(o);
#pragma unroll
          for (int e = 0; e < 8; ++e) o[e] = kp[e] * en[e];
          *(LAS u32x4*)(SLOT(S_K) + toff) = pack8(o);
#pragma unroll
          for (int e = 0; e < 8; ++e) o[e] = r[e] * ep[e];
          *(LAS u32x4*)(SLOT(S_R) + toff) = pack8(o);
#pragma unroll
          for (int e = 0; e < 8; ++e) { en[e] = ex2(tot[e] - cs[e]); o[e] = bb[e] * en[e]; }
          *(LAS u32x4*)(SLOT(S_BT) + toff) = pack8(o);
#pragma unroll
          for (int e = 0; e < 8; ++e) o[e] = kp[e] * en[e];
          *(LAS u32x4*)(SLOT(S_KT) + toff) = pack8(o);
#ifndef V_V
          *(LAS u32x4*)(SLOT(S_V) + toff) = pack8(v);
#endif
        }
        __syncthreads();
        relaunder(lo);
        int wv = w; asm volatile("" : "+s"(wv));
#if defined(LOAD_AT) && LOAD_AT == 4
        if (c + 1 < SEQ / 64) RWKV_LOAD(c + 1, tv, c8v);
#endif
#ifdef U_P4
        f32x4 tacc[5];
#pragma unroll
        for (int it = 0; it < 5; ++it) { const int task = wv + 8 * it; f32x4 a = {0.f, 0.f, 0.f, 0.f};
            if (task < 36) {
                int q, mn;
                if (task < 6) { q = 0; mn = (int)((0xEDC984ull >> (4 * task)) & 0xF); }
                else { q = 1 + (task - 6) / 10; mn = (int)((0xFEDCA98540ull >> (4 * ((task - 6) % 10))) & 0xF); }
                const int m0 = 16 * (mn >> 2), n0 = 16 * (mn & 3);
                const LAS unsigned char* XA = (q < 2) ? SLOT(S_A) : SLOT(S_R); const LAS unsigned char* XB = (q & 1) ? SLOT(S_K) : SLOT(S_B);
#pragma unroll
                for (int kk = 0; kk < 2; ++kk) a = MFMA16(frag_n(XA, m0, kk, lo), frag_n(XB, n0, kk, lo), a);
                if (m0 == n0) {
#pragma unroll
                    for (int rr = 0; rr < 4; ++rr) { const bool keep = (q < 2) ? (frv < 4 * fqv + rr) : (frv <= 4 * fqv + rr); a[rr] = keep ? a[rr] : 0.f; } } }
            tacc[it] = a; }
        if (wv < 4) {
            f32x4 a = {0.f, 0.f, 0.f, 0.f};
#pragma unroll
            for (int kk = 0; kk < 2; ++kk) a = MFMA16(frag_n(SLOT(S_A), 16 * wv, kk, lo), frag_n(SLOT(S_B), 16 * wv, kk, lo), a);
#pragma unroll
            for (int rr = 0; rr < 4; ++rr) a[rr] = (frv < 4 * fqv + rr) ? a[rr] : 0.f;
            float x[16];
            { LAS float* NS = (LAS float*)(SLOT(hnxt) + wv * 1024);
#pragma unroll
              for (int rr = 0; rr < 4; ++rr) NS[(4 * fqv + rr) * 16 + frv] = a[rr];
              asm volatile("s_waitcnt lgkmcnt(0)" ::: "memory");
#pragma unroll
              for (int rw = 0; rw < 16; ++rw) { float s = (rw == frv) ? 1.f : 0.f;
#pragma unroll
                  for (int sc = 0; sc < rw; ++sc) s = __builtin_fmaf(NS[rw * 16 + sc], x[sc], s);
                  x[rw] = s; }
              asm volatile("s_waitcnt lgkmcnt(0)" ::: "memory"); }
            if (fqv == 0) { LAS unsigned char* dp = SLOT(S_D) + ((16 * wv + frv) * LP + 16 * wv) * 2;
                float lo8[8], hi8[8];
#pragma unroll
                for (int e = 0; e < 8; ++e) { lo8[e] = x[e]; hi8[e] = x[8 + e]; }
                *(LAS u32x4*)dp = pack8(lo8); *(LAS u32x4*)(dp + 16) = pack8(hi8); }
        }
#pragma unroll
        for (int it = 0; it < 6; ++it) { const int task = wv + 8 * it;
            if (task < 36) {
                int q, mn;
                if (task < 6) { q = 0; mn = (int)((0xEDC984ull >> (4 * task)) & 0xF); }
                else { q = 1 + (task - 6) / 10; mn = (int)((0xFEDCA98540ull >> (4 * ((task - 6) % 10))) & 0xF); }
                st_tile_T(SLOT((q == 0) ? S_MOFF : (q == 1) ? S_MAK : (q == 2) ? S_MRB : S_MRK), 16 * (mn >> 2), 16 * (mn & 3), lo, tacc[it < 5 ? it : 4]);
            } else if (task < 48) {
                const int z = task - 36; const int mn = (int)((0xB76321ull >> (4 * (z % 6))) & 0xF);
                st_tile_T(SLOT((z < 6) ? S_MAK : S_MRK), 16 * (mn >> 2), 16 * (mn & 3), lo, (f32x4){0.f, 0.f, 0.f, 0.f});
            } }
#else
#ifdef V_C
        u32x4 dq[3];
#pragma unroll
        for (int j = 0; j < 3; ++j) dq[j] = *(const LAS u32x4*)(L + O_TT + wv * 48 + j * 16);
#endif
        if (wv < 4) {
            f32x4 a = {0.f, 0.f, 0.f, 0.f};
#pragma unroll
            for (int kk = 0; kk < 2; ++kk) a = MFMA16(frag_n(SLOT(S_A), 16 * wv, kk, lo), frag_n(SLOT(S_B), 16 * wv, kk, lo), a);
#pragma unroll
            for (int rr = 0; rr < 4; ++rr) a[rr] = (frv < 4 * fqv + rr) ? a[rr] : 0.f;
            float x[16];
            { LAS float* NS = (LAS float*)(SLOT(hnxt) + wv * 1024);
#pragma unroll
              for (int rr = 0; rr < 4; ++rr) NS[(4 * fqv + rr) * 16 + frv] = a[rr];
              asm volatile("s_waitcnt lgkmcnt(0)" ::: "memory");
#pragma unroll
              for (int rw = 0; rw < 16; ++rw) { float s = (rw == frv) ? 1.f : 0.f;
#pragma unroll
                  for (int sc = 0; sc < rw; ++sc) s = __builtin_fmaf(NS[rw * 16 + sc], x[sc], s);
                  x[rw] = s; }
              asm volatile("s_waitcnt lgkmcnt(0)" ::: "memory"); }
            if (fqv == 0) { LAS unsigned char* dp = SLOT(S_D) + ((16 * wv + frv) * LP + 16 * wv) * 2;
                float lo8[8], hi8[8];
#pragma unroll
                for (int e = 0; e < 8; ++e) { lo8[e] = x[e]; hi8[e] = x[8 + e]; }
                *(LAS u32x4*)dp = pack8(lo8); *(LAS u32x4*)(dp + 16) = pack8(hi8); }
        }
#ifdef V_C
        {
#pragma unroll
          for (int it = 0; it < 6; ++it) {
            const unsigned e0 = (unsigned)__builtin_amdgcn_readfirstlane((int)((it & 1) ? dq[it >> 1].z : dq[it >> 1].x)), e1 = (unsigned)__builtin_amdgcn_readfirstlane((int)((it & 1) ? dq[it >> 1].w : dq[it >> 1].y));
            const int mode = (int)(e1 >> 16); LAS unsigned char* dst = L + ((e1 & 0xffffu) << 4) + lo.bs;
            if (mode < 3) {
                const LAS unsigned char* pa = L + ((e0 & 0xffffu) << 4) + lo.bn; const LAS unsigned char* pb = L + ((e0 >> 16) << 4) + lo.bn;
                f32x4 a = MFMA16(*(const LAS bf16x8*)pa, *(const LAS bf16x8*)pb, (f32x4){0.f, 0.f, 0.f, 0.f});
                a = MFMA16(*(const LAS bf16x8*)(pa + 64), *(const LAS bf16x8*)(pb + 64), a);
                if (mode) { const int thr = frv + ((mode == 1) ? 1 : 0);
#pragma unroll
                    for (int rr = 0; rr < 4; ++rr) a[rr] = (thr <= 4 * fqv + rr) ? a[rr] : 0.f; }
                u32x2 wq_; wq_.x = pk2(a[0], a[1]); wq_.y = pk2(a[2], a[3]); *(LAS u32x2*)dst = wq_;
            } else { *(LAS u32x2*)dst = (u32x2){0u, 0u}; } } }
#else
#pragma unroll
        for (int it = 0; it < 6; ++it) { const int task = wv + 8 * it;
            if (task < 36) {
                int q, mn;
                if (task < 6) { q = 0; mn = (int)((0xEDC984ull >> (4 * task)) & 0xF); }
                else { q = 1 + (task - 6) / 10; mn = (int)((0xFEDCA98540ull >> (4 * ((task - 6) % 10))) & 0xF); }
                const int m0 = 16 * (mn >> 2), n0 = 16 * (mn & 3);
                const LAS unsigned char* XA = (q < 2) ? SLOT(S_A) : SLOT(S_R); const LAS unsigned char* XB = (q & 1) ? SLOT(S_K) : SLOT(S_B);
                f32x4 a = {0.f, 0.f, 0.f, 0.f};
#pragma unroll
                for (int kk = 0; kk < 2; ++kk) a = MFMA16(frag_n(XA, m0, kk, lo), frag_n(XB, n0, kk, lo), a);
                if (m0 == n0) {
#pragma unroll
                    for (int rr = 0; rr < 4; ++rr) { const bool keep = (q < 2) ? (frv < 4 * fqv + rr) : (frv <= 4 * fqv + rr); a[rr] = keep ? a[rr] : 0.f; } }
                st_tile_T(SLOT((q == 0) ? S_MOFF : (q == 1) ? S_MAK : (q == 2) ? S_MRB : S_MRK), m0, n0, lo, a);
            } else if (task < 48) {
                const int z = task - 36; const int mn = (int)((0xB76321ull >> (4 * (z % 6))) & 0xF);
                st_tile_T(SLOT((z < 6) ? S_MAK : S_MRK), 16 * (mn >> 2), 16 * (mn & 3), lo, (f32x4){0.f, 0.f, 0.f, 0.f});
            } }
#endif
#endif
        __syncthreads();
        relaunder(lo);
#if defined(LOAD_AT) && LOAD_AT == 5
        if (c + 1 < SEQ / 64) RWKV_LOAD(c + 1, tv, c8v);
#endif
        f32x4 yacc[4];
#ifdef U_P5
        if (w < 4) {
            f32x4 xr[4];
#pragma unroll
            for (int i = 0; i < 4; ++i) { f32x4 a = {0.f, 0.f, 0.f, 0.f};
#pragma unroll
                for (int kk = 0; kk < 2; ++kk) { if (32 * kk < 16 * i + 16) a = MFMA16(frag_t(SLOT(S_MAK), kk, 16 * i, lo), frag_t(SLOT(S_V), kk, cw, lo), a);
                    a = MFMA16(frag_n(SLOT(S_A), 16 * i, kk, lo), frag_n(SLOT(hcur), cw, kk, lo), a); }
                xr[i] = a; }
#pragma unroll
            for (int i = 0; i < 4; ++i) { f32x4 a = xr[i];
#pragma unroll
                for (int kk = 0; kk < 2; ++kk) if (32 * kk < 16 * i) a = MFMA16(frag_t(SLOT(S_MOFF), kk, 16 * i, lo), frag_n(SLOT(S_ZT), cw, kk, lo), a);
                st_tile_T(SLOT(S_ACC), 16 * i, cw, lo, a);
                asm volatile("" ::: "memory");
                const f32x4 z = MFMA16(frag_t(SLOT(S_D), i >> 1, 16 * i, lo), frag_n(SLOT(S_ACC), cw, i >> 1, lo), (f32x4){0.f, 0.f, 0.f, 0.f});
                st_tile_T(SLOT(S_ZT), 16 * i, cw, lo, z);
                asm volatile("" ::: "memory"); }
#else
        if (w < 4) {
#pragma unroll
            for (int i = 0; i < 4; ++i) { f32x4 a = {0.f, 0.f, 0.f, 0.f};
#pragma unroll
                for (int kk = 0; kk < 2; ++kk) { if (32 * kk < 16 * i + 16) a = MFMA16(frag_t(SLOT(S_MAK), kk, 16 * i, lo), frag_t(SLOT(S_V), kk, cw, lo), a);
                    a = MFMA16(frag_n(SLOT(S_A), 16 * i, kk, lo), frag_n(SLOT(hcur), cw, kk, lo), a); }
#pragma unroll
                for (int kk = 0; kk < 2; ++kk) if (32 * kk < 16 * i) a = MFMA16(frag_t(SLOT(S_MOFF), kk, 16 * i, lo), frag_n(SLOT(S_ZT), cw, kk, lo), a);
                st_tile_T(SLOT(S_ACC), 16 * i, cw, lo, a);
                const f32x4 z = MFMA16(frag_t(SLOT(S_D), i >> 1, 16 * i, lo), frag_n(SLOT(S_ACC), cw, i >> 1, lo), (f32x4){0.f, 0.f, 0.f, 0.f});
                st_tile_T(SLOT(S_ZT), 16 * i, cw, lo, z); }
#endif
        } else {
#pragma unroll
            for (int i = 0; i < 4; ++i) { f32x4 a = {0.f, 0.f, 0.f, 0.f};
#pragma unroll
                for (int kk = 0; kk < 2; ++kk) { if (32 * kk < 16 * i + 16) a = MFMA16(frag_t(SLOT(S_MRK), kk, 16 * i, lo), frag_t(SLOT(S_V), kk, cw, lo), a);
                    a = MFMA16(frag_n(SLOT(S_R), 16 * i, kk, lo), frag_n(SLOT(hcur), cw, kk, lo), a);
                }
                yacc[i] = a; }
        }
        __syncthreads();
        relaunder(lo);
#if !defined(LOAD_AT)
        if (c + 1 < SEQ / 64) RWKV_LOAD(c + 1, tv, c8v);
#endif
#ifdef U_P7
        if (w >= 4) {
#pragma unroll
            for (int i = 0; i < 4; ++i) {
#pragma unroll
                for (int rr = 0; rr < 4; ++rr) hacc[i][rr] = hacc[i][rr] * ex2(((const LAS float*)(L + O_CL))[16 * i + 4 * fqv + rr]);
#pragma unroll
                for (int kk = 0; kk < 2; ++kk) { hacc[i] = MFMA16(frag_t(SLOT(S_KT), kk, 16 * i, lo), frag_t(SLOT(S_V), kk, cw, lo), hacc[i]);
                    hacc[i] = MFMA16(frag_t(SLOT(S_BT), kk, 16 * i, lo), frag_n(SLOT(S_ZT), cw, kk, lo), hacc[i]); }
#pragma unroll
                for (int kk = 0; kk < 2; ++kk) if (32 * kk < 16 * i + 16) yacc[i] = MFMA16(frag_t(SLOT(S_MRB), kk, 16 * i, lo), frag_n(SLOT(S_ZT), cw, kk, lo), yacc[i]); }
#pragma unroll
            for (int i = 0; i < 4; ++i) { st_tile_T(SLOT(hnxt), 16 * i, cw, lo, hacc[i]);
#pragma unroll
                for (int rr = 0; rr < 4; ++rr) ((LAS float*)(L + O_YB))[(16 * i + 4 * fqv + rr) * FP + cw + frv] = yacc[i][rr]; }
        }
#else
        if (w >= 4) {
#pragma unroll
            for (int i = 0; i < 4; ++i) {
#pragma unroll
                for (int rr = 0; rr < 4; ++rr) hacc[i][rr] = hacc[i][rr] * ex2(((const LAS float*)(L + O_CL))[16 * i + 4 * fqv + rr]);
#pragma unroll
                for (int kk = 0; kk < 2; ++kk) { hacc[i] = MFMA16(frag_t(SLOT(S_KT), kk, 16 * i, lo), frag_t(SLOT(S_V), kk, cw, lo), hacc[i]);
                    hacc[i] = MFMA16(frag_t(SLOT(S_BT), kk, 16 * i, lo), frag_n(SLOT(S_ZT), cw, kk, lo), hacc[i]); }
                st_tile_T(SLOT(hnxt), 16 * i, cw, lo, hacc[i]);
#pragma unroll
                for (int kk = 0; kk < 2; ++kk) if (32 * kk < 16 * i + 16) yacc[i] = MFMA16(frag_t(SLOT(S_MRB), kk, 16 * i, lo), frag_n(SLOT(S_ZT), cw, kk, lo), yacc[i]);
#pragma unroll
                for (int rr = 0; rr < 4; ++rr) ((LAS float*)(L + O_YB))[(16 * i + 4 * fqv + rr) * FP + cw + frv] = yacc[i][rr]; }
        }
#endif
        __syncthreads();
        { float y[8], g0[8], g1[8]; ld8l((const LAS float*)(L + O_YB) + tv * FP + c8v, y); ld8l((const LAS float*)(L + O_CST) + 10 * 64 + c8v, g0); ld8l((const LAS float*)(L + O_CST) + 11 * 64 + c8v, g1);
          float s = 0.f;
#pragma unroll
          for (int e = 0; e < 8; ++e) s += y[e];
          const float mean = sum8(s) * (1.f / 64.f); float q = 0.f;
#pragma unroll
          for (int e = 0; e < 8; ++e) { y[e] -= mean; q += y[e] * y[e]; }
          const float rs = rsqrtf(sum8(q) * (1.f / 64.f) + RWKV_GN_EPS);
#ifdef V_V
          float vv[8]; unpack8(*(const LAS u32x4*)(SLOT(S_V) + (tv * LP + c8v) * 2), vv);
#pragma unroll
          for (int e = 0; e < 8; ++e) y[e] = y[e] * rs * g0[e] + g1[e] + cb * vv[e];
#else
#pragma unroll
          for (int e = 0; e < 8; ++e) y[e] = y[e] * rs * g0[e] + g1[e] + cb * v[e];
#endif
          *(u32x4*)(Yout + ((size_t)b * SEQ + c * 64 + tv) * 512 + h * 64 + c8v) = pack8(y); }
        { const int tmp = hcur; hcur = hnxt; hnxt = tmp; }
    }
    __syncthreads();
#undef SLOT
#undef RWKV_LOAD
}
}

namespace gla {
using rwkv::vtr; using rwkv::unpack8; using rwkv::pack8; using rwkv::ld8l; using rwkv::ex2; using rwkv::LOG2E; using rwkv::LN2; using rwkv::MFMA16;
constexpr int LP = 72, VP = 136, TB = 64 * LP * 2;
constexpr int B_QH = 0, B_KH = TB, B_KT = 2 * TB, B_PT = 3 * TB, B_VV = 4 * TB, B_ST = B_VV + 64 * VP * 2, B_OB = B_ST + 128 * LP * 2, B_WT = B_OB + 64 * 132 * 4,
              B_CL = B_WT + 8 * 64 * 4, B_AUP = B_CL + 64 * 4, B_AB = B_AUP + 16 * 64 * 4, B_GN = B_AB + 64 * 4, B_END = B_GN + 128 * 4;
static_assert(B_END <= 131072, "gla lds");
struct LaneOff { int bn, bt, btv, bs; };
__device__ __forceinline__ LaneOff lane_off(int fr, int fq) { LaneOff o; o.bn = (fr * LP + 8 * fq) * 2; o.bt = ((8 * fq + (fr >> 2)) * LP + 4 * (fr & 3)) * 2; o.btv = ((8 * fq + (fr >> 2)) * VP + 4 * (fr & 3)) * 2; o.bs = (fr * LP + 4 * fq) * 2; return o; }
__device__ __forceinline__ void relaunder(LaneOff& o) { asm volatile("" : "+v"(o.bn), "+v"(o.bt), "+v"(o.btv), "+v"(o.bs)); }
__device__ __forceinline__ bf16x8 frag_t(const LAS unsigned char* tile, int kk, int c0, const LaneOff& o) {
    const LAS unsigned char* q = tile + o.bt + (32 * kk * LP + c0) * 2; const s16x4 lo = vtr(q), hi = vtr(q + 4 * LP * 2); return (bf16x8){lo[0], lo[1], lo[2], lo[3], hi[0], hi[1], hi[2], hi[3]}; }
__device__ __forceinline__ bf16x8 frag_tv(const LAS unsigned char* tile, int kk, int c0, const LaneOff& o) {
    const LAS unsigned char* q = tile + o.btv + (32 * kk * VP + c0) * 2; const s16x4 lo = vtr(q), hi = vtr(q + 4 * VP * 2); return (bf16x8){lo[0], lo[1], lo[2], lo[3], hi[0], hi[1], hi[2], hi[3]}; }
__device__ __forceinline__ bf16x8 frag_n(const LAS unsigned char* tile, int r0, int kk, const LaneOff& o) { return *(const LAS bf16x8*)(tile + o.bn + (r0 * LP + 32 * kk) * 2); }
__device__ __forceinline__ void st_tile_T(LAS unsigned char* tile, int m0, int n0, const LaneOff& o, const f32x4 c) { u32x2 w; w.x = pk2(c[0], c[1]); w.y = pk2(c[2], c[3]); *(LAS u32x2*)(tile + o.bs + (n0 * LP + m0) * 2) = w; }

__device__ __forceinline__ void gla_unit(int l, int b, int h, LAS unsigned char* L, unsigned* done_ctr) {
    const Params p = load_params();
    const bf16_t* PA = (const bf16_t*)(p.ws + WS_PA); bf16_t* Yout = (bf16_t*)(p.ws + WS_YS) + (size_t)2 * T * 512;
    const int tid = opaque_tid(), lane = tid & 63, fr = lane & 15, fq = lane >> 4; const int w = __builtin_amdgcn_readfirstlane(tid >> 6);
    const int t = tid >> 3, c8 = (tid & 7) * 8;
    LaneOff lo = lane_off(fr, fq);
    for (int e = tid; e < 16 * 64; e += 512) ((LAS float*)(L + B_AUP))[e] = p.gla_a_up[(size_t)l * 16 * 256 + (e >> 6) * 256 + h * 64 + (e & 63)];
    if (tid < 64) ((LAS float*)(L + B_AB))[tid] = p.gla_a_b[l * 256 + h * 64 + tid];
    if (tid < 128) ((LAS float*)(L + B_GN))[tid] = p.gla_norm[l * 512 + h * 128 + tid];
    for (int e = tid; e < 128 * LP / 2; e += 512) ((LAS unsigned*)(L + B_ST))[e] = 0u;
    for (int e = tid; e < TB / 4; e += 512) ((LAS unsigned*)(L + B_PT))[e] = 0u;
    f32x4 sacc[4];
#pragma unroll
    for (int m = 0; m < 4; ++m) sacc[m] = (f32x4){0.f, 0.f, 0.f, 0.f};
    u32x4 rq, rk, rv0, rv1, rl0, rl1;
#define GLA_LOAD(c) do { const bf16_t* s_ = PA + ((size_t)b * SEQ + (c) * 64 + t) * NA; rq = *(const u32x4*)(s_ + GQ + h * 64 + c8); rk = *(const u32x4*)(s_ + GK + h * 64 + c8); \
        rv0 = *(const u32x4*)(s_ + GV + h * 128 + 2 * c8); rv1 = *(const u32x4*)(s_ + GV + h * 128 + 2 * c8 + 8); rl0 = *(const u32x4*)(s_ + GLAT); rl1 = *(const u32x4*)(s_ + GLAT + 8); } while (0)
    GLA_LOAD(0);
    __syncthreads();
    for (int c = 0; c < SEQ / 64; ++c) {
        int c8v = c8, tv = t, frv = fr, fqv = fq; asm volatile("" : "+v"(c8v), "+v"(tv), "+v"(frv), "+v"(fqv));
        const int twv = tv & 7;
        float cs[8];
        { float lat[16]; { float a8[8]; unpack8(rl0, a8);
#pragma unroll
              for (int j = 0; j < 8; ++j) lat[j] = a8[j];
              unpack8(rl1, a8);
#pragma unroll
              for (int j = 0; j < 8; ++j) lat[8 + j] = a8[j]; }
          float z[8]; ld8l((const LAS float*)(L + B_AB) + c8v, z);
#pragma unroll
          for (int j = 0; j < 16; ++j) { float a8[8]; ld8l((const LAS float*)(L + B_AUP) + j * 64 + c8v, a8);
#pragma unroll
              for (int e = 0; e < 8; ++e) z[e] += lat[j] * a8[e]; }
#pragma unroll
          for (int e = 0; e < 8; ++e) { const float x = -z[e]; const float sp = fmaxf(x, 0.f) + LN2 * __builtin_amdgcn_logf(1.0f + ex2(-fabsf(x) * LOG2E));
              float v_ = -sp * (LOG2E / 16.0f);
              float y = __shfl_up(v_, 8); if (twv >= 1) v_ += y;
              y = __shfl_up(v_, 16); if (twv >= 2) v_ += y;
              y = __shfl_up(v_, 32); if (twv >= 4) v_ += y;
              cs[e] = v_; }
          if (twv == 7) { LAS float* WT = (LAS float*)(L + B_WT) + w * 64 + c8v;
#pragma unroll
              for (int e = 0; e < 8; ++e) WT[e] = cs[e]; } }
        __syncthreads();
        { float off[8], tot[8];
#pragma unroll
          for (int e = 0; e < 8; ++e) { off[e] = 0.f; tot[e] = 0.f; }
#pragma unroll
          for (int g = 0; g < 8; ++g) { float x[8]; ld8l((const LAS float*)(L + B_WT) + g * 64 + c8v, x);
#pragma unroll
              for (int e = 0; e < 8; ++e) { if (g < w) off[e] += x[e]; tot[e] += x[e]; } }
          if (tv == 0) { LAS float* CL = (LAS float*)(L + B_CL) + c8v;
#pragma unroll
              for (int e = 0; e < 8; ++e) CL[e] = tot[e]; }
          float q8[8], k8[8], o[8], en[8]; unpack8(rq, q8); unpack8(rk, k8); const int toff = (tv * LP + c8v) * 2;
#pragma unroll
          for (int e = 0; e < 8; ++e) { cs[e] += off[e]; en[e] = ex2(-cs[e]); o[e] = q8[e] * 0.125f * __builtin_amdgcn_rcpf(en[e]); }
          *(LAS u32x4*)(L + B_QH + toff) = pack8(o);
#pragma unroll
          for (int e = 0; e < 8; ++e) o[e] = k8[e] * en[e];
          *(LAS u32x4*)(L + B_KH + toff) = pack8(o);
#pragma unroll
          for (int e = 0; e < 8; ++e) o[e] = k8[e] * ex2(tot[e] - cs[e]);
          *(LAS u32x4*)(L + B_KT + toff) = pack8(o);
          *(LAS u32x4*)(L + B_VV + (tv * VP + 2 * c8v) * 2) = rv0; *(LAS u32x4*)(L + B_VV + (tv * VP + 2 * c8v + 8) * 2) = rv1; }
        if (c + 1 < SEQ / 64) GLA_LOAD(c + 1);
        __syncthreads();
        relaunder(lo);
        { const int m0 = 16 * (w >> 1);
#pragma unroll
          for (int nn = 0; nn < 2; ++nn) { const int n0 = 32 * (w & 1) + 16 * nn;
              if (n0 <= m0) { f32x4 a = {0.f, 0.f, 0.f, 0.f};
#pragma unroll
                  for (int kk = 0; kk < 2; ++kk) a = MFMA16(frag_n(L + B_QH, m0, kk, lo), frag_n(L + B_KH, n0, kk, lo), a);
                  if (n0 == m0) {
#pragma unroll
                      for (int rr = 0; rr < 4; ++rr) a[rr] = (frv <= 4 * fqv + rr) ? a[rr] : 0.f; }
                  st_tile_T(L + B_PT, m0, n0, lo, a); } } }
        __syncthreads();
        relaunder(lo);
        { const int n0 = 16 * w;
#pragma unroll
          for (int m = 0; m < 4; ++m) { f32x4 a = {0.f, 0.f, 0.f, 0.f};
#pragma unroll
              for (int kk = 0; kk < 2; ++kk) { if (32 * kk < 16 * m + 16) a = MFMA16(frag_t(L + B_PT, kk, 16 * m, lo), frag_tv(L + B_VV, kk, n0, lo), a);
                  a = MFMA16(frag_n(L + B_QH, 16 * m, kk, lo), frag_n(L + B_ST, n0, kk, lo), a); }
#pragma unroll
              for (int rr = 0; rr < 4; ++rr) ((LAS float*)(L + B_OB))[(16 * m + 4 * fqv + rr) * 132 + n0 + frv] = a[rr]; }
          asm volatile("" ::: "memory");
#pragma unroll
          for (int m = 0; m < 4; ++m) { f32x4 a = sacc[m];
#pragma unroll
              for (int rr = 0; rr < 4; ++rr) a[rr] *= ex2(((const LAS float*)(L + B_CL))[16 * m + 4 * fqv + rr]);
#pragma unroll
              for (int kk = 0; kk < 2; ++kk) a = MFMA16(frag_t(L + B_KT, kk, 16 * m, lo), frag_tv(L + B_VV, kk, n0, lo), a);
              sacc[m] = a; st_tile_T(L + B_ST, 16 * m, n0, lo, a); } }
        __syncthreads();
        { float v0[8], v1[8], g0[8], g1[8]; float ss = 0.f; const LAS float* ob = (const LAS float*)(L + B_OB) + tv * 132 + 2 * c8v;
          ld8l(ob, v0); ld8l(ob + 8, v1);
#pragma unroll
          for (int e = 0; e < 8; ++e) ss += v0[e] * v0[e] + v1[e] * v1[e];
          ss = sum8(ss);
          const float rstd = rsqrtf(ss * (1.f / 128.f) + NORM_EPS);
          ld8l((const LAS float*)(L + B_GN) + 2 * c8v, g0); ld8l((const LAS float*)(L + B_GN) + 2 * c8v + 8, g1);
          float o0[8], o1[8];
#pragma unroll
          for (int e = 0; e < 8; ++e) { o0[e] = v0[e] * rstd * g0[e]; o1[e] = v1[e] * rstd * g1[e]; }
          bf16_t* dst = Yout + ((size_t)b * SEQ + c * 64 + tv) * 512 + h * 128 + 2 * c8v;
          *(u32x4*)dst = pack8(o0); *(u32x4*)(dst + 8) = pack8(o1); }
    }
    asm volatile("s_waitcnt vmcnt(0)" ::: "memory");
    __syncthreads();
    if (tid == 0) __hip_atomic_fetch_add(done_ctr, 1u, __ATOMIC_RELEASE, __HIP_MEMORY_SCOPE_AGENT);
#undef GLA_LOAD
}
}

#define XB_TMO      128
#define XB_XCNT(j)  (256  + 64 * (j))
#define XB_XSUB(j)  (1280 + 64 * (j))
#define XB_XGEN(j)  (2304 + 64 * (j))
#define XB_TOP      3328
#define XB_TOPGEN   3392
#define XCD_BAR_WORDS 3456
#define XB_SPIN_CAP (1u << 18)

__device__ __forceinline__ unsigned xb_ld(unsigned* p)              { return __hip_atomic_load(p, __ATOMIC_RELAXED, __HIP_MEMORY_SCOPE_AGENT); }
__device__ __forceinline__ unsigned xb_add(unsigned* p, unsigned v) { return __hip_atomic_fetch_add(p, v, __ATOMIC_RELAXED, __HIP_MEMORY_SCOPE_AGENT); }
__device__ __forceinline__ unsigned xb_xcc_id() { return (unsigned)__builtin_amdgcn_s_getreg((3 << 11) | 20) & 0xFu; }
#define XB_SPIN(cond, bar) do { unsigned _sp = 0; while (cond) { __builtin_amdgcn_s_sleep(1); \
    if ((++_sp & 255u) == 0u) { if (xb_ld(&(bar)[XB_TMO])) break; if (_sp > XB_SPIN_CAP) { atomicAdd(&(bar)[XB_TMO], 1u); break; } } } } while (0)

struct XcdBarrier {
    unsigned* bar; unsigned x;
    volatile LAS unsigned* st;
};

__device__ __forceinline__ XcdBarrier xcd_barrier_post(unsigned* bar, volatile LAS unsigned* st) {
    XcdBarrier b; b.bar = bar; b.x = xb_xcc_id(); b.st = st;
    if (threadIdx.x == 0) (void)xb_add(&bar[XB_XCNT(b.x)], 1u);
    return b;
}
__device__ __forceinline__ void xcd_barrier_complete(unsigned* bar, unsigned x, unsigned& nloc, unsigned& nx) {
    const unsigned G = gridDim.x * gridDim.y * gridDim.z;
    unsigned sum, cnt, mine, sp = 0u;
    for (;;) {
        sum = 0u; cnt = 0u; mine = 0u;
#pragma unroll
        for (unsigned j = 0; j < 16; ++j) { const unsigned c = xb_ld(&bar[XB_XCNT(j)]); sum += c; cnt += (c > 0u) ? 1u : 0u; mine = (j == x) ? c : mine; }
        if (sum == G) break;
        __builtin_amdgcn_s_sleep(1);
        if ((++sp & 255u) == 0u) { if (xb_ld(&bar[XB_TMO])) break; if (sp > XB_SPIN_CAP) { atomicAdd(&bar[XB_TMO], 1u); break; } }
    }
    nloc = mine > 0u ? mine : 1u; nx = cnt > 0u ? cnt : 1u;
}

__device__ __forceinline__ void xcd_barrier(const XcdBarrier& b) {
    asm volatile("s_waitcnt vmcnt(0)" ::: "memory");
    __syncthreads();
    if (threadIdx.x == 0) {
        unsigned* bar = b.bar;
        __builtin_amdgcn_s_waitcnt(0);
        unsigned nloc = b.st[0], nx = b.st[1];
        if (nloc == 0u) { xcd_barrier_complete(bar, b.x, nloc, nx); b.st[0] = nloc; b.st[1] = nx; }
        const unsigned old = xb_add(&bar[XB_XSUB(b.x)], 1u);
        const unsigned gen = old / nloc;
        if (old + 1u == (gen + 1u) * nloc) {
            __builtin_amdgcn_fence(__ATOMIC_RELEASE, "agent");
            asm volatile("s_waitcnt vmcnt(0)" ::: "memory");
            const unsigned og = xb_add(&bar[XB_TOP], 1u);
            const unsigned tg = og / nx;
            if (og + 1u == (tg + 1u) * nx) xb_add(&bar[XB_TOPGEN], 1u);
            else XB_SPIN(xb_ld(&bar[XB_TOPGEN]) == tg, bar);
            __builtin_amdgcn_fence(__ATOMIC_ACQUIRE, "agent");
            xb_add(&bar[XB_XGEN(b.x)], 1u);
            asm volatile("s_waitcnt vmcnt(0)" ::: "memory");
        } else {
            XB_SPIN(xb_ld(&bar[XB_XGEN(b.x)]) == gen, bar);
            __builtin_amdgcn_fence(__ATOMIC_ACQUIRE, "agent");
            asm volatile("s_waitcnt vmcnt(0)" ::: "memory");
        }
    }
    __syncthreads();
}

constexpr int NWAVES = 8, NTHREADS = 512;
constexpr int LDS_MISC = 155648, LDS_BYTES = 159744;
constexpr int PH_PER_LAYER = 8, N_PHASES = 1 + DEPTH * PH_PER_LAYER;
constexpr int CW_BAR = 4096;
constexpr int MG_BLOCKS = 192;
constexpr int RWKV_BLOCKS = 64, SUB_BLOCKS = 256 - RWKV_BLOCKS;
constexpr int N_ATT_UNITS = 64 * (SEQ / 512), N_MIX_ITEMS = 32 + N_ATT_UNITS;
#ifndef MK_MULTI_LAUNCH
#define MK_MULTI_LAUNCH 0
#endif

__device__ __forceinline__ void sub_barrier(unsigned* cnt, unsigned target) {
    asm volatile("s_waitcnt vmcnt(0)" ::: "memory");
    __syncthreads();
    if (threadIdx.x == 0) {
        __builtin_amdgcn_fence(__ATOMIC_RELEASE, "agent"); asm volatile("s_waitcnt vmcnt(0)" ::: "memory");
        __hip_atomic_fetch_add(cnt, 1u, __ATOMIC_RELAXED, __HIP_MEMORY_SCOPE_AGENT);
        unsigned sp = 0; while (__hip_atomic_load(cnt, __ATOMIC_RELAXED, __HIP_MEMORY_SCOPE_AGENT) < target && ++sp < (1u << 24)) __builtin_amdgcn_s_sleep(2);
        __builtin_amdgcn_fence(__ATOMIC_ACQUIRE, "agent"); asm volatile("s_waitcnt vmcnt(0)" ::: "memory");
    }
    __syncthreads();
}
__global__ void __launch_bounds__(NTHREADS, 2) hybrid_fwd(Params p_unused) {
    extern __shared__ __attribute__((aligned(16))) unsigned char lds[];
    cg::grid_group grid = cg::this_grid();
#define G ((int)gridDim.x)
#define bx ((int)blockIdx.x)
#define NGW (G * NWAVES)
#define PHASE_VARS const int tid = opaque_tid(), lane = tid & 63, wave = __builtin_amdgcn_readfirstlane(tid >> 6), gw = bx * NWAVES + wave; (void)lane; (void)gw
    LAS unsigned char* ldsl = (LAS unsigned char*)lds;
    { volatile LAS unsigned* misc = (volatile LAS unsigned*)(ldsl + LDS_MISC); if (threadIdx.x < 64) misc[threadIdx.x] = 0u; __syncthreads(); }
    (void)xcd_barrier_post((unsigned*)(kargs()->ws + WS_CTL) + CW_BAR, (volatile LAS unsigned*)(ldsl + LDS_MISC) + 8);
#define GRID_BAR() do { XcdBarrier xb_; xb_.bar = (unsigned*)(kargs()->ws + WS_CTL) + CW_BAR; xb_.x = xb_xcc_id(); xb_.st = (volatile LAS unsigned*)(ldsl + LDS_MISC) + 8; xcd_barrier(xb_); } while (0)
#ifndef EPI_ALIGN_PD1
#define EPI_ALIGN_PD1 true
#endif
#ifndef EPI_ALIGN_PA2
#define EPI_ALIGN_PA2 true
#endif
#ifndef REPEAT_PH
#define REPEAT_PH 0
#endif
#ifndef PH_MASK
#define PH_MASK 0xFFFF
#endif
#ifndef MIX_MASK
#define MIX_MASK 7
#endif
#define IN(k) true
#define EN(b) ((PH_MASK >> (b)) & 1)
#define SEAM(k) do { if (IN(k) && IN((k) + 1)) { if ((k) == 0) grid.sync(); else GRID_BAR(); } } while (0)
#define WSP(type, off) ((type*)(ws + (off)))

    if (EN(0) && IN(0)) { PHASE_VARS;
        convert_weights(0, lds, gw, NGW, wave, lane);
        KArgs kp = kargs(); unsigned char* ws = kp->ws; const int* positions = kp->positions; const float* x = kp->x; const float* g = kp->norm_pre;
        f32x2* ROPE = WSP(f32x2, WS_ROPE); bf16_t* HB = WSP(bf16_t, WS_HB);
        for (int i = bx * NTHREADS + tid; i < T * 16; i += G * NTHREADS) {
            const int t = i >> 4, j = i & 15; const float inv = exp2f(-(float)j * (13.287712379549449f / 16.0f));
            const float ang = (float)positions[t] * inv; const float k = rintf(ang * 0.15915494309189535f);
            float r = fmaf(-k, 6.2831854820251465f, ang); r = fmaf(-k, -1.7484555314695172e-7f, r);
            ROPE[i] = (f32x2){__cosf(r), __sinf(r)};
        }
        for (int m = gw; m < T; m += 4 * NGW) hb_rows4(x, g, HB, m, NGW, lane);
    }
    SEAM(0);
#ifdef EXTRA_SYNCS
    for (int i = 0; i < EXTRA_SYNCS; ++i) GRID_BAR();
#endif

    for (int l = 0; l < DEPTH; ++l) {
        const int P0 = 1 + l * PH_PER_LAYER;
        for (int rp = 0; rp < ((REPEAT_PH == 1) ? 2 : 1); ++rp) { if (rp) GRID_BAR();
        if (EN(1) && IN(P0 + 0)) {
            unsigned char* ws = kargs()->ws;
            pg8::PlainOrder S{(const char*)WSP(bf16_t, WS_HB), (const char*)WSP(bf16_t, WS_WIN), 1024, 1024, T / 256, NA / 256, G, bx, 0};
            EpiStore E{WSP(bf16_t, WS_PA), NA, ldsl};
#ifdef STAGGER_US
            if (bx >= 128) { const unsigned long long t0_ = __builtin_amdgcn_s_memrealtime(); while (__builtin_amdgcn_s_memrealtime() - t0_ < (unsigned long long)(STAGGER_US * 100)) __builtin_amdgcn_s_sleep(8); }
#endif
            pg8::gemm_phase<EpiStore, pg8::PlainOrder, true>(ldsl, pg8::Gemm{1024, 1024, 1024}, S, E);
#ifdef PROBE_PA1NULL
#endif
        }
        }
        SEAM(P0 + 0);
        if (EN(2) && IN(P0 + 1)) { PHASE_VARS;
            if (bx >= RWKV_BLOCKS) {
                unsigned char* ws = kargs()->ws; const int c2 = bx - RWKV_BLOCKS;
                { const bf16_t* PA = WSP(bf16_t, WS_PA); const f32x2* ROPE = WSP(f32x2, WS_ROPE); float* RSTDQ = WSP(float, WS_RSTD); float* RSTDKV = RSTDQ + T; bf16_t* Kb = WSP(bf16_t, WS_K);
                  for (int m = c2 * NWAVES + wave; m < T; m += 4 * SUB_BLOCKS * NWAVES) mla_prep_rows4(PA, ROPE, RSTDQ, RSTDKV, Kb, m, SUB_BLOCKS * NWAVES, lane); }
                sub_barrier((unsigned*)(ws + WS_CTL) + 64 * 40, (unsigned)SUB_BLOCKS * (unsigned)(2 * l + 1));
                { pg8::PlainOrder S{(const char*)(WSP(bf16_t, WS_PA) + CQ), (const char*)WSP(bf16_t, WS_WUQ), NA, 256, T / 256, 3, SUB_BLOCKS, c2, 0};
                  EpiQ E{WSP(bf16_t, WS_Q), WSP(float, WS_RSTD), ldsl};
                  pg8::gemm_phase<EpiQ, pg8::PlainOrder, true>(ldsl, pg8::Gemm{NA, 256, 256}, S, E); }
                { pg8::PlainOrder S{(const char*)(WSP(bf16_t, WS_PA) + CKV), (const char*)WSP(bf16_t, WS_WUKV), NA, 256, T / 256, 4, SUB_BLOCKS, c2, 0};
                  EpiKV E{WSP(bf16_t, WS_K), WSP(bf16_t, WS_V), WSP(float, WS_RSTD) + T, ldsl};
                  pg8::gemm_phase<EpiKV, pg8::PlainOrder, true>(ldsl, pg8::Gemm{NA, 256, 256}, S, E); }
                sub_barrier((unsigned*)(kargs()->ws + WS_CTL) + 64 * 40, (unsigned)SUB_BLOCKS * (unsigned)(2 * l + 2));
            } else {
#ifdef RWKV_TWICE
#pragma unroll 1
                for (int rep_ = 0; rep_ < RWKV_TWICE; ++rep_) { rwkv::rwkv_unit(l, bx >> 3, bx & 7, ldsl); __syncthreads(); }
#else
                rwkv::rwkv_unit(l, bx >> 3, bx & 7, ldsl);
#endif
                if (threadIdx.x == 0) { unsigned* cnt = (unsigned*)(kargs()->ws + WS_CTL) + 64 * 40; unsigned sp = 0;
                    while (__hip_atomic_load(cnt, __ATOMIC_RELAXED, __HIP_MEMORY_SCOPE_AGENT) < (unsigned)SUB_BLOCKS * (unsigned)(2 * l + 2) && ++sp < (1u << 24)) __builtin_amdgcn_s_sleep(2);
                    __builtin_amdgcn_fence(__ATOMIC_ACQUIRE, "agent"); asm volatile("s_waitcnt vmcnt(0)" ::: "memory"); }
                __syncthreads();
            }
        }
        if (EN(4) && IN(P0 + 3)) { PHASE_VARS;
            volatile LAS unsigned* qw = (volatile LAS unsigned*)(ldsl + LDS_MISC);
            for (;;) {
                __syncthreads();
                if (tid == 0) { unsigned* CTL = (unsigned*)(kargs()->ws + WS_CTL); qw[0] = atomicAdd(CTL + 64 * (1 + l), 1u); }
                __syncthreads();
                const int it = __builtin_amdgcn_readfirstlane((int)qw[0]);
                if (it >= N_MIX_ITEMS) break;
                if (it < 32) gla::gla_unit(l, it >> 2, it & 3, ldsl, (unsigned*)(kargs()->ws + WS_CTL) + 64 * (24 + l));
                else { const int a = it - 32; att::attn_unit((a & 63) >> 3, a & 7, (SEQ / 512 - 1) - (a >> 6), ldsl, (unsigned*)(kargs()->ws + WS_CTL) + 64 * (16 + l)); }
            }
            { unsigned* ctl = (unsigned*)(kargs()->ws + WS_CTL);
              __syncthreads();
              if (tid == 0) { const unsigned tk = __hip_atomic_fetch_add(ctl + 64 * (20 + l), 1u, __ATOMIC_RELAXED, __HIP_MEMORY_SCOPE_AGENT); qw[0] = tk;
                  if (tk < (unsigned)MG_BLOCKS) { unsigned sp = 0; while (__hip_atomic_load(ctl + 64 * (16 + l), __ATOMIC_RELAXED, __HIP_MEMORY_SCOPE_AGENT) < (unsigned)N_ATT_UNITS && ++sp < (1u << 22)) __builtin_amdgcn_s_sleep(8); }
                  __builtin_amdgcn_fence(__ATOMIC_ACQUIRE, "agent"); asm volatile("s_waitcnt vmcnt(0)" ::: "memory"); }
              __syncthreads();
              const int tk = __builtin_amdgcn_readfirstlane((int)qw[0]);
              if (tk < MG_BLOCKS) {
                  unsigned char* ws = kargs()->ws;
                  pg8::PlainOrder S{(const char*)WSP(bf16_t, WS_HB), (const char*)(WSP(bf16_t, WS_WIN) + (size_t)(NA + 1536) * 1024), 1024, 1024, T / 256, 12, MG_BLOCKS, tk, 0};
                  EpiGateMG8 E{WSP(unsigned char, WS_SMG8), ldsl};
                  pg8::gemm_phase<EpiGateMG8, pg8::PlainOrder, true>(ldsl, pg8::Gemm{1024, 1024, 1024}, S, E);
                  __syncthreads();
                  if (tid == 0) { unsigned sp = 0; while (__hip_atomic_load(ctl + 64 * (24 + l), __ATOMIC_RELAXED, __HIP_MEMORY_SCOPE_AGENT) < 32u && ++sp < (1u << 22)) __builtin_amdgcn_s_sleep(8);
                      __builtin_amdgcn_fence(__ATOMIC_ACQUIRE, "agent"); asm volatile("s_waitcnt vmcnt(0)" ::: "memory"); }
                  __syncthreads();
                  pg8::PlainOrder S2{(const char*)WSP(bf16_t, WS_HB), (const char*)(WSP(bf16_t, WS_WIN) + (size_t)NA * 1024), 1024, 1024, T / 256, 4, MG_BLOCKS, tk, 2};
                  EpiGateBG E2{WSP(bf16_t, WS_YS), 0, 2, ldsl};
                  pg8::gemm_phase<EpiGateBG, pg8::PlainOrder, true>(ldsl, pg8::Gemm{1024, 1024, 1024}, S2, E2);
              } }
        }
        SEAM(P0 + 3);
        if (EN(5) && IN(P0 + 4)) {
            unsigned char* ws = kargs()->ws;
            pg8::PlainOrder S{(const char*)WSP(bf16_t, WS_HB), (const char*)(WSP(bf16_t, WS_WIN) + (size_t)(NA + 512) * 1024), 1024, 1024, T / 256, 2, G, bx, 0};
            EpiGateBG E{WSP(bf16_t, WS_YS), 2, 0, ldsl};
            pg8::gemm_phase<EpiGateBG, pg8::PlainOrder, true>(ldsl, pg8::Gemm{1024, 1024, 1024}, S, E);
        }
        SEAM(P0 + 4);
        for (int rp = 0; rp < ((REPEAT_PH == 6 && l == 0) ? 2 : 1); ++rp) { if (rp) GRID_BAR();
        if (EN(6) && IN(P0 + 5)) {
            unsigned char* ws = kargs()->ws;
            pg8::GroupOrder3 S{(const char*)WSP(bf16_t, WS_YS), (const char*)WSP(bf16_t, WS_WBO), 512, 512, T / 256, 4, G, bx, (size_t)T * 512 * 2, (size_t)1024 * 512 * 2};
            EpiMerge E{WSP(bf16_t, WS_MG), WSP(unsigned char, WS_SMG8), ldsl};
            pg8::gemm_phase<EpiMerge, pg8::GroupOrder3, EPI_ALIGN_PD1>(ldsl, pg8::Gemm{512, 512, 512}, S, E);
        }
        }
        SEAM(P0 + 5);
        for (int rp = 0; rp < ((REPEAT_PH == 7 && l == 0) ? 2 : 1); ++rp) { if (rp) GRID_BAR();
        if (EN(7) && IN(P0 + 6)) {
            unsigned char* ws = kargs()->ws;
            pg8::PlainOrder S{(const char*)WSP(bf16_t, WS_MG), (const char*)WSP(bf16_t, WS_WOUT), 1024, 1024, T / 256, 4, G, bx, 0};
            EpiStore E{WSP(bf16_t, WS_OF), 1024, ldsl};
            pg8::gemm_phase<EpiStore, pg8::PlainOrder, true>(ldsl, pg8::Gemm{1024, 1024, 1024}, S, E);
        }
        }
        SEAM(P0 + 6);
        if (EN(8) && IN(P0 + 7)) { PHASE_VARS;
            const bool more = (l + 1 < DEPTH);
            if (more) convert_weights(l + 1, lds, gw, NGW, wave, lane);
            KArgs kp = kargs(); unsigned char* ws = kp->ws; float* out = kp->out; const float* xold = (l == 0) ? kp->x : out; const float* gpost = kp->norm_post + l * DM; const float* gnext = more ? kp->norm_pre + (l + 1) * DM : nullptr;
            const bf16_t* OF = WSP(bf16_t, WS_OF); bf16_t* HB = WSP(bf16_t, WS_HB);
#define PD3_LOOP(XI, XO) for (int m = gw; m < T; m += 4 * NGW) { RowIn<XI> rr_[4];     \
                _Pragma("unroll") for (int q_ = 0; q_ < 4; ++q_) final_load<XI>(rr_[q_], OF + (size_t)(m + q_ * NGW) * DM, xold + (size_t)(m + q_ * NGW) * DM, lane); \
                _Pragma("unroll") for (int q_ = 0; q_ < 4; ++q_) final_row<XI, XO>(rr_[q_], gpost, out + (size_t)(m + q_ * NGW) * DM, gnext, HB + (size_t)(m + q_ * NGW) * DM, lane); }
            if (l == 0) { if (more) { PD3_LOOP(false, true) } else { PD3_LOOP(false, false) } }
            else        { if (more) { PD3_LOOP(true, true) } else { PD3_LOOP(true, false) } }
#undef PD3_LOOP
        }
        if (l + 1 < DEPTH) SEAM(P0 + 7);
    }
#undef IN
#undef EN
#undef SEAM
#undef WSP
#undef PHASE_VARS
#undef G
#undef bx
#undef NGW
}

extern "C" void kernel_launch(void* const* d_in, const int* in_sizes, int n_in, void* d_out, int out_size, void* d_ws, size_t ws_size, hipStream_t stream) {
    static int grid = 0;
    if (grid == 0) {
        if (n_in != 24 || in_sizes[0] != T * DM || out_size != T * DM || ws_size < WS_END) {
            fprintf(stderr, "kernel_launch: unexpected shapes (n_in %d, in0 %d, out %d, ws %zu; need ws >= %zu); nothing launched\n", n_in, n_in > 0 ? in_sizes[0] : -1, out_size, ws_size, (size_t)WS_END);
            grid = -1; return; }
        int dev = 0, cus = 0, per_cu = 0;
        (void)hipGetDevice(&dev); (void)hipDeviceGetAttribute(&cus, hipDeviceAttributeMultiprocessorCount, dev);
        if (hipFuncSetAttribute((const void*)hybrid_fwd, hipFuncAttributeMaxDynamicSharedMemorySize, LDS_BYTES) != hipSuccess) { fprintf(stderr, "kernel_launch: hipFuncSetAttribute failed\n"); grid = -1; return; }
        if (hipOccupancyMaxActiveBlocksPerMultiprocessor(&per_cu, (const void*)hybrid_fwd, NTHREADS, LDS_BYTES) != hipSuccess || per_cu < 1) {
            fprintf(stderr, "kernel_launch: occupancy query reports %d blocks per CU\n", per_cu); per_cu = 1; }
        (void)hipGetLastError();
        grid = cus * (per_cu < 1 ? 1 : 1);
        fprintf(stderr, "kernel_launch: grid %d (cus %d, occupancy %d), ws %zu\n", grid, cus, per_cu, ws_size);
    }
    if (grid < 0) return;
    (void)hipMemsetAsync((char*)d_ws + WS_CTL, 0, 65536, stream);
    Params p{};
    p.x = (const float*)d_in[0]; p.positions = (const int*)d_in[1]; p.norm_pre = (const float*)d_in[2]; p.w_in = (const float*)d_in[3]; p.mla_q_norm = (const float*)d_in[4]; p.mla_kv_norm = (const float*)d_in[5];
    p.mla_w_uq = (const float*)d_in[6]; p.mla_w_ukv = (const float*)d_in[7]; p.rwkv_mu = (const float*)d_in[8]; p.rwkv_w0 = (const float*)d_in[9]; p.rwkv_w_up = (const float*)d_in[10]; p.rwkv_a0 = (const float*)d_in[11];
    p.rwkv_a_up = (const float*)d_in[12]; p.rwkv_k_k = (const float*)d_in[13]; p.rwkv_k_a = (const float*)d_in[14]; p.rwkv_r_k = (const float*)d_in[15]; p.rwkv_ln_w = (const float*)d_in[16]; p.rwkv_ln_b = (const float*)d_in[17];
    p.gla_a_up = (const float*)d_in[18]; p.gla_a_b = (const float*)d_in[19]; p.gla_norm = (const float*)d_in[20]; p.w_branch_out = (const float*)d_in[21]; p.w_out = (const float*)d_in[22]; p.norm_post = (const float*)d_in[23];
    p.out = (float*)d_out; p.ws = (unsigned char*)d_ws;
#if MK_MULTI_LAUNCH
    for (int ph = 0; ph < N_PHASES; ++ph) { p.ph_lo = ph; p.ph_hi = ph + 1; void* args[] = {&p};
        hipError_t e = hipLaunchCooperativeKernel((const void*)hybrid_fwd, dim3(grid), dim3(NTHREADS), args, LDS_BYTES, stream);
        if (e != hipSuccess) { fprintf(stderr, "kernel_launch: launch of phase %d failed: %s\n", ph, hipGetErrorString(e)); break; } }
#else
    p.ph_lo = 0; p.ph_hi = N_PHASES; void* args[] = {&p};
    hipError_t e = hipLaunchCooperativeKernel((const void*)hybrid_fwd, dim3(grid), dim3(NTHREADS), args, LDS_BYTES, stream);
    if (e != hipSuccess) fprintf(stderr, "kernel_launch: cooperative launch failed: %s (grid %d)\n", hipGetErrorString(e), grid);
#endif
}
```

```cpp
#include <hip/hip_runtime.h>
#include <hip/hip_cooperative_groups.h>
#include <cstdio>
#include <cstdint>
#include <cmath>
namespace cg = cooperative_groups;
#define U_P2 1
#define U_P5 1
#define U_P7 1
#define V_A 1
#define V_B 1
#define V_V 1
#define NO_CG_SYNC 1
namespace pg8 {
#define PG8_LAS __attribute__((address_space(3)))
typedef unsigned short bf16_t;
typedef short bf16x8 __attribute__((ext_vector_type(8)));
typedef float f32x4 __attribute__((ext_vector_type(4)));
typedef unsigned u32x4 __attribute__((ext_vector_type(4)));
typedef unsigned u32x2 __attribute__((ext_vector_type(2)));
constexpr int BM = 256, BK = 64, HALF = 128, HTB = HALF * BK * 2  , STAGE_BYTES = 8 * HTB, NXCD = 8, WGM = 8;

__host__ __device__ __forceinline__ int lds_byte(int r, int c) { const int st = (r >> 4) * 2 + (c >> 5), rr = r & 15, cc = c & 31, ob = rr * 64 + cc * 2; return st * 1024 + (ob ^ (((ob >> 9) & 1) << 5)); }
__host__ __device__ __forceinline__ void stage_rc(int b, int& R, int& C) { const int st = b / 1024, sb = b % 1024, swz = sb ^ (((sb >> 9) & 1) << 5); R = (st >> 1) * 16 + swz / 64; C = (st & 1) * 32 + (swz % 64) / 2; }
__host__ __device__ __forceinline__ int perm32(int rho) { const int n = rho >> 4, i = rho & 15; return 8 * (i >> 2) + 4 * n + (i & 3); }

struct Unit { int pm, pn, aux; const char* A; const char* B; };
struct Gemm { int lda, ldb, K; };

__device__ __forceinline__ void tile_of(int L, int nM, int nN, int& pm, int& pn) {
    const int nwg = nM * nN; int wgid = L;
    { const int q = nwg / NXCD, r = nwg % NXCD, xcd = wgid % NXCD, off = wgid / NXCD; wgid = (xcd < r ? xcd * (q + 1) : r * (q + 1) + (xcd - r) * q) + off; }
    const int nig = WGM * nN, gid = wgid / nig, fm = gid * WGM, gsz = (nM - fm) < WGM ? (nM - fm) : WGM;
    pm = fm + ((wgid % nig) % gsz); pn = (wgid % nig) / gsz;
}
struct PlainOrder {
    const char* A; const char* Bt; int lda, ldb, nM, nN, G, c, bskip;
    int base = 0, cnt = -1;
    __device__ __forceinline__ bool next(int i, Unit& u) const {
        const long Lr = (long)i * G + c; if (Lr >= (long)(cnt >= 0 ? cnt : nM * nN)) return false;
        const long L = Lr + base;
        tile_of((int)L, nM, nN, u.pm, u.pn); u.aux = 0;
        u.A = A + (size_t)u.pm * BM * lda * 2; u.B = Bt + (size_t)(u.pn + ((u.pn >= 2) ? bskip : 0)) * BM * ldb * 2; return true;
    }
};
struct GroupOrder3 {
    const char* A; const char* Bt; int lda, ldb, nM, nN, G, c; size_t a_gstride, b_gstride;
    __device__ __forceinline__ bool next(int i, Unit& u) const {
        const int n = i % 3; const long L = (long)(i / 3) * G + c; if (L >= (long)nM * nN) return false;
        tile_of((int)L, nM, nN, u.pm, u.pn); u.aux = n;
        u.A = A + n * a_gstride + (size_t)u.pm * BM * lda * 2; u.B = Bt + n * b_gstride + (size_t)u.pn * BM * ldb * 2; return true;
    }
};

template <class Epi, class Sched, bool ALIGN_EPI>
__device__ __forceinline__ void gemm_phase(PG8_LAS unsigned char* lds, const Gemm g, const Sched& S, const Epi& E) {
    int tid_ = threadIdx.x; asm volatile("" : "+v"(tid_));
    const int tid = tid_, wid = __builtin_amdgcn_readfirstlane(tid >> 6), lane = tid & 63, wr = wid >> 2, wc = wid & 3, fr = lane & 15, fq = lane >> 4;
    const int K = g.K, nt = K / BK;
    unsigned voffA[2], voffB[2];
#pragma unroll
    for (int i = 0; i < 2; ++i) { int R, C; stage_rc(tid * 16 + i * 8192, R, C); const int Rb = (int)Epi::PERM == 2 ? (64 * (R >> 5) + perm32(R & 31)) : (int)Epi::PERM == 1 ? ((R & ~31) + perm32(R & 31)) : R;
        voffA[i] = (unsigned)(R * g.lda + C) * 2u; voffB[i] = (unsigned)(Rb * g.ldb + C) * 2u; }
    const size_t kstep = (size_t)(BK * 2);
    const size_t hstepA = (size_t)HALF * g.lda * 2, hstepB = (size_t)((int)Epi::PERM == 2 ? 32 : HALF) * g.ldb * 2;
    const unsigned ldsw = (unsigned)wid * 1024u;
    const int aoff = lds_byte(wr * 64 + fr, fq * 8), boff = lds_byte(wc * 32 + fr, fq * 8);
#define PG8_SA(b, h) (((b) * 2 + (h)) * HTB)
#define PG8_SB(b, h) ((4 + (b) * 2 + (h)) * HTB)
#define PG8_STAGE(bufoff, gbase, voff) do { _Pragma("unroll") for (int _i = 0; _i < 2; ++_i) \
        __builtin_amdgcn_global_load_lds((const unsigned*)((const char*)(gbase) + (voff)[_i]), (PG8_LAS unsigned*)(lds + (bufoff) + ldsw + _i * 8192), 16, 0, 0); } while (0)
#define PG8_LDA(dst, b, h) do { _Pragma("unroll") for (int m = 0; m < 4; ++m) _Pragma("unroll") for (int k = 0; k < 2; ++k) dst[m][k] = *(const PG8_LAS bf16x8*)(lds + PG8_SA(b, h) + aoff + m * 2048 + k * 1024); } while (0)
#define PG8_LDB(dst, b, h) do { _Pragma("unroll") for (int n = 0; n < 2; ++n) _Pragma("unroll") for (int k = 0; k < 2; ++k) dst[n][k] = *(const PG8_LAS bf16x8*)(lds + PG8_SB(b, h) + boff + n * 2048 + k * 1024); } while (0)
#define PG8_MMA(ai, bj, At, Bt) do { __builtin_amdgcn_s_setprio(1); _Pragma("unroll") for (int m = 0; m < 4; ++m) _Pragma("unroll") for (int n = 0; n < 2; ++n) _Pragma("unroll") for (int k = 0; k < 2; ++k) \
        acc[ai][bj][m][n] = __builtin_amdgcn_mfma_f32_16x16x32_bf16(Bt[n][k], At[m][k], acc[ai][bj][m][n], 0, 0, 0); __builtin_amdgcn_s_setprio(0); } while (0)
#define PG8_WAIT_V(n) asm volatile("s_waitcnt vmcnt(" #n ")" ::: "memory")
#define PG8_WAIT_L(n) asm volatile("s_waitcnt lgkmcnt(" #n ")" ::: "memory")
#define PG8_BAR __builtin_amdgcn_s_barrier()
#define PG8_SCHED __builtin_amdgcn_sched_barrier(0)
    Unit cur, nxt; int ui = 0;
    if (!S.next(0, cur)) return;
    f32x4 acc[2][2][4][2];
#pragma unroll
    for (int a = 0; a < 2; ++a)
#pragma unroll
        for (int b = 0; b < 2; ++b)
#pragma unroll
            for (int m = 0; m < 4; ++m)
#pragma unroll
                for (int n = 0; n < 2; ++n) acc[a][b][m][n] = (f32x4){0.f, 0.f, 0.f, 0.f};
    bf16x8 At[4][2], B0[2][2], B1[2][2];
    const char* cA = cur.A; const char* cB = cur.B;
    PG8_STAGE(PG8_SB(0, 0), cB, voffB); PG8_STAGE(PG8_SB(0, 1), cB + hstepB, voffB); PG8_STAGE(PG8_SA(0, 0), cA, voffA); PG8_STAGE(PG8_SA(0, 1), cA + hstepA, voffA);
    if (wr == 1) PG8_BAR;
    PG8_WAIT_V(2); PG8_BAR;
    PG8_STAGE(PG8_SB(1, 0), cB + kstep, voffB); PG8_STAGE(PG8_SA(1, 0), cA + kstep, voffA); PG8_STAGE(PG8_SB(1, 1), cB + hstepB + kstep, voffB);
    PG8_WAIT_V(6); PG8_BAR;
    for (;;) {
        const bool has_next = S.next(ui + 1, nxt);
        const char* nA = has_next ? nxt.A : cA; const char* nB = has_next ? nxt.B : cB;
#pragma unroll 1
        for (int t = 0; t < nt; t += 2) {
            const bool last = (t == nt - 2);
            const char* a1 = cA + (size_t)(t + 1) * kstep;
            const char* a2 = last ? nA : cA + (size_t)(t + 2) * kstep; const char* b2 = last ? nB : cB + (size_t)(t + 2) * kstep;
            const char* a3 = a2 + kstep; const char* b3 = b2 + kstep;
            PG8_LDB(B0, 0, 0); PG8_LDB(B1, 0, 1); PG8_SCHED; PG8_LDA(At, 0, 0); PG8_STAGE(PG8_SA(1, 1), a1 + hstepA, voffA);
            PG8_WAIT_V(8); PG8_WAIT_L(0); PG8_BAR; PG8_MMA(0, 0, At, B0); PG8_MMA(0, 1, At, B1); PG8_BAR; PG8_SCHED;
            PG8_LDA(At, 0, 1); PG8_STAGE(PG8_SB(0, 0), b2, voffB); PG8_STAGE(PG8_SB(0, 1), b2 + hstepB, voffB); PG8_STAGE(PG8_SA(0, 0), a2, voffA);
            PG8_WAIT_V(8); PG8_WAIT_L(0); PG8_BAR; PG8_MMA(1, 0, At, B0); PG8_MMA(1, 1, At, B1); PG8_BAR; PG8_SCHED;
            PG8_LDB(B0, 1, 0); PG8_LDB(B1, 1, 1); PG8_SCHED; PG8_LDA(At, 1, 0); PG8_STAGE(PG8_SA(0, 1), a2 + hstepA, voffA);
            PG8_WAIT_V(8); PG8_WAIT_L(0); PG8_BAR; PG8_MMA(0, 0, At, B0); PG8_MMA(0, 1, At, B1); PG8_BAR; PG8_SCHED;
            PG8_LDA(At, 1, 1); PG8_STAGE(PG8_SB(1, 0), b3, voffB); PG8_STAGE(PG8_SB(1, 1), b3 + hstepB, voffB); PG8_STAGE(PG8_SA(1, 0), a3, voffA);
            PG8_WAIT_V(8); PG8_WAIT_L(0); PG8_BAR; PG8_MMA(1, 0, At, B0); PG8_MMA(1, 1, At, B1); PG8_BAR; PG8_SCHED;
        }
        if constexpr (ALIGN_EPI) { if (wr == 0) PG8_BAR; }
        E(acc, cur, wr, wc, fr, fq);
        if (!has_next) break;
#pragma unroll
        for (int a = 0; a < 2; ++a)
#pragma unroll
            for (int b = 0; b < 2; ++b)
#pragma unroll
                for (int m = 0; m < 4; ++m)
#pragma unroll
                    for (int n = 0; n < 2; ++n) acc[a][b][m][n] = (f32x4){0.f, 0.f, 0.f, 0.f};
        cur = nxt; cA = nA; cB = nB; ++ui;
        if constexpr (ALIGN_EPI) { if (wr == 1) PG8_BAR; }
    }
    PG8_WAIT_V(0);
    if constexpr (!ALIGN_EPI) { if (wr == 0) PG8_BAR; }
    PG8_BAR;
#undef PG8_SA
#undef PG8_SB
#undef PG8_STAGE
#undef PG8_LDA
#undef PG8_LDB
#undef PG8_MMA
#undef PG8_WAIT_V
#undef PG8_WAIT_L
#undef PG8_BAR
#undef PG8_SCHED
}
}
#define LAS __attribute__((address_space(3)))
typedef unsigned short bf16_t;
typedef short bf16x8 __attribute__((ext_vector_type(8)));
typedef short s16x4 __attribute__((ext_vector_type(4)));
typedef float f32x4 __attribute__((ext_vector_type(4)));
typedef float f32x2 __attribute__((ext_vector_type(2)));
typedef float f32x16 __attribute__((ext_vector_type(16)));
typedef unsigned u32x4 __attribute__((ext_vector_type(4)));
typedef unsigned u32x2 __attribute__((ext_vector_type(2)));
typedef __bf16 bf16x2_t __attribute__((ext_vector_type(2)));

constexpr int BATCH = 8, SEQ = 4096, DM = 1024, T = BATCH * SEQ, DEPTH = 2;
constexpr int N_IN = 7728, NA = 3328, NG = 4608, NALL = NA + NG;
constexpr int CQ = 0, CKV = 256, KROPE = 384, GLAT = 416, RW_R = 512, RW_K = 1024, RW_V = 1536, RW_LW = 2048, RW_LA = 2112, GQ = 2304, GK = 2560, GV = 2816;
constexpr int KP = 544;
constexpr float NORM_EPS = 1e-6f, RWKV_GN_EPS = 64e-5f;
constexpr float QSCALE = 0.10206207261596577f * 1.4426950408889634f;

constexpr size_t MiB = 1u << 20;
constexpr size_t WS_CTL = 0;
constexpr size_t WS_ROPE = 1 * MiB;
constexpr size_t WS_RSTD = 5 * MiB;
constexpr size_t WS_WIN = 6 * MiB;
constexpr size_t WS_WBO = WS_WIN + (size_t)NALL * 1024 * 2;
constexpr size_t WS_WOUT = WS_WBO + 3 * MiB;
constexpr size_t WS_WUQ = WS_WOUT + 2 * MiB;
constexpr size_t WS_WUKV = WS_WUQ + 768 * 256 * 2;
constexpr size_t WS_HB = 28 * MiB;
constexpr size_t WS_PA = 92 * MiB;
constexpr size_t WS_Q = 300 * MiB;
constexpr size_t WS_K = 348 * MiB;
constexpr size_t WS_V = 382 * MiB;
constexpr size_t WS_YS = 414 * MiB;
constexpr size_t WS_SMG8 = WS_Q;
constexpr size_t WS_MG = WS_PA, WS_OF = WS_PA + 64 * MiB;
constexpr size_t WS_END = 510 * MiB;
static_assert(WS_WUKV + 1024 * 256 * 2 <= WS_HB, "weights fit");

__device__ __forceinline__ unsigned pk2(float lo, float hi) { f32x2 v = {lo, hi}; bf16x2_t b = __builtin_convertvector(v, bf16x2_t); return __builtin_bit_cast(unsigned, b); }
__device__ __forceinline__ float bflo(unsigned w) { return __uint_as_float(w << 16); }
__device__ __forceinline__ float bfhi(unsigned w) { return __uint_as_float(w & 0xffff0000u); }
__device__ __forceinline__ float bf2f(bf16_t b) { return __uint_as_float((unsigned)b << 16); }
__device__ __forceinline__ bf16_t f2bf(float f) { return (bf16_t)(pk2(f, 0.f) & 0xffffu); }
__device__ __forceinline__ float wave_sum(float v) {
#pragma unroll
    for (int o = 1; o < 64; o <<= 1) v += __shfl_xor(v, o);
    return v;
}
__device__ __forceinline__ float fast_exp(float x) { return __builtin_amdgcn_exp2f(x * 1.4426950408889634f); }
__device__ __forceinline__ float fast_sigmoid(float x) { return __builtin_amdgcn_rcpf(1.0f + fast_exp(-x)); }
template <int CTRL> __device__ __forceinline__ float dpp_f(float x) { return __int_as_float(__builtin_amdgcn_update_dpp(0, __float_as_int(x), CTRL, 0xf, 0xf, false)); }
__device__ __forceinline__ float sum8(float x) { x += dpp_f<0xB1>(x); x += dpp_f<0x4E>(x); x += dpp_f<0x141>(x); return x; }
__device__ __forceinline__ float sum16(float x) { x += dpp_f<0xB1>(x); x += dpp_f<0x4E>(x); x += dpp_f<0x141>(x); x += dpp_f<0x140>(x); return x; }

struct Params {
    const float* x; const int* positions; const float* norm_pre; const float* w_in; const float* mla_q_norm; const float* mla_kv_norm; const float* mla_w_uq; const float* mla_w_ukv;
    const float* rwkv_mu; const float* rwkv_w0; const float* rwkv_w_up; const float* rwkv_a0; const float* rwkv_a_up; const float* rwkv_k_k; const float* rwkv_k_a; const float* rwkv_r_k;
    const float* rwkv_ln_w; const float* rwkv_ln_b; const float* gla_a_up; const float* gla_a_b; const float* gla_norm; const float* w_branch_out; const float* w_out; const float* norm_post;
    float* out; unsigned char* ws; int ph_lo, ph_hi;
};

typedef const __attribute__((address_space(4))) Params* KArgs;
__device__ __forceinline__ KArgs kargs() { KArgs kp = (KArgs)__builtin_amdgcn_kernarg_segment_ptr(); asm volatile("" : "+s"(kp)); return kp; }

__device__ __forceinline__ Params load_params() { Params p{}; KArgs kp = kargs(); p.x = kp->x; p.positions = kp->positions; p.norm_pre = kp->norm_pre; p.w_in = kp->w_in; p.mla_q_norm = kp->mla_q_norm; p.mla_kv_norm = kp->mla_kv_norm; p.mla_w_uq = kp->mla_w_uq; p.mla_w_ukv = kp->mla_w_ukv; p.rwkv_mu = kp->rwkv_mu; p.rwkv_w0 = kp->rwkv_w0; p.rwkv_w_up = kp->rwkv_w_up; p.rwkv_a0 = kp->rwkv_a0; p.rwkv_a_up = kp->rwkv_a_up; p.rwkv_k_k = kp->rwkv_k_k; p.rwkv_k_a = kp->rwkv_k_a; p.rwkv_r_k = kp->rwkv_r_k; p.rwkv_ln_w = kp->rwkv_ln_w; p.rwkv_ln_b = kp->rwkv_ln_b; p.gla_a_up = kp->gla_a_up; p.gla_a_b = kp->gla_a_b; p.gla_norm = kp->gla_norm; p.w_branch_out = kp->w_branch_out; p.w_out = kp->w_out; p.norm_post = kp->norm_post; p.out = kp->out; p.ws = kp->ws; p.ph_lo = kp->ph_lo; p.ph_hi = kp->ph_hi; return p; }
__device__ __forceinline__ int opaque_tid() { int t = threadIdx.x; asm volatile("" : "+v"(t)); return t; }

using pg8::Unit;
constexpr int EPI_SCR = 131072, EPI_SCR_WAVE = 2304, EPI_PITCH = 144;
struct EpiGeo { LAS unsigned char* wp; const LAS unsigned char* rp; int r8, p8; };
__device__ __forceinline__ EpiGeo epi_geo(LAS unsigned char* lds, int wr, int wc, int fr, int fq) {
    LAS unsigned char* scr = lds + EPI_SCR + (wr * 4 + wc) * EPI_SCR_WAVE; const int lane = fq * 16 + fr;
    return EpiGeo{scr + fr * EPI_PITCH + fq * 16, scr + (lane >> 3) * EPI_PITCH + (lane & 7) * 16, lane >> 3, lane & 7};
}
__device__ __forceinline__ void epi_xpose(const EpiGeo& g, const u32x4 w0, const u32x4 w1, u32x4& r0, u32x4& r1) {
    *(LAS u32x4*)g.wp = w0; *(LAS u32x4*)(g.wp + 64) = w1;
    asm volatile("" ::: "memory");
    r0 = *(const LAS u32x4*)g.rp; r1 = *(const LAS u32x4*)(g.rp + 8 * EPI_PITCH);
    asm volatile("" ::: "memory");
}
__device__ __forceinline__ u32x4 pack8(const f32x4 v0, const f32x4 v1) { u32x4 w; w.x = pk2(v0[0], v0[1]); w.y = pk2(v0[2], v0[3]); w.z = pk2(v1[0], v1[1]); w.w = pk2(v1[2], v1[3]); return w; }
struct EpiStore {
    static constexpr int PERM = 2; bf16_t* O; int ldc; LAS unsigned char* lds; int skip;
    __device__ __forceinline__ void operator()(const f32x4 (&acc)[2][2][4][2], const Unit& u, int wr, int wc, int fr, int fq) const {
        const EpiGeo G = epi_geo(lds, wr, wc, fr, fq);
        bf16_t* gp = O + (size_t)(u.pm * 256 + wr * 64 + G.r8) * ldc + (u.pn + ((u.pn >= 2) ? skip : 0)) * 256 + wc * 64 + G.p8 * 8;
#pragma unroll
        for (int ai = 0; ai < 2; ++ai)
#pragma unroll
            for (int m = 0; m < 4; ++m) { u32x4 r0, r1; epi_xpose(G, pack8(acc[ai][0][m][0], acc[ai][0][m][1]), pack8(acc[ai][1][m][0], acc[ai][1][m][1]), r0, r1);
                bf16_t* g = gp + (size_t)(ai * 128 + m * 16) * ldc;
                *(u32x4*)g = r0; *(u32x4*)(g + (size_t)8 * ldc) = r1; }
    }
};
struct EpiQ {
    static constexpr int PERM = 2; bf16_t* Q; const float* rstd; LAS unsigned char* lds;
    __device__ __forceinline__ void operator()(const f32x4 (&acc)[2][2][4][2], const Unit& u, int wr, int wc, int fr, int fq) const {
        const EpiGeo G = epi_geo(lds, wr, wc, fr, fq);
        const int row0 = u.pm * 256 + wr * 64 + fr;
        float rsv[2][4];
#pragma unroll
        for (int ai = 0; ai < 2; ++ai)
#pragma unroll
            for (int m = 0; m < 4; ++m) rsv[ai][m] = rstd[row0 + ai * 128 + m * 16];
        bf16_t* gp = Q + (size_t)(u.pm * 256 + wr * 64 + G.r8) * 768 + u.pn * 256 + wc * 64 + G.p8 * 8;
#pragma unroll
        for (int ai = 0; ai < 2; ++ai)
#pragma unroll
            for (int m = 0; m < 4; ++m) { const float rs = rsv[ai][m] * QSCALE; u32x4 r0, r1;
                epi_xpose(G, pack8(acc[ai][0][m][0] * rs, acc[ai][0][m][1] * rs), pack8(acc[ai][1][m][0] * rs, acc[ai][1][m][1] * rs), r0, r1);
                bf16_t* g = gp + (size_t)(ai * 128 + m * 16) * 768;
                *(u32x4*)g = r0; *(u32x4*)(g + (size_t)8 * 768) = r1; }
    }
};
struct EpiKV {
    static constexpr int PERM = 2; bf16_t* Kb; bf16_t* Vb; const float* rstd; LAS unsigned char* lds;
    __device__ __forceinline__ void operator()(const f32x4 (&acc)[2][2][4][2], const Unit& u, int wr, int wc, int fr, int fq) const {
        const EpiGeo G = epi_geo(lds, wr, wc, fr, fq);
        const int row0 = u.pm * 256 + wr * 64 + fr; const bool isv = u.pn >= 2; const int ldc = isv ? 512 : KP;
        float rsv[2][4];
#pragma unroll
        for (int ai = 0; ai < 2; ++ai)
#pragma unroll
            for (int m = 0; m < 4; ++m) rsv[ai][m] = rstd[row0 + ai * 128 + m * 16];
        bf16_t* gp = (isv ? Vb : Kb) + (size_t)(u.pm * 256 + wr * 64 + G.r8) * ldc + (u.pn & 1) * 256 + wc * 64 + G.p8 * 8;
#pragma unroll
        for (int ai = 0; ai < 2; ++ai)
#pragma unroll
            for (int m = 0; m < 4; ++m) { const float rs = rsv[ai][m]; u32x4 r0, r1;
                epi_xpose(G, pack8(acc[ai][0][m][0] * rs, acc[ai][0][m][1] * rs), pack8(acc[ai][1][m][0] * rs, acc[ai][1][m][1] * rs), r0, r1);
                bf16_t* g = gp + (size_t)(ai * 128 + m * 16) * ldc;
                *(u32x4*)g = r0; *(u32x4*)(g + (size_t)8 * ldc) = r1; }
    }
};
__device__ __forceinline__ unsigned q8(float s) { return (unsigned)(s * 255.0f + 0.5f); }
__device__ __forceinline__ f32x4 silu4(const f32x4 a) { f32x4 r; r[0] = fast_sigmoid(a[0]) * a[0]; r[1] = fast_sigmoid(a[1]) * a[1]; r[2] = fast_sigmoid(a[2]) * a[2]; r[3] = fast_sigmoid(a[3]) * a[3]; return r; }
struct EpiGateBG {
    static constexpr int PERM = 2; bf16_t* YS; int pn0, skip; LAS unsigned char* lds;
    __device__ __forceinline__ void operator()(const f32x4 (&acc)[2][2][4][2], const Unit& u, int wr, int wc, int fr, int fq) const {
        const int pn = pn0 + u.pn + ((u.pn >= 2) ? skip : 0);
        const EpiGeo G = epi_geo(lds, wr, wc, fr, fq);
        bf16_t* gp = YS + (size_t)(pn >> 1) * T * 512 + (size_t)(u.pm * 256 + wr * 64 + G.r8) * 512 + (pn & 1) * 256 + wc * 64 + G.p8 * 8;
#pragma unroll
        for (int ai = 0; ai < 2; ++ai) {
            u32x4 y[4][2];
#pragma unroll
            for (int m = 0; m < 4; ++m)
#pragma unroll
                for (int h = 0; h < 2; ++h) y[m][h] = *(const u32x4*)(gp + (size_t)(ai * 128 + m * 16 + 8 * h) * 512);
#pragma unroll
            for (int m = 0; m < 4; ++m) { u32x4 r[2];
                epi_xpose(G, pack8(silu4(acc[ai][0][m][0]), silu4(acc[ai][0][m][1])), pack8(silu4(acc[ai][1][m][0]), silu4(acc[ai][1][m][1])), r[0], r[1]);
#pragma unroll
                for (int h = 0; h < 2; ++h) { const u32x4 yy = y[m][h], gg = r[h];
                    u32x4 w; w.x = pk2(bflo(gg.x) * bflo(yy.x), bfhi(gg.x) * bfhi(yy.x)); w.y = pk2(bflo(gg.y) * bflo(yy.y), bfhi(gg.y) * bfhi(yy.y));
                    w.z = pk2(bflo(gg.z) * bflo(yy.z), bfhi(gg.z) * bfhi(yy.z)); w.w = pk2(bflo(gg.w) * bflo(yy.w), bfhi(gg.w) * bfhi(yy.w));
                    *(u32x4*)(gp + (size_t)(ai * 128 + m * 16 + 8 * h) * 512) = w; } }
        }
    }
};
struct EpiGateMG8 {
    static constexpr int PERM = 2; unsigned char* SMG; LAS unsigned char* lds;
    __device__ __forceinline__ void operator()(const f32x4 (&acc)[2][2][4][2], const Unit& u, int wr, int wc, int fr, int fq) const {
        LAS unsigned char* scr = lds + EPI_SCR + (wr * 4 + wc) * EPI_SCR_WAVE; const int lane = fq * 16 + fr;
        LAS unsigned char* wp = scr + fr * 72 + fq * 8; const LAS unsigned char* rp = scr + (lane >> 2) * 72 + (lane & 3) * 16;
        unsigned char* gp = SMG + (size_t)((u.pm * 256 + wr * 64) >> 1) * 6144 + (size_t)(lane >> 3) * 6144 + (u.pn * 4 + wc) * 128 + ((lane >> 2) & 1) * 64 + (lane & 3) * 16;
#pragma unroll
        for (int ai = 0; ai < 2; ++ai)
#pragma unroll
            for (int m = 0; m < 4; ++m) {
#pragma unroll
                for (int bj = 0; bj < 2; ++bj) { const f32x4 a0 = acc[ai][bj][m][0], a1 = acc[ai][bj][m][1];
                    u32x2 w = {0u, 0u};
#pragma unroll
                    for (int j = 0; j < 4; ++j) { w.x = __builtin_amdgcn_cvt_pk_u8_f32(255.0f * fast_sigmoid(a0[j]), j, w.x); w.y = __builtin_amdgcn_cvt_pk_u8_f32(255.0f * fast_sigmoid(a1[j]), j, w.y); }
                    *(LAS u32x2*)(wp + bj * 32) = w; }
                asm volatile("" ::: "memory");
                const u32x2 ra = *(const LAS u32x2*)rp, rb = *(const LAS u32x2*)(rp + 8);
                asm volatile("" ::: "memory");
                *(u32x4*)(gp + (size_t)(ai * 64 + m * 8) * 6144) = (u32x4){ra.x, ra.y, rb.x, rb.y}; }
    }
};
struct EpiMerge {
    static constexpr int PERM = 2; bf16_t* MG; const unsigned char* SMG; LAS unsigned char* lds;
    __device__ __forceinline__ void operator()(const f32x4 (&acc)[2][2][4][2], const Unit& u, int wr, int wc, int fr, int fq) const {
        const EpiGeo G = epi_geo(lds, wr, wc, fr, fq); const int n = u.aux; constexpr float S = 1.0f / 255.0f;
        const size_t rowb = (size_t)(u.pm * 256 + wr * 64 + G.r8); const int colb = u.pn * 256 + wc * 64 + G.p8 * 8;
        const unsigned char* sp = SMG + (rowb >> 1) * 6144 + (size_t)(n * 16 + u.pn * 4 + wc) * 128 + (rowb & 1) * 64 + G.p8 * 8; bf16_t* mp = MG + rowb * 1024 + colb;
#pragma unroll
        for (int ai = 0; ai < 2; ++ai) {
            u32x2 g[4][2]; u32x4 y[4][2];
#pragma unroll
            for (int m = 0; m < 4; ++m)
#pragma unroll
                for (int h = 0; h < 2; ++h) { g[m][h] = *(const u32x2*)(sp + (size_t)(ai * 64 + m * 8 + 4 * h) * 6144); if (n > 0) y[m][h] = *(const u32x4*)(mp + (size_t)(ai * 128 + m * 16 + 8 * h) * 1024); }
#pragma unroll
            for (int m = 0; m < 4; ++m) { u32x4 r[2];
                epi_xpose(G, pack8(acc[ai][0][m][0], acc[ai][0][m][1]), pack8(acc[ai][1][m][0], acc[ai][1][m][1]), r[0], r[1]);
#pragma unroll
                for (int h = 0; h < 2; ++h) { const u32x2 gg = g[m][h]; const u32x4 aa = r[h];
                    float v[8] = {bflo(aa.x) * (S * (float)(gg.x & 0xffu)), bfhi(aa.x) * (S * (float)((gg.x >> 8) & 0xffu)), bflo(aa.y) * (S * (float)((gg.x >> 16) & 0xffu)), bfhi(aa.y) * (S * (float)(gg.x >> 24)),
                                  bflo(aa.z) * (S * (float)(gg.y & 0xffu)), bfhi(aa.z) * (S * (float)((gg.y >> 8) & 0xffu)), bflo(aa.w) * (S * (float)((gg.y >> 16) & 0xffu)), bfhi(aa.w) * (S * (float)(gg.y >> 24))};
                    if (n > 0) { const u32x4 yy = y[m][h];
                        v[0] += bflo(yy.x); v[1] += bfhi(yy.x); v[2] += bflo(yy.y); v[3] += bfhi(yy.y); v[4] += bflo(yy.z); v[5] += bfhi(yy.z); v[6] += bflo(yy.w); v[7] += bfhi(yy.w); }
                    u32x4 w; w.x = pk2(v[0], v[1]); w.y = pk2(v[2], v[3]); w.z = pk2(v[4], v[5]); w.w = pk2(v[6], v[7]);
                    *(u32x4*)(mp + (size_t)(ai * 128 + m * 16 + 8 * h) * 1024) = w; } }
        }
    }
};
struct EpiF32 {
    static constexpr bool PERM = false; float* O; int ldc;
    __device__ __forceinline__ void operator()(const f32x4 (&acc)[2][2][4][2], const Unit& u, int wr, int wc, int fr, int fq) const {
        const int row0 = u.pm * 256 + wr * 64 + fr, col0 = u.pn * 256 + wc * 32 + 4 * fq;
#pragma unroll
        for (int ai = 0; ai < 2; ++ai)
#pragma unroll
            for (int m = 0; m < 4; ++m) { float* rowp = O + (size_t)(row0 + ai * 128 + m * 16) * ldc + col0;
#pragma unroll
                for (int bj = 0; bj < 2; ++bj)
#pragma unroll
                    for (int n = 0; n < 2; ++n) *(f32x4*)(rowp + bj * 128 + n * 16) = acc[ai][bj][m][n]; }
    }
};

template <class SrcCol>
__device__ __forceinline__ void transpose_item(const float* W, int Ksrc, int Nsrc, bf16_t* WT, int Kdst, int item, int nblk, float* scr, int lane, SrcCol src, const float* kscale) {
    const int kb = item / nblk, nb = item % nblk, k0 = 64 * kb, n0 = 32 * nb;
    const int sc = src(n0 + (lane & 31));
    float vv[32];
#pragma unroll
    for (int i = 0; i < 32; ++i) { const int k = k0 + 2 * i + (lane >> 5); float v = 0.f;
        if (sc >= 0 && k < Ksrc) { v = W[(size_t)k * Nsrc + sc]; if (kscale) v *= kscale[k]; }
        vv[i] = v; }
#pragma unroll
    for (int i = 0; i < 32; ++i) scr[(2 * i + (lane >> 5)) * 33 + (lane & 31)] = vv[i];
    asm volatile("s_waitcnt lgkmcnt(0)" ::: "memory");
    const int c = lane & 7;
#pragma unroll
    for (int j = 0; j < 4; ++j) { const int n = (lane >> 3) + 8 * j; const float* s = scr + (8 * c) * 33 + n;
        u32x4 o; o.x = pk2(s[0 * 33], s[1 * 33]); o.y = pk2(s[2 * 33], s[3 * 33]); o.z = pk2(s[4 * 33], s[5 * 33]); o.w = pk2(s[6 * 33], s[7 * 33]);
        *(u32x4*)(WT + (size_t)(n0 + n) * Kdst + k0 + 8 * c) = o; }
    asm volatile("s_waitcnt lgkmcnt(0)" ::: "memory");
}
__device__ __forceinline__ int win_src(int j) {
    if (j < 416) return j;
    if (j < 432) return 3104 + (j - 416);
    if (j < 512) return -1;
    if (j < 2048) return 416 + (j - 512);
    if (j < 2176) return 1952 + (j - 2048);
    if (j < 2304) return -1;
    if (j < 3328) return 2080 + (j - 2304);
    return 3120 + (j - 3328);
}
__device__ __forceinline__ int wuq_src(int j) { const int h = j / 96, c = j % 96; if (c < 64) return h * 96 + c; const int r = c - 64; return h * 96 + 64 + (r & 1) * 16 + (r >> 1); }
__device__ __forceinline__ int wukv_src(int j) { return j < 512 ? (j >> 6) * 128 + (j & 63) : ((j - 512) >> 6) * 128 + 64 + (j & 63); }

__device__ __forceinline__ void convert_weights(int l, unsigned char* lds, int gw, int NGW, int wave, int lane) {
    float* scr = (float*)(lds + wave * 8448); const Params p = load_params();
    bf16_t* WinT = (bf16_t*)(p.ws + WS_WIN); bf16_t* WboT = (bf16_t*)(p.ws + WS_WBO); bf16_t* WoutT = (bf16_t*)(p.ws + WS_WOUT); bf16_t* WuqT = (bf16_t*)(p.ws + WS_WUQ); bf16_t* WukvT = (bf16_t*)(p.ws + WS_WUKV);
    constexpr int I_IN = 16 * (NALL / 32), I_BO = 8 * 32, I_OUT = 16 * 32, I_UQ = 4 * 24, I_UKV = 4 * 32;
    constexpr int NITEMS = I_IN + 3 * I_BO + I_OUT + I_UQ + I_UKV;
    for (int it = gw; it < NITEMS; it += NGW) {
        int r = it;
        if (r < I_IN) { transpose_item(p.w_in + (size_t)l * 1024 * N_IN, 1024, N_IN, WinT, 1024, r, NALL / 32, scr, lane, [](int j) { return win_src(j); }, nullptr); continue; } r -= I_IN;
        if (r < 3 * I_BO) { const int n = r / I_BO; r -= n * I_BO;
            transpose_item(p.w_branch_out + ((size_t)l * 3 + n) * 512 * 1024, 512, 1024, WboT + (size_t)n * 1024 * 512, 512, r, 32, scr, lane, [](int j) { return j; }, nullptr); continue; } r -= 3 * I_BO;
        if (r < I_OUT) { transpose_item(p.w_out + (size_t)l * 1024 * 1024, 1024, 1024, WoutT, 1024, r, 32, scr, lane, [](int j) { return j; }, nullptr); continue; } r -= I_OUT;
        if (r < I_UQ) { transpose_item(p.mla_w_uq + (size_t)l * 256 * 768, 256, 768, WuqT, 256, r, 24, scr, lane, [](int j) { return wuq_src(j); }, p.mla_q_norm + l * 256); continue; } r -= I_UQ;
        transpose_item(p.mla_w_ukv + (size_t)l * 128 * 1024, 128, 1024, WukvT, 256, r, 32, scr, lane, [](int j) { return wukv_src(j); }, p.mla_kv_norm + l * 128);
    }
}
__device__ __forceinline__ void hb_row(const float* xrow, const float* g, bf16_t* orow, int lane) {
    const f32x4* xr = (const f32x4*)xrow + lane; const f32x4* gr = (const f32x4*)g + lane;
    f32x4 v[4]; float s = 0.f;
#pragma unroll
    for (int j = 0; j < 4; ++j) { v[j] = xr[64 * j]; s += (v[j].x * v[j].x + v[j].y * v[j].y) + (v[j].z * v[j].z + v[j].w * v[j].w); }
    const float rstd = rsqrtf(wave_sum(s) * (1.f / DM) + NORM_EPS);
    u32x2* o8 = (u32x2*)orow + lane;
#pragma unroll
    for (int j = 0; j < 4; ++j) { const f32x4 gg = gr[64 * j]; u32x2 w; w.x = pk2(v[j].x * rstd * gg.x, v[j].y * rstd * gg.y); w.y = pk2(v[j].z * rstd * gg.z, v[j].w * rstd * gg.w); o8[64 * j] = w; }
}
__device__ __forceinline__ void hb_rows4(const float* x, const float* g, bf16_t* HB, int m, int stride, int lane) {
    f32x4 v[4][4];
#pragma unroll
    for (int r = 0; r < 4; ++r) { const f32x4* xr = (const f32x4*)(x + (size_t)(m + r * stride) * DM) + lane;
#pragma unroll
        for (int j = 0; j < 4; ++j) v[r][j] = xr[64 * j]; }
    const f32x4* gr = (const f32x4*)g + lane;
#pragma unroll
    for (int r = 0; r < 4; ++r) { float s = 0.f;
#pragma unroll
        for (int j = 0; j < 4; ++j) s += (v[r][j].x * v[r][j].x + v[r][j].y * v[r][j].y) + (v[r][j].z * v[r][j].z + v[r][j].w * v[r][j].w);
        const float rstd = rsqrtf(wave_sum(s) * (1.f / DM) + NORM_EPS);
        u32x2* o8 = (u32x2*)(HB + (size_t)(m + r * stride) * DM) + lane;
#pragma unroll
        for (int j = 0; j < 4; ++j) { const f32x4 gg = gr[64 * j]; u32x2 w; w.x = pk2(v[r][j].x * rstd * gg.x, v[r][j].y * rstd * gg.y); w.y = pk2(v[r][j].z * rstd * gg.z, v[r][j].w * rstd * gg.w); o8[64 * j] = w; } }
}
template <bool XIN16> struct RowIn { u32x4 oa, ob, xa, xb; f32x4 xv[4]; };
template <bool XIN16> __device__ __forceinline__ void final_load(RowIn<XIN16>& r, const bf16_t* orow, const float* xold, int lane) {
    r.oa = *((const u32x4*)orow + lane); r.ob = *((const u32x4*)orow + 64 + lane);
    if (XIN16) { r.xa = *((const u32x4*)xold + lane); r.xb = *((const u32x4*)xold + 64 + lane); }
    else {
#pragma unroll
        for (int h = 0; h < 2; ++h)
#pragma unroll
            for (int q = 0; q < 2; ++q) r.xv[2 * h + q] = *((const f32x4*)(xold + 512 * h + 8 * lane) + q); }
}
template <bool XIN16, bool XOUT16>
__device__ __forceinline__ void final_row(const RowIn<XIN16>& r, const float* gpost, float* xnew, const float* gnext, bf16_t* hbrow, int lane) {
    float o[16], x[16], g[16];
    { const u32x4 a = r.oa, b = r.ob;
      o[0] = bflo(a.x); o[1] = bfhi(a.x); o[2] = bflo(a.y); o[3] = bfhi(a.y); o[4] = bflo(a.z); o[5] = bfhi(a.z); o[6] = bflo(a.w); o[7] = bfhi(a.w);
      o[8] = bflo(b.x); o[9] = bfhi(b.x); o[10] = bflo(b.y); o[11] = bfhi(b.y); o[12] = bflo(b.z); o[13] = bfhi(b.z); o[14] = bflo(b.w); o[15] = bfhi(b.w); }
    if (XIN16) { const u32x4 a = r.xa, b = r.xb;
      x[0] = bflo(a.x); x[1] = bfhi(a.x); x[2] = bflo(a.y); x[3] = bfhi(a.y); x[4] = bflo(a.z); x[5] = bfhi(a.z); x[6] = bflo(a.w); x[7] = bfhi(a.w);
      x[8] = bflo(b.x); x[9] = bfhi(b.x); x[10] = bflo(b.y); x[11] = bfhi(b.y); x[12] = bflo(b.z); x[13] = bfhi(b.z); x[14] = bflo(b.w); x[15] = bfhi(b.w); }
#pragma unroll
    for (int h = 0; h < 2; ++h)
#pragma unroll
        for (int q = 0; q < 2; ++q) { const f32x4 gv = *((const f32x4*)(gpost + 512 * h + 8 * lane) + q);
            if (!XIN16) {
#pragma unroll
                for (int e = 0; e < 4; ++e) x[8 * h + 4 * q + e] = r.xv[2 * h + q][e]; }
#pragma unroll
            for (int e = 0; e < 4; ++e) g[8 * h + 4 * q + e] = gv[e]; }
    float s = 0.f;
#pragma unroll
    for (int e = 0; e < 16; ++e) s += o[e] * o[e];
    const float rstd = rsqrtf(wave_sum(s) * (1.f / DM) + NORM_EPS);
    float s2 = 0.f;
#pragma unroll
    for (int e = 0; e < 16; ++e) { x[e] += o[e] * rstd * g[e]; s2 += x[e] * x[e]; }
    if (XOUT16) {
#pragma unroll
        for (int h = 0; h < 2; ++h) { u32x4 w; w.x = pk2(x[8 * h], x[8 * h + 1]); w.y = pk2(x[8 * h + 2], x[8 * h + 3]); w.z = pk2(x[8 * h + 4], x[8 * h + 5]); w.w = pk2(x[8 * h + 6], x[8 * h + 7]);
            *((u32x4*)xnew + 64 * h + lane) = w; }
    } else {
#pragma unroll
        for (int h = 0; h < 2; ++h)
#pragma unroll
            for (int q = 0; q < 2; ++q) *((f32x4*)(xnew + 512 * h + 8 * lane) + q) = (f32x4){x[8 * h + 4 * q], x[8 * h + 4 * q + 1], x[8 * h + 4 * q + 2], x[8 * h + 4 * q + 3]};
    }
    if (gnext) { const float rstd2 = rsqrtf(wave_sum(s2) * (1.f / DM) + NORM_EPS);
#pragma unroll
        for (int h = 0; h < 2; ++h) { const f32x4 g0 = *((const f32x4*)(gnext + 512 * h + 8 * lane)), g1 = *((const f32x4*)(gnext + 512 * h + 8 * lane) + 1);
            u32x4 w; w.x = pk2(x[8 * h] * rstd2 * g0[0], x[8 * h + 1] * rstd2 * g0[1]); w.y = pk2(x[8 * h + 2] * rstd2 * g0[2], x[8 * h + 3] * rstd2 * g0[3]);
            w.z = pk2(x[8 * h + 4] * rstd2 * g1[0], x[8 * h + 5] * rstd2 * g1[1]); w.w = pk2(x[8 * h + 6] * rstd2 * g1[2], x[8 * h + 7] * rstd2 * g1[3]);
            *((u32x4*)hbrow + 64 * h + lane) = w; } }
}
__device__ __forceinline__ void mla_prep_row(const bf16_t* prow, const f32x2* rope_t, float* rstdq, float* rstdkv, bf16_t* krow, int lane) {
    const u32x2 a = *((const u32x2*)(prow + CQ) + lane); const unsigned c = *((const unsigned*)(prow + CKV) + lane);
    float sq = bflo(a.x) * bflo(a.x) + bfhi(a.x) * bfhi(a.x) + bflo(a.y) * bflo(a.y) + bfhi(a.y) * bfhi(a.y);
    float sk = bflo(c) * bflo(c) + bfhi(c) * bfhi(c);
    sq = wave_sum(sq); sk = wave_sum(sk);
    if (lane == 0) { *rstdq = rsqrtf(sq * (1.f / 256.f) + NORM_EPS); *rstdkv = rsqrtf(sk * (1.f / 128.f) + NORM_EPS); }
    if (lane < 16) { const float x1 = bf2f(prow[KROPE + lane]), x2 = bf2f(prow[KROPE + 16 + lane]); const f32x2 cs = rope_t[lane];
        *((unsigned*)(krow + 512) + lane) = pk2(x1 * cs.x - x2 * cs.y, x2 * cs.x + x1 * cs.y); }
}

__device__ __forceinline__ void mla_prep_rows4(const bf16_t* PA, const f32x2* ROPE, float* RSTDQ, float* RSTDKV, bf16_t* Kb, int m, int stride, int lane) {
    u32x2 a[4]; unsigned c[4]; float x1[4], x2[4]; f32x2 cs[4];
#pragma unroll
    for (int j = 0; j < 4; ++j) { const int r = (m + j * stride < T) ? m + j * stride : m; const bf16_t* prow = PA + (size_t)r * NA;
        a[j] = *((const u32x2*)(prow + CQ) + lane); c[j] = *((const unsigned*)(prow + CKV) + lane);
        x1[j] = bf2f(prow[KROPE + (lane & 15)]); x2[j] = bf2f(prow[KROPE + 16 + (lane & 15)]); cs[j] = ROPE[(size_t)r * 16 + (lane & 15)]; }
#pragma unroll
    for (int j = 0; j < 4; ++j) { const int r = m + j * stride; if (r < T) {
        float sq = bflo(a[j].x) * bflo(a[j].x) + bfhi(a[j].x) * bfhi(a[j].x) + bflo(a[j].y) * bflo(a[j].y) + bfhi(a[j].y) * bfhi(a[j].y);
        float sk = bflo(c[j]) * bflo(c[j]) + bfhi(c[j]) * bfhi(c[j]);
        sq = wave_sum(sq); sk = wave_sum(sk);
        if (lane == 0) { RSTDQ[r] = rsqrtf(sq * (1.f / 256.f) + NORM_EPS); RSTDKV[r] = rsqrtf(sk * (1.f / 128.f) + NORM_EPS); }
        if (lane < 16) *((unsigned*)(Kb + (size_t)r * KP + 512) + lane) = pk2(x1[j] * cs[j].x - x2[j] * cs[j].y, x2[j] * cs[j].x + x1[j] * cs[j].y); } }
}

#ifdef BANDSKIP
namespace att {
constexpr int KSLOT = 12288, VSLOT = 8192, BUFB = KSLOT + VSLOT, L_WS = 2 * BUFB, L_OST = L_WS + 8 * 128 * 4, L_END = L_OST + 8 * 4096;
constexpr int UNIT_ROWS = 512;
__device__ __forceinline__ int crow(int r, int hi) { return (r & 3) + 8 * (r >> 2) + 4 * hi; }
__device__ __forceinline__ s16x4 vtr(const LAS unsigned char* p) { return __builtin_bit_cast(s16x4, __builtin_amdgcn_ds_read_tr16_b64_v4i16((LAS s16x4*)p)); }
__device__ __forceinline__ void load_q(bf16x8 (&qr)[6], const bf16_t* Q, const f32x2* rope, size_t row, int h, int hi) {
    const bf16_t* Qw = Q + row * 768 + h * 96 + hi * 8;
#pragma unroll
    for (int s = 0; s < 6; ++s) qr[s] = *(const bf16x8*)(Qw + s * 16);
    const f32x4* rp = (const f32x4*)(rope + row * 16 + 4 * hi);
#pragma unroll
    for (int s = 4; s < 6; ++s) { const f32x4 c01 = rp[(s - 4) * 4], c23 = rp[(s - 4) * 4 + 1]; const u32x4 w = __builtin_bit_cast(u32x4, qr[s]); u32x4 o;
        { const float e = bflo(w.x), d = bfhi(w.x); o.x = pk2(e * c01[0] - d * c01[1], d * c01[0] + e * c01[1]); }
        { const float e = bflo(w.y), d = bfhi(w.y); o.y = pk2(e * c01[2] - d * c01[3], d * c01[2] + e * c01[3]); }
        { const float e = bflo(w.z), d = bfhi(w.z); o.z = pk2(e * c23[0] - d * c23[1], d * c23[0] + e * c23[1]); }
        { const float e = bflo(w.w), d = bfhi(w.w); o.w = pk2(e * c23[2] - d * c23[3], d * c23[2] + e * c23[3]); }
        qr[s] = __builtin_bit_cast(bf16x8, o); }
}
__device__ __forceinline__ void softmax_half(f32x16& p0, f32x16& p1, f32x16& o0, f32x16& o1, float& mrun, float& lrun, bf16x8 (&pa)[4],
                                             bool first, bool band, int kb0, int qrel, int r32, int hi, LAS float* wsf) {
    if (band) {
#pragma unroll
        for (int r = 0; r < 16; ++r) { const int kv = kb0 + (r & 3) + 8 * (r >> 2); if (kv > qrel) p0[r] = -INFINITY; if (kv + 32 > qrel) p1[r] = -INFINITY; } }
    float mx = fmaxf(p0[0], p1[0]);
#pragma unroll
    for (int r = 1; r < 16; ++r) mx = fmaxf(mx, fmaxf(p0[r], p1[r]));
    mx = fmaxf(mx, __shfl_xor(mx, 32));
    if (first || __any(mx > 8.0f)) {
        const float dl = first ? mx : fmaxf(mx, 0.f); mrun += dl;
#pragma unroll
        for (int r = 0; r < 16; ++r) { p0[r] -= dl; p1[r] -= dl; }
        const float alpha = __builtin_amdgcn_exp2f(-dl); lrun *= alpha;
        if (hi == 0) wsf[r32] = alpha;
#pragma unroll
        for (int r = 0; r < 16; ++r) { const float a = wsf[crow(r, hi)]; o0[r] *= a; o1[r] *= a; }
    }
    float ls = 0.f;
#pragma unroll
    for (int r = 0; r < 16; ++r) { p0[r] = __builtin_amdgcn_exp2f(p0[r]); p1[r] = __builtin_amdgcn_exp2f(p1[r]); ls += p0[r] + p1[r]; }
    lrun += ls;
#pragma unroll
    for (int s = 0; s < 4; ++s) { const int bb = 8 * (s & 1); u32x4 w;
        if (s < 2) { w.x = pk2(p0[bb], p0[bb + 1]); w.y = pk2(p0[bb + 2], p0[bb + 3]); w.z = pk2(p0[bb + 4], p0[bb + 5]); w.w = pk2(p0[bb + 6], p0[bb + 7]); }
        else { w.x = pk2(p1[bb], p1[bb + 1]); w.y = pk2(p1[bb + 2], p1[bb + 3]); w.z = pk2(p1[bb + 4], p1[bb + 5]); w.w = pk2(p1[bb + 6], p1[bb + 7]); }
        pa[s] = __builtin_bit_cast(bf16x8, w); }
}
__device__ __forceinline__ void attn_unit(int b, int h, int qb, LAS unsigned char* lds, unsigned* done_ctr) {
    KArgs kp = kargs(); unsigned char* ws_ = kp->ws;
    const bf16_t* Q = (const bf16_t*)(ws_ + WS_Q); const bf16_t* Kg = (const bf16_t*)(ws_ + WS_K); const bf16_t* Vg = (const bf16_t*)(ws_ + WS_V); bf16_t* O = (bf16_t*)(ws_ + WS_YS);
    const int tid = opaque_tid(), lane = tid & 63, r32 = lane & 31, hi = lane >> 5; const int wid = __builtin_amdgcn_readfirstlane(tid >> 6);
    const size_t rowbase = (size_t)b * SEQ; const int q0 = qb * UNIT_ROWS;
    bf16x8 qa[6], qb_[6];
    const int rba = 32 * wid, rbb = 32 * (15 - wid);
    load_q(qa, Q, (const f32x2*)(ws_ + WS_ROPE), rowbase + q0 + rba + r32, h, hi);
    load_q(qb_, Q, (const f32x2*)(ws_ + WS_ROPE), rowbase + q0 + rbb + r32, h, hi);
    const char* kbase0 = (const char*)(Kg + rowbase * KP + h * 64); const char* kbase1 = (const char*)(Kg + rowbase * KP + 512);
    const char* vbase = (const char*)(Vg + rowbase * 512 + h * 64);
    const unsigned kof = (unsigned)(((tid & 63) * KP + (tid >> 6) * 8) * 2), vof = (unsigned)((((tid & 255) >> 2) * 512 + (tid >> 8) * 32 + (tid & 3) * 8) * 2);
    const int NT = (q0 + UNIT_ROWS) / 64;
    LAS float* wsf = (LAS float*)(lds + L_WS) + wid * 128;
    u32x4 sk0, sk1, sv;
    sk0 = *(const u32x4*)(kbase0 + kof); if (tid < 256) sk1 = *(const u32x4*)(kbase1 + kof); sv = *(const u32x4*)(vbase + vof);
    *(LAS u32x4*)(lds + tid * 16) = sk0; if (tid < 256) *(LAS u32x4*)(lds + (tid + 512) * 16) = sk1; *(LAS u32x4*)(lds + KSLOT + tid * 16) = sv;
    __syncthreads();
    f32x16 oa0 = {}, oa1 = {}, ob0 = {}, ob1 = {}; float ma = 0.f, la = 0.f, mb = 0.f, lb = 0.f;
    const int qra = rba + r32, qrb = rbb + r32;
    const int tlastA = NT - 8 + ((rba + 31) >> 6), tlastB = NT - 8 + ((rbb + 31) >> 6);
    for (int t = 0; t < NT; ++t) {
        int tidv = tid; asm volatile("" : "+v"(tidv));
        const int lanev = tidv & 63, r32v = lanev & 31, hiv = lanev >> 5;
        const unsigned kofv = (unsigned)(((tidv & 63) * KP + (tidv >> 6) * 8) * 2), vofv = (unsigned)((((tidv & 255) >> 2) * 512 + (tidv >> 8) * 32 + (tidv & 3) * 8) * 2);
        LAS unsigned char* buf = lds + (t & 1) * BUFB; LAS unsigned char* nbuf = lds + ((t + 1) & 1) * BUFB;
        if (t + 1 < NT) { const size_t ko = (size_t)(t + 1) * 64 * KP * 2, vo = (size_t)(t + 1) * 64 * 512 * 2;
            sk0 = *(const u32x4*)(kbase0 + ko + kofv); if (tidv < 256) sk1 = *(const u32x4*)(kbase1 + ko + kofv); sv = *(const u32x4*)(vbase + vo + vofv); }
        const bool band = t >= NT - 8; const int kb0 = 64 * (t - (NT - 8)) + 4 * hiv;
        const bool doA = t <= tlastA, doB = t <= tlastB;
        f32x16 pa0, pa1, pb0, pb1;
#pragma unroll
        for (int r = 0; r < 16; ++r) { pa0[r] = -ma; pa1[r] = -ma; pb0[r] = -mb; pb1[r] = -mb; }
        { const LAS unsigned char* kb = buf + hiv * 1024 + r32v * 16;
#pragma unroll
          for (int s = 0; s < 6; ++s) { const bf16x8 a0 = *(const LAS bf16x8*)(kb + s * 2048), a1 = *(const LAS bf16x8*)(kb + s * 2048 + 512);
              if (doA) { pa0 = __builtin_amdgcn_mfma_f32_32x32x16_bf16(a0, qa[s], pa0, 0, 0, 0); pa1 = __builtin_amdgcn_mfma_f32_32x32x16_bf16(a1, qa[s], pa1, 0, 0, 0); }
              if (doB) { pb0 = __builtin_amdgcn_mfma_f32_32x32x16_bf16(a0, qb_[s], pb0, 0, 0, 0); pb1 = __builtin_amdgcn_mfma_f32_32x32x16_bf16(a1, qb_[s], pb1, 0, 0, 0); } } }
        bf16x8 fa[4], fb[4];
        if (doA) softmax_half(pa0, pa1, oa0, oa1, ma, la, fa, t == 0, band, kb0, (rba + r32v), r32v, hiv, wsf);
        if (doB) softmax_half(pb0, pb1, ob0, ob1, mb, lb, fb, t == 0, band, kb0, (rbb + r32v), r32v, hiv, wsf + 64);
        { const LAS unsigned char* vb = buf + KSLOT + ((lanev >> 4) & 1) * 32 + (lanev & 3) * 8 + (4 * hiv + ((lanev & 15) >> 2)) * 64;
#pragma unroll
          for (int s = 0; s < 4; ++s) {
              { const s16x4 lo = vtr(vb + s * 1024), hh = vtr(vb + s * 1024 + 512); const bf16x8 vf = {lo[0], lo[1], lo[2], lo[3], hh[0], hh[1], hh[2], hh[3]};
                if (doA) oa0 = __builtin_amdgcn_mfma_f32_32x32x16_bf16(fa[s], vf, oa0, 0, 0, 0); if (doB) ob0 = __builtin_amdgcn_mfma_f32_32x32x16_bf16(fb[s], vf, ob0, 0, 0, 0); }
              { const s16x4 lo = vtr(vb + 4096 + s * 1024), hh = vtr(vb + 4096 + s * 1024 + 512); const bf16x8 vf = {lo[0], lo[1], lo[2], lo[3], hh[0], hh[1], hh[2], hh[3]};
                if (doA) oa1 = __builtin_amdgcn_mfma_f32_32x32x16_bf16(fa[s], vf, oa1, 0, 0, 0); if (doB) ob1 = __builtin_amdgcn_mfma_f32_32x32x16_bf16(fb[s], vf, ob1, 0, 0, 0); } } }
        if (t + 1 < NT) { *(LAS u32x4*)(nbuf + tidv * 16) = sk0; if (tidv < 256) *(LAS u32x4*)(nbuf + (tidv + 512) * 16) = sk1; *(LAS u32x4*)(nbuf + KSLOT + tidv * 16) = sv; }
        __syncthreads();
    }
    la += __shfl_xor(la, 32); lb += __shfl_xor(lb, 32);
    if (hi == 0) { wsf[32 + r32] = la; wsf[96 + r32] = lb; }
    LAS bf16_t* stg = (LAS bf16_t*)(lds + L_OST) + wid * 2048;
#pragma unroll
    for (int hf = 0; hf < 2; ++hf) {
#pragma unroll
        for (int r = 0; r < 16; ++r) { const int orow = crow(r, hi); const float rl = __builtin_amdgcn_rcpf(wsf[hf * 64 + 32 + orow]);
            stg[orow * 64 + r32] = f2bf((hf ? ob0[r] : oa0[r]) * rl); stg[orow * 64 + 32 + r32] = f2bf((hf ? ob1[r] : oa1[r]) * rl); }
        asm volatile("" ::: "memory");
        bf16_t* Ow = O + (rowbase + q0 + (hf ? rbb : rba)) * 512 + h * 64;
#pragma unroll
        for (int i = 0; i < 4; ++i) { const int row = i * 8 + (lane >> 3), ch = lane & 7; const u32x4 v = *(const LAS u32x4*)(stg + row * 64 + ch * 8); *(u32x4*)(Ow + (size_t)row * 512 + ch * 8) = v; }
        asm volatile("" ::: "memory");
    }
    asm volatile("s_waitcnt vmcnt(0)" ::: "memory");
    __syncthreads();
    if (tid == 0) __hip_atomic_fetch_add(done_ctr, 1u, __ATOMIC_RELEASE, __HIP_MEMORY_SCOPE_AGENT);
}
}
#else
namespace att {
constexpr int KSLOT = 12288, VSLOT = 8192, BUFB = KSLOT + VSLOT, L_WS = 2 * BUFB, L_OST = L_WS + 8 * 128 * 4, L_END = L_OST + 8 * 4096;
constexpr int UNIT_ROWS = 512;
__device__ __forceinline__ int crow(int r, int hi) { return (r & 3) + 8 * (r >> 2) + 4 * hi; }
__device__ __forceinline__ s16x4 vtr(const LAS unsigned char* p) { return __builtin_bit_cast(s16x4, __builtin_amdgcn_ds_read_tr16_b64_v4i16((LAS s16x4*)p)); }
__device__ __forceinline__ void load_q(bf16x8 (&qr)[6], const bf16_t* Q, const f32x2* rope, size_t row, int h, int hi) {
    const bf16_t* Qw = Q + row * 768 + h * 96 + hi * 8;
#pragma unroll
    for (int s = 0; s < 6; ++s) qr[s] = *(const bf16x8*)(Qw + s * 16);
    const f32x4* rp = (const f32x4*)(rope + row * 16 + 4 * hi);
#pragma unroll
    for (int s = 4; s < 6; ++s) { const f32x4 c01 = rp[(s - 4) * 4], c23 = rp[(s - 4) * 4 + 1]; const u32x4 w = __builtin_bit_cast(u32x4, qr[s]); u32x4 o;
        { const float e = bflo(w.x), d = bfhi(w.x); o.x = pk2(e * c01[0] - d * c01[1], d * c01[0] + e * c01[1]); }
        { const float e = bflo(w.y), d = bfhi(w.y); o.y = pk2(e * c01[2] - d * c01[3], d * c01[2] + e * c01[3]); }
        { const float e = bflo(w.z), d = bfhi(w.z); o.z = pk2(e * c23[0] - d * c23[1], d * c23[0] + e * c23[1]); }
        { const float e = bflo(w.w), d = bfhi(w.w); o.w = pk2(e * c23[2] - d * c23[3], d * c23[2] + e * c23[3]); }
        qr[s] = __builtin_bit_cast(bf16x8, o); }
}
__device__ __forceinline__ void softmax_half(f32x16& p0, f32x16& p1, f32x16& o0, f32x16& o1, float& mrun, float& lrun, bf16x8 (&pa)[4],
                                             bool first, bool band, int kb0, int qrel, int r32, int hi, LAS float* wsf) {
    if (band) {
#pragma unroll
        for (int r = 0; r < 16; ++r) { const int kv = kb0 + (r & 3) + 8 * (r >> 2); if (kv > qrel) p0[r] = -INFINITY; if (kv + 32 > qrel) p1[r] = -INFINITY; } }
    float mx = fmaxf(p0[0], p1[0]);
#pragma unroll
    for (int r = 1; r < 16; ++r) mx = fmaxf(mx, fmaxf(p0[r], p1[r]));
    mx = fmaxf(mx, __shfl_xor(mx, 32));
    if (first || __any(mx > 8.0f)) {
        const float dl = first ? mx : fmaxf(mx, 0.f); mrun += dl;
#pragma unroll
        for (int r = 0; r < 16; ++r) { p0[r] -= dl; p1[r] -= dl; }
        const float alpha = __builtin_amdgcn_exp2f(-dl); lrun *= alpha;
        if (hi == 0) wsf[r32] = alpha;
#pragma unroll
        for (int r = 0; r < 16; ++r) { const float a = wsf[crow(r, hi)]; o0[r] *= a; o1[r] *= a; }
    }
    float ls = 0.f;
#pragma unroll
    for (int r = 0; r < 16; ++r) { p0[r] = __builtin_amdgcn_exp2f(p0[r]); p1[r] = __builtin_amdgcn_exp2f(p1[r]); ls += p0[r] + p1[r]; }
    lrun += ls;
#pragma unroll
    for (int s = 0; s < 4; ++s) { const int bb = 8 * (s & 1); u32x4 w;
        if (s < 2) { w.x = pk2(p0[bb], p0[bb + 1]); w.y = pk2(p0[bb + 2], p0[bb + 3]); w.z = pk2(p0[bb + 4], p0[bb + 5]); w.w = pk2(p0[bb + 6], p0[bb + 7]); }
        else { w.x = pk2(p1[bb], p1[bb + 1]); w.y = pk2(p1[bb + 2], p1[bb + 3]); w.z = pk2(p1[bb + 4], p1[bb + 5]); w.w = pk2(p1[bb + 6], p1[bb + 7]); }
        pa[s] = __builtin_bit_cast(bf16x8, w); }
}
__device__ __forceinline__ void attn_unit(int b, int h, int qb, LAS unsigned char* lds, unsigned* done_ctr) {
    KArgs kp = kargs(); unsigned char* ws_ = kp->ws;
    const bf16_t* Q = (const bf16_t*)(ws_ + WS_Q); const bf16_t* Kg = (const bf16_t*)(ws_ + WS_K); const bf16_t* Vg = (const bf16_t*)(ws_ + WS_V); bf16_t* O = (bf16_t*)(ws_ + WS_YS);
    const int tid = opaque_tid(), lane = tid & 63, r32 = lane & 31, hi = lane >> 5; const int wid = __builtin_amdgcn_readfirstlane(tid >> 6);
    const size_t rowbase = (size_t)b * SEQ; const int q0 = qb * UNIT_ROWS;
    bf16x8 qa[6], qb_[6];
    load_q(qa, Q, (const f32x2*)(ws_ + WS_ROPE), rowbase + q0 + wid * 64 + r32, h, hi);
    load_q(qb_, Q, (const f32x2*)(ws_ + WS_ROPE), rowbase + q0 + wid * 64 + 32 + r32, h, hi);
    const bf16_t* ksrc0 = Kg + (rowbase + (tid & 63)) * KP + h * 64 + (tid >> 6) * 8;
    const bf16_t* ksrc1 = Kg + (rowbase + (tid & 63)) * KP + 512 + (tid >> 6) * 8;
    const bf16_t* vsrc = Vg + (rowbase + ((tid & 255) >> 2)) * 512 + h * 64 + (tid >> 8) * 32 + (tid & 3) * 8;
    const int NT = (q0 + UNIT_ROWS) / 64;
    LAS float* wsf = (LAS float*)(lds + L_WS) + wid * 128;
    u32x4 sk0, sk1, sv;
    sk0 = *(const u32x4*)ksrc0; if (tid < 256) sk1 = *(const u32x4*)ksrc1; sv = *(const u32x4*)vsrc;
    *(LAS u32x4*)(lds + tid * 16) = sk0; if (tid < 256) *(LAS u32x4*)(lds + (tid + 512) * 16) = sk1; *(LAS u32x4*)(lds + KSLOT + tid * 16) = sv;
    __syncthreads();
    f32x16 oa0 = {}, oa1 = {}, ob0 = {}, ob1 = {}; float ma = 0.f, la = 0.f, mb = 0.f, lb = 0.f;
    const int qra = wid * 64 + r32, qrb = qra + 32;
    for (int t = 0; t < NT; ++t) {
        LAS unsigned char* buf = lds + (t & 1) * BUFB; LAS unsigned char* nbuf = lds + ((t + 1) & 1) * BUFB;
        if (t + 1 < NT) { sk0 = *(const u32x4*)(ksrc0 + (size_t)(t + 1) * 64 * KP); if (tid < 256) sk1 = *(const u32x4*)(ksrc1 + (size_t)(t + 1) * 64 * KP); sv = *(const u32x4*)(vsrc + (size_t)(t + 1) * 64 * 512); }
        f32x16 pa0, pa1, pb0, pb1;
#pragma unroll
        for (int r = 0; r < 16; ++r) { pa0[r] = -ma; pa1[r] = -ma; pb0[r] = -mb; pb1[r] = -mb; }
        { const LAS unsigned char* kb = buf + hi * 1024 + r32 * 16;
#pragma unroll
          for (int s = 0; s < 6; ++s) { const bf16x8 a0 = *(const LAS bf16x8*)(kb + s * 2048), a1 = *(const LAS bf16x8*)(kb + s * 2048 + 512);
              pa0 = __builtin_amdgcn_mfma_f32_32x32x16_bf16(a0, qa[s], pa0, 0, 0, 0); pa1 = __builtin_amdgcn_mfma_f32_32x32x16_bf16(a1, qa[s], pa1, 0, 0, 0);
              pb0 = __builtin_amdgcn_mfma_f32_32x32x16_bf16(a0, qb_[s], pb0, 0, 0, 0); pb1 = __builtin_amdgcn_mfma_f32_32x32x16_bf16(a1, qb_[s], pb1, 0, 0, 0); } }
        const bool band = t >= NT - 8; const int kb0 = 64 * (t - (NT - 8)) + 4 * hi;
        bf16x8 fa[4], fb[4];
        softmax_half(pa0, pa1, oa0, oa1, ma, la, fa, t == 0, band, kb0, qra, r32, hi, wsf);
        softmax_half(pb0, pb1, ob0, ob1, mb, lb, fb, t == 0, band, kb0, qrb, r32, hi, wsf + 64);
        { const LAS unsigned char* vb = buf + KSLOT + ((lane >> 4) & 1) * 32 + (lane & 3) * 8 + (4 * hi + ((lane & 15) >> 2)) * 64;
#pragma unroll
          for (int s = 0; s < 4; ++s) {
              { const s16x4 lo = vtr(vb + s * 1024), hh = vtr(vb + s * 1024 + 512); const bf16x8 vf = {lo[0], lo[1], lo[2], lo[3], hh[0], hh[1], hh[2], hh[3]};
                oa0 = __builtin_amdgcn_mfma_f32_32x32x16_bf16(fa[s], vf, oa0, 0, 0, 0); ob0 = __builtin_amdgcn_mfma_f32_32x32x16_bf16(fb[s], vf, ob0, 0, 0, 0); }
              { const s16x4 lo = vtr(vb + 4096 + s * 1024), hh = vtr(vb + 4096 + s * 1024 + 512); const bf16x8 vf = {lo[0], lo[1], lo[2], lo[3], hh[0], hh[1], hh[2], hh[3]};
                oa1 = __builtin_amdgcn_mfma_f32_32x32x16_bf16(fa[s], vf, oa1, 0, 0, 0); ob1 = __builtin_amdgcn_mfma_f32_32x32x16_bf16(fb[s], vf, ob1, 0, 0, 0); } } }
        if (t + 1 < NT) { *(LAS u32x4*)(nbuf + tid * 16) = sk0; if (tid < 256) *(LAS u32x4*)(nbuf + (tid + 512) * 16) = sk1; *(LAS u32x4*)(nbuf + KSLOT + tid * 16) = sv; }
        __syncthreads();
    }
    la += __shfl_xor(la, 32); lb += __shfl_xor(lb, 32);
    if (hi == 0) { wsf[32 + r32] = la; wsf[96 + r32] = lb; }
    LAS bf16_t* stg = (LAS bf16_t*)(lds + L_OST) + wid * 2048;
#pragma unroll
    for (int hf = 0; hf < 2; ++hf) {
#pragma unroll
        for (int r = 0; r < 16; ++r) { const int orow = crow(r, hi); const float rl = __builtin_amdgcn_rcpf(wsf[hf * 64 + 32 + orow]);
            stg[orow * 64 + r32] = f2bf((hf ? ob0[r] : oa0[r]) * rl); stg[orow * 64 + 32 + r32] = f2bf((hf ? ob1[r] : oa1[r]) * rl); }
        asm volatile("" ::: "memory");
        bf16_t* Ow = O + (rowbase + q0 + wid * 64 + hf * 32) * 512 + h * 64;
#pragma unroll
        for (int i = 0; i < 4; ++i) { const int row = i * 8 + (lane >> 3), ch = lane & 7; const u32x4 v = *(const LAS u32x4*)(stg + row * 64 + ch * 8); *(u32x4*)(Ow + (size_t)row * 512 + ch * 8) = v; }
        asm volatile("" ::: "memory");
    }
    asm volatile("s_waitcnt vmcnt(0)" ::: "memory");
    __syncthreads();
    if (tid == 0) __hip_atomic_fetch_add(done_ctr, 1u, __ATOMIC_RELEASE, __HIP_MEMORY_SCOPE_AGENT);
}
}
#endif

namespace rwkv {
constexpr int LP = 72, TB = 64 * LP * 2;
constexpr int S_HT0 = 0, S_HT1 = 1, S_A = 2  , S_B = 3  , S_K = 4, S_R = 5, S_BT = 6, S_KT = 7, S_V = 8,
              S_MOFF = 9, S_MAK = 10, S_MRK = 11, S_MRB = 12, S_D = 13, S_ZT = 14, S_ACC = 15, NSLOT = 16;
constexpr int FP = 68;
constexpr int O_ZW = S_K * TB, O_ZA = O_ZW + 64 * FP * 4, O_YB = S_MAK * TB, O_WT = NSLOT * TB, O_CL = O_WT + 8 * 64 * 4, O_CST = O_CL + 64 * 4, O_END = O_CST + 12 * 64 * 4, O_TT = O_END  ;
static_assert(O_ZA + 64 * FP * 4 <= (S_KT + 1) * TB && O_YB + 64 * FP * 4 <= (S_MRK + 1) * TB, "f32 aliases");
__device__ __forceinline__ s16x4 vtr(const LAS unsigned char* p) { return __builtin_bit_cast(s16x4, __builtin_amdgcn_ds_read_tr16_b64_v4i16((LAS s16x4*)p)); }
struct LaneOff { int bn, bt, bs; };
__device__ __forceinline__ LaneOff lane_off(int fr, int fq) { LaneOff o; o.bn = (fr * LP + 8 * fq) * 2; o.bt = ((8 * fq + (fr >> 2)) * LP + 4 * (fr & 3)) * 2; o.bs = (fr * LP + 4 * fq) * 2; return o; }
__device__ __forceinline__ void relaunder(LaneOff& o) { asm volatile("" : "+v"(o.bn), "+v"(o.bt), "+v"(o.bs)); }
__device__ __forceinline__ bf16x8 frag_t(const LAS unsigned char* tile, int kk, int c0, const LaneOff& o) {
    const LAS unsigned char* q = tile + o.bt + (32 * kk * LP + c0) * 2;
    const s16x4 lo = vtr(q), hi = vtr(q + 4 * LP * 2); return (bf16x8){lo[0], lo[1], lo[2], lo[3], hi[0], hi[1], hi[2], hi[3]};
}
__device__ __forceinline__ bf16x8 frag_n(const LAS unsigned char* tile, int r0, int kk, const LaneOff& o) { return *(const LAS bf16x8*)(tile + o.bn + (r0 * LP + 32 * kk) * 2); }
__device__ __forceinline__ f32x4 MFMA16(bf16x8 a, bf16x8 b, f32x4 c) { return __builtin_amdgcn_mfma_f32_16x16x32_bf16(a, b, c, 0, 0, 0); }
__device__ __forceinline__ void st_tile_T(LAS unsigned char* tile, int m0, int n0, const LaneOff& o, const f32x4 c) {
    u32x2 w; w.x = pk2(c[0], c[1]); w.y = pk2(c[2], c[3]); *(LAS u32x2*)(tile + o.bs + (n0 * LP + m0) * 2) = w;
}
__device__ __forceinline__ void unpack8(const u32x4 w, float (&f)[8]) { f[0] = bflo(w.x); f[1] = bfhi(w.x); f[2] = bflo(w.y); f[3] = bfhi(w.y); f[4] = bflo(w.z); f[5] = bfhi(w.z); f[6] = bflo(w.w); f[7] = bfhi(w.w); }
__device__ __forceinline__ u32x4 pack8(const float (&f)[8]) { u32x4 w; w.x = pk2(f[0], f[1]); w.y = pk2(f[2], f[3]); w.z = pk2(f[4], f[5]); w.w = pk2(f[6], f[7]); return w; }
__device__ __forceinline__ void ld8(const float* p, float (&f)[8]) { const f32x4 a = *(const f32x4*)p, b = *(const f32x4*)(p + 4); f[0] = a[0]; f[1] = a[1]; f[2] = a[2]; f[3] = a[3]; f[4] = b[0]; f[5] = b[1]; f[6] = b[2]; f[7] = b[3]; }
__device__ __forceinline__ void ld8l(const LAS float* p, float (&f)[8]) { const f32x4 a = *(const LAS f32x4*)p, b = *(const LAS f32x4*)(p + 4); f[0] = a[0]; f[1] = a[1]; f[2] = a[2]; f[3] = a[3]; f[4] = b[0]; f[5] = b[1]; f[6] = b[2]; f[7] = b[3]; }
__device__ __forceinline__ float ex2(float x) { return __builtin_amdgcn_exp2f(x); }
constexpr float LOG2E = 1.4426950408889634f, LN2 = 0.6931471805599453f;

__device__ __forceinline__ void rwkv_unit(int l, int b, int h, LAS unsigned char* L) {
    const int tid = opaque_tid(), lane = tid & 63, fr = lane & 15, fq = lane >> 4; const int w = __builtin_amdgcn_readfirstlane(tid >> 6);
    const Params p = load_params();
    const bf16_t* PA = (const bf16_t*)(p.ws + WS_PA); bf16_t* Yout = (bf16_t*)(p.ws + WS_YS) + (size_t)T * 512;
    const int t = tid >> 3, c8 = (tid & 7) * 8;
    const int tw = (lane >> 3);
    const int cw = 16 * (w & 3);
    const float* mu = p.rwkv_mu + l * 1664;
    LaneOff lo = lane_off(fr, fq);
#define SLOT(s) (L + (s) * TB)
    bf16x8 bup[2];
    { const float* U = ((w < 4) ? p.rwkv_w_up : p.rwkv_a_up) + (size_t)l * 64 * 512 + h * 64 + 16 * (w & 3) + fr;
#pragma unroll
      for (int kk = 0; kk < 2; ++kk) { float f[8];
#pragma unroll
          for (int e = 0; e < 8; ++e) f[e] = U[(size_t)(32 * kk + 8 * fq + e) * 512];
          bup[kk] = __builtin_bit_cast(bf16x8, pack8(f)); } }
    for (int e = tid; e < TB / 4; e += 512) { ((LAS unsigned*)SLOT(S_HT0))[e] = 0u; ((LAS unsigned*)SLOT(S_D))[e] = 0u; ((LAS unsigned*)SLOT(S_MOFF))[e] = 0u; ((LAS unsigned*)SLOT(S_MRB))[e] = 0u;
        ((LAS unsigned*)SLOT(S_ZT))[e] = 0u; ((LAS unsigned*)SLOT(S_ACC))[e] = 0u; }
    f32x4 hacc[4];
#pragma unroll
    for (int i = 0; i < 4; ++i) hacc[i] = (f32x4){0.f, 0.f, 0.f, 0.f};
    int hcur = S_HT0, hnxt = S_HT1;
    u32x4 raw[10];
#define RWKV_LOAD(c, t, c8) do { const size_t row_ = (size_t)b * SEQ + (c) * 64 + (t); const bf16_t* s_ = PA + row_ * NA; const bool hp_ = ((c) * 64 + (t)) > 0; const u32x4 z_ = {0u, 0u, 0u, 0u}; \
        raw[0] = *(const u32x4*)(s_ + RW_R + h * 64 + c8); raw[1] = hp_ ? *(const u32x4*)(s_ - NA + RW_R + h * 64 + c8) : z_; \
        raw[2] = *(const u32x4*)(s_ + RW_K + h * 64 + c8); raw[3] = hp_ ? *(const u32x4*)(s_ - NA + RW_K + h * 64 + c8) : z_; \
        raw[4] = *(const u32x4*)(s_ + RW_V + h * 64 + c8); raw[5] = hp_ ? *(const u32x4*)(s_ - NA + RW_V + h * 64 + c8) : z_; \
        raw[6] = *(const u32x4*)(s_ + RW_LW + c8); raw[7] = hp_ ? *(const u32x4*)(s_ - NA + RW_LW + c8) : z_; \
        raw[8] = *(const u32x4*)(s_ + RW_LA + c8); raw[9] = hp_ ? *(const u32x4*)(s_ - NA + RW_LA + c8) : z_; } while (0)
    for (int e = tid; e < 12 * 64; e += 512) { const int rw_ = e >> 6, i_ = e & 63; const int hci = l * 512 + h * 64 + i_; float val;
        switch (rw_) { case 0: val = mu[h * 64 + i_]; break; case 1: val = mu[512 + h * 64 + i_]; break; case 2: val = mu[1024 + h * 64 + i_]; break; case 3: val = mu[1536 + i_]; break; case 4: val = mu[1600 + i_]; break;
            case 5: val = p.rwkv_w0[hci]; break; case 6: val = p.rwkv_a0[hci]; break; case 7: val = p.rwkv_k_k[hci]; break; case 8: val = p.rwkv_k_a[hci]; break; case 9: val = p.rwkv_r_k[hci]; break;
            case 10: val = p.rwkv_ln_w[hci]; break; default: val = p.rwkv_ln_b[hci]; break; }
        ((LAS float*)(L + O_CST))[e] = val; }
#ifdef V_C
    if (tid < 48) { const int task = tid / 6 + 8 * (tid % 6); u32x4 d = {0u, 0u, 0u, 3u};
        if (task < 36) { int q, mn;
            if (task < 6) { q = 0; mn = (int)((0xEDC984ull >> (4 * task)) & 0xF); }
            else { q = 1 + (task - 6) / 10; mn = (int)((0xFEDCA98540ull >> (4 * ((task - 6) % 10))) & 0xF); }
            const int m0 = 16 * (mn >> 2), n0 = 16 * (mn & 3);
            d.x = (unsigned)(((q < 2) ? S_A : S_R) * TB + m0 * LP * 2); d.y = (unsigned)(((q & 1) ? S_K : S_B) * TB + n0 * LP * 2);
            d.z = (unsigned)(((q == 0) ? S_MOFF : (q == 1) ? S_MAK : (q == 2) ? S_MRB : S_MRK) * TB + (n0 * LP + m0) * 2);
            d.w = (m0 == n0) ? ((q < 2) ? 1u : 2u) : 0u;
        } else { const int z = task - 36; const int mn = (int)((0xB76321ull >> (4 * (z % 6))) & 0xF);
            d.z = (unsigned)(((z < 6) ? S_MAK : S_MRK) * TB + (16 * (mn & 3) * LP + 16 * (mn >> 2)) * 2); }
        *(LAS u32x2*)(L + O_TT + tid * 8) = (u32x2){(d.x >> 4) | ((d.y >> 4) << 16), (d.z >> 4) | (d.w << 16)}; }
#endif
    RWKV_LOAD(0, t, c8);
    __syncthreads();
    for (int c = 0; c < SEQ / 64; ++c) {
        int c8v = c8, tv = t, frv = fr, fqv = fq; asm volatile("" : "+v"(c8v), "+v"(tv), "+v"(frv), "+v"(fqv));
        const int twv = tv & 7;
        float r[8], kraw[8], v[8];
        { float cu[8], pr[8], m8[8], o[8];
          unpack8(raw[0], cu); unpack8(raw[1], pr); ld8l((const LAS float*)(L + O_CST) + 0 * 64 + c8v, m8);
#pragma unroll
          for (int e = 0; e < 8; ++e) r[e] = cu[e] + (pr[e] - cu[e]) * m8[e];
          unpack8(raw[2], cu); unpack8(raw[3], pr); ld8l((const LAS float*)(L + O_CST) + 1 * 64 + c8v, m8);
#pragma unroll
          for (int e = 0; e < 8; ++e) kraw[e] = cu[e] + (pr[e] - cu[e]) * m8[e];
          unpack8(raw[4], cu); unpack8(raw[5], pr); ld8l((const LAS float*)(L + O_CST) + 2 * 64 + c8v, m8);
#pragma unroll
          for (int e = 0; e < 8; ++e) v[e] = cu[e] + (pr[e] - cu[e]) * m8[e];
#ifdef V_V
          *(LAS u32x4*)(SLOT(S_V) + (tv * LP + c8v) * 2) = pack8(v);
#endif
          unpack8(raw[6], cu); unpack8(raw[7], pr); ld8l((const LAS float*)(L + O_CST) + 3 * 64 + c8v, m8);
#pragma unroll
          for (int e = 0; e < 8; ++e) { const float x = cu[e] + (pr[e] - cu[e]) * m8[e]; o[e] = 1.0f - 2.0f * __builtin_amdgcn_rcpf(ex2(x * (2.0f * LOG2E)) + 1.0f); }
          *(LAS u32x4*)(SLOT(S_A) + (tv * LP + c8v) * 2) = pack8(o);
          unpack8(raw[8], cu); unpack8(raw[9], pr); ld8l((const LAS float*)(L + O_CST) + 4 * 64 + c8v, m8);
#pragma unroll
          for (int e = 0; e < 8; ++e) o[e] = cu[e] + (pr[e] - cu[e]) * m8[e];
          *(LAS u32x4*)(SLOT(S_B) + (tv * LP + c8v) * 2) = pack8(o); }
        __syncthreads();
        relaunder(lo);
#ifdef U_P2
        { const LAS unsigned char* X = (w < 4) ? SLOT(S_A) : SLOT(S_B); LAS float* Z = (LAS float*)(L + ((w < 4) ? O_ZW : O_ZA));
          f32x4 zacc[4];
#pragma unroll
          for (int m = 0; m < 4; ++m) { f32x4 a = {0.f, 0.f, 0.f, 0.f};
#pragma unroll
              for (int kk = 0; kk < 2; ++kk) a = MFMA16(frag_n(X, 16 * m, kk, lo), bup[kk], a);
              zacc[m] = a; }
#pragma unroll
          for (int m = 0; m < 4; ++m)
#pragma unroll
              for (int rr = 0; rr < 4; ++rr) Z[(16 * m + 4 * fqv + rr) * FP + cw + frv] = zacc[m][rr]; }
#else
        { const LAS unsigned char* X = (w < 4) ? SLOT(S_A) : SLOT(S_B); LAS float* Z = (LAS float*)(L + ((w < 4) ? O_ZW : O_ZA));
#pragma unroll
          for (int m = 0; m < 4; ++m) { f32x4 a = {0.f, 0.f, 0.f, 0.f};
#pragma unroll
              for (int kk = 0; kk < 2; ++kk) a = MFMA16(frag_n(X, 16 * m, kk, lo), bup[kk], a);
#pragma unroll
              for (int rr = 0; rr < 4; ++rr) Z[(16 * m + 4 * fqv + rr) * FP + cw + frv] = a[rr]; } }
#endif
        __syncthreads();
        float kk_[8], kp[8], bb[8], lw[8], cs[8], cb;
        { float zw[8], za[8], c0[8], c1[8];
          ld8l((const LAS float*)(L + O_ZW) + tv * FP + c8v, zw); ld8l((const LAS float*)(L + O_ZA) + tv * FP + c8v, za);
          ld8l((const LAS float*)(L + O_CST) + 5 * 64 + c8v, c0); ld8l((const LAS float*)(L + O_CST) + 6 * 64 + c8v, c1);
          float av[8];
#pragma unroll
#ifdef V_A
          for (int e = 0; e < 8; ++e) { lw[e] = -(LOG2E * 0.6065306597126334f) * __builtin_amdgcn_rcpf(1.0f + ex2(-(zw[e] + c0[e]) * LOG2E));
              av[e] = __builtin_amdgcn_rcpf(1.0f + ex2(-(za[e] + c1[e]) * LOG2E)); }
#else
          for (int e = 0; e < 8; ++e) { const float x = -(zw[e] + c0[e]); const float sp = fmaxf(x, 0.f) + LN2 * __builtin_amdgcn_logf(1.0f + ex2(-fabsf(x) * LOG2E));
              lw[e] = -LOG2E * ex2((-sp - 0.5f) * LOG2E);
              av[e] = __builtin_amdgcn_rcpf(1.0f + ex2(-(za[e] + c1[e]) * LOG2E)); }
#endif
          ld8l((const LAS float*)(L + O_CST) + 7 * 64 + c8v, c0); ld8l((const LAS float*)(L + O_CST) + 8 * 64 + c8v, c1);
          float ss = 0.f;
#pragma unroll
          for (int e = 0; e < 8; ++e) { kk_[e] = kraw[e] * c0[e]; ss += kk_[e] * kk_[e]; kp[e] = kraw[e] * (1.0f + (av[e] - 1.0f) * c1[e]); }
          ss = sum8(ss);
          const float inv = 1.0f / fmaxf(sqrtf(ss), 1e-12f);
          ld8l((const LAS float*)(L + O_CST) + 9 * 64 + c8v, c0);
          float cp = 0.f;
#pragma unroll
          for (int e = 0; e < 8; ++e) { kk_[e] *= inv; bb[e] = kk_[e] * av[e]; cp += r[e] * kp[e] * c0[e]; }
          cb = sum8(cp);
#pragma unroll
          for (int e = 0; e < 8; ++e) { float x = lw[e];
              float y = __shfl_up(x, 8); if (twv >= 1) x += y;
              y = __shfl_up(x, 16); if (twv >= 2) x += y;
              y = __shfl_up(x, 32); if (twv >= 4) x += y;
              cs[e] = x; }
          if (twv == 7) { LAS float* WT = (LAS float*)(L + O_WT) + w * 64 + c8v;
#pragma unroll
              for (int e = 0; e < 8; ++e) WT[e] = cs[e]; } }
        __syncthreads();
        { float off[8], tot[8];
#pragma unroll
          for (int e = 0; e < 8; ++e) { off[e] = 0.f; tot[e] = 0.f; }
#ifdef V_B
          { int wq = w; asm volatile("" : "+s"(wq));
#pragma unroll
            for (int g = 0; g < 8; ++g) { float x[8]; ld8l((const LAS float*)(L + O_WT) + g * 64 + c8v, x); const float mk = (g < wq) ? 1.0f : 0.0f;
#pragma unroll
                for (int e = 0; e < 8; ++e) { off[e] = __builtin_fmaf(x[e], mk, off[e]); tot[e] += x[e]; }
                if (g & 1) __builtin_amdgcn_sched_barrier(0); } }
#else
#pragma unroll
          for (int g = 0; g < 8; ++g) { float x[8]; ld8l((const LAS float*)(L + O_WT) + g * 64 + c8v, x);
#pragma unroll
              for (int e = 0; e < 8; ++e) { if (g < w) off[e] += x[e]; tot[e] += x[e]; } }
#endif
          if (tv == 0) { LAS float* CL = (LAS float*)(L + O_CL) + c8v;
#pragma unroll
              for (int e = 0; e < 8; ++e) CL[e] = tot[e]; }
          float o[8], en[8], ep[8]; const int toff = (tv * LP + c8v) * 2;
#pragma unroll
          for (int e = 0; e < 8; ++e) { cs[e] += off[e]; en[e] = ex2(-cs[e]); ep[e] = __builtin_amdgcn_rcpf(en[e]); o[e] = -kk_[e] * ep[e] * ex2(-lw[e]); }
          *(LAS u32x4*)(SLOT(S_A) + toff) = pack8(o);
#pragma unroll
          for (int e = 0; e < 8; ++e) o[e] = bb[e] * en[e];
          *(LAS u32x4*)(SLOT(S_B) + toff) = pack8(o);
#pragma unroll
          for (int e = 0; e < 8; ++e) o[e] = kp[e] * en[e];
          *(LAS u32x4*)(SLOT(S_K) + toff) = pack8(o);
#pragma unroll
          for (int e = 0; e < 8; ++e) o[e] = r[e] * ep[e];
          *(LAS u32x4*)(SLOT(S_R) + toff) = pack8(o);
#pragma unroll
          for (int e = 0; e < 8; ++e) { en[e] = ex2(tot[e] - cs[e]); o[e] = bb[e] * en[e]; }
          *(LAS u32x4*)(SLOT(S_BT) + toff) = pack8(o);
#pragma unroll
          for (int e = 0; e < 8; ++e) o[e] = kp[e] * en[e];
          *(LAS u32x4*)(SLOT(S_KT) + toff) = pack8(o);
#ifndef V_V
          *(LAS u32x4*)(SLOT(S_V) + toff) = pack8(v);
#endif
        }
        __syncthreads();
        relaunder(lo);
        int wv = w; asm volatile("" : "+s"(wv));
#if defined(LOAD_AT) && LOAD_AT == 4
        if (c + 1 < SEQ / 64) RWKV_LOAD(c + 1, tv, c8v);
#endif
#ifdef U_P4
        f32x4 tacc[5];
#pragma unroll
        for (int it = 0; it < 5; ++it) { const int task = wv + 8 * it; f32x4 a = {0.f, 0.f, 0.f, 0.f};
            if (task < 36) {
                int q, mn;
                if (task < 6) { q = 0; mn = (int)((0xEDC984ull >> (4 * task)) & 0xF); }
                else { q = 1 + (task - 6) / 10; mn = (int)((0xFEDCA98540ull >> (4 * ((task - 6) % 10))) & 0xF); }
                const int m0 = 16 * (mn >> 2), n0 = 16 * (mn & 3);
                const LAS unsigned char* XA = (q < 2) ? SLOT(S_A) : SLOT(S_R); const LAS unsigned char* XB = (q & 1) ? SLOT(S_K) : SLOT(S_B);
#pragma unroll
                for (int kk = 0; kk < 2; ++kk) a = MFMA16(frag_n(XA, m0, kk, lo), frag_n(XB, n0, kk, lo), a);
                if (m0 == n0) {
#pragma unroll
                    for (int rr = 0; rr < 4; ++rr) { const bool keep = (q < 2) ? (frv < 4 * fqv + rr) : (frv <= 4 * fqv + rr); a[rr] = keep ? a[rr] : 0.f; } } }
            tacc[it] = a; }
        if (wv < 4) {
            f32x4 a = {0.f, 0.f, 0.f, 0.f};
#pragma unroll
            for (int kk = 0; kk < 2; ++kk) a = MFMA16(frag_n(SLOT(S_A), 16 * wv, kk, lo), frag_n(SLOT(S_B), 16 * wv, kk, lo), a);
#pragma unroll
            for (int rr = 0; rr < 4; ++rr) a[rr] = (frv < 4 * fqv + rr) ? a[rr] : 0.f;
            float x[16];
            { LAS float* NS = (LAS float*)(SLOT(hnxt) + wv * 1024);
#pragma unroll
              for (int rr = 0; rr < 4; ++rr) NS[(4 * fqv + rr) * 16 + frv] = a[rr];
              asm volatile("s_waitcnt lgkmcnt(0)" ::: "memory");
#pragma unroll
              for (int rw = 0; rw < 16; ++rw) { float s = (rw == frv) ? 1.f : 0.f;
#pragma unroll
                  for (int sc = 0; sc < rw; ++sc) s = __builtin_fmaf(NS[rw * 16 + sc], x[sc], s);
                  x[rw] = s; }
              asm volatile("s_waitcnt lgkmcnt(0)" ::: "memory"); }
            if (fqv == 0) { LAS unsigned char* dp = SLOT(S_D) + ((16 * wv + frv) * LP + 16 * wv) * 2;
                float lo8[8], hi8[8];
#pragma unroll
                for (int e = 0; e < 8; ++e) { lo8[e] = x[e]; hi8[e] = x[8 + e]; }
                *(LAS u32x4*)dp = pack8(lo8); *(LAS u32x4*)(dp + 16) = pack8(hi8); }
        }
#pragma unroll
        for (int it = 0; it < 6; ++it) { const int task = wv + 8 * it;
            if (task < 36) {
                int q, mn;
                if (task < 6) { q = 0; mn = (int)((0xEDC984ull >> (4 * task)) & 0xF); }
                else { q = 1 + (task - 6) / 10; mn = (int)((0xFEDCA98540ull >> (4 * ((task - 6) % 10))) & 0xF); }
                st_tile_T(SLOT((q == 0) ? S_MOFF : (q == 1) ? S_MAK : (q == 2) ? S_MRB : S_MRK), 16 * (mn >> 2), 16 * (mn & 3), lo, tacc[it < 5 ? it : 4]);
            } else if (task < 48) {
                const int z = task - 36; const int mn = (int)((0xB76321ull >> (4 * (z % 6))) & 0xF);
                st_tile_T(SLOT((z < 6) ? S_MAK : S_MRK), 16 * (mn >> 2), 16 * (mn & 3), lo, (f32x4){0.f, 0.f, 0.f, 0.f});
            } }
#else
#ifdef V_C
        u32x4 dq[3];
#pragma unroll
        for (int j = 0; j < 3; ++j) dq[j] = *(const LAS u32x4*)(L + O_TT + wv * 48 + j * 16);
#endif
        if (wv < 4) {
            f32x4 a = {0.f, 0.f, 0.f, 0.f};
#pragma unroll
            for (int kk = 0; kk < 2; ++kk) a = MFMA16(frag_n(SLOT(S_A), 16 * wv, kk, lo), frag_n(SLOT(S_B), 16 * wv, kk, lo), a);
#pragma unroll
            for (int rr = 0; rr < 4; ++rr) a[rr] = (frv < 4 * fqv + rr) ? a[rr] : 0.f;
            float x[16];
            { LAS float* NS = (LAS float*)(SLOT(hnxt) + wv * 1024);
#pragma unroll
              for (int rr = 0; rr < 4; ++rr) NS[(4 * fqv + rr) * 16 + frv] = a[rr];
              asm volatile("s_waitcnt lgkmcnt(0)" ::: "memory");
#pragma unroll
              for (int rw = 0; rw < 16; ++rw) { float s = (rw == frv) ? 1.f : 0.f;
#pragma unroll
                  for (int sc = 0; sc < rw; ++sc) s = __builtin_fmaf(NS[rw * 16 + sc], x[sc], s);
                  x[rw] = s; }
              asm volatile("s_waitcnt lgkmcnt(0)" ::: "memory"); }
            if (fqv == 0) { LAS unsigned char* dp = SLOT(S_D) + ((16 * wv + frv) * LP + 16 * wv) * 2;
                float lo8[8], hi8[8];
#pragma unroll
                for (int e = 0; e < 8; ++e) { lo8[e] = x[e]; hi8[e] = x[8 + e]; }
                *(LAS u32x4*)dp = pack8(lo8); *(LAS u32x4*)(dp + 16) = pack8(hi8); }
        }
#ifdef V_C
        {
#pragma unroll
          for (int it = 0; it < 6; ++it) {
            const unsigned e0 = (unsigned)__builtin_amdgcn_readfirstlane((int)((it & 1) ? dq[it >> 1].z : dq[it >> 1].x)), e1 = (unsigned)__builtin_amdgcn_readfirstlane((int)((it & 1) ? dq[it >> 1].w : dq[it >> 1].y));
            const int mode = (int)(e1 >> 16); LAS unsigned char* dst = L + ((e1 & 0xffffu) << 4) + lo.bs;
            if (mode < 3) {
                const LAS unsigned char* pa = L + ((e0 & 0xffffu) << 4) + lo.bn; const LAS unsigned char* pb = L + ((e0 >> 16) << 4) + lo.bn;
                f32x4 a = MFMA16(*(const LAS bf16x8*)pa, *(const LAS bf16x8*)pb, (f32x4){0.f, 0.f, 0.f, 0.f});
                a = MFMA16(*(const LAS bf16x8*)(pa + 64), *(const LAS bf16x8*)(pb + 64), a);
                if (mode) { const int thr = frv + ((mode == 1) ? 1 : 0);
#pragma unroll
                    for (int rr = 0; rr < 4; ++rr) a[rr] = (thr <= 4 * fqv + rr) ? a[rr] : 0.f; }
                u32x2 wq_; wq_.x = pk2(a[0], a[1]); wq_.y = pk2(a[2], a[3]); *(LAS u32x2*)dst = wq_;
            } else { *(LAS u32x2*)dst = (u32x2){0u, 0u}; } } }
#else
#pragma unroll
        for (int it = 0; it < 6; ++it) { const int task = wv + 8 * it;
            if (task < 36) {
                int q, mn;
                if (task < 6) { q = 0; mn = (int)((0xEDC984ull >> (4 * task)) & 0xF); }
                else { q = 1 + (task - 6) / 10; mn = (int)((0xFEDCA98540ull >> (4 * ((task - 6) % 10))) & 0xF); }
                const int m0 = 16 * (mn >> 2), n0 = 16 * (mn & 3);
                const LAS unsigned char* XA = (q < 2) ? SLOT(S_A) : SLOT(S_R); const LAS unsigned char* XB = (q & 1) ? SLOT(S_K) : SLOT(S_B);
                f32x4 a = {0.f, 0.f, 0.f, 0.f};
#pragma unroll
                for (int kk = 0; kk < 2; ++kk) a = MFMA16(frag_n(XA, m0, kk, lo), frag_n(XB, n0, kk, lo), a);
                if (m0 == n0) {
#pragma unroll
                    for (int rr = 0; rr < 4; ++rr) { const bool keep = (q < 2) ? (frv < 4 * fqv + rr) : (frv <= 4 * fqv + rr); a[rr] = keep ? a[rr] : 0.f; } }
                st_tile_T(SLOT((q == 0) ? S_MOFF : (q == 1) ? S_MAK : (q == 2) ? S_MRB : S_MRK), m0, n0, lo, a);
            } else if (task < 48) {
                const int z = task - 36; const int mn = (int)((0xB76321ull >> (4 * (z % 6))) & 0xF);
                st_tile_T(SLOT((z < 6) ? S_MAK : S_MRK), 16 * (mn >> 2), 16 * (mn & 3), lo, (f32x4){0.f, 0.f, 0.f, 0.f});
            } }
#endif
#endif
        __syncthreads();
        relaunder(lo);
#if defined(LOAD_AT) && LOAD_AT == 5
        if (c + 1 < SEQ / 64) RWKV_LOAD(c + 1, tv, c8v);
#endif
        f32x4 yacc[4];
#ifdef U_P5
        if (w < 4) {
            f32x4 xr[4];
#pragma unroll
            for (int i = 0; i < 4; ++i) { f32x4 a = {0.f, 0.f, 0.f, 0.f};
#pragma unroll
                for (int kk = 0; kk < 2; ++kk) { if (32 * kk < 16 * i + 16) a = MFMA16(frag_t(SLOT(S_MAK), kk, 16 * i, lo), frag_t(SLOT(S_V), kk, cw, lo), a);
                    a = MFMA16(frag_n(SLOT(S_A), 16 * i, kk, lo), frag_n(SLOT(hcur), cw, kk, lo), a); }
                xr[i] = a; }
#pragma unroll
            for (int i = 0; i < 4; ++i) { f32x4 a = xr[i];
#pragma unroll
                for (int kk = 0; kk < 2; ++kk) if (32 * kk < 16 * i) a = MFMA16(frag_t(SLOT(S_MOFF), kk, 16 * i, lo), frag_n(SLOT(S_ZT), cw, kk, lo), a);
                st_tile_T(SLOT(S_ACC), 16 * i, cw, lo, a);
                asm volatile("" ::: "memory");
                const f32x4 z = MFMA16(frag_t(SLOT(S_D), i >> 1, 16 * i, lo), frag_n(SLOT(S_ACC), cw, i >> 1, lo), (f32x4){0.f, 0.f, 0.f, 0.f});
                st_tile_T(SLOT(S_ZT), 16 * i, cw, lo, z);
                asm volatile("" ::: "memory"); }
#else
        if (w < 4) {
#pragma unroll
            for (int i = 0; i < 4; ++i) { f32x4 a = {0.f, 0.f, 0.f, 0.f};
#pragma unroll
                for (int kk = 0; kk < 2; ++kk) { if (32 * kk < 16 * i + 16) a = MFMA16(frag_t(SLOT(S_MAK), kk, 16 * i, lo), frag_t(SLOT(S_V), kk, cw, lo), a);
                    a = MFMA16(frag_n(SLOT(S_A), 16 * i, kk, lo), frag_n(SLOT(hcur), cw, kk, lo), a); }
#pragma unroll
                for (int kk = 0; kk < 2; ++kk) if (32 * kk < 16 * i) a = MFMA16(frag_t(SLOT(S_MOFF), kk, 16 * i, lo), frag_n(SLOT(S_ZT), cw, kk, lo), a);
                st_tile_T(SLOT(S_ACC), 16 * i, cw, lo, a);
                const f32x4 z = MFMA16(frag_t(SLOT(S_D), i >> 1, 16 * i, lo), frag_n(SLOT(S_ACC), cw, i >> 1, lo), (f32x4){0.f, 0.f, 0.f, 0.f});
                st_tile_T(SLOT(S_ZT), 16 * i, cw, lo, z); }
#endif
        } else {
#pragma unroll
            for (int i = 0; i < 4; ++i) { f32x4 a = {0.f, 0.f, 0.f, 0.f};
#pragma unroll
                for (int kk = 0; kk < 2; ++kk) { if (32 * kk < 16 * i + 16) a = MFMA16(frag_t(SLOT(S_MRK), kk, 16 * i, lo), frag_t(SLOT(S_V), kk, cw, lo), a);
                    a = MFMA16(frag_n(SLOT(S_R), 16 * i, kk, lo), frag_n(SLOT(hcur), cw, kk, lo), a);
                }
                yacc[i] = a; }
        }
        __syncthreads();
        relaunder(lo);
#if !defined(LOAD_AT)
        if (c + 1 < SEQ / 64) RWKV_LOAD(c + 1, tv, c8v);
#endif
#ifdef U_P7
        if (w >= 4) {
#pragma unroll
            for (int i = 0; i < 4; ++i) {
#pragma unroll
                for (int rr = 0; rr < 4; ++rr) hacc[i][rr] = hacc[i][rr] * ex2(((const LAS float*)(L + O_CL))[16 * i + 4 * fqv + rr]);
#pragma unroll
                for (int kk = 0; kk < 2; ++kk) { hacc[i] = MFMA16(frag_t(SLOT(S_KT), kk, 16 * i, lo), frag_t(SLOT(S_V), kk, cw, lo), hacc[i]);
                    hacc[i] = MFMA16(frag_t(SLOT(S_BT), kk, 16 * i, lo), frag_n(SLOT(S_ZT), cw, kk, lo), hacc[i]); }
#pragma unroll
                for (int kk = 0; kk < 2; ++kk) if (32 * kk < 16 * i + 16) yacc[i] = MFMA16(frag_t(SLOT(S_MRB), kk, 16 * i, lo), frag_n(SLOT(S_ZT), cw, kk, lo), yacc[i]); }
#pragma unroll
            for (int i = 0; i < 4; ++i) { st_tile_T(SLOT(hnxt), 16 * i, cw, lo, hacc[i]);
#pragma unroll
                for (int rr = 0; rr < 4; ++rr) ((LAS float*)(L + O_YB))[(16 * i + 4 * fqv + rr) * FP + cw + frv] = yacc[i][rr]; }
        }
#else
        if (w >= 4) {
#pragma unroll
            for (int i = 0; i < 4; ++i) {
#pragma unroll
                for (int rr = 0; rr < 4; ++rr) hacc[i][rr] = hacc[i][rr] * ex2(((const LAS float*)(L + O_CL))[16 * i + 4 * fqv + rr]);
#pragma unroll
                for (int kk = 0; kk < 2; ++kk) { hacc[i] = MFMA16(frag_t(SLOT(S_KT), kk, 16 * i, lo), frag_t(SLOT(S_V), kk, cw, lo), hacc[i]);
                    hacc[i] = MFMA16(frag_t(SLOT(S_BT), kk, 16 * i, lo), frag_n(SLOT(S_ZT), cw, kk, lo), hacc[i]); }
                st_tile_T(SLOT(hnxt), 16 * i, cw, lo, hacc[i]);
#pragma unroll
                for (int kk = 0; kk < 2; ++kk) if (32 * kk < 16 * i + 16) yacc[i] = MFMA16(frag_t(SLOT(S_MRB), kk, 16 * i, lo), frag_n(SLOT(S_ZT), cw, kk, lo), yacc[i]);
#pragma unroll
                for (int rr = 0; rr < 4; ++rr) ((LAS float*)(L + O_YB))[(16 * i + 4 * fqv + rr) * FP + cw + frv] = yacc[i][rr]; }
        }
#endif
        __syncthreads();
        { float y[8], g0[8], g1[8]; ld8l((const LAS float*)(L + O_YB) + tv * FP + c8v, y); ld8l((const LAS float*)(L + O_CST) + 10 * 64 + c8v, g0); ld8l((const LAS float*)(L + O_CST) + 11 * 64 + c8v, g1);
          float s = 0.f;
#pragma unroll
          for (int e = 0; e < 8; ++e) s += y[e];
          const float mean = sum8(s) * (1.f / 64.f); float q = 0.f;
#pragma unroll
          for (int e = 0; e < 8; ++e) { y[e] -= mean; q += y[e] * y[e]; }
          const float rs = rsqrtf(sum8(q) * (1.f / 64.f) + RWKV_GN_EPS);
#ifdef V_V
          float vv[8]; unpack8(*(const LAS u32x4*)(SLOT(S_V) + (tv * LP + c8v) * 2), vv);
#pragma unroll
          for (int e = 0; e < 8; ++e) y[e] = y[e] * rs * g0[e] + g1[e] + cb * vv[e];
#else
#pragma unroll
          for (int e = 0; e < 8; ++e) y[e] = y[e] * rs * g0[e] + g1[e] + cb * v[e];
#endif
          *(u32x4*)(Yout + ((size_t)b * SEQ + c * 64 + tv) * 512 + h * 64 + c8v) = pack8(y); }
        { const int tmp = hcur; hcur = hnxt; hnxt = tmp; }
    }
    __syncthreads();
#undef SLOT
#undef RWKV_LOAD
}
}

namespace gla {
using rwkv::vtr; using rwkv::unpack8; using rwkv::pack8; using rwkv::ld8l; using rwkv::ex2; using rwkv::LOG2E; using rwkv::LN2; using rwkv::MFMA16;
constexpr int LP = 72, VP = 136, TB = 64 * LP * 2;
constexpr int B_QH = 0, B_KH = TB, B_KT = 2 * TB, B_PT = 3 * TB, B_VV = 4 * TB, B_ST = B_VV + 64 * VP * 2, B_OB = B_ST + 128 * LP * 2, B_WT = B_OB + 64 * 132 * 4,
              B_CL = B_WT + 8 * 64 * 4, B_AUP = B_CL + 64 * 4, B_AB = B_AUP + 16 * 64 * 4, B_GN = B_AB + 64 * 4, B_END = B_GN + 128 * 4;
static_assert(B_END <= 131072, "gla lds");
struct LaneOff { int bn, bt, btv, bs; };
__device__ __forceinline__ LaneOff lane_off(int fr, int fq) { LaneOff o; o.bn = (fr * LP + 8 * fq) * 2; o.bt = ((8 * fq + (fr >> 2)) * LP + 4 * (fr & 3)) * 2; o.btv = ((8 * fq + (fr >> 2)) * VP + 4 * (fr & 3)) * 2; o.bs = (fr * LP + 4 * fq) * 2; return o; }
__device__ __forceinline__ void relaunder(LaneOff& o) { asm volatile("" : "+v"(o.bn), "+v"(o.bt), "+v"(o.btv), "+v"(o.bs)); }
__device__ __forceinline__ bf16x8 frag_t(const LAS unsigned char* tile, int kk, int c0, const LaneOff& o) {
    const LAS unsigned char* q = tile + o.bt + (32 * kk * LP + c0) * 2; const s16x4 lo = vtr(q), hi = vtr(q + 4 * LP * 2); return (bf16x8){lo[0], lo[1], lo[2], lo[3], hi[0], hi[1], hi[2], hi[3]}; }
__device__ __forceinline__ bf16x8 frag_tv(const LAS unsigned char* tile, int kk, int c0, const LaneOff& o) {
    const LAS unsigned char* q = tile + o.btv + (32 * kk * VP + c0) * 2; const s16x4 lo = vtr(q), hi = vtr(q + 4 * VP * 2); return (bf16x8){lo[0], lo[1], lo[2], lo[3], hi[0], hi[1], hi[2], hi[3]}; }
__device__ __forceinline__ bf16x8 frag_n(const LAS unsigned char* tile, int r0, int kk, const LaneOff& o) { return *(const LAS bf16x8*)(tile + o.bn + (r0 * LP + 32 * kk) * 2); }
__device__ __forceinline__ void st_tile_T(LAS unsigned char* tile, int m0, int n0, const LaneOff& o, const f32x4 c) { u32x2 w; w.x = pk2(c[0], c[1]); w.y = pk2(c[2], c[3]); *(LAS u32x2*)(tile + o.bs + (n0 * LP + m0) * 2) = w; }

__device__ __forceinline__ void gla_unit(int l, int b, int h, LAS unsigned char* L, unsigned* done_ctr) {
    const Params p = load_params();
    const bf16_t* PA = (const bf16_t*)(p.ws + WS_PA); bf16_t* Yout = (bf16_t*)(p.ws + WS_YS) + (size_t)2 * T * 512;
    const int tid = opaque_tid(), lane = tid & 63, fr = lane & 15, fq = lane >> 4; const int w = __builtin_amdgcn_readfirstlane(tid >> 6);
    const int t = tid >> 3, c8 = (tid & 7) * 8;
    LaneOff lo = lane_off(fr, fq);
    for (int e = tid; e < 16 * 64; e += 512) ((LAS float*)(L + B_AUP))[e] = p.gla_a_up[(size_t)l * 16 * 256 + (e >> 6) * 256 + h * 64 + (e & 63)];
    if (tid < 64) ((LAS float*)(L + B_AB))[tid] = p.gla_a_b[l * 256 + h * 64 + tid];
    if (tid < 128) ((LAS float*)(L + B_GN))[tid] = p.gla_norm[l * 512 + h * 128 + tid];
    for (int e = tid; e < 128 * LP / 2; e += 512) ((LAS unsigned*)(L + B_ST))[e] = 0u;
    for (int e = tid; e < TB / 4; e += 512) ((LAS unsigned*)(L + B_PT))[e] = 0u;
    f32x4 sacc[4];
#pragma unroll
    for (int m = 0; m < 4; ++m) sacc[m] = (f32x4){0.f, 0.f, 0.f, 0.f};
    u32x4 rq, rk, rv0, rv1, rl0, rl1;
#define GLA_LOAD(c) do { const bf16_t* s_ = PA + ((size_t)b * SEQ + (c) * 64 + t) * NA; rq = *(const u32x4*)(s_ + GQ + h * 64 + c8); rk = *(const u32x4*)(s_ + GK + h * 64 + c8); \
        rv0 = *(const u32x4*)(s_ + GV + h * 128 + 2 * c8); rv1 = *(const u32x4*)(s_ + GV + h * 128 + 2 * c8 + 8); rl0 = *(const u32x4*)(s_ + GLAT); rl1 = *(const u32x4*)(s_ + GLAT + 8); } while (0)
    GLA_LOAD(0);
    __syncthreads();
    for (int c = 0; c < SEQ / 64; ++c) {
        int c8v = c8, tv = t, frv = fr, fqv = fq; asm volatile("" : "+v"(c8v), "+v"(tv), "+v"(frv), "+v"(fqv));
        const int twv = tv & 7;
        float cs[8];
        { float lat[16]; { float a8[8]; unpack8(rl0, a8);
#pragma unroll
              for (int j = 0; j < 8; ++j) lat[j] = a8[j];
              unpack8(rl1, a8);
#pragma unroll
              for (int j = 0; j < 8; ++j) lat[8 + j] = a8[j]; }
          float z[8]; ld8l((const LAS float*)(L + B_AB) + c8v, z);
#pragma unroll
          for (int j = 0; j < 16; ++j) { float a8[8]; ld8l((const LAS float*)(L + B_AUP) + j * 64 + c8v, a8);
#pragma unroll
              for (int e = 0; e < 8; ++e) z[e] += lat[j] * a8[e]; }
#pragma unroll
          for (int e = 0; e < 8; ++e) { const float x = -z[e]; const float sp = fmaxf(x, 0.f) + LN2 * __builtin_amdgcn_logf(1.0f + ex2(-fabsf(x) * LOG2E));
              float v_ = -sp * (LOG2E / 16.0f);
              float y = __shfl_up(v_, 8); if (twv >= 1) v_ += y;
              y = __shfl_up(v_, 16); if (twv >= 2) v_ += y;
              y = __shfl_up(v_, 32); if (twv >= 4) v_ += y;
              cs[e] = v_; }
          if (twv == 7) { LAS float* WT = (LAS float*)(L + B_WT) + w * 64 + c8v;
#pragma unroll
              for (int e = 0; e < 8; ++e) WT[e] = cs[e]; } }
        __syncthreads();
        { float off[8], tot[8];
#pragma unroll
          for (int e = 0; e < 8; ++e) { off[e] = 0.f; tot[e] = 0.f; }
#pragma unroll
          for (int g = 0; g < 8; ++g) { float x[8]; ld8l((const LAS float*)(L + B_WT) + g * 64 + c8v, x);
#pragma unroll
              for (int e = 0; e < 8; ++e) { if (g < w) off[e] += x[e]; tot[e] += x[e]; } }
          if (tv == 0) { LAS float* CL = (LAS float*)(L + B_CL) + c8v;
#pragma unroll
              for (int e = 0; e < 8; ++e) CL[e] = tot[e]; }
          float q8[8], k8[8], o[8], en[8]; unpack8(rq, q8); unpack8(rk, k8); const int toff = (tv * LP + c8v) * 2;
#pragma unroll
          for (int e = 0; e < 8; ++e) { cs[e] += off[e]; en[e] = ex2(-cs[e]); o[e] = q8[e] * 0.125f * __builtin_amdgcn_rcpf(en[e]); }
          *(LAS u32x4*)(L + B_QH + toff) = pack8(o);
#pragma unroll
          for (int e = 0; e < 8; ++e) o[e] = k8[e] * en[e];
          *(LAS u32x4*)(L + B_KH + toff) = pack8(o);
#pragma unroll
          for (int e = 0; e < 8; ++e) o[e] = k8[e] * ex2(tot[e] - cs[e]);
          *(LAS u32x4*)(L + B_KT + toff) = pack8(o);
          *(LAS u32x4*)(L + B_VV + (tv * VP + 2 * c8v) * 2) = rv0; *(LAS u32x4*)(L + B_VV + (tv * VP + 2 * c8v + 8) * 2) = rv1; }
        if (c + 1 < SEQ / 64) GLA_LOAD(c + 1);
        __syncthreads();
        relaunder(lo);
        { const int m0 = 16 * (w >> 1);
#pragma unroll
          for (int nn = 0; nn < 2; ++nn) { const int n0 = 32 * (w & 1) + 16 * nn;
              if (n0 <= m0) { f32x4 a = {0.f, 0.f, 0.f, 0.f};
#pragma unroll
                  for (int kk = 0; kk < 2; ++kk) a = MFMA16(frag_n(L + B_QH, m0, kk, lo), frag_n(L + B_KH, n0, kk, lo), a);
                  if (n0 == m0) {
#pragma unroll
                      for (int rr = 0; rr < 4; ++rr) a[rr] = (frv <= 4 * fqv + rr) ? a[rr] : 0.f; }
                  st_tile_T(L + B_PT, m0, n0, lo, a); } } }
        __syncthreads();
        relaunder(lo);
        { const int n0 = 16 * w;
#pragma unroll
          for (int m = 0; m < 4; ++m) { f32x4 a = {0.f, 0.f, 0.f, 0.f};
#pragma unroll
              for (int kk = 0; kk < 2; ++kk) { if (32 * kk < 16 * m + 16) a = MFMA16(frag_t(L + B_PT, kk, 16 * m, lo), frag_tv(L + B_VV, kk, n0, lo), a);
                  a = MFMA16(frag_n(L + B_QH, 16 * m, kk, lo), frag_n(L + B_ST, n0, kk, lo), a); }
#pragma unroll
              for (int rr = 0; rr < 4; ++rr) ((LAS float*)(L + B_OB))[(16 * m + 4 * fqv + rr) * 132 + n0 + frv] = a[rr]; }
          asm volatile("" ::: "memory");
#pragma unroll
          for (int m = 0; m < 4; ++m) { f32x4 a = sacc[m];
#pragma unroll
              for (int rr = 0; rr < 4; ++rr) a[rr] *= ex2(((const LAS float*)(L + B_CL))[16 * m + 4 * fqv + rr]);
#pragma unroll
              for (int kk = 0; kk < 2; ++kk) a = MFMA16(frag_t(L + B_KT, kk, 16 * m, lo), frag_tv(L + B_VV, kk, n0, lo), a);
              sacc[m] = a; st_tile_T(L + B_ST, 16 * m, n0, lo, a); } }
        __syncthreads();
        { float v0[8], v1[8], g0[8], g1[8]; float ss = 0.f; const LAS float* ob = (const LAS float*)(L + B_OB) + tv * 132 + 2 * c8v;
          ld8l(ob, v0); ld8l(ob + 8, v1);
#pragma unroll
          for (int e = 0; e < 8; ++e) ss += v0[e] * v0[e] + v1[e] * v1[e];
          ss = sum8(ss);
          const float rstd = rsqrtf(ss * (1.f / 128.f) + NORM_EPS);
          ld8l((const LAS float*)(L + B_GN) + 2 * c8v, g0); ld8l((const LAS float*)(L + B_GN) + 2 * c8v + 8, g1);
          float o0[8], o1[8];
#pragma unroll
          for (int e = 0; e < 8; ++e) { o0[e] = v0[e] * rstd * g0[e]; o1[e] = v1[e] * rstd * g1[e]; }
          bf16_t* dst = Yout + ((size_t)b * SEQ + c * 64 + tv) * 512 + h * 128 + 2 * c8v;
          *(u32x4*)dst = pack8(o0); *(u32x4*)(dst + 8) = pack8(o1); }
    }
    asm volatile("s_waitcnt vmcnt(0)" ::: "memory");
    __syncthreads();
    if (tid == 0) __hip_atomic_fetch_add(done_ctr, 1u, __ATOMIC_RELEASE, __HIP_MEMORY_SCOPE_AGENT);
#undef GLA_LOAD
}
}

#define XB_TMO      128
#define XB_XCNT(j)  (256  + 64 * (j))
#define XB_XSUB(j)  (1280 + 64 * (j))
#define XB_XGEN(j)  (2304 + 64 * (j))
#define XB_TOP      3328
#define XB_TOPGEN   3392
#define XCD_BAR_WORDS 3456
#define XB_SPIN_CAP (1u << 18)

__device__ __forceinline__ unsigned xb_ld(unsigned* p)              { return __hip_atomic_load(p, __ATOMIC_RELAXED, __HIP_MEMORY_SCOPE_AGENT); }
__device__ __forceinline__ unsigned xb_add(unsigned* p, unsigned v) { return __hip_atomic_fetch_add(p, v, __ATOMIC_RELAXED, __HIP_MEMORY_SCOPE_AGENT); }
__device__ __forceinline__ unsigned xb_xcc_id() { return (unsigned)__builtin_amdgcn_s_getreg((3 << 11) | 20) & 0xFu; }
#define XB_SPIN(cond, bar) do { unsigned _sp = 0; while (cond) { __builtin_amdgcn_s_sleep(1); \
    if ((++_sp & 255u) == 0u) { if (xb_ld(&(bar)[XB_TMO])) break; if (_sp > XB_SPIN_CAP) { atomicAdd(&(bar)[XB_TMO], 1u); break; } } } } while (0)

struct XcdBarrier {
    unsigned* bar; unsigned x;
    volatile LAS unsigned* st;
};

__device__ __forceinline__ XcdBarrier xcd_barrier_post(unsigned* bar, volatile LAS unsigned* st) {
    XcdBarrier b; b.bar = bar; b.x = xb_xcc_id(); b.st = st;
    if (threadIdx.x == 0) (void)xb_add(&bar[XB_XCNT(b.x)], 1u);
    return b;
}
__device__ __forceinline__ void xcd_barrier_complete(unsigned* bar, unsigned x, unsigned& nloc, unsigned& nx) {
    const unsigned G = gridDim.x * gridDim.y * gridDim.z;
    unsigned sum, cnt, mine, sp = 0u;
    for (;;) {
        sum = 0u; cnt = 0u; mine = 0u;
#pragma unroll
        for (unsigned j = 0; j < 16; ++j) { const unsigned c = xb_ld(&bar[XB_XCNT(j)]); sum += c; cnt += (c > 0u) ? 1u : 0u; mine = (j == x) ? c : mine; }
        if (sum == G) break;
        __builtin_amdgcn_s_sleep(1);
        if ((++sp & 255u) == 0u) { if (xb_ld(&bar[XB_TMO])) break; if (sp > XB_SPIN_CAP) { atomicAdd(&bar[XB_TMO], 1u); break; } }
    }
    nloc = mine > 0u ? mine : 1u; nx = cnt > 0u ? cnt : 1u;
}

__device__ __forceinline__ void xcd_barrier(const XcdBarrier& b) {
    asm volatile("s_waitcnt vmcnt(0)" ::: "memory");
    __syncthreads();
    if (threadIdx.x == 0) {
        unsigned* bar = b.bar;
        __builtin_amdgcn_s_waitcnt(0);
        unsigned nloc = b.st[0], nx = b.st[1];
        if (nloc == 0u) { xcd_barrier_complete(bar, b.x, nloc, nx); b.st[0] = nloc; b.st[1] = nx; }
        const unsigned old = xb_add(&bar[XB_XSUB(b.x)], 1u);
        const unsigned gen = old / nloc;
        if (old + 1u == (gen + 1u) * nloc) {
            __builtin_amdgcn_fence(__ATOMIC_RELEASE, "agent");
            asm volatile("s_waitcnt vmcnt(0)" ::: "memory");
            const unsigned og = xb_add(&bar[XB_TOP], 1u);
            const unsigned tg = og / nx;
            if (og + 1u == (tg + 1u) * nx) xb_add(&bar[XB_TOPGEN], 1u);
            else XB_SPIN(xb_ld(&bar[XB_TOPGEN]) == tg, bar);
            __builtin_amdgcn_fence(__ATOMIC_ACQUIRE, "agent");
            xb_add(&bar[XB_XGEN(b.x)], 1u);
            asm volatile("s_waitcnt vmcnt(0)" ::: "memory");
        } else {
            XB_SPIN(xb_ld(&bar[XB_XGEN(b.x)]) == gen, bar);
            __builtin_amdgcn_fence(__ATOMIC_ACQUIRE, "agent");
            asm volatile("s_waitcnt vmcnt(0)" ::: "memory");
        }
    }
    __syncthreads();
}

constexpr int NWAVES = 8, NTHREADS = 512;
constexpr int LDS_MISC = 155648, LDS_BYTES = 159744;
constexpr int PH_PER_LAYER = 8, N_PHASES = 1 + DEPTH * PH_PER_LAYER;
constexpr int CW_BAR = 4096;
constexpr int MG_BLOCKS = 192;
constexpr int RWKV_BLOCKS = 64, SUB_BLOCKS = 256 - RWKV_BLOCKS;
constexpr int N_ATT_UNITS = 64 * (SEQ / 512), N_MIX_ITEMS = 32 + N_ATT_UNITS;
#ifndef MK_MULTI_LAUNCH
#define MK_MULTI_LAUNCH 0
#endif

__device__ __forceinline__ void sub_barrier(unsigned* cnt, unsigned target) {
    asm volatile("s_waitcnt vmcnt(0)" ::: "memory");
    __syncthreads();
    if (threadIdx.x == 0) {
        __builtin_amdgcn_fence(__ATOMIC_RELEASE, "agent"); asm volatile("s_waitcnt vmcnt(0)" ::: "memory");
        __hip_atomic_fetch_add(cnt, 1u, __ATOMIC_RELAXED, __HIP_MEMORY_SCOPE_AGENT);
        unsigned sp = 0; while (__hip_atomic_load(cnt, __ATOMIC_RELAXED, __HIP_MEMORY_SCOPE_AGENT) < target && ++sp < (1u << 24)) __builtin_amdgcn_s_sleep(2);
        __builtin_amdgcn_fence(__ATOMIC_ACQUIRE, "agent"); asm volatile("s_waitcnt vmcnt(0)" ::: "memory");
    }
    __syncthreads();
}
__global__ void __launch_bounds__(NTHREADS, 2) hybrid_fwd(Params p_unused) {
    extern __shared__ __attribute__((aligned(16))) unsigned char lds[];
#ifndef NO_CG_SYNC
    cg::grid_group grid = cg::this_grid();
#endif
#define G ((int)gridDim.x)
#define bx ((int)blockIdx.x)
#define NGW (G * NWAVES)
#define PHASE_VARS const int tid = opaque_tid(), lane = tid & 63, wave = __builtin_amdgcn_readfirstlane(tid >> 6), gw = bx * NWAVES + wave; (void)lane; (void)gw
    LAS unsigned char* ldsl = (LAS unsigned char*)lds;
    { volatile LAS unsigned* misc = (volatile LAS unsigned*)(ldsl + LDS_MISC); if (threadIdx.x < 64) misc[threadIdx.x] = 0u; __syncthreads(); }
    (void)xcd_barrier_post((unsigned*)(kargs()->ws + WS_CTL) + CW_BAR, (volatile LAS unsigned*)(ldsl + LDS_MISC) + 8);
#define GRID_BAR() do { XcdBarrier xb_; xb_.bar = (unsigned*)(kargs()->ws + WS_CTL) + CW_BAR; xb_.x = xb_xcc_id(); xb_.st = (volatile LAS unsigned*)(ldsl + LDS_MISC) + 8; xcd_barrier(xb_); } while (0)
#ifndef EPI_ALIGN_PD1
#define EPI_ALIGN_PD1 true
#endif
#ifndef EPI_ALIGN_PA2
#define EPI_ALIGN_PA2 true
#endif
#ifndef REPEAT_PH
#define REPEAT_PH 0
#endif
#ifndef PH_MASK
#define PH_MASK 0xFFFF
#endif
#ifndef MIX_MASK
#define MIX_MASK 7
#endif
#define IN(k) true
#define EN(b) ((PH_MASK >> (b)) & 1)
#ifdef NO_CG_SYNC
#define SEAM(k) do { if (IN(k) && IN((k) + 1)) { GRID_BAR(); } } while (0)
#else
#define SEAM(k) do { if (IN(k) && IN((k) + 1)) { if ((k) == 0) grid.sync(); else GRID_BAR(); } } while (0)
#endif
#define WSP(type, off) ((type*)(ws + (off)))

    if (EN(0) && IN(0)) { PHASE_VARS;
        convert_weights(0, lds, gw, NGW, wave, lane);
        KArgs kp = kargs(); unsigned char* ws = kp->ws; const int* positions = kp->positions; const float* x = kp->x; const float* g = kp->norm_pre;
        f32x2* ROPE = WSP(f32x2, WS_ROPE); bf16_t* HB = WSP(bf16_t, WS_HB);
        for (int i = bx * NTHREADS + tid; i < T * 16; i += G * NTHREADS) {
            const int t = i >> 4, j = i & 15; const float inv = exp2f(-(float)j * (13.287712379549449f / 16.0f));
            const float ang = (float)positions[t] * inv; const float k = rintf(ang * 0.15915494309189535f);
            float r = fmaf(-k, 6.2831854820251465f, ang); r = fmaf(-k, -1.7484555314695172e-7f, r);
            ROPE[i] = (f32x2){__cosf(r), __sinf(r)};
        }
        for (int m = gw; m < T; m += 4 * NGW) hb_rows4(x, g, HB, m, NGW, lane);
    }
    SEAM(0);
#ifdef EXTRA_SYNCS
    for (int i = 0; i < EXTRA_SYNCS; ++i) GRID_BAR();
#endif

    for (int l = 0; l < DEPTH; ++l) {
        const int P0 = 1 + l * PH_PER_LAYER;
        for (int rp = 0; rp < ((REPEAT_PH == 1) ? 2 : 1); ++rp) { if (rp) GRID_BAR();
        if (EN(1) && IN(P0 + 0)) {
            unsigned char* ws = kargs()->ws;
            pg8::PlainOrder S{(const char*)WSP(bf16_t, WS_HB), (const char*)WSP(bf16_t, WS_WIN), 1024, 1024, T / 256, NA / 256, G, bx, 0};
            EpiStore E{WSP(bf16_t, WS_PA), NA, ldsl};
#ifdef STAGGER_US
            if (bx >= 128) { const unsigned long long t0_ = __builtin_amdgcn_s_memrealtime(); while (__builtin_amdgcn_s_memrealtime() - t0_ < (unsigned long long)(STAGGER_US * 100)) __builtin_amdgcn_s_sleep(8); }
#endif
            pg8::gemm_phase<EpiStore, pg8::PlainOrder, true>(ldsl, pg8::Gemm{1024, 1024, 1024}, S, E);
#ifdef PROBE_PA1NULL
#endif
        }
        }
        SEAM(P0 + 0);
        if (EN(2) && IN(P0 + 1)) { PHASE_VARS;
            if (bx >= RWKV_BLOCKS) {
                unsigned char* ws = kargs()->ws; const int c2 = bx - RWKV_BLOCKS;
                { const bf16_t* PA = WSP(bf16_t, WS_PA); const f32x2* ROPE = WSP(f32x2, WS_ROPE); float* RSTDQ = WSP(float, WS_RSTD); float* RSTDKV = RSTDQ + T; bf16_t* Kb = WSP(bf16_t, WS_K);
                  for (int m = c2 * NWAVES + wave; m < T; m += 4 * SUB_BLOCKS * NWAVES) mla_prep_rows4(PA, ROPE, RSTDQ, RSTDKV, Kb, m, SUB_BLOCKS * NWAVES, lane); }
                sub_barrier((unsigned*)(ws + WS_CTL) + 64 * 40, (unsigned)SUB_BLOCKS * (unsigned)(2 * l + 1));
                { pg8::PlainOrder S{(const char*)(WSP(bf16_t, WS_PA) + CQ), (const char*)WSP(bf16_t, WS_WUQ), NA, 256, T / 256, 3, SUB_BLOCKS, c2, 0};
                  EpiQ E{WSP(bf16_t, WS_Q), WSP(float, WS_RSTD), ldsl};
                  pg8::gemm_phase<EpiQ, pg8::PlainOrder, true>(ldsl, pg8::Gemm{NA, 256, 256}, S, E); }
                { pg8::PlainOrder S{(const char*)(WSP(bf16_t, WS_PA) + CKV), (const char*)WSP(bf16_t, WS_WUKV), NA, 256, T / 256, 4, SUB_BLOCKS, c2, 0};
                  EpiKV E{WSP(bf16_t, WS_K), WSP(bf16_t, WS_V), WSP(float, WS_RSTD) + T, ldsl};
                  pg8::gemm_phase<EpiKV, pg8::PlainOrder, true>(ldsl, pg8::Gemm{NA, 256, 256}, S, E); }
                sub_barrier((unsigned*)(kargs()->ws + WS_CTL) + 64 * 40, (unsigned)SUB_BLOCKS * (unsigned)(2 * l + 2));
            } else {
#ifdef RWKV_TWICE
#pragma unroll 1
                for (int rep_ = 0; rep_ < RWKV_TWICE; ++rep_) { rwkv::rwkv_unit(l, bx >> 3, bx & 7, ldsl); __syncthreads(); }
#else
                rwkv::rwkv_unit(l, bx >> 3, bx & 7, ldsl);
#endif
                if (threadIdx.x == 0) { unsigned* cnt = (unsigned*)(kargs()->ws + WS_CTL) + 64 * 40; unsigned sp = 0;
                    while (__hip_atomic_load(cnt, __ATOMIC_RELAXED, __HIP_MEMORY_SCOPE_AGENT) < (unsigned)SUB_BLOCKS * (unsigned)(2 * l + 2) && ++sp < (1u << 24)) __builtin_amdgcn_s_sleep(2);
                    __builtin_amdgcn_fence(__ATOMIC_ACQUIRE, "agent"); asm volatile("s_waitcnt vmcnt(0)" ::: "memory"); }
                __syncthreads();
            }
        }
        if (EN(4) && IN(P0 + 3)) { PHASE_VARS;
            volatile LAS unsigned* qw = (volatile LAS unsigned*)(ldsl + LDS_MISC);
            for (;;) {
                __syncthreads();
                if (tid == 0) { unsigned* CTL = (unsigned*)(kargs()->ws + WS_CTL); qw[0] = atomicAdd(CTL + 64 * (1 + l), 1u); }
                __syncthreads();
                const int it = __builtin_amdgcn_readfirstlane((int)qw[0]);
                if (it >= N_MIX_ITEMS) break;
                if (it < 32) gla::gla_unit(l, it >> 2, it & 3, ldsl, (unsigned*)(kargs()->ws + WS_CTL) + 64 * (24 + l));
                else { const int a = it - 32; att::attn_unit((a & 63) >> 3, a & 7, (SEQ / 512 - 1) - (a >> 6), ldsl, (unsigned*)(kargs()->ws + WS_CTL) + 64 * (16 + l)); }
            }
            { unsigned* ctl = (unsigned*)(kargs()->ws + WS_CTL);
              __syncthreads();
              if (tid == 0) { const unsigned tk = __hip_atomic_fetch_add(ctl + 64 * (20 + l), 1u, __ATOMIC_RELAXED, __HIP_MEMORY_SCOPE_AGENT); qw[0] = tk;
                  if (tk < (unsigned)MG_BLOCKS) { unsigned sp = 0; while (__hip_atomic_load(ctl + 64 * (16 + l), __ATOMIC_RELAXED, __HIP_MEMORY_SCOPE_AGENT) < (unsigned)N_ATT_UNITS && ++sp < (1u << 22)) __builtin_amdgcn_s_sleep(8); }
                  __builtin_amdgcn_fence(__ATOMIC_ACQUIRE, "agent"); asm volatile("s_waitcnt vmcnt(0)" ::: "memory"); }
              __syncthreads();
              const int tk = __builtin_amdgcn_readfirstlane((int)qw[0]);
              if (tk < MG_BLOCKS) {
                  unsigned char* ws = kargs()->ws;
                  pg8::PlainOrder S{(const char*)WSP(bf16_t, WS_HB), (const char*)(WSP(bf16_t, WS_WIN) + (size_t)(NA + 1536) * 1024), 1024, 1024, T / 256, 12, MG_BLOCKS, tk, 0};
                  EpiGateMG8 E{WSP(unsigned char, WS_SMG8), ldsl};
                  pg8::gemm_phase<EpiGateMG8, pg8::PlainOrder, true>(ldsl, pg8::Gemm{1024, 1024, 1024}, S, E);
                  __syncthreads();
                  if (tid == 0) { unsigned sp = 0; while (__hip_atomic_load(ctl + 64 * (24 + l), __ATOMIC_RELAXED, __HIP_MEMORY_SCOPE_AGENT) < 32u && ++sp < (1u << 22)) __builtin_amdgcn_s_sleep(8);
                      __builtin_amdgcn_fence(__ATOMIC_ACQUIRE, "agent"); asm volatile("s_waitcnt vmcnt(0)" ::: "memory"); }
                  __syncthreads();
                  pg8::PlainOrder S2{(const char*)WSP(bf16_t, WS_HB), (const char*)(WSP(bf16_t, WS_WIN) + (size_t)NA * 1024), 1024, 1024, T / 256, 4, MG_BLOCKS, tk, 2};
                  EpiGateBG E2{WSP(bf16_t, WS_YS), 0, 2, ldsl};
                  pg8::gemm_phase<EpiGateBG, pg8::PlainOrder, true>(ldsl, pg8::Gemm{1024, 1024, 1024}, S2, E2);
              } }
        }
        SEAM(P0 + 3);
        if (EN(5) && IN(P0 + 4)) {
            unsigned char* ws = kargs()->ws;
            pg8::PlainOrder S{(const char*)WSP(bf16_t, WS_HB), (const char*)(WSP(bf16_t, WS_WIN) + (size_t)(NA + 512) * 1024), 1024, 1024, T / 256, 2, G, bx, 0};
            EpiGateBG E{WSP(bf16_t, WS_YS), 2, 0, ldsl};
            pg8::gemm_phase<EpiGateBG, pg8::PlainOrder, true>(ldsl, pg8::Gemm{1024, 1024, 1024}, S, E);
        }
        SEAM(P0 + 4);
        for (int rp = 0; rp < ((REPEAT_PH == 6 && l == 0) ? 2 : 1); ++rp) { if (rp) GRID_BAR();
        if (EN(6) && IN(P0 + 5)) {
            unsigned char* ws = kargs()->ws;
            pg8::GroupOrder3 S{(const char*)WSP(bf16_t, WS_YS), (const char*)WSP(bf16_t, WS_WBO), 512, 512, T / 256, 4, G, bx, (size_t)T * 512 * 2, (size_t)1024 * 512 * 2};
            EpiMerge E{WSP(bf16_t, WS_MG), WSP(unsigned char, WS_SMG8), ldsl};
            pg8::gemm_phase<EpiMerge, pg8::GroupOrder3, EPI_ALIGN_PD1>(ldsl, pg8::Gemm{512, 512, 512}, S, E);
        }
        }
        SEAM(P0 + 5);
        for (int rp = 0; rp < ((REPEAT_PH == 7 && l == 0) ? 2 : 1); ++rp) { if (rp) GRID_BAR();
        if (EN(7) && IN(P0 + 6)) {
            unsigned char* ws = kargs()->ws;
            pg8::PlainOrder S{(const char*)WSP(bf16_t, WS_MG), (const char*)WSP(bf16_t, WS_WOUT), 1024, 1024, T / 256, 4, G, bx, 0};
            EpiStore E{WSP(bf16_t, WS_OF), 1024, ldsl};
            pg8::gemm_phase<EpiStore, pg8::PlainOrder, true>(ldsl, pg8::Gemm{1024, 1024, 1024}, S, E);
        }
        }
        SEAM(P0 + 6);
        if (EN(8) && IN(P0 + 7)) { PHASE_VARS;
            const bool more = (l + 1 < DEPTH);
            if (more) convert_weights(l + 1, lds, gw, NGW, wave, lane);
            KArgs kp = kargs(); unsigned char* ws = kp->ws; float* out = kp->out; const float* xold = (l == 0) ? kp->x : out; const float* gpost = kp->norm_post + l * DM; const float* gnext = more ? kp->norm_pre + (l + 1) * DM : nullptr;
            const bf16_t* OF = WSP(bf16_t, WS_OF); bf16_t* HB = WSP(bf16_t, WS_HB);
#define PD3_LOOP(XI, XO) for (int m = gw; m < T; m += 4 * NGW) { RowIn<XI> rr_[4];     \
                _Pragma("unroll") for (int q_ = 0; q_ < 4; ++q_) final_load<XI>(rr_[q_], OF + (size_t)(m + q_ * NGW) * DM, xold + (size_t)(m + q_ * NGW) * DM, lane); \
                _Pragma("unroll") for (int q_ = 0; q_ < 4; ++q_) final_row<XI, XO>(rr_[q_], gpost, out + (size_t)(m + q_ * NGW) * DM, gnext, HB + (size_t)(m + q_ * NGW) * DM, lane); }
            if (l == 0) { if (more) { PD3_LOOP(false, true) } else { PD3_LOOP(false, false) } }
            else        { if (more) { PD3_LOOP(true, true) } else { PD3_LOOP(true, false) } }
#undef PD3_LOOP
        }
        if (l + 1 < DEPTH) SEAM(P0 + 7);
    }
#undef IN
#undef EN
#undef SEAM
#undef WSP
#undef PHASE_VARS
#undef G
#undef bx
#undef NGW
}

extern "C" void kernel_launch(void* const* d_in, const int* in_sizes, int n_in, void* d_out, int out_size, void* d_ws, size_t ws_size, hipStream_t stream) {
    static int grid = 0;
    if (grid == 0) {
        if (n_in != 24 || in_sizes[0] != T * DM || out_size != T * DM || ws_size < WS_END) {
            fprintf(stderr, "kernel_launch: unexpected shapes (n_in %d, in0 %d, out %d, ws %zu; need ws >= %zu); nothing launched\n", n_in, n_in > 0 ? in_sizes[0] : -1, out_size, ws_size, (size_t)WS_END);
            grid = -1; return; }
        int dev = 0, cus = 0, per_cu = 0;
        (void)hipGetDevice(&dev); (void)hipDeviceGetAttribute(&cus, hipDeviceAttributeMultiprocessorCount, dev);
        if (hipFuncSetAttribute((const void*)hybrid_fwd, hipFuncAttributeMaxDynamicSharedMemorySize, LDS_BYTES) != hipSuccess) { fprintf(stderr, "kernel_launch: hipFuncSetAttribute failed\n"); grid = -1; return; }
        if (hipOccupancyMaxActiveBlocksPerMultiprocessor(&per_cu, (const void*)hybrid_fwd, NTHREADS, LDS_BYTES) != hipSuccess || per_cu < 1) {
            fprintf(stderr, "kernel_launch: occupancy query reports %d blocks per CU\n", per_cu); per_cu = 1; }
        (void)hipGetLastError();
        grid = cus * (per_cu < 1 ? 1 : 1);
        fprintf(stderr, "kernel_launch: grid %d (cus %d, occupancy %d), ws %zu\n", grid, cus, per_cu, ws_size);
    }
    if (grid < 0) return;
    (void)hipMemsetAsync((char*)d_ws + WS_CTL, 0, 65536, stream);
    Params p{};
    p.x = (const float*)d_in[0]; p.positions = (const int*)d_in[1]; p.norm_pre = (const float*)d_in[2]; p.w_in = (const float*)d_in[3]; p.mla_q_norm = (const float*)d_in[4]; p.mla_kv_norm = (const float*)d_in[5];
    p.mla_w_uq = (const float*)d_in[6]; p.mla_w_ukv = (const float*)d_in[7]; p.rwkv_mu = (const float*)d_in[8]; p.rwkv_w0 = (const float*)d_in[9]; p.rwkv_w_up = (const float*)d_in[10]; p.rwkv_a0 = (const float*)d_in[11];
    p.rwkv_a_up = (const float*)d_in[12]; p.rwkv_k_k = (const float*)d_in[13]; p.rwkv_k_a = (const float*)d_in[14]; p.rwkv_r_k = (const float*)d_in[15]; p.rwkv_ln_w = (const float*)d_in[16]; p.rwkv_ln_b = (const float*)d_in[17];
    p.gla_a_up = (const float*)d_in[18]; p.gla_a_b = (const float*)d_in[19]; p.gla_norm = (const float*)d_in[20]; p.w_branch_out = (const float*)d_in[21]; p.w_out = (const float*)d_in[22]; p.norm_post = (const float*)d_in[23];
    p.out = (float*)d_out; p.ws = (unsigned char*)d_ws;
#if MK_MULTI_LAUNCH
    for (int ph = 0; ph < N_PHASES; ++ph) { p.ph_lo = ph; p.ph_hi = ph + 1; void* args[] = {&p};
        hipError_t e = hipLaunchCooperativeKernel((const void*)hybrid_fwd, dim3(grid), dim3(NTHREADS), args, LDS_BYTES, stream);
        if (e != hipSuccess) { fprintf(stderr, "kernel_launch: launch of phase %d failed: %s\n", ph, hipGetErrorString(e)); break; } }
#else
    p.ph_lo = 0; p.ph_hi = N_PHASES; void* args[] = {&p};
    hipError_t e = hipLaunchCooperativeKernel((const void*)hybrid_fwd, dim3(grid), dim3(NTHREADS), args, LDS_BYTES, stream);
    if (e != hipSuccess) fprintf(stderr, "kernel_launch: cooperative launch failed: %s (grid %d)\n", hipGetErrorString(e), grid);
#endif
}
```

```cpp
#include <hip/hip_runtime.h>
#include <hip/hip_cooperative_groups.h>
#include <cstdio>
#include <cstdint>
#include <cmath>
namespace cg = cooperative_groups;
#define U_P2 1
#define U_P5 1
#define U_P7 1
#define V_A 1
#define V_B 1
#define V_V 1
#define NO_CG_SYNC 1
namespace pg8 {
#define PG8_LAS __attribute__((address_space(3)))
typedef unsigned short bf16_t;
typedef short bf16x8 __attribute__((ext_vector_type(8)));
typedef float f32x4 __attribute__((ext_vector_type(4)));
typedef unsigned u32x4 __attribute__((ext_vector_type(4)));
typedef unsigned u32x2 __attribute__((ext_vector_type(2)));
constexpr int BM = 256, BK = 64, HALF = 128, HTB = HALF * BK * 2  , STAGE_BYTES = 8 * HTB, NXCD = 8, WGM = 8;

__host__ __device__ __forceinline__ int lds_byte(int r, int c) { const int st = (r >> 4) * 2 + (c >> 5), rr = r & 15, cc = c & 31, ob = rr * 64 + cc * 2; return st * 1024 + (ob ^ (((ob >> 9) & 1) << 5)); }
__host__ __device__ __forceinline__ void stage_rc(int b, int& R, int& C) { const int st = b / 1024, sb = b % 1024, swz = sb ^ (((sb >> 9) & 1) << 5); R = (st >> 1) * 16 + swz / 64; C = (st & 1) * 32 + (swz % 64) / 2; }
__host__ __device__ __forceinline__ int perm32(int rho) { const int n = rho >> 4, i = rho & 15; return 8 * (i >> 2) + 4 * n + (i & 3); }

struct Unit { int pm, pn, aux; const char* A; const char* B; };
struct Gemm { int lda, ldb, K; };

__device__ __forceinline__ void tile_of(int L, int nM, int nN, int& pm, int& pn) {
    const int nwg = nM * nN; int wgid = L;
    { const int q = nwg / NXCD, r = nwg % NXCD, xcd = wgid % NXCD, off = wgid / NXCD; wgid = (xcd < r ? xcd * (q + 1) : r * (q + 1) + (xcd - r) * q) + off; }
    const int nig = WGM * nN, gid = wgid / nig, fm = gid * WGM, gsz = (nM - fm) < WGM ? (nM - fm) : WGM;
    pm = fm + ((wgid % nig) % gsz); pn = (wgid % nig) / gsz;
}
struct PlainOrder {
    const char* A; const char* Bt; int lda, ldb, nM, nN, G, c, bskip;
    int base = 0, cnt = -1;
    int bth = 2;
    __device__ __forceinline__ bool next(int i, Unit& u) const {
        const long Lr = (long)i * G + c; if (Lr >= (long)(cnt >= 0 ? cnt : nM * nN)) return false;
        const long L = Lr + base;
        tile_of((int)L, nM, nN, u.pm, u.pn); u.aux = 0;
        u.A = A + (size_t)u.pm * BM * lda * 2; u.B = Bt + (size_t)(u.pn + ((u.pn >= bth) ? bskip : 0)) * BM * ldb * 2; return true;
    }
};
struct GroupOrder3 {
    const char* A; const char* Bt; int lda, ldb, nM, nN, G, c; size_t a_gstride, b_gstride;
    __device__ __forceinline__ bool next(int i, Unit& u) const {
        const int n = i % 3; const long L = (long)(i / 3) * G + c; if (L >= (long)nM * nN) return false;
        tile_of((int)L, nM, nN, u.pm, u.pn); u.aux = n;
        u.A = A + n * a_gstride + (size_t)u.pm * BM * lda * 2; u.B = Bt + n * b_gstride + (size_t)u.pn * BM * ldb * 2; return true;
    }
};

template <class Epi, class Sched, bool ALIGN_EPI>
__device__ __forceinline__ void gemm_phase(PG8_LAS unsigned char* lds, const Gemm g, const Sched& S, const Epi& E) {
    int tid_ = threadIdx.x; asm volatile("" : "+v"(tid_));
    const int tid = tid_, wid = __builtin_amdgcn_readfirstlane(tid >> 6), lane = tid & 63, wr = wid >> 2, wc = wid & 3, fr = lane & 15, fq = lane >> 4;
    const int K = g.K, nt = K / BK;
    unsigned voffA[2], voffB[2];
#pragma unroll
    for (int i = 0; i < 2; ++i) { int R, C; stage_rc(tid * 16 + i * 8192, R, C); const int Rb = (int)Epi::PERM == 2 ? (64 * (R >> 5) + perm32(R & 31)) : (int)Epi::PERM == 1 ? ((R & ~31) + perm32(R & 31)) : R;
        voffA[i] = (unsigned)(R * g.lda + C) * 2u; voffB[i] = (unsigned)(Rb * g.ldb + C) * 2u; }
    const size_t kstep = (size_t)(BK * 2);
    const size_t hstepA = (size_t)HALF * g.lda * 2, hstepB = (size_t)((int)Epi::PERM == 2 ? 32 : HALF) * g.ldb * 2;
    const unsigned ldsw = (unsigned)wid * 1024u;
    const int aoff = lds_byte(wr * 64 + fr, fq * 8), boff = lds_byte(wc * 32 + fr, fq * 8);
#define PG8_SA(b, h) (((b) * 2 + (h)) * HTB)
#define PG8_SB(b, h) ((4 + (b) * 2 + (h)) * HTB)
#define PG8_STAGE(bufoff, gbase, voff) do { _Pragma("unroll") for (int _i = 0; _i < 2; ++_i) \
        __builtin_amdgcn_global_load_lds((const unsigned*)((const char*)(gbase) + (voff)[_i]), (PG8_LAS unsigned*)(lds + (bufoff) + ldsw + _i * 8192), 16, 0, 0); } while (0)
#define PG8_LDA(dst, b, h) do { _Pragma("unroll") for (int m = 0; m < 4; ++m) _Pragma("unroll") for (int k = 0; k < 2; ++k) dst[m][k] = *(const PG8_LAS bf16x8*)(lds + PG8_SA(b, h) + aoff + m * 2048 + k * 1024); } while (0)
#define PG8_LDB(dst, b, h) do { _Pragma("unroll") for (int n = 0; n < 2; ++n) _Pragma("unroll") for (int k = 0; k < 2; ++k) dst[n][k] = *(const PG8_LAS bf16x8*)(lds + PG8_SB(b, h) + boff + n * 2048 + k * 1024); } while (0)
#define PG8_MMA(ai, bj, At, Bt) do { __builtin_amdgcn_s_setprio(1); _Pragma("unroll") for (int m = 0; m < 4; ++m) _Pragma("unroll") for (int n = 0; n < 2; ++n) _Pragma("unroll") for (int k = 0; k < 2; ++k) \
        acc[ai][bj][m][n] = __builtin_amdgcn_mfma_f32_16x16x32_bf16(Bt[n][k], At[m][k], acc[ai][bj][m][n], 0, 0, 0); __builtin_amdgcn_s_setprio(0); } while (0)
#define PG8_WAIT_V(n) asm volatile("s_waitcnt vmcnt(" #n ")" ::: "memory")
#define PG8_WAIT_L(n) asm volatile("s_waitcnt lgkmcnt(" #n ")" ::: "memory")
#define PG8_BAR __builtin_amdgcn_s_barrier()
#define PG8_SCHED __builtin_amdgcn_sched_barrier(0)
    Unit cur, nxt; int ui = 0;
    if (!S.next(0, cur)) return;
    f32x4 acc[2][2][4][2];
#pragma unroll
    for (int a = 0; a < 2; ++a)
#pragma unroll
        for (int b = 0; b < 2; ++b)
#pragma unroll
            for (int m = 0; m < 4; ++m)
#pragma unroll
                for (int n = 0; n < 2; ++n) acc[a][b][m][n] = (f32x4){0.f, 0.f, 0.f, 0.f};
    bf16x8 At[4][2], B0[2][2], B1[2][2];
    const char* cA = cur.A; const char* cB = cur.B;
    PG8_STAGE(PG8_SB(0, 0), cB, voffB); PG8_STAGE(PG8_SB(0, 1), cB + hstepB, voffB); PG8_STAGE(PG8_SA(0, 0), cA, voffA); PG8_STAGE(PG8_SA(0, 1), cA + hstepA, voffA);
    if (wr == 1) PG8_BAR;
    PG8_WAIT_V(2); PG8_BAR;
    PG8_STAGE(PG8_SB(1, 0), cB + kstep, voffB); PG8_STAGE(PG8_SA(1, 0), cA + kstep, voffA); PG8_STAGE(PG8_SB(1, 1), cB + hstepB + kstep, voffB);
    PG8_WAIT_V(6); PG8_BAR;
    for (;;) {
        const bool has_next = S.next(ui + 1, nxt);
        const char* nA = has_next ? nxt.A : cA; const char* nB = has_next ? nxt.B : cB;
#pragma unroll 1
        for (int t = 0; t < nt; t += 2) {
            const bool last = (t == nt - 2);
            const char* a1 = cA + (size_t)(t + 1) * kstep;
            const char* a2 = last ? nA : cA + (size_t)(t + 2) * kstep; const char* b2 = last ? nB : cB + (size_t)(t + 2) * kstep;
            const char* a3 = a2 + kstep; const char* b3 = b2 + kstep;
            PG8_LDB(B0, 0, 0); PG8_LDB(B1, 0, 1); PG8_SCHED; PG8_LDA(At, 0, 0); PG8_STAGE(PG8_SA(1, 1), a1 + hstepA, voffA);
            PG8_WAIT_V(8); PG8_WAIT_L(0); PG8_BAR; PG8_MMA(0, 0, At, B0); PG8_MMA(0, 1, At, B1); PG8_BAR; PG8_SCHED;
            PG8_LDA(At, 0, 1); PG8_STAGE(PG8_SB(0, 0), b2, voffB); PG8_STAGE(PG8_SB(0, 1), b2 + hstepB, voffB); PG8_STAGE(PG8_SA(0, 0), a2, voffA);
            PG8_WAIT_V(8); PG8_WAIT_L(0); PG8_BAR; PG8_MMA(1, 0, At, B0); PG8_MMA(1, 1, At, B1); PG8_BAR; PG8_SCHED;
            PG8_LDB(B0, 1, 0); PG8_LDB(B1, 1, 1); PG8_SCHED; PG8_LDA(At, 1, 0); PG8_STAGE(PG8_SA(0, 1), a2 + hstepA, voffA);
            PG8_WAIT_V(8); PG8_WAIT_L(0); PG8_BAR; PG8_MMA(0, 0, At, B0); PG8_MMA(0, 1, At, B1); PG8_BAR; PG8_SCHED;
            PG8_LDA(At, 1, 1); PG8_STAGE(PG8_SB(1, 0), b3, voffB); PG8_STAGE(PG8_SB(1, 1), b3 + hstepB, voffB); PG8_STAGE(PG8_SA(1, 0), a3, voffA);
            PG8_WAIT_V(8); PG8_WAIT_L(0); PG8_BAR; PG8_MMA(1, 0, At, B0); PG8_MMA(1, 1, At, B1); PG8_BAR; PG8_SCHED;
        }
        if constexpr (ALIGN_EPI) { if (wr == 0) PG8_BAR; }
        E(acc, cur, wr, wc, fr, fq);
        if (!has_next) break;
#pragma unroll
        for (int a = 0; a < 2; ++a)
#pragma unroll
            for (int b = 0; b < 2; ++b)
#pragma unroll
                for (int m = 0; m < 4; ++m)
#pragma unroll
                    for (int n = 0; n < 2; ++n) acc[a][b][m][n] = (f32x4){0.f, 0.f, 0.f, 0.f};
        cur = nxt; cA = nA; cB = nB; ++ui;
        if constexpr (ALIGN_EPI) { if (wr == 1) PG8_BAR; }
    }
    PG8_WAIT_V(0);
    if constexpr (!ALIGN_EPI) { if (wr == 0) PG8_BAR; }
    PG8_BAR;
#undef PG8_SA
#undef PG8_SB
#undef PG8_STAGE
#undef PG8_LDA
#undef PG8_LDB
#undef PG8_MMA
#undef PG8_WAIT_V
#undef PG8_WAIT_L
#undef PG8_BAR
#undef PG8_SCHED
}
}
#define LAS __attribute__((address_space(3)))
typedef unsigned short bf16_t;
typedef short bf16x8 __attribute__((ext_vector_type(8)));
typedef short s16x4 __attribute__((ext_vector_type(4)));
typedef float f32x4 __attribute__((ext_vector_type(4)));
typedef float f32x2 __attribute__((ext_vector_type(2)));
typedef float f32x16 __attribute__((ext_vector_type(16)));
typedef unsigned u32x4 __attribute__((ext_vector_type(4)));
typedef unsigned u32x2 __attribute__((ext_vector_type(2)));
typedef __bf16 bf16x2_t __attribute__((ext_vector_type(2)));

constexpr int BATCH = 8, SEQ = 4096, DM = 1024, T = BATCH * SEQ, DEPTH = 2;
constexpr int N_IN = 7728, NA = 3328, NG = 4608, NALL = NA + NG;
constexpr int CQ = 0, CKV = 256, KROPE = 384, GLAT = 416, RW_R = 512, RW_K = 1024, RW_V = 1536, RW_LW = 2048, RW_LA = 2112, GQ = 2304, GK = 2560, GV = 2816;
constexpr int KP = 544;
constexpr float NORM_EPS = 1e-6f, RWKV_GN_EPS = 64e-5f;
constexpr float QSCALE = 0.10206207261596577f * 1.4426950408889634f;

constexpr size_t MiB = 1u << 20;
constexpr size_t WS_CTL = 0;
constexpr size_t WS_ROPE = 1 * MiB;
constexpr size_t WS_RSTD = 5 * MiB;
constexpr size_t WS_WIN = 6 * MiB;
constexpr size_t WS_WBO = WS_WIN + (size_t)NALL * 1024 * 2;
constexpr size_t WS_WOUT = WS_WBO + 3 * MiB;
constexpr size_t WS_WUQ = WS_WOUT + 2 * MiB;
constexpr size_t WS_WUKV = WS_WUQ + 768 * 256 * 2;
constexpr size_t WS_HB = 28 * MiB;
constexpr size_t WS_PA = 92 * MiB;
constexpr size_t WS_Q = 300 * MiB;
constexpr size_t WS_K = 348 * MiB;
constexpr size_t WS_V = 382 * MiB;
constexpr size_t WS_YS = 414 * MiB;
constexpr size_t WS_SMG8 = WS_Q;
constexpr size_t WS_MG = WS_PA, WS_OF = WS_PA + 64 * MiB;
constexpr size_t WS_END = 510 * MiB;
static_assert(WS_WUKV + 1024 * 256 * 2 <= WS_HB, "weights fit");

__device__ __forceinline__ unsigned pk2(float lo, float hi) { f32x2 v = {lo, hi}; bf16x2_t b = __builtin_convertvector(v, bf16x2_t); return __builtin_bit_cast(unsigned, b); }
__device__ __forceinline__ float bflo(unsigned w) { return __uint_as_float(w << 16); }
__device__ __forceinline__ float bfhi(unsigned w) { return __uint_as_float(w & 0xffff0000u); }
__device__ __forceinline__ float bf2f(bf16_t b) { return __uint_as_float((unsigned)b << 16); }
__device__ __forceinline__ bf16_t f2bf(float f) { return (bf16_t)(pk2(f, 0.f) & 0xffffu); }
__device__ __forceinline__ float wave_sum(float v) {
#pragma unroll
    for (int o = 1; o < 64; o <<= 1) v += __shfl_xor(v, o);
    return v;
}
__device__ __forceinline__ float fast_exp(float x) { return __builtin_amdgcn_exp2f(x * 1.4426950408889634f); }
__device__ __forceinline__ float fast_sigmoid(float x) { return __builtin_amdgcn_rcpf(1.0f + fast_exp(-x)); }
template <int CTRL> __device__ __forceinline__ float dpp_f(float x) { return __int_as_float(__builtin_amdgcn_update_dpp(0, __float_as_int(x), CTRL, 0xf, 0xf, false)); }
__device__ __forceinline__ float sum8(float x) { x += dpp_f<0xB1>(x); x += dpp_f<0x4E>(x); x += dpp_f<0x141>(x); return x; }
__device__ __forceinline__ float sum16(float x) { x += dpp_f<0xB1>(x); x += dpp_f<0x4E>(x); x += dpp_f<0x141>(x); x += dpp_f<0x140>(x); return x; }

struct Params {
    const float* x; const int* positions; const float* norm_pre; const float* w_in; const float* mla_q_norm; const float* mla_kv_norm; const float* mla_w_uq; const float* mla_w_ukv;
    const float* rwkv_mu; const float* rwkv_w0; const float* rwkv_w_up; const float* rwkv_a0; const float* rwkv_a_up; const float* rwkv_k_k; const float* rwkv_k_a; const float* rwkv_r_k;
    const float* rwkv_ln_w; const float* rwkv_ln_b; const float* gla_a_up; const float* gla_a_b; const float* gla_norm; const float* w_branch_out; const float* w_out; const float* norm_post;
    float* out; unsigned char* ws; int ph_lo, ph_hi;
};

typedef const __attribute__((address_space(4))) Params* KArgs;
__device__ __forceinline__ KArgs kargs() { KArgs kp = (KArgs)__builtin_amdgcn_kernarg_segment_ptr(); asm volatile("" : "+s"(kp)); return kp; }

__device__ __forceinline__ Params load_params() { Params p{}; KArgs kp = kargs(); p.x = kp->x; p.positions = kp->positions; p.norm_pre = kp->norm_pre; p.w_in = kp->w_in; p.mla_q_norm = kp->mla_q_norm; p.mla_kv_norm = kp->mla_kv_norm; p.mla_w_uq = kp->mla_w_uq; p.mla_w_ukv = kp->mla_w_ukv; p.rwkv_mu = kp->rwkv_mu; p.rwkv_w0 = kp->rwkv_w0; p.rwkv_w_up = kp->rwkv_w_up; p.rwkv_a0 = kp->rwkv_a0; p.rwkv_a_up = kp->rwkv_a_up; p.rwkv_k_k = kp->rwkv_k_k; p.rwkv_k_a = kp->rwkv_k_a; p.rwkv_r_k = kp->rwkv_r_k; p.rwkv_ln_w = kp->rwkv_ln_w; p.rwkv_ln_b = kp->rwkv_ln_b; p.gla_a_up = kp->gla_a_up; p.gla_a_b = kp->gla_a_b; p.gla_norm = kp->gla_norm; p.w_branch_out = kp->w_branch_out; p.w_out = kp->w_out; p.norm_post = kp->norm_post; p.out = kp->out; p.ws = kp->ws; p.ph_lo = kp->ph_lo; p.ph_hi = kp->ph_hi; return p; }
__device__ __forceinline__ int opaque_tid() { int t = threadIdx.x; asm volatile("" : "+v"(t)); return t; }

using pg8::Unit;
constexpr int EPI_SCR = 131072, EPI_SCR_WAVE = 2304, EPI_PITCH = 144;
struct EpiGeo { LAS unsigned char* wp; const LAS unsigned char* rp; int r8, p8; };
__device__ __forceinline__ EpiGeo epi_geo(LAS unsigned char* lds, int wr, int wc, int fr, int fq) {
    LAS unsigned char* scr = lds + EPI_SCR + (wr * 4 + wc) * EPI_SCR_WAVE; const int lane = fq * 16 + fr;
    return EpiGeo{scr + fr * EPI_PITCH + fq * 16, scr + (lane >> 3) * EPI_PITCH + (lane & 7) * 16, lane >> 3, lane & 7};
}
__device__ __forceinline__ void epi_xpose(const EpiGeo& g, const u32x4 w0, const u32x4 w1, u32x4& r0, u32x4& r1) {
    *(LAS u32x4*)g.wp = w0; *(LAS u32x4*)(g.wp + 64) = w1;
    asm volatile("" ::: "memory");
    r0 = *(const LAS u32x4*)g.rp; r1 = *(const LAS u32x4*)(g.rp + 8 * EPI_PITCH);
    asm volatile("" ::: "memory");
}
__device__ __forceinline__ u32x4 pack8(const f32x4 v0, const f32x4 v1) { u32x4 w; w.x = pk2(v0[0], v0[1]); w.y = pk2(v0[2], v0[3]); w.z = pk2(v1[0], v1[1]); w.w = pk2(v1[2], v1[3]); return w; }
__device__ __forceinline__ f32x4 silu4(const f32x4 a) { f32x4 r; r[0] = fast_sigmoid(a[0]) * a[0]; r[1] = fast_sigmoid(a[1]) * a[1]; r[2] = fast_sigmoid(a[2]) * a[2]; r[3] = fast_sigmoid(a[3]) * a[3]; return r; }
struct EpiStore {
    static constexpr int PERM = 2; bf16_t* O; int ldc; LAS unsigned char* lds; int gt = -1; bf16_t* YG = nullptr;
    __device__ __forceinline__ void operator()(const f32x4 (&acc)[2][2][4][2], const Unit& u, int wr, int wc, int fr, int fq) const {
        const EpiGeo G = epi_geo(lds, wr, wc, fr, fq);
        if (u.pn == gt) {
            bf16_t* gq = YG + (size_t)(u.pm * 256 + wr * 64 + G.r8) * 512 + wc * 64 + G.p8 * 8;
#pragma unroll
            for (int ai = 0; ai < 2; ++ai)
#pragma unroll
                for (int m = 0; m < 4; ++m) { u32x4 r0, r1; epi_xpose(G, pack8(silu4(acc[ai][0][m][0]), silu4(acc[ai][0][m][1])), pack8(silu4(acc[ai][1][m][0]), silu4(acc[ai][1][m][1])), r0, r1);
                    bf16_t* g = gq + (size_t)(ai * 128 + m * 16) * 512;
                    *(u32x4*)g = r0; *(u32x4*)(g + (size_t)8 * 512) = r1; }
            return; }
        bf16_t* gp = O + (size_t)(u.pm * 256 + wr * 64 + G.r8) * ldc + u.pn * 256 + wc * 64 + G.p8 * 8;
#pragma unroll
        for (int ai = 0; ai < 2; ++ai)
#pragma unroll
            for (int m = 0; m < 4; ++m) { u32x4 r0, r1; epi_xpose(G, pack8(acc[ai][0][m][0], acc[ai][0][m][1]), pack8(acc[ai][1][m][0], acc[ai][1][m][1]), r0, r1);
                bf16_t* g = gp + (size_t)(ai * 128 + m * 16) * ldc;
                *(u32x4*)g = r0; *(u32x4*)(g + (size_t)8 * ldc) = r1; }
    }
};
struct EpiQ {
    static constexpr int PERM = 2; bf16_t* Q; const float* rstd; LAS unsigned char* lds;
    __device__ __forceinline__ void operator()(const f32x4 (&acc)[2][2][4][2], const Unit& u, int wr, int wc, int fr, int fq) const {
        const EpiGeo G = epi_geo(lds, wr, wc, fr, fq);
        const int row0 = u.pm * 256 + wr * 64 + fr;
        float rsv[2][4];
#pragma unroll
        for (int ai = 0; ai < 2; ++ai)
#pragma unroll
            for (int m = 0; m < 4; ++m) rsv[ai][m] = rstd[row0 + ai * 128 + m * 16];
        bf16_t* gp = Q + (size_t)(u.pm * 256 + wr * 64 + G.r8) * 768 + u.pn * 256 + wc * 64 + G.p8 * 8;
#pragma unroll
        for (int ai = 0; ai < 2; ++ai)
#pragma unroll
            for (int m = 0; m < 4; ++m) { const float rs = rsv[ai][m] * QSCALE; u32x4 r0, r1;
                epi_xpose(G, pack8(acc[ai][0][m][0] * rs, acc[ai][0][m][1] * rs), pack8(acc[ai][1][m][0] * rs, acc[ai][1][m][1] * rs), r0, r1);
                bf16_t* g = gp + (size_t)(ai * 128 + m * 16) * 768;
                *(u32x4*)g = r0; *(u32x4*)(g + (size_t)8 * 768) = r1; }
    }
};
struct EpiKV {
    static constexpr int PERM = 2; bf16_t* Kb; bf16_t* Vb; const float* rstd; LAS unsigned char* lds;
    __device__ __forceinline__ void operator()(const f32x4 (&acc)[2][2][4][2], const Unit& u, int wr, int wc, int fr, int fq) const {
        const EpiGeo G = epi_geo(lds, wr, wc, fr, fq);
        const int row0 = u.pm * 256 + wr * 64 + fr; const bool isv = u.pn >= 2; const int ldc = isv ? 512 : KP;
        float rsv[2][4];
#pragma unroll
        for (int ai = 0; ai < 2; ++ai)
#pragma unroll
            for (int m = 0; m < 4; ++m) rsv[ai][m] = rstd[row0 + ai * 128 + m * 16];
        bf16_t* gp = (isv ? Vb : Kb) + (size_t)(u.pm * 256 + wr * 64 + G.r8) * ldc + (u.pn & 1) * 256 + wc * 64 + G.p8 * 8;
#pragma unroll
        for (int ai = 0; ai < 2; ++ai)
#pragma unroll
            for (int m = 0; m < 4; ++m) { const float rs = rsv[ai][m]; u32x4 r0, r1;
                epi_xpose(G, pack8(acc[ai][0][m][0] * rs, acc[ai][0][m][1] * rs), pack8(acc[ai][1][m][0] * rs, acc[ai][1][m][1] * rs), r0, r1);
                bf16_t* g = gp + (size_t)(ai * 128 + m * 16) * ldc;
                *(u32x4*)g = r0; *(u32x4*)(g + (size_t)8 * ldc) = r1; }
    }
};
__device__ __forceinline__ unsigned q8(float s) { return (unsigned)(s * 255.0f + 0.5f); }
struct EpiGateBG {
    static constexpr int PERM = 2; bf16_t* YS; int pn0, skip; LAS unsigned char* lds; int th = 2;
    __device__ __forceinline__ void operator()(const f32x4 (&acc)[2][2][4][2], const Unit& u, int wr, int wc, int fr, int fq) const {
        const int pn = pn0 + u.pn + ((u.pn >= th) ? skip : 0);
        const EpiGeo G = epi_geo(lds, wr, wc, fr, fq);
        bf16_t* gp = YS + (size_t)(pn >> 1) * T * 512 + (size_t)(u.pm * 256 + wr * 64 + G.r8) * 512 + (pn & 1) * 256 + wc * 64 + G.p8 * 8;
#pragma unroll
        for (int ai = 0; ai < 2; ++ai) {
            u32x4 y[4][2];
#pragma unroll
            for (int m = 0; m < 4; ++m)
#pragma unroll
                for (int h = 0; h < 2; ++h) y[m][h] = *(const u32x4*)(gp + (size_t)(ai * 128 + m * 16 + 8 * h) * 512);
#pragma unroll
            for (int m = 0; m < 4; ++m) { u32x4 r[2];
                epi_xpose(G, pack8(silu4(acc[ai][0][m][0]), silu4(acc[ai][0][m][1])), pack8(silu4(acc[ai][1][m][0]), silu4(acc[ai][1][m][1])), r[0], r[1]);
#pragma unroll
                for (int h = 0; h < 2; ++h) { const u32x4 yy = y[m][h], gg = r[h];
                    u32x4 w; w.x = pk2(bflo(gg.x) * bflo(yy.x), bfhi(gg.x) * bfhi(yy.x)); w.y = pk2(bflo(gg.y) * bflo(yy.y), bfhi(gg.y) * bfhi(yy.y));
                    w.z = pk2(bflo(gg.z) * bflo(yy.z), bfhi(gg.z) * bfhi(yy.z)); w.w = pk2(bflo(gg.w) * bflo(yy.w), bfhi(gg.w) * bfhi(yy.w));
                    *(u32x4*)(gp + (size_t)(ai * 128 + m * 16 + 8 * h) * 512) = w; } }
        }
    }
};
struct EpiGateMG8 {
    static constexpr int PERM = 2; unsigned char* SMG; LAS unsigned char* lds;
    __device__ __forceinline__ void operator()(const f32x4 (&acc)[2][2][4][2], const Unit& u, int wr, int wc, int fr, int fq) const {
        LAS unsigned char* scr = lds + EPI_SCR + (wr * 4 + wc) * EPI_SCR_WAVE; const int lane = fq * 16 + fr;
        LAS unsigned char* wp = scr + fr * 72 + fq * 8; const LAS unsigned char* rp = scr + (lane >> 2) * 72 + (lane & 3) * 16;
        unsigned char* gp = SMG + (size_t)((u.pm * 256 + wr * 64) >> 1) * 6144 + (size_t)(lane >> 3) * 6144 + (u.pn * 4 + wc) * 128 + ((lane >> 2) & 1) * 64 + (lane & 3) * 16;
#pragma unroll
        for (int ai = 0; ai < 2; ++ai)
#pragma unroll
            for (int m = 0; m < 4; ++m) {
#pragma unroll
                for (int bj = 0; bj < 2; ++bj) { const f32x4 a0 = acc[ai][bj][m][0], a1 = acc[ai][bj][m][1];
                    u32x2 w = {0u, 0u};
#pragma unroll
                    for (int j = 0; j < 4; ++j) { w.x = __builtin_amdgcn_cvt_pk_u8_f32(255.0f * fast_sigmoid(a0[j]), j, w.x); w.y = __builtin_amdgcn_cvt_pk_u8_f32(255.0f * fast_sigmoid(a1[j]), j, w.y); }
                    *(LAS u32x2*)(wp + bj * 32) = w; }
                asm volatile("" ::: "memory");
                const u32x2 ra = *(const LAS u32x2*)rp, rb = *(const LAS u32x2*)(rp + 8);
                asm volatile("" ::: "memory");
                *(u32x4*)(gp + (size_t)(ai * 64 + m * 8) * 6144) = (u32x4){ra.x, ra.y, rb.x, rb.y}; }
    }
};
struct EpiMerge {
    static constexpr int PERM = 2; bf16_t* MG; const unsigned char* SMG; LAS unsigned char* lds;
    __device__ __forceinline__ void operator()(const f32x4 (&acc)[2][2][4][2], const Unit& u, int wr, int wc, int fr, int fq) const {
        const EpiGeo G = epi_geo(lds, wr, wc, fr, fq); const int n = u.aux; constexpr float S = 1.0f / 255.0f;
        const size_t rowb = (size_t)(u.pm * 256 + wr * 64 + G.r8); const int colb = u.pn * 256 + wc * 64 + G.p8 * 8;
        const unsigned char* sp = SMG + (rowb >> 1) * 6144 + (size_t)(n * 16 + u.pn * 4 + wc) * 128 + (rowb & 1) * 64 + G.p8 * 8; bf16_t* mp = MG + rowb * 1024 + colb;
#pragma unroll
        for (int ai = 0; ai < 2; ++ai) {
            u32x2 g[4][2]; u32x4 y[4][2];
#pragma unroll
            for (int m = 0; m < 4; ++m)
#pragma unroll
                for (int h = 0; h < 2; ++h) { g[m][h] = *(const u32x2*)(sp + (size_t)(ai * 64 + m * 8 + 4 * h) * 6144); if (n > 0) y[m][h] = *(const u32x4*)(mp + (size_t)(ai * 128 + m * 16 + 8 * h) * 1024); }
#pragma unroll
            for (int m = 0; m < 4; ++m) { u32x4 r[2];
                epi_xpose(G, pack8(acc[ai][0][m][0], acc[ai][0][m][1]), pack8(acc[ai][1][m][0], acc[ai][1][m][1]), r[0], r[1]);
#pragma unroll
                for (int h = 0; h < 2; ++h) { const u32x2 gg = g[m][h]; const u32x4 aa = r[h];
                    float v[8] = {bflo(aa.x) * (S * (float)(gg.x & 0xffu)), bfhi(aa.x) * (S * (float)((gg.x >> 8) & 0xffu)), bflo(aa.y) * (S * (float)((gg.x >> 16) & 0xffu)), bfhi(aa.y) * (S * (float)(gg.x >> 24)),
                                  bflo(aa.z) * (S * (float)(gg.y & 0xffu)), bfhi(aa.z) * (S * (float)((gg.y >> 8) & 0xffu)), bflo(aa.w) * (S * (float)((gg.y >> 16) & 0xffu)), bfhi(aa.w) * (S * (float)(gg.y >> 24))};
                    if (n > 0) { const u32x4 yy = y[m][h];
                        v[0] += bflo(yy.x); v[1] += bfhi(yy.x); v[2] += bflo(yy.y); v[3] += bfhi(yy.y); v[4] += bflo(yy.z); v[5] += bfhi(yy.z); v[6] += bflo(yy.w); v[7] += bfhi(yy.w); }
                    u32x4 w; w.x = pk2(v[0], v[1]); w.y = pk2(v[2], v[3]); w.z = pk2(v[4], v[5]); w.w = pk2(v[6], v[7]);
                    *(u32x4*)(mp + (size_t)(ai * 128 + m * 16 + 8 * h) * 1024) = w; } }
        }
    }
};
struct EpiF32 {
    static constexpr bool PERM = false; float* O; int ldc;
    __device__ __forceinline__ void operator()(const f32x4 (&acc)[2][2][4][2], const Unit& u, int wr, int wc, int fr, int fq) const {
        const int row0 = u.pm * 256 + wr * 64 + fr, col0 = u.pn * 256 + wc * 32 + 4 * fq;
#pragma unroll
        for (int ai = 0; ai < 2; ++ai)
#pragma unroll
            for (int m = 0; m < 4; ++m) { float* rowp = O + (size_t)(row0 + ai * 128 + m * 16) * ldc + col0;
#pragma unroll
                for (int bj = 0; bj < 2; ++bj)
#pragma unroll
                    for (int n = 0; n < 2; ++n) *(f32x4*)(rowp + bj * 128 + n * 16) = acc[ai][bj][m][n]; }
    }
};

template <class SrcCol>
__device__ __forceinline__ void transpose_item(const float* W, int Ksrc, int Nsrc, bf16_t* WT, int Kdst, int item, int nblk, float* scr, int lane, SrcCol src, const float* kscale) {
    const int kb = item / nblk, nb = item % nblk, k0 = 64 * kb, n0 = 32 * nb;
    const int sc = src(n0 + (lane & 31));
    float vv[32];
#pragma unroll
    for (int i = 0; i < 32; ++i) { const int k = k0 + 2 * i + (lane >> 5); float v = 0.f;
        if (sc >= 0 && k < Ksrc) { v = W[(size_t)k * Nsrc + sc]; if (kscale) v *= kscale[k]; }
        vv[i] = v; }
#pragma unroll
    for (int i = 0; i < 32; ++i) scr[(2 * i + (lane >> 5)) * 33 + (lane & 31)] = vv[i];
    asm volatile("s_waitcnt lgkmcnt(0)" ::: "memory");
    const int c = lane & 7;
#pragma unroll
    for (int j = 0; j < 4; ++j) { const int n = (lane >> 3) + 8 * j; const float* s = scr + (8 * c) * 33 + n;
        u32x4 o; o.x = pk2(s[0 * 33], s[1 * 33]); o.y = pk2(s[2 * 33], s[3 * 33]); o.z = pk2(s[4 * 33], s[5 * 33]); o.w = pk2(s[6 * 33], s[7 * 33]);
        *(u32x4*)(WT + (size_t)(n0 + n) * Kdst + k0 + 8 * c) = o; }
    asm volatile("s_waitcnt lgkmcnt(0)" ::: "memory");
}
__device__ __forceinline__ int win_src(int j) {
    if (j < 416) return j;
    if (j < 432) return 3104 + (j - 416);
    if (j < 512) return -1;
    if (j < 2048) return 416 + (j - 512);
    if (j < 2176) return 1952 + (j - 2048);
    if (j < 2304) return -1;
    if (j < 3328) return 2080 + (j - 2304);
    return 3120 + (j - 3328);
}
__device__ __forceinline__ int wuq_src(int j) { const int h = j / 96, c = j % 96; if (c < 64) return h * 96 + c; const int r = c - 64; return h * 96 + 64 + (r & 1) * 16 + (r >> 1); }
__device__ __forceinline__ int wukv_src(int j) { return j < 512 ? (j >> 6) * 128 + (j & 63) : ((j - 512) >> 6) * 128 + 64 + (j & 63); }

__device__ __forceinline__ void convert_weights(int l, unsigned char* lds, int gw, int NGW, int wave, int lane) {
    float* scr = (float*)(lds + wave * 8448); const Params p = load_params();
    bf16_t* WinT = (bf16_t*)(p.ws + WS_WIN); bf16_t* WboT = (bf16_t*)(p.ws + WS_WBO); bf16_t* WoutT = (bf16_t*)(p.ws + WS_WOUT); bf16_t* WuqT = (bf16_t*)(p.ws + WS_WUQ); bf16_t* WukvT = (bf16_t*)(p.ws + WS_WUKV);
    constexpr int I_IN = 16 * (NALL / 32), I_BO = 8 * 32, I_OUT = 16 * 32, I_UQ = 4 * 24, I_UKV = 4 * 32;
    constexpr int NITEMS = I_IN + 3 * I_BO + I_OUT + I_UQ + I_UKV;
    for (int it = gw; it < NITEMS; it += NGW) {
        int r = it;
        if (r < I_IN) { transpose_item(p.w_in + (size_t)l * 1024 * N_IN, 1024, N_IN, WinT, 1024, r, NALL / 32, scr, lane, [](int j) { return win_src(j); }, nullptr); continue; } r -= I_IN;
        if (r < 3 * I_BO) { const int n = r / I_BO; r -= n * I_BO;
            transpose_item(p.w_branch_out + ((size_t)l * 3 + n) * 512 * 1024, 512, 1024, WboT + (size_t)n * 1024 * 512, 512, r, 32, scr, lane, [](int j) { return j; }, nullptr); continue; } r -= 3 * I_BO;
        if (r < I_OUT) { transpose_item(p.w_out + (size_t)l * 1024 * 1024, 1024, 1024, WoutT, 1024, r, 32, scr, lane, [](int j) { return j; }, nullptr); continue; } r -= I_OUT;
        if (r < I_UQ) { transpose_item(p.mla_w_uq + (size_t)l * 256 * 768, 256, 768, WuqT, 256, r, 24, scr, lane, [](int j) { return wuq_src(j); }, p.mla_q_norm + l * 256); continue; } r -= I_UQ;
        transpose_item(p.mla_w_ukv + (size_t)l * 128 * 1024, 128, 1024, WukvT, 256, r, 32, scr, lane, [](int j) { return wukv_src(j); }, p.mla_kv_norm + l * 128);
    }
}
__device__ __forceinline__ void hb_row(const float* xrow, const float* g, bf16_t* orow, int lane) {
    const f32x4* xr = (const f32x4*)xrow + lane; const f32x4* gr = (const f32x4*)g + lane;
    f32x4 v[4]; float s = 0.f;
#pragma unroll
    for (int j = 0; j < 4; ++j) { v[j] = xr[64 * j]; s += (v[j].x * v[j].x + v[j].y * v[j].y) + (v[j].z * v[j].z + v[j].w * v[j].w); }
    const float rstd = rsqrtf(wave_sum(s) * (1.f / DM) + NORM_EPS);
    u32x2* o8 = (u32x2*)orow + lane;
#pragma unroll
    for (int j = 0; j < 4; ++j) { const f32x4 gg = gr[64 * j]; u32x2 w; w.x = pk2(v[j].x * rstd * gg.x, v[j].y * rstd * gg.y); w.y = pk2(v[j].z * rstd * gg.z, v[j].w * rstd * gg.w); o8[64 * j] = w; }
}
__device__ __forceinline__ void hb_rows4(const float* x, const float* g, bf16_t* HB, int m, int stride, int lane) {
    f32x4 v[4][4];
#pragma unroll
    for (int r = 0; r < 4; ++r) { const f32x4* xr = (const f32x4*)(x + (size_t)(m + r * stride) * DM) + lane;
#pragma unroll
        for (int j = 0; j < 4; ++j) v[r][j] = xr[64 * j]; }
    const f32x4* gr = (const f32x4*)g + lane;
#pragma unroll
    for (int r = 0; r < 4; ++r) { float s = 0.f;
#pragma unroll
        for (int j = 0; j < 4; ++j) s += (v[r][j].x * v[r][j].x + v[r][j].y * v[r][j].y) + (v[r][j].z * v[r][j].z + v[r][j].w * v[r][j].w);
        const float rstd = rsqrtf(wave_sum(s) * (1.f / DM) + NORM_EPS);
        u32x2* o8 = (u32x2*)(HB + (size_t)(m + r * stride) * DM) + lane;
#pragma unroll
        for (int j = 0; j < 4; ++j) { const f32x4 gg = gr[64 * j]; u32x2 w; w.x = pk2(v[r][j].x * rstd * gg.x, v[r][j].y * rstd * gg.y); w.y = pk2(v[r][j].z * rstd * gg.z, v[r][j].w * rstd * gg.w); o8[64 * j] = w; } }
}
template <bool XIN16> struct RowIn { u32x4 oa, ob, xa, xb; f32x4 xv[4]; };
template <bool XIN16> __device__ __forceinline__ void final_load(RowIn<XIN16>& r, const bf16_t* orow, const float* xold, int lane) {
    r.oa = *((const u32x4*)orow + lane); r.ob = *((const u32x4*)orow + 64 + lane);
    if (XIN16) { r.xa = *((const u32x4*)xold + lane); r.xb = *((const u32x4*)xold + 64 + lane); }
    else {
#pragma unroll
        for (int h = 0; h < 2; ++h)
#pragma unroll
            for (int q = 0; q < 2; ++q) r.xv[2 * h + q] = *((const f32x4*)(xold + 512 * h + 8 * lane) + q); }
}
template <bool XIN16, bool XOUT16>
__device__ __forceinline__ void final_row(const RowIn<XIN16>& r, const float* gpost, float* xnew, const float* gnext, bf16_t* hbrow, int lane) {
    float o[16], x[16], g[16];
    { const u32x4 a = r.oa, b = r.ob;
      o[0] = bflo(a.x); o[1] = bfhi(a.x); o[2] = bflo(a.y); o[3] = bfhi(a.y); o[4] = bflo(a.z); o[5] = bfhi(a.z); o[6] = bflo(a.w); o[7] = bfhi(a.w);
      o[8] = bflo(b.x); o[9] = bfhi(b.x); o[10] = bflo(b.y); o[11] = bfhi(b.y); o[12] = bflo(b.z); o[13] = bfhi(b.z); o[14] = bflo(b.w); o[15] = bfhi(b.w); }
    if (XIN16) { const u32x4 a = r.xa, b = r.xb;
      x[0] = bflo(a.x); x[1] = bfhi(a.x); x[2] = bflo(a.y); x[3] = bfhi(a.y); x[4] = bflo(a.z); x[5] = bfhi(a.z); x[6] = bflo(a.w); x[7] = bfhi(a.w);
      x[8] = bflo(b.x); x[9] = bfhi(b.x); x[10] = bflo(b.y); x[11] = bfhi(b.y); x[12] = bflo(b.z); x[13] = bfhi(b.z); x[14] = bflo(b.w); x[15] = bfhi(b.w); }
#pragma unroll
    for (int h = 0; h < 2; ++h)
#pragma unroll
        for (int q = 0; q < 2; ++q) { const f32x4 gv = *((const f32x4*)(gpost + 512 * h + 8 * lane) + q);
            if (!XIN16) {
#pragma unroll
                for (int e = 0; e < 4; ++e) x[8 * h + 4 * q + e] = r.xv[2 * h + q][e]; }
#pragma unroll
            for (int e = 0; e < 4; ++e) g[8 * h + 4 * q + e] = gv[e]; }
    float s = 0.f;
#pragma unroll
    for (int e = 0; e < 16; ++e) s += o[e] * o[e];
    const float rstd = rsqrtf(wave_sum(s) * (1.f / DM) + NORM_EPS);
    float s2 = 0.f;
#pragma unroll
    for (int e = 0; e < 16; ++e) { x[e] += o[e] * rstd * g[e]; s2 += x[e] * x[e]; }
    if (XOUT16) {
#pragma unroll
        for (int h = 0; h < 2; ++h) { u32x4 w; w.x = pk2(x[8 * h], x[8 * h + 1]); w.y = pk2(x[8 * h + 2], x[8 * h + 3]); w.z = pk2(x[8 * h + 4], x[8 * h + 5]); w.w = pk2(x[8 * h + 6], x[8 * h + 7]);
            *((u32x4*)xnew + 64 * h + lane) = w; }
    } else {
#pragma unroll
        for (int h = 0; h < 2; ++h)
#pragma unroll
            for (int q = 0; q < 2; ++q) *((f32x4*)(xnew + 512 * h + 8 * lane) + q) = (f32x4){x[8 * h + 4 * q], x[8 * h + 4 * q + 1], x[8 * h + 4 * q + 2], x[8 * h + 4 * q + 3]};
    }
    if (gnext) { const float rstd2 = rsqrtf(wave_sum(s2) * (1.f / DM) + NORM_EPS);
#pragma unroll
        for (int h = 0; h < 2; ++h) { const f32x4 g0 = *((const f32x4*)(gnext + 512 * h + 8 * lane)), g1 = *((const f32x4*)(gnext + 512 * h + 8 * lane) + 1);
            u32x4 w; w.x = pk2(x[8 * h] * rstd2 * g0[0], x[8 * h + 1] * rstd2 * g0[1]); w.y = pk2(x[8 * h + 2] * rstd2 * g0[2], x[8 * h + 3] * rstd2 * g0[3]);
            w.z = pk2(x[8 * h + 4] * rstd2 * g1[0], x[8 * h + 5] * rstd2 * g1[1]); w.w = pk2(x[8 * h + 6] * rstd2 * g1[2], x[8 * h + 7] * rstd2 * g1[3]);
            *((u32x4*)hbrow + 64 * h + lane) = w; } }
}
__device__ __forceinline__ void mla_prep_row(const bf16_t* prow, const f32x2* rope_t, float* rstdq, float* rstdkv, bf16_t* krow, int lane) {
    const u32x2 a = *((const u32x2*)(prow + CQ) + lane); const unsigned c = *((const unsigned*)(prow + CKV) + lane);
    float sq = bflo(a.x) * bflo(a.x) + bfhi(a.x) * bfhi(a.x) + bflo(a.y) * bflo(a.y) + bfhi(a.y) * bfhi(a.y);
    float sk = bflo(c) * bflo(c) + bfhi(c) * bfhi(c);
    sq = wave_sum(sq); sk = wave_sum(sk);
    if (lane == 0) { *rstdq = rsqrtf(sq * (1.f / 256.f) + NORM_EPS); *rstdkv = rsqrtf(sk * (1.f / 128.f) + NORM_EPS); }
    if (lane < 16) { const float x1 = bf2f(prow[KROPE + lane]), x2 = bf2f(prow[KROPE + 16 + lane]); const f32x2 cs = rope_t[lane];
        *((unsigned*)(krow + 512) + lane) = pk2(x1 * cs.x - x2 * cs.y, x2 * cs.x + x1 * cs.y); }
}

__device__ __forceinline__ void mla_prep_rows4(const bf16_t* PA, const f32x2* ROPE, float* RSTDQ, float* RSTDKV, bf16_t* Kb, int m, int stride, int lane) {
    u32x2 a[4]; unsigned c[4]; float x1[4], x2[4]; f32x2 cs[4];
#pragma unroll
    for (int j = 0; j < 4; ++j) { const int r = (m + j * stride < T) ? m + j * stride : m; const bf16_t* prow = PA + (size_t)r * NA;
        a[j] = *((const u32x2*)(prow + CQ) + lane); c[j] = *((const unsigned*)(prow + CKV) + lane);
        x1[j] = bf2f(prow[KROPE + (lane & 15)]); x2[j] = bf2f(prow[KROPE + 16 + (lane & 15)]); cs[j] = ROPE[(size_t)r * 16 + (lane & 15)]; }
#pragma unroll
    for (int j = 0; j < 4; ++j) { const int r = m + j * stride; if (r < T) {
        float sq = bflo(a[j].x) * bflo(a[j].x) + bfhi(a[j].x) * bfhi(a[j].x) + bflo(a[j].y) * bflo(a[j].y) + bfhi(a[j].y) * bfhi(a[j].y);
        float sk = bflo(c[j]) * bflo(c[j]) + bfhi(c[j]) * bfhi(c[j]);
        sq = wave_sum(sq); sk = wave_sum(sk);
        if (lane == 0) { RSTDQ[r] = rsqrtf(sq * (1.f / 256.f) + NORM_EPS); RSTDKV[r] = rsqrtf(sk * (1.f / 128.f) + NORM_EPS); }
        if (lane < 16) *((unsigned*)(Kb + (size_t)r * KP + 512) + lane) = pk2(x1[j] * cs[j].x - x2[j] * cs[j].y, x2[j] * cs[j].x + x1[j] * cs[j].y); } }
}

#ifdef BANDSKIP
namespace att {
constexpr int KSLOT = 12288, VSLOT = 8192, BUFB = KSLOT + VSLOT, L_WS = 2 * BUFB, L_OST = L_WS + 8 * 128 * 4, L_END = L_OST + 8 * 4096;
constexpr int UNIT_ROWS = 512;
__device__ __forceinline__ int crow(int r, int hi) { return (r & 3) + 8 * (r >> 2) + 4 * hi; }
__device__ __forceinline__ s16x4 vtr(const LAS unsigned char* p) { return __builtin_bit_cast(s16x4, __builtin_amdgcn_ds_read_tr16_b64_v4i16((LAS s16x4*)p)); }
__device__ __forceinline__ void load_q(bf16x8 (&qr)[6], const bf16_t* Q, const f32x2* rope, size_t row, int h, int hi) {
    const bf16_t* Qw = Q + row * 768 + h * 96 + hi * 8;
#pragma unroll
    for (int s = 0; s < 6; ++s) qr[s] = *(const bf16x8*)(Qw + s * 16);
    const f32x4* rp = (const f32x4*)(rope + row * 16 + 4 * hi);
#pragma unroll
    for (int s = 4; s < 6; ++s) { const f32x4 c01 = rp[(s - 4) * 4], c23 = rp[(s - 4) * 4 + 1]; const u32x4 w = __builtin_bit_cast(u32x4, qr[s]); u32x4 o;
        { const float e = bflo(w.x), d = bfhi(w.x); o.x = pk2(e * c01[0] - d * c01[1], d * c01[0] + e * c01[1]); }
        { const float e = bflo(w.y), d = bfhi(w.y); o.y = pk2(e * c01[2] - d * c01[3], d * c01[2] + e * c01[3]); }
        { const float e = bflo(w.z), d = bfhi(w.z); o.z = pk2(e * c23[0] - d * c23[1], d * c23[0] + e * c23[1]); }
        { const float e = bflo(w.w), d = bfhi(w.w); o.w = pk2(e * c23[2] - d * c23[3], d * c23[2] + e * c23[3]); }
        qr[s] = __builtin_bit_cast(bf16x8, o); }
}
__device__ __forceinline__ void softmax_half(f32x16& p0, f32x16& p1, f32x16& o0, f32x16& o1, float& mrun, float& lrun, bf16x8 (&pa)[4],
                                             bool first, bool band, int kb0, int qrel, int r32, int hi, LAS float* wsf) {
    if (band) {
#pragma unroll
        for (int r = 0; r < 16; ++r) { const int kv = kb0 + (r & 3) + 8 * (r >> 2); if (kv > qrel) p0[r] = -INFINITY; if (kv + 32 > qrel) p1[r] = -INFINITY; } }
    float mx = fmaxf(p0[0], p1[0]);
#pragma unroll
    for (int r = 1; r < 16; ++r) mx = fmaxf(mx, fmaxf(p0[r], p1[r]));
    mx = fmaxf(mx, __shfl_xor(mx, 32));
    if (first || __any(mx > 8.0f)) {
        const float dl = first ? mx : fmaxf(mx, 0.f); mrun += dl;
#pragma unroll
        for (int r = 0; r < 16; ++r) { p0[r] -= dl; p1[r] -= dl; }
        const float alpha = __builtin_amdgcn_exp2f(-dl); lrun *= alpha;
        if (hi == 0) wsf[r32] = alpha;
#pragma unroll
        for (int r = 0; r < 16; ++r) { const float a = wsf[crow(r, hi)]; o0[r] *= a; o1[r] *= a; }
    }
    float ls = 0.f;
#pragma unroll
    for (int r = 0; r < 16; ++r) { p0[r] = __builtin_amdgcn_exp2f(p0[r]); p1[r] = __builtin_amdgcn_exp2f(p1[r]); ls += p0[r] + p1[r]; }
    lrun += ls;
#pragma unroll
    for (int s = 0; s < 4; ++s) { const int bb = 8 * (s & 1); u32x4 w;
        if (s < 2) { w.x = pk2(p0[bb], p0[bb + 1]); w.y = pk2(p0[bb + 2], p0[bb + 3]); w.z = pk2(p0[bb + 4], p0[bb + 5]); w.w = pk2(p0[bb + 6], p0[bb + 7]); }
        else { w.x = pk2(p1[bb], p1[bb + 1]); w.y = pk2(p1[bb + 2], p1[bb + 3]); w.z = pk2(p1[bb + 4], p1[bb + 5]); w.w = pk2(p1[bb + 6], p1[bb + 7]); }
        pa[s] = __builtin_bit_cast(bf16x8, w); }
}
__device__ __forceinline__ void attn_unit(int b, int h, int qb, LAS unsigned char* lds, unsigned* done_ctr) {
    KArgs kp = kargs(); unsigned char* ws_ = kp->ws;
    const bf16_t* Q = (const bf16_t*)(ws_ + WS_Q); const bf16_t* Kg = (const bf16_t*)(ws_ + WS_K); const bf16_t* Vg = (const bf16_t*)(ws_ + WS_V); bf16_t* O = (bf16_t*)(ws_ + WS_YS);
    const int tid = opaque_tid(), lane = tid & 63, r32 = lane & 31, hi = lane >> 5; const int wid = __builtin_amdgcn_readfirstlane(tid >> 6);
    const size_t rowbase = (size_t)b * SEQ; const int q0 = qb * UNIT_ROWS;
    bf16x8 qa[6], qb_[6];
    const int rba = 32 * wid, rbb = 32 * (15 - wid);
    load_q(qa, Q, (const f32x2*)(ws_ + WS_ROPE), rowbase + q0 + rba + r32, h, hi);
    load_q(qb_, Q, (const f32x2*)(ws_ + WS_ROPE), rowbase + q0 + rbb + r32, h, hi);
    const char* kbase0 = (const char*)(Kg + rowbase * KP + h * 64); const char* kbase1 = (const char*)(Kg + rowbase * KP + 512);
    const char* vbase = (const char*)(Vg + rowbase * 512 + h * 64);
    const unsigned kof = (unsigned)(((tid & 63) * KP + (tid >> 6) * 8) * 2), vof = (unsigned)((((tid & 255) >> 2) * 512 + (tid >> 8) * 32 + (tid & 3) * 8) * 2);
    const int NT = (q0 + UNIT_ROWS) / 64;
    LAS float* wsf = (LAS float*)(lds + L_WS) + wid * 128;
    u32x4 sk0, sk1, sv;
    sk0 = *(const u32x4*)(kbase0 + kof); if (tid < 256) sk1 = *(const u32x4*)(kbase1 + kof); sv = *(const u32x4*)(vbase + vof);
    *(LAS u32x4*)(lds + tid * 16) = sk0; if (tid < 256) *(LAS u32x4*)(lds + (tid + 512) * 16) = sk1; *(LAS u32x4*)(lds + KSLOT + tid * 16) = sv;
    __syncthreads();
    f32x16 oa0 = {}, oa1 = {}, ob0 = {}, ob1 = {}; float ma = 0.f, la = 0.f, mb = 0.f, lb = 0.f;
    const int qra = rba + r32, qrb = rbb + r32;
    const int tlastA = NT - 8 + ((rba + 31) >> 6), tlastB = NT - 8 + ((rbb + 31) >> 6);
    for (int t = 0; t < NT; ++t) {
        int tidv = tid; asm volatile("" : "+v"(tidv));
        const int lanev = tidv & 63, r32v = lanev & 31, hiv = lanev >> 5;
        const unsigned kofv = (unsigned)(((tidv & 63) * KP + (tidv >> 6) * 8) * 2), vofv = (unsigned)((((tidv & 255) >> 2) * 512 + (tidv >> 8) * 32 + (tidv & 3) * 8) * 2);
        LAS unsigned char* buf = lds + (t & 1) * BUFB; LAS unsigned char* nbuf = lds + ((t + 1) & 1) * BUFB;
        if (t + 1 < NT) { const size_t ko = (size_t)(t + 1) * 64 * KP * 2, vo = (size_t)(t + 1) * 64 * 512 * 2;
            sk0 = *(const u32x4*)(kbase0 + ko + kofv); if (tidv < 256) sk1 = *(const u32x4*)(kbase1 + ko + kofv); sv = *(const u32x4*)(vbase + vo + vofv); }
        const bool band = t >= NT - 8; const int kb0 = 64 * (t - (NT - 8)) + 4 * hiv;
        const bool doA = t <= tlastA, doB = t <= tlastB;
        f32x16 pa0, pa1, pb0, pb1;
#pragma unroll
        for (int r = 0; r < 16; ++r) { pa0[r] = -ma; pa1[r] = -ma; pb0[r] = -mb; pb1[r] = -mb; }
        { const LAS unsigned char* kb = buf + hiv * 1024 + r32v * 16;
#pragma unroll
          for (int s = 0; s < 6; ++s) { const bf16x8 a0 = *(const LAS bf16x8*)(kb + s * 2048), a1 = *(const LAS bf16x8*)(kb + s * 2048 + 512);
              if (doA) { pa0 = __builtin_amdgcn_mfma_f32_32x32x16_bf16(a0, qa[s], pa0, 0, 0, 0); pa1 = __builtin_amdgcn_mfma_f32_32x32x16_bf16(a1, qa[s], pa1, 0, 0, 0); }
              if (doB) { pb0 = __builtin_amdgcn_mfma_f32_32x32x16_bf16(a0, qb_[s], pb0, 0, 0, 0); pb1 = __builtin_amdgcn_mfma_f32_32x32x16_bf16(a1, qb_[s], pb1, 0, 0, 0); } } }
        bf16x8 fa[4], fb[4];
        if (doA) softmax_half(pa0, pa1, oa0, oa1, ma, la, fa, t == 0, band, kb0, (rba + r32v), r32v, hiv, wsf);
        if (doB) softmax_half(pb0, pb1, ob0, ob1, mb, lb, fb, t == 0, band, kb0, (rbb + r32v), r32v, hiv, wsf + 64);
        { const LAS unsigned char* vb = buf + KSLOT + ((lanev >> 4) & 1) * 32 + (lanev & 3) * 8 + (4 * hiv + ((lanev & 15) >> 2)) * 64;
#pragma unroll
          for (int s = 0; s < 4; ++s) {
              { const s16x4 lo = vtr(vb + s * 1024), hh = vtr(vb + s * 1024 + 512); const bf16x8 vf = {lo[0], lo[1], lo[2], lo[3], hh[0], hh[1], hh[2], hh[3]};
                if (doA) oa0 = __builtin_amdgcn_mfma_f32_32x32x16_bf16(fa[s], vf, oa0, 0, 0, 0); if (doB) ob0 = __builtin_amdgcn_mfma_f32_32x32x16_bf16(fb[s], vf, ob0, 0, 0, 0); }
              { const s16x4 lo = vtr(vb + 4096 + s * 1024), hh = vtr(vb + 4096 + s * 1024 + 512); const bf16x8 vf = {lo[0], lo[1], lo[2], lo[3], hh[0], hh[1], hh[2], hh[3]};
                if (doA) oa1 = __builtin_amdgcn_mfma_f32_32x32x16_bf16(fa[s], vf, oa1, 0, 0, 0); if (doB) ob1 = __builtin_amdgcn_mfma_f32_32x32x16_bf16(fb[s], vf, ob1, 0, 0, 0); } } }
        if (t + 1 < NT) { *(LAS u32x4*)(nbuf + tidv * 16) = sk0; if (tidv < 256) *(LAS u32x4*)(nbuf + (tidv + 512) * 16) = sk1; *(LAS u32x4*)(nbuf + KSLOT + tidv * 16) = sv; }
        __syncthreads();
    }
    la += __shfl_xor(la, 32); lb += __shfl_xor(lb, 32);
    if (hi == 0) { wsf[32 + r32] = la; wsf[96 + r32] = lb; }
    LAS bf16_t* stg = (LAS bf16_t*)(lds + L_OST) + wid * 2048;
#pragma unroll
    for (int hf = 0; hf < 2; ++hf) {
#pragma unroll
        for (int r = 0; r < 16; ++r) { const int orow = crow(r, hi); const float rl = __builtin_amdgcn_rcpf(wsf[hf * 64 + 32 + orow]);
            stg[orow * 64 + r32] = f2bf((hf ? ob0[r] : oa0[r]) * rl); stg[orow * 64 + 32 + r32] = f2bf((hf ? ob1[r] : oa1[r]) * rl); }
        asm volatile("" ::: "memory");
        bf16_t* Ow = O + (rowbase + q0 + (hf ? rbb : rba)) * 512 + h * 64;
#pragma unroll
        for (int i = 0; i < 4; ++i) { const int row = i * 8 + (lane >> 3), ch = lane & 7; const u32x4 v = *(const LAS u32x4*)(stg + row * 64 + ch * 8); *(u32x4*)(Ow + (size_t)row * 512 + ch * 8) = v; }
        asm volatile("" ::: "memory");
    }
    asm volatile("s_waitcnt vmcnt(0)" ::: "memory");
    __syncthreads();
    if (tid == 0) __hip_atomic_fetch_add(done_ctr, 1u, __ATOMIC_RELEASE, __HIP_MEMORY_SCOPE_AGENT);
}
}
#else
namespace att {
constexpr int KSLOT = 12288, VSLOT = 8192, BUFB = KSLOT + VSLOT, L_WS = 2 * BUFB, L_OST = L_WS + 8 * 128 * 4, L_END = L_OST + 8 * 4096;
constexpr int UNIT_ROWS = 512;
__device__ __forceinline__ int crow(int r, int hi) { return (r & 3) + 8 * (r >> 2) + 4 * hi; }
__device__ __forceinline__ s16x4 vtr(const LAS unsigned char* p) { return __builtin_bit_cast(s16x4, __builtin_amdgcn_ds_read_tr16_b64_v4i16((LAS s16x4*)p)); }
__device__ __forceinline__ void load_q(bf16x8 (&qr)[6], const bf16_t* Q, const f32x2* rope, size_t row, int h, int hi) {
    const bf16_t* Qw = Q + row * 768 + h * 96 + hi * 8;
#pragma unroll
    for (int s = 0; s < 6; ++s) qr[s] = *(const bf16x8*)(Qw + s * 16);
    const f32x4* rp = (const f32x4*)(rope + row * 16 + 4 * hi);
#pragma unroll
    for (int s = 4; s < 6; ++s) { const f32x4 c01 = rp[(s - 4) * 4], c23 = rp[(s - 4) * 4 + 1]; const u32x4 w = __builtin_bit_cast(u32x4, qr[s]); u32x4 o;
        { const float e = bflo(w.x), d = bfhi(w.x); o.x = pk2(e * c01[0] - d * c01[1], d * c01[0] + e * c01[1]); }
        { const float e = bflo(w.y), d = bfhi(w.y); o.y = pk2(e * c01[2] - d * c01[3], d * c01[2] + e * c01[3]); }
        { const float e = bflo(w.z), d = bfhi(w.z); o.z = pk2(e * c23[0] - d * c23[1], d * c23[0] + e * c23[1]); }
        { const float e = bflo(w.w), d = bfhi(w.w); o.w = pk2(e * c23[2] - d * c23[3], d * c23[2] + e * c23[3]); }
        qr[s] = __builtin_bit_cast(bf16x8, o); }
}
__device__ __forceinline__ void softmax_half(f32x16& p0, f32x16& p1, f32x16& o0, f32x16& o1, float& mrun, float& lrun, bf16x8 (&pa)[4],
                                             bool first, bool band, int kb0, int qrel, int r32, int hi, LAS float* wsf) {
    if (band) {
#pragma unroll
        for (int r = 0; r < 16; ++r) { const int kv = kb0 + (r & 3) + 8 * (r >> 2); if (kv > qrel) p0[r] = -INFINITY; if (kv + 32 > qrel) p1[r] = -INFINITY; } }
    float mx = fmaxf(p0[0], p1[0]);
#pragma unroll
    for (int r = 1; r < 16; ++r) mx = fmaxf(mx, fmaxf(p0[r], p1[r]));
    mx = fmaxf(mx, __shfl_xor(mx, 32));
    if (first || __any(mx > 8.0f)) {
        const float dl = first ? mx : fmaxf(mx, 0.f); mrun += dl;
#pragma unroll
        for (int r = 0; r < 16; ++r) { p0[r] -= dl; p1[r] -= dl; }
        const float alpha = __builtin_amdgcn_exp2f(-dl); lrun *= alpha;
        if (hi == 0) wsf[r32] = alpha;
#pragma unroll
        for (int r = 0; r < 16; ++r) { const float a = wsf[crow(r, hi)]; o0[r] *= a; o1[r] *= a; }
    }
    float ls = 0.f;
#pragma unroll
    for (int r = 0; r < 16; ++r) { p0[r] = __builtin_amdgcn_exp2f(p0[r]); p1[r] = __builtin_amdgcn_exp2f(p1[r]); ls += p0[r] + p1[r]; }
    lrun += ls;
#pragma unroll
    for (int s = 0; s < 4; ++s) { const int bb = 8 * (s & 1); u32x4 w;
        if (s < 2) { w.x = pk2(p0[bb], p0[bb + 1]); w.y = pk2(p0[bb + 2], p0[bb + 3]); w.z = pk2(p0[bb + 4], p0[bb + 5]); w.w = pk2(p0[bb + 6], p0[bb + 7]); }
        else { w.x = pk2(p1[bb], p1[bb + 1]); w.y = pk2(p1[bb + 2], p1[bb + 3]); w.z = pk2(p1[bb + 4], p1[bb + 5]); w.w = pk2(p1[bb + 6], p1[bb + 7]); }
        pa[s] = __builtin_bit_cast(bf16x8, w); }
}
__device__ __forceinline__ void attn_unit(int b, int h, int qb, LAS unsigned char* lds, unsigned* done_ctr) {
    KArgs kp = kargs(); unsigned char* ws_ = kp->ws;
    const bf16_t* Q = (const bf16_t*)(ws_ + WS_Q); const bf16_t* Kg = (const bf16_t*)(ws_ + WS_K); const bf16_t* Vg = (const bf16_t*)(ws_ + WS_V); bf16_t* O = (bf16_t*)(ws_ + WS_YS);
    const int tid = opaque_tid(), lane = tid & 63, r32 = lane & 31, hi = lane >> 5; const int wid = __builtin_amdgcn_readfirstlane(tid >> 6);
    const size_t rowbase = (size_t)b * SEQ; const int q0 = qb * UNIT_ROWS;
    bf16x8 qa[6], qb_[6];
    load_q(qa, Q, (const f32x2*)(ws_ + WS_ROPE), rowbase + q0 + wid * 64 + r32, h, hi);
    load_q(qb_, Q, (const f32x2*)(ws_ + WS_ROPE), rowbase + q0 + wid * 64 + 32 + r32, h, hi);
    const bf16_t* ksrc0 = Kg + (rowbase + (tid & 63)) * KP + h * 64 + (tid >> 6) * 8;
    const bf16_t* ksrc1 = Kg + (rowbase + (tid & 63)) * KP + 512 + (tid >> 6) * 8;
    const bf16_t* vsrc = Vg + (rowbase + ((tid & 255) >> 2)) * 512 + h * 64 + (tid >> 8) * 32 + (tid & 3) * 8;
    const int NT = (q0 + UNIT_ROWS) / 64;
    LAS float* wsf = (LAS float*)(lds + L_WS) + wid * 128;
    u32x4 sk0, sk1, sv;
    sk0 = *(const u32x4*)ksrc0; if (tid < 256) sk1 = *(const u32x4*)ksrc1; sv = *(const u32x4*)vsrc;
    *(LAS u32x4*)(lds + tid * 16) = sk0; if (tid < 256) *(LAS u32x4*)(lds + (tid + 512) * 16) = sk1; *(LAS u32x4*)(lds + KSLOT + tid * 16) = sv;
    __syncthreads();
    f32x16 oa0 = {}, oa1 = {}, ob0 = {}, ob1 = {}; float ma = 0.f, la = 0.f, mb = 0.f, lb = 0.f;
    const int qra = wid * 64 + r32, qrb = qra + 32;
    for (int t = 0; t < NT; ++t) {
        LAS unsigned char* buf = lds + (t & 1) * BUFB; LAS unsigned char* nbuf = lds + ((t + 1) & 1) * BUFB;
        if (t + 1 < NT) { sk0 = *(const u32x4*)(ksrc0 + (size_t)(t + 1) * 64 * KP); if (tid < 256) sk1 = *(const u32x4*)(ksrc1 + (size_t)(t + 1) * 64 * KP); sv = *(const u32x4*)(vsrc + (size_t)(t + 1) * 64 * 512); }
        f32x16 pa0, pa1, pb0, pb1;
#pragma unroll
        for (int r = 0; r < 16; ++r) { pa0[r] = -ma; pa1[r] = -ma; pb0[r] = -mb; pb1[r] = -mb; }
        { const LAS unsigned char* kb = buf + hi * 1024 + r32 * 16;
#pragma unroll
          for (int s = 0; s < 6; ++s) { const bf16x8 a0 = *(const LAS bf16x8*)(kb + s * 2048), a1 = *(const LAS bf16x8*)(kb + s * 2048 + 512);
              pa0 = __builtin_amdgcn_mfma_f32_32x32x16_bf16(a0, qa[s], pa0, 0, 0, 0); pa1 = __builtin_amdgcn_mfma_f32_32x32x16_bf16(a1, qa[s], pa1, 0, 0, 0);
              pb0 = __builtin_amdgcn_mfma_f32_32x32x16_bf16(a0, qb_[s], pb0, 0, 0, 0); pb1 = __builtin_amdgcn_mfma_f32_32x32x16_bf16(a1, qb_[s], pb1, 0, 0, 0); } }
        const bool band = t >= NT - 8; const int kb0 = 64 * (t - (NT - 8)) + 4 * hi;
        bf16x8 fa[4], fb[4];
        softmax_half(pa0, pa1, oa0, oa1, ma, la, fa, t == 0, band, kb0, qra, r32, hi, wsf);
        softmax_half(pb0, pb1, ob0, ob1, mb, lb, fb, t == 0, band, kb0, qrb, r32, hi, wsf + 64);
        { const LAS unsigned char* vb = buf + KSLOT + ((lane >> 4) & 1) * 32 + (lane & 3) * 8 + (4 * hi + ((lane & 15) >> 2)) * 64;
#pragma unroll
          for (int s = 0; s < 4; ++s) {
              { const s16x4 lo = vtr(vb + s * 1024), hh = vtr(vb + s * 1024 + 512); const bf16x8 vf = {lo[0], lo[1], lo[2], lo[3], hh[0], hh[1], hh[2], hh[3]};
                oa0 = __builtin_amdgcn_mfma_f32_32x32x16_bf16(fa[s], vf, oa0, 0, 0, 0); ob0 = __builtin_amdgcn_mfma_f32_32x32x16_bf16(fb[s], vf, ob0, 0, 0, 0); }
              { const s16x4 lo = vtr(vb + 4096 + s * 1024), hh = vtr(vb + 4096 + s * 1024 + 512); const bf16x8 vf = {lo[0], lo[1], lo[2], lo[3], hh[0], hh[1], hh[2], hh[3]};
                oa1 = __builtin_amdgcn_mfma_f32_32x32x16_bf16(fa[s], vf, oa1, 0, 0, 0); ob1 = __builtin_amdgcn_mfma_f32_32x32x16_bf16(fb[s], vf, ob1, 0, 0, 0); } } }
        if (t + 1 < NT) { *(LAS u32x4*)(nbuf + tid * 16) = sk0; if (tid < 256) *(LAS u32x4*)(nbuf + (tid + 512) * 16) = sk1; *(LAS u32x4*)(nbuf + KSLOT + tid * 16) = sv; }
        __syncthreads();
    }
    la += __shfl_xor(la, 32); lb += __shfl_xor(lb, 32);
    if (hi == 0) { wsf[32 + r32] = la; wsf[96 + r32] = lb; }
    LAS bf16_t* stg = (LAS bf16_t*)(lds + L_OST) + wid * 2048;
#pragma unroll
    for (int hf = 0; hf < 2; ++hf) {
#pragma unroll
        for (int r = 0; r < 16; ++r) { const int orow = crow(r, hi); const float rl = __builtin_amdgcn_rcpf(wsf[hf * 64 + 32 + orow]);
            stg[orow * 64 + r32] = f2bf((hf ? ob0[r] : oa0[r]) * rl); stg[orow * 64 + 32 + r32] = f2bf((hf ? ob1[r] : oa1[r]) * rl); }
        asm volatile("" ::: "memory");
        bf16_t* Ow = O + (rowbase + q0 + wid * 64 + hf * 32) * 512 + h * 64;
        if (h < 4) {
            u32x4 gg[4];
#pragma unroll
            for (int i = 0; i < 4; ++i) gg[i] = *(const u32x4*)(Ow + (size_t)(i * 8 + (lane >> 3)) * 512 + (lane & 7) * 8);
#pragma unroll
            for (int i = 0; i < 4; ++i) { const int row = i * 8 + (lane >> 3), ch = lane & 7; const u32x4 v = *(const LAS u32x4*)(stg + row * 64 + ch * 8); const u32x4 g = gg[i]; u32x4 w;
                w.x = pk2(bflo(v.x) * bflo(g.x), bfhi(v.x) * bfhi(g.x)); w.y = pk2(bflo(v.y) * bflo(g.y), bfhi(v.y) * bfhi(g.y)); w.z = pk2(bflo(v.z) * bflo(g.z), bfhi(v.z) * bfhi(g.z)); w.w = pk2(bflo(v.w) * bflo(g.w), bfhi(v.w) * bfhi(g.w));
                *(u32x4*)(Ow + (size_t)row * 512 + ch * 8) = w; }
        } else {
#pragma unroll
        for (int i = 0; i < 4; ++i) { const int row = i * 8 + (lane >> 3), ch = lane & 7; const u32x4 v = *(const LAS u32x4*)(stg + row * 64 + ch * 8); *(u32x4*)(Ow + (size_t)row * 512 + ch * 8) = v; }
        }
        asm volatile("" ::: "memory");
    }
    asm volatile("s_waitcnt vmcnt(0)" ::: "memory");
    __syncthreads();
    if (tid == 0) __hip_atomic_fetch_add(done_ctr, 1u, __ATOMIC_RELEASE, __HIP_MEMORY_SCOPE_AGENT);
}
}
#endif

namespace rwkv {
constexpr int LP = 72, TB = 64 * LP * 2;
constexpr int S_HT0 = 0, S_HT1 = 1, S_A = 2  , S_B = 3  , S_K = 4, S_R = 5, S_BT = 6, S_KT = 7, S_V = 8,
              S_MOFF = 9, S_MAK = 10, S_MRK = 11, S_MRB = 12, S_D = 13, S_ZT = 14, S_ACC = 15, NSLOT = 16;
constexpr int FP = 68;
constexpr int O_ZW = S_K * TB, O_ZA = O_ZW + 64 * FP * 4, O_YB = S_MAK * TB, O_WT = NSLOT * TB, O_CL = O_WT + 8 * 64 * 4, O_CST = O_CL + 64 * 4, O_END = O_CST + 12 * 64 * 4, O_TT = O_END  ;
static_assert(O_ZA + 64 * FP * 4 <= (S_KT + 1) * TB && O_YB + 64 * FP * 4 <= (S_MRK + 1) * TB, "f32 aliases");
__device__ __forceinline__ s16x4 vtr(const LAS unsigned char* p) { return __builtin_bit_cast(s16x4, __builtin_amdgcn_ds_read_tr16_b64_v4i16((LAS s16x4*)p)); }
struct LaneOff { int bn, bt, bs; };
__device__ __forceinline__ LaneOff lane_off(int fr, int fq) { LaneOff o; o.bn = (fr * LP + 8 * fq) * 2; o.bt = ((8 * fq + (fr >> 2)) * LP + 4 * (fr & 3)) * 2; o.bs = (fr * LP + 4 * fq) * 2; return o; }
__device__ __forceinline__ void relaunder(LaneOff& o) { asm volatile("" : "+v"(o.bn), "+v"(o.bt), "+v"(o.bs)); }
__device__ __forceinline__ bf16x8 frag_t(const LAS unsigned char* tile, int kk, int c0, const LaneOff& o) {
    const LAS unsigned char* q = tile + o.bt + (32 * kk * LP + c0) * 2;
    const s16x4 lo = vtr(q), hi = vtr(q + 4 * LP * 2); return (bf16x8){lo[0], lo[1], lo[2], lo[3], hi[0], hi[1], hi[2], hi[3]};
}
__device__ __forceinline__ bf16x8 frag_n(const LAS unsigned char* tile, int r0, int kk, const LaneOff& o) { return *(const LAS bf16x8*)(tile + o.bn + (r0 * LP + 32 * kk) * 2); }
__device__ __forceinline__ f32x4 MFMA16(bf16x8 a, bf16x8 b, f32x4 c) { return __builtin_amdgcn_mfma_f32_16x16x32_bf16(a, b, c, 0, 0, 0); }
__device__ __forceinline__ void st_tile_T(LAS unsigned char* tile, int m0, int n0, const LaneOff& o, const f32x4 c) {
    u32x2 w; w.x = pk2(c[0], c[1]); w.y = pk2(c[2], c[3]); *(LAS u32x2*)(tile + o.bs + (n0 * LP + m0) * 2) = w;
}
__device__ __forceinline__ void unpack8(const u32x4 w, float (&f)[8]) { f[0] = bflo(w.x); f[1] = bfhi(w.x); f[2] = bflo(w.y); f[3] = bfhi(w.y); f[4] = bflo(w.z); f[5] = bfhi(w.z); f[6] = bflo(w.w); f[7] = bfhi(w.w); }
__device__ __forceinline__ u32x4 pack8(const float (&f)[8]) { u32x4 w; w.x = pk2(f[0], f[1]); w.y = pk2(f[2], f[3]); w.z = pk2(f[4], f[5]); w.w = pk2(f[6], f[7]); return w; }
__device__ __forceinline__ void ld8(const float* p, float (&f)[8]) { const f32x4 a = *(const f32x4*)p, b = *(const f32x4*)(p + 4); f[0] = a[0]; f[1] = a[1]; f[2] = a[2]; f[3] = a[3]; f[4] = b[0]; f[5] = b[1]; f[6] = b[2]; f[7] = b[3]; }
__device__ __forceinline__ void ld8l(const LAS float* p, float (&f)[8]) { const f32x4 a = *(const LAS f32x4*)p, b = *(const LAS f32x4*)(p + 4); f[0] = a[0]; f[1] = a[1]; f[2] = a[2]; f[3] = a[3]; f[4] = b[0]; f[5] = b[1]; f[6] = b[2]; f[7] = b[3]; }
__device__ __forceinline__ float ex2(float x) { return __builtin_amdgcn_exp2f(x); }
constexpr float LOG2E = 1.4426950408889634f, LN2 = 0.6931471805599453f;

__device__ __forceinline__ void rwkv_unit(int l, int b, int h, LAS unsigned char* L) {
    const int tid = opaque_tid(), lane = tid & 63, fr = lane & 15, fq = lane >> 4; const int w = __builtin_amdgcn_readfirstlane(tid >> 6);
    const Params p = load_params();
    const bf16_t* PA = (const bf16_t*)(p.ws + WS_PA); bf16_t* Yout = (bf16_t*)(p.ws + WS_YS) + (size_t)T * 512;
    const int t = tid >> 3, c8 = (tid & 7) * 8;
    const int tw = (lane >> 3);
    const int cw = 16 * (w & 3);
    const float* mu = p.rwkv_mu + l * 1664;
    LaneOff lo = lane_off(fr, fq);
#define SLOT(s) (L + (s) * TB)
    bf16x8 bup[2];
    { const float* U = ((w < 4) ? p.rwkv_w_up : p.rwkv_a_up) + (size_t)l * 64 * 512 + h * 64 + 16 * (w & 3) + fr;
#pragma unroll
      for (int kk = 0; kk < 2; ++kk) { float f[8];
#pragma unroll
          for (int e = 0; e < 8; ++e) f[e] = U[(size_t)(32 * kk + 8 * fq + e) * 512];
          bup[kk] = __builtin_bit_cast(bf16x8, pack8(f)); } }
    for (int e = tid; e < TB / 4; e += 512) { ((LAS unsigned*)SLOT(S_HT0))[e] = 0u; ((LAS unsigned*)SLOT(S_D))[e] = 0u; ((LAS unsigned*)SLOT(S_MOFF))[e] = 0u; ((LAS unsigned*)SLOT(S_MRB))[e] = 0u;
        ((LAS unsigned*)SLOT(S_ZT))[e] = 0u; ((LAS unsigned*)SLOT(S_ACC))[e] = 0u; }
    f32x4 hacc[4];
#pragma unroll
    for (int i = 0; i < 4; ++i) hacc[i] = (f32x4){0.f, 0.f, 0.f, 0.f};
    int hcur = S_HT0, hnxt = S_HT1;
    u32x4 raw[10];
#define RWKV_LOAD(c, t, c8) do { const size_t row_ = (size_t)b * SEQ + (c) * 64 + (t); const bf16_t* s_ = PA + row_ * NA; const bool hp_ = ((c) * 64 + (t)) > 0; const u32x4 z_ = {0u, 0u, 0u, 0u}; \
        raw[0] = *(const u32x4*)(s_ + RW_R + h * 64 + c8); raw[1] = hp_ ? *(const u32x4*)(s_ - NA + RW_R + h * 64 + c8) : z_; \
        raw[2] = *(const u32x4*)(s_ + RW_K + h * 64 + c8); raw[3] = hp_ ? *(const u32x4*)(s_ - NA + RW_K + h * 64 + c8) : z_; \
        raw[4] = *(const u32x4*)(s_ + RW_V + h * 64 + c8); raw[5] = hp_ ? *(const u32x4*)(s_ - NA + RW_V + h * 64 + c8) : z_; \
        raw[6] = *(const u32x4*)(s_ + RW_LW + c8); raw[7] = hp_ ? *(const u32x4*)(s_ - NA + RW_LW + c8) : z_; \
        raw[8] = *(const u32x4*)(s_ + RW_LA + c8); raw[9] = hp_ ? *(const u32x4*)(s_ - NA + RW_LA + c8) : z_; } while (0)
    for (int e = tid; e < 12 * 64; e += 512) { const int rw_ = e >> 6, i_ = e & 63; const int hci = l * 512 + h * 64 + i_; float val;
        switch (rw_) { case 0: val = mu[h * 64 + i_]; break; case 1: val = mu[512 + h * 64 + i_]; break; case 2: val = mu[1024 + h * 64 + i_]; break; case 3: val = mu[1536 + i_]; break; case 4: val = mu[1600 + i_]; break;
            case 5: val = p.rwkv_w0[hci]; break; case 6: val = p.rwkv_a0[hci]; break; case 7: val = p.rwkv_k_k[hci]; break; case 8: val = p.rwkv_k_a[hci]; break; case 9: val = p.rwkv_r_k[hci]; break;
            case 10: val = p.rwkv_ln_w[hci]; break; default: val = p.rwkv_ln_b[hci]; break; }
        ((LAS float*)(L + O_CST))[e] = val; }
#ifdef V_C
    if (tid < 48) { const int task = tid / 6 + 8 * (tid % 6); u32x4 d = {0u, 0u, 0u, 3u};
        if (task < 36) { int q, mn;
            if (task < 6) { q = 0; mn = (int)((0xEDC984ull >> (4 * task)) & 0xF); }
            else { q = 1 + (task - 6) / 10; mn = (int)((0xFEDCA98540ull >> (4 * ((task - 6) % 10))) & 0xF); }
            const int m0 = 16 * (mn >> 2), n0 = 16 * (mn & 3);
            d.x = (unsigned)(((q < 2) ? S_A : S_R) * TB + m0 * LP * 2); d.y = (unsigned)(((q & 1) ? S_K : S_B) * TB + n0 * LP * 2);
            d.z = (unsigned)(((q == 0) ? S_MOFF : (q == 1) ? S_MAK : (q == 2) ? S_MRB : S_MRK) * TB + (n0 * LP + m0) * 2);
            d.w = (m0 == n0) ? ((q < 2) ? 1u : 2u) : 0u;
        } else { const int z = task - 36; const int mn = (int)((0xB76321ull >> (4 * (z % 6))) & 0xF);
            d.z = (unsigned)(((z < 6) ? S_MAK : S_MRK) * TB + (16 * (mn & 3) * LP + 16 * (mn >> 2)) * 2); }
        *(LAS u32x2*)(L + O_TT + tid * 8) = (u32x2){(d.x >> 4) | ((d.y >> 4) << 16), (d.z >> 4) | (d.w << 16)}; }
#endif
    RWKV_LOAD(0, t, c8);
    __syncthreads();
    for (int c = 0; c < SEQ / 64; ++c) {
        int c8v = c8, tv = t, frv = fr, fqv = fq; asm volatile("" : "+v"(c8v), "+v"(tv), "+v"(frv), "+v"(fqv));
        const int twv = tv & 7;
        float r[8], kraw[8], v[8];
        { float cu[8], pr[8], m8[8], o[8];
          unpack8(raw[0], cu); unpack8(raw[1], pr); ld8l((const LAS float*)(L + O_CST) + 0 * 64 + c8v, m8);
#pragma unroll
          for (int e = 0; e < 8; ++e) r[e] = cu[e] + (pr[e] - cu[e]) * m8[e];
          unpack8(raw[2], cu); unpack8(raw[3], pr); ld8l((const LAS float*)(L + O_CST) + 1 * 64 + c8v, m8);
#pragma unroll
          for (int e = 0; e < 8; ++e) kraw[e] = cu[e] + (pr[e] - cu[e]) * m8[e];
          unpack8(raw[4], cu); unpack8(raw[5], pr); ld8l((const LAS float*)(L + O_CST) + 2 * 64 + c8v, m8);
#pragma unroll
          for (int e = 0; e < 8; ++e) v[e] = cu[e] + (pr[e] - cu[e]) * m8[e];
#ifdef V_V
          *(LAS u32x4*)(SLOT(S_V) + (tv * LP + c8v) * 2) = pack8(v);
#endif
          unpack8(raw[6], cu); unpack8(raw[7], pr); ld8l((const LAS float*)(L + O_CST) + 3 * 64 + c8v, m8);
#pragma unroll
          for (int e = 0; e < 8; ++e) { const float x = cu[e] + (pr[e] - cu[e]) * m8[e]; o[e] = 1.0f - 2.0f * __builtin_amdgcn_rcpf(ex2(x * (2.0f * LOG2E)) + 1.0f); }
          *(LAS u32x4*)(SLOT(S_A) + (tv * LP + c8v) * 2) = pack8(o);
          unpack8(raw[8], cu); unpack8(raw[9], pr); ld8l((const LAS float*)(L + O_CST) + 4 * 64 + c8v, m8);
#pragma unroll
          for (int e = 0; e < 8; ++e) o[e] = cu[e] + (pr[e] - cu[e]) * m8[e];
          *(LAS u32x4*)(SLOT(S_B) + (tv * LP + c8v) * 2) = pack8(o); }
        __syncthreads();
        relaunder(lo);
#ifdef U_P2
        { const LAS unsigned char* X = (w < 4) ? SLOT(S_A) : SLOT(S_B); LAS float* Z = (LAS float*)(L + ((w < 4) ? O_ZW : O_ZA));
          f32x4 zacc[4];
#pragma unroll
          for (int m = 0; m < 4; ++m) { f32x4 a = {0.f, 0.f, 0.f, 0.f};
#pragma unroll
              for (int kk = 0; kk < 2; ++kk) a = MFMA16(frag_n(X, 16 * m, kk, lo), bup[kk], a);
              zacc[m] = a; }
#pragma unroll
          for (int m = 0; m < 4; ++m)
#pragma unroll
              for (int rr = 0; rr < 4; ++rr) Z[(16 * m + 4 * fqv + rr) * FP + cw + frv] = zacc[m][rr]; }
#else
        { const LAS unsigned char* X = (w < 4) ? SLOT(S_A) : SLOT(S_B); LAS float* Z = (LAS float*)(L + ((w < 4) ? O_ZW : O_ZA));
#pragma unroll
          for (int m = 0; m < 4; ++m) { f32x4 a = {0.f, 0.f, 0.f, 0.f};
#pragma unroll
              for (int kk = 0; kk < 2; ++kk) a = MFMA16(frag_n(X, 16 * m, kk, lo), bup[kk], a);
#pragma unroll
              for (int rr = 0; rr < 4; ++rr) Z[(16 * m + 4 * fqv + rr) * FP + cw + frv] = a[rr]; } }
#endif
        __syncthreads();
        float kk_[8], kp[8], bb[8], lw[8], cs[8], cb;
        { float zw[8], za[8], c0[8], c1[8];
          ld8l((const LAS float*)(L + O_ZW) + tv * FP + c8v, zw); ld8l((const LAS float*)(L + O_ZA) + tv * FP + c8v, za);
          ld8l((const LAS float*)(L + O_CST) + 5 * 64 + c8v, c0); ld8l((const LAS float*)(L + O_CST) + 6 * 64 + c8v, c1);
          float av[8];
#pragma unroll
#ifdef V_A
          for (int e = 0; e < 8; ++e) { lw[e] = -(LOG2E * 0.6065306597126334f) * __builtin_amdgcn_rcpf(1.0f + ex2(-(zw[e] + c0[e]) * LOG2E));
              av[e] = __builtin_amdgcn_rcpf(1.0f + ex2(-(za[e] + c1[e]) * LOG2E)); }
#else
          for (int e = 0; e < 8; ++e) { const float x = -(zw[e] + c0[e]); const float sp = fmaxf(x, 0.f) + LN2 * __builtin_amdgcn_logf(1.0f + ex2(-fabsf(x) * LOG2E));
              lw[e] = -LOG2E * ex2((-sp - 0.5f) * LOG2E);
              av[e] = __builtin_amdgcn_rcpf(1.0f + ex2(-(za[e] + c1[e]) * LOG2E)); }
#endif
          ld8l((const LAS float*)(L + O_CST) + 7 * 64 + c8v, c0); ld8l((const LAS float*)(L + O_CST) + 8 * 64 + c8v, c1);
          float ss = 0.f;
#pragma unroll
          for (int e = 0; e < 8; ++e) { kk_[e] = kraw[e] * c0[e]; ss += kk_[e] * kk_[e]; kp[e] = kraw[e] * (1.0f + (av[e] - 1.0f) * c1[e]); }
          ss = sum8(ss);
          const float inv = 1.0f / fmaxf(sqrtf(ss), 1e-12f);
          ld8l((const LAS float*)(L + O_CST) + 9 * 64 + c8v, c0);
          float cp = 0.f;
#pragma unroll
          for (int e = 0; e < 8; ++e) { kk_[e] *= inv; bb[e] = kk_[e] * av[e]; cp += r[e] * kp[e] * c0[e]; }
          cb = sum8(cp);
#pragma unroll
          for (int e = 0; e < 8; ++e) { float x = lw[e];
              float y = __shfl_up(x, 8); if (twv >= 1) x += y;
              y = __shfl_up(x, 16); if (twv >= 2) x += y;
              y = __shfl_up(x, 32); if (twv >= 4) x += y;
              cs[e] = x; }
          if (twv == 7) { LAS float* WT = (LAS float*)(L + O_WT) + w * 64 + c8v;
#pragma unroll
              for (int e = 0; e < 8; ++e) WT[e] = cs[e]; } }
        __syncthreads();
        { float off[8], tot[8];
#pragma unroll
          for (int e = 0; e < 8; ++e) { off[e] = 0.f; tot[e] = 0.f; }
#ifdef V_B
          { int wq = w; asm volatile("" : "+s"(wq));
#pragma unroll
            for (int g = 0; g < 8; ++g) { float x[8]; ld8l((const LAS float*)(L + O_WT) + g * 64 + c8v, x); const float mk = (g < wq) ? 1.0f : 0.0f;
#pragma unroll
                for (int e = 0; e < 8; ++e) { off[e] = __builtin_fmaf(x[e], mk, off[e]); tot[e] += x[e]; }
                if (g & 1) __builtin_amdgcn_sched_barrier(0); } }
#else
#pragma unroll
          for (int g = 0; g < 8; ++g) { float x[8]; ld8l((const LAS float*)(L + O_WT) + g * 64 + c8v, x);
#pragma unroll
              for (int e = 0; e < 8; ++e) { if (g < w) off[e] += x[e]; tot[e] += x[e]; } }
#endif
          if (tv == 0) { LAS float* CL = (LAS float*)(L + O_CL) + c8v;
#pragma unroll
              for (int e = 0; e < 8; ++e) CL[e] = tot[e]; }
          float o[8], en[8], ep[8]; const int toff = (tv * LP + c8v) * 2;
#pragma unroll
          for (int e = 0; e < 8; ++e) { cs[e] += off[e]; en[e] = ex2(-cs[e]); ep[e] = __builtin_amdgcn_rcpf(en[e]); o[e] = -kk_[e] * ep[e] * ex2(-lw[e]); }
          *(LAS u32x4*)(SLOT(S_A) + toff) = pack8(o);
#pragma unroll
          for (int e = 0; e < 8; ++e) o[e] = bb[e] * en[e];
          *(LAS u32x4*)(SLOT(S_B) + toff) = pack8(o);
#pragma unroll
          for (int e = 0; e < 8; ++e) o[e] = kp[e] * en[e];
          *(LAS u32x4*)(SLOT(S_K) + toff) = pack8(o);
#pragma unroll
          for (int e = 0; e < 8; ++e) o[e] = r[e] * ep[e];
          *(LAS u32x4*)(SLOT(S_R) + toff) = pack8(o);
#pragma unroll
          for (int e = 0; e < 8; ++e) { en[e] = ex2(tot[e] - cs[e]); o[e] = bb[e] * en[e]; }
          *(LAS u32x4*)(SLOT(S_BT) + toff) = pack8(o);
#pragma unroll
          for (int e = 0; e < 8; ++e) o[e] = kp[e] * en[e];
          *(LAS u32x4*)(SLOT(S_KT) + toff) = pack8(o);
#ifndef V_V
          *(LAS u32x4*)(SLOT(S_V) + toff) = pack8(v);
#endif
        }
        __syncthreads();
        relaunder(lo);
        int wv = w; asm volatile("" : "+s"(wv));
#if defined(LOAD_AT) && LOAD_AT == 4
        if (c + 1 < SEQ / 64) RWKV_LOAD(c + 1, tv, c8v);
#endif
#ifdef U_P4
        f32x4 tacc[5];
#pragma unroll
        for (int it = 0; it < 5; ++it) { const int task = wv + 8 * it; f32x4 a = {0.f, 0.f, 0.f, 0.f};
            if (task < 36) {
                int q, mn;
                if (task < 6) { q = 0; mn = (int)((0xEDC984ull >> (4 * task)) & 0xF); }
                else { q = 1 + (task - 6) / 10; mn = (int)((0xFEDCA98540ull >> (4 * ((task - 6) % 10))) & 0xF); }
                const int m0 = 16 * (mn >> 2), n0 = 16 * (mn & 3);
                const LAS unsigned char* XA = (q < 2) ? SLOT(S_A) : SLOT(S_R); const LAS unsigned char* XB = (q & 1) ? SLOT(S_K) : SLOT(S_B);
#pragma unroll
                for (int kk = 0; kk < 2; ++kk) a = MFMA16(frag_n(XA, m0, kk, lo), frag_n(XB, n0, kk, lo), a);
                if (m0 == n0) {
#pragma unroll
                    for (int rr = 0; rr < 4; ++rr) { const bool keep = (q < 2) ? (frv < 4 * fqv + rr) : (frv <= 4 * fqv + rr); a[rr] = keep ? a[rr] : 0.f; } } }
            tacc[it] = a; }
        if (wv < 4) {
            f32x4 a = {0.f, 0.f, 0.f, 0.f};
#pragma unroll
            for (int kk = 0; kk < 2; ++kk) a = MFMA16(frag_n(SLOT(S_A), 16 * wv, kk, lo), frag_n(SLOT(S_B), 16 * wv, kk, lo), a);
#pragma unroll
            for (int rr = 0; rr < 4; ++rr) a[rr] = (frv < 4 * fqv + rr) ? a[rr] : 0.f;
            float x[16];
            { LAS float* NS = (LAS float*)(SLOT(hnxt) + wv * 1024);
#pragma unroll
              for (int rr = 0; rr < 4; ++rr) NS[(4 * fqv + rr) * 16 + frv] = a[rr];
              asm volatile("s_waitcnt lgkmcnt(0)" ::: "memory");
#pragma unroll
              for (int rw = 0; rw < 16; ++rw) { float s = (rw == frv) ? 1.f : 0.f;
#pragma unroll
                  for (int sc = 0; sc < rw; ++sc) s = __builtin_fmaf(NS[rw * 16 + sc], x[sc], s);
                  x[rw] = s; }
              asm volatile("s_waitcnt lgkmcnt(0)" ::: "memory"); }
            if (fqv == 0) { LAS unsigned char* dp = SLOT(S_D) + ((16 * wv + frv) * LP + 16 * wv) * 2;
                float lo8[8], hi8[8];
#pragma unroll
                for (int e = 0; e < 8; ++e) { lo8[e] = x[e]; hi8[e] = x[8 + e]; }
                *(LAS u32x4*)dp = pack8(lo8); *(LAS u32x4*)(dp + 16) = pack8(hi8); }
        }
#pragma unroll
        for (int it = 0; it < 6; ++it) { const int task = wv + 8 * it;
            if (task < 36) {
                int q, mn;
                if (task < 6) { q = 0; mn = (int)((0xEDC984ull >> (4 * task)) & 0xF); }
                else { q = 1 + (task - 6) / 10; mn = (int)((0xFEDCA98540ull >> (4 * ((task - 6) % 10))) & 0xF); }
                st_tile_T(SLOT((q == 0) ? S_MOFF : (q == 1) ? S_MAK : (q == 2) ? S_MRB : S_MRK), 16 * (mn >> 2), 16 * (mn & 3), lo, tacc[it < 5 ? it : 4]);
            } else if (task < 48) {
                const int z = task - 36; const int mn = (int)((0xB76321ull >> (4 * (z % 6))) & 0xF);
                st_tile_T(SLOT((z < 6) ? S_MAK : S_MRK), 16 * (mn >> 2), 16 * (mn & 3), lo, (f32x4){0.f, 0.f, 0.f, 0.f});
            } }
#else
#ifdef V_C
        u32x4 dq[3];
#pragma unroll
        for (int j = 0; j < 3; ++j) dq[j] = *(const LAS u32x4*)(L + O_TT + wv * 48 + j * 16);
#endif
        if (wv < 4) {
            f32x4 a = {0.f, 0.f, 0.f, 0.f};
#pragma unroll
            for (int kk = 0; kk < 2; ++kk) a = MFMA16(frag_n(SLOT(S_A), 16 * wv, kk, lo), frag_n(SLOT(S_B), 16 * wv, kk, lo), a);
#pragma unroll
            for (int rr = 0; rr < 4; ++rr) a[rr] = (frv < 4 * fqv + rr) ? a[rr] : 0.f;
            float x[16];
            { LAS float* NS = (LAS float*)(SLOT(hnxt) + wv * 1024);
#pragma unroll
              for (int rr = 0; rr < 4; ++rr) NS[(4 * fqv + rr) * 16 + frv] = a[rr];
              asm volatile("s_waitcnt lgkmcnt(0)" ::: "memory");
#pragma unroll
              for (int rw = 0; rw < 16; ++rw) { float s = (rw == frv) ? 1.f : 0.f;
#pragma unroll
                  for (int sc = 0; sc < rw; ++sc) s = __builtin_fmaf(NS[rw * 16 + sc], x[sc], s);
                  x[rw] = s; }
              asm volatile("s_waitcnt lgkmcnt(0)" ::: "memory"); }
            if (fqv == 0) { LAS unsigned char* dp = SLOT(S_D) + ((16 * wv + frv) * LP + 16 * wv) * 2;
                float lo8[8], hi8[8];
#pragma unroll
                for (int e = 0; e < 8; ++e) { lo8[e] = x[e]; hi8[e] = x[8 + e]; }
                *(LAS u32x4*)dp = pack8(lo8); *(LAS u32x4*)(dp + 16) = pack8(hi8); }
        }
#ifdef V_C
        {
#pragma unroll
          for (int it = 0; it < 6; ++it) {
            const unsigned e0 = (unsigned)__builtin_amdgcn_readfirstlane((int)((it & 1) ? dq[it >> 1].z : dq[it >> 1].x)), e1 = (unsigned)__builtin_amdgcn_readfirstlane((int)((it & 1) ? dq[it >> 1].w : dq[it >> 1].y));
            const int mode = (int)(e1 >> 16); LAS unsigned char* dst = L + ((e1 & 0xffffu) << 4) + lo.bs;
            if (mode < 3) {
                const LAS unsigned char* pa = L + ((e0 & 0xffffu) << 4) + lo.bn; const LAS unsigned char* pb = L + ((e0 >> 16) << 4) + lo.bn;
                f32x4 a = MFMA16(*(const LAS bf16x8*)pa, *(const LAS bf16x8*)pb, (f32x4){0.f, 0.f, 0.f, 0.f});
                a = MFMA16(*(const LAS bf16x8*)(pa + 64), *(const LAS bf16x8*)(pb + 64), a);
                if (mode) { const int thr = frv + ((mode == 1) ? 1 : 0);
#pragma unroll
                    for (int rr = 0; rr < 4; ++rr) a[rr] = (thr <= 4 * fqv + rr) ? a[rr] : 0.f; }
                u32x2 wq_; wq_.x = pk2(a[0], a[1]); wq_.y = pk2(a[2], a[3]); *(LAS u32x2*)dst = wq_;
            } else { *(LAS u32x2*)dst = (u32x2){0u, 0u}; } } }
#else
#pragma unroll
        for (int it = 0; it < 6; ++it) { const int task = wv + 8 * it;
            if (task < 36) {
                int q, mn;
                if (task < 6) { q = 0; mn = (int)((0xEDC984ull >> (4 * task)) & 0xF); }
                else { q = 1 + (task - 6) / 10; mn = (int)((0xFEDCA98540ull >> (4 * ((task - 6) % 10))) & 0xF); }
                const int m0 = 16 * (mn >> 2), n0 = 16 * (mn & 3);
                const LAS unsigned char* XA = (q < 2) ? SLOT(S_A) : SLOT(S_R); const LAS unsigned char* XB = (q & 1) ? SLOT(S_K) : SLOT(S_B);
                f32x4 a = {0.f, 0.f, 0.f, 0.f};
#pragma unroll
                for (int kk = 0; kk < 2; ++kk) a = MFMA16(frag_n(XA, m0, kk, lo), frag_n(XB, n0, kk, lo), a);
                if (m0 == n0) {
#pragma unroll
                    for (int rr = 0; rr < 4; ++rr) { const bool keep = (q < 2) ? (frv < 4 * fqv + rr) : (frv <= 4 * fqv + rr); a[rr] = keep ? a[rr] : 0.f; } }
                st_tile_T(SLOT((q == 0) ? S_MOFF : (q == 1) ? S_MAK : (q == 2) ? S_MRB : S_MRK), m0, n0, lo, a);
            } else if (task < 48) {
                const int z = task - 36; const int mn = (int)((0xB76321ull >> (4 * (z % 6))) & 0xF);
                st_tile_T(SLOT((z < 6) ? S_MAK : S_MRK), 16 * (mn >> 2), 16 * (mn & 3), lo, (f32x4){0.f, 0.f, 0.f, 0.f});
            } }
#endif
#endif
        __syncthreads();
        relaunder(lo);
#if defined(LOAD_AT) && LOAD_AT == 5
        if (c + 1 < SEQ / 64) RWKV_LOAD(c + 1, tv, c8v);
#endif
        f32x4 yacc[4];
#ifdef U_P5
        if (w < 4) {
            f32x4 xr[4];
#pragma unroll
            for (int i = 0; i < 4; ++i) { f32x4 a = {0.f, 0.f, 0.f, 0.f};
#pragma unroll
                for (int kk = 0; kk < 2; ++kk) { if (32 * kk < 16 * i + 16) a = MFMA16(frag_t(SLOT(S_MAK), kk, 16 * i, lo), frag_t(SLOT(S_V), kk, cw, lo), a);
                    a = MFMA16(frag_n(SLOT(S_A), 16 * i, kk, lo), frag_n(SLOT(hcur), cw, kk, lo), a); }
                xr[i] = a; }
#pragma unroll
            for (int i = 0; i < 4; ++i) { f32x4 a = xr[i];
#pragma unroll
                for (int kk = 0; kk < 2; ++kk) if (32 * kk < 16 * i) a = MFMA16(frag_t(SLOT(S_MOFF), kk, 16 * i, lo), frag_n(SLOT(S_ZT), cw, kk, lo), a);
                st_tile_T(SLOT(S_ACC), 16 * i, cw, lo, a);
                asm volatile("" ::: "memory");
                const f32x4 z = MFMA16(frag_t(SLOT(S_D), i >> 1, 16 * i, lo), frag_n(SLOT(S_ACC), cw, i >> 1, lo), (f32x4){0.f, 0.f, 0.f, 0.f});
                st_tile_T(SLOT(S_ZT), 16 * i, cw, lo, z);
                asm volatile("" ::: "memory"); }
#else
        if (w < 4) {
#pragma unroll
            for (int i = 0; i < 4; ++i) { f32x4 a = {0.f, 0.f, 0.f, 0.f};
#pragma unroll
                for (int kk = 0; kk < 2; ++kk) { if (32 * kk < 16 * i + 16) a = MFMA16(frag_t(SLOT(S_MAK), kk, 16 * i, lo), frag_t(SLOT(S_V), kk, cw, lo), a);
                    a = MFMA16(frag_n(SLOT(S_A), 16 * i, kk, lo), frag_n(SLOT(hcur), cw, kk, lo), a); }
#pragma unroll
                for (int kk = 0; kk < 2; ++kk) if (32 * kk < 16 * i) a = MFMA16(frag_t(SLOT(S_MOFF), kk, 16 * i, lo), frag_n(SLOT(S_ZT), cw, kk, lo), a);
                st_tile_T(SLOT(S_ACC), 16 * i, cw, lo, a);
                const f32x4 z = MFMA16(frag_t(SLOT(S_D), i >> 1, 16 * i, lo), frag_n(SLOT(S_ACC), cw, i >> 1, lo), (f32x4){0.f, 0.f, 0.f, 0.f});
                st_tile_T(SLOT(S_ZT), 16 * i, cw, lo, z); }
#endif
        } else {
#pragma unroll
            for (int i = 0; i < 4; ++i) { f32x4 a = {0.f, 0.f, 0.f, 0.f};
#pragma unroll
                for (int kk = 0; kk < 2; ++kk) { if (32 * kk < 16 * i + 16) a = MFMA16(frag_t(SLOT(S_MRK), kk, 16 * i, lo), frag_t(SLOT(S_V), kk, cw, lo), a);
                    a = MFMA16(frag_n(SLOT(S_R), 16 * i, kk, lo), frag_n(SLOT(hcur), cw, kk, lo), a);
                }
                yacc[i] = a; }
        }
        __syncthreads();
        relaunder(lo);
#if !defined(LOAD_AT)
        if (c + 1 < SEQ / 64) RWKV_LOAD(c + 1, tv, c8v);
#endif
#ifdef U_P7
        if (w >= 4) {
#pragma unroll
            for (int i = 0; i < 4; ++i) {
#pragma unroll
                for (int rr = 0; rr < 4; ++rr) hacc[i][rr] = hacc[i][rr] * ex2(((const LAS float*)(L + O_CL))[16 * i + 4 * fqv + rr]);
#pragma unroll
                for (int kk = 0; kk < 2; ++kk) { hacc[i] = MFMA16(frag_t(SLOT(S_KT), kk, 16 * i, lo), frag_t(SLOT(S_V), kk, cw, lo), hacc[i]);
                    hacc[i] = MFMA16(frag_t(SLOT(S_BT), kk, 16 * i, lo), frag_n(SLOT(S_ZT), cw, kk, lo), hacc[i]); }
#pragma unroll
                for (int kk = 0; kk < 2; ++kk) if (32 * kk < 16 * i + 16) yacc[i] = MFMA16(frag_t(SLOT(S_MRB), kk, 16 * i, lo), frag_n(SLOT(S_ZT), cw, kk, lo), yacc[i]); }
#pragma unroll
            for (int i = 0; i < 4; ++i) { st_tile_T(SLOT(hnxt), 16 * i, cw, lo, hacc[i]);
#pragma unroll
                for (int rr = 0; rr < 4; ++rr) ((LAS float*)(L + O_YB))[(16 * i + 4 * fqv + rr) * FP + cw + frv] = yacc[i][rr]; }
        }
#else
        if (w >= 4) {
#pragma unroll
            for (int i = 0; i < 4; ++i) {
#pragma unroll
                for (int rr = 0; rr < 4; ++rr) hacc[i][rr] = hacc[i][rr] * ex2(((const LAS float*)(L + O_CL))[16 * i + 4 * fqv + rr]);
#pragma unroll
                for (int kk = 0; kk < 2; ++kk) { hacc[i] = MFMA16(frag_t(SLOT(S_KT), kk, 16 * i, lo), frag_t(SLOT(S_V), kk, cw, lo), hacc[i]);
                    hacc[i] = MFMA16(frag_t(SLOT(S_BT), kk, 16 * i, lo), frag_n(SLOT(S_ZT), cw, kk, lo), hacc[i]); }
                st_tile_T(SLOT(hnxt), 16 * i, cw, lo, hacc[i]);
#pragma unroll
                for (int kk = 0; kk < 2; ++kk) if (32 * kk < 16 * i + 16) yacc[i] = MFMA16(frag_t(SLOT(S_MRB), kk, 16 * i, lo), frag_n(SLOT(S_ZT), cw, kk, lo), yacc[i]);
#pragma unroll
                for (int rr = 0; rr < 4; ++rr) ((LAS float*)(L + O_YB))[(16 * i + 4 * fqv + rr) * FP + cw + frv] = yacc[i][rr]; }
        }
#endif
        __syncthreads();
        { float y[8], g0[8], g1[8]; ld8l((const LAS float*)(L + O_YB) + tv * FP + c8v, y); ld8l((const LAS float*)(L + O_CST) + 10 * 64 + c8v, g0); ld8l((const LAS float*)(L + O_CST) + 11 * 64 + c8v, g1);
          float s = 0.f;
#pragma unroll
          for (int e = 0; e < 8; ++e) s += y[e];
          const float mean = sum8(s) * (1.f / 64.f); float q = 0.f;
#pragma unroll
          for (int e = 0; e < 8; ++e) { y[e] -= mean; q += y[e] * y[e]; }
          const float rs = rsqrtf(sum8(q) * (1.f / 64.f) + RWKV_GN_EPS);
#ifdef V_V
          float vv[8]; unpack8(*(const LAS u32x4*)(SLOT(S_V) + (tv * LP + c8v) * 2), vv);
#pragma unroll
          for (int e = 0; e < 8; ++e) y[e] = y[e] * rs * g0[e] + g1[e] + cb * vv[e];
#else
#pragma unroll
          for (int e = 0; e < 8; ++e) y[e] = y[e] * rs * g0[e] + g1[e] + cb * v[e];
#endif
          *(u32x4*)(Yout + ((size_t)b * SEQ + c * 64 + tv) * 512 + h * 64 + c8v) = pack8(y); }
        { const int tmp = hcur; hcur = hnxt; hnxt = tmp; }
    }
    __syncthreads();
#undef SLOT
#undef RWKV_LOAD
}
}

namespace gla {
using rwkv::vtr; using rwkv::unpack8; using rwkv::pack8; using rwkv::ld8l; using rwkv::ex2; using rwkv::LOG2E; using rwkv::LN2; using rwkv::MFMA16;
constexpr int LP = 72, VP = 136, TB = 64 * LP * 2;
constexpr int B_QH = 0, B_KH = TB, B_KT = 2 * TB, B_PT = 3 * TB, B_VV = 4 * TB, B_ST = B_VV + 64 * VP * 2, B_OB = B_ST + 128 * LP * 2, B_WT = B_OB + 64 * 132 * 4,
              B_CL = B_WT + 8 * 64 * 4, B_AUP = B_CL + 64 * 4, B_AB = B_AUP + 16 * 64 * 4, B_GN = B_AB + 64 * 4, B_END = B_GN + 128 * 4;
static_assert(B_END <= 131072, "gla lds");
struct LaneOff { int bn, bt, btv, bs; };
__device__ __forceinline__ LaneOff lane_off(int fr, int fq) { LaneOff o; o.bn = (fr * LP + 8 * fq) * 2; o.bt = ((8 * fq + (fr >> 2)) * LP + 4 * (fr & 3)) * 2; o.btv = ((8 * fq + (fr >> 2)) * VP + 4 * (fr & 3)) * 2; o.bs = (fr * LP + 4 * fq) * 2; return o; }
__device__ __forceinline__ void relaunder(LaneOff& o) { asm volatile("" : "+v"(o.bn), "+v"(o.bt), "+v"(o.btv), "+v"(o.bs)); }
__device__ __forceinline__ bf16x8 frag_t(const LAS unsigned char* tile, int kk, int c0, const LaneOff& o) {
    const LAS unsigned char* q = tile + o.bt + (32 * kk * LP + c0) * 2; const s16x4 lo = vtr(q), hi = vtr(q + 4 * LP * 2); return (bf16x8){lo[0], lo[1], lo[2], lo[3], hi[0], hi[1], hi[2], hi[3]}; }
__device__ __forceinline__ bf16x8 frag_tv(const LAS unsigned char* tile, int kk, int c0, const LaneOff& o) {
    const LAS unsigned char* q = tile + o.btv + (32 * kk * VP + c0) * 2; const s16x4 lo = vtr(q), hi = vtr(q + 4 * VP * 2); return (bf16x8){lo[0], lo[1], lo[2], lo[3], hi[0], hi[1], hi[2], hi[3]}; }
__device__ __forceinline__ bf16x8 frag_n(const LAS unsigned char* tile, int r0, int kk, const LaneOff& o) { return *(const LAS bf16x8*)(tile + o.bn + (r0 * LP + 32 * kk) * 2); }
__device__ __forceinline__ void st_tile_T(LAS unsigned char* tile, int m0, int n0, const LaneOff& o, const f32x4 c) { u32x2 w; w.x = pk2(c[0], c[1]); w.y = pk2(c[2], c[3]); *(LAS u32x2*)(tile + o.bs + (n0 * LP + m0) * 2) = w; }

__device__ __forceinline__ void gla_unit(int l, int b, int h, LAS unsigned char* L, unsigned* done_ctr) {
    const Params p = load_params();
    const bf16_t* PA = (const bf16_t*)(p.ws + WS_PA); bf16_t* Yout = (bf16_t*)(p.ws + WS_YS) + (size_t)2 * T * 512;
    const int tid = opaque_tid(), lane = tid & 63, fr = lane & 15, fq = lane >> 4; const int w = __builtin_amdgcn_readfirstlane(tid >> 6);
    const int t = tid >> 3, c8 = (tid & 7) * 8;
    LaneOff lo = lane_off(fr, fq);
    for (int e = tid; e < 16 * 64; e += 512) ((LAS float*)(L + B_AUP))[e] = p.gla_a_up[(size_t)l * 16 * 256 + (e >> 6) * 256 + h * 64 + (e & 63)];
    if (tid < 64) ((LAS float*)(L + B_AB))[tid] = p.gla_a_b[l * 256 + h * 64 + tid];
    if (tid < 128) ((LAS float*)(L + B_GN))[tid] = p.gla_norm[l * 512 + h * 128 + tid];
    for (int e = tid; e < 128 * LP / 2; e += 512) ((LAS unsigned*)(L + B_ST))[e] = 0u;
    for (int e = tid; e < TB / 4; e += 512) ((LAS unsigned*)(L + B_PT))[e] = 0u;
    f32x4 sacc[4];
#pragma unroll
    for (int m = 0; m < 4; ++m) sacc[m] = (f32x4){0.f, 0.f, 0.f, 0.f};
    u32x4 rq, rk, rv0, rv1, rl0, rl1;
#define GLA_LOAD(c) do { const bf16_t* s_ = PA + ((size_t)b * SEQ + (c) * 64 + t) * NA; rq = *(const u32x4*)(s_ + GQ + h * 64 + c8); rk = *(const u32x4*)(s_ + GK + h * 64 + c8); \
        rv0 = *(const u32x4*)(s_ + GV + h * 128 + 2 * c8); rv1 = *(const u32x4*)(s_ + GV + h * 128 + 2 * c8 + 8); rl0 = *(const u32x4*)(s_ + GLAT); rl1 = *(const u32x4*)(s_ + GLAT + 8); } while (0)
    GLA_LOAD(0);
    __syncthreads();
    for (int c = 0; c < SEQ / 64; ++c) {
        int c8v = c8, tv = t, frv = fr, fqv = fq; asm volatile("" : "+v"(c8v), "+v"(tv), "+v"(frv), "+v"(fqv));
        const int twv = tv & 7;
        float cs[8];
        { float lat[16]; { float a8[8]; unpack8(rl0, a8);
#pragma unroll
              for (int j = 0; j < 8; ++j) lat[j] = a8[j];
              unpack8(rl1, a8);
#pragma unroll
              for (int j = 0; j < 8; ++j) lat[8 + j] = a8[j]; }
          float z[8]; ld8l((const LAS float*)(L + B_AB) + c8v, z);
#pragma unroll
          for (int j = 0; j < 16; ++j) { float a8[8]; ld8l((const LAS float*)(L + B_AUP) + j * 64 + c8v, a8);
#pragma unroll
              for (int e = 0; e < 8; ++e) z[e] += lat[j] * a8[e]; }
#pragma unroll
          for (int e = 0; e < 8; ++e) { const float x = -z[e]; const float sp = fmaxf(x, 0.f) + LN2 * __builtin_amdgcn_logf(1.0f + ex2(-fabsf(x) * LOG2E));
              float v_ = -sp * (LOG2E / 16.0f);
              float y = __shfl_up(v_, 8); if (twv >= 1) v_ += y;
              y = __shfl_up(v_, 16); if (twv >= 2) v_ += y;
              y = __shfl_up(v_, 32); if (twv >= 4) v_ += y;
              cs[e] = v_; }
          if (twv == 7) { LAS float* WT = (LAS float*)(L + B_WT) + w * 64 + c8v;
#pragma unroll
              for (int e = 0; e < 8; ++e) WT[e] = cs[e]; } }
        __syncthreads();
        { float off[8], tot[8];
#pragma unroll
          for (int e = 0; e < 8; ++e) { off[e] = 0.f; tot[e] = 0.f; }
#pragma unroll
          for (int g = 0; g < 8; ++g) { float x[8]; ld8l((const LAS float*)(L + B_WT) + g * 64 + c8v, x);
#pragma unroll
              for (int e = 0; e < 8; ++e) { if (g < w) off[e] += x[e]; tot[e] += x[e]; } }
          if (tv == 0) { LAS float* CL = (LAS float*)(L + B_CL) + c8v;
#pragma unroll
              for (int e = 0; e < 8; ++e) CL[e] = tot[e]; }
          float q8[8], k8[8], o[8], en[8]; unpack8(rq, q8); unpack8(rk, k8); const int toff = (tv * LP + c8v) * 2;
#pragma unroll
          for (int e = 0; e < 8; ++e) { cs[e] += off[e]; en[e] = ex2(-cs[e]); o[e] = q8[e] * 0.125f * __builtin_amdgcn_rcpf(en[e]); }
          *(LAS u32x4*)(L + B_QH + toff) = pack8(o);
#pragma unroll
          for (int e = 0; e < 8; ++e) o[e] = k8[e] * en[e];
          *(LAS u32x4*)(L + B_KH + toff) = pack8(o);
#pragma unroll
          for (int e = 0; e < 8; ++e) o[e] = k8[e] * ex2(tot[e] - cs[e]);
          *(LAS u32x4*)(L + B_KT + toff) = pack8(o);
          *(LAS u32x4*)(L + B_VV + (tv * VP + 2 * c8v) * 2) = rv0; *(LAS u32x4*)(L + B_VV + (tv * VP + 2 * c8v + 8) * 2) = rv1; }
        if (c + 1 < SEQ / 64) GLA_LOAD(c + 1);
        __syncthreads();
        relaunder(lo);
        { const int m0 = 16 * (w >> 1);
#pragma unroll
          for (int nn = 0; nn < 2; ++nn) { const int n0 = 32 * (w & 1) + 16 * nn;
              if (n0 <= m0) { f32x4 a = {0.f, 0.f, 0.f, 0.f};
#pragma unroll
                  for (int kk = 0; kk < 2; ++kk) a = MFMA16(frag_n(L + B_QH, m0, kk, lo), frag_n(L + B_KH, n0, kk, lo), a);
                  if (n0 == m0) {
#pragma unroll
                      for (int rr = 0; rr < 4; ++rr) a[rr] = (frv <= 4 * fqv + rr) ? a[rr] : 0.f; }
                  st_tile_T(L + B_PT, m0, n0, lo, a); } } }
        __syncthreads();
        relaunder(lo);
        { const int n0 = 16 * w;
#pragma unroll
          for (int m = 0; m < 4; ++m) { f32x4 a = {0.f, 0.f, 0.f, 0.f};
#pragma unroll
              for (int kk = 0; kk < 2; ++kk) { if (32 * kk < 16 * m + 16) a = MFMA16(frag_t(L + B_PT, kk, 16 * m, lo), frag_tv(L + B_VV, kk, n0, lo), a);
                  a = MFMA16(frag_n(L + B_QH, 16 * m, kk, lo), frag_n(L + B_ST, n0, kk, lo), a); }
#pragma unroll
              for (int rr = 0; rr < 4; ++rr) ((LAS float*)(L + B_OB))[(16 * m + 4 * fqv + rr) * 132 + n0 + frv] = a[rr]; }
          asm volatile("" ::: "memory");
#pragma unroll
          for (int m = 0; m < 4; ++m) { f32x4 a = sacc[m];
#pragma unroll
              for (int rr = 0; rr < 4; ++rr) a[rr] *= ex2(((const LAS float*)(L + B_CL))[16 * m + 4 * fqv + rr]);
#pragma unroll
              for (int kk = 0; kk < 2; ++kk) a = MFMA16(frag_t(L + B_KT, kk, 16 * m, lo), frag_tv(L + B_VV, kk, n0, lo), a);
              sacc[m] = a; st_tile_T(L + B_ST, 16 * m, n0, lo, a); } }
        __syncthreads();
        { float v0[8], v1[8], g0[8], g1[8]; float ss = 0.f; const LAS float* ob = (const LAS float*)(L + B_OB) + tv * 132 + 2 * c8v;
          ld8l(ob, v0); ld8l(ob + 8, v1);
#pragma unroll
          for (int e = 0; e < 8; ++e) ss += v0[e] * v0[e] + v1[e] * v1[e];
          ss = sum8(ss);
          const float rstd = rsqrtf(ss * (1.f / 128.f) + NORM_EPS);
          ld8l((const LAS float*)(L + B_GN) + 2 * c8v, g0); ld8l((const LAS float*)(L + B_GN) + 2 * c8v + 8, g1);
          float o0[8], o1[8];
#pragma unroll
          for (int e = 0; e < 8; ++e) { o0[e] = v0[e] * rstd * g0[e]; o1[e] = v1[e] * rstd * g1[e]; }
          bf16_t* dst = Yout + ((size_t)b * SEQ + c * 64 + tv) * 512 + h * 128 + 2 * c8v;
          *(u32x4*)dst = pack8(o0); *(u32x4*)(dst + 8) = pack8(o1); }
    }
    asm volatile("s_waitcnt vmcnt(0)" ::: "memory");
    __syncthreads();
    if (tid == 0) __hip_atomic_fetch_add(done_ctr, 1u, __ATOMIC_RELEASE, __HIP_MEMORY_SCOPE_AGENT);
#undef GLA_LOAD
}
}

#define XB_TMO      128
#define XB_XCNT(j)  (256  + 64 * (j))
#define XB_XSUB(j)  (1280 + 64 * (j))
#define XB_XGEN(j)  (2304 + 64 * (j))
#define XB_TOP      3328
#define XB_TOPGEN   3392
#define XCD_BAR_WORDS 3456
#define XB_SPIN_CAP (1u << 18)

__device__ __forceinline__ unsigned xb_ld(unsigned* p)              { return __hip_atomic_load(p, __ATOMIC_RELAXED, __HIP_MEMORY_SCOPE_AGENT); }
__device__ __forceinline__ unsigned xb_add(unsigned* p, unsigned v) { return __hip_atomic_fetch_add(p, v, __ATOMIC_RELAXED, __HIP_MEMORY_SCOPE_AGENT); }
__device__ __forceinline__ unsigned xb_xcc_id() { return (unsigned)__builtin_amdgcn_s_getreg((3 << 11) | 20) & 0xFu; }
#define XB_SPIN(cond, bar) do { unsigned _sp = 0; while (cond) { __builtin_amdgcn_s_sleep(1); \
    if ((++_sp & 255u) == 0u) { if (xb_ld(&(bar)[XB_TMO])) break; if (_sp > XB_SPIN_CAP) { atomicAdd(&(bar)[XB_TMO], 1u); break; } } } } while (0)

struct XcdBarrier {
    unsigned* bar; unsigned x;
    volatile LAS unsigned* st;
};

__device__ __forceinline__ XcdBarrier xcd_barrier_post(unsigned* bar, volatile LAS unsigned* st) {
    XcdBarrier b; b.bar = bar; b.x = xb_xcc_id(); b.st = st;
    if (threadIdx.x == 0) (void)xb_add(&bar[XB_XCNT(b.x)], 1u);
    return b;
}
__device__ __forceinline__ void xcd_barrier_complete(unsigned* bar, unsigned x, unsigned& nloc, unsigned& nx) {
    const unsigned G = gridDim.x * gridDim.y * gridDim.z;
    unsigned sum, cnt, mine, sp = 0u;
    for (;;) {
        sum = 0u; cnt = 0u; mine = 0u;
#pragma unroll
        for (unsigned j = 0; j < 16; ++j) { const unsigned c = xb_ld(&bar[XB_XCNT(j)]); sum += c; cnt += (c > 0u) ? 1u : 0u; mine = (j == x) ? c : mine; }
        if (sum == G) break;
        __builtin_amdgcn_s_sleep(1);
        if ((++sp & 255u) == 0u) { if (xb_ld(&bar[XB_TMO])) break; if (sp > XB_SPIN_CAP) { atomicAdd(&bar[XB_TMO], 1u); break; } }
    }
    nloc = mine > 0u ? mine : 1u; nx = cnt > 0u ? cnt : 1u;
}

__device__ __forceinline__ void xcd_barrier(const XcdBarrier& b) {
    asm volatile("s_waitcnt vmcnt(0)" ::: "memory");
    __syncthreads();
    if (threadIdx.x == 0) {
        unsigned* bar = b.bar;
        __builtin_amdgcn_s_waitcnt(0);
        unsigned nloc = b.st[0], nx = b.st[1];
        if (nloc == 0u) { xcd_barrier_complete(bar, b.x, nloc, nx); b.st[0] = nloc; b.st[1] = nx; }
        const unsigned old = xb_add(&bar[XB_XSUB(b.x)], 1u);
        const unsigned gen = old / nloc;
        if (old + 1u == (gen + 1u) * nloc) {
            __builtin_amdgcn_fence(__ATOMIC_RELEASE, "agent");
            asm volatile("s_waitcnt vmcnt(0)" ::: "memory");
            const unsigned og = xb_add(&bar[XB_TOP], 1u);
            const unsigned tg = og / nx;
            if (og + 1u == (tg + 1u) * nx) xb_add(&bar[XB_TOPGEN], 1u);
            else XB_SPIN(xb_ld(&bar[XB_TOPGEN]) == tg, bar);
            __builtin_amdgcn_fence(__ATOMIC_ACQUIRE, "agent");
            xb_add(&bar[XB_XGEN(b.x)], 1u);
            asm volatile("s_waitcnt vmcnt(0)" ::: "memory");
        } else {
            XB_SPIN(xb_ld(&bar[XB_XGEN(b.x)]) == gen, bar);
            __builtin_amdgcn_fence(__ATOMIC_ACQUIRE, "agent");
            asm volatile("s_waitcnt vmcnt(0)" ::: "memory");
        }
    }
    __syncthreads();
}

constexpr int NWAVES = 8, NTHREADS = 512;
constexpr int LDS_MISC = 155648, LDS_BYTES = 159744;
constexpr int PH_PER_LAYER = 8, N_PHASES = 1 + DEPTH * PH_PER_LAYER;
constexpr int CW_BAR = 4096;
constexpr int MG_BLOCKS = 192;
constexpr int RWKV_BLOCKS = 64, GLA_BLOCKS = 32, SUB_BLOCKS = 256 - RWKV_BLOCKS - GLA_BLOCKS;
constexpr int N_ATT_UNITS = 64 * (SEQ / 512), N_MIX_ITEMS = N_ATT_UNITS;
#ifndef MK_MULTI_LAUNCH
#define MK_MULTI_LAUNCH 0
#endif

__device__ __forceinline__ void sub_barrier(unsigned* cnt, unsigned target) {
    asm volatile("s_waitcnt vmcnt(0)" ::: "memory");
    __syncthreads();
    if (threadIdx.x == 0) {
        __builtin_amdgcn_fence(__ATOMIC_RELEASE, "agent"); asm volatile("s_waitcnt vmcnt(0)" ::: "memory");
        __hip_atomic_fetch_add(cnt, 1u, __ATOMIC_RELAXED, __HIP_MEMORY_SCOPE_AGENT);
        unsigned sp = 0; while (__hip_atomic_load(cnt, __ATOMIC_RELAXED, __HIP_MEMORY_SCOPE_AGENT) < target && ++sp < (1u << 24)) __builtin_amdgcn_s_sleep(2);
        __builtin_amdgcn_fence(__ATOMIC_ACQUIRE, "agent"); asm volatile("s_waitcnt vmcnt(0)" ::: "memory");
    }
    __syncthreads();
}
__global__ void __launch_bounds__(NTHREADS, 2) hybrid_fwd(Params p_unused) {
    extern __shared__ __attribute__((aligned(16))) unsigned char lds[];
#ifndef NO_CG_SYNC
    cg::grid_group grid = cg::this_grid();
#endif
#define G ((int)gridDim.x)
#define bx ((int)blockIdx.x)
#define NGW (G * NWAVES)
#define PHASE_VARS const int tid = opaque_tid(), lane = tid & 63, wave = __builtin_amdgcn_readfirstlane(tid >> 6), gw = bx * NWAVES + wave; (void)lane; (void)gw
    LAS unsigned char* ldsl = (LAS unsigned char*)lds;
    { volatile LAS unsigned* misc = (volatile LAS unsigned*)(ldsl + LDS_MISC); if (threadIdx.x < 64) misc[threadIdx.x] = 0u; __syncthreads(); }
    (void)xcd_barrier_post((unsigned*)(kargs()->ws + WS_CTL) + CW_BAR, (volatile LAS unsigned*)(ldsl + LDS_MISC) + 8);
#define GRID_BAR() do { XcdBarrier xb_; xb_.bar = (unsigned*)(kargs()->ws + WS_CTL) + CW_BAR; xb_.x = xb_xcc_id(); xb_.st = (volatile LAS unsigned*)(ldsl + LDS_MISC) + 8; xcd_barrier(xb_); } while (0)
#ifndef EPI_ALIGN_PD1
#define EPI_ALIGN_PD1 true
#endif
#ifndef EPI_ALIGN_PA2
#define EPI_ALIGN_PA2 true
#endif
#ifndef REPEAT_PH
#define REPEAT_PH 0
#endif
#ifndef PH_MASK
#define PH_MASK 0xFFFF
#endif
#ifndef MIX_MASK
#define MIX_MASK 7
#endif
#define IN(k) true
#define EN(b) ((PH_MASK >> (b)) & 1)
#ifdef NO_CG_SYNC
#define SEAM(k) do { if (IN(k) && IN((k) + 1)) { GRID_BAR(); } } while (0)
#else
#define SEAM(k) do { if (IN(k) && IN((k) + 1)) { if ((k) == 0) grid.sync(); else GRID_BAR(); } } while (0)
#endif
#define WSP(type, off) ((type*)(ws + (off)))
#ifdef PROBE_TS_A
#define TS_PTR ((unsigned long long*)(kargs()->ws + WS_CTL + 40960))
#define TS_E0 ((volatile LAS unsigned long long*)(ldsl + LDS_MISC + 256))
#define TS_SET(i) do { if (l == 1 && threadIdx.x == 0) { if ((i) == 0) TS_E0[0] = (unsigned long long)__builtin_amdgcn_s_memrealtime(); else { const unsigned long long t_ = (unsigned long long)__builtin_amdgcn_s_memrealtime() - TS_E0[0]; atomicMax(TS_PTR + (i), t_); } } } while (0)
#define TS_MAX(i) do { if (l == 1 && threadIdx.x == 0) { const unsigned long long t_ = (unsigned long long)__builtin_amdgcn_s_memrealtime() - TS_E0[0]; atomicMax(TS_PTR + (i), t_); atomicMax(TS_PTR + (i) + 1, ~t_); } } while (0)
#else
#define TS_SET(i) do { } while (0)
#define TS_MAX(i) do { } while (0)
#endif

    if (EN(0) && IN(0)) { PHASE_VARS;
        convert_weights(0, lds, gw, NGW, wave, lane);
        KArgs kp = kargs(); unsigned char* ws = kp->ws; const int* positions = kp->positions; const float* x = kp->x; const float* g = kp->norm_pre;
        f32x2* ROPE = WSP(f32x2, WS_ROPE); bf16_t* HB = WSP(bf16_t, WS_HB);
        for (int i = bx * NTHREADS + tid; i < T * 16; i += G * NTHREADS) {
            const int t = i >> 4, j = i & 15; const float inv = exp2f(-(float)j * (13.287712379549449f / 16.0f));
            const float ang = (float)positions[t] * inv; const float k = rintf(ang * 0.15915494309189535f);
            float r = fmaf(-k, 6.2831854820251465f, ang); r = fmaf(-k, -1.7484555314695172e-7f, r);
            ROPE[i] = (f32x2){__cosf(r), __sinf(r)};
        }
        for (int m = gw; m < T; m += 4 * NGW) hb_rows4(x, g, HB, m, NGW, lane);
    }
    SEAM(0);
#ifdef EXTRA_SYNCS
    for (int i = 0; i < EXTRA_SYNCS; ++i) GRID_BAR();
#endif

    for (int l = 0; l < DEPTH; ++l) {
        const int P0 = 1 + l * PH_PER_LAYER;
        for (int rp = 0; rp < ((REPEAT_PH == 1) ? 2 : 1); ++rp) { if (rp) GRID_BAR();
        if (EN(1) && IN(P0 + 0)) {
            unsigned char* ws = kargs()->ws;
            pg8::PlainOrder S{(const char*)WSP(bf16_t, WS_HB), (const char*)WSP(bf16_t, WS_WIN), 1024, 1024, T / 256, NA / 256 + 1, G, bx, 0};
            EpiStore E{WSP(bf16_t, WS_PA), NA, ldsl, NA / 256, WSP(bf16_t, WS_YS)};
#ifdef STAGGER_US
            if (bx >= 128) { const unsigned long long t0_ = __builtin_amdgcn_s_memrealtime(); while (__builtin_amdgcn_s_memrealtime() - t0_ < (unsigned long long)(STAGGER_US * 100)) __builtin_amdgcn_s_sleep(8); }
#endif
            pg8::gemm_phase<EpiStore, pg8::PlainOrder, true>(ldsl, pg8::Gemm{1024, 1024, 1024}, S, E);
#ifdef PROBE_PA1NULL
#endif
        }
        }
        SEAM(P0 + 0);
        TS_SET(0);
        if (EN(2) && IN(P0 + 1)) { PHASE_VARS;
            if (bx >= RWKV_BLOCKS + GLA_BLOCKS) {
                unsigned char* ws = kargs()->ws; const int c2 = bx - RWKV_BLOCKS - GLA_BLOCKS;
                { const bf16_t* PA = WSP(bf16_t, WS_PA); const f32x2* ROPE = WSP(f32x2, WS_ROPE); float* RSTDQ = WSP(float, WS_RSTD); float* RSTDKV = RSTDQ + T; bf16_t* Kb = WSP(bf16_t, WS_K);
                  for (int m = c2 * NWAVES + wave; m < T; m += 4 * SUB_BLOCKS * NWAVES) mla_prep_rows4(PA, ROPE, RSTDQ, RSTDKV, Kb, m, SUB_BLOCKS * NWAVES, lane); }
                sub_barrier((unsigned*)(ws + WS_CTL) + 64 * 40, (unsigned)SUB_BLOCKS * (unsigned)(2 * l + 1));
                { pg8::PlainOrder S{(const char*)(WSP(bf16_t, WS_PA) + CQ), (const char*)WSP(bf16_t, WS_WUQ), NA, 256, T / 256, 3, SUB_BLOCKS, c2, 0};
                  EpiQ E{WSP(bf16_t, WS_Q), WSP(float, WS_RSTD), ldsl};
                  pg8::gemm_phase<EpiQ, pg8::PlainOrder, true>(ldsl, pg8::Gemm{NA, 256, 256}, S, E); }
                { pg8::PlainOrder S{(const char*)(WSP(bf16_t, WS_PA) + CKV), (const char*)WSP(bf16_t, WS_WUKV), NA, 256, T / 256, 4, SUB_BLOCKS, c2, 0};
                  EpiKV E{WSP(bf16_t, WS_K), WSP(bf16_t, WS_V), WSP(float, WS_RSTD) + T, ldsl};
                  pg8::gemm_phase<EpiKV, pg8::PlainOrder, true>(ldsl, pg8::Gemm{NA, 256, 256}, S, E); }
                sub_barrier((unsigned*)(kargs()->ws + WS_CTL) + 64 * 40, (unsigned)SUB_BLOCKS * (unsigned)(2 * l + 2));
            } else {
                if (bx >= RWKV_BLOCKS) { const int gi = bx - RWKV_BLOCKS; gla::gla_unit(l, gi >> 2, gi & 3, ldsl, (unsigned*)(kargs()->ws + WS_CTL) + 64 * (24 + l)); TS_MAX(12); }
                else {
#ifdef RWKV_TWICE
#pragma unroll 1
                for (int rep_ = 0; rep_ < RWKV_TWICE; ++rep_) { rwkv::rwkv_unit(l, bx >> 3, bx & 7, ldsl); __syncthreads(); }
#else
                rwkv::rwkv_unit(l, bx >> 3, bx & 7, ldsl);
#endif
                TS_MAX(8);
                }
                if (threadIdx.x == 0) { unsigned* cnt = (unsigned*)(kargs()->ws + WS_CTL) + 64 * 40; unsigned sp = 0;
                    while (__hip_atomic_load(cnt, __ATOMIC_RELAXED, __HIP_MEMORY_SCOPE_AGENT) < (unsigned)SUB_BLOCKS * (unsigned)(2 * l + 2) && ++sp < (1u << 24)) __builtin_amdgcn_s_sleep(2);
                    __builtin_amdgcn_fence(__ATOMIC_ACQUIRE, "agent"); asm volatile("s_waitcnt vmcnt(0)" ::: "memory"); }
                __syncthreads();
            }
        }
        if (EN(4) && IN(P0 + 3)) { PHASE_VARS;
            volatile LAS unsigned* qw = (volatile LAS unsigned*)(ldsl + LDS_MISC);
            for (;;) {
                __syncthreads();
                if (tid == 0) { unsigned* CTL = (unsigned*)(kargs()->ws + WS_CTL); qw[0] = atomicAdd(CTL + 64 * (1 + l), 1u); }
                __syncthreads();
                const int it = __builtin_amdgcn_readfirstlane((int)qw[0]);
                if (it >= N_MIX_ITEMS) break;
                { const int a = it; att::attn_unit((a & 63) >> 3, a & 7, (SEQ / 512 - 1) - (a >> 6), ldsl, (unsigned*)(kargs()->ws + WS_CTL) + 64 * (16 + l));  TS_MAX(10); }
            }
            { unsigned* ctl = (unsigned*)(kargs()->ws + WS_CTL);
              __syncthreads();
              if (tid == 0) { const unsigned tk = __hip_atomic_fetch_add(ctl + 64 * (20 + l), 1u, __ATOMIC_RELAXED, __HIP_MEMORY_SCOPE_AGENT); qw[0] = tk;
                  if (tk < (unsigned)MG_BLOCKS) { unsigned sp = 0; while (__hip_atomic_load(ctl + 64 * (16 + l), __ATOMIC_RELAXED, __HIP_MEMORY_SCOPE_AGENT) < (unsigned)N_ATT_UNITS && ++sp < (1u << 22)) __builtin_amdgcn_s_sleep(8); }
                  __builtin_amdgcn_fence(__ATOMIC_ACQUIRE, "agent"); asm volatile("s_waitcnt vmcnt(0)" ::: "memory"); }
              __syncthreads();
              const int tk = __builtin_amdgcn_readfirstlane((int)qw[0]);
              if (tk < MG_BLOCKS) TS_MAX(1);
              if (tk < MG_BLOCKS) {
                  unsigned char* ws = kargs()->ws;
                  pg8::PlainOrder S{(const char*)WSP(bf16_t, WS_HB), (const char*)(WSP(bf16_t, WS_WIN) + (size_t)(NA + 1536) * 1024), 1024, 1024, T / 256, 12, MG_BLOCKS, tk, 0};
                  EpiGateMG8 E{WSP(unsigned char, WS_SMG8), ldsl};
                  pg8::gemm_phase<EpiGateMG8, pg8::PlainOrder, true>(ldsl, pg8::Gemm{1024, 1024, 1024}, S, E);
                  TS_MAX(3);
                  __syncthreads();
                  if (tid == 0) { unsigned sp = 0; while (__hip_atomic_load(ctl + 64 * (24 + l), __ATOMIC_RELAXED, __HIP_MEMORY_SCOPE_AGENT) < 32u && ++sp < (1u << 22)) __builtin_amdgcn_s_sleep(8);
                      __builtin_amdgcn_fence(__ATOMIC_ACQUIRE, "agent"); asm volatile("s_waitcnt vmcnt(0)" ::: "memory"); }
                  __syncthreads();
                  pg8::PlainOrder S2{(const char*)WSP(bf16_t, WS_HB), (const char*)(WSP(bf16_t, WS_WIN) + (size_t)(NA + 256) * 1024), 1024, 1024, T / 256, 3, MG_BLOCKS, tk, 2, 0, -1, 1};
                  EpiGateBG E2{WSP(bf16_t, WS_YS), 1, 2, ldsl, 1};
                  pg8::gemm_phase<EpiGateBG, pg8::PlainOrder, true>(ldsl, pg8::Gemm{1024, 1024, 1024}, S2, E2);
                  TS_MAX(5);
              } }
        }
        SEAM(P0 + 3);
        TS_SET(7);
        if (EN(5) && IN(P0 + 4)) {
            unsigned char* ws = kargs()->ws;
            pg8::PlainOrder S{(const char*)WSP(bf16_t, WS_HB), (const char*)(WSP(bf16_t, WS_WIN) + (size_t)(NA + 512) * 1024), 1024, 1024, T / 256, 2, G, bx, 0};
            EpiGateBG E{WSP(bf16_t, WS_YS), 2, 0, ldsl};
            pg8::gemm_phase<EpiGateBG, pg8::PlainOrder, true>(ldsl, pg8::Gemm{1024, 1024, 1024}, S, E);
        }
        SEAM(P0 + 4);
        for (int rp = 0; rp < ((REPEAT_PH == 6 && l == 0) ? 2 : 1); ++rp) { if (rp) GRID_BAR();
        if (EN(6) && IN(P0 + 5)) {
            unsigned char* ws = kargs()->ws;
            pg8::GroupOrder3 S{(const char*)WSP(bf16_t, WS_YS), (const char*)WSP(bf16_t, WS_WBO), 512, 512, T / 256, 4, G, bx, (size_t)T * 512 * 2, (size_t)1024 * 512 * 2};
            EpiMerge E{WSP(bf16_t, WS_MG), WSP(unsigned char, WS_SMG8), ldsl};
            pg8::gemm_phase<EpiMerge, pg8::GroupOrder3, EPI_ALIGN_PD1>(ldsl, pg8::Gemm{512, 512, 512}, S, E);
        }
        }
        SEAM(P0 + 5);
        for (int rp = 0; rp < ((REPEAT_PH == 7 && l == 0) ? 2 : 1); ++rp) { if (rp) GRID_BAR();
        if (EN(7) && IN(P0 + 6)) {
            unsigned char* ws = kargs()->ws;
            pg8::PlainOrder S{(const char*)WSP(bf16_t, WS_MG), (const char*)WSP(bf16_t, WS_WOUT), 1024, 1024, T / 256, 4, G, bx, 0};
            EpiStore E{WSP(bf16_t, WS_OF), 1024, ldsl};
            pg8::gemm_phase<EpiStore, pg8::PlainOrder, true>(ldsl, pg8::Gemm{1024, 1024, 1024}, S, E);
        }
        }
        SEAM(P0 + 6);
        if (EN(8) && IN(P0 + 7)) { PHASE_VARS;
            const bool more = (l + 1 < DEPTH);
            if (more) convert_weights(l + 1, lds, gw, NGW, wave, lane);
            KArgs kp = kargs(); unsigned char* ws = kp->ws; float* out = kp->out; const float* xold = (l == 0) ? kp->x : out; const float* gpost = kp->norm_post + l * DM; const float* gnext = more ? kp->norm_pre + (l + 1) * DM : nullptr;
            const bf16_t* OF = WSP(bf16_t, WS_OF); bf16_t* HB = WSP(bf16_t, WS_HB);
#define PD3_LOOP(XI, XO) for (int m = gw; m < T; m += 4 * NGW) { RowIn<XI> rr_[4];     \
                _Pragma("unroll") for (int q_ = 0; q_ < 4; ++q_) final_load<XI>(rr_[q_], OF + (size_t)(m + q_ * NGW) * DM, xold + (size_t)(m + q_ * NGW) * DM, lane); \
                _Pragma("unroll") for (int q_ = 0; q_ < 4; ++q_) final_row<XI, XO>(rr_[q_], gpost, out + (size_t)(m + q_ * NGW) * DM, gnext, HB + (size_t)(m + q_ * NGW) * DM, lane); }
            if (l == 0) { if (more) { PD3_LOOP(false, true) } else { PD3_LOOP(false, false) } }
            else        { if (more) { PD3_LOOP(true, true) } else { PD3_LOOP(true, false) } }
#undef PD3_LOOP
        }
        if (l + 1 < DEPTH) SEAM(P0 + 7);
    }
#ifdef PROBE_TS_A
    if (bx == 0 && threadIdx.x == 0) {
        auto val = [&](int i) { unsigned long long v = __hip_atomic_load(TS_PTR + i, __ATOMIC_RELAXED, __HIP_MEMORY_SCOPE_AGENT); return (i == 2 || i == 4 || i == 6 || i == 9 || i == 11 || i == 13) ? ~v : v; };
        const unsigned long long d = val(PROBE_TS_A) - val(PROBE_TS_B);
        const unsigned long long t0_ = __builtin_amdgcn_s_memrealtime();
        if (d < 400000ull) while ((unsigned long long)__builtin_amdgcn_s_memrealtime() - t0_ < (unsigned long long)PROBE_TS_K * d) __builtin_amdgcn_s_sleep(8);
    }
#endif
#undef IN
#undef EN
#undef SEAM
#undef WSP
#undef PHASE_VARS
#undef G
#undef bx
#undef NGW
}

extern "C" void kernel_launch(void* const* d_in, const int* in_sizes, int n_in, void* d_out, int out_size, void* d_ws, size_t ws_size, hipStream_t stream) {
    static int grid = 0;
    if (grid == 0) {
        if (n_in != 24 || in_sizes[0] != T * DM || out_size != T * DM || ws_size < WS_END) {
            fprintf(stderr, "kernel_launch: unexpected shapes (n_in %d, in0 %d, out %d, ws %zu; need ws >= %zu); nothing launched\n", n_in, n_in > 0 ? in_sizes[0] : -1, out_size, ws_size, (size_t)WS_END);
            grid = -1; return; }
        int dev = 0, cus = 0, per_cu = 0;
        (void)hipGetDevice(&dev); (void)hipDeviceGetAttribute(&cus, hipDeviceAttributeMultiprocessorCount, dev);
        if (hipFuncSetAttribute((const void*)hybrid_fwd, hipFuncAttributeMaxDynamicSharedMemorySize, LDS_BYTES) != hipSuccess) { fprintf(stderr, "kernel_launch: hipFuncSetAttribute failed\n"); grid = -1; return; }
        if (hipOccupancyMaxActiveBlocksPerMultiprocessor(&per_cu, (const void*)hybrid_fwd, NTHREADS, LDS_BYTES) != hipSuccess || per_cu < 1) {
            fprintf(stderr, "kernel_launch: occupancy query reports %d blocks per CU\n", per_cu); per_cu = 1; }
        (void)hipGetLastError();
        grid = cus * (per_cu < 1 ? 1 : 1);
        fprintf(stderr, "kernel_launch: grid %d (cus %d, occupancy %d), ws %zu\n", grid, cus, per_cu, ws_size);
    }
    if (grid < 0) return;
    (void)hipMemsetAsync((char*)d_ws + WS_CTL, 0, 65536, stream);
    Params p{};
    p.x = (const float*)d_in[0]; p.positions = (const int*)d_in[1]; p.norm_pre = (const float*)d_in[2]; p.w_in = (const float*)d_in[3]; p.mla_q_norm = (const float*)d_in[4]; p.mla_kv_norm = (const float*)d_in[5];
    p.mla_w_uq = (const float*)d_in[6]; p.mla_w_ukv = (const float*)d_in[7]; p.rwkv_mu = (const float*)d_in[8]; p.rwkv_w0 = (const float*)d_in[9]; p.rwkv_w_up = (const float*)d_in[10]; p.rwkv_a0 = (const float*)d_in[11];
    p.rwkv_a_up = (const float*)d_in[12]; p.rwkv_k_k = (const float*)d_in[13]; p.rwkv_k_a = (const float*)d_in[14]; p.rwkv_r_k = (const float*)d_in[15]; p.rwkv_ln_w = (const float*)d_in[16]; p.rwkv_ln_b = (const float*)d_in[17];
    p.gla_a_up = (const float*)d_in[18]; p.gla_a_b = (const float*)d_in[19]; p.gla_norm = (const float*)d_in[20]; p.w_branch_out = (const float*)d_in[21]; p.w_out = (const float*)d_in[22]; p.norm_post = (const float*)d_in[23];
    p.out = (float*)d_out; p.ws = (unsigned char*)d_ws;
#if MK_MULTI_LAUNCH
    for (int ph = 0; ph < N_PHASES; ++ph) { p.ph_lo = ph; p.ph_hi = ph + 1; void* args[] = {&p};
        hipError_t e = hipLaunchCooperativeKernel((const void*)hybrid_fwd, dim3(grid), dim3(NTHREADS), args, LDS_BYTES, stream);
        if (e != hipSuccess) { fprintf(stderr, "kernel_launch: launch of phase %d failed: %s\n", ph, hipGetErrorString(e)); break; } }
#else
    p.ph_lo = 0; p.ph_hi = N_PHASES; void* args[] = {&p};
    hipError_t e = hipLaunchCooperativeKernel((const void*)hybrid_fwd, dim3(grid), dim3(NTHREADS), args, LDS_BYTES, stream);
    if (e != hipSuccess) fprintf(stderr, "kernel_launch: cooperative launch failed: %s (grid %d)\n", hipGetErrorString(e), grid);
#endif
}
```

```cpp
#include <hip/hip_runtime.h>
#include <hip/hip_cooperative_groups.h>
#include <cstdio>
#include <cstdint>
#include <cmath>
namespace cg = cooperative_groups;
#define U_P5 1
#define U_P7 1
#define V_A 1
#define V_B 1
#define V_V 1
#define NO_CG_SYNC 1
namespace pg8 {
#define PG8_LAS __attribute__((address_space(3)))
typedef unsigned short bf16_t;
typedef short bf16x8 __attribute__((ext_vector_type(8)));
typedef float f32x4 __attribute__((ext_vector_type(4)));
typedef unsigned u32x4 __attribute__((ext_vector_type(4)));
typedef unsigned u32x2 __attribute__((ext_vector_type(2)));
constexpr int BM = 256, BK = 64, HALF = 128, HTB = HALF * BK * 2  , STAGE_BYTES = 8 * HTB, NXCD = 8, WGM = 8;

__host__ __device__ __forceinline__ int lds_byte(int r, int c) { const int st = (r >> 4) * 2 + (c >> 5), rr = r & 15, cc = c & 31, ob = rr * 64 + cc * 2; return st * 1024 + (ob ^ (((ob >> 9) & 1) << 5)); }
__host__ __device__ __forceinline__ void stage_rc(int b, int& R, int& C) { const int st = b / 1024, sb = b % 1024, swz = sb ^ (((sb >> 9) & 1) << 5); R = (st >> 1) * 16 + swz / 64; C = (st & 1) * 32 + (swz % 64) / 2; }
__host__ __device__ __forceinline__ int perm32(int rho) { const int n = rho >> 4, i = rho & 15; return 8 * (i >> 2) + 4 * n + (i & 3); }

struct Unit { int pm, pn, aux; const char* A; const char* B; };
struct Gemm { int lda, ldb, K; };

__device__ __forceinline__ void tile_of(int L, int nM, int nN, int& pm, int& pn) {
    const int nwg = nM * nN; int wgid = L;
    { const int q = nwg / NXCD, r = nwg % NXCD, xcd = wgid % NXCD, off = wgid / NXCD; wgid = (xcd < r ? xcd * (q + 1) : r * (q + 1) + (xcd - r) * q) + off; }
    const int nig = WGM * nN, gid = wgid / nig, fm = gid * WGM, gsz = (nM - fm) < WGM ? (nM - fm) : WGM;
    pm = fm + ((wgid % nig) % gsz); pn = (wgid % nig) / gsz;
}
struct PlainOrder {
    const char* A; const char* Bt; int lda, ldb, nM, nN, G, c, bskip;
    int base = 0, cnt = -1;
    int bth = 2;
    __device__ __forceinline__ bool next(int i, Unit& u) const {
        const long Lr = (long)i * G + c; if (Lr >= (long)(cnt >= 0 ? cnt : nM * nN)) return false;
        const long L = Lr + base;
        tile_of((int)L, nM, nN, u.pm, u.pn); u.aux = 0;
        u.A = A + (size_t)u.pm * BM * lda * 2; u.B = Bt + (size_t)(u.pn + ((u.pn >= bth) ? bskip : 0)) * BM * ldb * 2; return true;
    }
};
struct GroupOrder3 {
    const char* A; const char* Bt; int lda, ldb, nM, nN, G, c; size_t a_gstride, b_gstride;
    __device__ __forceinline__ bool next(int i, Unit& u) const {
        const int n = i % 3; const long L = (long)(i / 3) * G + c; if (L >= (long)nM * nN) return false;
        tile_of((int)L, nM, nN, u.pm, u.pn); u.aux = n;
        u.A = A + n * a_gstride + (size_t)u.pm * BM * lda * 2; u.B = Bt + n * b_gstride + (size_t)u.pn * BM * ldb * 2; return true;
    }
};

template <class Epi, class Sched, bool ALIGN_EPI>
__device__ __forceinline__ void gemm_phase(PG8_LAS unsigned char* lds, const Gemm g, const Sched& S, const Epi& E) {
    int tid_ = threadIdx.x; asm volatile("" : "+v"(tid_));
    const int tid = tid_, wid = __builtin_amdgcn_readfirstlane(tid >> 6), lane = tid & 63, wr = wid >> 2, wc = wid & 3, fr = lane & 15, fq = lane >> 4;
    const int K = g.K, nt = K / BK;
    unsigned voffA[2], voffB[2];
#pragma unroll
    for (int i = 0; i < 2; ++i) { int R, C; stage_rc(tid * 16 + i * 8192, R, C); const int Rb = (int)Epi::PERM == 2 ? (64 * (R >> 5) + perm32(R & 31)) : (int)Epi::PERM == 1 ? ((R & ~31) + perm32(R & 31)) : R;
        voffA[i] = (unsigned)(R * g.lda + C) * 2u; voffB[i] = (unsigned)(Rb * g.ldb + C) * 2u; }
    const size_t kstep = (size_t)(BK * 2);
    const size_t hstepA = (size_t)HALF * g.lda * 2, hstepB = (size_t)((int)Epi::PERM == 2 ? 32 : HALF) * g.ldb * 2;
    const unsigned ldsw = (unsigned)wid * 1024u;
    const int aoff = lds_byte(wr * 64 + fr, fq * 8), boff = lds_byte(wc * 32 + fr, fq * 8);
#define PG8_SA(b, h) (((b) * 2 + (h)) * HTB)
#define PG8_SB(b, h) ((4 + (b) * 2 + (h)) * HTB)
#define PG8_STAGE(bufoff, gbase, voff) do { _Pragma("unroll") for (int _i = 0; _i < 2; ++_i) \
        __builtin_amdgcn_global_load_lds((const unsigned*)((const char*)(gbase) + (voff)[_i]), (PG8_LAS unsigned*)(lds + (bufoff) + ldsw + _i * 8192), 16, 0, 0); } while (0)
#define PG8_LDA(dst, b, h) do { _Pragma("unroll") for (int m = 0; m < 4; ++m) _Pragma("unroll") for (int k = 0; k < 2; ++k) dst[m][k] = *(const PG8_LAS bf16x8*)(lds + PG8_SA(b, h) + aoff + m * 2048 + k * 1024); } while (0)
#define PG8_LDB(dst, b, h) do { _Pragma("unroll") for (int n = 0; n < 2; ++n) _Pragma("unroll") for (int k = 0; k < 2; ++k) dst[n][k] = *(const PG8_LAS bf16x8*)(lds + PG8_SB(b, h) + boff + n * 2048 + k * 1024); } while (0)
#define PG8_MMA(ai, bj, At, Bt) do { __builtin_amdgcn_s_setprio(1); _Pragma("unroll") for (int m = 0; m < 4; ++m) _Pragma("unroll") for (int n = 0; n < 2; ++n) _Pragma("unroll") for (int k = 0; k < 2; ++k) \
        acc[ai][bj][m][n] = __builtin_amdgcn_mfma_f32_16x16x32_bf16(Bt[n][k], At[m][k], acc[ai][bj][m][n], 0, 0, 0); __builtin_amdgcn_s_setprio(0); } while (0)
#define PG8_WAIT_V(n) asm volatile("s_waitcnt vmcnt(" #n ")" ::: "memory")
#define PG8_WAIT_L(n) asm volatile("s_waitcnt lgkmcnt(" #n ")" ::: "memory")
#define PG8_BAR __builtin_amdgcn_s_barrier()
#define PG8_SCHED __builtin_amdgcn_sched_barrier(0)
    Unit cur, nxt; int ui = 0;
    if (!S.next(0, cur)) return;
    f32x4 acc[2][2][4][2];
#pragma unroll
    for (int a = 0; a < 2; ++a)
#pragma unroll
        for (int b = 0; b < 2; ++b)
#pragma unroll
            for (int m = 0; m < 4; ++m)
#pragma unroll
                for (int n = 0; n < 2; ++n) acc[a][b][m][n] = (f32x4){0.f, 0.f, 0.f, 0.f};
    bf16x8 At[4][2], B0[2][2], B1[2][2];
    const char* cA = cur.A; const char* cB = cur.B;
    PG8_STAGE(PG8_SB(0, 0), cB, voffB); PG8_STAGE(PG8_SB(0, 1), cB + hstepB, voffB); PG8_STAGE(PG8_SA(0, 0), cA, voffA); PG8_STAGE(PG8_SA(0, 1), cA + hstepA, voffA);
    if (wr == 1) PG8_BAR;
    PG8_WAIT_V(2); PG8_BAR;
    PG8_STAGE(PG8_SB(1, 0), cB + kstep, voffB); PG8_STAGE(PG8_SA(1, 0), cA + kstep, voffA); PG8_STAGE(PG8_SB(1, 1), cB + hstepB + kstep, voffB);
    PG8_WAIT_V(6); PG8_BAR;
    for (;;) {
        const bool has_next = S.next(ui + 1, nxt);
        const char* nA = has_next ? nxt.A : cA; const char* nB = has_next ? nxt.B : cB;
#pragma unroll 1
        for (int t = 0; t < nt; t += 2) {
            const bool last = (t == nt - 2);
            const char* a1 = cA + (size_t)(t + 1) * kstep;
            const char* a2 = last ? nA : cA + (size_t)(t + 2) * kstep; const char* b2 = last ? nB : cB + (size_t)(t + 2) * kstep;
            const char* a3 = a2 + kstep; const char* b3 = b2 + kstep;
            PG8_LDB(B0, 0, 0); PG8_LDB(B1, 0, 1); PG8_SCHED; PG8_LDA(At, 0, 0); PG8_STAGE(PG8_SA(1, 1), a1 + hstepA, voffA);
            PG8_WAIT_V(8); PG8_WAIT_L(0); PG8_BAR; PG8_MMA(0, 0, At, B0); PG8_MMA(0, 1, At, B1); PG8_BAR; PG8_SCHED;
            PG8_LDA(At, 0, 1); PG8_STAGE(PG8_SB(0, 0), b2, voffB); PG8_STAGE(PG8_SB(0, 1), b2 + hstepB, voffB); PG8_STAGE(PG8_SA(0, 0), a2, voffA);
            PG8_WAIT_V(8); PG8_WAIT_L(0); PG8_BAR; PG8_MMA(1, 0, At, B0); PG8_MMA(1, 1, At, B1); PG8_BAR; PG8_SCHED;
            PG8_LDB(B0, 1, 0); PG8_LDB(B1, 1, 1); PG8_SCHED; PG8_LDA(At, 1, 0); PG8_STAGE(PG8_SA(0, 1), a2 + hstepA, voffA);
            PG8_WAIT_V(8); PG8_WAIT_L(0); PG8_BAR; PG8_MMA(0, 0, At, B0); PG8_MMA(0, 1, At, B1); PG8_BAR; PG8_SCHED;
            PG8_LDA(At, 1, 1); PG8_STAGE(PG8_SB(1, 0), b3, voffB); PG8_STAGE(PG8_SB(1, 1), b3 + hstepB, voffB); PG8_STAGE(PG8_SA(1, 0), a3, voffA);
            PG8_WAIT_V(8); PG8_WAIT_L(0); PG8_BAR; PG8_MMA(1, 0, At, B0); PG8_MMA(1, 1, At, B1); PG8_BAR; PG8_SCHED;
        }
        if constexpr (ALIGN_EPI) { if (wr == 0) PG8_BAR; }
        E(acc, cur, wr, wc, fr, fq);
        if (!has_next) break;
#pragma unroll
        for (int a = 0; a < 2; ++a)
#pragma unroll
            for (int b = 0; b < 2; ++b)
#pragma unroll
                for (int m = 0; m < 4; ++m)
#pragma unroll
                    for (int n = 0; n < 2; ++n) acc[a][b][m][n] = (f32x4){0.f, 0.f, 0.f, 0.f};
        cur = nxt; cA = nA; cB = nB; ++ui;
        if constexpr (ALIGN_EPI) { if (wr == 1) PG8_BAR; }
    }
    PG8_WAIT_V(0);
    if constexpr (!ALIGN_EPI) { if (wr == 0) PG8_BAR; }
    PG8_BAR;
#undef PG8_SA
#undef PG8_SB
#undef PG8_STAGE
#undef PG8_LDA
#undef PG8_LDB
#undef PG8_MMA
#undef PG8_WAIT_V
#undef PG8_WAIT_L
#undef PG8_BAR
#undef PG8_SCHED
}
}
#define LAS __attribute__((address_space(3)))
typedef unsigned short bf16_t;
typedef short bf16x8 __attribute__((ext_vector_type(8)));
typedef short s16x4 __attribute__((ext_vector_type(4)));
typedef float f32x4 __attribute__((ext_vector_type(4)));
typedef float f32x2 __attribute__((ext_vector_type(2)));
typedef float f32x16 __attribute__((ext_vector_type(16)));
typedef unsigned u32x4 __attribute__((ext_vector_type(4)));
typedef unsigned u32x2 __attribute__((ext_vector_type(2)));
typedef __bf16 bf16x2_t __attribute__((ext_vector_type(2)));

constexpr int BATCH = 8, SEQ = 4096, DM = 1024, T = BATCH * SEQ, DEPTH = 2;
constexpr int N_IN = 7728, NA = 3328, NG = 4608, NALL = NA + NG;
constexpr int CQ = 0, CKV = 256, KROPE = 384, GLAT = 416, RW_R = 512, RW_K = 1024, RW_V = 1536, RW_LW = 2048, RW_LA = 2112, GQ = 2304, GK = 2560, GV = 2816;
constexpr int KP = 544;
constexpr float NORM_EPS = 1e-6f, RWKV_GN_EPS = 64e-5f;
constexpr float QSCALE = 0.10206207261596577f * 1.4426950408889634f;

constexpr size_t MiB = 1u << 20;
constexpr size_t WS_CTL = 0;
constexpr size_t WS_ROPE = 1 * MiB;
constexpr size_t WS_RSTD = 5 * MiB;
constexpr size_t WS_WIN = 6 * MiB;
constexpr size_t WS_WBO = WS_WIN + (size_t)NALL * 1024 * 2;
constexpr size_t WS_WOUT = WS_WBO + 3 * MiB;
constexpr size_t WS_WUQ = WS_WOUT + 2 * MiB;
constexpr size_t WS_WUKV = WS_WUQ + 768 * 256 * 2;
constexpr size_t WS_HB = 28 * MiB;
constexpr size_t WS_PA = 92 * MiB;
constexpr size_t WS_Q = 300 * MiB;
constexpr size_t WS_K = 348 * MiB;
constexpr size_t WS_V = 382 * MiB;
constexpr size_t WS_YS = 414 * MiB;
constexpr size_t WS_SMG8 = WS_Q;
constexpr size_t WS_MG = WS_PA, WS_OF = WS_PA + 64 * MiB;
constexpr size_t WS_END = 510 * MiB;
static_assert(WS_WUKV + 1024 * 256 * 2 <= WS_HB, "weights fit");

__device__ __forceinline__ unsigned pk2(float lo, float hi) { f32x2 v = {lo, hi}; bf16x2_t b = __builtin_convertvector(v, bf16x2_t); return __builtin_bit_cast(unsigned, b); }
__device__ __forceinline__ float bflo(unsigned w) { return __uint_as_float(w << 16); }
__device__ __forceinline__ float bfhi(unsigned w) { return __uint_as_float(w & 0xffff0000u); }
__device__ __forceinline__ float bf2f(bf16_t b) { return __uint_as_float((unsigned)b << 16); }
__device__ __forceinline__ bf16_t f2bf(float f) { return (bf16_t)(pk2(f, 0.f) & 0xffffu); }
__device__ __forceinline__ float wave_sum(float v) {
#pragma unroll
    for (int o = 1; o < 64; o <<= 1) v += __shfl_xor(v, o);
    return v;
}
__device__ __forceinline__ float fast_exp(float x) { return __builtin_amdgcn_exp2f(x * 1.4426950408889634f); }
__device__ __forceinline__ float fast_sigmoid(float x) { return __builtin_amdgcn_rcpf(1.0f + fast_exp(-x)); }
template <int CTRL> __device__ __forceinline__ float dpp_f(float x) { return __int_as_float(__builtin_amdgcn_update_dpp(0, __float_as_int(x), CTRL, 0xf, 0xf, false)); }
__device__ __forceinline__ float sum8(float x) { x += dpp_f<0xB1>(x); x += dpp_f<0x4E>(x); x += dpp_f<0x141>(x); return x; }
__device__ __forceinline__ float sum16(float x) { x += dpp_f<0xB1>(x); x += dpp_f<0x4E>(x); x += dpp_f<0x141>(x); x += dpp_f<0x140>(x); return x; }

struct Params {
    const float* x; const int* positions; const float* norm_pre; const float* w_in; const float* mla_q_norm; const float* mla_kv_norm; const float* mla_w_uq; const float* mla_w_ukv;
    const float* rwkv_mu; const float* rwkv_w0; const float* rwkv_w_up; const float* rwkv_a0; const float* rwkv_a_up; const float* rwkv_k_k; const float* rwkv_k_a; const float* rwkv_r_k;
    const float* rwkv_ln_w; const float* rwkv_ln_b; const float* gla_a_up; const float* gla_a_b; const float* gla_norm; const float* w_branch_out; const float* w_out; const float* norm_post;
    float* out; unsigned char* ws; int ph_lo, ph_hi;
};

typedef const __attribute__((address_space(4))) Params* KArgs;
__device__ __forceinline__ KArgs kargs() { KArgs kp = (KArgs)__builtin_amdgcn_kernarg_segment_ptr(); asm volatile("" : "+s"(kp)); return kp; }

__device__ __forceinline__ Params load_params() { Params p{}; KArgs kp = kargs(); p.x = kp->x; p.positions = kp->positions; p.norm_pre = kp->norm_pre; p.w_in = kp->w_in; p.mla_q_norm = kp->mla_q_norm; p.mla_kv_norm = kp->mla_kv_norm; p.mla_w_uq = kp->mla_w_uq; p.mla_w_ukv = kp->mla_w_ukv; p.rwkv_mu = kp->rwkv_mu; p.rwkv_w0 = kp->rwkv_w0; p.rwkv_w_up = kp->rwkv_w_up; p.rwkv_a0 = kp->rwkv_a0; p.rwkv_a_up = kp->rwkv_a_up; p.rwkv_k_k = kp->rwkv_k_k; p.rwkv_k_a = kp->rwkv_k_a; p.rwkv_r_k = kp->rwkv_r_k; p.rwkv_ln_w = kp->rwkv_ln_w; p.rwkv_ln_b = kp->rwkv_ln_b; p.gla_a_up = kp->gla_a_up; p.gla_a_b = kp->gla_a_b; p.gla_norm = kp->gla_norm; p.w_branch_out = kp->w_branch_out; p.w_out = kp->w_out; p.norm_post = kp->norm_post; p.out = kp->out; p.ws = kp->ws; p.ph_lo = kp->ph_lo; p.ph_hi = kp->ph_hi; return p; }
__device__ __forceinline__ int opaque_tid() { int t = threadIdx.x; asm volatile("" : "+v"(t)); return t; }

using pg8::Unit;
constexpr int EPI_SCR = 131072, EPI_SCR_WAVE = 2304, EPI_PITCH = 144;
struct EpiGeo { LAS unsigned char* wp; const LAS unsigned char* rp; int r8, p8; };
__device__ __forceinline__ EpiGeo epi_geo(LAS unsigned char* lds, int wr, int wc, int fr, int fq) {
    LAS unsigned char* scr = lds + EPI_SCR + (wr * 4 + wc) * EPI_SCR_WAVE; const int lane = fq * 16 + fr;
    return EpiGeo{scr + fr * EPI_PITCH + fq * 16, scr + (lane >> 3) * EPI_PITCH + (lane & 7) * 16, lane >> 3, lane & 7};
}
__device__ __forceinline__ void epi_xpose(const EpiGeo& g, const u32x4 w0, const u32x4 w1, u32x4& r0, u32x4& r1) {
    *(LAS u32x4*)g.wp = w0; *(LAS u32x4*)(g.wp + 64) = w1;
    asm volatile("" ::: "memory");
    r0 = *(const LAS u32x4*)g.rp; r1 = *(const LAS u32x4*)(g.rp + 8 * EPI_PITCH);
    asm volatile("" ::: "memory");
}
__device__ __forceinline__ u32x4 pack8(const f32x4 v0, const f32x4 v1) { u32x4 w; w.x = pk2(v0[0], v0[1]); w.y = pk2(v0[2], v0[3]); w.z = pk2(v1[0], v1[1]); w.w = pk2(v1[2], v1[3]); return w; }
__device__ __forceinline__ f32x4 silu4(const f32x4 a) { f32x4 r; r[0] = fast_sigmoid(a[0]) * a[0]; r[1] = fast_sigmoid(a[1]) * a[1]; r[2] = fast_sigmoid(a[2]) * a[2]; r[3] = fast_sigmoid(a[3]) * a[3]; return r; }
struct EpiStore {
    static constexpr int PERM = 2; bf16_t* O; int ldc; LAS unsigned char* lds; int gt = -1; bf16_t* YG = nullptr;
    __device__ __forceinline__ void operator()(const f32x4 (&acc)[2][2][4][2], const Unit& u, int wr, int wc, int fr, int fq) const {
        const EpiGeo G = epi_geo(lds, wr, wc, fr, fq);
        if (u.pn == gt) {
            bf16_t* gq = YG + (size_t)(u.pm * 256 + wr * 64 + G.r8) * 512 + wc * 64 + G.p8 * 8;
#pragma unroll
            for (int ai = 0; ai < 2; ++ai)
#pragma unroll
                for (int m = 0; m < 4; ++m) { u32x4 r0, r1; epi_xpose(G, pack8(silu4(acc[ai][0][m][0]), silu4(acc[ai][0][m][1])), pack8(silu4(acc[ai][1][m][0]), silu4(acc[ai][1][m][1])), r0, r1);
                    bf16_t* g = gq + (size_t)(ai * 128 + m * 16) * 512;
                    *(u32x4*)g = r0; *(u32x4*)(g + (size_t)8 * 512) = r1; }
            return; }
        bf16_t* gp = O + (size_t)(u.pm * 256 + wr * 64 + G.r8) * ldc + u.pn * 256 + wc * 64 + G.p8 * 8;
#pragma unroll
        for (int ai = 0; ai < 2; ++ai)
#pragma unroll
            for (int m = 0; m < 4; ++m) { u32x4 r0, r1; epi_xpose(G, pack8(acc[ai][0][m][0], acc[ai][0][m][1]), pack8(acc[ai][1][m][0], acc[ai][1][m][1]), r0, r1);
                bf16_t* g = gp + (size_t)(ai * 128 + m * 16) * ldc;
                *(u32x4*)g = r0; *(u32x4*)(g + (size_t)8 * ldc) = r1; }
    }
};
struct EpiQ {
    static constexpr int PERM = 2; bf16_t* Q; const float* rstd; LAS unsigned char* lds;
    __device__ __forceinline__ void operator()(const f32x4 (&acc)[2][2][4][2], const Unit& u, int wr, int wc, int fr, int fq) const {
        const EpiGeo G = epi_geo(lds, wr, wc, fr, fq);
        const int row0 = u.pm * 256 + wr * 64 + fr;
        float rsv[2][4];
#pragma unroll
        for (int ai = 0; ai < 2; ++ai)
#pragma unroll
            for (int m = 0; m < 4; ++m) rsv[ai][m] = rstd[row0 + ai * 128 + m * 16];
        bf16_t* gp = Q + (size_t)(u.pm * 256 + wr * 64 + G.r8) * 768 + u.pn * 256 + wc * 64 + G.p8 * 8;
#pragma unroll
        for (int ai = 0; ai < 2; ++ai)
#pragma unroll
            for (int m = 0; m < 4; ++m) { const float rs = rsv[ai][m] * QSCALE; u32x4 r0, r1;
                epi_xpose(G, pack8(acc[ai][0][m][0] * rs, acc[ai][0][m][1] * rs), pack8(acc[ai][1][m][0] * rs, acc[ai][1][m][1] * rs), r0, r1);
                bf16_t* g = gp + (size_t)(ai * 128 + m * 16) * 768;
                *(u32x4*)g = r0; *(u32x4*)(g + (size_t)8 * 768) = r1; }
    }
};
struct EpiKV {
    static constexpr int PERM = 2; bf16_t* Kb; bf16_t* Vb; const float* rstd; LAS unsigned char* lds;
    __device__ __forceinline__ void operator()(const f32x4 (&acc)[2][2][4][2], const Unit& u, int wr, int wc, int fr, int fq) const {
        const EpiGeo G = epi_geo(lds, wr, wc, fr, fq);
        const int row0 = u.pm * 256 + wr * 64 + fr; const bool isv = u.pn >= 2; const int ldc = isv ? 512 : KP;
        float rsv[2][4];
#pragma unroll
        for (int ai = 0; ai < 2; ++ai)
#pragma unroll
            for (int m = 0; m < 4; ++m) rsv[ai][m] = rstd[row0 + ai * 128 + m * 16];
        bf16_t* gp = (isv ? Vb : Kb) + (size_t)(u.pm * 256 + wr * 64 + G.r8) * ldc + (u.pn & 1) * 256 + wc * 64 + G.p8 * 8;
#pragma unroll
        for (int ai = 0; ai < 2; ++ai)
#pragma unroll
            for (int m = 0; m < 4; ++m) { const float rs = rsv[ai][m]; u32x4 r0, r1;
                epi_xpose(G, pack8(acc[ai][0][m][0] * rs, acc[ai][0][m][1] * rs), pack8(acc[ai][1][m][0] * rs, acc[ai][1][m][1] * rs), r0, r1);
                bf16_t* g = gp + (size_t)(ai * 128 + m * 16) * ldc;
                *(u32x4*)g = r0; *(u32x4*)(g + (size_t)8 * ldc) = r1; }
    }
};
__device__ __forceinline__ unsigned q8(float s) { return (unsigned)(s * 255.0f + 0.5f); }
struct EpiGateBG {
    static constexpr int PERM = 2; bf16_t* YS; int pn0, skip; LAS unsigned char* lds; int th = 2;
    __device__ __forceinline__ void operator()(const f32x4 (&acc)[2][2][4][2], const Unit& u, int wr, int wc, int fr, int fq) const {
        const int pn = pn0 + u.pn + ((u.pn >= th) ? skip : 0);
        const EpiGeo G = epi_geo(lds, wr, wc, fr, fq);
        bf16_t* gp = YS + (size_t)(pn >> 1) * T * 512 + (size_t)(u.pm * 256 + wr * 64 + G.r8) * 512 + (pn & 1) * 256 + wc * 64 + G.p8 * 8;
#pragma unroll
        for (int ai = 0; ai < 2; ++ai) {
            u32x4 y[4][2];
#pragma unroll
            for (int m = 0; m < 4; ++m)
#pragma unroll
                for (int h = 0; h < 2; ++h) y[m][h] = *(const u32x4*)(gp + (size_t)(ai * 128 + m * 16 + 8 * h) * 512);
#pragma unroll
            for (int m = 0; m < 4; ++m) { u32x4 r[2];
                epi_xpose(G, pack8(silu4(acc[ai][0][m][0]), silu4(acc[ai][0][m][1])), pack8(silu4(acc[ai][1][m][0]), silu4(acc[ai][1][m][1])), r[0], r[1]);
#pragma unroll
                for (int h = 0; h < 2; ++h) { const u32x4 yy = y[m][h], gg = r[h];
                    u32x4 w; w.x = pk2(bflo(gg.x) * bflo(yy.x), bfhi(gg.x) * bfhi(yy.x)); w.y = pk2(bflo(gg.y) * bflo(yy.y), bfhi(gg.y) * bfhi(yy.y));
                    w.z = pk2(bflo(gg.z) * bflo(yy.z), bfhi(gg.z) * bfhi(yy.z)); w.w = pk2(bflo(gg.w) * bflo(yy.w), bfhi(gg.w) * bfhi(yy.w));
                    *(u32x4*)(gp + (size_t)(ai * 128 + m * 16 + 8 * h) * 512) = w; } }
        }
    }
};
struct EpiGateMG8 {
    static constexpr int PERM = 2; unsigned char* SMG; LAS unsigned char* lds;
    __device__ __forceinline__ void operator()(const f32x4 (&acc)[2][2][4][2], const Unit& u, int wr, int wc, int fr, int fq) const {
        LAS unsigned char* scr = lds + EPI_SCR + (wr * 4 + wc) * EPI_SCR_WAVE; const int lane = fq * 16 + fr;
        LAS unsigned char* wp = scr + fr * 72 + fq * 8; const LAS unsigned char* rp = scr + (lane >> 2) * 72 + (lane & 3) * 16;
        unsigned char* gp = SMG + (size_t)((u.pm * 256 + wr * 64) >> 1) * 6144 + (size_t)(lane >> 3) * 6144 + (u.pn * 4 + wc) * 128 + ((lane >> 2) & 1) * 64 + (lane & 3) * 16;
#pragma unroll
        for (int ai = 0; ai < 2; ++ai)
#pragma unroll
            for (int m = 0; m < 4; ++m) {
#pragma unroll
                for (int bj = 0; bj < 2; ++bj) { const f32x4 a0 = acc[ai][bj][m][0], a1 = acc[ai][bj][m][1];
                    u32x2 w = {0u, 0u};
#pragma unroll
                    for (int j = 0; j < 4; ++j) { w.x = __builtin_amdgcn_cvt_pk_u8_f32(255.0f * fast_sigmoid(a0[j]), j, w.x); w.y = __builtin_amdgcn_cvt_pk_u8_f32(255.0f * fast_sigmoid(a1[j]), j, w.y); }
                    *(LAS u32x2*)(wp + bj * 32) = w; }
                asm volatile("" ::: "memory");
                const u32x2 ra = *(const LAS u32x2*)rp, rb = *(const LAS u32x2*)(rp + 8);
                asm volatile("" ::: "memory");
                *(u32x4*)(gp + (size_t)(ai * 64 + m * 8) * 6144) = (u32x4){ra.x, ra.y, rb.x, rb.y}; }
    }
};
struct EpiMerge {
    static constexpr int PERM = 2; bf16_t* MG; const unsigned char* SMG; LAS unsigned char* lds;
    __device__ __forceinline__ void operator()(const f32x4 (&acc)[2][2][4][2], const Unit& u, int wr, int wc, int fr, int fq) const {
        const EpiGeo G = epi_geo(lds, wr, wc, fr, fq); const int n = u.aux; constexpr float S = 1.0f / 255.0f;
        const size_t rowb = (size_t)(u.pm * 256 + wr * 64 + G.r8); const int colb = u.pn * 256 + wc * 64 + G.p8 * 8;
        const unsigned char* sp = SMG + (rowb >> 1) * 6144 + (size_t)(n * 16 + u.pn * 4 + wc) * 128 + (rowb & 1) * 64 + G.p8 * 8; bf16_t* mp = MG + rowb * 1024 + colb;
#pragma unroll
        for (int ai = 0; ai < 2; ++ai) {
            u32x2 g[4][2]; u32x4 y[4][2];
#pragma unroll
            for (int m = 0; m < 4; ++m)
#pragma unroll
                for (int h = 0; h < 2; ++h) { g[m][h] = *(const u32x2*)(sp + (size_t)(ai * 64 + m * 8 + 4 * h) * 6144); if (n > 0) y[m][h] = *(const u32x4*)(mp + (size_t)(ai * 128 + m * 16 + 8 * h) * 1024); }
#pragma unroll
            for (int m = 0; m < 4; ++m) { u32x4 r[2];
                epi_xpose(G, pack8(acc[ai][0][m][0], acc[ai][0][m][1]), pack8(acc[ai][1][m][0], acc[ai][1][m][1]), r[0], r[1]);
#pragma unroll
                for (int h = 0; h < 2; ++h) { const u32x2 gg = g[m][h]; const u32x4 aa = r[h];
                    float v[8] = {bflo(aa.x) * (S * (float)(gg.x & 0xffu)), bfhi(aa.x) * (S * (float)((gg.x >> 8) & 0xffu)), bflo(aa.y) * (S * (float)((gg.x >> 16) & 0xffu)), bfhi(aa.y) * (S * (float)(gg.x >> 24)),
                                  bflo(aa.z) * (S * (float)(gg.y & 0xffu)), bfhi(aa.z) * (S * (float)((gg.y >> 8) & 0xffu)), bflo(aa.w) * (S * (float)((gg.y >> 16) & 0xffu)), bfhi(aa.w) * (S * (float)(gg.y >> 24))};
                    if (n > 0) { const u32x4 yy = y[m][h];
                        v[0] += bflo(yy.x); v[1] += bfhi(yy.x); v[2] += bflo(yy.y); v[3] += bfhi(yy.y); v[4] += bflo(yy.z); v[5] += bfhi(yy.z); v[6] += bflo(yy.w); v[7] += bfhi(yy.w); }
                    u32x4 w; w.x = pk2(v[0], v[1]); w.y = pk2(v[2], v[3]); w.z = pk2(v[4], v[5]); w.w = pk2(v[6], v[7]);
                    *(u32x4*)(mp + (size_t)(ai * 128 + m * 16 + 8 * h) * 1024) = w; } }
        }
    }
};
struct EpiF32 {
    static constexpr bool PERM = false; float* O; int ldc;
    __device__ __forceinline__ void operator()(const f32x4 (&acc)[2][2][4][2], const Unit& u, int wr, int wc, int fr, int fq) const {
        const int row0 = u.pm * 256 + wr * 64 + fr, col0 = u.pn * 256 + wc * 32 + 4 * fq;
#pragma unroll
        for (int ai = 0; ai < 2; ++ai)
#pragma unroll
            for (int m = 0; m < 4; ++m) { float* rowp = O + (size_t)(row0 + ai * 128 + m * 16) * ldc + col0;
#pragma unroll
                for (int bj = 0; bj < 2; ++bj)
#pragma unroll
                    for (int n = 0; n < 2; ++n) *(f32x4*)(rowp + bj * 128 + n * 16) = acc[ai][bj][m][n]; }
    }
};

template <class SrcCol>
__device__ __forceinline__ void transpose_item(const float* W, int Ksrc, int Nsrc, bf16_t* WT, int Kdst, int item, int nblk, float* scr, int lane, SrcCol src, const float* kscale) {
    const int kb = item / nblk, nb = item % nblk, k0 = 64 * kb, n0 = 32 * nb;
    const int sc = src(n0 + (lane & 31));
    float vv[32];
#pragma unroll
    for (int i = 0; i < 32; ++i) { const int k = k0 + 2 * i + (lane >> 5); float v = 0.f;
        if (sc >= 0 && k < Ksrc) { v = W[(size_t)k * Nsrc + sc]; if (kscale) v *= kscale[k]; }
        vv[i] = v; }
#pragma unroll
    for (int i = 0; i < 32; ++i) scr[(2 * i + (lane >> 5)) * 33 + (lane & 31)] = vv[i];
    asm volatile("s_waitcnt lgkmcnt(0)" ::: "memory");
    const int c = lane & 7;
#pragma unroll
    for (int j = 0; j < 4; ++j) { const int n = (lane >> 3) + 8 * j; const float* s = scr + (8 * c) * 33 + n;
        u32x4 o; o.x = pk2(s[0 * 33], s[1 * 33]); o.y = pk2(s[2 * 33], s[3 * 33]); o.z = pk2(s[4 * 33], s[5 * 33]); o.w = pk2(s[6 * 33], s[7 * 33]);
        *(u32x4*)(WT + (size_t)(n0 + n) * Kdst + k0 + 8 * c) = o; }
    asm volatile("s_waitcnt lgkmcnt(0)" ::: "memory");
}
__device__ __forceinline__ int win_src(int j) {
    if (j < 416) return j;
    if (j < 432) return 3104 + (j - 416);
    if (j < 512) return -1;
    if (j < 2048) return 416 + (j - 512);
    if (j < 2176) return 1952 + (j - 2048);
    if (j < 2304) return -1;
    if (j < 3328) return 2080 + (j - 2304);
    return 3120 + (j - 3328);
}
__device__ __forceinline__ int wuq_src(int j) { const int h = j / 96, c = j % 96; if (c < 64) return h * 96 + c; const int r = c - 64; return h * 96 + 64 + (r & 1) * 16 + (r >> 1); }
__device__ __forceinline__ int wukv_src(int j) { return j < 512 ? (j >> 6) * 128 + (j & 63) : ((j - 512) >> 6) * 128 + 64 + (j & 63); }

__device__ __forceinline__ void convert_weights(int l, unsigned char* lds, int gw, int NGW, int wave, int lane) {
    float* scr = (float*)(lds + wave * 8448); const Params p = load_params();
    bf16_t* WinT = (bf16_t*)(p.ws + WS_WIN); bf16_t* WboT = (bf16_t*)(p.ws + WS_WBO); bf16_t* WoutT = (bf16_t*)(p.ws + WS_WOUT); bf16_t* WuqT = (bf16_t*)(p.ws + WS_WUQ); bf16_t* WukvT = (bf16_t*)(p.ws + WS_WUKV);
    constexpr int I_IN = 16 * (NALL / 32), I_BO = 8 * 32, I_OUT = 16 * 32, I_UQ = 4 * 24, I_UKV = 4 * 32;
    constexpr int NITEMS = I_IN + 3 * I_BO + I_OUT + I_UQ + I_UKV;
    for (int it = gw; it < NITEMS; it += NGW) {
        int r = it;
        if (r < I_IN) { transpose_item(p.w_in + (size_t)l * 1024 * N_IN, 1024, N_IN, WinT, 1024, r, NALL / 32, scr, lane, [](int j) { return win_src(j); }, nullptr); continue; } r -= I_IN;
        if (r < 3 * I_BO) { const int n = r / I_BO; r -= n * I_BO;
            transpose_item(p.w_branch_out + ((size_t)l * 3 + n) * 512 * 1024, 512, 1024, WboT + (size_t)n * 1024 * 512, 512, r, 32, scr, lane, [](int j) { return j; }, nullptr); continue; } r -= 3 * I_BO;
        if (r < I_OUT) { transpose_item(p.w_out + (size_t)l * 1024 * 1024, 1024, 1024, WoutT, 1024, r, 32, scr, lane, [](int j) { return j; }, nullptr); continue; } r -= I_OUT;
        if (r < I_UQ) { transpose_item(p.mla_w_uq + (size_t)l * 256 * 768, 256, 768, WuqT, 256, r, 24, scr, lane, [](int j) { return wuq_src(j); }, p.mla_q_norm + l * 256); continue; } r -= I_UQ;
        transpose_item(p.mla_w_ukv + (size_t)l * 128 * 1024, 128, 1024, WukvT, 256, r, 32, scr, lane, [](int j) { return wukv_src(j); }, p.mla_kv_norm + l * 128);
    }
}
__device__ __forceinline__ void hb_row(const float* xrow, const float* g, bf16_t* orow, int lane) {
    const f32x4* xr = (const f32x4*)xrow + lane; const f32x4* gr = (const f32x4*)g + lane;
    f32x4 v[4]; float s = 0.f;
#pragma unroll
    for (int j = 0; j < 4; ++j) { v[j] = xr[64 * j]; s += (v[j].x * v[j].x + v[j].y * v[j].y) + (v[j].z * v[j].z + v[j].w * v[j].w); }
    const float rstd = rsqrtf(wave_sum(s) * (1.f / DM) + NORM_EPS);
    u32x2* o8 = (u32x2*)orow + lane;
#pragma unroll
    for (int j = 0; j < 4; ++j) { const f32x4 gg = gr[64 * j]; u32x2 w; w.x = pk2(v[j].x * rstd * gg.x, v[j].y * rstd * gg.y); w.y = pk2(v[j].z * rstd * gg.z, v[j].w * rstd * gg.w); o8[64 * j] = w; }
}
__device__ __forceinline__ void hb_rows4(const float* x, const float* g, bf16_t* HB, int m, int stride, int lane) {
    f32x4 v[4][4];
#pragma unroll
    for (int r = 0; r < 4; ++r) { const f32x4* xr = (const f32x4*)(x + (size_t)(m + r * stride) * DM) + lane;
#pragma unroll
        for (int j = 0; j < 4; ++j) v[r][j] = xr[64 * j]; }
    const f32x4* gr = (const f32x4*)g + lane;
#pragma unroll
    for (int r = 0; r < 4; ++r) { float s = 0.f;
#pragma unroll
        for (int j = 0; j < 4; ++j) s += (v[r][j].x * v[r][j].x + v[r][j].y * v[r][j].y) + (v[r][j].z * v[r][j].z + v[r][j].w * v[r][j].w);
        const float rstd = rsqrtf(wave_sum(s) * (1.f / DM) + NORM_EPS);
        u32x2* o8 = (u32x2*)(HB + (size_t)(m + r * stride) * DM) + lane;
#pragma unroll
        for (int j = 0; j < 4; ++j) { const f32x4 gg = gr[64 * j]; u32x2 w; w.x = pk2(v[r][j].x * rstd * gg.x, v[r][j].y * rstd * gg.y); w.y = pk2(v[r][j].z * rstd * gg.z, v[r][j].w * rstd * gg.w); o8[64 * j] = w; } }
}
template <bool XIN16> struct RowIn { u32x4 oa, ob, xa, xb; f32x4 xv[4]; };
template <bool XIN16> __device__ __forceinline__ void final_load(RowIn<XIN16>& r, const bf16_t* orow, const float* xold, int lane) {
    r.oa = *((const u32x4*)orow + lane); r.ob = *((const u32x4*)orow + 64 + lane);
    if (XIN16) { r.xa = *((const u32x4*)xold + lane); r.xb = *((const u32x4*)xold + 64 + lane); }
    else {
#pragma unroll
        for (int h = 0; h < 2; ++h)
#pragma unroll
            for (int q = 0; q < 2; ++q) r.xv[2 * h + q] = *((const f32x4*)(xold + 512 * h + 8 * lane) + q); }
}
template <bool XIN16, bool XOUT16>
__device__ __forceinline__ void final_row(const RowIn<XIN16>& r, const float* gpost, float* xnew, const float* gnext, bf16_t* hbrow, int lane) {
    float o[16], x[16], g[16];
    { const u32x4 a = r.oa, b = r.ob;
      o[0] = bflo(a.x); o[1] = bfhi(a.x); o[2] = bflo(a.y); o[3] = bfhi(a.y); o[4] = bflo(a.z); o[5] = bfhi(a.z); o[6] = bflo(a.w); o[7] = bfhi(a.w);
      o[8] = bflo(b.x); o[9] = bfhi(b.x); o[10] = bflo(b.y); o[11] = bfhi(b.y); o[12] = bflo(b.z); o[13] = bfhi(b.z); o[14] = bflo(b.w); o[15] = bfhi(b.w); }
    if (XIN16) { const u32x4 a = r.xa, b = r.xb;
      x[0] = bflo(a.x); x[1] = bfhi(a.x); x[2] = bflo(a.y); x[3] = bfhi(a.y); x[4] = bflo(a.z); x[5] = bfhi(a.z); x[6] = bflo(a.w); x[7] = bfhi(a.w);
      x[8] = bflo(b.x); x[9] = bfhi(b.x); x[10] = bflo(b.y); x[11] = bfhi(b.y); x[12] = bflo(b.z); x[13] = bfhi(b.z); x[14] = bflo(b.w); x[15] = bfhi(b.w); }
#pragma unroll
    for (int h = 0; h < 2; ++h)
#pragma unroll
        for (int q = 0; q < 2; ++q) { const f32x4 gv = *((const f32x4*)(gpost + 512 * h + 8 * lane) + q);
            if (!XIN16) {
#pragma unroll
                for (int e = 0; e < 4; ++e) x[8 * h + 4 * q + e] = r.xv[2 * h + q][e]; }
#pragma unroll
            for (int e = 0; e < 4; ++e) g[8 * h + 4 * q + e] = gv[e]; }
    float s = 0.f;
#pragma unroll
    for (int e = 0; e < 16; ++e) s += o[e] * o[e];
    const float rstd = rsqrtf(wave_sum(s) * (1.f / DM) + NORM_EPS);
    float s2 = 0.f;
#pragma unroll
    for (int e = 0; e < 16; ++e) { x[e] += o[e] * rstd * g[e]; s2 += x[e] * x[e]; }
    if (XOUT16) {
#pragma unroll
        for (int h = 0; h < 2; ++h) { u32x4 w; w.x = pk2(x[8 * h], x[8 * h + 1]); w.y = pk2(x[8 * h + 2], x[8 * h + 3]); w.z = pk2(x[8 * h + 4], x[8 * h + 5]); w.w = pk2(x[8 * h + 6], x[8 * h + 7]);
            *((u32x4*)xnew + 64 * h + lane) = w; }
    } else {
#pragma unroll
        for (int h = 0; h < 2; ++h)
#pragma unroll
            for (int q = 0; q < 2; ++q) *((f32x4*)(xnew + 512 * h + 8 * lane) + q) = (f32x4){x[8 * h + 4 * q], x[8 * h + 4 * q + 1], x[8 * h + 4 * q + 2], x[8 * h + 4 * q + 3]};
    }
    if (gnext) { const float rstd2 = rsqrtf(wave_sum(s2) * (1.f / DM) + NORM_EPS);
#pragma unroll
        for (int h = 0; h < 2; ++h) { const f32x4 g0 = *((const f32x4*)(gnext + 512 * h + 8 * lane)), g1 = *((const f32x4*)(gnext + 512 * h + 8 * lane) + 1);
            u32x4 w; w.x = pk2(x[8 * h] * rstd2 * g0[0], x[8 * h + 1] * rstd2 * g0[1]); w.y = pk2(x[8 * h + 2] * rstd2 * g0[2], x[8 * h + 3] * rstd2 * g0[3]);
            w.z = pk2(x[8 * h + 4] * rstd2 * g1[0], x[8 * h + 5] * rstd2 * g1[1]); w.w = pk2(x[8 * h + 6] * rstd2 * g1[2], x[8 * h + 7] * rstd2 * g1[3]);
            *((u32x4*)hbrow + 64 * h + lane) = w; } }
}
__device__ __forceinline__ void mla_prep_row(const bf16_t* prow, const f32x2* rope_t, float* rstdq, float* rstdkv, bf16_t* krow, int lane) {
    const u32x2 a = *((const u32x2*)(prow + CQ) + lane); const unsigned c = *((const unsigned*)(prow + CKV) + lane);
    float sq = bflo(a.x) * bflo(a.x) + bfhi(a.x) * bfhi(a.x) + bflo(a.y) * bflo(a.y) + bfhi(a.y) * bfhi(a.y);
    float sk = bflo(c) * bflo(c) + bfhi(c) * bfhi(c);
    sq = wave_sum(sq); sk = wave_sum(sk);
    if (lane == 0) { *rstdq = rsqrtf(sq * (1.f / 256.f) + NORM_EPS); *rstdkv = rsqrtf(sk * (1.f / 128.f) + NORM_EPS); }
    if (lane < 16) { const float x1 = bf2f(prow[KROPE + lane]), x2 = bf2f(prow[KROPE + 16 + lane]); const f32x2 cs = rope_t[lane];
        *((unsigned*)(krow + 512) + lane) = pk2(x1 * cs.x - x2 * cs.y, x2 * cs.x + x1 * cs.y); }
}

__device__ __forceinline__ void mla_prep_rows4(const bf16_t* PA, const f32x2* ROPE, float* RSTDQ, float* RSTDKV, bf16_t* Kb, int m, int stride, int lane) {
    u32x2 a[4]; unsigned c[4]; float x1[4], x2[4]; f32x2 cs[4];
#pragma unroll
    for (int j = 0; j < 4; ++j) { const int r = (m + j * stride < T) ? m + j * stride : m; const bf16_t* prow = PA + (size_t)r * NA;
        a[j] = *((const u32x2*)(prow + CQ) + lane); c[j] = *((const unsigned*)(prow + CKV) + lane);
        x1[j] = bf2f(prow[KROPE + (lane & 15)]); x2[j] = bf2f(prow[KROPE + 16 + (lane & 15)]); cs[j] = ROPE[(size_t)r * 16 + (lane & 15)]; }
#pragma unroll
    for (int j = 0; j < 4; ++j) { const int r = m + j * stride; if (r < T) {
        float sq = bflo(a[j].x) * bflo(a[j].x) + bfhi(a[j].x) * bfhi(a[j].x) + bflo(a[j].y) * bflo(a[j].y) + bfhi(a[j].y) * bfhi(a[j].y);
        float sk = bflo(c[j]) * bflo(c[j]) + bfhi(c[j]) * bfhi(c[j]);
        sq = wave_sum(sq); sk = wave_sum(sk);
        if (lane == 0) { RSTDQ[r] = rsqrtf(sq * (1.f / 256.f) + NORM_EPS); RSTDKV[r] = rsqrtf(sk * (1.f / 128.f) + NORM_EPS); }
        if (lane < 16) *((unsigned*)(Kb + (size_t)r * KP + 512) + lane) = pk2(x1[j] * cs[j].x - x2[j] * cs[j].y, x2[j] * cs[j].x + x1[j] * cs[j].y); } }
}

#ifdef BANDSKIP
namespace att {
constexpr int KSLOT = 12288, VSLOT = 8192, BUFB = KSLOT + VSLOT, L_WS = 2 * BUFB, L_OST = L_WS + 8 * 128 * 4, L_END = L_OST + 8 * 4096;
constexpr int UNIT_ROWS = 512;
__device__ __forceinline__ int crow(int r, int hi) { return (r & 3) + 8 * (r >> 2) + 4 * hi; }
__device__ __forceinline__ s16x4 vtr(const LAS unsigned char* p) { return __builtin_bit_cast(s16x4, __builtin_amdgcn_ds_read_tr16_b64_v4i16((LAS s16x4*)p)); }
__device__ __forceinline__ void load_q(bf16x8 (&qr)[6], const bf16_t* Q, const f32x2* rope, size_t row, int h, int hi) {
    const bf16_t* Qw = Q + row * 768 + h * 96 + hi * 8;
#pragma unroll
    for (int s = 0; s < 6; ++s) qr[s] = *(const bf16x8*)(Qw + s * 16);
    const f32x4* rp = (const f32x4*)(rope + row * 16 + 4 * hi);
#pragma unroll
    for (int s = 4; s < 6; ++s) { const f32x4 c01 = rp[(s - 4) * 4], c23 = rp[(s - 4) * 4 + 1]; const u32x4 w = __builtin_bit_cast(u32x4, qr[s]); u32x4 o;
        { const float e = bflo(w.x), d = bfhi(w.x); o.x = pk2(e * c01[0] - d * c01[1], d * c01[0] + e * c01[1]); }
        { const float e = bflo(w.y), d = bfhi(w.y); o.y = pk2(e * c01[2] - d * c01[3], d * c01[2] + e * c01[3]); }
        { const float e = bflo(w.z), d = bfhi(w.z); o.z = pk2(e * c23[0] - d * c23[1], d * c23[0] + e * c23[1]); }
        { const float e = bflo(w.w), d = bfhi(w.w); o.w = pk2(e * c23[2] - d * c23[3], d * c23[2] + e * c23[3]); }
        qr[s] = __builtin_bit_cast(bf16x8, o); }
}
__device__ __forceinline__ void softmax_half(f32x16& p0, f32x16& p1, f32x16& o0, f32x16& o1, float& mrun, float& lrun, bf16x8 (&pa)[4],
                                             bool first, bool band, int kb0, int qrel, int r32, int hi, LAS float* wsf) {
    if (band) {
#pragma unroll
        for (int r = 0; r < 16; ++r) { const int kv = kb0 + (r & 3) + 8 * (r >> 2); if (kv > qrel) p0[r] = -INFINITY; if (kv + 32 > qrel) p1[r] = -INFINITY; } }
    float mx = fmaxf(p0[0], p1[0]);
#pragma unroll
    for (int r = 1; r < 16; ++r) mx = fmaxf(mx, fmaxf(p0[r], p1[r]));
    mx = fmaxf(mx, __shfl_xor(mx, 32));
    if (first || __any(mx > 8.0f)) {
        const float dl = first ? mx : fmaxf(mx, 0.f); mrun += dl;
#pragma unroll
        for (int r = 0; r < 16; ++r) { p0[r] -= dl; p1[r] -= dl; }
        const float alpha = __builtin_amdgcn_exp2f(-dl); lrun *= alpha;
        if (hi == 0) wsf[r32] = alpha;
#pragma unroll
        for (int r = 0; r < 16; ++r) { const float a = wsf[crow(r, hi)]; o0[r] *= a; o1[r] *= a; }
    }
    float ls = 0.f;
#pragma unroll
    for (int r = 0; r < 16; ++r) { p0[r] = __builtin_amdgcn_exp2f(p0[r]); p1[r] = __builtin_amdgcn_exp2f(p1[r]); ls += p0[r] + p1[r]; }
    lrun += ls;
#pragma unroll
    for (int s = 0; s < 4; ++s) { const int bb = 8 * (s & 1); u32x4 w;
        if (s < 2) { w.x = pk2(p0[bb], p0[bb + 1]); w.y = pk2(p0[bb + 2], p0[bb + 3]); w.z = pk2(p0[bb + 4], p0[bb + 5]); w.w = pk2(p0[bb + 6], p0[bb + 7]); }
        else { w.x = pk2(p1[bb], p1[bb + 1]); w.y = pk2(p1[bb + 2], p1[bb + 3]); w.z = pk2(p1[bb + 4], p1[bb + 5]); w.w = pk2(p1[bb + 6], p1[bb + 7]); }
        pa[s] = __builtin_bit_cast(bf16x8, w); }
}
__device__ __forceinline__ void attn_unit(int b, int h, int qb, LAS unsigned char* lds, unsigned* done_ctr) {
    KArgs kp = kargs(); unsigned char* ws_ = kp->ws;
    const bf16_t* Q = (const bf16_t*)(ws_ + WS_Q); const bf16_t* Kg = (const bf16_t*)(ws_ + WS_K); const bf16_t* Vg = (const bf16_t*)(ws_ + WS_V); bf16_t* O = (bf16_t*)(ws_ + WS_YS);
    const int tid = opaque_tid(), lane = tid & 63, r32 = lane & 31, hi = lane >> 5; const int wid = __builtin_amdgcn_readfirstlane(tid >> 6);
    const size_t rowbase = (size_t)b * SEQ; const int q0 = qb * UNIT_ROWS;
    bf16x8 qa[6], qb_[6];
    const int rba = 32 * wid, rbb = 32 * (15 - wid);
    load_q(qa, Q, (const f32x2*)(ws_ + WS_ROPE), rowbase + q0 + rba + r32, h, hi);
    load_q(qb_, Q, (const f32x2*)(ws_ + WS_ROPE), rowbase + q0 + rbb + r32, h, hi);
    const char* kbase0 = (const char*)(Kg + rowbase * KP + h * 64); const char* kbase1 = (const char*)(Kg + rowbase * KP + 512);
    const char* vbase = (const char*)(Vg + rowbase * 512 + h * 64);
    const unsigned kof = (unsigned)(((tid & 63) * KP + (tid >> 6) * 8) * 2), vof = (unsigned)((((tid & 255) >> 2) * 512 + (tid >> 8) * 32 + (tid & 3) * 8) * 2);
    const int NT = (q0 + UNIT_ROWS) / 64;
    LAS float* wsf = (LAS float*)(lds + L_WS) + wid * 128;
    u32x4 sk0, sk1, sv;
    sk0 = *(const u32x4*)(kbase0 + kof); if (tid < 256) sk1 = *(const u32x4*)(kbase1 + kof); sv = *(const u32x4*)(vbase + vof);
    *(LAS u32x4*)(lds + tid * 16) = sk0; if (tid < 256) *(LAS u32x4*)(lds + (tid + 512) * 16) = sk1; *(LAS u32x4*)(lds + KSLOT + tid * 16) = sv;
    __syncthreads();
    f32x16 oa0 = {}, oa1 = {}, ob0 = {}, ob1 = {}; float ma = 0.f, la = 0.f, mb = 0.f, lb = 0.f;
    const int qra = rba + r32, qrb = rbb + r32;
    const int tlastA = NT - 8 + ((rba + 31) >> 6), tlastB = NT - 8 + ((rbb + 31) >> 6);
    for (int t = 0; t < NT; ++t) {
        int tidv = tid; asm volatile("" : "+v"(tidv));
        const int lanev = tidv & 63, r32v = lanev & 31, hiv = lanev >> 5;
        const unsigned kofv = (unsigned)(((tidv & 63) * KP + (tidv >> 6) * 8) * 2), vofv = (unsigned)((((tidv & 255) >> 2) * 512 + (tidv >> 8) * 32 + (tidv & 3) * 8) * 2);
        LAS unsigned char* buf = lds + (t & 1) * BUFB; LAS unsigned char* nbuf = lds + ((t + 1) & 1) * BUFB;
        if (t + 1 < NT) { const size_t ko = (size_t)(t + 1) * 64 * KP * 2, vo = (size_t)(t + 1) * 64 * 512 * 2;
            sk0 = *(const u32x4*)(kbase0 + ko + kofv); if (tidv < 256) sk1 = *(const u32x4*)(kbase1 + ko + kofv); sv = *(const u32x4*)(vbase + vo + vofv); }
        const bool band = t >= NT - 8; const int kb0 = 64 * (t - (NT - 8)) + 4 * hiv;
        const bool doA = t <= tlastA, doB = t <= tlastB;
        f32x16 pa0, pa1, pb0, pb1;
#pragma unroll
        for (int r = 0; r < 16; ++r) { pa0[r] = -ma; pa1[r] = -ma; pb0[r] = -mb; pb1[r] = -mb; }
        { const LAS unsigned char* kb = buf + hiv * 1024 + r32v * 16;
#pragma unroll
          for (int s = 0; s < 6; ++s) { const bf16x8 a0 = *(const LAS bf16x8*)(kb + s * 2048), a1 = *(const LAS bf16x8*)(kb + s * 2048 + 512);
              if (doA) { pa0 = __builtin_amdgcn_mfma_f32_32x32x16_bf16(a0, qa[s], pa0, 0, 0, 0); pa1 = __builtin_amdgcn_mfma_f32_32x32x16_bf16(a1, qa[s], pa1, 0, 0, 0); }
              if (doB) { pb0 = __builtin_amdgcn_mfma_f32_32x32x16_bf16(a0, qb_[s], pb0, 0, 0, 0); pb1 = __builtin_amdgcn_mfma_f32_32x32x16_bf16(a1, qb_[s], pb1, 0, 0, 0); } } }
        bf16x8 fa[4], fb[4];
        if (doA) softmax_half(pa0, pa1, oa0, oa1, ma, la, fa, t == 0, band, kb0, (rba + r32v), r32v, hiv, wsf);
        if (doB) softmax_half(pb0, pb1, ob0, ob1, mb, lb, fb, t == 0, band, kb0, (rbb + r32v), r32v, hiv, wsf + 64);
        { const LAS unsigned char* vb = buf + KSLOT + ((lanev >> 4) & 1) * 32 + (lanev & 3) * 8 + (4 * hiv + ((lanev & 15) >> 2)) * 64;
#pragma unroll
          for (int s = 0; s < 4; ++s) {
              { const s16x4 lo = vtr(vb + s * 1024), hh = vtr(vb + s * 1024 + 512); const bf16x8 vf = {lo[0], lo[1], lo[2], lo[3], hh[0], hh[1], hh[2], hh[3]};
                if (doA) oa0 = __builtin_amdgcn_mfma_f32_32x32x16_bf16(fa[s], vf, oa0, 0, 0, 0); if (doB) ob0 = __builtin_amdgcn_mfma_f32_32x32x16_bf16(fb[s], vf, ob0, 0, 0, 0); }
              { const s16x4 lo = vtr(vb + 4096 + s * 1024), hh = vtr(vb + 4096 + s * 1024 + 512); const bf16x8 vf = {lo[0], lo[1], lo[2], lo[3], hh[0], hh[1], hh[2], hh[3]};
                if (doA) oa1 = __builtin_amdgcn_mfma_f32_32x32x16_bf16(fa[s], vf, oa1, 0, 0, 0); if (doB) ob1 = __builtin_amdgcn_mfma_f32_32x32x16_bf16(fb[s], vf, ob1, 0, 0, 0); } } }
        if (t + 1 < NT) { *(LAS u32x4*)(nbuf + tidv * 16) = sk0; if (tidv < 256) *(LAS u32x4*)(nbuf + (tidv + 512) * 16) = sk1; *(LAS u32x4*)(nbuf + KSLOT + tidv * 16) = sv; }
        __syncthreads();
    }
    la += __shfl_xor(la, 32); lb += __shfl_xor(lb, 32);
    if (hi == 0) { wsf[32 + r32] = la; wsf[96 + r32] = lb; }
    LAS bf16_t* stg = (LAS bf16_t*)(lds + L_OST) + wid * 2048;
#pragma unroll
    for (int hf = 0; hf < 2; ++hf) {
#pragma unroll
        for (int r = 0; r < 16; ++r) { const int orow = crow(r, hi); const float rl = __builtin_amdgcn_rcpf(wsf[hf * 64 + 32 + orow]);
            stg[orow * 64 + r32] = f2bf((hf ? ob0[r] : oa0[r]) * rl); stg[orow * 64 + 32 + r32] = f2bf((hf ? ob1[r] : oa1[r]) * rl); }
        asm volatile("" ::: "memory");
        bf16_t* Ow = O + (rowbase + q0 + (hf ? rbb : rba)) * 512 + h * 64;
#pragma unroll
        for (int i = 0; i < 4; ++i) { const int row = i * 8 + (lane >> 3), ch = lane & 7; const u32x4 v = *(const LAS u32x4*)(stg + row * 64 + ch * 8); *(u32x4*)(Ow + (size_t)row * 512 + ch * 8) = v; }
        asm volatile("" ::: "memory");
    }
    asm volatile("s_waitcnt vmcnt(0)" ::: "memory");
    __syncthreads();
    if (tid == 0) __hip_atomic_fetch_add(done_ctr, 1u, __ATOMIC_RELEASE, __HIP_MEMORY_SCOPE_AGENT);
}
}
#else
namespace att {
constexpr int KSLOT = 12288, VSLOT = 8192, BUFB = KSLOT + VSLOT, L_WS = 2 * BUFB, L_OST = L_WS + 8 * 128 * 4, L_END = L_OST + 8 * 4096;
constexpr int UNIT_ROWS = 512;
__device__ __forceinline__ int crow(int r, int hi) { return (r & 3) + 8 * (r >> 2) + 4 * hi; }
__device__ __forceinline__ s16x4 vtr(const LAS unsigned char* p) { return __builtin_bit_cast(s16x4, __builtin_amdgcn_ds_read_tr16_b64_v4i16((LAS s16x4*)p)); }
__device__ __forceinline__ void load_q(bf16x8 (&qr)[6], const bf16_t* Q, const f32x2* rope, size_t row, int h, int hi) {
    const bf16_t* Qw = Q + row * 768 + h * 96 + hi * 8;
#pragma unroll
    for (int s = 0; s < 6; ++s) qr[s] = *(const bf16x8*)(Qw + s * 16);
    const f32x4* rp = (const f32x4*)(rope + row * 16 + 4 * hi);
#pragma unroll
    for (int s = 4; s < 6; ++s) { const f32x4 c01 = rp[(s - 4) * 4], c23 = rp[(s - 4) * 4 + 1]; const u32x4 w = __builtin_bit_cast(u32x4, qr[s]); u32x4 o;
        { const float e = bflo(w.x), d = bfhi(w.x); o.x = pk2(e * c01[0] - d * c01[1], d * c01[0] + e * c01[1]); }
        { const float e = bflo(w.y), d = bfhi(w.y); o.y = pk2(e * c01[2] - d * c01[3], d * c01[2] + e * c01[3]); }
        { const float e = bflo(w.z), d = bfhi(w.z); o.z = pk2(e * c23[0] - d * c23[1], d * c23[0] + e * c23[1]); }
        { const float e = bflo(w.w), d = bfhi(w.w); o.w = pk2(e * c23[2] - d * c23[3], d * c23[2] + e * c23[3]); }
        qr[s] = __builtin_bit_cast(bf16x8, o); }
}
__device__ __forceinline__ void softmax_half(f32x16& p0, f32x16& p1, f32x16& o0, f32x16& o1, float& mrun, float& lrun, bf16x8 (&pa)[4],
                                             bool first, bool band, int kb0, int qrel, int r32, int hi, LAS float* wsf) {
    if (band) {
#pragma unroll
        for (int r = 0; r < 16; ++r) { const int kv = kb0 + (r & 3) + 8 * (r >> 2); if (kv > qrel) p0[r] = -INFINITY; if (kv + 32 > qrel) p1[r] = -INFINITY; } }
    float mx = fmaxf(p0[0], p1[0]);
#pragma unroll
    for (int r = 1; r < 16; ++r) mx = fmaxf(mx, fmaxf(p0[r], p1[r]));
    mx = fmaxf(mx, __shfl_xor(mx, 32));
    if (first || __any(mx > 8.0f)) {
        const float dl = first ? mx : fmaxf(mx, 0.f); mrun += dl;
#pragma unroll
        for (int r = 0; r < 16; ++r) { p0[r] -= dl; p1[r] -= dl; }
        const float alpha = __builtin_amdgcn_exp2f(-dl); lrun *= alpha;
        if (hi == 0) wsf[r32] = alpha;
#pragma unroll
        for (int r = 0; r < 16; ++r) { const float a = wsf[crow(r, hi)]; o0[r] *= a; o1[r] *= a; }
    }
    float ls = 0.f;
#pragma unroll
    for (int r = 0; r < 16; ++r) { p0[r] = __builtin_amdgcn_exp2f(p0[r]); p1[r] = __builtin_amdgcn_exp2f(p1[r]); ls += p0[r] + p1[r]; }
    lrun += ls;
#pragma unroll
    for (int s = 0; s < 4; ++s) { const int bb = 8 * (s & 1); u32x4 w;
        if (s < 2) { w.x = pk2(p0[bb], p0[bb + 1]); w.y = pk2(p0[bb + 2], p0[bb + 3]); w.z = pk2(p0[bb + 4], p0[bb + 5]); w.w = pk2(p0[bb + 6], p0[bb + 7]); }
        else { w.x = pk2(p1[bb], p1[bb + 1]); w.y = pk2(p1[bb + 2], p1[bb + 3]); w.z = pk2(p1[bb + 4], p1[bb + 5]); w.w = pk2(p1[bb + 6], p1[bb + 7]); }
        pa[s] = __builtin_bit_cast(bf16x8, w); }
}
__device__ __forceinline__ void attn_unit(int b, int h, int qb, LAS unsigned char* lds, unsigned* done_ctr) {
    KArgs kp = kargs(); unsigned char* ws_ = kp->ws;
    const bf16_t* Q = (const bf16_t*)(ws_ + WS_Q); const bf16_t* Kg = (const bf16_t*)(ws_ + WS_K); const bf16_t* Vg = (const bf16_t*)(ws_ + WS_V); bf16_t* O = (bf16_t*)(ws_ + WS_YS);
    const int tid = opaque_tid(), lane = tid & 63, r32 = lane & 31, hi = lane >> 5; const int wid = __builtin_amdgcn_readfirstlane(tid >> 6);
    const size_t rowbase = (size_t)b * SEQ; const int q0 = qb * UNIT_ROWS;
    bf16x8 qa[6], qb_[6];
    load_q(qa, Q, (const f32x2*)(ws_ + WS_ROPE), rowbase + q0 + wid * 64 + r32, h, hi);
    load_q(qb_, Q, (const f32x2*)(ws_ + WS_ROPE), rowbase + q0 + wid * 64 + 32 + r32, h, hi);
    const bf16_t* ksrc0 = Kg + (rowbase + (tid & 63)) * KP + h * 64 + (tid >> 6) * 8;
    const bf16_t* ksrc1 = Kg + (rowbase + (tid & 63)) * KP + 512 + (tid >> 6) * 8;
    const bf16_t* vsrc = Vg + (rowbase + ((tid & 255) >> 2)) * 512 + h * 64 + (tid >> 8) * 32 + (tid & 3) * 8;
    const int NT = (q0 + UNIT_ROWS) / 64;
    LAS float* wsf = (LAS float*)(lds + L_WS) + wid * 128;
    u32x4 sk0, sk1, sv;
    sk0 = *(const u32x4*)ksrc0; if (tid < 256) sk1 = *(const u32x4*)ksrc1; sv = *(const u32x4*)vsrc;
    *(LAS u32x4*)(lds + tid * 16) = sk0; if (tid < 256) *(LAS u32x4*)(lds + (tid + 512) * 16) = sk1; *(LAS u32x4*)(lds + KSLOT + tid * 16) = sv;
    __syncthreads();
    f32x16 oa0 = {}, oa1 = {}, ob0 = {}, ob1 = {}; float ma = 0.f, la = 0.f, mb = 0.f, lb = 0.f;
    const int qra = wid * 64 + r32, qrb = qra + 32;
    for (int t = 0; t < NT; ++t) {
        LAS unsigned char* buf = lds + (t & 1) * BUFB; LAS unsigned char* nbuf = lds + ((t + 1) & 1) * BUFB;
        if (t + 1 < NT) { sk0 = *(const u32x4*)(ksrc0 + (size_t)(t + 1) * 64 * KP); if (tid < 256) sk1 = *(const u32x4*)(ksrc1 + (size_t)(t + 1) * 64 * KP); sv = *(const u32x4*)(vsrc + (size_t)(t + 1) * 64 * 512); }
        f32x16 pa0, pa1, pb0, pb1;
#pragma unroll
        for (int r = 0; r < 16; ++r) { pa0[r] = -ma; pa1[r] = -ma; pb0[r] = -mb; pb1[r] = -mb; }
        { const LAS unsigned char* kb = buf + hi * 1024 + r32 * 16;
#pragma unroll
          for (int s = 0; s < 6; ++s) { const bf16x8 a0 = *(const LAS bf16x8*)(kb + s * 2048), a1 = *(const LAS bf16x8*)(kb + s * 2048 + 512);
              pa0 = __builtin_amdgcn_mfma_f32_32x32x16_bf16(a0, qa[s], pa0, 0, 0, 0); pa1 = __builtin_amdgcn_mfma_f32_32x32x16_bf16(a1, qa[s], pa1, 0, 0, 0);
              pb0 = __builtin_amdgcn_mfma_f32_32x32x16_bf16(a0, qb_[s], pb0, 0, 0, 0); pb1 = __builtin_amdgcn_mfma_f32_32x32x16_bf16(a1, qb_[s], pb1, 0, 0, 0); } }
        const bool band = t >= NT - 8; const int kb0 = 64 * (t - (NT - 8)) + 4 * hi;
        bf16x8 fa[4], fb[4];
        softmax_half(pa0, pa1, oa0, oa1, ma, la, fa, t == 0, band, kb0, qra, r32, hi, wsf);
        softmax_half(pb0, pb1, ob0, ob1, mb, lb, fb, t == 0, band, kb0, qrb, r32, hi, wsf + 64);
        { const LAS unsigned char* vb = buf + KSLOT + ((lane >> 4) & 1) * 32 + (lane & 3) * 8 + (4 * hi + ((lane & 15) >> 2)) * 64;
#pragma unroll
          for (int s = 0; s < 4; ++s) {
              { const s16x4 lo = vtr(vb + s * 1024), hh = vtr(vb + s * 1024 + 512); const bf16x8 vf = {lo[0], lo[1], lo[2], lo[3], hh[0], hh[1], hh[2], hh[3]};
                oa0 = __builtin_amdgcn_mfma_f32_32x32x16_bf16(fa[s], vf, oa0, 0, 0, 0); ob0 = __builtin_amdgcn_mfma_f32_32x32x16_bf16(fb[s], vf, ob0, 0, 0, 0); }
              { const s16x4 lo = vtr(vb + 4096 + s * 1024), hh = vtr(vb + 4096 + s * 1024 + 512); const bf16x8 vf = {lo[0], lo[1], lo[2], lo[3], hh[0], hh[1], hh[2], hh[3]};
                oa1 = __builtin_amdgcn_mfma_f32_32x32x16_bf16(fa[s], vf, oa1, 0, 0, 0); ob1 = __builtin_amdgcn_mfma_f32_32x32x16_bf16(fb[s], vf, ob1, 0, 0, 0); } } }
        if (t + 1 < NT) { *(LAS u32x4*)(nbuf + tid * 16) = sk0; if (tid < 256) *(LAS u32x4*)(nbuf + (tid + 512) * 16) = sk1; *(LAS u32x4*)(nbuf + KSLOT + tid * 16) = sv; }
        __syncthreads();
    }
    la += __shfl_xor(la, 32); lb += __shfl_xor(lb, 32);
    if (hi == 0) { wsf[32 + r32] = la; wsf[96 + r32] = lb; }
    LAS bf16_t* stg = (LAS bf16_t*)(lds + L_OST) + wid * 2048;
#pragma unroll
    for (int hf = 0; hf < 2; ++hf) {
#pragma unroll
        for (int r = 0; r < 16; ++r) { const int orow = crow(r, hi); const float rl = __builtin_amdgcn_rcpf(wsf[hf * 64 + 32 + orow]);
            stg[orow * 64 + r32] = f2bf((hf ? ob0[r] : oa0[r]) * rl); stg[orow * 64 + 32 + r32] = f2bf((hf ? ob1[r] : oa1[r]) * rl); }
        asm volatile("" ::: "memory");
        bf16_t* Ow = O + (rowbase + q0 + wid * 64 + hf * 32) * 512 + h * 64;
        if (h < 4) {
            u32x4 gg[4];
#pragma unroll
            for (int i = 0; i < 4; ++i) gg[i] = *(const u32x4*)(Ow + (size_t)(i * 8 + (lane >> 3)) * 512 + (lane & 7) * 8);
#pragma unroll
            for (int i = 0; i < 4; ++i) { const int row = i * 8 + (lane >> 3), ch = lane & 7; const u32x4 v = *(const LAS u32x4*)(stg + row * 64 + ch * 8); const u32x4 g = gg[i]; u32x4 w;
                w.x = pk2(bflo(v.x) * bflo(g.x), bfhi(v.x) * bfhi(g.x)); w.y = pk2(bflo(v.y) * bflo(g.y), bfhi(v.y) * bfhi(g.y)); w.z = pk2(bflo(v.z) * bflo(g.z), bfhi(v.z) * bfhi(g.z)); w.w = pk2(bflo(v.w) * bflo(g.w), bfhi(v.w) * bfhi(g.w));
                *(u32x4*)(Ow + (size_t)row * 512 + ch * 8) = w; }
        } else {
#pragma unroll
        for (int i = 0; i < 4; ++i) { const int row = i * 8 + (lane >> 3), ch = lane & 7; const u32x4 v = *(const LAS u32x4*)(stg + row * 64 + ch * 8); *(u32x4*)(Ow + (size_t)row * 512 + ch * 8) = v; }
        }
        asm volatile("" ::: "memory");
    }
    asm volatile("s_waitcnt vmcnt(0)" ::: "memory");
    __syncthreads();
    if (tid == 0) __hip_atomic_fetch_add(done_ctr, 1u, __ATOMIC_RELEASE, __HIP_MEMORY_SCOPE_AGENT);
}
}
#endif

namespace rwkv {
constexpr int LP = 72, TB = 64 * LP * 2;
constexpr int S_HT0 = 0, S_HT1 = 1, S_A = 2  , S_B = 3  , S_K = 4, S_R = 5, S_BT = 6, S_KT = 7, S_V = 8,
              S_MOFF = 9, S_MAK = 10, S_MRK = 11, S_MRB = 12, S_D = 13, S_ZT = 14, S_ACC = 15, NSLOT = 16;
constexpr int FP = 68;
constexpr int O_ZW = S_K * TB, O_ZA = O_ZW + 64 * FP * 4, O_YB = S_MAK * TB, O_WT = NSLOT * TB, O_CL = O_WT + 8 * 64 * 4, O_CST = O_CL + 64 * 4, O_END = O_CST + 12 * 64 * 4, O_TT = O_END  ;
static_assert(O_ZA + 64 * FP * 4 <= (S_KT + 1) * TB && O_YB + 64 * FP * 4 <= (S_MRK + 1) * TB, "f32 aliases");
__device__ __forceinline__ s16x4 vtr(const LAS unsigned char* p) { return __builtin_bit_cast(s16x4, __builtin_amdgcn_ds_read_tr16_b64_v4i16((LAS s16x4*)p)); }
struct LaneOff { int bn, bt, bs; };
__device__ __forceinline__ LaneOff lane_off(int fr, int fq) { LaneOff o; o.bn = (fr * LP + 8 * fq) * 2; o.bt = ((8 * fq + (fr >> 2)) * LP + 4 * (fr & 3)) * 2; o.bs = (fr * LP + 4 * fq) * 2; return o; }
__device__ __forceinline__ void relaunder(LaneOff& o) { asm volatile("" : "+v"(o.bn), "+v"(o.bt), "+v"(o.bs)); }
__device__ __forceinline__ bf16x8 frag_t(const LAS unsigned char* tile, int kk, int c0, const LaneOff& o) {
    const LAS unsigned char* q = tile + o.bt + (32 * kk * LP + c0) * 2;
    const s16x4 lo = vtr(q), hi = vtr(q + 4 * LP * 2); return (bf16x8){lo[0], lo[1], lo[2], lo[3], hi[0], hi[1], hi[2], hi[3]};
}
__device__ __forceinline__ bf16x8 frag_n(const LAS unsigned char* tile, int r0, int kk, const LaneOff& o) { return *(const LAS bf16x8*)(tile + o.bn + (r0 * LP + 32 * kk) * 2); }
__device__ __forceinline__ f32x4 MFMA16(bf16x8 a, bf16x8 b, f32x4 c) { return __builtin_amdgcn_mfma_f32_16x16x32_bf16(a, b, c, 0, 0, 0); }
__device__ __forceinline__ void st_tile_T(LAS unsigned char* tile, int m0, int n0, const LaneOff& o, const f32x4 c) {
    u32x2 w; w.x = pk2(c[0], c[1]); w.y = pk2(c[2], c[3]); *(LAS u32x2*)(tile + o.bs + (n0 * LP + m0) * 2) = w;
}
__device__ __forceinline__ void unpack8(const u32x4 w, float (&f)[8]) { f[0] = bflo(w.x); f[1] = bfhi(w.x); f[2] = bflo(w.y); f[3] = bfhi(w.y); f[4] = bflo(w.z); f[5] = bfhi(w.z); f[6] = bflo(w.w); f[7] = bfhi(w.w); }
__device__ __forceinline__ u32x4 pack8(const float (&f)[8]) { u32x4 w; w.x = pk2(f[0], f[1]); w.y = pk2(f[2], f[3]); w.z = pk2(f[4], f[5]); w.w = pk2(f[6], f[7]); return w; }
__device__ __forceinline__ void ld8(const float* p, float (&f)[8]) { const f32x4 a = *(const f32x4*)p, b = *(const f32x4*)(p + 4); f[0] = a[0]; f[1] = a[1]; f[2] = a[2]; f[3] = a[3]; f[4] = b[0]; f[5] = b[1]; f[6] = b[2]; f[7] = b[3]; }
__device__ __forceinline__ void ld8l(const LAS float* p, float (&f)[8]) { const f32x4 a = *(const LAS f32x4*)p, b = *(const LAS f32x4*)(p + 4); f[0] = a[0]; f[1] = a[1]; f[2] = a[2]; f[3] = a[3]; f[4] = b[0]; f[5] = b[1]; f[6] = b[2]; f[7] = b[3]; }
__device__ __forceinline__ float ex2(float x) { return __builtin_amdgcn_exp2f(x); }
constexpr float LOG2E = 1.4426950408889634f, LN2 = 0.6931471805599453f;

__device__ __forceinline__ void rwkv_unit(int l, int b, int h, LAS unsigned char* L) {
    const int tid = opaque_tid(), lane = tid & 63, fr = lane & 15, fq = lane >> 4; const int w = __builtin_amdgcn_readfirstlane(tid >> 6);
    const Params p = load_params();
    const bf16_t* PA = (const bf16_t*)(p.ws + WS_PA); bf16_t* Yout = (bf16_t*)(p.ws + WS_YS) + (size_t)T * 512;
    const int t = tid >> 3, c8 = (tid & 7) * 8;
    const int tw = (lane >> 3);
    const int cw = 16 * (w & 3);
    const float* mu = p.rwkv_mu + l * 1664;
    LaneOff lo = lane_off(fr, fq);
#define SLOT(s) (L + (s) * TB)
    bf16x8 bup[2];
    { const float* U = ((w < 4) ? p.rwkv_w_up : p.rwkv_a_up) + (size_t)l * 64 * 512 + h * 64 + 16 * (w & 3) + fr;
#pragma unroll
      for (int kk = 0; kk < 2; ++kk) { float f[8];
#pragma unroll
          for (int e = 0; e < 8; ++e) f[e] = U[(size_t)(32 * kk + 8 * fq + e) * 512];
          bup[kk] = __builtin_bit_cast(bf16x8, pack8(f)); } }
    for (int e = tid; e < TB / 4; e += 512) { ((LAS unsigned*)SLOT(S_HT0))[e] = 0u; ((LAS unsigned*)SLOT(S_D))[e] = 0u; ((LAS unsigned*)SLOT(S_MOFF))[e] = 0u; ((LAS unsigned*)SLOT(S_MRB))[e] = 0u;
        ((LAS unsigned*)SLOT(S_ZT))[e] = 0u; ((LAS unsigned*)SLOT(S_ACC))[e] = 0u; }
    f32x4 hacc[4];
#pragma unroll
    for (int i = 0; i < 4; ++i) hacc[i] = (f32x4){0.f, 0.f, 0.f, 0.f};
    int hcur = S_HT0, hnxt = S_HT1;
    u32x4 raw[10];
#define RWKV_LOAD(c, t, c8) do { const size_t row_ = (size_t)b * SEQ + (c) * 64 + (t); const bf16_t* s_ = PA + row_ * NA; const bool hp_ = ((c) * 64 + (t)) > 0; const u32x4 z_ = {0u, 0u, 0u, 0u}; \
        raw[0] = *(const u32x4*)(s_ + RW_R + h * 64 + c8); raw[1] = hp_ ? *(const u32x4*)(s_ - NA + RW_R + h * 64 + c8) : z_; \
        raw[2] = *(const u32x4*)(s_ + RW_K + h * 64 + c8); raw[3] = hp_ ? *(const u32x4*)(s_ - NA + RW_K + h * 64 + c8) : z_; \
        raw[4] = *(const u32x4*)(s_ + RW_V + h * 64 + c8); raw[5] = hp_ ? *(const u32x4*)(s_ - NA + RW_V + h * 64 + c8) : z_; \
        raw[6] = *(const u32x4*)(s_ + RW_LW + c8); raw[7] = hp_ ? *(const u32x4*)(s_ - NA + RW_LW + c8) : z_; \
        raw[8] = *(const u32x4*)(s_ + RW_LA + c8); raw[9] = hp_ ? *(const u32x4*)(s_ - NA + RW_LA + c8) : z_; } while (0)
    for (int e = tid; e < 12 * 64; e += 512) { const int rw_ = e >> 6, i_ = e & 63; const int hci = l * 512 + h * 64 + i_; float val;
        switch (rw_) { case 0: val = mu[h * 64 + i_]; break; case 1: val = mu[512 + h * 64 + i_]; break; case 2: val = mu[1024 + h * 64 + i_]; break; case 3: val = mu[1536 + i_]; break; case 4: val = mu[1600 + i_]; break;
            case 5: val = p.rwkv_w0[hci]; break; case 6: val = p.rwkv_a0[hci]; break; case 7: val = p.rwkv_k_k[hci]; break; case 8: val = p.rwkv_k_a[hci]; break; case 9: val = p.rwkv_r_k[hci]; break;
            case 10: val = p.rwkv_ln_w[hci]; break; default: val = p.rwkv_ln_b[hci]; break; }
        ((LAS float*)(L + O_CST))[e] = val; }
#ifdef V_C
    if (tid < 48) { const int task = tid / 6 + 8 * (tid % 6); u32x4 d = {0u, 0u, 0u, 3u};
        if (task < 36) { int q, mn;
            if (task < 6) { q = 0; mn = (int)((0xEDC984ull >> (4 * task)) & 0xF); }
            else { q = 1 + (task - 6) / 10; mn = (int)((0xFEDCA98540ull >> (4 * ((task - 6) % 10))) & 0xF); }
            const int m0 = 16 * (mn >> 2), n0 = 16 * (mn & 3);
            d.x = (unsigned)(((q < 2) ? S_A : S_R) * TB + m0 * LP * 2); d.y = (unsigned)(((q & 1) ? S_K : S_B) * TB + n0 * LP * 2);
            d.z = (unsigned)(((q == 0) ? S_MOFF : (q == 1) ? S_MAK : (q == 2) ? S_MRB : S_MRK) * TB + (n0 * LP + m0) * 2);
            d.w = (m0 == n0) ? ((q < 2) ? 1u : 2u) : 0u;
        } else { const int z = task - 36; const int mn = (int)((0xB76321ull >> (4 * (z % 6))) & 0xF);
            d.z = (unsigned)(((z < 6) ? S_MAK : S_MRK) * TB + (16 * (mn & 3) * LP + 16 * (mn >> 2)) * 2); }
        *(LAS u32x2*)(L + O_TT + tid * 8) = (u32x2){(d.x >> 4) | ((d.y >> 4) << 16), (d.z >> 4) | (d.w << 16)}; }
#endif
    RWKV_LOAD(0, t, c8);
    __syncthreads();
    for (int c = 0; c < SEQ / 64; ++c) {
        int c8v = c8, tv = t, frv = fr, fqv = fq; asm volatile("" : "+v"(c8v), "+v"(tv), "+v"(frv), "+v"(fqv));
        const int twv = tv & 7;
        float r[8], kraw[8], v[8];
        { float cu[8], pr[8], m8[8], o[8];
#ifdef U_P1
          float m3_[8], m4_[8]; ld8l((const LAS float*)(L + O_CST) + 3 * 64 + c8v, m3_); ld8l((const LAS float*)(L + O_CST) + 4 * 64 + c8v, m4_);
#endif
          unpack8(raw[0], cu); unpack8(raw[1], pr); ld8l((const LAS float*)(L + O_CST) + 0 * 64 + c8v, m8);
#pragma unroll
          for (int e = 0; e < 8; ++e) r[e] = cu[e] + (pr[e] - cu[e]) * m8[e];
          unpack8(raw[2], cu); unpack8(raw[3], pr); ld8l((const LAS float*)(L + O_CST) + 1 * 64 + c8v, m8);
#pragma unroll
          for (int e = 0; e < 8; ++e) kraw[e] = cu[e] + (pr[e] - cu[e]) * m8[e];
          unpack8(raw[4], cu); unpack8(raw[5], pr); ld8l((const LAS float*)(L + O_CST) + 2 * 64 + c8v, m8);
#pragma unroll
          for (int e = 0; e < 8; ++e) v[e] = cu[e] + (pr[e] - cu[e]) * m8[e];
#ifdef V_V
          *(LAS u32x4*)(SLOT(S_V) + (tv * LP + c8v) * 2) = pack8(v);
#endif
#ifdef U_P1
          unpack8(raw[6], cu); unpack8(raw[7], pr);
#pragma unroll
          for (int e = 0; e < 8; ++e) { const float x = cu[e] + (pr[e] - cu[e]) * m3_[e]; o[e] = 1.0f - 2.0f * __builtin_amdgcn_rcpf(ex2(x * (2.0f * LOG2E)) + 1.0f); }
          *(LAS u32x4*)(SLOT(S_A) + (tv * LP + c8v) * 2) = pack8(o);
          unpack8(raw[8], cu); unpack8(raw[9], pr);
#pragma unroll
          for (int e = 0; e < 8; ++e) o[e] = cu[e] + (pr[e] - cu[e]) * m4_[e];
          *(LAS u32x4*)(SLOT(S_B) + (tv * LP + c8v) * 2) = pack8(o); }
#else
          unpack8(raw[6], cu); unpack8(raw[7], pr); ld8l((const LAS float*)(L + O_CST) + 3 * 64 + c8v, m8);
#pragma unroll
          for (int e = 0; e < 8; ++e) { const float x = cu[e] + (pr[e] - cu[e]) * m8[e]; o[e] = 1.0f - 2.0f * __builtin_amdgcn_rcpf(ex2(x * (2.0f * LOG2E)) + 1.0f); }
          *(LAS u32x4*)(SLOT(S_A) + (tv * LP + c8v) * 2) = pack8(o);
          unpack8(raw[8], cu); unpack8(raw[9], pr); ld8l((const LAS float*)(L + O_CST) + 4 * 64 + c8v, m8);
#pragma unroll
          for (int e = 0; e < 8; ++e) o[e] = cu[e] + (pr[e] - cu[e]) * m8[e];
          *(LAS u32x4*)(SLOT(S_B) + (tv * LP + c8v) * 2) = pack8(o); }
#endif
        __syncthreads();
        relaunder(lo);
#ifdef U_P2
        { const LAS unsigned char* X = (w < 4) ? SLOT(S_A) : SLOT(S_B); LAS float* Z = (LAS float*)(L + ((w < 4) ? O_ZW : O_ZA));
          f32x4 zacc[4];
#pragma unroll
          for (int m = 0; m < 4; ++m) { f32x4 a = {0.f, 0.f, 0.f, 0.f};
#pragma unroll
              for (int kk = 0; kk < 2; ++kk) a = MFMA16(frag_n(X, 16 * m, kk, lo), bup[kk], a);
              zacc[m] = a; }
#pragma unroll
          for (int m = 0; m < 4; ++m)
#pragma unroll
              for (int rr = 0; rr < 4; ++rr) Z[(16 * m + 4 * fqv + rr) * FP + cw + frv] = zacc[m][rr]; }
#else
        { const LAS unsigned char* X = (w < 4) ? SLOT(S_A) : SLOT(S_B); LAS float* Z = (LAS float*)(L + ((w < 4) ? O_ZW : O_ZA));
#pragma unroll
          for (int m = 0; m < 4; ++m) { f32x4 a = {0.f, 0.f, 0.f, 0.f};
#pragma unroll
              for (int kk = 0; kk < 2; ++kk) a = MFMA16(frag_n(X, 16 * m, kk, lo), bup[kk], a);
#pragma unroll
              for (int rr = 0; rr < 4; ++rr) Z[(16 * m + 4 * fqv + rr) * FP + cw + frv] = a[rr]; } }
#endif
        __syncthreads();
        float kk_[8], kp[8], bb[8], lw[8], cs[8], cb;
        { float zw[8], za[8], c0[8], c1[8];
          ld8l((const LAS float*)(L + O_ZW) + tv * FP + c8v, zw); ld8l((const LAS float*)(L + O_ZA) + tv * FP + c8v, za);
          ld8l((const LAS float*)(L + O_CST) + 5 * 64 + c8v, c0); ld8l((const LAS float*)(L + O_CST) + 6 * 64 + c8v, c1);
          float av[8];
#pragma unroll
#ifdef V_A
          for (int e = 0; e < 8; ++e) { lw[e] = -(LOG2E * 0.6065306597126334f) * __builtin_amdgcn_rcpf(1.0f + ex2(-(zw[e] + c0[e]) * LOG2E));
              av[e] = __builtin_amdgcn_rcpf(1.0f + ex2(-(za[e] + c1[e]) * LOG2E)); }
#else
          for (int e = 0; e < 8; ++e) { const float x = -(zw[e] + c0[e]); const float sp = fmaxf(x, 0.f) + LN2 * __builtin_amdgcn_logf(1.0f + ex2(-fabsf(x) * LOG2E));
              lw[e] = -LOG2E * ex2((-sp - 0.5f) * LOG2E);
              av[e] = __builtin_amdgcn_rcpf(1.0f + ex2(-(za[e] + c1[e]) * LOG2E)); }
#endif
          ld8l((const LAS float*)(L + O_CST) + 7 * 64 + c8v, c0); ld8l((const LAS float*)(L + O_CST) + 8 * 64 + c8v, c1);
          float ss = 0.f;
#pragma unroll
          for (int e = 0; e < 8; ++e) { kk_[e] = kraw[e] * c0[e]; ss += kk_[e] * kk_[e]; kp[e] = kraw[e] * (1.0f + (av[e] - 1.0f) * c1[e]); }
          ss = sum8(ss);
          const float inv = 1.0f / fmaxf(sqrtf(ss), 1e-12f);
          ld8l((const LAS float*)(L + O_CST) + 9 * 64 + c8v, c0);
          float cp = 0.f;
#pragma unroll
          for (int e = 0; e < 8; ++e) { kk_[e] *= inv; bb[e] = kk_[e] * av[e]; cp += r[e] * kp[e] * c0[e]; }
          cb = sum8(cp);
#pragma unroll
          for (int e = 0; e < 8; ++e) { float x = lw[e];
              float y = __shfl_up(x, 8); if (twv >= 1) x += y;
              y = __shfl_up(x, 16); if (twv >= 2) x += y;
              y = __shfl_up(x, 32); if (twv >= 4) x += y;
              cs[e] = x; }
          if (twv == 7) { LAS float* WT = (LAS float*)(L + O_WT) + w * 64 + c8v;
#pragma unroll
              for (int e = 0; e < 8; ++e) WT[e] = cs[e]; } }
        __syncthreads();
        { float off[8], tot[8];
#pragma unroll
          for (int e = 0; e < 8; ++e) { off[e] = 0.f; tot[e] = 0.f; }
#ifdef V_B
          { int wq = w; asm volatile("" : "+s"(wq));
#pragma unroll
            for (int g = 0; g < 8; ++g) { float x[8]; ld8l((const LAS float*)(L + O_WT) + g * 64 + c8v, x); const float mk = (g < wq) ? 1.0f : 0.0f;
#pragma unroll
                for (int e = 0; e < 8; ++e) { off[e] = __builtin_fmaf(x[e], mk, off[e]); tot[e] += x[e]; }
                if (g & 1) __builtin_amdgcn_sched_barrier(0); } }
#else
#pragma unroll
          for (int g = 0; g < 8; ++g) { float x[8]; ld8l((const LAS float*)(L + O_WT) + g * 64 + c8v, x);
#pragma unroll
              for (int e = 0; e < 8; ++e) { if (g < w) off[e] += x[e]; tot[e] += x[e]; } }
#endif
          if (tv == 0) { LAS float* CL = (LAS float*)(L + O_CL) + c8v;
#pragma unroll
              for (int e = 0; e < 8; ++e) CL[e] = tot[e]; }
          float o[8], en[8], ep[8]; const int toff = (tv * LP + c8v) * 2;
#pragma unroll
          for (int e = 0; e < 8; ++e) { cs[e] += off[e]; en[e] = ex2(-cs[e]); ep[e] = __builtin_amdgcn_rcpf(en[e]); o[e] = -kk_[e] * ep[e] * ex2(-lw[e]); }
          *(LAS u32x4*)(SLOT(S_A) + toff) = pack8(o);
#pragma unroll
          for (int e = 0; e < 8; ++e) o[e] = bb[e] * en[e];
          *(LAS u32x4*)(SLOT(S_B) + toff) = pack8(o);
#pragma unroll
          for (int e = 0; e < 8; ++e) o[e] = kp[e] * en[e];
          *(LAS u32x4*)(SLOT(S_K) + toff) = pack8(o);
#pragma unroll
          for (int e = 0; e < 8; ++e) o[e] = r[e] * ep[e];
          *(LAS u32x4*)(SLOT(S_R) + toff) = pack8(o);
#pragma unroll
          for (int e = 0; e < 8; ++e) { en[e] = ex2(tot[e] - cs[e]); o[e] = bb[e] * en[e]; }
          *(LAS u32x4*)(SLOT(S_BT) + toff) = pack8(o);
#pragma unroll
          for (int e = 0; e < 8; ++e) o[e] = kp[e] * en[e];
          *(LAS u32x4*)(SLOT(S_KT) + toff) = pack8(o);
#ifndef V_V
          *(LAS u32x4*)(SLOT(S_V) + toff) = pack8(v);
#endif
        }
        __syncthreads();
        relaunder(lo);
        int wv = w; asm volatile("" : "+s"(wv));
#if defined(LOAD_AT) && LOAD_AT == 4
        if (c + 1 < SEQ / 64) RWKV_LOAD(c + 1, tv, c8v);
#endif
#ifdef U_P4
        f32x4 tacc[5];
#pragma unroll
        for (int it = 0; it < 5; ++it) { const int task = wv + 8 * it; f32x4 a = {0.f, 0.f, 0.f, 0.f};
            if (task < 36) {
                int q, mn;
                if (task < 6) { q = 0; mn = (int)((0xEDC984ull >> (4 * task)) & 0xF); }
                else { q = 1 + (task - 6) / 10; mn = (int)((0xFEDCA98540ull >> (4 * ((task - 6) % 10))) & 0xF); }
                const int m0 = 16 * (mn >> 2), n0 = 16 * (mn & 3);
                const LAS unsigned char* XA = (q < 2) ? SLOT(S_A) : SLOT(S_R); const LAS unsigned char* XB = (q & 1) ? SLOT(S_K) : SLOT(S_B);
#pragma unroll
                for (int kk = 0; kk < 2; ++kk) a = MFMA16(frag_n(XA, m0, kk, lo), frag_n(XB, n0, kk, lo), a);
                if (m0 == n0) {
#pragma unroll
                    for (int rr = 0; rr < 4; ++rr) { const bool keep = (q < 2) ? (frv < 4 * fqv + rr) : (frv <= 4 * fqv + rr); a[rr] = keep ? a[rr] : 0.f; } } }
            tacc[it] = a; }
        if (wv < 4) {
            f32x4 a = {0.f, 0.f, 0.f, 0.f};
#pragma unroll
            for (int kk = 0; kk < 2; ++kk) a = MFMA16(frag_n(SLOT(S_A), 16 * wv, kk, lo), frag_n(SLOT(S_B), 16 * wv, kk, lo), a);
#pragma unroll
            for (int rr = 0; rr < 4; ++rr) a[rr] = (frv < 4 * fqv + rr) ? a[rr] : 0.f;
            float x[16];
            { LAS float* NS = (LAS float*)(SLOT(hnxt) + wv * 1024);
#pragma unroll
              for (int rr = 0; rr < 4; ++rr) NS[(4 * fqv + rr) * 16 + frv] = a[rr];
              asm volatile("s_waitcnt lgkmcnt(0)" ::: "memory");
#pragma unroll
              for (int rw = 0; rw < 16; ++rw) { float s = (rw == frv) ? 1.f : 0.f;
#pragma unroll
                  for (int sc = 0; sc < rw; ++sc) s = __builtin_fmaf(NS[rw * 16 + sc], x[sc], s);
                  x[rw] = s; }
              asm volatile("s_waitcnt lgkmcnt(0)" ::: "memory"); }
            if (fqv == 0) { LAS unsigned char* dp = SLOT(S_D) + ((16 * wv + frv) * LP + 16 * wv) * 2;
                float lo8[8], hi8[8];
#pragma unroll
                for (int e = 0; e < 8; ++e) { lo8[e] = x[e]; hi8[e] = x[8 + e]; }
                *(LAS u32x4*)dp = pack8(lo8); *(LAS u32x4*)(dp + 16) = pack8(hi8); }
        }
#pragma unroll
        for (int it = 0; it < 6; ++it) { const int task = wv + 8 * it;
            if (task < 36) {
                int q, mn;
                if (task < 6) { q = 0; mn = (int)((0xEDC984ull >> (4 * task)) & 0xF); }
                else { q = 1 + (task - 6) / 10; mn = (int)((0xFEDCA98540ull >> (4 * ((task - 6) % 10))) & 0xF); }
                st_tile_T(SLOT((q == 0) ? S_MOFF : (q == 1) ? S_MAK : (q == 2) ? S_MRB : S_MRK), 16 * (mn >> 2), 16 * (mn & 3), lo, tacc[it < 5 ? it : 4]);
            } else if (task < 48) {
                const int z = task - 36; const int mn = (int)((0xB76321ull >> (4 * (z % 6))) & 0xF);
                st_tile_T(SLOT((z < 6) ? S_MAK : S_MRK), 16 * (mn >> 2), 16 * (mn & 3), lo, (f32x4){0.f, 0.f, 0.f, 0.f});
            } }
#else
#ifdef V_C
        u32x4 dq[3];
#pragma unroll
        for (int j = 0; j < 3; ++j) dq[j] = *(const LAS u32x4*)(L + O_TT + wv * 48 + j * 16);
#endif
        if (wv < 4) {
            f32x4 a = {0.f, 0.f, 0.f, 0.f};
#pragma unroll
            for (int kk = 0; kk < 2; ++kk) a = MFMA16(frag_n(SLOT(S_A), 16 * wv, kk, lo), frag_n(SLOT(S_B), 16 * wv, kk, lo), a);
#pragma unroll
            for (int rr = 0; rr < 4; ++rr) a[rr] = (frv < 4 * fqv + rr) ? a[rr] : 0.f;
            float x[16];
            { LAS float* NS = (LAS float*)(SLOT(hnxt) + wv * 1024);
#pragma unroll
              for (int rr = 0; rr < 4; ++rr) NS[(4 * fqv + rr) * 16 + frv] = a[rr];
              asm volatile("s_waitcnt lgkmcnt(0)" ::: "memory");
#pragma unroll
              for (int rw = 0; rw < 16; ++rw) { float s = (rw == frv) ? 1.f : 0.f;
#pragma unroll
                  for (int sc = 0; sc < rw; ++sc) s = __builtin_fmaf(NS[rw * 16 + sc], x[sc], s);
                  x[rw] = s; }
              asm volatile("s_waitcnt lgkmcnt(0)" ::: "memory"); }
            if (fqv == 0) { LAS unsigned char* dp = SLOT(S_D) + ((16 * wv + frv) * LP + 16 * wv) * 2;
                float lo8[8], hi8[8];
#pragma unroll
                for (int e = 0; e < 8; ++e) { lo8[e] = x[e]; hi8[e] = x[8 + e]; }
                *(LAS u32x4*)dp = pack8(lo8); *(LAS u32x4*)(dp + 16) = pack8(hi8); }
        }
#ifdef V_C
        {
#pragma unroll
          for (int it = 0; it < 6; ++it) {
            const unsigned e0 = (unsigned)__builtin_amdgcn_readfirstlane((int)((it & 1) ? dq[it >> 1].z : dq[it >> 1].x)), e1 = (unsigned)__builtin_amdgcn_readfirstlane((int)((it & 1) ? dq[it >> 1].w : dq[it >> 1].y));
            const int mode = (int)(e1 >> 16); LAS unsigned char* dst = L + ((e1 & 0xffffu) << 4) + lo.bs;
            if (mode < 3) {
                const LAS unsigned char* pa = L + ((e0 & 0xffffu) << 4) + lo.bn; const LAS unsigned char* pb = L + ((e0 >> 16) << 4) + lo.bn;
                f32x4 a = MFMA16(*(const LAS bf16x8*)pa, *(const LAS bf16x8*)pb, (f32x4){0.f, 0.f, 0.f, 0.f});
                a = MFMA16(*(const LAS bf16x8*)(pa + 64), *(const LAS bf16x8*)(pb + 64), a);
                if (mode) { const int thr = frv + ((mode == 1) ? 1 : 0);
#pragma unroll
                    for (int rr = 0; rr < 4; ++rr) a[rr] = (thr <= 4 * fqv + rr) ? a[rr] : 0.f; }
                u32x2 wq_; wq_.x = pk2(a[0], a[1]); wq_.y = pk2(a[2], a[3]); *(LAS u32x2*)dst = wq_;
            } else { *(LAS u32x2*)dst = (u32x2){0u, 0u}; } } }
#else
#pragma unroll
        for (int it = 0; it < 6; ++it) { const int task = wv + 8 * it;
            if (task < 36) {
                int q, mn;
                if (task < 6) { q = 0; mn = (int)((0xEDC984ull >> (4 * task)) & 0xF); }
                else { q = 1 + (task - 6) / 10; mn = (int)((0xFEDCA98540ull >> (4 * ((task - 6) % 10))) & 0xF); }
                const int m0 = 16 * (mn >> 2), n0 = 16 * (mn & 3);
                const LAS unsigned char* XA = (q < 2) ? SLOT(S_A) : SLOT(S_R); const LAS unsigned char* XB = (q & 1) ? SLOT(S_K) : SLOT(S_B);
                f32x4 a = {0.f, 0.f, 0.f, 0.f};
#pragma unroll
                for (int kk = 0; kk < 2; ++kk) a = MFMA16(frag_n(XA, m0, kk, lo), frag_n(XB, n0, kk, lo), a);
                if (m0 == n0) {
#pragma unroll
                    for (int rr = 0; rr < 4; ++rr) { const bool keep = (q < 2) ? (frv < 4 * fqv + rr) : (frv <= 4 * fqv + rr); a[rr] = keep ? a[rr] : 0.f; } }
                st_tile_T(SLOT((q == 0) ? S_MOFF : (q == 1) ? S_MAK : (q == 2) ? S_MRB : S_MRK), m0, n0, lo, a);
            } else if (task < 48) {
                const int z = task - 36; const int mn = (int)((0xB76321ull >> (4 * (z % 6))) & 0xF);
                st_tile_T(SLOT((z < 6) ? S_MAK : S_MRK), 16 * (mn >> 2), 16 * (mn & 3), lo, (f32x4){0.f, 0.f, 0.f, 0.f});
            } }
#endif
#endif
        __syncthreads();
        relaunder(lo);
#if defined(LOAD_AT) && LOAD_AT == 5
        if (c + 1 < SEQ / 64) RWKV_LOAD(c + 1, tv, c8v);
#endif
        f32x4 yacc[4];
#ifdef U_P5
        if (w < 4) {
            f32x4 xr[4];
#pragma unroll
            for (int i = 0; i < 4; ++i) { f32x4 a = {0.f, 0.f, 0.f, 0.f};
#pragma unroll
                for (int kk = 0; kk < 2; ++kk) { if (32 * kk < 16 * i + 16) a = MFMA16(frag_t(SLOT(S_MAK), kk, 16 * i, lo), frag_t(SLOT(S_V), kk, cw, lo), a);
                    a = MFMA16(frag_n(SLOT(S_A), 16 * i, kk, lo), frag_n(SLOT(hcur), cw, kk, lo), a); }
                xr[i] = a; }
#pragma unroll
            for (int i = 0; i < 4; ++i) { f32x4 a = xr[i];
#pragma unroll
                for (int kk = 0; kk < 2; ++kk) if (32 * kk < 16 * i) a = MFMA16(frag_t(SLOT(S_MOFF), kk, 16 * i, lo), frag_n(SLOT(S_ZT), cw, kk, lo), a);
                st_tile_T(SLOT(S_ACC), 16 * i, cw, lo, a);
                asm volatile("" ::: "memory");
                const f32x4 z = MFMA16(frag_t(SLOT(S_D), i >> 1, 16 * i, lo), frag_n(SLOT(S_ACC), cw, i >> 1, lo), (f32x4){0.f, 0.f, 0.f, 0.f});
                st_tile_T(SLOT(S_ZT), 16 * i, cw, lo, z);
                asm volatile("" ::: "memory"); }
#else
        if (w < 4) {
#pragma unroll
            for (int i = 0; i < 4; ++i) { f32x4 a = {0.f, 0.f, 0.f, 0.f};
#pragma unroll
                for (int kk = 0; kk < 2; ++kk) { if (32 * kk < 16 * i + 16) a = MFMA16(frag_t(SLOT(S_MAK), kk, 16 * i, lo), frag_t(SLOT(S_V), kk, cw, lo), a);
                    a = MFMA16(frag_n(SLOT(S_A), 16 * i, kk, lo), frag_n(SLOT(hcur), cw, kk, lo), a); }
#pragma unroll
                for (int kk = 0; kk < 2; ++kk) if (32 * kk < 16 * i) a = MFMA16(frag_t(SLOT(S_MOFF), kk, 16 * i, lo), frag_n(SLOT(S_ZT), cw, kk, lo), a);
                st_tile_T(SLOT(S_ACC), 16 * i, cw, lo, a);
                const f32x4 z = MFMA16(frag_t(SLOT(S_D), i >> 1, 16 * i, lo), frag_n(SLOT(S_ACC), cw, i >> 1, lo), (f32x4){0.f, 0.f, 0.f, 0.f});
                st_tile_T(SLOT(S_ZT), 16 * i, cw, lo, z); }
#endif
        } else {
#pragma unroll
            for (int i = 0; i < 4; ++i) { f32x4 a = {0.f, 0.f, 0.f, 0.f};
#pragma unroll
                for (int kk = 0; kk < 2; ++kk) { if (32 * kk < 16 * i + 16) a = MFMA16(frag_t(SLOT(S_MRK), kk, 16 * i, lo), frag_t(SLOT(S_V), kk, cw, lo), a);
                    a = MFMA16(frag_n(SLOT(S_R), 16 * i, kk, lo), frag_n(SLOT(hcur), cw, kk, lo), a);
                }
                yacc[i] = a; }
        }
        __syncthreads();
        relaunder(lo);
#if !defined(LOAD_AT)
        if (c + 1 < SEQ / 64) RWKV_LOAD(c + 1, tv, c8v);
#endif
#ifdef U_P7
        if (w >= 4) {
#pragma unroll
            for (int i = 0; i < 4; ++i) {
#pragma unroll
                for (int rr = 0; rr < 4; ++rr) hacc[i][rr] = hacc[i][rr] * ex2(((const LAS float*)(L + O_CL))[16 * i + 4 * fqv + rr]);
#pragma unroll
                for (int kk = 0; kk < 2; ++kk) { hacc[i] = MFMA16(frag_t(SLOT(S_KT), kk, 16 * i, lo), frag_t(SLOT(S_V), kk, cw, lo), hacc[i]);
                    hacc[i] = MFMA16(frag_t(SLOT(S_BT), kk, 16 * i, lo), frag_n(SLOT(S_ZT), cw, kk, lo), hacc[i]); }
#pragma unroll
                for (int kk = 0; kk < 2; ++kk) if (32 * kk < 16 * i + 16) yacc[i] = MFMA16(frag_t(SLOT(S_MRB), kk, 16 * i, lo), frag_n(SLOT(S_ZT), cw, kk, lo), yacc[i]); }
#pragma unroll
            for (int i = 0; i < 4; ++i) { st_tile_T(SLOT(hnxt), 16 * i, cw, lo, hacc[i]);
#pragma unroll
                for (int rr = 0; rr < 4; ++rr) ((LAS float*)(L + O_YB))[(16 * i + 4 * fqv + rr) * FP + cw + frv] = yacc[i][rr]; }
        }
#else
        if (w >= 4) {
#pragma unroll
            for (int i = 0; i < 4; ++i) {
#pragma unroll
                for (int rr = 0; rr < 4; ++rr) hacc[i][rr] = hacc[i][rr] * ex2(((const LAS float*)(L + O_CL))[16 * i + 4 * fqv + rr]);
#pragma unroll
                for (int kk = 0; kk < 2; ++kk) { hacc[i] = MFMA16(frag_t(SLOT(S_KT), kk, 16 * i, lo), frag_t(SLOT(S_V), kk, cw, lo), hacc[i]);
                    hacc[i] = MFMA16(frag_t(SLOT(S_BT), kk, 16 * i, lo), frag_n(SLOT(S_ZT), cw, kk, lo), hacc[i]); }
                st_tile_T(SLOT(hnxt), 16 * i, cw, lo, hacc[i]);
#pragma unroll
                for (int kk = 0; kk < 2; ++kk) if (32 * kk < 16 * i + 16) yacc[i] = MFMA16(frag_t(SLOT(S_MRB), kk, 16 * i, lo), frag_n(SLOT(S_ZT), cw, kk, lo), yacc[i]);
#pragma unroll
                for (int rr = 0; rr < 4; ++rr) ((LAS float*)(L + O_YB))[(16 * i + 4 * fqv + rr) * FP + cw + frv] = yacc[i][rr]; }
        }
#endif
        __syncthreads();
        { float y[8], g0[8], g1[8]; ld8l((const LAS float*)(L + O_YB) + tv * FP + c8v, y); ld8l((const LAS float*)(L + O_CST) + 10 * 64 + c8v, g0); ld8l((const LAS float*)(L + O_CST) + 11 * 64 + c8v, g1);
          float s = 0.f;
#pragma unroll
          for (int e = 0; e < 8; ++e) s += y[e];
          const float mean = sum8(s) * (1.f / 64.f); float q = 0.f;
#pragma unroll
          for (int e = 0; e < 8; ++e) { y[e] -= mean; q += y[e] * y[e]; }
          const float rs = rsqrtf(sum8(q) * (1.f / 64.f) + RWKV_GN_EPS);
#ifdef V_V
          float vv[8]; unpack8(*(const LAS u32x4*)(SLOT(S_V) + (tv * LP + c8v) * 2), vv);
#pragma unroll
          for (int e = 0; e < 8; ++e) y[e] = y[e] * rs * g0[e] + g1[e] + cb * vv[e];
#else
#pragma unroll
          for (int e = 0; e < 8; ++e) y[e] = y[e] * rs * g0[e] + g1[e] + cb * v[e];
#endif
          *(u32x4*)(Yout + ((size_t)b * SEQ + c * 64 + tv) * 512 + h * 64 + c8v) = pack8(y); }
        { const int tmp = hcur; hcur = hnxt; hnxt = tmp; }
    }
    __syncthreads();
#undef SLOT
#undef RWKV_LOAD
}
}

namespace gla {
using rwkv::vtr; using rwkv::unpack8; using rwkv::pack8; using rwkv::ld8l; using rwkv::ex2; using rwkv::LOG2E; using rwkv::LN2; using rwkv::MFMA16;
constexpr int LP = 72, VP = 136, TB = 64 * LP * 2;
constexpr int B_QH = 0, B_KH = TB, B_KT = 2 * TB, B_PT = 3 * TB, B_VV = 4 * TB, B_ST = B_VV + 64 * VP * 2, B_OB = B_ST + 128 * LP * 2, B_WT = B_OB + 64 * 132 * 4,
              B_CL = B_WT + 8 * 64 * 4, B_AUP = B_CL + 64 * 4, B_AB = B_AUP + 16 * 64 * 4, B_GN = B_AB + 64 * 4, B_END = B_GN + 128 * 4;
static_assert(B_END <= 131072, "gla lds");
struct LaneOff { int bn, bt, btv, bs; };
__device__ __forceinline__ LaneOff lane_off(int fr, int fq) { LaneOff o; o.bn = (fr * LP + 8 * fq) * 2; o.bt = ((8 * fq + (fr >> 2)) * LP + 4 * (fr & 3)) * 2; o.btv = ((8 * fq + (fr >> 2)) * VP + 4 * (fr & 3)) * 2; o.bs = (fr * LP + 4 * fq) * 2; return o; }
__device__ __forceinline__ void relaunder(LaneOff& o) { asm volatile("" : "+v"(o.bn), "+v"(o.bt), "+v"(o.btv), "+v"(o.bs)); }
__device__ __forceinline__ bf16x8 frag_t(const LAS unsigned char* tile, int kk, int c0, const LaneOff& o) {
    const LAS unsigned char* q = tile + o.bt + (32 * kk * LP + c0) * 2; const s16x4 lo = vtr(q), hi = vtr(q + 4 * LP * 2); return (bf16x8){lo[0], lo[1], lo[2], lo[3], hi[0], hi[1], hi[2], hi[3]}; }
__device__ __forceinline__ bf16x8 frag_tv(const LAS unsigned char* tile, int kk, int c0, const LaneOff& o) {
    const LAS unsigned char* q = tile + o.btv + (32 * kk * VP + c0) * 2; const s16x4 lo = vtr(q), hi = vtr(q + 4 * VP * 2); return (bf16x8){lo[0], lo[1], lo[2], lo[3], hi[0], hi[1], hi[2], hi[3]}; }
__device__ __forceinline__ bf16x8 frag_n(const LAS unsigned char* tile, int r0, int kk, const LaneOff& o) { return *(const LAS bf16x8*)(tile + o.bn + (r0 * LP + 32 * kk) * 2); }
__device__ __forceinline__ void st_tile_T(LAS unsigned char* tile, int m0, int n0, const LaneOff& o, const f32x4 c) { u32x2 w; w.x = pk2(c[0], c[1]); w.y = pk2(c[2], c[3]); *(LAS u32x2*)(tile + o.bs + (n0 * LP + m0) * 2) = w; }

__device__ __forceinline__ void gla_unit(int l, int b, int h, LAS unsigned char* L, unsigned* done_ctr) {
    const Params p = load_params();
    const bf16_t* PA = (const bf16_t*)(p.ws + WS_PA); bf16_t* Yout = (bf16_t*)(p.ws + WS_YS) + (size_t)2 * T * 512;
    const int tid = opaque_tid(), lane = tid & 63, fr = lane & 15, fq = lane >> 4; const int w = __builtin_amdgcn_readfirstlane(tid >> 6);
    const int t = tid >> 3, c8 = (tid & 7) * 8;
    LaneOff lo = lane_off(fr, fq);
    for (int e = tid; e < 16 * 64; e += 512) ((LAS float*)(L + B_AUP))[e] = p.gla_a_up[(size_t)l * 16 * 256 + (e >> 6) * 256 + h * 64 + (e & 63)];
    if (tid < 64) ((LAS float*)(L + B_AB))[tid] = p.gla_a_b[l * 256 + h * 64 + tid];
    if (tid < 128) ((LAS float*)(L + B_GN))[tid] = p.gla_norm[l * 512 + h * 128 + tid];
    for (int e = tid; e < 128 * LP / 2; e += 512) ((LAS unsigned*)(L + B_ST))[e] = 0u;
    for (int e = tid; e < TB / 4; e += 512) ((LAS unsigned*)(L + B_PT))[e] = 0u;
    f32x4 sacc[4];
#pragma unroll
    for (int m = 0; m < 4; ++m) sacc[m] = (f32x4){0.f, 0.f, 0.f, 0.f};
    u32x4 rq, rk, rv0, rv1, rl0, rl1;
#define GLA_LOAD(c) do { const bf16_t* s_ = PA + ((size_t)b * SEQ + (c) * 64 + t) * NA; rq = *(const u32x4*)(s_ + GQ + h * 64 + c8); rk = *(const u32x4*)(s_ + GK + h * 64 + c8); \
        rv0 = *(const u32x4*)(s_ + GV + h * 128 + 2 * c8); rv1 = *(const u32x4*)(s_ + GV + h * 128 + 2 * c8 + 8); rl0 = *(const u32x4*)(s_ + GLAT); rl1 = *(const u32x4*)(s_ + GLAT + 8); } while (0)
    GLA_LOAD(0);
    __syncthreads();
    for (int c = 0; c < SEQ / 64; ++c) {
        int c8v = c8, tv = t, frv = fr, fqv = fq; asm volatile("" : "+v"(c8v), "+v"(tv), "+v"(frv), "+v"(fqv));
        const int twv = tv & 7;
        float cs[8];
        { float lat[16]; { float a8[8]; unpack8(rl0, a8);
#pragma unroll
              for (int j = 0; j < 8; ++j) lat[j] = a8[j];
              unpack8(rl1, a8);
#pragma unroll
              for (int j = 0; j < 8; ++j) lat[8 + j] = a8[j]; }
          float z[8]; ld8l((const LAS float*)(L + B_AB) + c8v, z);
#pragma unroll
          for (int j = 0; j < 16; ++j) { float a8[8]; ld8l((const LAS float*)(L + B_AUP) + j * 64 + c8v, a8);
#pragma unroll
              for (int e = 0; e < 8; ++e) z[e] += lat[j] * a8[e]; }
#pragma unroll
          for (int e = 0; e < 8; ++e) { const float x = -z[e]; const float sp = fmaxf(x, 0.f) + LN2 * __builtin_amdgcn_logf(1.0f + ex2(-fabsf(x) * LOG2E));
              float v_ = -sp * (LOG2E / 16.0f);
              float y = __shfl_up(v_, 8); if (twv >= 1) v_ += y;
              y = __shfl_up(v_, 16); if (twv >= 2) v_ += y;
              y = __shfl_up(v_, 32); if (twv >= 4) v_ += y;
              cs[e] = v_; }
          if (twv == 7) { LAS float* WT = (LAS float*)(L + B_WT) + w * 64 + c8v;
#pragma unroll
              for (int e = 0; e < 8; ++e) WT[e] = cs[e]; } }
        __syncthreads();
        { float off[8], tot[8];
#pragma unroll
          for (int e = 0; e < 8; ++e) { off[e] = 0.f; tot[e] = 0.f; }
#pragma unroll
          for (int g = 0; g < 8; ++g) { float x[8]; ld8l((const LAS float*)(L + B_WT) + g * 64 + c8v, x);
#pragma unroll
              for (int e = 0; e < 8; ++e) { if (g < w) off[e] += x[e]; tot[e] += x[e]; } }
          if (tv == 0) { LAS float* CL = (LAS float*)(L + B_CL) + c8v;
#pragma unroll
              for (int e = 0; e < 8; ++e) CL[e] = tot[e]; }
          float q8[8], k8[8], o[8], en[8]; unpack8(rq, q8); unpack8(rk, k8); const int toff = (tv * LP + c8v) * 2;
#pragma unroll
          for (int e = 0; e < 8; ++e) { cs[e] += off[e]; en[e] = ex2(-cs[e]); o[e] = q8[e] * 0.125f * __builtin_amdgcn_rcpf(en[e]); }
          *(LAS u32x4*)(L + B_QH + toff) = pack8(o);
#pragma unroll
          for (int e = 0; e < 8; ++e) o[e] = k8[e] * en[e];
          *(LAS u32x4*)(L + B_KH + toff) = pack8(o);
#pragma unroll
          for (int e = 0; e < 8; ++e) o[e] = k8[e] * ex2(tot[e] - cs[e]);
          *(LAS u32x4*)(L + B_KT + toff) = pack8(o);
          *(LAS u32x4*)(L + B_VV + (tv * VP + 2 * c8v) * 2) = rv0; *(LAS u32x4*)(L + B_VV + (tv * VP + 2 * c8v + 8) * 2) = rv1; }
        if (c + 1 < SEQ / 64) GLA_LOAD(c + 1);
        __syncthreads();
        relaunder(lo);
        { const int m0 = 16 * (w >> 1);
#pragma unroll
          for (int nn = 0; nn < 2; ++nn) { const int n0 = 32 * (w & 1) + 16 * nn;
              if (n0 <= m0) { f32x4 a = {0.f, 0.f, 0.f, 0.f};
#pragma unroll
                  for (int kk = 0; kk < 2; ++kk) a = MFMA16(frag_n(L + B_QH, m0, kk, lo), frag_n(L + B_KH, n0, kk, lo), a);
                  if (n0 == m0) {
#pragma unroll
                      for (int rr = 0; rr < 4; ++rr) a[rr] = (frv <= 4 * fqv + rr) ? a[rr] : 0.f; }
                  st_tile_T(L + B_PT, m0, n0, lo, a); } } }
        __syncthreads();
        relaunder(lo);
        { const int n0 = 16 * w;
#pragma unroll
          for (int m = 0; m < 4; ++m) { f32x4 a = {0.f, 0.f, 0.f, 0.f};
#pragma unroll
              for (int kk = 0; kk < 2; ++kk) { if (32 * kk < 16 * m + 16) a = MFMA16(frag_t(L + B_PT, kk, 16 * m, lo), frag_tv(L + B_VV, kk, n0, lo), a);
                  a = MFMA16(frag_n(L + B_QH, 16 * m, kk, lo), frag_n(L + B_ST, n0, kk, lo), a); }
#pragma unroll
              for (int rr = 0; rr < 4; ++rr) ((LAS float*)(L + B_OB))[(16 * m + 4 * fqv + rr) * 132 + n0 + frv] = a[rr]; }
          asm volatile("" ::: "memory");
#pragma unroll
          for (int m = 0; m < 4; ++m) { f32x4 a = sacc[m];
#pragma unroll
              for (int rr = 0; rr < 4; ++rr) a[rr] *= ex2(((const LAS float*)(L + B_CL))[16 * m + 4 * fqv + rr]);
#pragma unroll
              for (int kk = 0; kk < 2; ++kk) a = MFMA16(frag_t(L + B_KT, kk, 16 * m, lo), frag_tv(L + B_VV, kk, n0, lo), a);
              sacc[m] = a; st_tile_T(L + B_ST, 16 * m, n0, lo, a); } }
        __syncthreads();
        { float v0[8], v1[8], g0[8], g1[8]; float ss = 0.f; const LAS float* ob = (const LAS float*)(L + B_OB) + tv * 132 + 2 * c8v;
          ld8l(ob, v0); ld8l(ob + 8, v1);
#pragma unroll
          for (int e = 0; e < 8; ++e) ss += v0[e] * v0[e] + v1[e] * v1[e];
          ss = sum8(ss);
          const float rstd = rsqrtf(ss * (1.f / 128.f) + NORM_EPS);
          ld8l((const LAS float*)(L + B_GN) + 2 * c8v, g0); ld8l((const LAS float*)(L + B_GN) + 2 * c8v + 8, g1);
          float o0[8], o1[8];
#pragma unroll
          for (int e = 0; e < 8; ++e) { o0[e] = v0[e] * rstd * g0[e]; o1[e] = v1[e] * rstd * g1[e]; }
          bf16_t* dst = Yout + ((size_t)b * SEQ + c * 64 + tv) * 512 + h * 128 + 2 * c8v;
          *(u32x4*)dst = pack8(o0); *(u32x4*)(dst + 8) = pack8(o1); }
    }
    asm volatile("s_waitcnt vmcnt(0)" ::: "memory");
    __syncthreads();
    if (tid == 0) __hip_atomic_fetch_add(done_ctr, 1u, __ATOMIC_RELEASE, __HIP_MEMORY_SCOPE_AGENT);
#undef GLA_LOAD
}
}

#define XB_TMO      128
#define XB_XCNT(j)  (256  + 64 * (j))
#define XB_XSUB(j)  (1280 + 64 * (j))
#define XB_XGEN(j)  (2304 + 64 * (j))
#define XB_TOP      3328
#define XB_TOPGEN   3392
#define XCD_BAR_WORDS 3456
#define XB_SPIN_CAP (1u << 18)

__device__ __forceinline__ unsigned xb_ld(unsigned* p)              { return __hip_atomic_load(p, __ATOMIC_RELAXED, __HIP_MEMORY_SCOPE_AGENT); }
__device__ __forceinline__ unsigned xb_add(unsigned* p, unsigned v) { return __hip_atomic_fetch_add(p, v, __ATOMIC_RELAXED, __HIP_MEMORY_SCOPE_AGENT); }
__device__ __forceinline__ unsigned xb_xcc_id() { return (unsigned)__builtin_amdgcn_s_getreg((3 << 11) | 20) & 0xFu; }
#define XB_SPIN(cond, bar) do { unsigned _sp = 0; while (cond) { __builtin_amdgcn_s_sleep(1); \
    if ((++_sp & 255u) == 0u) { if (xb_ld(&(bar)[XB_TMO])) break; if (_sp > XB_SPIN_CAP) { atomicAdd(&(bar)[XB_TMO], 1u); break; } } } } while (0)

struct XcdBarrier {
    unsigned* bar; unsigned x;
    volatile LAS unsigned* st;
};

__device__ __forceinline__ XcdBarrier xcd_barrier_post(unsigned* bar, volatile LAS unsigned* st) {
    XcdBarrier b; b.bar = bar; b.x = xb_xcc_id(); b.st = st;
    if (threadIdx.x == 0) (void)xb_add(&bar[XB_XCNT(b.x)], 1u);
    return b;
}
__device__ __forceinline__ void xcd_barrier_complete(unsigned* bar, unsigned x, unsigned& nloc, unsigned& nx) {
    const unsigned G = gridDim.x * gridDim.y * gridDim.z;
    unsigned sum, cnt, mine, sp = 0u;
    for (;;) {
        sum = 0u; cnt = 0u; mine = 0u;
#pragma unroll
        for (unsigned j = 0; j < 16; ++j) { const unsigned c = xb_ld(&bar[XB_XCNT(j)]); sum += c; cnt += (c > 0u) ? 1u : 0u; mine = (j == x) ? c : mine; }
        if (sum == G) break;
        __builtin_amdgcn_s_sleep(1);
        if ((++sp & 255u) == 0u) { if (xb_ld(&bar[XB_TMO])) break; if (sp > XB_SPIN_CAP) { atomicAdd(&bar[XB_TMO], 1u); break; } }
    }
    nloc = mine > 0u ? mine : 1u; nx = cnt > 0u ? cnt : 1u;
}

__device__ __forceinline__ void xcd_barrier(const XcdBarrier& b) {
    asm volatile("s_waitcnt vmcnt(0)" ::: "memory");
    __syncthreads();
    if (threadIdx.x == 0) {
        unsigned* bar = b.bar;
        __builtin_amdgcn_s_waitcnt(0);
        unsigned nloc = b.st[0], nx = b.st[1];
        if (nloc == 0u) { xcd_barrier_complete(bar, b.x, nloc, nx); b.st[0] = nloc; b.st[1] = nx; }
        const unsigned old = xb_add(&bar[XB_XSUB(b.x)], 1u);
        const unsigned gen = old / nloc;
        if (old + 1u == (gen + 1u) * nloc) {
            __builtin_amdgcn_fence(__ATOMIC_RELEASE, "agent");
            asm volatile("s_waitcnt vmcnt(0)" ::: "memory");
            const unsigned og = xb_add(&bar[XB_TOP], 1u);
            const unsigned tg = og / nx;
            if (og + 1u == (tg + 1u) * nx) xb_add(&bar[XB_TOPGEN], 1u);
            else XB_SPIN(xb_ld(&bar[XB_TOPGEN]) == tg, bar);
            __builtin_amdgcn_fence(__ATOMIC_ACQUIRE, "agent");
            xb_add(&bar[XB_XGEN(b.x)], 1u);
            asm volatile("s_waitcnt vmcnt(0)" ::: "memory");
        } else {
            XB_SPIN(xb_ld(&bar[XB_XGEN(b.x)]) == gen, bar);
            __builtin_amdgcn_fence(__ATOMIC_ACQUIRE, "agent");
            asm volatile("s_waitcnt vmcnt(0)" ::: "memory");
        }
    }
    __syncthreads();
}

constexpr int NWAVES = 8, NTHREADS = 512;
constexpr int LDS_MISC = 155648, LDS_BYTES = 159744;
constexpr int PH_PER_LAYER = 8, N_PHASES = 1 + DEPTH * PH_PER_LAYER;
constexpr int CW_BAR = 4096;
constexpr int MG_BLOCKS = 192;
constexpr int RWKV_BLOCKS = 64, GLA_BLOCKS = 32, SUB_BLOCKS = 256 - RWKV_BLOCKS - GLA_BLOCKS;
constexpr int N_ATT_UNITS = 64 * (SEQ / 512), N_MIX_ITEMS = N_ATT_UNITS;
#ifndef MK_MULTI_LAUNCH
#define MK_MULTI_LAUNCH 0
#endif

__device__ __forceinline__ void sub_barrier(unsigned* cnt, unsigned target) {
    asm volatile("s_waitcnt vmcnt(0)" ::: "memory");
    __syncthreads();
    if (threadIdx.x == 0) {
        __builtin_amdgcn_fence(__ATOMIC_RELEASE, "agent"); asm volatile("s_waitcnt vmcnt(0)" ::: "memory");
        __hip_atomic_fetch_add(cnt, 1u, __ATOMIC_RELAXED, __HIP_MEMORY_SCOPE_AGENT);
        unsigned sp = 0; while (__hip_atomic_load(cnt, __ATOMIC_RELAXED, __HIP_MEMORY_SCOPE_AGENT) < target && ++sp < (1u << 24)) __builtin_amdgcn_s_sleep(2);
        __builtin_amdgcn_fence(__ATOMIC_ACQUIRE, "agent"); asm volatile("s_waitcnt vmcnt(0)" ::: "memory");
    }
    __syncthreads();
}
__global__ void __launch_bounds__(NTHREADS, 2) hybrid_fwd(Params p_unused) {
    extern __shared__ __attribute__((aligned(16))) unsigned char lds[];
#ifndef NO_CG_SYNC
    cg::grid_group grid = cg::this_grid();
#endif
#define G ((int)gridDim.x)
#define bx ((int)blockIdx.x)
#define NGW (G * NWAVES)
#define PHASE_VARS const int tid = opaque_tid(), lane = tid & 63, wave = __builtin_amdgcn_readfirstlane(tid >> 6), gw = bx * NWAVES + wave; (void)lane; (void)gw
    LAS unsigned char* ldsl = (LAS unsigned char*)lds;
    { volatile LAS unsigned* misc = (volatile LAS unsigned*)(ldsl + LDS_MISC); if (threadIdx.x < 64) misc[threadIdx.x] = 0u; __syncthreads(); }
    (void)xcd_barrier_post((unsigned*)(kargs()->ws + WS_CTL) + CW_BAR, (volatile LAS unsigned*)(ldsl + LDS_MISC) + 8);
#define GRID_BAR() do { XcdBarrier xb_; xb_.bar = (unsigned*)(kargs()->ws + WS_CTL) + CW_BAR; xb_.x = xb_xcc_id(); xb_.st = (volatile LAS unsigned*)(ldsl + LDS_MISC) + 8; xcd_barrier(xb_); } while (0)
#ifndef EPI_ALIGN_PD1
#define EPI_ALIGN_PD1 true
#endif
#ifndef EPI_ALIGN_PA2
#define EPI_ALIGN_PA2 true
#endif
#ifndef REPEAT_PH
#define REPEAT_PH 0
#endif
#ifndef PH_MASK
#define PH_MASK 0xFFFF
#endif
#ifndef MIX_MASK
#define MIX_MASK 7
#endif
#define IN(k) true
#define EN(b) ((PH_MASK >> (b)) & 1)
#ifdef NO_CG_SYNC
#define SEAM(k) do { if (IN(k) && IN((k) + 1)) { GRID_BAR(); } } while (0)
#else
#define SEAM(k) do { if (IN(k) && IN((k) + 1)) { if ((k) == 0) grid.sync(); else GRID_BAR(); } } while (0)
#endif
#define WSP(type, off) ((type*)(ws + (off)))
#ifdef PROBE_TS_A
#define TS_PTR ((unsigned long long*)(kargs()->ws + WS_CTL + 40960))
#define TS_E0 ((volatile LAS unsigned long long*)(ldsl + LDS_MISC + 256))
#define TS_SET(i) do { if (l == 1 && threadIdx.x == 0) { if ((i) == 0) TS_E0[0] = (unsigned long long)__builtin_amdgcn_s_memrealtime(); else { const unsigned long long t_ = (unsigned long long)__builtin_amdgcn_s_memrealtime() - TS_E0[0]; atomicMax(TS_PTR + (i), t_); } } } while (0)
#define TS_MAX(i) do { if (l == 1 && threadIdx.x == 0) { const unsigned long long t_ = (unsigned long long)__builtin_amdgcn_s_memrealtime() - TS_E0[0]; atomicMax(TS_PTR + (i), t_); atomicMax(TS_PTR + (i) + 1, ~t_); } } while (0)
#else
#define TS_SET(i) do { } while (0)
#define TS_MAX(i) do { } while (0)
#endif

    if (EN(0) && IN(0)) { PHASE_VARS;
        convert_weights(0, lds, gw, NGW, wave, lane);
        KArgs kp = kargs(); unsigned char* ws = kp->ws; const int* positions = kp->positions; const float* x = kp->x; const float* g = kp->norm_pre;
        f32x2* ROPE = WSP(f32x2, WS_ROPE); bf16_t* HB = WSP(bf16_t, WS_HB);
        for (int i = bx * NTHREADS + tid; i < T * 16; i += G * NTHREADS) {
            const int t = i >> 4, j = i & 15; const float inv = exp2f(-(float)j * (13.287712379549449f / 16.0f));
            const float ang = (float)positions[t] * inv; const float k = rintf(ang * 0.15915494309189535f);
            float r = fmaf(-k, 6.2831854820251465f, ang); r = fmaf(-k, -1.7484555314695172e-7f, r);
            ROPE[i] = (f32x2){__cosf(r), __sinf(r)};
        }
        for (int m = gw; m < T; m += 4 * NGW) hb_rows4(x, g, HB, m, NGW, lane);
    }
    SEAM(0);
#ifdef EXTRA_SYNCS
    for (int i = 0; i < EXTRA_SYNCS; ++i) GRID_BAR();
#endif

    for (int l = 0; l < DEPTH; ++l) {
        const int P0 = 1 + l * PH_PER_LAYER;
        for (int rp = 0; rp < ((REPEAT_PH == 1) ? 2 : 1); ++rp) { if (rp) GRID_BAR();
        if (EN(1) && IN(P0 + 0)) {
            unsigned char* ws = kargs()->ws;
            pg8::PlainOrder S{(const char*)WSP(bf16_t, WS_HB), (const char*)WSP(bf16_t, WS_WIN), 1024, 1024, T / 256, NA / 256 + 1, G, bx, 0};
            EpiStore E{WSP(bf16_t, WS_PA), NA, ldsl, NA / 256, WSP(bf16_t, WS_YS)};
#ifdef STAGGER_US
            if (bx >= 128) { const unsigned long long t0_ = __builtin_amdgcn_s_memrealtime(); while (__builtin_amdgcn_s_memrealtime() - t0_ < (unsigned long long)(STAGGER_US * 100)) __builtin_amdgcn_s_sleep(8); }
#endif
            pg8::gemm_phase<EpiStore, pg8::PlainOrder, true>(ldsl, pg8::Gemm{1024, 1024, 1024}, S, E);
#ifdef PROBE_PA1NULL
#endif
        }
        }
        SEAM(P0 + 0);
        TS_SET(0);
        if (EN(2) && IN(P0 + 1)) { PHASE_VARS;
            if (bx >= RWKV_BLOCKS + GLA_BLOCKS) {
                unsigned char* ws = kargs()->ws; const int c2 = bx - RWKV_BLOCKS - GLA_BLOCKS;
                { const bf16_t* PA = WSP(bf16_t, WS_PA); const f32x2* ROPE = WSP(f32x2, WS_ROPE); float* RSTDQ = WSP(float, WS_RSTD); float* RSTDKV = RSTDQ + T; bf16_t* Kb = WSP(bf16_t, WS_K);
                  for (int m = c2 * NWAVES + wave; m < T; m += 4 * SUB_BLOCKS * NWAVES) mla_prep_rows4(PA, ROPE, RSTDQ, RSTDKV, Kb, m, SUB_BLOCKS * NWAVES, lane); }
                sub_barrier((unsigned*)(ws + WS_CTL) + 64 * 40, (unsigned)SUB_BLOCKS * (unsigned)(2 * l + 1));
                { pg8::PlainOrder S{(const char*)(WSP(bf16_t, WS_PA) + CQ), (const char*)WSP(bf16_t, WS_WUQ), NA, 256, T / 256, 3, SUB_BLOCKS, c2, 0};
                  EpiQ E{WSP(bf16_t, WS_Q), WSP(float, WS_RSTD), ldsl};
                  pg8::gemm_phase<EpiQ, pg8::PlainOrder, true>(ldsl, pg8::Gemm{NA, 256, 256}, S, E); }
                { pg8::PlainOrder S{(const char*)(WSP(bf16_t, WS_PA) + CKV), (const char*)WSP(bf16_t, WS_WUKV), NA, 256, T / 256, 4, SUB_BLOCKS, c2, 0};
                  EpiKV E{WSP(bf16_t, WS_K), WSP(bf16_t, WS_V), WSP(float, WS_RSTD) + T, ldsl};
                  pg8::gemm_phase<EpiKV, pg8::PlainOrder, true>(ldsl, pg8::Gemm{NA, 256, 256}, S, E); }
                sub_barrier((unsigned*)(kargs()->ws + WS_CTL) + 64 * 40, (unsigned)SUB_BLOCKS * (unsigned)(2 * l + 2));
            } else {
                if (bx >= RWKV_BLOCKS) { const int gi = bx - RWKV_BLOCKS; gla::gla_unit(l, gi >> 2, gi & 3, ldsl, (unsigned*)(kargs()->ws + WS_CTL) + 64 * (24 + l)); TS_MAX(12); }
                else {
#ifdef RWKV_TWICE
#pragma unroll 1
                for (int rep_ = 0; rep_ < RWKV_TWICE; ++rep_) { rwkv::rwkv_unit(l, bx >> 3, bx & 7, ldsl); __syncthreads(); }
#else
                rwkv::rwkv_unit(l, bx >> 3, bx & 7, ldsl);
#endif
                TS_MAX(8);
                }
                if (threadIdx.x == 0) { unsigned* cnt = (unsigned*)(kargs()->ws + WS_CTL) + 64 * 40; unsigned sp = 0;
                    while (__hip_atomic_load(cnt, __ATOMIC_RELAXED, __HIP_MEMORY_SCOPE_AGENT) < (unsigned)SUB_BLOCKS * (unsigned)(2 * l + 2) && ++sp < (1u << 24)) __builtin_amdgcn_s_sleep(2);
                    __builtin_amdgcn_fence(__ATOMIC_ACQUIRE, "agent"); asm volatile("s_waitcnt vmcnt(0)" ::: "memory"); }
                __syncthreads();
            }
        }
        if (EN(4) && IN(P0 + 3)) { PHASE_VARS;
            volatile LAS unsigned* qw = (volatile LAS unsigned*)(ldsl + LDS_MISC);
            for (;;) {
                __syncthreads();
                if (tid == 0) { unsigned* CTL = (unsigned*)(kargs()->ws + WS_CTL); qw[0] = atomicAdd(CTL + 64 * (1 + l), 1u); }
                __syncthreads();
                const int it = __builtin_amdgcn_readfirstlane((int)qw[0]);
                if (it >= N_MIX_ITEMS) break;
                { const int a = it; att::attn_unit((a & 63) >> 3, a & 7, (SEQ / 512 - 1) - (a >> 6), ldsl, (unsigned*)(kargs()->ws + WS_CTL) + 64 * (16 + l));  TS_MAX(10); }
            }
            { unsigned* ctl = (unsigned*)(kargs()->ws + WS_CTL);
              __syncthreads();
              if (tid == 0) { const unsigned tk = __hip_atomic_fetch_add(ctl + 64 * (20 + l), 1u, __ATOMIC_RELAXED, __HIP_MEMORY_SCOPE_AGENT); qw[0] = tk;
                  if (tk < (unsigned)MG_BLOCKS) { unsigned sp = 0; while (__hip_atomic_load(ctl + 64 * (16 + l), __ATOMIC_RELAXED, __HIP_MEMORY_SCOPE_AGENT) < (unsigned)N_ATT_UNITS && ++sp < (1u << 22)) __builtin_amdgcn_s_sleep(8); }
                  __builtin_amdgcn_fence(__ATOMIC_ACQUIRE, "agent"); asm volatile("s_waitcnt vmcnt(0)" ::: "memory"); }
              __syncthreads();
              const int tk = __builtin_amdgcn_readfirstlane((int)qw[0]);
              if (tk < MG_BLOCKS) TS_MAX(1);
              if (tk < MG_BLOCKS) {
                  unsigned char* ws = kargs()->ws;
                  pg8::PlainOrder S{(const char*)WSP(bf16_t, WS_HB), (const char*)(WSP(bf16_t, WS_WIN) + (size_t)(NA + 1536) * 1024), 1024, 1024, T / 256, 12, MG_BLOCKS, tk, 0};
                  EpiGateMG8 E{WSP(unsigned char, WS_SMG8), ldsl};
                  pg8::gemm_phase<EpiGateMG8, pg8::PlainOrder, true>(ldsl, pg8::Gemm{1024, 1024, 1024}, S, E);
                  TS_MAX(3);
                  __syncthreads();
                  if (tid == 0) { unsigned sp = 0; while (__hip_atomic_load(ctl + 64 * (24 + l), __ATOMIC_RELAXED, __HIP_MEMORY_SCOPE_AGENT) < 32u && ++sp < (1u << 22)) __builtin_amdgcn_s_sleep(8);
                      __builtin_amdgcn_fence(__ATOMIC_ACQUIRE, "agent"); asm volatile("s_waitcnt vmcnt(0)" ::: "memory"); }
                  __syncthreads();
                  pg8::PlainOrder S2{(const char*)WSP(bf16_t, WS_HB), (const char*)(WSP(bf16_t, WS_WIN) + (size_t)(NA + 256) * 1024), 1024, 1024, T / 256, 3, MG_BLOCKS, tk, 2, 0, -1, 1};
                  EpiGateBG E2{WSP(bf16_t, WS_YS), 1, 2, ldsl, 1};
                  pg8::gemm_phase<EpiGateBG, pg8::PlainOrder, true>(ldsl, pg8::Gemm{1024, 1024, 1024}, S2, E2);
                  TS_MAX(5);
              } }
        }
        SEAM(P0 + 3);
        TS_SET(7);
        if (EN(5) && IN(P0 + 4)) {
            unsigned char* ws = kargs()->ws;
            pg8::PlainOrder S{(const char*)WSP(bf16_t, WS_HB), (const char*)(WSP(bf16_t, WS_WIN) + (size_t)(NA + 512) * 1024), 1024, 1024, T / 256, 2, G, bx, 0};
            EpiGateBG E{WSP(bf16_t, WS_YS), 2, 0, ldsl};
            pg8::gemm_phase<EpiGateBG, pg8::PlainOrder, true>(ldsl, pg8::Gemm{1024, 1024, 1024}, S, E);
        }
        SEAM(P0 + 4);
        for (int rp = 0; rp < ((REPEAT_PH == 6 && l == 0) ? 2 : 1); ++rp) { if (rp) GRID_BAR();
        if (EN(6) && IN(P0 + 5)) {
            unsigned char* ws = kargs()->ws;
            pg8::GroupOrder3 S{(const char*)WSP(bf16_t, WS_YS), (const char*)WSP(bf16_t, WS_WBO), 512, 512, T / 256, 4, G, bx, (size_t)T * 512 * 2, (size_t)1024 * 512 * 2};
            EpiMerge E{WSP(bf16_t, WS_MG), WSP(unsigned char, WS_SMG8), ldsl};
            pg8::gemm_phase<EpiMerge, pg8::GroupOrder3, EPI_ALIGN_PD1>(ldsl, pg8::Gemm{512, 512, 512}, S, E);
        }
        }
        SEAM(P0 + 5);
        for (int rp = 0; rp < ((REPEAT_PH == 7 && l == 0) ? 2 : 1); ++rp) { if (rp) GRID_BAR();
        if (EN(7) && IN(P0 + 6)) {
            unsigned char* ws = kargs()->ws;
            pg8::PlainOrder S{(const char*)WSP(bf16_t, WS_MG), (const char*)WSP(bf16_t, WS_WOUT), 1024, 1024, T / 256, 4, G, bx, 0};
            EpiStore E{WSP(bf16_t, WS_OF), 1024, ldsl};
            pg8::gemm_phase<EpiStore, pg8::PlainOrder, true>(ldsl, pg8::Gemm{1024, 1024, 1024}, S, E);
        }
        }
        SEAM(P0 + 6);
        if (EN(8) && IN(P0 + 7)) { PHASE_VARS;
            const bool more = (l + 1 < DEPTH);
            if (more) convert_weights(l + 1, lds, gw, NGW, wave, lane);
            KArgs kp = kargs(); unsigned char* ws = kp->ws; float* out = kp->out; const float* xold = (l == 0) ? kp->x : out; const float* gpost = kp->norm_post + l * DM; const float* gnext = more ? kp->norm_pre + (l + 1) * DM : nullptr;
            const bf16_t* OF = WSP(bf16_t, WS_OF); bf16_t* HB = WSP(bf16_t, WS_HB);
#define PD3_LOOP(XI, XO) for (int m = gw; m < T; m += 4 * NGW) { RowIn<XI> rr_[4];     \
                _Pragma("unroll") for (int q_ = 0; q_ < 4; ++q_) final_load<XI>(rr_[q_], OF + (size_t)(m + q_ * NGW) * DM, xold + (size_t)(m + q_ * NGW) * DM, lane); \
                _Pragma("unroll") for (int q_ = 0; q_ < 4; ++q_) final_row<XI, XO>(rr_[q_], gpost, out + (size_t)(m + q_ * NGW) * DM, gnext, HB + (size_t)(m + q_ * NGW) * DM, lane); }
            if (l == 0) { if (more) { PD3_LOOP(false, true) } else { PD3_LOOP(false, false) } }
            else        { if (more) { PD3_LOOP(true, true) } else { PD3_LOOP(true, false) } }
#undef PD3_LOOP
        }
        if (l + 1 < DEPTH) SEAM(P0 + 7);
    }
#ifdef PROBE_TS_A
    if (bx == 0 && threadIdx.x == 0) {
        auto val = [&](int i) { unsigned long long v = __hip_atomic_load(TS_PTR + i, __ATOMIC_RELAXED, __HIP_MEMORY_SCOPE_AGENT); return (i == 2 || i == 4 || i == 6 || i == 9 || i == 11 || i == 13) ? ~v : v; };
        const unsigned long long d = val(PROBE_TS_A) - val(PROBE_TS_B);
        const unsigned long long t0_ = __builtin_amdgcn_s_memrealtime();
        if (d < 400000ull) while ((unsigned long long)__builtin_amdgcn_s_memrealtime() - t0_ < (unsigned long long)PROBE_TS_K * d) __builtin_amdgcn_s_sleep(8);
    }
#endif
#undef IN
#undef EN
#undef SEAM
#undef WSP
#undef PHASE_VARS
#undef G
#undef bx
#undef NGW
}

extern "C" void kernel_launch(void* const* d_in, const int* in_sizes, int n_in, void* d_out, int out_size, void* d_ws, size_t ws_size, hipStream_t stream) {
    static int grid = 0;
    if (grid == 0) {
        if (n_in != 24 || in_sizes[0] != T * DM || out_size != T * DM || ws_size < WS_END) {
            fprintf(stderr, "kernel_launch: unexpected shapes (n_in %d, in0 %d, out %d, ws %zu; need ws >= %zu); nothing launched\n", n_in, n_in > 0 ? in_sizes[0] : -1, out_size, ws_size, (size_t)WS_END);
            grid = -1; return; }
        int dev = 0, cus = 0, per_cu = 0;
        (void)hipGetDevice(&dev); (void)hipDeviceGetAttribute(&cus, hipDeviceAttributeMultiprocessorCount, dev);
        if (hipFuncSetAttribute((const void*)hybrid_fwd, hipFuncAttributeMaxDynamicSharedMemorySize, LDS_BYTES) != hipSuccess) { fprintf(stderr, "kernel_launch: hipFuncSetAttribute failed\n"); grid = -1; return; }
        if (hipOccupancyMaxActiveBlocksPerMultiprocessor(&per_cu, (const void*)hybrid_fwd, NTHREADS, LDS_BYTES) != hipSuccess || per_cu < 1) {
            fprintf(stderr, "kernel_launch: occupancy query reports %d blocks per CU\n", per_cu); per_cu = 1; }
        (void)hipGetLastError();
        grid = cus * (per_cu < 1 ? 1 : 1);
        fprintf(stderr, "kernel_launch: grid %d (cus %d, occupancy %d), ws %zu\n", grid, cus, per_cu, ws_size);
    }
    if (grid < 0) return;
    (void)hipMemsetAsync((char*)d_ws + WS_CTL, 0, 65536, stream);
    Params p{};
    p.x = (const float*)d_in[0]; p.positions = (const int*)d_in[1]; p.norm_pre = (const float*)d_in[2]; p.w_in = (const float*)d_in[3]; p.mla_q_norm = (const float*)d_in[4]; p.mla_kv_norm = (const float*)d_in[5];
    p.mla_w_uq = (const float*)d_in[6]; p.mla_w_ukv = (const float*)d_in[7]; p.rwkv_mu = (const float*)d_in[8]; p.rwkv_w0 = (const float*)d_in[9]; p.rwkv_w_up = (const float*)d_in[10]; p.rwkv_a0 = (const float*)d_in[11];
    p.rwkv_a_up = (const float*)d_in[12]; p.rwkv_k_k = (const float*)d_in[13]; p.rwkv_k_a = (const float*)d_in[14]; p.rwkv_r_k = (const float*)d_in[15]; p.rwkv_ln_w = (const float*)d_in[16]; p.rwkv_ln_b = (const float*)d_in[17];
    p.gla_a_up = (const float*)d_in[18]; p.gla_a_b = (const float*)d_in[19]; p.gla_norm = (const float*)d_in[20]; p.w_branch_out = (const float*)d_in[21]; p.w_out = (const float*)d_in[22]; p.norm_post = (const float*)d_in[23];
    p.out = (float*)d_out; p.ws = (unsigned char*)d_ws;
#if MK_MULTI_LAUNCH
    for (int ph = 0; ph < N_PHASES; ++ph) { p.ph_lo = ph; p.ph_hi = ph + 1; void* args[] = {&p};
        hipError_t e = hipLaunchCooperativeKernel((const void*)hybrid_fwd, dim3(grid), dim3(NTHREADS), args, LDS_BYTES, stream);
        if (e != hipSuccess) { fprintf(stderr, "kernel_launch: launch of phase %d failed: %s\n", ph, hipGetErrorString(e)); break; } }
#else
    p.ph_lo = 0; p.ph_hi = N_PHASES; void* args[] = {&p};
    hipError_t e = hipLaunchCooperativeKernel((const void*)hybrid_fwd, dim3(grid), dim3(NTHREADS), args, LDS_BYTES, stream);
    if (e != hipSuccess) fprintf(stderr, "kernel_launch: cooperative launch failed: %s (grid %d)\n", hipGetErrorString(e), grid);
#endif
}
```

```cpp
#include <hip/hip_runtime.h>
#include <hip/hip_cooperative_groups.h>
#include <cstdio>
#include <cstdint>
#include <cmath>
namespace cg = cooperative_groups;
#define U_P5 1
#define U_P7B 1
#define LIGHT_BAR 1
#define NO_WV_LAUNDER 1
#define SPLIT_PF 1
#define GLA_BATCH 1
#define V_A 1
#define V_B 1
#define V_V 1
#define NO_CG_SYNC 1
#define KV_K128 1
#define EPI_PRE 1
#define SIG_TRIM 1
#define PB1_ROT 1
namespace pg8 {
#define PG8_LAS __attribute__((address_space(3)))
typedef unsigned short bf16_t;
typedef short bf16x8 __attribute__((ext_vector_type(8)));
typedef float f32x4 __attribute__((ext_vector_type(4)));
typedef unsigned u32x4 __attribute__((ext_vector_type(4)));
typedef unsigned u32x2 __attribute__((ext_vector_type(2)));
constexpr int BM = 256, BK = 64, HALF = 128, HTB = HALF * BK * 2  , STAGE_BYTES = 8 * HTB, NXCD = 8, WGM = 8;

__host__ __device__ __forceinline__ int lds_byte(int r, int c) { const int st = (r >> 4) * 2 + (c >> 5), rr = r & 15, cc = c & 31, ob = rr * 64 + cc * 2; return st * 1024 + (ob ^ (((ob >> 9) & 1) << 5)); }
__host__ __device__ __forceinline__ void stage_rc(int b, int& R, int& C) { const int st = b / 1024, sb = b % 1024, swz = sb ^ (((sb >> 9) & 1) << 5); R = (st >> 1) * 16 + swz / 64; C = (st & 1) * 32 + (swz % 64) / 2; }
__host__ __device__ __forceinline__ int perm32(int rho) { const int n = rho >> 4, i = rho & 15; return 8 * (i >> 2) + 4 * n + (i & 3); }

struct Unit { int pm, pn, aux; const char* A; const char* B; };
struct Gemm { int lda, ldb, K; };

__device__ __forceinline__ void tile_of(int L, int nM, int nN, int& pm, int& pn) {
    const int nwg = nM * nN; int wgid = L;
    { const int q = nwg / NXCD, r = nwg % NXCD, xcd = wgid % NXCD, off = wgid / NXCD; wgid = (xcd < r ? xcd * (q + 1) : r * (q + 1) + (xcd - r) * q) + off; }
    const int nig = WGM * nN, gid = wgid / nig, fm = gid * WGM, gsz = (nM - fm) < WGM ? (nM - fm) : WGM;
    pm = fm + ((wgid % nig) % gsz); pn = (wgid % nig) / gsz;
}
struct PlainOrder {
    const char* A; const char* Bt; int lda, ldb, nM, nN, G, c, bskip;
    int base = 0, cnt = -1;
    int bth = 2;
    __device__ __forceinline__ bool next(int i, Unit& u) const {
        const long Lr = (long)i * G + c; if (Lr >= (long)(cnt >= 0 ? cnt : nM * nN)) return false;
        const long L = Lr + base;
        tile_of((int)L, nM, nN, u.pm, u.pn); u.aux = 0;
        u.A = A + (size_t)u.pm * BM * lda * 2; u.B = Bt + (size_t)(u.pn + ((u.pn >= bth) ? bskip : 0)) * BM * ldb * 2; return true;
    }
};
struct GroupOrder3 {
    const char* A; const char* Bt; int lda, ldb, nM, nN, G, c; size_t a_gstride, b_gstride;
    __device__ __forceinline__ bool next(int i, Unit& u) const {
        const int n = i % 3; const long L = (long)(i / 3) * G + c; if (L >= (long)nM * nN) return false;
        tile_of((int)L, nM, nN, u.pm, u.pn); u.aux = n;
        u.A = A + n * a_gstride + (size_t)u.pm * BM * lda * 2; u.B = Bt + n * b_gstride + (size_t)u.pn * BM * ldb * 2; return true;
    }
};

template <class E_, class = void> struct epi_npre { static constexpr int value = 0; };
template <class E_> struct epi_npre<E_, decltype((void)E_::NPRE)> { static constexpr int value = E_::NPRE; };
template <class Epi, class Sched, bool ALIGN_EPI>
__device__ __forceinline__ void gemm_phase(PG8_LAS unsigned char* lds, const Gemm g, const Sched& S, const Epi& E) {
    int tid_ = threadIdx.x; asm volatile("" : "+v"(tid_));
    const int tid = tid_, wid = __builtin_amdgcn_readfirstlane(tid >> 6), lane = tid & 63, wr = wid >> 2, wc = wid & 3, fr = lane & 15, fq = lane >> 4;
    const int K = g.K, nt = K / BK;
    unsigned voffA[2], voffB[2];
#pragma unroll
    for (int i = 0; i < 2; ++i) { int R, C; stage_rc(tid * 16 + i * 8192, R, C); const int Rb = (int)Epi::PERM == 2 ? (64 * (R >> 5) + perm32(R & 31)) : (int)Epi::PERM == 1 ? ((R & ~31) + perm32(R & 31)) : R;
        voffA[i] = (unsigned)(R * g.lda + C) * 2u; voffB[i] = (unsigned)(Rb * g.ldb + C) * 2u; }
    const size_t kstep = (size_t)(BK * 2);
    const size_t hstepA = (size_t)HALF * g.lda * 2, hstepB = (size_t)((int)Epi::PERM == 2 ? 32 : HALF) * g.ldb * 2;
    const unsigned ldsw = (unsigned)wid * 1024u;
    const int aoff = lds_byte(wr * 64 + fr, fq * 8), boff = lds_byte(wc * 32 + fr, fq * 8);
#define PG8_SA(b, h) (((b) * 2 + (h)) * HTB)
#define PG8_SB(b, h) ((4 + (b) * 2 + (h)) * HTB)
#define PG8_STAGE(bufoff, gbase, voff) do { _Pragma("unroll") for (int _i = 0; _i < 2; ++_i) \
        __builtin_amdgcn_global_load_lds((const unsigned*)((const char*)(gbase) + (voff)[_i]), (PG8_LAS unsigned*)(lds + (bufoff) + ldsw + _i * 8192), 16, 0, 0); } while (0)
#define PG8_LDA(dst, b, h) do { _Pragma("unroll") for (int m = 0; m < 4; ++m) _Pragma("unroll") for (int k = 0; k < 2; ++k) dst[m][k] = *(const PG8_LAS bf16x8*)(lds + PG8_SA(b, h) + aoff + m * 2048 + k * 1024); } while (0)
#define PG8_LDB(dst, b, h) do { _Pragma("unroll") for (int n = 0; n < 2; ++n) _Pragma("unroll") for (int k = 0; k < 2; ++k) dst[n][k] = *(const PG8_LAS bf16x8*)(lds + PG8_SB(b, h) + boff + n * 2048 + k * 1024); } while (0)
#define PG8_MMA(ai, bj, At, Bt) do { __builtin_amdgcn_s_setprio(1); _Pragma("unroll") for (int m = 0; m < 4; ++m) _Pragma("unroll") for (int n = 0; n < 2; ++n) _Pragma("unroll") for (int k = 0; k < 2; ++k) \
        acc[ai][bj][m][n] = __builtin_amdgcn_mfma_f32_16x16x32_bf16(Bt[n][k], At[m][k], acc[ai][bj][m][n], 0, 0, 0); __builtin_amdgcn_s_setprio(0); } while (0)
#define PG8_WAIT_V(n) asm volatile("s_waitcnt vmcnt(" #n ")" ::: "memory")
#define PG8_WAIT_L(n) asm volatile("s_waitcnt lgkmcnt(" #n ")" ::: "memory")
#define PG8_BAR __builtin_amdgcn_s_barrier()
#define PG8_SCHED __builtin_amdgcn_sched_barrier(0)
    Unit cur, nxt; int ui = 0;
    if (!S.next(0, cur)) return;
    f32x4 acc[2][2][4][2];
#pragma unroll
    for (int a = 0; a < 2; ++a)
#pragma unroll
        for (int b = 0; b < 2; ++b)
#pragma unroll
            for (int m = 0; m < 4; ++m)
#pragma unroll
                for (int n = 0; n < 2; ++n) acc[a][b][m][n] = (f32x4){0.f, 0.f, 0.f, 0.f};
    bf16x8 At[4][2], B0[2][2], B1[2][2];
    const char* cA = cur.A; const char* cB = cur.B;
    PG8_STAGE(PG8_SB(0, 0), cB, voffB); PG8_STAGE(PG8_SB(0, 1), cB + hstepB, voffB); PG8_STAGE(PG8_SA(0, 0), cA, voffA); PG8_STAGE(PG8_SA(0, 1), cA + hstepA, voffA);
    if (wr == 1) PG8_BAR;
    PG8_WAIT_V(2); PG8_BAR;
    PG8_STAGE(PG8_SB(1, 0), cB + kstep, voffB); PG8_STAGE(PG8_SA(1, 0), cA + kstep, voffA); PG8_STAGE(PG8_SB(1, 1), cB + hstepB + kstep, voffB);
    PG8_WAIT_V(6); PG8_BAR;
    for (;;) {
        const bool has_next = S.next(ui + 1, nxt);
        const char* nA = has_next ? nxt.A : cA; const char* nB = has_next ? nxt.B : cB;
        float epre[8];
        if constexpr (epi_npre<Epi>::value > 0) E.prefetch(cur, wr, fr, epre);
#pragma unroll 1
        for (int t = 0; t < nt; t += 2) {
            const bool last = (t == nt - 2);
            const char* a1 = cA + (size_t)(t + 1) * kstep;
            const char* a2 = last ? nA : cA + (size_t)(t + 2) * kstep; const char* b2 = last ? nB : cB + (size_t)(t + 2) * kstep;
            const char* a3 = a2 + kstep; const char* b3 = b2 + kstep;
            PG8_LDB(B0, 0, 0); PG8_LDB(B1, 0, 1); PG8_SCHED; PG8_LDA(At, 0, 0); PG8_STAGE(PG8_SA(1, 1), a1 + hstepA, voffA);
            PG8_WAIT_V(8); PG8_WAIT_L(0); PG8_BAR; PG8_MMA(0, 0, At, B0); PG8_MMA(0, 1, At, B1); PG8_BAR; PG8_SCHED;
            PG8_LDA(At, 0, 1); PG8_STAGE(PG8_SB(0, 0), b2, voffB); PG8_STAGE(PG8_SB(0, 1), b2 + hstepB, voffB); PG8_STAGE(PG8_SA(0, 0), a2, voffA);
            PG8_WAIT_V(8); PG8_WAIT_L(0); PG8_BAR; PG8_MMA(1, 0, At, B0); PG8_MMA(1, 1, At, B1); PG8_BAR; PG8_SCHED;
            PG8_LDB(B0, 1, 0); PG8_LDB(B1, 1, 1); PG8_SCHED; PG8_LDA(At, 1, 0); PG8_STAGE(PG8_SA(0, 1), a2 + hstepA, voffA);
            PG8_WAIT_V(8); PG8_WAIT_L(0); PG8_BAR; PG8_MMA(0, 0, At, B0); PG8_MMA(0, 1, At, B1); PG8_BAR; PG8_SCHED;
            PG8_LDA(At, 1, 1); PG8_STAGE(PG8_SB(1, 0), b3, voffB); PG8_STAGE(PG8_SB(1, 1), b3 + hstepB, voffB); PG8_STAGE(PG8_SA(1, 0), a3, voffA);
            PG8_WAIT_V(8); PG8_WAIT_L(0); PG8_BAR; PG8_MMA(1, 0, At, B0); PG8_MMA(1, 1, At, B1); PG8_BAR; PG8_SCHED;
        }
        if constexpr (ALIGN_EPI) { if (wr == 0) PG8_BAR; }
        if constexpr (epi_npre<Epi>::value > 0) E(acc, cur, wr, wc, fr, fq, epre); else E(acc, cur, wr, wc, fr, fq);
        if (!has_next) break;
#pragma unroll
        for (int a = 0; a < 2; ++a)
#pragma unroll
            for (int b = 0; b < 2; ++b)
#pragma unroll
                for (int m = 0; m < 4; ++m)
#pragma unroll
                    for (int n = 0; n < 2; ++n) acc[a][b][m][n] = (f32x4){0.f, 0.f, 0.f, 0.f};
        cur = nxt; cA = nA; cB = nB; ++ui;
        if constexpr (ALIGN_EPI) { if (wr == 1) PG8_BAR; }
    }
    PG8_WAIT_V(0);
    if constexpr (!ALIGN_EPI) { if (wr == 0) PG8_BAR; }
    PG8_BAR;
#undef PG8_SA
#undef PG8_SB
#undef PG8_STAGE
#undef PG8_LDA
#undef PG8_LDB
#undef PG8_MMA
#undef PG8_WAIT_V
#undef PG8_WAIT_L
#undef PG8_BAR
#undef PG8_SCHED
}
}
#define LAS __attribute__((address_space(3)))
typedef unsigned short bf16_t;
typedef short bf16x8 __attribute__((ext_vector_type(8)));
typedef short s16x4 __attribute__((ext_vector_type(4)));
typedef float f32x4 __attribute__((ext_vector_type(4)));
typedef float f32x2 __attribute__((ext_vector_type(2)));
typedef float f32x16 __attribute__((ext_vector_type(16)));
typedef unsigned u32x4 __attribute__((ext_vector_type(4)));
typedef unsigned u32x2 __attribute__((ext_vector_type(2)));
typedef __bf16 bf16x2_t __attribute__((ext_vector_type(2)));

constexpr int BATCH = 8, SEQ = 4096, DM = 1024, T = BATCH * SEQ, DEPTH = 2;
constexpr int N_IN = 7728, NA = 3328, NG = 4608, NALL = NA + NG;
constexpr int CQ = 0, CKV = 256, KROPE = 384, GLAT = 416, RW_R = 512, RW_K = 1024, RW_V = 1536, RW_LW = 2048, RW_LA = 2112, GQ = 2304, GK = 2560, GV = 2816;
constexpr int KP = 544;
constexpr float NORM_EPS = 1e-6f, RWKV_GN_EPS = 64e-5f;
constexpr float QSCALE = 0.10206207261596577f * 1.4426950408889634f;

constexpr size_t MiB = 1u << 20;
constexpr size_t WS_CTL = 0;
constexpr size_t WS_ROPE = 1 * MiB;
constexpr size_t WS_RSTD = 5 * MiB;
constexpr size_t WS_WIN = 6 * MiB;
constexpr size_t WS_WBO = WS_WIN + (size_t)NALL * 1024 * 2;
constexpr size_t WS_WOUT = WS_WBO + 3 * MiB;
constexpr size_t WS_WUQ = WS_WOUT + 2 * MiB;
constexpr size_t WS_WUKV = WS_WUQ + 768 * 256 * 2;
constexpr size_t WS_HB = 28 * MiB;
constexpr size_t WS_PA = 92 * MiB;
constexpr size_t WS_Q = 300 * MiB;
constexpr size_t WS_K = 348 * MiB;
constexpr size_t WS_V = 382 * MiB;
constexpr size_t WS_YS = 414 * MiB;
constexpr size_t WS_SMG8 = WS_Q;
constexpr size_t WS_MG = WS_PA, WS_OF = WS_PA + 64 * MiB;
constexpr size_t WS_END = 510 * MiB;
static_assert(WS_WUKV + 1024 * 256 * 2 <= WS_HB, "weights fit");

__device__ __forceinline__ unsigned pk2(float lo, float hi) { f32x2 v = {lo, hi}; bf16x2_t b = __builtin_convertvector(v, bf16x2_t); return __builtin_bit_cast(unsigned, b); }
__device__ __forceinline__ float bflo(unsigned w) { return __uint_as_float(w << 16); }
__device__ __forceinline__ float bfhi(unsigned w) { return __uint_as_float(w & 0xffff0000u); }
__device__ __forceinline__ float bf2f(bf16_t b) { return __uint_as_float((unsigned)b << 16); }
__device__ __forceinline__ bf16_t f2bf(float f) { return (bf16_t)(pk2(f, 0.f) & 0xffffu); }
__device__ __forceinline__ float wave_sum(float v) {
#pragma unroll
    for (int o = 1; o < 64; o <<= 1) v += __shfl_xor(v, o);
    return v;
}
__device__ __forceinline__ float fast_exp(float x) { return __builtin_amdgcn_exp2f(x * 1.4426950408889634f); }
__device__ __forceinline__ float fast_sigmoid(float x) { return __builtin_amdgcn_rcpf(1.0f + fast_exp(-x)); }
template <int CTRL> __device__ __forceinline__ float dpp_f(float x) { return __int_as_float(__builtin_amdgcn_update_dpp(0, __float_as_int(x), CTRL, 0xf, 0xf, false)); }
__device__ __forceinline__ float sum8(float x) { x += dpp_f<0xB1>(x); x += dpp_f<0x4E>(x); x += dpp_f<0x141>(x); return x; }
__device__ __forceinline__ float sum16(float x) { x += dpp_f<0xB1>(x); x += dpp_f<0x4E>(x); x += dpp_f<0x141>(x); x += dpp_f<0x140>(x); return x; }

struct Params {
    const float* x; const int* positions; const float* norm_pre; const float* w_in; const float* mla_q_norm; const float* mla_kv_norm; const float* mla_w_uq; const float* mla_w_ukv;
    const float* rwkv_mu; const float* rwkv_w0; const float* rwkv_w_up; const float* rwkv_a0; const float* rwkv_a_up; const float* rwkv_k_k; const float* rwkv_k_a; const float* rwkv_r_k;
    const float* rwkv_ln_w; const float* rwkv_ln_b; const float* gla_a_up; const float* gla_a_b; const float* gla_norm; const float* w_branch_out; const float* w_out; const float* norm_post;
    float* out; unsigned char* ws; int ph_lo, ph_hi;
};

typedef const __attribute__((address_space(4))) Params* KArgs;
__device__ __forceinline__ KArgs kargs() { KArgs kp = (KArgs)__builtin_amdgcn_kernarg_segment_ptr(); asm volatile("" : "+s"(kp)); return kp; }

__device__ __forceinline__ Params load_params() { Params p{}; KArgs kp = kargs(); p.x = kp->x; p.positions = kp->positions; p.norm_pre = kp->norm_pre; p.w_in = kp->w_in; p.mla_q_norm = kp->mla_q_norm; p.mla_kv_norm = kp->mla_kv_norm; p.mla_w_uq = kp->mla_w_uq; p.mla_w_ukv = kp->mla_w_ukv; p.rwkv_mu = kp->rwkv_mu; p.rwkv_w0 = kp->rwkv_w0; p.rwkv_w_up = kp->rwkv_w_up; p.rwkv_a0 = kp->rwkv_a0; p.rwkv_a_up = kp->rwkv_a_up; p.rwkv_k_k = kp->rwkv_k_k; p.rwkv_k_a = kp->rwkv_k_a; p.rwkv_r_k = kp->rwkv_r_k; p.rwkv_ln_w = kp->rwkv_ln_w; p.rwkv_ln_b = kp->rwkv_ln_b; p.gla_a_up = kp->gla_a_up; p.gla_a_b = kp->gla_a_b; p.gla_norm = kp->gla_norm; p.w_branch_out = kp->w_branch_out; p.w_out = kp->w_out; p.norm_post = kp->norm_post; p.out = kp->out; p.ws = kp->ws; p.ph_lo = kp->ph_lo; p.ph_hi = kp->ph_hi; return p; }
__device__ __forceinline__ int opaque_tid() { int t = threadIdx.x; asm volatile("" : "+v"(t)); return t; }

using pg8::Unit;
constexpr int EPI_SCR = 131072, EPI_SCR_WAVE = 2304, EPI_PITCH = 144;
struct EpiGeo { LAS unsigned char* wp; const LAS unsigned char* rp; int r8, p8; };
__device__ __forceinline__ EpiGeo epi_geo(LAS unsigned char* lds, int wr, int wc, int fr, int fq) {
    LAS unsigned char* scr = lds + EPI_SCR + (wr * 4 + wc) * EPI_SCR_WAVE; const int lane = fq * 16 + fr;
    return EpiGeo{scr + fr * EPI_PITCH + fq * 16, scr + (lane >> 3) * EPI_PITCH + (lane & 7) * 16, lane >> 3, lane & 7};
}
__device__ __forceinline__ void epi_xpose(const EpiGeo& g, const u32x4 w0, const u32x4 w1, u32x4& r0, u32x4& r1) {
    *(LAS u32x4*)g.wp = w0; *(LAS u32x4*)(g.wp + 64) = w1;
    asm volatile("" ::: "memory");
    r0 = *(const LAS u32x4*)g.rp; r1 = *(const LAS u32x4*)(g.rp + 8 * EPI_PITCH);
    asm volatile("" ::: "memory");
}
__device__ __forceinline__ u32x4 pack8(const f32x4 v0, const f32x4 v1) { u32x4 w; w.x = pk2(v0[0], v0[1]); w.y = pk2(v0[2], v0[3]); w.z = pk2(v1[0], v1[1]); w.w = pk2(v1[2], v1[3]); return w; }
__device__ __forceinline__ f32x4 silu4(const f32x4 a) { f32x4 r; r[0] = fast_sigmoid(a[0]) * a[0]; r[1] = fast_sigmoid(a[1]) * a[1]; r[2] = fast_sigmoid(a[2]) * a[2]; r[3] = fast_sigmoid(a[3]) * a[3]; return r; }
struct EpiStore {
    static constexpr int PERM = 2; bf16_t* O; int ldc; LAS unsigned char* lds; int gt = -1; bf16_t* YG = nullptr;
    __device__ __forceinline__ void operator()(const f32x4 (&acc)[2][2][4][2], const Unit& u, int wr, int wc, int fr, int fq) const {
        const EpiGeo G = epi_geo(lds, wr, wc, fr, fq);
        if (u.pn == gt) {
            bf16_t* gq = YG + (size_t)(u.pm * 256 + wr * 64 + G.r8) * 512 + wc * 64 + G.p8 * 8;
#pragma unroll
            for (int ai = 0; ai < 2; ++ai)
#pragma unroll
                for (int m = 0; m < 4; ++m) { u32x4 r0, r1; epi_xpose(G, pack8(silu4(acc[ai][0][m][0]), silu4(acc[ai][0][m][1])), pack8(silu4(acc[ai][1][m][0]), silu4(acc[ai][1][m][1])), r0, r1);
                    bf16_t* g = gq + (size_t)(ai * 128 + m * 16) * 512;
                    *(u32x4*)g = r0; *(u32x4*)(g + (size_t)8 * 512) = r1; }
            return; }
        bf16_t* gp = O + (size_t)(u.pm * 256 + wr * 64 + G.r8) * ldc + u.pn * 256 + wc * 64 + G.p8 * 8;
#pragma unroll
        for (int ai = 0; ai < 2; ++ai)
#pragma unroll
            for (int m = 0; m < 4; ++m) { u32x4 r0, r1; epi_xpose(G, pack8(acc[ai][0][m][0], acc[ai][0][m][1]), pack8(acc[ai][1][m][0], acc[ai][1][m][1]), r0, r1);
                bf16_t* g = gp + (size_t)(ai * 128 + m * 16) * ldc;
                *(u32x4*)g = r0; *(u32x4*)(g + (size_t)8 * ldc) = r1; }
    }
};
struct EpiQ {
    static constexpr int PERM = 2; bf16_t* Q; const float* rstd; LAS unsigned char* lds;
#ifdef EPI_PRE
    static constexpr int NPRE = 8;
    __device__ __forceinline__ void prefetch(const Unit& u, int wr, int fr, float (&p)[8]) const { const int row0 = u.pm * 256 + wr * 64 + fr;
#pragma unroll
        for (int j = 0; j < 8; ++j) p[j] = rstd[row0 + (j >> 2) * 128 + (j & 3) * 16]; }
    __device__ __forceinline__ void operator()(const f32x4 (&acc)[2][2][4][2], const Unit& u, int wr, int wc, int fr, int fq, const float (&p)[8]) const {
        const EpiGeo G = epi_geo(lds, wr, wc, fr, fq);
        float rsv[2][4];
#pragma unroll
        for (int j = 0; j < 8; ++j) rsv[j >> 2][j & 3] = p[j];
#else
    __device__ __forceinline__ void operator()(const f32x4 (&acc)[2][2][4][2], const Unit& u, int wr, int wc, int fr, int fq) const {
        const EpiGeo G = epi_geo(lds, wr, wc, fr, fq);
        const int row0 = u.pm * 256 + wr * 64 + fr;
        float rsv[2][4];
#pragma unroll
        for (int ai = 0; ai < 2; ++ai)
#pragma unroll
            for (int m = 0; m < 4; ++m) rsv[ai][m] = rstd[row0 + ai * 128 + m * 16];
#endif
        bf16_t* gp = Q + (size_t)(u.pm * 256 + wr * 64 + G.r8) * 768 + u.pn * 256 + wc * 64 + G.p8 * 8;
#pragma unroll
        for (int ai = 0; ai < 2; ++ai)
#pragma unroll
            for (int m = 0; m < 4; ++m) { const float rs = rsv[ai][m] * QSCALE; u32x4 r0, r1;
                epi_xpose(G, pack8(acc[ai][0][m][0] * rs, acc[ai][0][m][1] * rs), pack8(acc[ai][1][m][0] * rs, acc[ai][1][m][1] * rs), r0, r1);
                bf16_t* g = gp + (size_t)(ai * 128 + m * 16) * 768;
                *(u32x4*)g = r0; *(u32x4*)(g + (size_t)8 * 768) = r1; }
    }
};
struct EpiKV {
    static constexpr int PERM = 2; bf16_t* Kb; bf16_t* Vb; const float* rstd; LAS unsigned char* lds;
#ifdef EPI_PRE
    static constexpr int NPRE = 8;
    __device__ __forceinline__ void prefetch(const Unit& u, int wr, int fr, float (&p)[8]) const { const int row0 = u.pm * 256 + wr * 64 + fr;
#pragma unroll
        for (int j = 0; j < 8; ++j) p[j] = rstd[row0 + (j >> 2) * 128 + (j & 3) * 16]; }
    __device__ __forceinline__ void operator()(const f32x4 (&acc)[2][2][4][2], const Unit& u, int wr, int wc, int fr, int fq, const float (&p)[8]) const {
        const EpiGeo G = epi_geo(lds, wr, wc, fr, fq);
        const bool isv = u.pn >= 2; const int ldc = isv ? 512 : KP;
        float rsv[2][4];
#pragma unroll
        for (int j = 0; j < 8; ++j) rsv[j >> 2][j & 3] = p[j];
#else
    __device__ __forceinline__ void operator()(const f32x4 (&acc)[2][2][4][2], const Unit& u, int wr, int wc, int fr, int fq) const {
        const EpiGeo G = epi_geo(lds, wr, wc, fr, fq);
        const int row0 = u.pm * 256 + wr * 64 + fr; const bool isv = u.pn >= 2; const int ldc = isv ? 512 : KP;
        float rsv[2][4];
#pragma unroll
        for (int ai = 0; ai < 2; ++ai)
#pragma unroll
            for (int m = 0; m < 4; ++m) rsv[ai][m] = rstd[row0 + ai * 128 + m * 16];
#endif
        bf16_t* gp = (isv ? Vb : Kb) + (size_t)(u.pm * 256 + wr * 64 + G.r8) * ldc + (u.pn & 1) * 256 + wc * 64 + G.p8 * 8;
#pragma unroll
        for (int ai = 0; ai < 2; ++ai)
#pragma unroll
            for (int m = 0; m < 4; ++m) { const float rs = rsv[ai][m]; u32x4 r0, r1;
                epi_xpose(G, pack8(acc[ai][0][m][0] * rs, acc[ai][0][m][1] * rs), pack8(acc[ai][1][m][0] * rs, acc[ai][1][m][1] * rs), r0, r1);
                bf16_t* g = gp + (size_t)(ai * 128 + m * 16) * ldc;
                *(u32x4*)g = r0; *(u32x4*)(g + (size_t)8 * ldc) = r1; }
    }
};
__device__ __forceinline__ unsigned q8(float s) { return (unsigned)(s * 255.0f + 0.5f); }
struct EpiGateBG {
    static constexpr int PERM = 2; bf16_t* YS; int pn0, skip; LAS unsigned char* lds; int th = 2;
    __device__ __forceinline__ void operator()(const f32x4 (&acc)[2][2][4][2], const Unit& u, int wr, int wc, int fr, int fq) const {
        const int pn = pn0 + u.pn + ((u.pn >= th) ? skip : 0);
        const EpiGeo G = epi_geo(lds, wr, wc, fr, fq);
        bf16_t* gp = YS + (size_t)(pn >> 1) * T * 512 + (size_t)(u.pm * 256 + wr * 64 + G.r8) * 512 + (pn & 1) * 256 + wc * 64 + G.p8 * 8;
#pragma unroll
        for (int ai = 0; ai < 2; ++ai) {
            u32x4 y[4][2];
#pragma unroll
            for (int m = 0; m < 4; ++m)
#pragma unroll
                for (int h = 0; h < 2; ++h) y[m][h] = *(const u32x4*)(gp + (size_t)(ai * 128 + m * 16 + 8 * h) * 512);
#pragma unroll
            for (int m = 0; m < 4; ++m) { u32x4 r[2];
                epi_xpose(G, pack8(silu4(acc[ai][0][m][0]), silu4(acc[ai][0][m][1])), pack8(silu4(acc[ai][1][m][0]), silu4(acc[ai][1][m][1])), r[0], r[1]);
#pragma unroll
                for (int h = 0; h < 2; ++h) { const u32x4 yy = y[m][h], gg = r[h];
                    u32x4 w; w.x = pk2(bflo(gg.x) * bflo(yy.x), bfhi(gg.x) * bfhi(yy.x)); w.y = pk2(bflo(gg.y) * bflo(yy.y), bfhi(gg.y) * bfhi(yy.y));
                    w.z = pk2(bflo(gg.z) * bflo(yy.z), bfhi(gg.z) * bfhi(yy.z)); w.w = pk2(bflo(gg.w) * bflo(yy.w), bfhi(gg.w) * bfhi(yy.w));
                    *(u32x4*)(gp + (size_t)(ai * 128 + m * 16 + 8 * h) * 512) = w; } }
        }
    }
};
struct EpiGateMG8 {
    static constexpr int PERM = 2; unsigned char* SMG; LAS unsigned char* lds;
    __device__ __forceinline__ void operator()(const f32x4 (&acc)[2][2][4][2], const Unit& u, int wr, int wc, int fr, int fq) const {
        LAS unsigned char* scr = lds + EPI_SCR + (wr * 4 + wc) * EPI_SCR_WAVE; const int lane = fq * 16 + fr;
        LAS unsigned char* wp = scr + fr * 72 + fq * 8; const LAS unsigned char* rp = scr + (lane >> 2) * 72 + (lane & 3) * 16;
        unsigned char* gp = SMG + (size_t)((u.pm * 256 + wr * 64) >> 1) * 6144 + (size_t)(lane >> 3) * 6144 + (u.pn * 4 + wc) * 128 + ((lane >> 2) & 1) * 64 + (lane & 3) * 16;
#pragma unroll
        for (int ai = 0; ai < 2; ++ai)
#pragma unroll
            for (int m = 0; m < 4; ++m) {
#pragma unroll
                for (int bj = 0; bj < 2; ++bj) { const f32x4 a0 = acc[ai][bj][m][0], a1 = acc[ai][bj][m][1];
                    u32x2 w = {0u, 0u};
#pragma unroll
                    for (int j = 0; j < 4; ++j) { w.x = __builtin_amdgcn_cvt_pk_u8_f32(255.0f * fast_sigmoid(a0[j]), j, w.x); w.y = __builtin_amdgcn_cvt_pk_u8_f32(255.0f * fast_sigmoid(a1[j]), j, w.y); }
                    *(LAS u32x2*)(wp + bj * 32) = w; }
                asm volatile("" ::: "memory");
                const u32x2 ra = *(const LAS u32x2*)rp, rb = *(const LAS u32x2*)(rp + 8);
                asm volatile("" ::: "memory");
                *(u32x4*)(gp + (size_t)(ai * 64 + m * 8) * 6144) = (u32x4){ra.x, ra.y, rb.x, rb.y}; }
    }
};
struct EpiMerge {
    static constexpr int PERM = 2; bf16_t* MG; const unsigned char* SMG; LAS unsigned char* lds;
    __device__ __forceinline__ void operator()(const f32x4 (&acc)[2][2][4][2], const Unit& u, int wr, int wc, int fr, int fq) const {
        const EpiGeo G = epi_geo(lds, wr, wc, fr, fq); const int n = u.aux; constexpr float S = 1.0f / 255.0f;
        const size_t rowb = (size_t)(u.pm * 256 + wr * 64 + G.r8); const int colb = u.pn * 256 + wc * 64 + G.p8 * 8;
        const unsigned char* sp = SMG + (rowb >> 1) * 6144 + (size_t)(n * 16 + u.pn * 4 + wc) * 128 + (rowb & 1) * 64 + G.p8 * 8; bf16_t* mp = MG + rowb * 1024 + colb;
#pragma unroll
        for (int ai = 0; ai < 2; ++ai) {
            u32x2 g[4][2]; u32x4 y[4][2];
#pragma unroll
            for (int m = 0; m < 4; ++m)
#pragma unroll
                for (int h = 0; h < 2; ++h) { g[m][h] = *(const u32x2*)(sp + (size_t)(ai * 64 + m * 8 + 4 * h) * 6144); if (n > 0) y[m][h] = *(const u32x4*)(mp + (size_t)(ai * 128 + m * 16 + 8 * h) * 1024); }
#pragma unroll
            for (int m = 0; m < 4; ++m) { u32x4 r[2];
                epi_xpose(G, pack8(acc[ai][0][m][0], acc[ai][0][m][1]), pack8(acc[ai][1][m][0], acc[ai][1][m][1]), r[0], r[1]);
#pragma unroll
                for (int h = 0; h < 2; ++h) { const u32x2 gg = g[m][h]; const u32x4 aa = r[h];
                    float v[8] = {bflo(aa.x) * (S * (float)(gg.x & 0xffu)), bfhi(aa.x) * (S * (float)((gg.x >> 8) & 0xffu)), bflo(aa.y) * (S * (float)((gg.x >> 16) & 0xffu)), bfhi(aa.y) * (S * (float)(gg.x >> 24)),
                                  bflo(aa.z) * (S * (float)(gg.y & 0xffu)), bfhi(aa.z) * (S * (float)((gg.y >> 8) & 0xffu)), bflo(aa.w) * (S * (float)((gg.y >> 16) & 0xffu)), bfhi(aa.w) * (S * (float)(gg.y >> 24))};
                    if (n > 0) { const u32x4 yy = y[m][h];
                        v[0] += bflo(yy.x); v[1] += bfhi(yy.x); v[2] += bflo(yy.y); v[3] += bfhi(yy.y); v[4] += bflo(yy.z); v[5] += bfhi(yy.z); v[6] += bflo(yy.w); v[7] += bfhi(yy.w); }
                    u32x4 w; w.x = pk2(v[0], v[1]); w.y = pk2(v[2], v[3]); w.z = pk2(v[4], v[5]); w.w = pk2(v[6], v[7]);
                    *(u32x4*)(mp + (size_t)(ai * 128 + m * 16 + 8 * h) * 1024) = w; } }
        }
    }
};
struct EpiF32 {
    static constexpr bool PERM = false; float* O; int ldc;
    __device__ __forceinline__ void operator()(const f32x4 (&acc)[2][2][4][2], const Unit& u, int wr, int wc, int fr, int fq) const {
        const int row0 = u.pm * 256 + wr * 64 + fr, col0 = u.pn * 256 + wc * 32 + 4 * fq;
#pragma unroll
        for (int ai = 0; ai < 2; ++ai)
#pragma unroll
            for (int m = 0; m < 4; ++m) { float* rowp = O + (size_t)(row0 + ai * 128 + m * 16) * ldc + col0;
#pragma unroll
                for (int bj = 0; bj < 2; ++bj)
#pragma unroll
                    for (int n = 0; n < 2; ++n) *(f32x4*)(rowp + bj * 128 + n * 16) = acc[ai][bj][m][n]; }
    }
};

template <class SrcCol>
__device__ __forceinline__ void transpose_item(const float* W, int Ksrc, int Nsrc, bf16_t* WT, int Kdst, int item, int nblk, float* scr, int lane, SrcCol src, const float* kscale) {
    const int kb = item / nblk, nb = item % nblk, k0 = 64 * kb, n0 = 32 * nb;
    const int sc = src(n0 + (lane & 31));
    float vv[32];
#pragma unroll
    for (int i = 0; i < 32; ++i) { const int k = k0 + 2 * i + (lane >> 5); float v = 0.f;
        if (sc >= 0 && k < Ksrc) { v = W[(size_t)k * Nsrc + sc]; if (kscale) v *= kscale[k]; }
        vv[i] = v; }
#pragma unroll
    for (int i = 0; i < 32; ++i) scr[(2 * i + (lane >> 5)) * 33 + (lane & 31)] = vv[i];
    asm volatile("s_waitcnt lgkmcnt(0)" ::: "memory");
    const int c = lane & 7;
#pragma unroll
    for (int j = 0; j < 4; ++j) { const int n = (lane >> 3) + 8 * j; const float* s = scr + (8 * c) * 33 + n;
        u32x4 o; o.x = pk2(s[0 * 33], s[1 * 33]); o.y = pk2(s[2 * 33], s[3 * 33]); o.z = pk2(s[4 * 33], s[5 * 33]); o.w = pk2(s[6 * 33], s[7 * 33]);
        *(u32x4*)(WT + (size_t)(n0 + n) * Kdst + k0 + 8 * c) = o; }
    asm volatile("s_waitcnt lgkmcnt(0)" ::: "memory");
}
__device__ __forceinline__ int win_src(int j) {
    if (j < 416) return j;
    if (j < 432) return 3104 + (j - 416);
    if (j < 512) return -1;
    if (j < 2048) return 416 + (j - 512);
    if (j < 2176) return 1952 + (j - 2048);
    if (j < 2304) return -1;
    if (j < 3328) return 2080 + (j - 2304);
    return 3120 + (j - 3328);
}
__device__ __forceinline__ int wuq_src(int j) { const int h = j / 96, c = j % 96; if (c < 64) return h * 96 + c; const int r = c - 64; return h * 96 + 64 + (r & 1) * 16 + (r >> 1); }
__device__ __forceinline__ int wukv_src(int j) { return j < 512 ? (j >> 6) * 128 + (j & 63) : ((j - 512) >> 6) * 128 + 64 + (j & 63); }

__device__ __forceinline__ void convert_weights(int l, unsigned char* lds, int gw, int NGW, int wave, int lane) {
    float* scr = (float*)(lds + wave * 8448); const Params p = load_params();
    bf16_t* WinT = (bf16_t*)(p.ws + WS_WIN); bf16_t* WboT = (bf16_t*)(p.ws + WS_WBO); bf16_t* WoutT = (bf16_t*)(p.ws + WS_WOUT); bf16_t* WuqT = (bf16_t*)(p.ws + WS_WUQ); bf16_t* WukvT = (bf16_t*)(p.ws + WS_WUKV);
    constexpr int I_IN = 16 * (NALL / 32), I_BO = 8 * 32, I_OUT = 16 * 32, I_UQ = 4 * 24, I_UKV = 4 * 32;
    constexpr int NITEMS = I_IN + 3 * I_BO + I_OUT + I_UQ + I_UKV;
    for (int it = gw; it < NITEMS; it += NGW) {
        int r = it;
        if (r < I_IN) { transpose_item(p.w_in + (size_t)l * 1024 * N_IN, 1024, N_IN, WinT, 1024, r, NALL / 32, scr, lane, [](int j) { return win_src(j); }, nullptr); continue; } r -= I_IN;
        if (r < 3 * I_BO) { const int n = r / I_BO; r -= n * I_BO;
            transpose_item(p.w_branch_out + ((size_t)l * 3 + n) * 512 * 1024, 512, 1024, WboT + (size_t)n * 1024 * 512, 512, r, 32, scr, lane, [](int j) { return j; }, nullptr); continue; } r -= 3 * I_BO;
        if (r < I_OUT) { transpose_item(p.w_out + (size_t)l * 1024 * 1024, 1024, 1024, WoutT, 1024, r, 32, scr, lane, [](int j) { return j; }, nullptr); continue; } r -= I_OUT;
        if (r < I_UQ) { transpose_item(p.mla_w_uq + (size_t)l * 256 * 768, 256, 768, WuqT, 256, r, 24, scr, lane, [](int j) { return wuq_src(j); }, p.mla_q_norm + l * 256); continue; } r -= I_UQ;
        transpose_item(p.mla_w_ukv + (size_t)l * 128 * 1024, 128, 1024, WukvT, 256, r, 32, scr, lane, [](int j) { return wukv_src(j); }, p.mla_kv_norm + l * 128);
    }
}
__device__ __forceinline__ void hb_row(const float* xrow, const float* g, bf16_t* orow, int lane) {
    const f32x4* xr = (const f32x4*)xrow + lane; const f32x4* gr = (const f32x4*)g + lane;
    f32x4 v[4]; float s = 0.f;
#pragma unroll
    for (int j = 0; j < 4; ++j) { v[j] = xr[64 * j]; s += (v[j].x * v[j].x + v[j].y * v[j].y) + (v[j].z * v[j].z + v[j].w * v[j].w); }
    const float rstd = rsqrtf(wave_sum(s) * (1.f / DM) + NORM_EPS);
    u32x2* o8 = (u32x2*)orow + lane;
#pragma unroll
    for (int j = 0; j < 4; ++j) { const f32x4 gg = gr[64 * j]; u32x2 w; w.x = pk2(v[j].x * rstd * gg.x, v[j].y * rstd * gg.y); w.y = pk2(v[j].z * rstd * gg.z, v[j].w * rstd * gg.w); o8[64 * j] = w; }
}
__device__ __forceinline__ void hb_rows4(const float* x, const float* g, bf16_t* HB, int m, int stride, int lane) {
    f32x4 v[4][4];
#pragma unroll
    for (int r = 0; r < 4; ++r) { const f32x4* xr = (const f32x4*)(x + (size_t)(m + r * stride) * DM) + lane;
#pragma unroll
        for (int j = 0; j < 4; ++j) v[r][j] = xr[64 * j]; }
    const f32x4* gr = (const f32x4*)g + lane;
#pragma unroll
    for (int r = 0; r < 4; ++r) { float s = 0.f;
#pragma unroll
        for (int j = 0; j < 4; ++j) s += (v[r][j].x * v[r][j].x + v[r][j].y * v[r][j].y) + (v[r][j].z * v[r][j].z + v[r][j].w * v[r][j].w);
        const float rstd = rsqrtf(wave_sum(s) * (1.f / DM) + NORM_EPS);
        u32x2* o8 = (u32x2*)(HB + (size_t)(m + r * stride) * DM) + lane;
#pragma unroll
        for (int j = 0; j < 4; ++j) { const f32x4 gg = gr[64 * j]; u32x2 w; w.x = pk2(v[r][j].x * rstd * gg.x, v[r][j].y * rstd * gg.y); w.y = pk2(v[r][j].z * rstd * gg.z, v[r][j].w * rstd * gg.w); o8[64 * j] = w; } }
}
template <bool XIN16> struct RowIn { u32x4 oa, ob, xa, xb; f32x4 xv[4]; };
template <bool XIN16> __device__ __forceinline__ void final_load(RowIn<XIN16>& r, const bf16_t* orow, const float* xold, int lane) {
    r.oa = *((const u32x4*)orow + lane); r.ob = *((const u32x4*)orow + 64 + lane);
    if (XIN16) { r.xa = *((const u32x4*)xold + lane); r.xb = *((const u32x4*)xold + 64 + lane); }
    else {
#pragma unroll
        for (int h = 0; h < 2; ++h)
#pragma unroll
            for (int q = 0; q < 2; ++q) r.xv[2 * h + q] = *((const f32x4*)(xold + 512 * h + 8 * lane) + q); }
}
template <bool XIN16, bool XOUT16>
__device__ __forceinline__ void final_row(const RowIn<XIN16>& r, const float* gpost, float* xnew, const float* gnext, bf16_t* hbrow, int lane) {
    float o[16], x[16], g[16];
    { const u32x4 a = r.oa, b = r.ob;
      o[0] = bflo(a.x); o[1] = bfhi(a.x); o[2] = bflo(a.y); o[3] = bfhi(a.y); o[4] = bflo(a.z); o[5] = bfhi(a.z); o[6] = bflo(a.w); o[7] = bfhi(a.w);
      o[8] = bflo(b.x); o[9] = bfhi(b.x); o[10] = bflo(b.y); o[11] = bfhi(b.y); o[12] = bflo(b.z); o[13] = bfhi(b.z); o[14] = bflo(b.w); o[15] = bfhi(b.w); }
    if (XIN16) { const u32x4 a = r.xa, b = r.xb;
      x[0] = bflo(a.x); x[1] = bfhi(a.x); x[2] = bflo(a.y); x[3] = bfhi(a.y); x[4] = bflo(a.z); x[5] = bfhi(a.z); x[6] = bflo(a.w); x[7] = bfhi(a.w);
      x[8] = bflo(b.x); x[9] = bfhi(b.x); x[10] = bflo(b.y); x[11] = bfhi(b.y); x[12] = bflo(b.z); x[13] = bfhi(b.z); x[14] = bflo(b.w); x[15] = bfhi(b.w); }
#pragma unroll
    for (int h = 0; h < 2; ++h)
#pragma unroll
        for (int q = 0; q < 2; ++q) { const f32x4 gv = *((const f32x4*)(gpost + 512 * h + 8 * lane) + q);
            if (!XIN16) {
#pragma unroll
                for (int e = 0; e < 4; ++e) x[8 * h + 4 * q + e] = r.xv[2 * h + q][e]; }
#pragma unroll
            for (int e = 0; e < 4; ++e) g[8 * h + 4 * q + e] = gv[e]; }
    float s = 0.f;
#pragma unroll
    for (int e = 0; e < 16; ++e) s += o[e] * o[e];
    const float rstd = rsqrtf(wave_sum(s) * (1.f / DM) + NORM_EPS);
    float s2 = 0.f;
#pragma unroll
    for (int e = 0; e < 16; ++e) { x[e] += o[e] * rstd * g[e]; s2 += x[e] * x[e]; }
    if (XOUT16) {
#pragma unroll
        for (int h = 0; h < 2; ++h) { u32x4 w; w.x = pk2(x[8 * h], x[8 * h + 1]); w.y = pk2(x[8 * h + 2], x[8 * h + 3]); w.z = pk2(x[8 * h + 4], x[8 * h + 5]); w.w = pk2(x[8 * h + 6], x[8 * h + 7]);
            *((u32x4*)xnew + 64 * h + lane) = w; }
    } else {
#pragma unroll
        for (int h = 0; h < 2; ++h)
#pragma unroll
            for (int q = 0; q < 2; ++q) *((f32x4*)(xnew + 512 * h + 8 * lane) + q) = (f32x4){x[8 * h + 4 * q], x[8 * h + 4 * q + 1], x[8 * h + 4 * q + 2], x[8 * h + 4 * q + 3]};
    }
    if (gnext) { const float rstd2 = rsqrtf(wave_sum(s2) * (1.f / DM) + NORM_EPS);
#pragma unroll
        for (int h = 0; h < 2; ++h) { const f32x4 g0 = *((const f32x4*)(gnext + 512 * h + 8 * lane)), g1 = *((const f32x4*)(gnext + 512 * h + 8 * lane) + 1);
            u32x4 w; w.x = pk2(x[8 * h] * rstd2 * g0[0], x[8 * h + 1] * rstd2 * g0[1]); w.y = pk2(x[8 * h + 2] * rstd2 * g0[2], x[8 * h + 3] * rstd2 * g0[3]);
            w.z = pk2(x[8 * h + 4] * rstd2 * g1[0], x[8 * h + 5] * rstd2 * g1[1]); w.w = pk2(x[8 * h + 6] * rstd2 * g1[2], x[8 * h + 7] * rstd2 * g1[3]);
            *((u32x4*)hbrow + 64 * h + lane) = w; } }
}
__device__ __forceinline__ void mla_prep_row(const bf16_t* prow, const f32x2* rope_t, float* rstdq, float* rstdkv, bf16_t* krow, int lane) {
    const u32x2 a = *((const u32x2*)(prow + CQ) + lane); const unsigned c = *((const unsigned*)(prow + CKV) + lane);
    float sq = bflo(a.x) * bflo(a.x) + bfhi(a.x) * bfhi(a.x) + bflo(a.y) * bflo(a.y) + bfhi(a.y) * bfhi(a.y);
    float sk = bflo(c) * bflo(c) + bfhi(c) * bfhi(c);
    sq = wave_sum(sq); sk = wave_sum(sk);
    if (lane == 0) { *rstdq = rsqrtf(sq * (1.f / 256.f) + NORM_EPS); *rstdkv = rsqrtf(sk * (1.f / 128.f) + NORM_EPS); }
    if (lane < 16) { const float x1 = bf2f(prow[KROPE + lane]), x2 = bf2f(prow[KROPE + 16 + lane]); const f32x2 cs = rope_t[lane];
        *((unsigned*)(krow + 512) + lane) = pk2(x1 * cs.x - x2 * cs.y, x2 * cs.x + x1 * cs.y); }
}

__device__ __forceinline__ void mla_prep_rows4(const bf16_t* PA, const f32x2* ROPE, float* RSTDQ, float* RSTDKV, bf16_t* Kb, int m, int stride, int lane) {
    u32x2 a[4]; unsigned c[4]; float x1[4], x2[4]; f32x2 cs[4];
#pragma unroll
    for (int j = 0; j < 4; ++j) { const int r = (m + j * stride < T) ? m + j * stride : m; const bf16_t* prow = PA + (size_t)r * NA;
        a[j] = *((const u32x2*)(prow + CQ) + lane); c[j] = *((const unsigned*)(prow + CKV) + lane);
        x1[j] = bf2f(prow[KROPE + (lane & 15)]); x2[j] = bf2f(prow[KROPE + 16 + (lane & 15)]); cs[j] = ROPE[(size_t)r * 16 + (lane & 15)]; }
#pragma unroll
    for (int j = 0; j < 4; ++j) { const int r = m + j * stride; if (r < T) {
        float sq = bflo(a[j].x) * bflo(a[j].x) + bfhi(a[j].x) * bfhi(a[j].x) + bflo(a[j].y) * bflo(a[j].y) + bfhi(a[j].y) * bfhi(a[j].y);
        float sk = bflo(c[j]) * bflo(c[j]) + bfhi(c[j]) * bfhi(c[j]);
        sq = wave_sum(sq); sk = wave_sum(sk);
        if (lane == 0) { RSTDQ[r] = rsqrtf(sq * (1.f / 256.f) + NORM_EPS); RSTDKV[r] = rsqrtf(sk * (1.f / 128.f) + NORM_EPS); }
        if (lane < 16) *((unsigned*)(Kb + (size_t)r * KP + 512) + lane) = pk2(x1[j] * cs[j].x - x2[j] * cs[j].y, x2[j] * cs[j].x + x1[j] * cs[j].y); } }
}

__device__ __forceinline__ void mla_prep_rows8(const bf16_t* PA, const f32x2* ROPE, float* RSTDQ, float* RSTDKV, bf16_t* Kb, int m, int stride, int lane) {
    u32x2 a[8]; unsigned c[8]; float x1[8], x2[8]; f32x2 cs[8];
#pragma unroll
    for (int j = 0; j < 8; ++j) { const int r = (m + j * stride < T) ? m + j * stride : m; const bf16_t* prow = PA + (size_t)r * NA;
        a[j] = *((const u32x2*)(prow + CQ) + lane); c[j] = *((const unsigned*)(prow + CKV) + lane);
        x1[j] = bf2f(prow[KROPE + (lane & 15)]); x2[j] = bf2f(prow[KROPE + 16 + (lane & 15)]); cs[j] = ROPE[(size_t)r * 16 + (lane & 15)]; }
#pragma unroll
    for (int j = 0; j < 8; ++j) { const int r = m + j * stride; if (r < T) {
        float sq = bflo(a[j].x) * bflo(a[j].x) + bfhi(a[j].x) * bfhi(a[j].x) + bflo(a[j].y) * bflo(a[j].y) + bfhi(a[j].y) * bfhi(a[j].y);
        float sk = bflo(c[j]) * bflo(c[j]) + bfhi(c[j]) * bfhi(c[j]);
        sq = wave_sum(sq); sk = wave_sum(sk);
        if (lane == 0) { RSTDQ[r] = rsqrtf(sq * (1.f / 256.f) + NORM_EPS); RSTDKV[r] = rsqrtf(sk * (1.f / 128.f) + NORM_EPS); }
        if (lane < 16) *((unsigned*)(Kb + (size_t)r * KP + 512) + lane) = pk2(x1[j] * cs[j].x - x2[j] * cs[j].y, x2[j] * cs[j].x + x1[j] * cs[j].y); } }
}

#ifdef BANDSKIP
namespace att {
constexpr int KSLOT = 12288, VSLOT = 8192, BUFB = KSLOT + VSLOT, L_WS = 2 * BUFB, L_OST = L_WS + 8 * 128 * 4, L_END = L_OST + 8 * 4096;
constexpr int UNIT_ROWS = 512;
__device__ __forceinline__ int crow(int r, int hi) { return (r & 3) + 8 * (r >> 2) + 4 * hi; }
__device__ __forceinline__ s16x4 vtr(const LAS unsigned char* p) { return __builtin_bit_cast(s16x4, __builtin_amdgcn_ds_read_tr16_b64_v4i16((LAS s16x4*)p)); }
__device__ __forceinline__ void load_q(bf16x8 (&qr)[6], const bf16_t* Q, const f32x2* rope, size_t row, int h, int hi) {
    const bf16_t* Qw = Q + row * 768 + h * 96 + hi * 8;
#pragma unroll
    for (int s = 0; s < 6; ++s) qr[s] = *(const bf16x8*)(Qw + s * 16);
    const f32x4* rp = (const f32x4*)(rope + row * 16 + 4 * hi);
#pragma unroll
    for (int s = 4; s < 6; ++s) { const f32x4 c01 = rp[(s - 4) * 4], c23 = rp[(s - 4) * 4 + 1]; const u32x4 w = __builtin_bit_cast(u32x4, qr[s]); u32x4 o;
        { const float e = bflo(w.x), d = bfhi(w.x); o.x = pk2(e * c01[0] - d * c01[1], d * c01[0] + e * c01[1]); }
        { const float e = bflo(w.y), d = bfhi(w.y); o.y = pk2(e * c01[2] - d * c01[3], d * c01[2] + e * c01[3]); }
        { const float e = bflo(w.z), d = bfhi(w.z); o.z = pk2(e * c23[0] - d * c23[1], d * c23[0] + e * c23[1]); }
        { const float e = bflo(w.w), d = bfhi(w.w); o.w = pk2(e * c23[2] - d * c23[3], d * c23[2] + e * c23[3]); }
        qr[s] = __builtin_bit_cast(bf16x8, o); }
}
__device__ __forceinline__ void softmax_half(f32x16& p0, f32x16& p1, f32x16& o0, f32x16& o1, float& mrun, float& lrun, bf16x8 (&pa)[4],
                                             bool first, bool band, int kb0, int qrel, int r32, int hi, LAS float* wsf) {
    if (band) {
#pragma unroll
        for (int r = 0; r < 16; ++r) { const int kv = kb0 + (r & 3) + 8 * (r >> 2); if (kv > qrel) p0[r] = -INFINITY; if (kv + 32 > qrel) p1[r] = -INFINITY; } }
    float mx = fmaxf(p0[0], p1[0]);
#pragma unroll
    for (int r = 1; r < 16; ++r) mx = fmaxf(mx, fmaxf(p0[r], p1[r]));
    mx = fmaxf(mx, __shfl_xor(mx, 32));
    if (first || __any(mx > 8.0f)) {
        const float dl = first ? mx : fmaxf(mx, 0.f); mrun += dl;
#pragma unroll
        for (int r = 0; r < 16; ++r) { p0[r] -= dl; p1[r] -= dl; }
        const float alpha = __builtin_amdgcn_exp2f(-dl); lrun *= alpha;
        if (hi == 0) wsf[r32] = alpha;
#pragma unroll
        for (int r = 0; r < 16; ++r) { const float a = wsf[crow(r, hi)]; o0[r] *= a; o1[r] *= a; }
    }
    float ls = 0.f;
#pragma unroll
    for (int r = 0; r < 16; ++r) { p0[r] = __builtin_amdgcn_exp2f(p0[r]); p1[r] = __builtin_amdgcn_exp2f(p1[r]); ls += p0[r] + p1[r]; }
    lrun += ls;
#pragma unroll
    for (int s = 0; s < 4; ++s) { const int bb = 8 * (s & 1); u32x4 w;
        if (s < 2) { w.x = pk2(p0[bb], p0[bb + 1]); w.y = pk2(p0[bb + 2], p0[bb + 3]); w.z = pk2(p0[bb + 4], p0[bb + 5]); w.w = pk2(p0[bb + 6], p0[bb + 7]); }
        else { w.x = pk2(p1[bb], p1[bb + 1]); w.y = pk2(p1[bb + 2], p1[bb + 3]); w.z = pk2(p1[bb + 4], p1[bb + 5]); w.w = pk2(p1[bb + 6], p1[bb + 7]); }
        pa[s] = __builtin_bit_cast(bf16x8, w); }
}
__device__ __forceinline__ void attn_unit(int b, int h, int qb, LAS unsigned char* lds, unsigned* done_ctr) {
    KArgs kp = kargs(); unsigned char* ws_ = kp->ws;
    const bf16_t* Q = (const bf16_t*)(ws_ + WS_Q); const bf16_t* Kg = (const bf16_t*)(ws_ + WS_K); const bf16_t* Vg = (const bf16_t*)(ws_ + WS_V); bf16_t* O = (bf16_t*)(ws_ + WS_YS);
    const int tid = opaque_tid(), lane = tid & 63, r32 = lane & 31, hi = lane >> 5; const int wid = __builtin_amdgcn_readfirstlane(tid >> 6);
    const size_t rowbase = (size_t)b * SEQ; const int q0 = qb * UNIT_ROWS;
    bf16x8 qa[6], qb_[6];
    const int rba = 32 * wid, rbb = 32 * (15 - wid);
    load_q(qa, Q, (const f32x2*)(ws_ + WS_ROPE), rowbase + q0 + rba + r32, h, hi);
    load_q(qb_, Q, (const f32x2*)(ws_ + WS_ROPE), rowbase + q0 + rbb + r32, h, hi);
    const char* kbase0 = (const char*)(Kg + rowbase * KP + h * 64); const char* kbase1 = (const char*)(Kg + rowbase * KP + 512);
    const char* vbase = (const char*)(Vg + rowbase * 512 + h * 64);
    const unsigned kof = (unsigned)(((tid & 63) * KP + (tid >> 6) * 8) * 2), vof = (unsigned)((((tid & 255) >> 2) * 512 + (tid >> 8) * 32 + (tid & 3) * 8) * 2);
    const int NT = (q0 + UNIT_ROWS) / 64;
    LAS float* wsf = (LAS float*)(lds + L_WS) + wid * 128;
    u32x4 sk0, sk1, sv;
    sk0 = *(const u32x4*)(kbase0 + kof); if (tid < 256) sk1 = *(const u32x4*)(kbase1 + kof); sv = *(const u32x4*)(vbase + vof);
    *(LAS u32x4*)(lds + tid * 16) = sk0; if (tid < 256) *(LAS u32x4*)(lds + (tid + 512) * 16) = sk1; *(LAS u32x4*)(lds + KSLOT + tid * 16) = sv;
    __syncthreads();
    f32x16 oa0 = {}, oa1 = {}, ob0 = {}, ob1 = {}; float ma = 0.f, la = 0.f, mb = 0.f, lb = 0.f;
    const int qra = rba + r32, qrb = rbb + r32;
    const int tlastA = NT - 8 + ((rba + 31) >> 6), tlastB = NT - 8 + ((rbb + 31) >> 6);
    for (int t = 0; t < NT; ++t) {
        int tidv = tid; asm volatile("" : "+v"(tidv));
        const int lanev = tidv & 63, r32v = lanev & 31, hiv = lanev >> 5;
        const unsigned kofv = (unsigned)(((tidv & 63) * KP + (tidv >> 6) * 8) * 2), vofv = (unsigned)((((tidv & 255) >> 2) * 512 + (tidv >> 8) * 32 + (tidv & 3) * 8) * 2);
        LAS unsigned char* buf = lds + (t & 1) * BUFB; LAS unsigned char* nbuf = lds + ((t + 1) & 1) * BUFB;
        if (t + 1 < NT) { const size_t ko = (size_t)(t + 1) * 64 * KP * 2, vo = (size_t)(t + 1) * 64 * 512 * 2;
            sk0 = *(const u32x4*)(kbase0 + ko + kofv); if (tidv < 256) sk1 = *(const u32x4*)(kbase1 + ko + kofv); sv = *(const u32x4*)(vbase + vo + vofv); }
        const bool band = t >= NT - 8; const int kb0 = 64 * (t - (NT - 8)) + 4 * hiv;
        const bool doA = t <= tlastA, doB = t <= tlastB;
        f32x16 pa0, pa1, pb0, pb1;
#pragma unroll
        for (int r = 0; r < 16; ++r) { pa0[r] = -ma; pa1[r] = -ma; pb0[r] = -mb; pb1[r] = -mb; }
        { const LAS unsigned char* kb = buf + hiv * 1024 + r32v * 16;
#pragma unroll
          for (int s = 0; s < 6; ++s) { const bf16x8 a0 = *(const LAS bf16x8*)(kb + s * 2048), a1 = *(const LAS bf16x8*)(kb + s * 2048 + 512);
              if (doA) { pa0 = __builtin_amdgcn_mfma_f32_32x32x16_bf16(a0, qa[s], pa0, 0, 0, 0); pa1 = __builtin_amdgcn_mfma_f32_32x32x16_bf16(a1, qa[s], pa1, 0, 0, 0); }
              if (doB) { pb0 = __builtin_amdgcn_mfma_f32_32x32x16_bf16(a0, qb_[s], pb0, 0, 0, 0); pb1 = __builtin_amdgcn_mfma_f32_32x32x16_bf16(a1, qb_[s], pb1, 0, 0, 0); } } }
        bf16x8 fa[4], fb[4];
        if (doA) softmax_half(pa0, pa1, oa0, oa1, ma, la, fa, t == 0, band, kb0, (rba + r32v), r32v, hiv, wsf);
        if (doB) softmax_half(pb0, pb1, ob0, ob1, mb, lb, fb, t == 0, band, kb0, (rbb + r32v), r32v, hiv, wsf + 64);
        { const LAS unsigned char* vb = buf + KSLOT + ((lanev >> 4) & 1) * 32 + (lanev & 3) * 8 + (4 * hiv + ((lanev & 15) >> 2)) * 64;
#pragma unroll
          for (int s = 0; s < 4; ++s) {
              { const s16x4 lo = vtr(vb + s * 1024), hh = vtr(vb + s * 1024 + 512); const bf16x8 vf = {lo[0], lo[1], lo[2], lo[3], hh[0], hh[1], hh[2], hh[3]};
                if (doA) oa0 = __builtin_amdgcn_mfma_f32_32x32x16_bf16(fa[s], vf, oa0, 0, 0, 0); if (doB) ob0 = __builtin_amdgcn_mfma_f32_32x32x16_bf16(fb[s], vf, ob0, 0, 0, 0); }
              { const s16x4 lo = vtr(vb + 4096 + s * 1024), hh = vtr(vb + 4096 + s * 1024 + 512); const bf16x8 vf = {lo[0], lo[1], lo[2], lo[3], hh[0], hh[1], hh[2], hh[3]};
                if (doA) oa1 = __builtin_amdgcn_mfma_f32_32x32x16_bf16(fa[s], vf, oa1, 0, 0, 0); if (doB) ob1 = __builtin_amdgcn_mfma_f32_32x32x16_bf16(fb[s], vf, ob1, 0, 0, 0); } } }
        if (t + 1 < NT) { *(LAS u32x4*)(nbuf + tidv * 16) = sk0; if (tidv < 256) *(LAS u32x4*)(nbuf + (tidv + 512) * 16) = sk1; *(LAS u32x4*)(nbuf + KSLOT + tidv * 16) = sv; }
        __syncthreads();
    }
    la += __shfl_xor(la, 32); lb += __shfl_xor(lb, 32);
    if (hi == 0) { wsf[32 + r32] = la; wsf[96 + r32] = lb; }
    LAS bf16_t* stg = (LAS bf16_t*)(lds + L_OST) + wid * 2048;
#pragma unroll
    for (int hf = 0; hf < 2; ++hf) {
#pragma unroll
        for (int r = 0; r < 16; ++r) { const int orow = crow(r, hi); const float rl = __builtin_amdgcn_rcpf(wsf[hf * 64 + 32 + orow]);
            stg[orow * 64 + r32] = f2bf((hf ? ob0[r] : oa0[r]) * rl); stg[orow * 64 + 32 + r32] = f2bf((hf ? ob1[r] : oa1[r]) * rl); }
        asm volatile("" ::: "memory");
        bf16_t* Ow = O + (rowbase + q0 + (hf ? rbb : rba)) * 512 + h * 64;
#pragma unroll
        for (int i = 0; i < 4; ++i) { const int row = i * 8 + (lane >> 3), ch = lane & 7; const u32x4 v = *(const LAS u32x4*)(stg + row * 64 + ch * 8); *(u32x4*)(Ow + (size_t)row * 512 + ch * 8) = v; }
        asm volatile("" ::: "memory");
    }
    asm volatile("s_waitcnt vmcnt(0)" ::: "memory");
    __syncthreads();
    if (tid == 0) __hip_atomic_fetch_add(done_ctr, 1u, __ATOMIC_RELEASE, __HIP_MEMORY_SCOPE_AGENT);
}
}
#else
namespace att {
constexpr int KSLOT = 12288, VSLOT = 8192, BUFB = KSLOT + VSLOT, L_WS = 2 * BUFB, L_OST = L_WS + 8 * 128 * 4, L_END = L_OST + 8 * 4096;
constexpr int UNIT_ROWS = 512;
__device__ __forceinline__ int crow(int r, int hi) { return (r & 3) + 8 * (r >> 2) + 4 * hi; }
__device__ __forceinline__ s16x4 vtr(const LAS unsigned char* p) { return __builtin_bit_cast(s16x4, __builtin_amdgcn_ds_read_tr16_b64_v4i16((LAS s16x4*)p)); }
__device__ __forceinline__ void load_q(bf16x8 (&qr)[6], const bf16_t* Q, const f32x2* rope, size_t row, int h, int hi) {
    const bf16_t* Qw = Q + row * 768 + h * 96 + hi * 8;
#pragma unroll
    for (int s = 0; s < 6; ++s) qr[s] = *(const bf16x8*)(Qw + s * 16);
    const f32x4* rp = (const f32x4*)(rope + row * 16 + 4 * hi);
#pragma unroll
    for (int s = 4; s < 6; ++s) { const f32x4 c01 = rp[(s - 4) * 4], c23 = rp[(s - 4) * 4 + 1]; const u32x4 w = __builtin_bit_cast(u32x4, qr[s]); u32x4 o;
        { const float e = bflo(w.x), d = bfhi(w.x); o.x = pk2(e * c01[0] - d * c01[1], d * c01[0] + e * c01[1]); }
        { const float e = bflo(w.y), d = bfhi(w.y); o.y = pk2(e * c01[2] - d * c01[3], d * c01[2] + e * c01[3]); }
        { const float e = bflo(w.z), d = bfhi(w.z); o.z = pk2(e * c23[0] - d * c23[1], d * c23[0] + e * c23[1]); }
        { const float e = bflo(w.w), d = bfhi(w.w); o.w = pk2(e * c23[2] - d * c23[3], d * c23[2] + e * c23[3]); }
        qr[s] = __builtin_bit_cast(bf16x8, o); }
}
__device__ __forceinline__ void softmax_half(f32x16& p0, f32x16& p1, f32x16& o0, f32x16& o1, float& mrun, float& lrun, bf16x8 (&pa)[4],
                                             bool first, bool band, int kb0, int qrel, int r32, int hi, LAS float* wsf) {
    if (band) {
#pragma unroll
        for (int r = 0; r < 16; ++r) { const int kv = kb0 + (r & 3) + 8 * (r >> 2); if (kv > qrel) p0[r] = -INFINITY; if (kv + 32 > qrel) p1[r] = -INFINITY; } }
    float mx = fmaxf(p0[0], p1[0]);
#pragma unroll
    for (int r = 1; r < 16; ++r) mx = fmaxf(mx, fmaxf(p0[r], p1[r]));
    mx = fmaxf(mx, __shfl_xor(mx, 32));
    if (first || __any(mx > 8.0f)) {
        const float dl = first ? mx : fmaxf(mx, 0.f); mrun += dl;
#pragma unroll
        for (int r = 0; r < 16; ++r) { p0[r] -= dl; p1[r] -= dl; }
        const float alpha = __builtin_amdgcn_exp2f(-dl); lrun *= alpha;
        if (hi == 0) wsf[r32] = alpha;
#pragma unroll
        for (int r = 0; r < 16; ++r) { const float a = wsf[crow(r, hi)]; o0[r] *= a; o1[r] *= a; }
    }
    float ls = 0.f;
#pragma unroll
    for (int r = 0; r < 16; ++r) { p0[r] = __builtin_amdgcn_exp2f(p0[r]); p1[r] = __builtin_amdgcn_exp2f(p1[r]); ls += p0[r] + p1[r]; }
    lrun += ls;
#pragma unroll
    for (int s = 0; s < 4; ++s) { const int bb = 8 * (s & 1); u32x4 w;
        if (s < 2) { w.x = pk2(p0[bb], p0[bb + 1]); w.y = pk2(p0[bb + 2], p0[bb + 3]); w.z = pk2(p0[bb + 4], p0[bb + 5]); w.w = pk2(p0[bb + 6], p0[bb + 7]); }
        else { w.x = pk2(p1[bb], p1[bb + 1]); w.y = pk2(p1[bb + 2], p1[bb + 3]); w.z = pk2(p1[bb + 4], p1[bb + 5]); w.w = pk2(p1[bb + 6], p1[bb + 7]); }
        pa[s] = __builtin_bit_cast(bf16x8, w); }
}
__device__ __forceinline__ void attn_unit(int b, int h, int qb, LAS unsigned char* lds, unsigned* done_ctr) {
    KArgs kp = kargs(); unsigned char* ws_ = kp->ws;
    const bf16_t* Q = (const bf16_t*)(ws_ + WS_Q); const bf16_t* Kg = (const bf16_t*)(ws_ + WS_K); const bf16_t* Vg = (const bf16_t*)(ws_ + WS_V); bf16_t* O = (bf16_t*)(ws_ + WS_YS);
    const int tid = opaque_tid(), lane = tid & 63, r32 = lane & 31, hi = lane >> 5; const int wid = __builtin_amdgcn_readfirstlane(tid >> 6);
    const size_t rowbase = (size_t)b * SEQ; const int q0 = qb * UNIT_ROWS;
    bf16x8 qa[6], qb_[6];
    load_q(qa, Q, (const f32x2*)(ws_ + WS_ROPE), rowbase + q0 + wid * 64 + r32, h, hi);
    load_q(qb_, Q, (const f32x2*)(ws_ + WS_ROPE), rowbase + q0 + wid * 64 + 32 + r32, h, hi);
    const bf16_t* ksrc0 = Kg + (rowbase + (tid & 63)) * KP + h * 64 + (tid >> 6) * 8;
    const bf16_t* ksrc1 = Kg + (rowbase + (tid & 63)) * KP + 512 + (tid >> 6) * 8;
    const bf16_t* vsrc = Vg + (rowbase + ((tid & 255) >> 2)) * 512 + h * 64 + (tid >> 8) * 32 + (tid & 3) * 8;
    const int NT = (q0 + UNIT_ROWS) / 64;
    LAS float* wsf = (LAS float*)(lds + L_WS) + wid * 128;
    u32x4 sk0, sk1, sv;
    sk0 = *(const u32x4*)ksrc0; if (tid < 256) sk1 = *(const u32x4*)ksrc1; sv = *(const u32x4*)vsrc;
    *(LAS u32x4*)(lds + tid * 16) = sk0; if (tid < 256) *(LAS u32x4*)(lds + (tid + 512) * 16) = sk1; *(LAS u32x4*)(lds + KSLOT + tid * 16) = sv;
    __syncthreads();
    f32x16 oa0 = {}, oa1 = {}, ob0 = {}, ob1 = {}; float ma = 0.f, la = 0.f, mb = 0.f, lb = 0.f;
    const int qra = wid * 64 + r32, qrb = qra + 32;
#ifdef ATT_STATIC_PRIO
    if (wid >= 4) __builtin_amdgcn_s_setprio(1);
#endif
    for (int t = 0; t < NT; ++t) {
        LAS unsigned char* buf = lds + (t & 1) * BUFB; LAS unsigned char* nbuf = lds + ((t + 1) & 1) * BUFB;
        if (t + 1 < NT) { sk0 = *(const u32x4*)(ksrc0 + (size_t)(t + 1) * 64 * KP); if (tid < 256) sk1 = *(const u32x4*)(ksrc1 + (size_t)(t + 1) * 64 * KP); sv = *(const u32x4*)(vsrc + (size_t)(t + 1) * 64 * 512); }
        f32x16 pa0, pa1, pb0, pb1;
#pragma unroll
        for (int r = 0; r < 16; ++r) { pa0[r] = -ma; pa1[r] = -ma; pb0[r] = -mb; pb1[r] = -mb; }
        { const LAS unsigned char* kb = buf + hi * 1024 + r32 * 16;
#pragma unroll
          for (int s = 0; s < 6; ++s) { const bf16x8 a0 = *(const LAS bf16x8*)(kb + s * 2048), a1 = *(const LAS bf16x8*)(kb + s * 2048 + 512);
              pa0 = __builtin_amdgcn_mfma_f32_32x32x16_bf16(a0, qa[s], pa0, 0, 0, 0); pa1 = __builtin_amdgcn_mfma_f32_32x32x16_bf16(a1, qa[s], pa1, 0, 0, 0);
              pb0 = __builtin_amdgcn_mfma_f32_32x32x16_bf16(a0, qb_[s], pb0, 0, 0, 0); pb1 = __builtin_amdgcn_mfma_f32_32x32x16_bf16(a1, qb_[s], pb1, 0, 0, 0); } }
        const bool band = t >= NT - 8; const int kb0 = 64 * (t - (NT - 8)) + 4 * hi;
        bf16x8 fa[4], fb[4];
        softmax_half(pa0, pa1, oa0, oa1, ma, la, fa, t == 0, band, kb0, qra, r32, hi, wsf);
        softmax_half(pb0, pb1, ob0, ob1, mb, lb, fb, t == 0, band, kb0, qrb, r32, hi, wsf + 64);
        { const LAS unsigned char* vb = buf + KSLOT + ((lane >> 4) & 1) * 32 + (lane & 3) * 8 + (4 * hi + ((lane & 15) >> 2)) * 64;
#pragma unroll
          for (int s = 0; s < 4; ++s) {
              { const s16x4 lo = vtr(vb + s * 1024), hh = vtr(vb + s * 1024 + 512); const bf16x8 vf = {lo[0], lo[1], lo[2], lo[3], hh[0], hh[1], hh[2], hh[3]};
                oa0 = __builtin_amdgcn_mfma_f32_32x32x16_bf16(fa[s], vf, oa0, 0, 0, 0); ob0 = __builtin_amdgcn_mfma_f32_32x32x16_bf16(fb[s], vf, ob0, 0, 0, 0); }
              { const s16x4 lo = vtr(vb + 4096 + s * 1024), hh = vtr(vb + 4096 + s * 1024 + 512); const bf16x8 vf = {lo[0], lo[1], lo[2], lo[3], hh[0], hh[1], hh[2], hh[3]};
                oa1 = __builtin_amdgcn_mfma_f32_32x32x16_bf16(fa[s], vf, oa1, 0, 0, 0); ob1 = __builtin_amdgcn_mfma_f32_32x32x16_bf16(fb[s], vf, ob1, 0, 0, 0); } } }
        if (t + 1 < NT) { *(LAS u32x4*)(nbuf + tid * 16) = sk0; if (tid < 256) *(LAS u32x4*)(nbuf + (tid + 512) * 16) = sk1; *(LAS u32x4*)(nbuf + KSLOT + tid * 16) = sv; }
        __syncthreads();
    }
#ifdef ATT_STATIC_PRIO
    __builtin_amdgcn_s_setprio(0);
#endif
    la += __shfl_xor(la, 32); lb += __shfl_xor(lb, 32);
    if (hi == 0) { wsf[32 + r32] = la; wsf[96 + r32] = lb; }
    LAS bf16_t* stg = (LAS bf16_t*)(lds + L_OST) + wid * 2048;
#pragma unroll
    for (int hf = 0; hf < 2; ++hf) {
#pragma unroll
        for (int r = 0; r < 16; ++r) { const int orow = crow(r, hi); const float rl = __builtin_amdgcn_rcpf(wsf[hf * 64 + 32 + orow]);
            stg[orow * 64 + r32] = f2bf((hf ? ob0[r] : oa0[r]) * rl); stg[orow * 64 + 32 + r32] = f2bf((hf ? ob1[r] : oa1[r]) * rl); }
        asm volatile("" ::: "memory");
        bf16_t* Ow = O + (rowbase + q0 + wid * 64 + hf * 32) * 512 + h * 64;
        if (h < 4) {
            u32x4 gg[4];
#pragma unroll
            for (int i = 0; i < 4; ++i) gg[i] = *(const u32x4*)(Ow + (size_t)(i * 8 + (lane >> 3)) * 512 + (lane & 7) * 8);
#pragma unroll
            for (int i = 0; i < 4; ++i) { const int row = i * 8 + (lane >> 3), ch = lane & 7; const u32x4 v = *(const LAS u32x4*)(stg + row * 64 + ch * 8); const u32x4 g = gg[i]; u32x4 w;
                w.x = pk2(bflo(v.x) * bflo(g.x), bfhi(v.x) * bfhi(g.x)); w.y = pk2(bflo(v.y) * bflo(g.y), bfhi(v.y) * bfhi(g.y)); w.z = pk2(bflo(v.z) * bflo(g.z), bfhi(v.z) * bfhi(g.z)); w.w = pk2(bflo(v.w) * bflo(g.w), bfhi(v.w) * bfhi(g.w));
                *(u32x4*)(Ow + (size_t)row * 512 + ch * 8) = w; }
        } else {
#pragma unroll
        for (int i = 0; i < 4; ++i) { const int row = i * 8 + (lane >> 3), ch = lane & 7; const u32x4 v = *(const LAS u32x4*)(stg + row * 64 + ch * 8); *(u32x4*)(Ow + (size_t)row * 512 + ch * 8) = v; }
        }
        asm volatile("" ::: "memory");
    }
    asm volatile("s_waitcnt vmcnt(0)" ::: "memory");
    __syncthreads();
    if (tid == 0) __hip_atomic_fetch_add(done_ctr, 1u, __ATOMIC_RELEASE, __HIP_MEMORY_SCOPE_AGENT);
}
}
#endif

namespace rwkv {
constexpr int LP = 72, TB = 64 * LP * 2;
constexpr int S_HT0 = 0, S_HT1 = 1, S_A = 2  , S_B = 3  , S_K = 4, S_R = 5, S_BT = 6, S_KT = 7, S_V = 8,
              S_MOFF = 9, S_MAK = 10, S_MRK = 11, S_MRB = 12, S_D = 13, S_ZT = 14, S_ACC = 15, NSLOT = 16;
constexpr int FP = 68;
constexpr int O_ZW = S_K * TB, O_ZA = O_ZW + 64 * FP * 4, O_YB = S_MAK * TB, O_WT = NSLOT * TB, O_CL = O_WT + 8 * 64 * 4, O_CST = O_CL + 64 * 4, O_END = O_CST + 12 * 64 * 4, O_TT = O_END  ;
static_assert(O_ZA + 64 * FP * 4 <= (S_KT + 1) * TB && O_YB + 64 * FP * 4 <= (S_MRK + 1) * TB, "f32 aliases");
__device__ __forceinline__ s16x4 vtr(const LAS unsigned char* p) { return __builtin_bit_cast(s16x4, __builtin_amdgcn_ds_read_tr16_b64_v4i16((LAS s16x4*)p)); }
struct LaneOff { int bn, bt, bs; };
__device__ __forceinline__ LaneOff lane_off(int fr, int fq) { LaneOff o; o.bn = (fr * LP + 8 * fq) * 2; o.bt = ((8 * fq + (fr >> 2)) * LP + 4 * (fr & 3)) * 2; o.bs = (fr * LP + 4 * fq) * 2; return o; }
__device__ __forceinline__ void relaunder(LaneOff& o) { asm volatile("" : "+v"(o.bn), "+v"(o.bt), "+v"(o.bs)); }
__device__ __forceinline__ bf16x8 frag_t(const LAS unsigned char* tile, int kk, int c0, const LaneOff& o) {
    const LAS unsigned char* q = tile + o.bt + (32 * kk * LP + c0) * 2;
    const s16x4 lo = vtr(q), hi = vtr(q + 4 * LP * 2); return (bf16x8){lo[0], lo[1], lo[2], lo[3], hi[0], hi[1], hi[2], hi[3]};
}
__device__ __forceinline__ bf16x8 frag_n(const LAS unsigned char* tile, int r0, int kk, const LaneOff& o) { return *(const LAS bf16x8*)(tile + o.bn + (r0 * LP + 32 * kk) * 2); }
__device__ __forceinline__ f32x4 MFMA16(bf16x8 a, bf16x8 b, f32x4 c) { return __builtin_amdgcn_mfma_f32_16x16x32_bf16(a, b, c, 0, 0, 0); }
__device__ __forceinline__ void st_tile_T(LAS unsigned char* tile, int m0, int n0, const LaneOff& o, const f32x4 c) {
    u32x2 w; w.x = pk2(c[0], c[1]); w.y = pk2(c[2], c[3]); *(LAS u32x2*)(tile + o.bs + (n0 * LP + m0) * 2) = w;
}
__device__ __forceinline__ void unpack8(const u32x4 w, float (&f)[8]) { f[0] = bflo(w.x); f[1] = bfhi(w.x); f[2] = bflo(w.y); f[3] = bfhi(w.y); f[4] = bflo(w.z); f[5] = bfhi(w.z); f[6] = bflo(w.w); f[7] = bfhi(w.w); }
__device__ __forceinline__ u32x4 pack8(const float (&f)[8]) { u32x4 w; w.x = pk2(f[0], f[1]); w.y = pk2(f[2], f[3]); w.z = pk2(f[4], f[5]); w.w = pk2(f[6], f[7]); return w; }
__device__ __forceinline__ void ld8(const float* p, float (&f)[8]) { const f32x4 a = *(const f32x4*)p, b = *(const f32x4*)(p + 4); f[0] = a[0]; f[1] = a[1]; f[2] = a[2]; f[3] = a[3]; f[4] = b[0]; f[5] = b[1]; f[6] = b[2]; f[7] = b[3]; }
__device__ __forceinline__ void ld8l(const LAS float* p, float (&f)[8]) { const f32x4 a = *(const LAS f32x4*)p, b = *(const LAS f32x4*)(p + 4); f[0] = a[0]; f[1] = a[1]; f[2] = a[2]; f[3] = a[3]; f[4] = b[0]; f[5] = b[1]; f[6] = b[2]; f[7] = b[3]; }
__device__ __forceinline__ float ex2(float x) { return __builtin_amdgcn_exp2f(x); }
constexpr float LOG2E = 1.4426950408889634f, LN2 = 0.6931471805599453f;

__device__ __forceinline__ void rwkv_unit(int l, int b, int h, LAS unsigned char* L) {
    const int tid = opaque_tid(), lane = tid & 63, fr = lane & 15, fq = lane >> 4; const int w = __builtin_amdgcn_readfirstlane(tid >> 6);
    const Params p = load_params();
    const bf16_t* PA = (const bf16_t*)(p.ws + WS_PA); bf16_t* Yout = (bf16_t*)(p.ws + WS_YS) + (size_t)T * 512;
    const int t = tid >> 3, c8 = (tid & 7) * 8;
    const int tw = (lane >> 3);
    const int cw = 16 * (w & 3);
    const float* mu = p.rwkv_mu + l * 1664;
    LaneOff lo = lane_off(fr, fq);
#define SLOT(s) (L + (s) * TB)
    bf16x8 bup[2];
    { const float* U = ((w < 4) ? p.rwkv_w_up : p.rwkv_a_up) + (size_t)l * 64 * 512 + h * 64 + 16 * (w & 3) + fr;
#pragma unroll
      for (int kk = 0; kk < 2; ++kk) { float f[8];
#pragma unroll
          for (int e = 0; e < 8; ++e) f[e] = U[(size_t)(32 * kk + 8 * fq + e) * 512];
          bup[kk] = __builtin_bit_cast(bf16x8, pack8(f)); } }
    for (int e = tid; e < TB / 4; e += 512) { ((LAS unsigned*)SLOT(S_HT0))[e] = 0u; ((LAS unsigned*)SLOT(S_D))[e] = 0u; ((LAS unsigned*)SLOT(S_MOFF))[e] = 0u; ((LAS unsigned*)SLOT(S_MRB))[e] = 0u;
        ((LAS unsigned*)SLOT(S_ZT))[e] = 0u; ((LAS unsigned*)SLOT(S_ACC))[e] = 0u; }
    f32x4 hacc[4];
#pragma unroll
    for (int i = 0; i < 4; ++i) hacc[i] = (f32x4){0.f, 0.f, 0.f, 0.f};
    int hcur = S_HT0, hnxt = S_HT1;
    u32x4 raw[10];
#define RWKV_LOAD(c, t, c8) do { const size_t row_ = (size_t)b * SEQ + (c) * 64 + (t); const bf16_t* s_ = PA + row_ * NA; const bool hp_ = ((c) * 64 + (t)) > 0; const u32x4 z_ = {0u, 0u, 0u, 0u}; \
        raw[0] = *(const u32x4*)(s_ + RW_R + h * 64 + c8); raw[1] = hp_ ? *(const u32x4*)(s_ - NA + RW_R + h * 64 + c8) : z_; \
        raw[2] = *(const u32x4*)(s_ + RW_K + h * 64 + c8); raw[3] = hp_ ? *(const u32x4*)(s_ - NA + RW_K + h * 64 + c8) : z_; \
        raw[4] = *(const u32x4*)(s_ + RW_V + h * 64 + c8); raw[5] = hp_ ? *(const u32x4*)(s_ - NA + RW_V + h * 64 + c8) : z_; \
        raw[6] = *(const u32x4*)(s_ + RW_LW + c8); raw[7] = hp_ ? *(const u32x4*)(s_ - NA + RW_LW + c8) : z_; \
        raw[8] = *(const u32x4*)(s_ + RW_LA + c8); raw[9] = hp_ ? *(const u32x4*)(s_ - NA + RW_LA + c8) : z_; } while (0)
    for (int e = tid; e < 12 * 64; e += 512) { const int rw_ = e >> 6, i_ = e & 63; const int hci = l * 512 + h * 64 + i_; float val;
        switch (rw_) { case 0: val = mu[h * 64 + i_]; break; case 1: val = mu[512 + h * 64 + i_]; break; case 2: val = mu[1024 + h * 64 + i_]; break; case 3: val = mu[1536 + i_]; break; case 4: val = mu[1600 + i_]; break;
            case 5: val = p.rwkv_w0[hci]; break; case 6: val = p.rwkv_a0[hci]; break; case 7: val = p.rwkv_k_k[hci]; break; case 8: val = p.rwkv_k_a[hci]; break; case 9: val = p.rwkv_r_k[hci]; break;
            case 10: val = p.rwkv_ln_w[hci]; break; default: val = p.rwkv_ln_b[hci]; break; }
        ((LAS float*)(L + O_CST))[e] = val; }
#ifdef V_C
    if (tid < 48) { const int task = tid / 6 + 8 * (tid % 6); u32x4 d = {0u, 0u, 0u, 3u};
        if (task < 36) { int q, mn;
            if (task < 6) { q = 0; mn = (int)((0xEDC984ull >> (4 * task)) & 0xF); }
            else { q = 1 + (task - 6) / 10; mn = (int)((0xFEDCA98540ull >> (4 * ((task - 6) % 10))) & 0xF); }
            const int m0 = 16 * (mn >> 2), n0 = 16 * (mn & 3);
            d.x = (unsigned)(((q < 2) ? S_A : S_R) * TB + m0 * LP * 2); d.y = (unsigned)(((q & 1) ? S_K : S_B) * TB + n0 * LP * 2);
            d.z = (unsigned)(((q == 0) ? S_MOFF : (q == 1) ? S_MAK : (q == 2) ? S_MRB : S_MRK) * TB + (n0 * LP + m0) * 2);
            d.w = (m0 == n0) ? ((q < 2) ? 1u : 2u) : 0u;
        } else { const int z = task - 36; const int mn = (int)((0xB76321ull >> (4 * (z % 6))) & 0xF);
            d.z = (unsigned)(((z < 6) ? S_MAK : S_MRK) * TB + (16 * (mn & 3) * LP + 16 * (mn >> 2)) * 2); }
        *(LAS u32x2*)(L + O_TT + tid * 8) = (u32x2){(d.x >> 4) | ((d.y >> 4) << 16), (d.z >> 4) | (d.w << 16)}; }
#endif
#ifdef LIGHT_BAR
#define LBAR() do { asm volatile("s_waitcnt lgkmcnt(0)" ::: "memory"); __builtin_amdgcn_s_barrier(); asm volatile("" ::: "memory"); } while (0)
#else
#define LBAR() __syncthreads()
#endif
    RWKV_LOAD(0, t, c8);
    __syncthreads();
    for (int c = 0; c < SEQ / 64; ++c) {
        int c8v = c8, tv = t, frv = fr, fqv = fq; asm volatile("" : "+v"(c8v), "+v"(tv), "+v"(frv), "+v"(fqv));
        const int twv = tv & 7;
        float r[8], kraw[8], v[8];
        { float cu[8], pr[8], m8[8], o[8];
#ifdef U_P1
          float m3_[8], m4_[8]; ld8l((const LAS float*)(L + O_CST) + 3 * 64 + c8v, m3_); ld8l((const LAS float*)(L + O_CST) + 4 * 64 + c8v, m4_);
#endif
          unpack8(raw[0], cu); unpack8(raw[1], pr); ld8l((const LAS float*)(L + O_CST) + 0 * 64 + c8v, m8);
#pragma unroll
          for (int e = 0; e < 8; ++e) r[e] = cu[e] + (pr[e] - cu[e]) * m8[e];
          unpack8(raw[2], cu); unpack8(raw[3], pr); ld8l((const LAS float*)(L + O_CST) + 1 * 64 + c8v, m8);
#pragma unroll
          for (int e = 0; e < 8; ++e) kraw[e] = cu[e] + (pr[e] - cu[e]) * m8[e];
          unpack8(raw[4], cu); unpack8(raw[5], pr); ld8l((const LAS float*)(L + O_CST) + 2 * 64 + c8v, m8);
#pragma unroll
          for (int e = 0; e < 8; ++e) v[e] = cu[e] + (pr[e] - cu[e]) * m8[e];
#ifdef V_V
          *(LAS u32x4*)(SLOT(S_V) + (tv * LP + c8v) * 2) = pack8(v);
#endif
#ifdef U_P1
          unpack8(raw[6], cu); unpack8(raw[7], pr);
#pragma unroll
          for (int e = 0; e < 8; ++e) { const float x = cu[e] + (pr[e] - cu[e]) * m3_[e]; o[e] = 1.0f - 2.0f * __builtin_amdgcn_rcpf(ex2(x * (2.0f * LOG2E)) + 1.0f); }
          *(LAS u32x4*)(SLOT(S_A) + (tv * LP + c8v) * 2) = pack8(o);
          unpack8(raw[8], cu); unpack8(raw[9], pr);
#pragma unroll
          for (int e = 0; e < 8; ++e) o[e] = cu[e] + (pr[e] - cu[e]) * m4_[e];
          *(LAS u32x4*)(SLOT(S_B) + (tv * LP + c8v) * 2) = pack8(o); }
#else
          unpack8(raw[6], cu); unpack8(raw[7], pr); ld8l((const LAS float*)(L + O_CST) + 3 * 64 + c8v, m8);
#pragma unroll
          for (int e = 0; e < 8; ++e) { const float x = cu[e] + (pr[e] - cu[e]) * m8[e]; o[e] = 1.0f - 2.0f * __builtin_amdgcn_rcpf(ex2(x * (2.0f * LOG2E)) + 1.0f); }
          *(LAS u32x4*)(SLOT(S_A) + (tv * LP + c8v) * 2) = pack8(o);
          unpack8(raw[8], cu); unpack8(raw[9], pr); ld8l((const LAS float*)(L + O_CST) + 4 * 64 + c8v, m8);
#pragma unroll
          for (int e = 0; e < 8; ++e) o[e] = cu[e] + (pr[e] - cu[e]) * m8[e];
          *(LAS u32x4*)(SLOT(S_B) + (tv * LP + c8v) * 2) = pack8(o); }
#endif
        LBAR();
        relaunder(lo);
#ifdef U_P2
        { const LAS unsigned char* X = (w < 4) ? SLOT(S_A) : SLOT(S_B); LAS float* Z = (LAS float*)(L + ((w < 4) ? O_ZW : O_ZA));
          f32x4 zacc[4];
#pragma unroll
          for (int m = 0; m < 4; ++m) { f32x4 a = {0.f, 0.f, 0.f, 0.f};
#pragma unroll
              for (int kk = 0; kk < 2; ++kk) a = MFMA16(frag_n(X, 16 * m, kk, lo), bup[kk], a);
              zacc[m] = a; }
#pragma unroll
          for (int m = 0; m < 4; ++m)
#pragma unroll
              for (int rr = 0; rr < 4; ++rr) Z[(16 * m + 4 * fqv + rr) * FP + cw + frv] = zacc[m][rr]; }
#else
        { const LAS unsigned char* X = (w < 4) ? SLOT(S_A) : SLOT(S_B); LAS float* Z = (LAS float*)(L + ((w < 4) ? O_ZW : O_ZA));
#pragma unroll
          for (int m = 0; m < 4; ++m) { f32x4 a = {0.f, 0.f, 0.f, 0.f};
#pragma unroll
              for (int kk = 0; kk < 2; ++kk) a = MFMA16(frag_n(X, 16 * m, kk, lo), bup[kk], a);
#pragma unroll
              for (int rr = 0; rr < 4; ++rr) Z[(16 * m + 4 * fqv + rr) * FP + cw + frv] = a[rr]; } }
#endif
        LBAR();
        float kk_[8], kp[8], bb[8], lw[8], cs[8], cb;
        { float zw[8], za[8], c0[8], c1[8];
          ld8l((const LAS float*)(L + O_ZW) + tv * FP + c8v, zw); ld8l((const LAS float*)(L + O_ZA) + tv * FP + c8v, za);
          ld8l((const LAS float*)(L + O_CST) + 5 * 64 + c8v, c0); ld8l((const LAS float*)(L + O_CST) + 6 * 64 + c8v, c1);
          float av[8];
#pragma unroll
#ifdef V_A
          for (int e = 0; e < 8; ++e) { lw[e] = -(LOG2E * 0.6065306597126334f) * __builtin_amdgcn_rcpf(1.0f + ex2(-(zw[e] + c0[e]) * LOG2E));
              av[e] = __builtin_amdgcn_rcpf(1.0f + ex2(-(za[e] + c1[e]) * LOG2E)); }
#else
          for (int e = 0; e < 8; ++e) { const float x = -(zw[e] + c0[e]); const float sp = fmaxf(x, 0.f) + LN2 * __builtin_amdgcn_logf(1.0f + ex2(-fabsf(x) * LOG2E));
              lw[e] = -LOG2E * ex2((-sp - 0.5f) * LOG2E);
              av[e] = __builtin_amdgcn_rcpf(1.0f + ex2(-(za[e] + c1[e]) * LOG2E)); }
#endif
          ld8l((const LAS float*)(L + O_CST) + 7 * 64 + c8v, c0); ld8l((const LAS float*)(L + O_CST) + 8 * 64 + c8v, c1);
          float ss = 0.f;
#pragma unroll
          for (int e = 0; e < 8; ++e) { kk_[e] = kraw[e] * c0[e]; ss += kk_[e] * kk_[e]; kp[e] = kraw[e] * (1.0f + (av[e] - 1.0f) * c1[e]); }
          ss = sum8(ss);
          const float inv = 1.0f / fmaxf(sqrtf(ss), 1e-12f);
          ld8l((const LAS float*)(L + O_CST) + 9 * 64 + c8v, c0);
          float cp = 0.f;
#pragma unroll
          for (int e = 0; e < 8; ++e) { kk_[e] *= inv; bb[e] = kk_[e] * av[e]; cp += r[e] * kp[e] * c0[e]; }
          cb = sum8(cp);
#pragma unroll
          for (int e = 0; e < 8; ++e) { float x = lw[e];
              float y = __shfl_up(x, 8); if (twv >= 1) x += y;
              y = __shfl_up(x, 16); if (twv >= 2) x += y;
              y = __shfl_up(x, 32); if (twv >= 4) x += y;
              cs[e] = x; }
          if (twv == 7) { LAS float* WT = (LAS float*)(L + O_WT) + w * 64 + c8v;
#pragma unroll
              for (int e = 0; e < 8; ++e) WT[e] = cs[e]; } }
        LBAR();
        { float off[8], tot[8];
#pragma unroll
          for (int e = 0; e < 8; ++e) { off[e] = 0.f; tot[e] = 0.f; }
#ifdef V_B
          { int wq = w; asm volatile("" : "+s"(wq));
#pragma unroll
            for (int g = 0; g < 8; ++g) { float x[8]; ld8l((const LAS float*)(L + O_WT) + g * 64 + c8v, x); const float mk = (g < wq) ? 1.0f : 0.0f;
#pragma unroll
                for (int e = 0; e < 8; ++e) { off[e] = __builtin_fmaf(x[e], mk, off[e]); tot[e] += x[e]; }
                if (g & 1) __builtin_amdgcn_sched_barrier(0); } }
#else
#pragma unroll
          for (int g = 0; g < 8; ++g) { float x[8]; ld8l((const LAS float*)(L + O_WT) + g * 64 + c8v, x);
#pragma unroll
              for (int e = 0; e < 8; ++e) { if (g < w) off[e] += x[e]; tot[e] += x[e]; } }
#endif
          if (tv == 0) { LAS float* CL = (LAS float*)(L + O_CL) + c8v;
#pragma unroll
              for (int e = 0; e < 8; ++e) CL[e] = tot[e]; }
          float o[8], en[8], ep[8]; const int toff = (tv * LP + c8v) * 2;
#pragma unroll
          for (int e = 0; e < 8; ++e) { cs[e] += off[e]; en[e] = ex2(-cs[e]); ep[e] = __builtin_amdgcn_rcpf(en[e]); o[e] = -kk_[e] * ep[e] * ex2(-lw[e]); }
          *(LAS u32x4*)(SLOT(S_A) + toff) = pack8(o);
#pragma unroll
          for (int e = 0; e < 8; ++e) o[e] = bb[e] * en[e];
          *(LAS u32x4*)(SLOT(S_B) + toff) = pack8(o);
#pragma unroll
          for (int e = 0; e < 8; ++e) o[e] = kp[e] * en[e];
          *(LAS u32x4*)(SLOT(S_K) + toff) = pack8(o);
#pragma unroll
          for (int e = 0; e < 8; ++e) o[e] = r[e] * ep[e];
          *(LAS u32x4*)(SLOT(S_R) + toff) = pack8(o);
#pragma unroll
          for (int e = 0; e < 8; ++e) { en[e] = ex2(tot[e] - cs[e]); o[e] = bb[e] * en[e]; }
          *(LAS u32x4*)(SLOT(S_BT) + toff) = pack8(o);
#pragma unroll
          for (int e = 0; e < 8; ++e) o[e] = kp[e] * en[e];
          *(LAS u32x4*)(SLOT(S_KT) + toff) = pack8(o);
#ifndef V_V
          *(LAS u32x4*)(SLOT(S_V) + toff) = pack8(v);
#endif
        }
        LBAR();
        relaunder(lo);
#ifdef NO_WV_LAUNDER
        const int wv = w;
#else
        int wv = w; asm volatile("" : "+s"(wv));
#endif
#if defined(LOAD_AT) && LOAD_AT == 4
        if (c + 1 < SEQ / 64) RWKV_LOAD(c + 1, tv, c8v);
#endif
#ifdef U_P4
        f32x4 tacc[5];
#ifdef U_P4B
        bf16x8 da_[2], db_[2];
#define P4_DECODE(task) int q, mn; if ((task) < 6) { q = 0; mn = (int)((0xEDC984ull >> (4 * (task))) & 0xF); } else { q = 1 + ((task) - 6) / 10; mn = (int)((0xFEDCA98540ull >> (4 * (((task) - 6) % 10))) & 0xF); } \
            const int m0 = 16 * (mn >> 2), n0 = 16 * (mn & 3); const LAS unsigned char* XA = (q < 2) ? SLOT(S_A) : SLOT(S_R); const LAS unsigned char* XB = (q & 1) ? SLOT(S_K) : SLOT(S_B); (void)XA; (void)XB
#pragma unroll
        for (int bt_ = 0; bt_ < 2; ++bt_) {
            bf16x8 fa_[3][2], fb_[3][2];
#pragma unroll
            for (int j = 0; j < 3; ++j) { const int it = (3 * bt_ + j < 5) ? 3 * bt_ + j : 4; const int task_ = wv + 8 * it; const int task = task_ < 36 ? task_ : 35;
                { P4_DECODE(task);
#pragma unroll
                    for (int kk = 0; kk < 2; ++kk) { fa_[j][kk] = frag_n(XA, m0, kk, lo); fb_[j][kk] = frag_n(XB, n0, kk, lo); } } }
            if (bt_ == 0) { const int wd = wv & 3;
#pragma unroll
                for (int kk = 0; kk < 2; ++kk) { da_[kk] = frag_n(SLOT(S_A), 16 * wd, kk, lo); db_[kk] = frag_n(SLOT(S_B), 16 * wd, kk, lo); } }
            __builtin_amdgcn_sched_barrier(0); asm volatile("s_waitcnt lgkmcnt(0)" ::: "memory"); __builtin_amdgcn_sched_barrier(0);
#pragma unroll
            for (int j = 0; j < 3; ++j) { const int it = 3 * bt_ + j; if (it < 5) { const int task = wv + 8 * it; f32x4 a = {0.f, 0.f, 0.f, 0.f};
                if (task < 36) { P4_DECODE(task);
#pragma unroll
                    for (int kk = 0; kk < 2; ++kk) a = MFMA16(fa_[j][kk], fb_[j][kk], a);
                    if (m0 == n0) {
#pragma unroll
                        for (int rr = 0; rr < 4; ++rr) { const bool keep = (q < 2) ? (frv < 4 * fqv + rr) : (frv <= 4 * fqv + rr); a[rr] = keep ? a[rr] : 0.f; } } }
                tacc[it] = a; } }
        }
#undef P4_DECODE
        if (wv < 4) {
            f32x4 a = {0.f, 0.f, 0.f, 0.f};
#pragma unroll
            for (int kk = 0; kk < 2; ++kk) a = MFMA16(da_[kk], db_[kk], a);
#else
#pragma unroll
        for (int it = 0; it < 5; ++it) { const int task = wv + 8 * it; f32x4 a = {0.f, 0.f, 0.f, 0.f};
            if (task < 36) {
                int q, mn;
                if (task < 6) { q = 0; mn = (int)((0xEDC984ull >> (4 * task)) & 0xF); }
                else { q = 1 + (task - 6) / 10; mn = (int)((0xFEDCA98540ull >> (4 * ((task - 6) % 10))) & 0xF); }
                const int m0 = 16 * (mn >> 2), n0 = 16 * (mn & 3);
                const LAS unsigned char* XA = (q < 2) ? SLOT(S_A) : SLOT(S_R); const LAS unsigned char* XB = (q & 1) ? SLOT(S_K) : SLOT(S_B);
#pragma unroll
                for (int kk = 0; kk < 2; ++kk) a = MFMA16(frag_n(XA, m0, kk, lo), frag_n(XB, n0, kk, lo), a);
                if (m0 == n0) {
#pragma unroll
                    for (int rr = 0; rr < 4; ++rr) { const bool keep = (q < 2) ? (frv < 4 * fqv + rr) : (frv <= 4 * fqv + rr); a[rr] = keep ? a[rr] : 0.f; } } }
            tacc[it] = a; }
        if (wv < 4) {
            f32x4 a = {0.f, 0.f, 0.f, 0.f};
#pragma unroll
            for (int kk = 0; kk < 2; ++kk) a = MFMA16(frag_n(SLOT(S_A), 16 * wv, kk, lo), frag_n(SLOT(S_B), 16 * wv, kk, lo), a);
#endif
#pragma unroll
            for (int rr = 0; rr < 4; ++rr) a[rr] = (frv < 4 * fqv + rr) ? a[rr] : 0.f;
            float x[16];
            { LAS float* NS = (LAS float*)(SLOT(hnxt) + wv * 1024);
#pragma unroll
              for (int rr = 0; rr < 4; ++rr) NS[(4 * fqv + rr) * 16 + frv] = a[rr];
              asm volatile("s_waitcnt lgkmcnt(0)" ::: "memory");
#pragma unroll
              for (int rw = 0; rw < 16; ++rw) { float s = (rw == frv) ? 1.f : 0.f;
#pragma unroll
                  for (int sc = 0; sc < rw; ++sc) s = __builtin_fmaf(NS[rw * 16 + sc], x[sc], s);
                  x[rw] = s; }
              asm volatile("s_waitcnt lgkmcnt(0)" ::: "memory"); }
            if (fqv == 0) { LAS unsigned char* dp = SLOT(S_D) + ((16 * wv + frv) * LP + 16 * wv) * 2;
                float lo8[8], hi8[8];
#pragma unroll
                for (int e = 0; e < 8; ++e) { lo8[e] = x[e]; hi8[e] = x[8 + e]; }
                *(LAS u32x4*)dp = pack8(lo8); *(LAS u32x4*)(dp + 16) = pack8(hi8); }
        }
#pragma unroll
        for (int it = 0; it < 6; ++it) { const int task = wv + 8 * it;
            if (task < 36) {
                int q, mn;
                if (task < 6) { q = 0; mn = (int)((0xEDC984ull >> (4 * task)) & 0xF); }
                else { q = 1 + (task - 6) / 10; mn = (int)((0xFEDCA98540ull >> (4 * ((task - 6) % 10))) & 0xF); }
                st_tile_T(SLOT((q == 0) ? S_MOFF : (q == 1) ? S_MAK : (q == 2) ? S_MRB : S_MRK), 16 * (mn >> 2), 16 * (mn & 3), lo, tacc[it < 5 ? it : 4]);
            } else if (task < 48) {
                const int z = task - 36; const int mn = (int)((0xB76321ull >> (4 * (z % 6))) & 0xF);
                st_tile_T(SLOT((z < 6) ? S_MAK : S_MRK), 16 * (mn >> 2), 16 * (mn & 3), lo, (f32x4){0.f, 0.f, 0.f, 0.f});
            } }
#else
#ifdef V_C
        u32x4 dq[3];
#pragma unroll
        for (int j = 0; j < 3; ++j) dq[j] = *(const LAS u32x4*)(L + O_TT + wv * 48 + j * 16);
#endif
        if (wv < 4) {
            f32x4 a = {0.f, 0.f, 0.f, 0.f};
#pragma unroll
            for (int kk = 0; kk < 2; ++kk) a = MFMA16(frag_n(SLOT(S_A), 16 * wv, kk, lo), frag_n(SLOT(S_B), 16 * wv, kk, lo), a);
#pragma unroll
            for (int rr = 0; rr < 4; ++rr) a[rr] = (frv < 4 * fqv + rr) ? a[rr] : 0.f;
            float x[16];
            { LAS float* NS = (LAS float*)(SLOT(hnxt) + wv * 1024);
#pragma unroll
              for (int rr = 0; rr < 4; ++rr) NS[(4 * fqv + rr) * 16 + frv] = a[rr];
              asm volatile("s_waitcnt lgkmcnt(0)" ::: "memory");
#pragma unroll
              for (int rw = 0; rw < 16; ++rw) { float s = (rw == frv) ? 1.f : 0.f;
#pragma unroll
                  for (int sc = 0; sc < rw; ++sc) s = __builtin_fmaf(NS[rw * 16 + sc], x[sc], s);
                  x[rw] = s; }
              asm volatile("s_waitcnt lgkmcnt(0)" ::: "memory"); }
            if (fqv == 0) { LAS unsigned char* dp = SLOT(S_D) + ((16 * wv + frv) * LP + 16 * wv) * 2;
                float lo8[8], hi8[8];
#pragma unroll
                for (int e = 0; e < 8; ++e) { lo8[e] = x[e]; hi8[e] = x[8 + e]; }
                *(LAS u32x4*)dp = pack8(lo8); *(LAS u32x4*)(dp + 16) = pack8(hi8); }
        }
#ifdef V_C
        {
#pragma unroll
          for (int it = 0; it < 6; ++it) {
            const unsigned e0 = (unsigned)__builtin_amdgcn_readfirstlane((int)((it & 1) ? dq[it >> 1].z : dq[it >> 1].x)), e1 = (unsigned)__builtin_amdgcn_readfirstlane((int)((it & 1) ? dq[it >> 1].w : dq[it >> 1].y));
            const int mode = (int)(e1 >> 16); LAS unsigned char* dst = L + ((e1 & 0xffffu) << 4) + lo.bs;
            if (mode < 3) {
                const LAS unsigned char* pa = L + ((e0 & 0xffffu) << 4) + lo.bn; const LAS unsigned char* pb = L + ((e0 >> 16) << 4) + lo.bn;
                f32x4 a = MFMA16(*(const LAS bf16x8*)pa, *(const LAS bf16x8*)pb, (f32x4){0.f, 0.f, 0.f, 0.f});
                a = MFMA16(*(const LAS bf16x8*)(pa + 64), *(const LAS bf16x8*)(pb + 64), a);
                if (mode) { const int thr = frv + ((mode == 1) ? 1 : 0);
#pragma unroll
                    for (int rr = 0; rr < 4; ++rr) a[rr] = (thr <= 4 * fqv + rr) ? a[rr] : 0.f; }
                u32x2 wq_; wq_.x = pk2(a[0], a[1]); wq_.y = pk2(a[2], a[3]); *(LAS u32x2*)dst = wq_;
            } else { *(LAS u32x2*)dst = (u32x2){0u, 0u}; } } }
#else
#pragma unroll
        for (int it = 0; it < 6; ++it) { const int task = wv + 8 * it;
            if (task < 36) {
                int q, mn;
                if (task < 6) { q = 0; mn = (int)((0xEDC984ull >> (4 * task)) & 0xF); }
                else { q = 1 + (task - 6) / 10; mn = (int)((0xFEDCA98540ull >> (4 * ((task - 6) % 10))) & 0xF); }
                const int m0 = 16 * (mn >> 2), n0 = 16 * (mn & 3);
                const LAS unsigned char* XA = (q < 2) ? SLOT(S_A) : SLOT(S_R); const LAS unsigned char* XB = (q & 1) ? SLOT(S_K) : SLOT(S_B);
                f32x4 a = {0.f, 0.f, 0.f, 0.f};
#pragma unroll
                for (int kk = 0; kk < 2; ++kk) a = MFMA16(frag_n(XA, m0, kk, lo), frag_n(XB, n0, kk, lo), a);
                if (m0 == n0) {
#pragma unroll
                    for (int rr = 0; rr < 4; ++rr) { const bool keep = (q < 2) ? (frv < 4 * fqv + rr) : (frv <= 4 * fqv + rr); a[rr] = keep ? a[rr] : 0.f; } }
                st_tile_T(SLOT((q == 0) ? S_MOFF : (q == 1) ? S_MAK : (q == 2) ? S_MRB : S_MRK), m0, n0, lo, a);
            } else if (task < 48) {
                const int z = task - 36; const int mn = (int)((0xB76321ull >> (4 * (z % 6))) & 0xF);
                st_tile_T(SLOT((z < 6) ? S_MAK : S_MRK), 16 * (mn >> 2), 16 * (mn & 3), lo, (f32x4){0.f, 0.f, 0.f, 0.f});
            } }
#endif
#endif
        LBAR();
        relaunder(lo);
#if defined(LOAD_AT) && LOAD_AT == 5
        if (c + 1 < SEQ / 64) RWKV_LOAD(c + 1, tv, c8v);
#endif
        f32x4 yacc[4];
#ifdef U_P5
        if (w < 4) {
            f32x4 xr[4];
#ifdef U_P5C
            { bf16x8 mk[4][2], af[4][2], vf[2], hf[2];
#pragma unroll
              for (int kk = 0; kk < 2; ++kk) { vf[kk] = frag_t(SLOT(S_V), kk, cw, lo); hf[kk] = frag_n(SLOT(hcur), cw, kk, lo); }
#pragma unroll
              for (int i = 0; i < 4; ++i)
#pragma unroll
                  for (int kk = 0; kk < 2; ++kk) { if (32 * kk < 16 * i + 16) mk[i][kk] = frag_t(SLOT(S_MAK), kk, 16 * i, lo); af[i][kk] = frag_n(SLOT(S_A), 16 * i, kk, lo); }
              __builtin_amdgcn_sched_barrier(0); asm volatile("s_waitcnt lgkmcnt(0)" ::: "memory"); __builtin_amdgcn_sched_barrier(0);
#pragma unroll
              for (int i = 0; i < 4; ++i) { f32x4 a = {0.f, 0.f, 0.f, 0.f};
#pragma unroll
                  for (int kk = 0; kk < 2; ++kk) { if (32 * kk < 16 * i + 16) a = MFMA16(mk[i][kk], vf[kk], a); a = MFMA16(af[i][kk], hf[kk], a); }
                  xr[i] = a; } }
#else
#pragma unroll
            for (int i = 0; i < 4; ++i) { f32x4 a = {0.f, 0.f, 0.f, 0.f};
#pragma unroll
                for (int kk = 0; kk < 2; ++kk) { if (32 * kk < 16 * i + 16) a = MFMA16(frag_t(SLOT(S_MAK), kk, 16 * i, lo), frag_t(SLOT(S_V), kk, cw, lo), a);
                    a = MFMA16(frag_n(SLOT(S_A), 16 * i, kk, lo), frag_n(SLOT(hcur), cw, kk, lo), a); }
                xr[i] = a; }
#endif
#pragma unroll
            for (int i = 0; i < 4; ++i) { f32x4 a = xr[i];
#pragma unroll
                for (int kk = 0; kk < 2; ++kk) if (32 * kk < 16 * i) a = MFMA16(frag_t(SLOT(S_MOFF), kk, 16 * i, lo), frag_n(SLOT(S_ZT), cw, kk, lo), a);
                st_tile_T(SLOT(S_ACC), 16 * i, cw, lo, a);
                asm volatile("" ::: "memory");
                const f32x4 z = MFMA16(frag_t(SLOT(S_D), i >> 1, 16 * i, lo), frag_n(SLOT(S_ACC), cw, i >> 1, lo), (f32x4){0.f, 0.f, 0.f, 0.f});
                st_tile_T(SLOT(S_ZT), 16 * i, cw, lo, z);
                asm volatile("" ::: "memory"); }
#else
        if (w < 4) {
#pragma unroll
            for (int i = 0; i < 4; ++i) { f32x4 a = {0.f, 0.f, 0.f, 0.f};
#pragma unroll
                for (int kk = 0; kk < 2; ++kk) { if (32 * kk < 16 * i + 16) a = MFMA16(frag_t(SLOT(S_MAK), kk, 16 * i, lo), frag_t(SLOT(S_V), kk, cw, lo), a);
                    a = MFMA16(frag_n(SLOT(S_A), 16 * i, kk, lo), frag_n(SLOT(hcur), cw, kk, lo), a); }
#pragma unroll
                for (int kk = 0; kk < 2; ++kk) if (32 * kk < 16 * i) a = MFMA16(frag_t(SLOT(S_MOFF), kk, 16 * i, lo), frag_n(SLOT(S_ZT), cw, kk, lo), a);
                st_tile_T(SLOT(S_ACC), 16 * i, cw, lo, a);
                const f32x4 z = MFMA16(frag_t(SLOT(S_D), i >> 1, 16 * i, lo), frag_n(SLOT(S_ACC), cw, i >> 1, lo), (f32x4){0.f, 0.f, 0.f, 0.f});
                st_tile_T(SLOT(S_ZT), 16 * i, cw, lo, z); }
#endif
        } else {
#ifdef U_P5C
            { bf16x8 mk[4][2], af[4][2], vf[2], hf[2];
#pragma unroll
              for (int kk = 0; kk < 2; ++kk) { vf[kk] = frag_t(SLOT(S_V), kk, cw, lo); hf[kk] = frag_n(SLOT(hcur), cw, kk, lo); }
#pragma unroll
              for (int i = 0; i < 4; ++i)
#pragma unroll
                  for (int kk = 0; kk < 2; ++kk) { if (32 * kk < 16 * i + 16) mk[i][kk] = frag_t(SLOT(S_MRK), kk, 16 * i, lo); af[i][kk] = frag_n(SLOT(S_R), 16 * i, kk, lo); }
              __builtin_amdgcn_sched_barrier(0); asm volatile("s_waitcnt lgkmcnt(0)" ::: "memory"); __builtin_amdgcn_sched_barrier(0);
#pragma unroll
              for (int i = 0; i < 4; ++i) { f32x4 a = {0.f, 0.f, 0.f, 0.f};
#pragma unroll
                  for (int kk = 0; kk < 2; ++kk) { if (32 * kk < 16 * i + 16) a = MFMA16(mk[i][kk], vf[kk], a); a = MFMA16(af[i][kk], hf[kk], a); }
                  yacc[i] = a; } }
#else
#pragma unroll
            for (int i = 0; i < 4; ++i) { f32x4 a = {0.f, 0.f, 0.f, 0.f};
#pragma unroll
                for (int kk = 0; kk < 2; ++kk) { if (32 * kk < 16 * i + 16) a = MFMA16(frag_t(SLOT(S_MRK), kk, 16 * i, lo), frag_t(SLOT(S_V), kk, cw, lo), a);
                    a = MFMA16(frag_n(SLOT(S_R), 16 * i, kk, lo), frag_n(SLOT(hcur), cw, kk, lo), a);
                }
                yacc[i] = a; }
#endif
#ifdef SPLIT_PF
            if (c + 1 < SEQ / 64) RWKV_LOAD(c + 1, tv, c8v);
#endif
        }
        LBAR();
        relaunder(lo);
#if defined(SPLIT_PF)
        if (w < 4 && c + 1 < SEQ / 64) RWKV_LOAD(c + 1, tv, c8v);
#elif !defined(LOAD_AT)
        if (c + 1 < SEQ / 64) RWKV_LOAD(c + 1, tv, c8v);
#endif
#ifdef U_P7B
        if (w >= 4) {
            f32x4 dec[4]; bf16x8 vfr[2], zfr[2];
#pragma unroll
            for (int i = 0; i < 4; ++i) dec[i] = *(const LAS f32x4*)((const LAS float*)(L + O_CL) + 16 * i + 4 * fqv);
#pragma unroll
            for (int kk = 0; kk < 2; ++kk) { vfr[kk] = frag_t(SLOT(S_V), kk, cw, lo); zfr[kk] = frag_n(SLOT(S_ZT), cw, kk, lo); }
#pragma unroll
            for (int hh = 0; hh < 2; ++hh) {
                bf16x8 kt[2][2], bt[2][2], mr[2][2];
#pragma unroll
                for (int j = 0; j < 2; ++j)
#pragma unroll
                    for (int kk = 0; kk < 2; ++kk) { const int i = 2 * hh + j; kt[j][kk] = frag_t(SLOT(S_KT), kk, 16 * i, lo); bt[j][kk] = frag_t(SLOT(S_BT), kk, 16 * i, lo);
                        if (32 * kk < 16 * i + 16) mr[j][kk] = frag_t(SLOT(S_MRB), kk, 16 * i, lo); }
                __builtin_amdgcn_sched_barrier(0); asm volatile("s_waitcnt lgkmcnt(0)" ::: "memory"); __builtin_amdgcn_sched_barrier(0);
#pragma unroll
                for (int j = 0; j < 2; ++j) { const int i = 2 * hh + j;
#pragma unroll
                    for (int rr = 0; rr < 4; ++rr) hacc[i][rr] = hacc[i][rr] * ex2(dec[i][rr]);
#pragma unroll
                    for (int kk = 0; kk < 2; ++kk) { hacc[i] = MFMA16(kt[j][kk], vfr[kk], hacc[i]); hacc[i] = MFMA16(bt[j][kk], zfr[kk], hacc[i]); }
#pragma unroll
                    for (int kk = 0; kk < 2; ++kk) if (32 * kk < 16 * i + 16) yacc[i] = MFMA16(mr[j][kk], zfr[kk], yacc[i]); }
            }
#pragma unroll
            for (int i = 0; i < 4; ++i) { st_tile_T(SLOT(hnxt), 16 * i, cw, lo, hacc[i]);
#pragma unroll
                for (int rr = 0; rr < 4; ++rr) ((LAS float*)(L + O_YB))[(16 * i + 4 * fqv + rr) * FP + cw + frv] = yacc[i][rr]; }
        }
#elif defined(U_P7)
        if (w >= 4) {
#pragma unroll
            for (int i = 0; i < 4; ++i) {
#pragma unroll
                for (int rr = 0; rr < 4; ++rr) hacc[i][rr] = hacc[i][rr] * ex2(((const LAS float*)(L + O_CL))[16 * i + 4 * fqv + rr]);
#pragma unroll
                for (int kk = 0; kk < 2; ++kk) { hacc[i] = MFMA16(frag_t(SLOT(S_KT), kk, 16 * i, lo), frag_t(SLOT(S_V), kk, cw, lo), hacc[i]);
                    hacc[i] = MFMA16(frag_t(SLOT(S_BT), kk, 16 * i, lo), frag_n(SLOT(S_ZT), cw, kk, lo), hacc[i]); }
#pragma unroll
                for (int kk = 0; kk < 2; ++kk) if (32 * kk < 16 * i + 16) yacc[i] = MFMA16(frag_t(SLOT(S_MRB), kk, 16 * i, lo), frag_n(SLOT(S_ZT), cw, kk, lo), yacc[i]); }
#pragma unroll
            for (int i = 0; i < 4; ++i) { st_tile_T(SLOT(hnxt), 16 * i, cw, lo, hacc[i]);
#pragma unroll
                for (int rr = 0; rr < 4; ++rr) ((LAS float*)(L + O_YB))[(16 * i + 4 * fqv + rr) * FP + cw + frv] = yacc[i][rr]; }
        }
#else
        if (w >= 4) {
#pragma unroll
            for (int i = 0; i < 4; ++i) {
#pragma unroll
                for (int rr = 0; rr < 4; ++rr) hacc[i][rr] = hacc[i][rr] * ex2(((const LAS float*)(L + O_CL))[16 * i + 4 * fqv + rr]);
#pragma unroll
                for (int kk = 0; kk < 2; ++kk) { hacc[i] = MFMA16(frag_t(SLOT(S_KT), kk, 16 * i, lo), frag_t(SLOT(S_V), kk, cw, lo), hacc[i]);
                    hacc[i] = MFMA16(frag_t(SLOT(S_BT), kk, 16 * i, lo), frag_n(SLOT(S_ZT), cw, kk, lo), hacc[i]); }
                st_tile_T(SLOT(hnxt), 16 * i, cw, lo, hacc[i]);
#pragma unroll
                for (int kk = 0; kk < 2; ++kk) if (32 * kk < 16 * i + 16) yacc[i] = MFMA16(frag_t(SLOT(S_MRB), kk, 16 * i, lo), frag_n(SLOT(S_ZT), cw, kk, lo), yacc[i]);
#pragma unroll
                for (int rr = 0; rr < 4; ++rr) ((LAS float*)(L + O_YB))[(16 * i + 4 * fqv + rr) * FP + cw + frv] = yacc[i][rr]; }
        }
#endif
        LBAR();
        { float y[8], g0[8], g1[8]; ld8l((const LAS float*)(L + O_YB) + tv * FP + c8v, y); ld8l((const LAS float*)(L + O_CST) + 10 * 64 + c8v, g0); ld8l((const LAS float*)(L + O_CST) + 11 * 64 + c8v, g1);
          float s = 0.f;
#pragma unroll
          for (int e = 0; e < 8; ++e) s += y[e];
          const float mean = sum8(s) * (1.f / 64.f); float q = 0.f;
#pragma unroll
          for (int e = 0; e < 8; ++e) { y[e] -= mean; q += y[e] * y[e]; }
          const float rs = rsqrtf(sum8(q) * (1.f / 64.f) + RWKV_GN_EPS);
#ifdef V_V
          float vv[8]; unpack8(*(const LAS u32x4*)(SLOT(S_V) + (tv * LP + c8v) * 2), vv);
#pragma unroll
          for (int e = 0; e < 8; ++e) y[e] = y[e] * rs * g0[e] + g1[e] + cb * vv[e];
#else
#pragma unroll
          for (int e = 0; e < 8; ++e) y[e] = y[e] * rs * g0[e] + g1[e] + cb * v[e];
#endif
          *(u32x4*)(Yout + ((size_t)b * SEQ + c * 64 + tv) * 512 + h * 64 + c8v) = pack8(y); }
        { const int tmp = hcur; hcur = hnxt; hnxt = tmp; }
    }
    __syncthreads();
#undef LBAR
#undef SLOT
#undef RWKV_LOAD
}
}

namespace gla {
using rwkv::vtr; using rwkv::unpack8; using rwkv::pack8; using rwkv::ld8l; using rwkv::ex2; using rwkv::LOG2E; using rwkv::LN2; using rwkv::MFMA16;
constexpr int LP = 72, VP = 136, TB = 64 * LP * 2;
constexpr int B_QH = 0, B_KH = TB, B_KT = 2 * TB, B_PT = 3 * TB, B_VV = 4 * TB, B_ST = B_VV + 64 * VP * 2, B_OB = B_ST + 128 * LP * 2, B_WT = B_OB + 64 * 132 * 4,
              B_CL = B_WT + 8 * 64 * 4, B_AUP = B_CL + 64 * 4, B_AB = B_AUP + 16 * 64 * 4, B_GN = B_AB + 64 * 4, B_END = B_GN + 128 * 4;
static_assert(B_END <= 131072, "gla lds");
struct LaneOff { int bn, bt, btv, bs; };
__device__ __forceinline__ LaneOff lane_off(int fr, int fq) { LaneOff o; o.bn = (fr * LP + 8 * fq) * 2; o.bt = ((8 * fq + (fr >> 2)) * LP + 4 * (fr & 3)) * 2; o.btv = ((8 * fq + (fr >> 2)) * VP + 4 * (fr & 3)) * 2; o.bs = (fr * LP + 4 * fq) * 2; return o; }
__device__ __forceinline__ void relaunder(LaneOff& o) { asm volatile("" : "+v"(o.bn), "+v"(o.bt), "+v"(o.btv), "+v"(o.bs)); }
__device__ __forceinline__ bf16x8 frag_t(const LAS unsigned char* tile, int kk, int c0, const LaneOff& o) {
    const LAS unsigned char* q = tile + o.bt + (32 * kk * LP + c0) * 2; const s16x4 lo = vtr(q), hi = vtr(q + 4 * LP * 2); return (bf16x8){lo[0], lo[1], lo[2], lo[3], hi[0], hi[1], hi[2], hi[3]}; }
__device__ __forceinline__ bf16x8 frag_tv(const LAS unsigned char* tile, int kk, int c0, const LaneOff& o) {
    const LAS unsigned char* q = tile + o.btv + (32 * kk * VP + c0) * 2; const s16x4 lo = vtr(q), hi = vtr(q + 4 * VP * 2); return (bf16x8){lo[0], lo[1], lo[2], lo[3], hi[0], hi[1], hi[2], hi[3]}; }
__device__ __forceinline__ bf16x8 frag_n(const LAS unsigned char* tile, int r0, int kk, const LaneOff& o) { return *(const LAS bf16x8*)(tile + o.bn + (r0 * LP + 32 * kk) * 2); }
__device__ __forceinline__ void st_tile_T(LAS unsigned char* tile, int m0, int n0, const LaneOff& o, const f32x4 c) { u32x2 w; w.x = pk2(c[0], c[1]); w.y = pk2(c[2], c[3]); *(LAS u32x2*)(tile + o.bs + (n0 * LP + m0) * 2) = w; }

__device__ __forceinline__ void gla_unit(int l, int b, int h, LAS unsigned char* L, unsigned* done_ctr) {
    const Params p = load_params();
    const bf16_t* PA = (const bf16_t*)(p.ws + WS_PA); bf16_t* Yout = (bf16_t*)(p.ws + WS_YS) + (size_t)2 * T * 512;
    const int tid = opaque_tid(), lane = tid & 63, fr = lane & 15, fq = lane >> 4; const int w = __builtin_amdgcn_readfirstlane(tid >> 6);
    const int t = tid >> 3, c8 = (tid & 7) * 8;
    LaneOff lo = lane_off(fr, fq);
    for (int e = tid; e < 16 * 64; e += 512) ((LAS float*)(L + B_AUP))[e] = p.gla_a_up[(size_t)l * 16 * 256 + (e >> 6) * 256 + h * 64 + (e & 63)];
    if (tid < 64) ((LAS float*)(L + B_AB))[tid] = p.gla_a_b[l * 256 + h * 64 + tid];
    if (tid < 128) ((LAS float*)(L + B_GN))[tid] = p.gla_norm[l * 512 + h * 128 + tid];
    for (int e = tid; e < 128 * LP / 2; e += 512) ((LAS unsigned*)(L + B_ST))[e] = 0u;
    for (int e = tid; e < TB / 4; e += 512) ((LAS unsigned*)(L + B_PT))[e] = 0u;
    f32x4 sacc[4];
#pragma unroll
    for (int m = 0; m < 4; ++m) sacc[m] = (f32x4){0.f, 0.f, 0.f, 0.f};
    u32x4 rq, rk, rv0, rv1, rl0, rl1;
#define GLA_LOAD(c) do { const bf16_t* s_ = PA + ((size_t)b * SEQ + (c) * 64 + t) * NA; rq = *(const u32x4*)(s_ + GQ + h * 64 + c8); rk = *(const u32x4*)(s_ + GK + h * 64 + c8); \
        rv0 = *(const u32x4*)(s_ + GV + h * 128 + 2 * c8); rv1 = *(const u32x4*)(s_ + GV + h * 128 + 2 * c8 + 8); rl0 = *(const u32x4*)(s_ + GLAT); rl1 = *(const u32x4*)(s_ + GLAT + 8); } while (0)
    GLA_LOAD(0);
    __syncthreads();
    for (int c = 0; c < SEQ / 64; ++c) {
        int c8v = c8, tv = t, frv = fr, fqv = fq; asm volatile("" : "+v"(c8v), "+v"(tv), "+v"(frv), "+v"(fqv));
        const int twv = tv & 7;
        float cs[8];
        { float lat[16]; { float a8[8]; unpack8(rl0, a8);
#pragma unroll
              for (int j = 0; j < 8; ++j) lat[j] = a8[j];
              unpack8(rl1, a8);
#pragma unroll
              for (int j = 0; j < 8; ++j) lat[8 + j] = a8[j]; }
          float z[8]; ld8l((const LAS float*)(L + B_AB) + c8v, z);
#pragma unroll
          for (int j = 0; j < 16; ++j) { float a8[8]; ld8l((const LAS float*)(L + B_AUP) + j * 64 + c8v, a8);
#pragma unroll
              for (int e = 0; e < 8; ++e) z[e] += lat[j] * a8[e]; }
#pragma unroll
          for (int e = 0; e < 8; ++e) { const float x = -z[e]; const float sp = fmaxf(x, 0.f) + LN2 * __builtin_amdgcn_logf(1.0f + ex2(-fabsf(x) * LOG2E));
              float v_ = -sp * (LOG2E / 16.0f);
              float y = __shfl_up(v_, 8); if (twv >= 1) v_ += y;
              y = __shfl_up(v_, 16); if (twv >= 2) v_ += y;
              y = __shfl_up(v_, 32); if (twv >= 4) v_ += y;
              cs[e] = v_; }
          if (twv == 7) { LAS float* WT = (LAS float*)(L + B_WT) + w * 64 + c8v;
#pragma unroll
              for (int e = 0; e < 8; ++e) WT[e] = cs[e]; } }
        __syncthreads();
        { float off[8], tot[8];
#pragma unroll
          for (int e = 0; e < 8; ++e) { off[e] = 0.f; tot[e] = 0.f; }
#pragma unroll
          for (int g = 0; g < 8; ++g) { float x[8]; ld8l((const LAS float*)(L + B_WT) + g * 64 + c8v, x);
#pragma unroll
              for (int e = 0; e < 8; ++e) { if (g < w) off[e] += x[e]; tot[e] += x[e]; } }
          if (tv == 0) { LAS float* CL = (LAS float*)(L + B_CL) + c8v;
#pragma unroll
              for (int e = 0; e < 8; ++e) CL[e] = tot[e]; }
          float q8[8], k8[8], o[8], en[8]; unpack8(rq, q8); unpack8(rk, k8); const int toff = (tv * LP + c8v) * 2;
#pragma unroll
          for (int e = 0; e < 8; ++e) { cs[e] += off[e]; en[e] = ex2(-cs[e]); o[e] = q8[e] * 0.125f * __builtin_amdgcn_rcpf(en[e]); }
          *(LAS u32x4*)(L + B_QH + toff) = pack8(o);
#pragma unroll
          for (int e = 0; e < 8; ++e) o[e] = k8[e] * en[e];
          *(LAS u32x4*)(L + B_KH + toff) = pack8(o);
#pragma unroll
          for (int e = 0; e < 8; ++e) o[e] = k8[e] * ex2(tot[e] - cs[e]);
          *(LAS u32x4*)(L + B_KT + toff) = pack8(o);
          *(LAS u32x4*)(L + B_VV + (tv * VP + 2 * c8v) * 2) = rv0; *(LAS u32x4*)(L + B_VV + (tv * VP + 2 * c8v + 8) * 2) = rv1; }
        if (c + 1 < SEQ / 64) GLA_LOAD(c + 1);
        __syncthreads();
        relaunder(lo);
        { const int m0 = 16 * (w >> 1);
#pragma unroll
          for (int nn = 0; nn < 2; ++nn) { const int n0 = 32 * (w & 1) + 16 * nn;
              if (n0 <= m0) { f32x4 a = {0.f, 0.f, 0.f, 0.f};
#pragma unroll
                  for (int kk = 0; kk < 2; ++kk) a = MFMA16(frag_n(L + B_QH, m0, kk, lo), frag_n(L + B_KH, n0, kk, lo), a);
                  if (n0 == m0) {
#pragma unroll
                      for (int rr = 0; rr < 4; ++rr) a[rr] = (frv <= 4 * fqv + rr) ? a[rr] : 0.f; }
                  st_tile_T(L + B_PT, m0, n0, lo, a); } } }
        __syncthreads();
        relaunder(lo);
#ifdef GLA_BATCH
        { const int n0 = 16 * w;
          bf16x8 pt[4][2], qh[4][2], kt[4][2], vv[2], stf[2]; f32x4 dec[4];
#pragma unroll
          for (int kk = 0; kk < 2; ++kk) { vv[kk] = frag_tv(L + B_VV, kk, n0, lo); stf[kk] = frag_n(L + B_ST, n0, kk, lo); }
#pragma unroll
          for (int m = 0; m < 4; ++m) { dec[m] = *(const LAS f32x4*)((const LAS float*)(L + B_CL) + 16 * m + 4 * fqv);
#pragma unroll
              for (int kk = 0; kk < 2; ++kk) { if (32 * kk < 16 * m + 16) pt[m][kk] = frag_t(L + B_PT, kk, 16 * m, lo); qh[m][kk] = frag_n(L + B_QH, 16 * m, kk, lo); kt[m][kk] = frag_t(L + B_KT, kk, 16 * m, lo); } }
          __builtin_amdgcn_sched_barrier(0); asm volatile("s_waitcnt lgkmcnt(0)" ::: "memory"); __builtin_amdgcn_sched_barrier(0);
          f32x4 oacc[4];
#pragma unroll
          for (int m = 0; m < 4; ++m) { f32x4 a = {0.f, 0.f, 0.f, 0.f};
#pragma unroll
              for (int kk = 0; kk < 2; ++kk) { if (32 * kk < 16 * m + 16) a = MFMA16(pt[m][kk], vv[kk], a); a = MFMA16(qh[m][kk], stf[kk], a); }
              oacc[m] = a; }
#pragma unroll
          for (int m = 0; m < 4; ++m) { f32x4 a = sacc[m];
#pragma unroll
              for (int rr = 0; rr < 4; ++rr) a[rr] *= ex2(dec[m][rr]);
#pragma unroll
              for (int kk = 0; kk < 2; ++kk) a = MFMA16(kt[m][kk], vv[kk], a);
              sacc[m] = a; }
#pragma unroll
          for (int m = 0; m < 4; ++m) {
#pragma unroll
              for (int rr = 0; rr < 4; ++rr) ((LAS float*)(L + B_OB))[(16 * m + 4 * fqv + rr) * 132 + n0 + frv] = oacc[m][rr];
              st_tile_T(L + B_ST, 16 * m, n0, lo, sacc[m]); } }
#else
        { const int n0 = 16 * w;
#pragma unroll
          for (int m = 0; m < 4; ++m) { f32x4 a = {0.f, 0.f, 0.f, 0.f};
#pragma unroll
              for (int kk = 0; kk < 2; ++kk) { if (32 * kk < 16 * m + 16) a = MFMA16(frag_t(L + B_PT, kk, 16 * m, lo), frag_tv(L + B_VV, kk, n0, lo), a);
                  a = MFMA16(frag_n(L + B_QH, 16 * m, kk, lo), frag_n(L + B_ST, n0, kk, lo), a); }
#pragma unroll
              for (int rr = 0; rr < 4; ++rr) ((LAS float*)(L + B_OB))[(16 * m + 4 * fqv + rr) * 132 + n0 + frv] = a[rr]; }
          asm volatile("" ::: "memory");
#pragma unroll
          for (int m = 0; m < 4; ++m) { f32x4 a = sacc[m];
#pragma unroll
              for (int rr = 0; rr < 4; ++rr) a[rr] *= ex2(((const LAS float*)(L + B_CL))[16 * m + 4 * fqv + rr]);
#pragma unroll
              for (int kk = 0; kk < 2; ++kk) a = MFMA16(frag_t(L + B_KT, kk, 16 * m, lo), frag_tv(L + B_VV, kk, n0, lo), a);
              sacc[m] = a; st_tile_T(L + B_ST, 16 * m, n0, lo, a); } }
#endif
        __syncthreads();
        { float v0[8], v1[8], g0[8], g1[8]; float ss = 0.f; const LAS float* ob = (const LAS float*)(L + B_OB) + tv * 132 + 2 * c8v;
          ld8l(ob, v0); ld8l(ob + 8, v1);
#pragma unroll
          for (int e = 0; e < 8; ++e) ss += v0[e] * v0[e] + v1[e] * v1[e];
          ss = sum8(ss);
          const float rstd = rsqrtf(ss * (1.f / 128.f) + NORM_EPS);
          ld8l((const LAS float*)(L + B_GN) + 2 * c8v, g0); ld8l((const LAS float*)(L + B_GN) + 2 * c8v + 8, g1);
          float o0[8], o1[8];
#pragma unroll
          for (int e = 0; e < 8; ++e) { o0[e] = v0[e] * rstd * g0[e]; o1[e] = v1[e] * rstd * g1[e]; }
          bf16_t* dst = Yout + ((size_t)b * SEQ + c * 64 + tv) * 512 + h * 128 + 2 * c8v;
          *(u32x4*)dst = pack8(o0); *(u32x4*)(dst + 8) = pack8(o1); }
    }
    asm volatile("s_waitcnt vmcnt(0)" ::: "memory");
    __syncthreads();
    if (tid == 0) __hip_atomic_fetch_add(done_ctr, 1u, __ATOMIC_RELEASE, __HIP_MEMORY_SCOPE_AGENT);
#undef GLA_LOAD
}
}

#define XB_TMO      128
#define XB_XCNT(j)  (256  + 64 * (j))
#define XB_XSUB(j)  (1280 + 64 * (j))
#define XB_XGEN(j)  (2304 + 64 * (j))
#define XB_TOP      3328
#define XB_TOPGEN   3392
#define XCD_BAR_WORDS 3456
#define XB_SPIN_CAP (1u << 18)

__device__ __forceinline__ unsigned xb_ld(unsigned* p)              { return __hip_atomic_load(p, __ATOMIC_RELAXED, __HIP_MEMORY_SCOPE_AGENT); }
__device__ __forceinline__ unsigned xb_add(unsigned* p, unsigned v) { return __hip_atomic_fetch_add(p, v, __ATOMIC_RELAXED, __HIP_MEMORY_SCOPE_AGENT); }
__device__ __forceinline__ unsigned xb_xcc_id() { return (unsigned)__builtin_amdgcn_s_getreg((3 << 11) | 20) & 0xFu; }
#define XB_SPIN(cond, bar) do { unsigned _sp = 0; while (cond) { __builtin_amdgcn_s_sleep(1); \
    if ((++_sp & 255u) == 0u) { if (xb_ld(&(bar)[XB_TMO])) break; if (_sp > XB_SPIN_CAP) { atomicAdd(&(bar)[XB_TMO], 1u); break; } } } } while (0)

struct XcdBarrier {
    unsigned* bar; unsigned x;
    volatile LAS unsigned* st;
};

__device__ __forceinline__ XcdBarrier xcd_barrier_post(unsigned* bar, volatile LAS unsigned* st) {
    XcdBarrier b; b.bar = bar; b.x = xb_xcc_id(); b.st = st;
    if (threadIdx.x == 0) (void)xb_add(&bar[XB_XCNT(b.x)], 1u);
    return b;
}
__device__ __forceinline__ void xcd_barrier_complete(unsigned* bar, unsigned x, unsigned& nloc, unsigned& nx) {
    const unsigned G = gridDim.x * gridDim.y * gridDim.z;
    unsigned sum, cnt, mine, sp = 0u;
    for (;;) {
        sum = 0u; cnt = 0u; mine = 0u;
#pragma unroll
        for (unsigned j = 0; j < 16; ++j) { const unsigned c = xb_ld(&bar[XB_XCNT(j)]); sum += c; cnt += (c > 0u) ? 1u : 0u; mine = (j == x) ? c : mine; }
        if (sum == G) break;
        __builtin_amdgcn_s_sleep(1);
        if ((++sp & 255u) == 0u) { if (xb_ld(&bar[XB_TMO])) break; if (sp > XB_SPIN_CAP) { atomicAdd(&bar[XB_TMO], 1u); break; } }
    }
    nloc = mine > 0u ? mine : 1u; nx = cnt > 0u ? cnt : 1u;
}

__device__ __forceinline__ void xcd_barrier(const XcdBarrier& b) {
    asm volatile("s_waitcnt vmcnt(0)" ::: "memory");
    __syncthreads();
    if (threadIdx.x == 0) {
        unsigned* bar = b.bar;
        __builtin_amdgcn_s_waitcnt(0);
        unsigned nloc = b.st[0], nx = b.st[1];
        if (nloc == 0u) { xcd_barrier_complete(bar, b.x, nloc, nx); b.st[0] = nloc; b.st[1] = nx; }
        const unsigned old = xb_add(&bar[XB_XSUB(b.x)], 1u);
        const unsigned gen = old / nloc;
        if (old + 1u == (gen + 1u) * nloc) {
            __builtin_amdgcn_fence(__ATOMIC_RELEASE, "agent");
            asm volatile("s_waitcnt vmcnt(0)" ::: "memory");
            const unsigned og = xb_add(&bar[XB_TOP], 1u);
            const unsigned tg = og / nx;
            if (og + 1u == (tg + 1u) * nx) xb_add(&bar[XB_TOPGEN], 1u);
            else XB_SPIN(xb_ld(&bar[XB_TOPGEN]) == tg, bar);
            __builtin_amdgcn_fence(__ATOMIC_ACQUIRE, "agent");
            xb_add(&bar[XB_XGEN(b.x)], 1u);
            asm volatile("s_waitcnt vmcnt(0)" ::: "memory");
        } else {
            XB_SPIN(xb_ld(&bar[XB_XGEN(b.x)]) == gen, bar);
            __builtin_amdgcn_fence(__ATOMIC_ACQUIRE, "agent");
            asm volatile("s_waitcnt vmcnt(0)" ::: "memory");
        }
    }
    __syncthreads();
}

constexpr int NWAVES = 8, NTHREADS = 512;
constexpr int LDS_MISC = 155648, LDS_BYTES = 159744;
constexpr int PH_PER_LAYER = 8, N_PHASES = 1 + DEPTH * PH_PER_LAYER;
constexpr int CW_BAR = 4096;
constexpr int MG_BLOCKS = 192;
constexpr int RWKV_BLOCKS = 64, GLA_BLOCKS = 32, SUB_BLOCKS = 256 - RWKV_BLOCKS - GLA_BLOCKS;
constexpr int N_ATT_UNITS = 64 * (SEQ / 512), N_MIX_ITEMS = N_ATT_UNITS;
#ifndef MK_MULTI_LAUNCH
#define MK_MULTI_LAUNCH 0
#endif

__device__ __forceinline__ void sub_barrier(unsigned* cnt, unsigned target) {
    asm volatile("s_waitcnt vmcnt(0)" ::: "memory");
    __syncthreads();
    if (threadIdx.x == 0) {
        __builtin_amdgcn_fence(__ATOMIC_RELEASE, "agent"); asm volatile("s_waitcnt vmcnt(0)" ::: "memory");
        __hip_atomic_fetch_add(cnt, 1u, __ATOMIC_RELAXED, __HIP_MEMORY_SCOPE_AGENT);
        unsigned sp = 0; while (__hip_atomic_load(cnt, __ATOMIC_RELAXED, __HIP_MEMORY_SCOPE_AGENT) < target && ++sp < (1u << 24)) __builtin_amdgcn_s_sleep(2);
        __builtin_amdgcn_fence(__ATOMIC_ACQUIRE, "agent"); asm volatile("s_waitcnt vmcnt(0)" ::: "memory");
    }
    __syncthreads();
}
__global__ void __launch_bounds__(NTHREADS, 2) hybrid_fwd(Params p_unused) {
    extern __shared__ __attribute__((aligned(16))) unsigned char lds[];
#ifndef NO_CG_SYNC
    cg::grid_group grid = cg::this_grid();
#endif
#define G ((int)gridDim.x)
#define bx ((int)blockIdx.x)
#define NGW (G * NWAVES)
#define PHASE_VARS const int tid = opaque_tid(), lane = tid & 63, wave = __builtin_amdgcn_readfirstlane(tid >> 6), gw = bx * NWAVES + wave; (void)lane; (void)gw
    LAS unsigned char* ldsl = (LAS unsigned char*)lds;
    { volatile LAS unsigned* misc = (volatile LAS unsigned*)(ldsl + LDS_MISC); if (threadIdx.x < 64) misc[threadIdx.x] = 0u; __syncthreads(); }
    (void)xcd_barrier_post((unsigned*)(kargs()->ws + WS_CTL) + CW_BAR, (volatile LAS unsigned*)(ldsl + LDS_MISC) + 8);
#define GRID_BAR() do { XcdBarrier xb_; xb_.bar = (unsigned*)(kargs()->ws + WS_CTL) + CW_BAR; xb_.x = xb_xcc_id(); xb_.st = (volatile LAS unsigned*)(ldsl + LDS_MISC) + 8; xcd_barrier(xb_); } while (0)
#ifndef EPI_ALIGN_PD1
#define EPI_ALIGN_PD1 true
#endif
#ifndef EPI_ALIGN_PA2
#define EPI_ALIGN_PA2 true
#endif
#ifndef REPEAT_PH
#define REPEAT_PH 0
#endif
#ifndef PH_MASK
#define PH_MASK 0xFFFF
#endif
#ifndef MIX_MASK
#define MIX_MASK 7
#endif
#define IN(k) true
#define EN(b) ((PH_MASK >> (b)) & 1)
#ifdef NO_CG_SYNC
#define SEAM(k) do { if (IN(k) && IN((k) + 1)) { GRID_BAR(); } } while (0)
#else
#define SEAM(k) do { if (IN(k) && IN((k) + 1)) { if ((k) == 0) grid.sync(); else GRID_BAR(); } } while (0)
#endif
#define WSP(type, off) ((type*)(ws + (off)))
#ifdef PROBE_TS_A
#define TS_PTR ((unsigned long long*)(kargs()->ws + WS_CTL + 40960))
#define TS_E0 ((volatile LAS unsigned long long*)(ldsl + LDS_MISC + 256))
#define TS_SET(i) do { if (l == 1 && threadIdx.x == 0) { if ((i) == 0) TS_E0[0] = (unsigned long long)__builtin_amdgcn_s_memrealtime(); else { const unsigned long long t_ = (unsigned long long)__builtin_amdgcn_s_memrealtime() - TS_E0[0]; atomicMax(TS_PTR + (i), t_); } } } while (0)
#define TS_MAX(i) do { if (l == 1 && threadIdx.x == 0) { const unsigned long long t_ = (unsigned long long)__builtin_amdgcn_s_memrealtime() - TS_E0[0]; atomicMax(TS_PTR + (i), t_); atomicMax(TS_PTR + (i) + 1, ~t_); } } while (0)
#else
#define TS_SET(i) do { } while (0)
#define TS_MAX(i) do { } while (0)
#endif

    if (EN(0) && IN(0)) { PHASE_VARS;
        convert_weights(0, lds, gw, NGW, wave, lane);
        KArgs kp = kargs(); unsigned char* ws = kp->ws; const int* positions = kp->positions; const float* x = kp->x; const float* g = kp->norm_pre;
        f32x2* ROPE = WSP(f32x2, WS_ROPE); bf16_t* HB = WSP(bf16_t, WS_HB);
        for (int i = bx * NTHREADS + tid; i < T * 16; i += G * NTHREADS) {
            const int t = i >> 4, j = i & 15; const float inv = exp2f(-(float)j * (13.287712379549449f / 16.0f));
            const float ang = (float)positions[t] * inv; const float k = rintf(ang * 0.15915494309189535f);
            float r = fmaf(-k, 6.2831854820251465f, ang); r = fmaf(-k, -1.7484555314695172e-7f, r);
            ROPE[i] = (f32x2){__cosf(r), __sinf(r)};
        }
        for (int m = gw; m < T; m += 4 * NGW) hb_rows4(x, g, HB, m, NGW, lane);
    }
    SEAM(0);
#ifdef EXTRA_SYNCS
    for (int i = 0; i < EXTRA_SYNCS; ++i) GRID_BAR();
#endif

    for (int l = 0; l < DEPTH; ++l) {
        const int P0 = 1 + l * PH_PER_LAYER;
        for (int rp = 0; rp < ((REPEAT_PH == 1) ? 2 : 1); ++rp) { if (rp) GRID_BAR();
        if (EN(1) && IN(P0 + 0)) {
            unsigned char* ws = kargs()->ws;
            pg8::PlainOrder S{(const char*)WSP(bf16_t, WS_HB), (const char*)WSP(bf16_t, WS_WIN), 1024, 1024, T / 256, NA / 256 + 1, G, bx, 0};
            EpiStore E{WSP(bf16_t, WS_PA), NA, ldsl, NA / 256, WSP(bf16_t, WS_YS)};
#ifdef STAGGER_US
            if (bx >= 128) { const unsigned long long t0_ = __builtin_amdgcn_s_memrealtime(); while (__builtin_amdgcn_s_memrealtime() - t0_ < (unsigned long long)(STAGGER_US * 100)) __builtin_amdgcn_s_sleep(8); }
#endif
            pg8::gemm_phase<EpiStore, pg8::PlainOrder, true>(ldsl, pg8::Gemm{1024, 1024, 1024}, S, E);
#ifdef PROBE_PA1NULL
#endif
        }
        }
        SEAM(P0 + 0);
        TS_SET(0);
        if (EN(2) && IN(P0 + 1)) { PHASE_VARS;
            if (bx >= RWKV_BLOCKS + GLA_BLOCKS) {
                unsigned char* ws = kargs()->ws; const int c2 = bx - RWKV_BLOCKS - GLA_BLOCKS;
                { const bf16_t* PA = WSP(bf16_t, WS_PA); const f32x2* ROPE = WSP(f32x2, WS_ROPE); float* RSTDQ = WSP(float, WS_RSTD); float* RSTDKV = RSTDQ + T; bf16_t* Kb = WSP(bf16_t, WS_K);
#ifdef MLA8
                  for (int m = c2 * NWAVES + wave; m < T; m += 8 * SUB_BLOCKS * NWAVES) mla_prep_rows8(PA, ROPE, RSTDQ, RSTDKV, Kb, m, SUB_BLOCKS * NWAVES, lane); }
#else
                  for (int m = c2 * NWAVES + wave; m < T; m += 4 * SUB_BLOCKS * NWAVES) mla_prep_rows4(PA, ROPE, RSTDQ, RSTDKV, Kb, m, SUB_BLOCKS * NWAVES, lane); }
#endif
                sub_barrier((unsigned*)(ws + WS_CTL) + 64 * 40, (unsigned)SUB_BLOCKS * (unsigned)(2 * l + 1));
                TS_MAX(26);
                { pg8::PlainOrder S{(const char*)(WSP(bf16_t, WS_PA) + CQ), (const char*)WSP(bf16_t, WS_WUQ), NA, 256, T / 256, 3, SUB_BLOCKS, c2, 0};
                  EpiQ E{WSP(bf16_t, WS_Q), WSP(float, WS_RSTD), ldsl};
                  pg8::gemm_phase<EpiQ, pg8::PlainOrder, true>(ldsl, pg8::Gemm{NA, 256, 256}, S, E); }
                { pg8::PlainOrder S{(const char*)(WSP(bf16_t, WS_PA) + CKV), (const char*)WSP(bf16_t, WS_WUKV), NA, 256, T / 256, 4, SUB_BLOCKS, c2, 0};
                  EpiKV E{WSP(bf16_t, WS_K), WSP(bf16_t, WS_V), WSP(float, WS_RSTD) + T, ldsl};
                  #ifdef KV_K128
                  int kkv_ = 128; asm volatile("" : "+s"(kkv_));
                  pg8::gemm_phase<EpiKV, pg8::PlainOrder, true>(ldsl, pg8::Gemm{NA, 256, kkv_}, S, E); }
#else
                  pg8::gemm_phase<EpiKV, pg8::PlainOrder, true>(ldsl, pg8::Gemm{NA, 256, 256}, S, E); }
#endif
                sub_barrier((unsigned*)(kargs()->ws + WS_CTL) + 64 * 40, (unsigned)SUB_BLOCKS * (unsigned)(2 * l + 2));
                TS_MAX(28);
            } else {
                if (bx >= RWKV_BLOCKS) { const int gi = bx - RWKV_BLOCKS; gla::gla_unit(l, gi >> 2, gi & 3, ldsl, (unsigned*)(kargs()->ws + WS_CTL) + 64 * (24 + l)); TS_MAX(12); }
                else {
#ifdef RWKV_TWICE
#pragma unroll 1
                for (int rep_ = 0; rep_ < RWKV_TWICE; ++rep_) { rwkv::rwkv_unit(l, bx >> 3, bx & 7, ldsl); __syncthreads(); }
#else
                rwkv::rwkv_unit(l, bx >> 3, bx & 7, ldsl);
#endif
                TS_MAX(8);
                }
                if (threadIdx.x == 0) { unsigned* cnt = (unsigned*)(kargs()->ws + WS_CTL) + 64 * 40; unsigned sp = 0;
                    while (__hip_atomic_load(cnt, __ATOMIC_RELAXED, __HIP_MEMORY_SCOPE_AGENT) < (unsigned)SUB_BLOCKS * (unsigned)(2 * l + 2) && ++sp < (1u << 24)) __builtin_amdgcn_s_sleep(2);
                    __builtin_amdgcn_fence(__ATOMIC_ACQUIRE, "agent"); asm volatile("s_waitcnt vmcnt(0)" ::: "memory"); }
                __syncthreads();
            }
        }
        if (EN(4) && IN(P0 + 3)) { PHASE_VARS;
            volatile LAS unsigned* qw = (volatile LAS unsigned*)(ldsl + LDS_MISC);
            for (;;) {
                __syncthreads();
                if (tid == 0) { unsigned* CTL = (unsigned*)(kargs()->ws + WS_CTL); qw[0] = atomicAdd(CTL + 64 * (1 + l), 1u); }
                __syncthreads();
                const int it = __builtin_amdgcn_readfirstlane((int)qw[0]);
                if (it >= N_MIX_ITEMS) break;
                { const int a = it; att::attn_unit((a & 63) >> 3, a & 7, (SEQ / 512 - 1) - (a >> 6), ldsl, (unsigned*)(kargs()->ws + WS_CTL) + 64 * (16 + l));  TS_MAX(10); }
            }
            { unsigned* ctl = (unsigned*)(kargs()->ws + WS_CTL);
              __syncthreads();
              if (tid == 0) { const unsigned tk = __hip_atomic_fetch_add(ctl + 64 * (20 + l), 1u, __ATOMIC_RELAXED, __HIP_MEMORY_SCOPE_AGENT); qw[0] = tk;
                  if (tk < (unsigned)MG_BLOCKS) { unsigned sp = 0; while (__hip_atomic_load(ctl + 64 * (16 + l), __ATOMIC_RELAXED, __HIP_MEMORY_SCOPE_AGENT) < (unsigned)N_ATT_UNITS && ++sp < (1u << 22)) __builtin_amdgcn_s_sleep(8); }
                  __builtin_amdgcn_fence(__ATOMIC_ACQUIRE, "agent"); asm volatile("s_waitcnt vmcnt(0)" ::: "memory"); }
              __syncthreads();
              const int tk = __builtin_amdgcn_readfirstlane((int)qw[0]);
              if (tk < MG_BLOCKS) TS_MAX(1);
              if (tk < MG_BLOCKS) {
                  unsigned char* ws = kargs()->ws;
                  pg8::PlainOrder S{(const char*)WSP(bf16_t, WS_HB), (const char*)(WSP(bf16_t, WS_WIN) + (size_t)(NA + 1536) * 1024), 1024, 1024, T / 256, 12, MG_BLOCKS, tk, 0};
                  EpiGateMG8 E{WSP(unsigned char, WS_SMG8), ldsl};
                  pg8::gemm_phase<EpiGateMG8, pg8::PlainOrder, true>(ldsl, pg8::Gemm{1024, 1024, 1024}, S, E);
                  TS_MAX(3);
                  __syncthreads();
                  if (tid == 0) { unsigned sp = 0; while (__hip_atomic_load(ctl + 64 * (24 + l), __ATOMIC_RELAXED, __HIP_MEMORY_SCOPE_AGENT) < 32u && ++sp < (1u << 22)) __builtin_amdgcn_s_sleep(8);
                      __builtin_amdgcn_fence(__ATOMIC_ACQUIRE, "agent"); asm volatile("s_waitcnt vmcnt(0)" ::: "memory"); }
                  __syncthreads();
                  pg8::PlainOrder S2{(const char*)WSP(bf16_t, WS_HB), (const char*)(WSP(bf16_t, WS_WIN) + (size_t)(NA + 256) * 1024), 1024, 1024, T / 256, 3, MG_BLOCKS, tk, 2, 0, -1, 1};
                  EpiGateBG E2{WSP(bf16_t, WS_YS), 1, 2, ldsl, 1};
                  pg8::gemm_phase<EpiGateBG, pg8::PlainOrder, true>(ldsl, pg8::Gemm{1024, 1024, 1024}, S2, E2);
                  TS_MAX(5);
              } }
        }
        SEAM(P0 + 3);
        TS_SET(7);
        if (EN(5) && IN(P0 + 4)) {
            unsigned char* ws = kargs()->ws;
            pg8::PlainOrder S{(const char*)WSP(bf16_t, WS_HB), (const char*)(WSP(bf16_t, WS_WIN) + (size_t)(NA + 512) * 1024), 1024, 1024, T / 256, 2, G, bx, 0};
            EpiGateBG E{WSP(bf16_t, WS_YS), 2, 0, ldsl};
            pg8::gemm_phase<EpiGateBG, pg8::PlainOrder, true>(ldsl, pg8::Gemm{1024, 1024, 1024}, S, E);
        }
        SEAM(P0 + 4);
        for (int rp = 0; rp < ((REPEAT_PH == 6 && l == 0) ? 2 : 1); ++rp) { if (rp) GRID_BAR();
        if (EN(6) && IN(P0 + 5)) {
            unsigned char* ws = kargs()->ws;
            pg8::GroupOrder3 S{(const char*)WSP(bf16_t, WS_YS), (const char*)WSP(bf16_t, WS_WBO), 512, 512, T / 256, 4, G, bx, (size_t)T * 512 * 2, (size_t)1024 * 512 * 2};
            EpiMerge E{WSP(bf16_t, WS_MG), WSP(unsigned char, WS_SMG8), ldsl};
            pg8::gemm_phase<EpiMerge, pg8::GroupOrder3, EPI_ALIGN_PD1>(ldsl, pg8::Gemm{512, 512, 512}, S, E);
        }
        }
        SEAM(P0 + 5);
        for (int rp = 0; rp < ((REPEAT_PH == 7 && l == 0) ? 2 : 1); ++rp) { if (rp) GRID_BAR();
        if (EN(7) && IN(P0 + 6)) {
            unsigned char* ws = kargs()->ws;
            pg8::PlainOrder S{(const char*)WSP(bf16_t, WS_MG), (const char*)WSP(bf16_t, WS_WOUT), 1024, 1024, T / 256, 4, G, bx, 0};
            EpiStore E{WSP(bf16_t, WS_OF), 1024, ldsl};
            pg8::gemm_phase<EpiStore, pg8::PlainOrder, true>(ldsl, pg8::Gemm{1024, 1024, 1024}, S, E);
        }
        }
        SEAM(P0 + 6);
        if (EN(8) && IN(P0 + 7)) { PHASE_VARS;
            const bool more = (l + 1 < DEPTH);
            if (more) convert_weights(l + 1, lds, gw, NGW, wave, lane);
            KArgs kp = kargs(); unsigned char* ws = kp->ws; float* out = kp->out; const float* xold = (l == 0) ? kp->x : out; const float* gpost = kp->norm_post + l * DM; const float* gnext = more ? kp->norm_pre + (l + 1) * DM : nullptr;
            const bf16_t* OF = WSP(bf16_t, WS_OF); bf16_t* HB = WSP(bf16_t, WS_HB);
#define PD3_LOOP(XI, XO) for (int m = gw; m < T; m += 4 * NGW) { RowIn<XI> rr_[4];     \
                _Pragma("unroll") for (int q_ = 0; q_ < 4; ++q_) final_load<XI>(rr_[q_], OF + (size_t)(m + q_ * NGW) * DM, xold + (size_t)(m + q_ * NGW) * DM, lane); \
                _Pragma("unroll") for (int q_ = 0; q_ < 4; ++q_) final_row<XI, XO>(rr_[q_], gpost, out + (size_t)(m + q_ * NGW) * DM, gnext, HB + (size_t)(m + q_ * NGW) * DM, lane); }
            if (l == 0) { if (more) { PD3_LOOP(false, true) } else { PD3_LOOP(false, false) } }
            else        { if (more) { PD3_LOOP(true, true) } else { PD3_LOOP(true, false) } }
#undef PD3_LOOP
        }
        if (l + 1 < DEPTH) SEAM(P0 + 7);
    }
#ifdef PROBE_TS_A
    if (bx == 0 && threadIdx.x == 0) {
        auto val = [&](int i) { unsigned long long v = __hip_atomic_load(TS_PTR + i, __ATOMIC_RELAXED, __HIP_MEMORY_SCOPE_AGENT); return (i == 2 || i == 4 || i == 6 || i == 9 || i == 11 || i == 13 || i == 27 || i == 29) ? ~v : v; };
        const unsigned long long d = val(PROBE_TS_A) - val(PROBE_TS_B);
        const unsigned long long t0_ = __builtin_amdgcn_s_memrealtime();
        if (d < 400000ull) while ((unsigned long long)__builtin_amdgcn_s_memrealtime() - t0_ < (unsigned long long)PROBE_TS_K * d) __builtin_amdgcn_s_sleep(8);
    }
#endif
#undef IN
#undef EN
#undef SEAM
#undef WSP
#undef PHASE_VARS
#undef G
#undef bx
#undef NGW
}

extern "C" void kernel_launch(void* const* d_in, const int* in_sizes, int n_in, void* d_out, int out_size, void* d_ws, size_t ws_size, hipStream_t stream) {
    static int grid = 0;
    if (grid == 0) {
        if (n_in != 24 || in_sizes[0] != T * DM || out_size != T * DM || ws_size < WS_END) {
            fprintf(stderr, "kernel_launch: unexpected shapes (n_in %d, in0 %d, out %d, ws %zu; need ws >= %zu); nothing launched\n", n_in, n_in > 0 ? in_sizes[0] : -1, out_size, ws_size, (size_t)WS_END);
            grid = -1; return; }
        int dev = 0, cus = 0, per_cu = 0;
        (void)hipGetDevice(&dev); (void)hipDeviceGetAttribute(&cus, hipDeviceAttributeMultiprocessorCount, dev);
        if (hipFuncSetAttribute((const void*)hybrid_fwd, hipFuncAttributeMaxDynamicSharedMemorySize, LDS_BYTES) != hipSuccess) { fprintf(stderr, "kernel_launch: hipFuncSetAttribute failed\n"); grid = -1; return; }
        if (hipOccupancyMaxActiveBlocksPerMultiprocessor(&per_cu, (const void*)hybrid_fwd, NTHREADS, LDS_BYTES) != hipSuccess || per_cu < 1) {
            fprintf(stderr, "kernel_launch: occupancy query reports %d blocks per CU\n", per_cu); per_cu = 1; }
        (void)hipGetLastError();
        grid = cus * (per_cu < 1 ? 1 : 1);
        fprintf(stderr, "kernel_launch: grid %d (cus %d, occupancy %d), ws %zu\n", grid, cus, per_cu, ws_size);
    }
    if (grid < 0) return;
    (void)hipMemsetAsync((char*)d_ws + WS_CTL, 0, 65536, stream);
    Params p{};
    p.x = (const float*)d_in[0]; p.positions = (const int*)d_in[1]; p.norm_pre = (const float*)d_in[2]; p.w_in = (const float*)d_in[3]; p.mla_q_norm = (const float*)d_in[4]; p.mla_kv_norm = (const float*)d_in[5];
    p.mla_w_uq = (const float*)d_in[6]; p.mla_w_ukv = (const float*)d_in[7]; p.rwkv_mu = (const float*)d_in[8]; p.rwkv_w0 = (const float*)d_in[9]; p.rwkv_w_up = (const float*)d_in[10]; p.rwkv_a0 = (const float*)d_in[11];
    p.rwkv_a_up = (const float*)d_in[12]; p.rwkv_k_k = (const float*)d_in[13]; p.rwkv_k_a = (const float*)d_in[14]; p.rwkv_r_k = (const float*)d_in[15]; p.rwkv_ln_w = (const float*)d_in[16]; p.rwkv_ln_b = (const float*)d_in[17];
    p.gla_a_up = (const float*)d_in[18]; p.gla_a_b = (const float*)d_in[19]; p.gla_norm = (const float*)d_in[20]; p.w_branch_out = (const float*)d_in[21]; p.w_out = (const float*)d_in[22]; p.norm_post = (const float*)d_in[23];
    p.out = (float*)d_out; p.ws = (unsigned char*)d_ws;
#if MK_MULTI_LAUNCH
    for (int ph = 0; ph < N_PHASES; ++ph) { p.ph_lo = ph; p.ph_hi = ph + 1; void* args[] = {&p};
        hipError_t e = hipLaunchCooperativeKernel((const void*)hybrid_fwd, dim3(grid), dim3(NTHREADS), args, LDS_BYTES, stream);
        if (e != hipSuccess) { fprintf(stderr, "kernel_launch: launch of phase %d failed: %s\n", ph, hipGetErrorString(e)); break; } }
#else
    p.ph_lo = 0; p.ph_hi = N_PHASES; void* args[] = {&p};
    hipError_t e = hipLaunchCooperativeKernel((const void*)hybrid_fwd, dim3(grid), dim3(NTHREADS), args, LDS_BYTES, stream);
    if (e != hipSuccess) fprintf(stderr, "kernel_launch: cooperative launch failed: %s (grid %d)\n", hipGetErrorString(e), grid);
#endif
}
```
